# Optimizing an MI355X kernel written in HIP

```python
import jax, jax.numpy as jnp
from jax import lax
import numpy as np

D_MODEL = 2048
BATCH = 4
SEQ = 2048
DEPTH = 1

PLE_DIM = 256
MIX_W = D_MODEL
HGRN_W = MIX_W // 2
CONV_W = MIX_W - HGRN_W
HGRN_HEAD_DIM = 128
HGRN_HEADS = HGRN_W // HGRN_HEAD_DIM
HGRN_CHUNK = 64
CONV_K = 3
CONV_GROUPS = 8
D_FF = 5632
EPS = 1e-6
MIX_IN = 4 * HGRN_W + 3 * CONV_W
SPLITS = [HGRN_W, 2 * HGRN_W, 3 * HGRN_W, 4 * HGRN_W,
          4 * HGRN_W + CONV_W, 4 * HGRN_W + 2 * CONV_W]

kernel_name = "hymba_hgrn2_shortconv_macaron"


def rms_norm(x, g):
    xf = x.astype(jnp.float32)
    r = lax.rsqrt(jnp.mean(xf * xf, axis=-1, keepdims=True) + EPS)
    return (xf * r).astype(x.dtype) * g


def swiglu(x, w_gate, w_up, w_down):
    return (jax.nn.silu(x @ w_gate) * (x @ w_up)) @ w_down


def hgrn2_chunked(q, f_logit, v, lb):
    bsz, s, h, dh = q.shape
    nc = s // HGRN_CHUNK
    qf = jax.nn.silu(q.astype(jnp.float32))
    f = lb + (1.0 - lb) * jax.nn.sigmoid(f_logit.astype(jnp.float32))
    k = 1.0 - f
    log_f = jnp.log(f)
    vf = v.astype(jnp.float32)

    def to_chunks(a):
        return a.reshape(bsz, nc, HGRN_CHUNK, h, dh).transpose(1, 0, 3, 2, 4)

    qc, kc, vc, lc = to_chunks(qf), to_chunks(k), to_chunks(vf), to_chunks(log_f)
    bc = jnp.cumsum(lc, axis=-2)
    causal = jnp.tril(jnp.ones((HGRN_CHUNK, HGRN_CHUNK), dtype=bool))

    def step(state, xs):
        qx, kx, vx, bx = xs
        rel = bx[..., :, None, :] - bx[..., None, :, :]
        decay = jnp.exp(jnp.where(causal[:, :, None], rel, -jnp.inf))
        scores = jnp.einsum('bhtk,bhsk,bhtsk->bhts', qx, kx, decay)
        o = (jnp.einsum('bhts,bhsv->bhtv', scores, vx)
             + jnp.einsum('bhtk,bhkv->bhtv', qx * jnp.exp(bx), state))
        b_last = bx[..., -1:, :]
        state = (jnp.exp(b_last)[..., 0, :, None] * state
                 + jnp.einsum('bhsk,bhsv->bhkv', kx * jnp.exp(b_last - bx), vx))
        return state, o

    s0 = jnp.zeros((bsz, h, dh, dh), jnp.float32)
    _, o = lax.scan(step, s0, (qc, kc, vc, bc))
    return o.transpose(1, 0, 3, 2, 4).reshape(bsz, s, h, dh).astype(q.dtype)


def short_conv(b_gate, c_gate, v, w_conv):
    u = c_gate * v
    up = jnp.pad(u, ((0, 0), (CONV_K - 1, 0), (0, 0)))
    s = u.shape[1]
    y = w_conv[0] * up[:, 0:s] + w_conv[1] * up[:, 1:s + 1] + w_conv[2] * up[:, 2:s + 2]
    return b_gate * y


def setup_inputs(seed: int = 0) -> dict:
    key = jax.random.key(seed)
    ks = jax.random.split(key, 24)

    def w(k, shape, fan_in):
        return jax.random.normal(k, shape, jnp.float32) * (fan_in ** -0.5)

    def gain(k, shape):
        return 1.0 + 0.02 * jax.random.normal(k, shape, jnp.float32)

    return {
        "x": jax.random.normal(ks[0], (BATCH, SEQ, D_MODEL), jnp.float32),
        "p": jax.random.normal(ks[1], (DEPTH, BATCH, SEQ, PLE_DIM), jnp.float32),
        "norm_ffn1": gain(ks[2], (DEPTH, D_MODEL)),
        "ffn1_gate": w(ks[3], (DEPTH, D_MODEL, D_FF), D_MODEL),
        "ffn1_up": w(ks[4], (DEPTH, D_MODEL, D_FF), D_MODEL),
        "ffn1_down": w(ks[5], (DEPTH, D_FF, D_MODEL), D_FF),
        "norm_mix": gain(ks[6], (DEPTH, D_MODEL)),
        "w_in": w(ks[7], (DEPTH, D_MODEL, MIX_IN), D_MODEL),
        "conv_w": w(ks[8], (DEPTH, CONV_K, CONV_W), CONV_K),
        "hgrn_lb_logits": jax.random.normal(ks[9], (DEPTH + 1, HGRN_W), jnp.float32),
        "hgrn_norm": gain(ks[10], (DEPTH, HGRN_HEAD_DIM)),
        "conv_norm": gain(ks[11], (DEPTH, CONV_W)),
        "w_out": w(ks[12], (DEPTH, MIX_W, D_MODEL), MIX_W),
        "norm_ffn2": gain(ks[13], (DEPTH, D_MODEL)),
        "ffn2_gate": w(ks[14], (DEPTH, D_MODEL, D_FF), D_MODEL),
        "ffn2_up": w(ks[15], (DEPTH, D_MODEL, D_FF), D_MODEL),
        "ffn2_down": w(ks[16], (DEPTH, D_FF, D_MODEL), D_FF),
        "norm_ple": gain(ks[17], (DEPTH, D_MODEL)),
        "w_ple": w(ks[18], (DEPTH, PLE_DIM, D_MODEL), PLE_DIM),
        "w_ple_gate": w(ks[19], (DEPTH, D_MODEL, D_MODEL), D_MODEL),
        "norm_final": gain(ks[20], (D_MODEL,)),
    }


def reference(x, p, norm_ffn1, ffn1_gate, ffn1_up, ffn1_down, norm_mix, w_in, conv_w,
              hgrn_lb_logits, hgrn_norm, conv_norm, w_out, norm_ffn2, ffn2_gate, ffn2_up,
              ffn2_down, norm_ple, w_ple, w_ple_gate, norm_final):
    bsz, s, _ = x.shape
    lb_all = jnp.cumsum(jax.nn.softmax(hgrn_lb_logits.astype(jnp.float32), axis=0), axis=0)
    h = x
    for i in range(DEPTH):
        h = h + 0.5 * swiglu(rms_norm(h, norm_ffn1[i]), ffn1_gate[i], ffn1_up[i], ffn1_down[i])

        u = rms_norm(h, norm_mix[i])
        proj = u @ w_in[i]
        q, f_logit, v_h, g_h, b_c, c_c, v_c = jnp.split(proj, SPLITS, axis=-1)

        hd = (bsz, s, HGRN_HEADS, HGRN_HEAD_DIM)
        lb = lb_all[i].reshape(HGRN_HEADS, HGRN_HEAD_DIM)
        o_h = hgrn2_chunked(q.reshape(hd), f_logit.reshape(hd), v_h.reshape(hd), lb)
        o_h = rms_norm(o_h, hgrn_norm[i]) * jax.nn.silu(g_h.reshape(hd))
        o_h = o_h.reshape(bsz, s, HGRN_W)

        y_c = short_conv(b_c, c_c, v_c, conv_w[i])
        y_c = rms_norm(y_c.reshape(bsz, s, CONV_GROUPS, CONV_W // CONV_GROUPS),
                       conv_norm[i].reshape(CONV_GROUPS, CONV_W // CONV_GROUPS)).reshape(bsz, s, CONV_W)

        h = h + jnp.concatenate([o_h, y_c], axis=-1) @ w_out[i]

        h = h + 0.5 * swiglu(rms_norm(h, norm_ffn2[i]), ffn2_gate[i], ffn2_up[i], ffn2_down[i])

        gate = jax.nn.sigmoid(rms_norm(h, norm_ple[i]) @ w_ple_gate[i])
        h = h + gate * (p[i] @ w_ple[i])
    return rms_norm(h, norm_final)
```

```cpp
#include <hip/hip_runtime.h>
#include <hip/hip_cooperative_groups.h>
#include <cstdio>
#include <cstdint>
namespace pg8 {
#define PG8_LAS __attribute__((address_space(3)))
typedef unsigned short bf16_t;
typedef short bf16x8 __attribute__((ext_vector_type(8)));
typedef float f32x4 __attribute__((ext_vector_type(4)));
typedef unsigned u32x4 __attribute__((ext_vector_type(4)));
constexpr int BM = 256, BK = 64, HALF = 128, HTB = HALF * BK * 2  , STAGE_BYTES = 8 * HTB, NXCD = 8, WGM = 8;

__host__ __device__ __forceinline__ int lds_byte(int r, int c) { const int st = (r >> 4) * 2 + (c >> 5), rr = r & 15, cc = c & 31, ob = rr * 64 + cc * 2; return st * 1024 + (ob ^ (((ob >> 9) & 1) << 5)); }
__host__ __device__ __forceinline__ void stage_rc(int b, int& R, int& C) { const int st = b / 1024, sb = b % 1024, swz = sb ^ (((sb >> 9) & 1) << 5); R = (st >> 1) * 16 + swz / 64; C = (st & 1) * 32 + (swz % 64) / 2; }
__host__ __device__ __forceinline__ int perm32(int rho) { const int n = rho >> 4, i = rho & 15; return 8 * (i >> 2) + 4 * n + (i & 3); }

struct Unit { int pm, pn; };
struct Gemm { const bf16_t* A; const bf16_t* Bt; int M, N, K; };

struct StaticOrder {
    int nM, nN, nwg, G, c;
    __host__ __device__ void init(int M, int N, int G_, int c_) { nM = M / BM; nN = N / BM; nwg = nM * nN; G = G_; c = c_; }
    __host__ __device__ bool next(int i, Unit& u) const {
        const long L = (long)i * G + c; if (L >= nwg) return false;
        int wgid = (int)L; { const int q = nwg / NXCD, r = nwg % NXCD, xcd = wgid % NXCD, off = wgid / NXCD; wgid = (xcd < r ? xcd * (q + 1) : r * (q + 1) + (xcd - r) * q) + off; }
        const int nig = WGM * nN, gid = wgid / nig, fm = gid * WGM, gsz = (nM - fm) < WGM ? (nM - fm) : WGM;
        u.pm = fm + ((wgid % nig) % gsz); u.pn = (wgid % nig) / gsz; return true;
    }
    __device__ __forceinline__ void a_ready(const Unit&) const {}
    __device__ __forceinline__ void done(const Unit&) const {}
};
typedef float f32x2 __attribute__((ext_vector_type(2)));
template <class Epi, class Sched, bool ALIGN_EPI = false, bool SP2 = false>
__device__ __forceinline__ void gemm_phase(PG8_LAS unsigned char* lds, const Gemm g, const Sched& S, const Epi& E) {
    const int tid = threadIdx.x, wid = __builtin_amdgcn_readfirstlane(tid >> 6), lane = tid & 63, wr = wid >> 2, wc = wid & 3, fr = lane & 15, fq = lane >> 4;
    const int K = g.K, nt = K / BK;
    unsigned voffA[2], voffB[2];
#pragma unroll
    for (int i = 0; i < 2; ++i) { int R, C; stage_rc(tid * 16 + i * 8192, R, C); const int Rb = Epi::PERM ? ((R & ~31) + perm32(R & 31)) : R;
        voffA[i] = (unsigned)(R * K + C) * 2u; voffB[i] = (unsigned)(Rb * K + C) * 2u; }
    const size_t kstep = (size_t)(BK * 2);
    const size_t hstep = (size_t)HALF * K * 2;
    const size_t tstep = 2 * hstep;
    const unsigned ldsw = (unsigned)wid * 1024u;
    const int aoff = lds_byte(wr * 64 + fr, fq * 8), boff = lds_byte(wc * 32 + fr, fq * 8);
#define PG8_SA(b, h) (((b) * 2 + (h)) * HTB)
#define PG8_SB(b, h) ((4 + (b) * 2 + (h)) * HTB)
#define PG8_STAGE(bufoff, gbase, voff) do { _Pragma("unroll") for (int _i = 0; _i < 2; ++_i) \
        __builtin_amdgcn_global_load_lds((const unsigned*)((const char*)(gbase) + (voff)[_i]), (PG8_LAS unsigned*)(lds + (bufoff) + ldsw + _i * 8192), 16, 0, 0); } while (0)
#define PG8_LDA(dst, b, h) do { _Pragma("unroll") for (int m = 0; m < 4; ++m) _Pragma("unroll") for (int k = 0; k < 2; ++k) dst[m][k] = *(const PG8_LAS bf16x8*)(lds + PG8_SA(b, h) + aoff + m * 2048 + k * 1024); } while (0)
#define PG8_LDB(dst, b, h) do { _Pragma("unroll") for (int n = 0; n < 2; ++n) _Pragma("unroll") for (int k = 0; k < 2; ++k) dst[n][k] = *(const PG8_LAS bf16x8*)(lds + PG8_SB(b, h) + boff + n * 2048 + k * 1024); } while (0)
#define PG8_MMA(ai, bj, At, Bt) do { __builtin_amdgcn_s_setprio(1); _Pragma("unroll") for (int m = 0; m < 4; ++m) _Pragma("unroll") for (int n = 0; n < 2; ++n) _Pragma("unroll") for (int k = 0; k < 2; ++k) \
        acc[ai][bj][m][n] = __builtin_amdgcn_mfma_f32_16x16x32_bf16(Bt[n][k], At[m][k], acc[ai][bj][m][n], 0, 0, 0); __builtin_amdgcn_s_setprio(0); } while (0)
#define PG8_WAIT_V(n) asm volatile("s_waitcnt vmcnt(" #n ")" ::: "memory")
#define PG8_WAIT_L(n) asm volatile("s_waitcnt lgkmcnt(" #n ")" ::: "memory")
#define PG8_BAR __builtin_amdgcn_s_barrier()
#define PG8_SCHED __builtin_amdgcn_sched_barrier(0)
    Unit cur, nxt; int ui = 0;
    if (!S.next(0, cur)) return;
    f32x4 acc[2][2][4][2];
#pragma unroll
    for (int a = 0; a < 2; ++a)
#pragma unroll
        for (int b = 0; b < 2; ++b)
#pragma unroll
            for (int m = 0; m < 4; ++m)
#pragma unroll
                for (int n = 0; n < 2; ++n) acc[a][b][m][n] = (f32x4){0.f, 0.f, 0.f, 0.f};
    bf16x8 At[4][2], B0[2][2], B1[2][2];
    const char* cA = (const char*)g.A + (size_t)cur.pm * tstep; const char* cB = (const char*)g.Bt + (size_t)cur.pn * tstep;
    S.a_ready(cur);
    if constexpr (SP2) {
        PG8_STAGE(PG8_SB(0, 0), cB, voffB); PG8_STAGE(PG8_SB(0, 1), cB + hstep, voffB); PG8_STAGE(PG8_SA(0, 0), cA, voffA); PG8_STAGE(PG8_SA(0, 1), cA + hstep, voffA);
        if (wr == 1) PG8_BAR;
        PG8_WAIT_V(2); PG8_BAR;
        PG8_STAGE(PG8_SB(1, 0), cB + kstep, voffB); PG8_STAGE(PG8_SA(1, 0), cA + kstep, voffA); PG8_STAGE(PG8_SB(1, 1), cB + hstep + kstep, voffB);
        PG8_WAIT_V(6); PG8_BAR;
    } else {
        PG8_STAGE(PG8_SB(0, 0), cB, voffB); PG8_STAGE(PG8_SA(0, 0), cA, voffA); PG8_STAGE(PG8_SB(0, 1), cB + hstep, voffB); PG8_STAGE(PG8_SA(0, 1), cA + hstep, voffA);
        if (wr == 1) PG8_BAR;
        PG8_WAIT_V(4); PG8_BAR;
        PG8_STAGE(PG8_SB(1, 0), cB + kstep, voffB); PG8_STAGE(PG8_SA(1, 0), cA + kstep, voffA); PG8_STAGE(PG8_SB(1, 1), cB + hstep + kstep, voffB);
        PG8_WAIT_V(6); PG8_BAR;
    }
    for (;;) {
        const bool has_next = S.next(ui + 1, nxt);
        const char* nA = has_next ? (const char*)g.A + (size_t)nxt.pm * tstep : cA; const char* nB = has_next ? (const char*)g.Bt + (size_t)nxt.pn * tstep : cB;
        for (int t = 0; t < nt; t += 2) {
            const bool last = (t == nt - 2);
            const char* a1 = cA + (size_t)(t + 1) * kstep;
            const char* a2 = last ? nA : cA + (size_t)(t + 2) * kstep; const char* b2 = last ? nB : cB + (size_t)(t + 2) * kstep;
            const char* a3 = a2 + kstep; const char* b3 = b2 + kstep;
            if (last && has_next) S.a_ready(nxt);
            if constexpr (SP2) {
            PG8_LDB(B0, 0, 0); PG8_LDB(B1, 0, 1); PG8_SCHED; PG8_LDA(At, 0, 0); PG8_STAGE(PG8_SA(1, 1), a1 + hstep, voffA);
            PG8_WAIT_V(8); PG8_WAIT_L(0); PG8_BAR; PG8_MMA(0, 0, At, B0); PG8_MMA(0, 1, At, B1); PG8_BAR; PG8_SCHED;
            PG8_LDA(At, 0, 1); PG8_STAGE(PG8_SB(0, 0), b2, voffB); PG8_STAGE(PG8_SB(0, 1), b2 + hstep, voffB); PG8_STAGE(PG8_SA(0, 0), a2, voffA);
            PG8_WAIT_V(8); PG8_WAIT_L(0); PG8_BAR; PG8_MMA(1, 0, At, B0); PG8_MMA(1, 1, At, B1); PG8_BAR; PG8_SCHED;
            PG8_LDB(B0, 1, 0); PG8_LDB(B1, 1, 1); PG8_SCHED; PG8_LDA(At, 1, 0); PG8_STAGE(PG8_SA(0, 1), a2 + hstep, voffA);
            PG8_WAIT_V(8); PG8_WAIT_L(0); PG8_BAR; PG8_MMA(0, 0, At, B0); PG8_MMA(0, 1, At, B1); PG8_BAR; PG8_SCHED;
            PG8_LDA(At, 1, 1); PG8_STAGE(PG8_SB(1, 0), b3, voffB); PG8_STAGE(PG8_SB(1, 1), b3 + hstep, voffB); PG8_STAGE(PG8_SA(1, 0), a3, voffA);
            PG8_WAIT_V(8); PG8_WAIT_L(0); PG8_BAR; PG8_MMA(1, 0, At, B0); PG8_MMA(1, 1, At, B1); PG8_BAR; PG8_SCHED;
            } else {
            PG8_LDB(B0, 0, 0); PG8_SCHED; PG8_LDA(At, 0, 0); PG8_STAGE(PG8_SA(1, 1), a1 + hstep, voffA);
            PG8_WAIT_L(8); PG8_BAR; PG8_WAIT_L(0); PG8_MMA(0, 0, At, B0); PG8_BAR; PG8_SCHED;
            PG8_LDB(B1, 0, 1); PG8_STAGE(PG8_SB(0, 0), b2, voffB);
            PG8_BAR; PG8_WAIT_L(0); PG8_MMA(0, 1, At, B1); PG8_BAR;
            PG8_LDA(At, 0, 1); PG8_STAGE(PG8_SA(0, 0), a2, voffA);
            PG8_BAR; PG8_WAIT_L(0); PG8_MMA(1, 0, At, B0); PG8_BAR; PG8_SCHED;
            PG8_STAGE(PG8_SB(0, 1), b2 + hstep, voffB);
            PG8_WAIT_V(6); PG8_BAR; PG8_MMA(1, 1, At, B1); PG8_BAR;
            PG8_LDB(B0, 1, 0); PG8_SCHED; PG8_LDA(At, 1, 0); PG8_STAGE(PG8_SA(0, 1), a2 + hstep, voffA);
            PG8_WAIT_L(8); PG8_BAR; PG8_WAIT_L(0); PG8_MMA(0, 0, At, B0); PG8_BAR; PG8_SCHED;
            PG8_LDB(B1, 1, 1); PG8_STAGE(PG8_SB(1, 0), b3, voffB);
            PG8_BAR; PG8_WAIT_L(0); PG8_MMA(0, 1, At, B1); PG8_BAR;
            PG8_LDA(At, 1, 1); PG8_STAGE(PG8_SA(1, 0), a3, voffA);
            PG8_BAR; PG8_WAIT_L(0); PG8_MMA(1, 0, At, B0); PG8_BAR; PG8_SCHED;
            PG8_STAGE(PG8_SB(1, 1), b3 + hstep, voffB);
            PG8_WAIT_V(6); PG8_BAR; PG8_MMA(1, 1, At, B1); PG8_BAR;
            }
        }
        if constexpr (ALIGN_EPI) { if (wr == 0) PG8_BAR; }
        if constexpr (!Epi::AFTER_DRAIN) { E(acc, cur, wr, wc, fr, fq); S.done(cur); }
        if (!has_next) break;
#pragma unroll
        for (int a = 0; a < 2; ++a)
#pragma unroll
            for (int b = 0; b < 2; ++b)
#pragma unroll
                for (int m = 0; m < 4; ++m)
#pragma unroll
                    for (int n = 0; n < 2; ++n) acc[a][b][m][n] = (f32x4){0.f, 0.f, 0.f, 0.f};
        cur = nxt; cA = nA; cB = nB; ++ui;
        if constexpr (ALIGN_EPI) { if (wr == 1) PG8_BAR; }
    }
    PG8_WAIT_V(0);
    if constexpr (!ALIGN_EPI) { if (wr == 0) PG8_BAR; }
    PG8_BAR;
    if constexpr (Epi::AFTER_DRAIN) { E.fused(acc, cur, wr, wc, fr, fq, lds, wid, lane); S.done(cur); }
#undef PG8_SA
#undef PG8_SB
#undef PG8_STAGE
#undef PG8_LDA
#undef PG8_LDB
#undef PG8_MMA
#undef PG8_WAIT_V
#undef PG8_WAIT_L
#undef PG8_BAR
#undef PG8_SCHED
}
}

namespace cg = cooperative_groups;
using pg8::bf16_t; using pg8::bf16x8; using pg8::f32x4; using pg8::u32x4; using pg8::Unit;
__device__ __forceinline__ unsigned cvt_pk_bf16(float lo, float hi) { unsigned r; asm volatile("v_cvt_pk_bf16_f32 %0, %1, %2" : "=v"(r) : "v"(lo), "v"(hi)); return r; }
#define LAS __attribute__((address_space(3)))
typedef unsigned u32x2 __attribute__((ext_vector_type(2)));
typedef float f32x2v __attribute__((ext_vector_type(2)));

constexpr int M_TOK = 8192, DM = 2048, FF = 5632, HW = 1024, CW = 1024, MIXIN = 7168, PLE = 256, SEQ = 2048;
constexpr float EPS = 1e-6f;
constexpr size_t MiB = 1ull << 20;
constexpr size_t WS_W1GU = 0, WS_W1D = 44 * MiB, WS_WIN = 66 * MiB, WS_WOUT = 94 * MiB, WS_W2GU = 102 * MiB, WS_W2D = 146 * MiB,
                 WS_WPG = 168 * MiB, WS_WPE = 176 * MiB, WS_PB = 177 * MiB, WS_XB = 181 * MiB, WS_MIX = 213 * MiB, WS_G = 245 * MiB,
                 WS_QS = 245 * MiB, WS_VH = 261 * MiB, WS_GH = 277 * MiB, WS_BC = 293 * MiB, WS_UC = 309 * MiB, WS_LF = 325 * MiB,
                 WS_S = 357 * MiB, WS_PLE = 245 * MiB, WS_SS = 389 * MiB, WS_END = 390 * MiB, WS_U = 0, WS_OT = 0;
constexpr int LDS_BYTES = 144 * 1024;
constexpr int NPHASE = 12;

__device__ __forceinline__ float bf2f(bf16_t b) { return __uint_as_float(((unsigned)b) << 16); }
__device__ __forceinline__ float bflo(unsigned w) { return __uint_as_float(w << 16); }
__device__ __forceinline__ float bfhi(unsigned w) { return __uint_as_float(w & 0xffff0000u); }
__device__ __forceinline__ float wave_sum(float v) {
#pragma unroll
    for (int o = 1; o < 64; o <<= 1) v += __shfl_xor(v, o);
    return v;
}
__device__ __forceinline__ float fsigmoid(float x) { return __builtin_amdgcn_rcpf(1.0f + __expf(-x)); }
__device__ __forceinline__ float fsilu(float x) { return x * fsigmoid(x); }
__device__ __forceinline__ float rinv_of(float ss) { return rsqrtf(ss * (1.0f / DM) + EPS); }

struct EpiGateUp {
    static constexpr bool PERM = true, AFTER_DRAIN = false;
    bf16_t* G; const float* ss;
    __device__ __forceinline__ void operator()(const f32x4 (&acc)[2][2][4][2], const Unit& u, int wr, int wc, int fr, int fq) const {
        const int row0 = u.pm * 256 + wr * 64 + fr, col0 = u.pn * 128 + wc * 32 + 8 * fq;
#pragma unroll
        for (int ai = 0; ai < 2; ++ai)
#pragma unroll
            for (int m = 0; m < 4; ++m) {
                const int r = row0 + ai * 128 + m * 16; const float ri = rinv_of(ss[r]);
                float v[8];
#pragma unroll
                for (int n = 0; n < 2; ++n)
#pragma unroll
                    for (int j = 0; j < 4; ++j) v[n * 4 + j] = fsilu(acc[ai][0][m][n][j] * ri) * (acc[ai][1][m][n][j] * ri);
                u32x4 w; w.x = cvt_pk_bf16(v[0], v[1]); w.y = cvt_pk_bf16(v[2], v[3]); w.z = cvt_pk_bf16(v[4], v[5]); w.w = cvt_pk_bf16(v[6], v[7]);
                *(u32x4*)(G + (size_t)r * FF + col0) = w;
            }
    }
};
struct EpiResid {
    static constexpr bool PERM = true, AFTER_DRAIN = false;
    const float* R; float* H; bf16_t* XB; float* ss_out; float scale;
    __device__ __forceinline__ void operator()(const f32x4 (&acc)[2][2][4][2], const Unit& u, int wr, int wc, int fr, int fq) const {
        const int row0 = u.pm * 256 + wr * 64 + fr, col0 = u.pn * 256 + wc * 32 + 8 * fq;
#pragma unroll
        for (int ai = 0; ai < 2; ++ai)
#pragma unroll
            for (int m = 0; m < 4; ++m) {
                const int r = row0 + ai * 128 + m * 16; float sq = 0.f;
#pragma unroll
                for (int bj = 0; bj < 2; ++bj) {
                    const size_t off = (size_t)r * DM + col0 + bj * 128;
                    f32x4 v0 = *(const f32x4*)(R + off) + acc[ai][bj][m][0] * scale, v1 = *(const f32x4*)(R + off + 4) + acc[ai][bj][m][1] * scale;
                    *(f32x4*)(H + off) = v0; *(f32x4*)(H + off + 4) = v1;
                    u32x4 w; w.x = cvt_pk_bf16(v0[0], v0[1]); w.y = cvt_pk_bf16(v0[2], v0[3]); w.z = cvt_pk_bf16(v1[0], v1[1]); w.w = cvt_pk_bf16(v1[2], v1[3]);
                    *(u32x4*)(XB + off) = w;
                    sq += (v0[0] * v0[0] + v0[1] * v0[1]) + (v0[2] * v0[2] + v0[3] * v0[3]) + (v1[0] * v1[0] + v1[1] * v1[1]) + (v1[2] * v1[2] + v1[3] * v1[3]);
                }
                sq += __shfl_xor(sq, 16); sq += __shfl_xor(sq, 32);
                if (fq == 0) atomicAdd(ss_out + r, sq);
            }
    }
};
struct EpiMixIn {
    static constexpr bool PERM = true, AFTER_DRAIN = false;
    const float* ss; const float* lbl;
    bf16_t *QS, *UC; float* LF;
    __device__ __forceinline__ void operator()(const f32x4 (&acc)[2][2][4][2], const Unit& u, int wr, int wc, int fr, int fq) const {
        const int row0 = u.pm * 256 + wr * 64 + fr; const int sec = u.pn >> 2;
        if (u.pn >= 20) {
            const int col0 = (u.pn - 20) * 128 + wc * 32 + 8 * fq;
#pragma unroll
            for (int ai = 0; ai < 2; ++ai)
#pragma unroll
                for (int m = 0; m < 4; ++m) {
                    const int r = row0 + ai * 128 + m * 16; const float ri = rinv_of(ss[r]); const float ri2 = ri * ri;
                    float v[8];
#pragma unroll
                    for (int n = 0; n < 2; ++n)
#pragma unroll
                        for (int j = 0; j < 4; ++j) v[n * 4 + j] = acc[ai][0][m][n][j] * acc[ai][1][m][n][j] * ri2;
                    u32x4 w; w.x = cvt_pk_bf16(v[0], v[1]); w.y = cvt_pk_bf16(v[2], v[3]); w.z = cvt_pk_bf16(v[4], v[5]); w.w = cvt_pk_bf16(v[6], v[7]);
                    *(u32x4*)(UC + (size_t)r * CW + col0) = w;
                }
            return;
        }
        const int col0 = (u.pn & 3) * 256 + wc * 32 + 8 * fq;
        if (sec == 1) {
#pragma unroll
            for (int bj = 0; bj < 2; ++bj)
#pragma unroll
                for (int n = 0; n < 2; ++n) {
                    const int c = col0 + bj * 128 + 4 * n; const f32x4 l0 = *(const f32x4*)(lbl + c), l1 = *(const f32x4*)(lbl + 1024 + c);
                    f32x4 lb; lb[0] = fsigmoid(l0[0] - l1[0]); lb[1] = fsigmoid(l0[1] - l1[1]); lb[2] = fsigmoid(l0[2] - l1[2]); lb[3] = fsigmoid(l0[3] - l1[3]);
#pragma unroll
                    for (int ai = 0; ai < 2; ++ai)
#pragma unroll
                        for (int m = 0; m < 4; ++m) {
                            const int r = row0 + ai * 128 + m * 16; const float ri = rinv_of(ss[r]);
                            const f32x4 x = acc[ai][bj][m][n]; f32x4 o;
                            o[0] = __logf(lb[0] + (1.0f - lb[0]) * fsigmoid(x[0] * ri)); o[1] = __logf(lb[1] + (1.0f - lb[1]) * fsigmoid(x[1] * ri));
                            o[2] = __logf(lb[2] + (1.0f - lb[2]) * fsigmoid(x[2] * ri)); o[3] = __logf(lb[3] + (1.0f - lb[3]) * fsigmoid(x[3] * ri));
                            *(f32x4*)(LF + (size_t)r * HW + c) = o;
                        }
                }
            return;
        }
        bf16_t* dst = QS + (size_t)(sec == 0 ? 0 : sec - 1) * ((size_t)M_TOK * HW);
        const bool act = (sec == 0 || sec == 3);
#pragma unroll
        for (int ai = 0; ai < 2; ++ai)
#pragma unroll
            for (int m = 0; m < 4; ++m) {
                const int r = row0 + ai * 128 + m * 16; const float ri = rinv_of(ss[r]);
#pragma unroll
                for (int bj = 0; bj < 2; ++bj) {
                    float v[8];
#pragma unroll
                    for (int n = 0; n < 2; ++n)
#pragma unroll
                        for (int j = 0; j < 4; ++j) { const float x = acc[ai][bj][m][n][j] * ri; v[n * 4 + j] = act ? fsilu(x) : x; }
                    u32x4 w; w.x = cvt_pk_bf16(v[0], v[1]); w.y = cvt_pk_bf16(v[2], v[3]); w.z = cvt_pk_bf16(v[4], v[5]); w.w = cvt_pk_bf16(v[6], v[7]);
                    *(u32x4*)(dst + (size_t)r * HW + col0 + bj * 128) = w;
                }
            }
    }
};
struct EpiStoreBf16 {
    static constexpr bool PERM = true, AFTER_DRAIN = false;
    bf16_t* O;
    __device__ __forceinline__ void operator()(const f32x4 (&acc)[2][2][4][2], const Unit& u, int wr, int wc, int fr, int fq) const {
        const int row0 = u.pm * 256 + wr * 64 + fr, col0 = u.pn * 256 + wc * 32 + 8 * fq;
#pragma unroll
        for (int ai = 0; ai < 2; ++ai)
#pragma unroll
            for (int m = 0; m < 4; ++m) {
                const int r = row0 + ai * 128 + m * 16;
#pragma unroll
                for (int bj = 0; bj < 2; ++bj) {
                    const f32x4 v0 = acc[ai][bj][m][0], v1 = acc[ai][bj][m][1];
                    u32x4 w; w.x = cvt_pk_bf16(v0[0], v0[1]); w.y = cvt_pk_bf16(v0[2], v0[3]); w.z = cvt_pk_bf16(v1[0], v1[1]); w.w = cvt_pk_bf16(v1[2], v1[3]);
                    *(u32x4*)(O + (size_t)r * DM + col0 + bj * 128) = w;
                }
            }
    }
};
struct EpiPleGate {
    static constexpr bool PERM = true, AFTER_DRAIN = false;
    float* H; const bf16_t* P; const float* ss;
    __device__ __forceinline__ void operator()(const f32x4 (&acc)[2][2][4][2], const Unit& u, int wr, int wc, int fr, int fq) const {
        const int row0 = u.pm * 256 + wr * 64 + fr, col0 = u.pn * 256 + wc * 32 + 8 * fq;
#pragma unroll
        for (int ai = 0; ai < 2; ++ai)
#pragma unroll
            for (int m = 0; m < 4; ++m) {
                const int r = row0 + ai * 128 + m * 16; const float ri = rinv_of(ss[r]);
#pragma unroll
                for (int bj = 0; bj < 2; ++bj) {
                    const size_t off = (size_t)r * DM + col0 + bj * 128;
                    const u32x4 pw = *(const u32x4*)(P + off);
                    f32x4 v0 = *(const f32x4*)(H + off), v1 = *(const f32x4*)(H + off + 4);
                    const f32x4 a0 = acc[ai][bj][m][0], a1 = acc[ai][bj][m][1];
                    v0[0] += fsigmoid(a0[0] * ri) * bflo(pw.x); v0[1] += fsigmoid(a0[1] * ri) * bfhi(pw.x);
                    v0[2] += fsigmoid(a0[2] * ri) * bflo(pw.y); v0[3] += fsigmoid(a0[3] * ri) * bfhi(pw.y);
                    v1[0] += fsigmoid(a1[0] * ri) * bflo(pw.z); v1[1] += fsigmoid(a1[1] * ri) * bfhi(pw.z);
                    v1[2] += fsigmoid(a1[2] * ri) * bflo(pw.w); v1[3] += fsigmoid(a1[3] * ri) * bfhi(pw.w);
                    *(f32x4*)(H + off) = v0; *(f32x4*)(H + off + 4) = v1;
                }
            }
    }
};

template <int MODE>
__device__ __forceinline__ void p0_item(const float* W, const float* W2, const float* gain, int K, int N, bf16_t* WT, LAS float* scr, int item, int lane) {
    const int nblk_k = K / 64; const int nb = item / nblk_k, kb = item % nblk_k; const int k0 = 64 * kb, n0 = 32 * nb;
    const float* src = W; int c0 = n0;
    if (MODE == 1) { const int t = n0 >> 8, bj = (n0 >> 7) & 1, c = n0 & 127; src = bj ? W2 : W; c0 = 128 * t + c; }
    if (MODE == 2) { if (n0 >= 5120) { const int tt = n0 - 5120; const int t = tt >> 8, bj = (tt >> 7) & 1, c = tt & 127; c0 = 5120 + 1024 * bj + 128 * t + c; } }
#pragma unroll 8
    for (int i = 0; i < 32; ++i) { const int kk = 2 * i + (lane >> 5); float v = src[(size_t)(k0 + kk) * N + c0 + (lane & 31)]; if (gain) v *= gain[k0 + kk]; scr[kk * 33 + (lane & 31)] = v; }
    asm volatile("s_waitcnt lgkmcnt(0)" ::: "memory");
    const int c = lane & 7;
#pragma unroll
    for (int j = 0; j < 4; ++j) { const int n = (lane >> 3) + 8 * j; const LAS float* s = scr + (8 * c) * 33 + n;
        u32x4 o; o.x = cvt_pk_bf16(s[0 * 33], s[1 * 33]); o.y = cvt_pk_bf16(s[2 * 33], s[3 * 33]); o.z = cvt_pk_bf16(s[4 * 33], s[5 * 33]); o.w = cvt_pk_bf16(s[6 * 33], s[7 * 33]);
        *(u32x4*)(WT + (size_t)(n0 + n) * K + k0 + 8 * c) = o; }
    asm volatile("s_waitcnt lgkmcnt(0)" ::: "memory");
}

struct Args { const float* in[21]; float* out; unsigned char* ws; int ph_lo, ph_hi; };

__device__ __forceinline__ void phase0(const Args& a, LAS unsigned char* lds, int wave, int lane) {
    unsigned char* ws = a.ws;
    LAS float* scr = (LAS float*)(lds + wave * 16384);
    const int gw = blockIdx.x * 8 + wave, NGW = gridDim.x * 8;
    constexpr int I0 = 32 * 352, I1 = 88 * 64, I2 = 32 * 224, I3 = 32 * 64, I7 = 4 * 64;
    constexpr int NIT = 2 * I0 + 2 * I1 + I2 + 2 * I3 + I7;
    for (int it = gw; it < NIT; it += NGW) {
        int r = it;
        if (r < I0) { p0_item<1>(a.in[3], a.in[4], a.in[2], DM, FF, (bf16_t*)(ws + WS_W1GU), scr, r, lane); continue; } r -= I0;
        if (r < I0) { p0_item<1>(a.in[14], a.in[15], a.in[13], DM, FF, (bf16_t*)(ws + WS_W2GU), scr, r, lane); continue; } r -= I0;
        if (r < I1) { p0_item<0>(a.in[5], nullptr, nullptr, FF, DM, (bf16_t*)(ws + WS_W1D), scr, r, lane); continue; } r -= I1;
        if (r < I1) { p0_item<0>(a.in[16], nullptr, nullptr, FF, DM, (bf16_t*)(ws + WS_W2D), scr, r, lane); continue; } r -= I1;
        if (r < I2) { p0_item<2>(a.in[7], nullptr, a.in[6], DM, MIXIN, (bf16_t*)(ws + WS_WIN), scr, r, lane); continue; } r -= I2;
        if (r < I3) { p0_item<0>(a.in[12], nullptr, nullptr, DM, DM, (bf16_t*)(ws + WS_WOUT), scr, r, lane); continue; } r -= I3;
        if (r < I3) { p0_item<0>(a.in[19], nullptr, a.in[17], DM, DM, (bf16_t*)(ws + WS_WPG), scr, r, lane); continue; } r -= I3;
        p0_item<0>(a.in[18], nullptr, nullptr, PLE, DM, (bf16_t*)(ws + WS_WPE), scr, r, lane);
    }
    float* SS = (float*)(ws + WS_SS);
    for (int m = gw; m < M_TOK; m += NGW) {
        const f32x4* xr = (const f32x4*)(a.in[0] + (size_t)m * DM) + lane; u32x2* xb = (u32x2*)((bf16_t*)(ws + WS_XB) + (size_t)m * DM) + lane;
        float s = 0.f;
#pragma unroll
        for (int j = 0; j < 8; ++j) { const f32x4 v = xr[64 * j]; s += (v[0] * v[0] + v[1] * v[1]) + (v[2] * v[2] + v[3] * v[3]);
            u32x2 w; w.x = cvt_pk_bf16(v[0], v[1]); w.y = cvt_pk_bf16(v[2], v[3]); xb[64 * j] = w; }
        s = wave_sum(s);
        if (lane == 0) { SS[m] = s; SS[8192 + m] = 0.f; SS[16384 + m] = 0.f; SS[24576 + m] = 0.f; }
    }
    { const int gt = blockIdx.x * 512 + threadIdx.x, NT = gridDim.x * 512;
      for (int i = gt; i < M_TOK * PLE / 4; i += NT) { const f32x4 v = ((const f32x4*)a.in[1])[i]; u32x2 w; w.x = cvt_pk_bf16(v[0], v[1]); w.y = cvt_pk_bf16(v[2], v[3]); ((u32x2*)(ws + WS_PB))[i] = w; } }
}

__device__ __forceinline__ void phase_hgrn_naive(const Args& a) {
    if (blockIdx.x >= 32 || threadIdx.x >= 128) return;
    unsigned char* ws = a.ws;
    const bf16_t* QS = (const bf16_t*)(ws + WS_QS); const float* LF = (const float*)(ws + WS_LF); const bf16_t* VH = (const bf16_t*)(ws + WS_VH);
    float* OT = (float*)(ws + WS_OT);
    const int b = blockIdx.x >> 3, h = blockIdx.x & 7, v = threadIdx.x;
    float S[128];
#pragma unroll
    for (int k = 0; k < 128; ++k) S[k] = 0.f;
    for (int t = 0; t < SEQ; ++t) {
        const size_t base = (size_t)(b * SEQ + t) * HW + h * 128;
        const float vt = bf2f(VH[base + v]);
        float o = 0.f;
#pragma unroll
        for (int k4 = 0; k4 < 32; ++k4) {
            const f32x4 lf = *(const f32x4*)(LF + base + 4 * k4); const u32x2 qw = *(const u32x2*)(QS + base + 4 * k4);
            const float q[4] = {bflo(qw.x), bfhi(qw.x), bflo(qw.y), bfhi(qw.y)};
#pragma unroll
            for (int j = 0; j < 4; ++j) { const float f = __expf(lf[j]); S[4 * k4 + j] = f * S[4 * k4 + j] + (1.0f - f) * vt; o += q[j] * S[4 * k4 + j]; }
        }
        OT[base + v] = o;
    }
}

__device__ __forceinline__ void phase_finalize(const Args& a, int wave, int lane) {
    unsigned char* ws = a.ws;
    const float* OT = (const float*)(ws + WS_OT); const bf16_t* GH = (const bf16_t*)(ws + WS_GH); const bf16_t* BC = (const bf16_t*)(ws + WS_BC); const bf16_t* UC = (const bf16_t*)(ws + WS_UC);
    bf16_t* MIX = (bf16_t*)(ws + WS_MIX);
    const float* hn = a.in[10]; const float* cn = a.in[11]; const float* cw = a.in[8];
    const int gw = blockIdx.x * 8 + wave, NGW = gridDim.x * 8;
    for (int it = gw; it < M_TOK * 16; it += NGW) {
        const int row = it >> 4, grp = it & 15;
        if (grp < 8) {
            const size_t off = (size_t)row * HW + grp * 128 + 2 * lane;
            const f32x2v o = *(const f32x2v*)(OT + off); const unsigned g = *(const unsigned*)(GH + off);
            const float ssq = wave_sum(o[0] * o[0] + o[1] * o[1]); const float ri = rsqrtf(ssq * (1.0f / 128) + EPS);
            const f32x2v w = *(const f32x2v*)(hn + 2 * lane);
            *(unsigned*)(MIX + (size_t)row * DM + grp * 128 + 2 * lane) = cvt_pk_bf16(o[0] * ri * w[0] * bflo(g), o[1] * ri * w[1] * bfhi(g));
        } else {
            const int c = (grp - 8) * 128 + 2 * lane; const int t = row & (SEQ - 1);
            const size_t off = (size_t)row * CW + c;
            const unsigned u0 = *(const unsigned*)(UC + off); const unsigned u1 = t >= 1 ? *(const unsigned*)(UC + off - CW) : 0u; const unsigned u2 = t >= 2 ? *(const unsigned*)(UC + off - 2 * CW) : 0u;
            const unsigned bg = *(const unsigned*)(BC + off);
            const f32x2v w0 = *(const f32x2v*)(cw + c), w1 = *(const f32x2v*)(cw + CW + c), w2 = *(const f32x2v*)(cw + 2 * CW + c);
            const float y0 = bflo(bg) * (w0[0] * bflo(u2) + w1[0] * bflo(u1) + w2[0] * bflo(u0));
            const float y1 = bfhi(bg) * (w0[1] * bfhi(u2) + w1[1] * bfhi(u1) + w2[1] * bfhi(u0));
            const float ssq = wave_sum(y0 * y0 + y1 * y1); const float ri = rsqrtf(ssq * (1.0f / 128) + EPS);
            const f32x2v g = *(const f32x2v*)(cn + c);
            *(unsigned*)(MIX + (size_t)row * DM + HW + c) = cvt_pk_bf16(y0 * ri * g[0], y1 * ri * g[1]);
        }
    }
}

__device__ __forceinline__ void phase_final(const Args& a, int wave, int lane) {
    const int gw = blockIdx.x * 8 + wave, NGW = gridDim.x * 8; const float* gF = a.in[20];
    for (int m = gw; m < M_TOK; m += NGW) {
        f32x4* xr = (f32x4*)(a.out + (size_t)m * DM) + lane; f32x4 v[8]; float s = 0.f;
#pragma unroll
        for (int j = 0; j < 8; ++j) { v[j] = xr[64 * j]; s += (v[j][0] * v[j][0] + v[j][1] * v[j][1]) + (v[j][2] * v[j][2] + v[j][3] * v[j][3]); }
        const float ri = rinv_of(wave_sum(s));
#pragma unroll
        for (int j = 0; j < 8; ++j) { const f32x4 g = ((const f32x4*)gF)[64 * j + lane]; xr[64 * j] = v[j] * ri * g; }
    }
}

template <class Epi>
__device__ __forceinline__ void run_gemm(LAS unsigned char* lds, const bf16_t* A, const bf16_t* Bt, int N, int K, const Epi& E) {
    pg8::Gemm g; g.A = A; g.Bt = Bt; g.M = M_TOK; g.N = N; g.K = K;
    pg8::StaticOrder S; S.init(M_TOK, N, (int)gridDim.x, (int)blockIdx.x);
    pg8::gemm_phase<Epi, pg8::StaticOrder, true, true>(lds, g, S, E);
}

__global__ void __launch_bounds__(512, 2) fwd_kernel(Args a) {
    extern __shared__ __attribute__((aligned(16))) unsigned char lds_raw[];
    LAS unsigned char* lds = (LAS unsigned char*)lds_raw;
    cg::grid_group grid = cg::this_grid();
    const int tid = threadIdx.x, lane = tid & 63, wave = __builtin_amdgcn_readfirstlane(tid >> 6);
    unsigned char* ws = a.ws;
    float* SS = (float*)(ws + WS_SS);
    bf16_t* XB = (bf16_t*)(ws + WS_XB); bf16_t* G = (bf16_t*)(ws + WS_G); bf16_t* MIX = (bf16_t*)(ws + WS_MIX);
#define PH(i) if (a.ph_lo <= (i) && (i) < a.ph_hi)
#define SYNC(i) if (a.ph_lo <= (i) && (i) + 1 < a.ph_hi) grid.sync();
    PH(0) { phase0(a, lds, wave, lane); } SYNC(0)
    PH(1) { EpiGateUp E; E.G = G; E.ss = SS; run_gemm(lds, XB, (const bf16_t*)(ws + WS_W1GU), 2 * FF, DM, E); } SYNC(1)
    PH(2) { EpiResid E; E.R = a.in[0]; E.H = a.out; E.XB = XB; E.ss_out = SS + 8192; E.scale = 0.5f; run_gemm(lds, G, (const bf16_t*)(ws + WS_W1D), DM, FF, E); } SYNC(2)
    PH(3) { EpiMixIn E; E.ss = SS + 8192; E.lbl = a.in[9]; E.QS = (bf16_t*)(ws + WS_QS);
            E.UC = (bf16_t*)(ws + WS_UC); E.LF = (float*)(ws + WS_LF); run_gemm(lds, XB, (const bf16_t*)(ws + WS_WIN), MIXIN, DM, E); } SYNC(3)
    PH(4) { phase_hgrn_naive(a); } SYNC(4)
    PH(5) { phase_finalize(a, wave, lane); } SYNC(5)
    PH(6) { EpiResid E; E.R = a.out; E.H = a.out; E.XB = XB; E.ss_out = SS + 16384; E.scale = 1.0f; run_gemm(lds, MIX, (const bf16_t*)(ws + WS_WOUT), DM, DM, E); } SYNC(6)
    PH(7) { EpiGateUp E; E.G = G; E.ss = SS + 16384; run_gemm(lds, XB, (const bf16_t*)(ws + WS_W2GU), 2 * FF, DM, E); } SYNC(7)
    PH(8) { EpiResid E; E.R = a.out; E.H = a.out; E.XB = XB; E.ss_out = SS + 24576; E.scale = 0.5f; run_gemm(lds, G, (const bf16_t*)(ws + WS_W2D), DM, FF, E); } SYNC(8)
    PH(9) { EpiStoreBf16 E; E.O = (bf16_t*)(ws + WS_PLE); int kp = PLE; asm volatile("" : "+s"(kp)); run_gemm(lds, (const bf16_t*)(ws + WS_PB), (const bf16_t*)(ws + WS_WPE), DM, kp, E); } SYNC(9)
    PH(10) { EpiPleGate E; E.H = a.out; E.P = (const bf16_t*)(ws + WS_PLE); E.ss = SS + 24576; run_gemm(lds, XB, (const bf16_t*)(ws + WS_WPG), DM, DM, E); } SYNC(10)
    PH(11) { phase_final(a, wave, lane); }
#undef PH
#undef SYNC
}

#ifndef MK_MULTI
#define MK_MULTI 0
#endif
extern "C" void kernel_launch(void* const* d_in, const int* in_sizes, int n_in, void* d_out, int out_size, void* d_ws, size_t ws_size, hipStream_t stream) {
    static int grid = 0;
    if (grid == 0) {
        if (n_in != 21 || out_size != M_TOK * DM || ws_size < WS_END) { fprintf(stderr, "kernel_launch: unexpected shapes (n_in %d out %d ws %zu need %zu)\n", n_in, out_size, ws_size, (size_t)WS_END); grid = -1; return; }
        int dev = 0, cus = 0, per_cu = 0;
        hipGetDevice(&dev); hipDeviceGetAttribute(&cus, hipDeviceAttributeMultiprocessorCount, dev);
        if (hipFuncSetAttribute((const void*)fwd_kernel, hipFuncAttributeMaxDynamicSharedMemorySize, LDS_BYTES) != hipSuccess) { fprintf(stderr, "kernel_launch: hipFuncSetAttribute failed\n"); grid = -1; return; }
        if (hipOccupancyMaxActiveBlocksPerMultiprocessor(&per_cu, (const void*)fwd_kernel, 512, LDS_BYTES) != hipSuccess || per_cu < 1) { fprintf(stderr, "kernel_launch: occupancy query failed (%d)\n", per_cu); grid = -1; return; }
        grid = cus * per_cu;
    }
    if (grid < 0) return;
    Args a{};
    for (int i = 0; i < 21; ++i) a.in[i] = (const float*)d_in[i];
    a.out = (float*)d_out; a.ws = (unsigned char*)d_ws;
#if MK_MULTI
    for (int p = 0; p < NPHASE; ++p) { a.ph_lo = p; a.ph_hi = p + 1; hipLaunchKernelGGL(fwd_kernel, dim3(grid), dim3(512), LDS_BYTES, stream, a); }
#else
    a.ph_lo = 0; a.ph_hi = NPHASE;
    void* args[] = {&a};
    hipError_t e = hipLaunchCooperativeKernel((void*)fwd_kernel, dim3(grid), dim3(512), args, LDS_BYTES, stream);
    if (e != hipSuccess) fprintf(stderr, "cooperative launch failed: %s (grid %d)\n", hipGetErrorString(e), grid);
#endif
}
```

```cpp
#include <hip/hip_runtime.h>
#include <hip/hip_cooperative_groups.h>
#include <cstdio>
#include <cstdint>
namespace pg8 {
#define PG8_LAS __attribute__((address_space(3)))
typedef unsigned short bf16_t;
typedef short bf16x8 __attribute__((ext_vector_type(8)));
typedef float f32x4 __attribute__((ext_vector_type(4)));
typedef unsigned u32x4 __attribute__((ext_vector_type(4)));
constexpr int BM = 256, BK = 64, HALF = 128, HTB = HALF * BK * 2  , STAGE_BYTES = 8 * HTB, NXCD = 8, WGM = 8;

__host__ __device__ __forceinline__ int lds_byte(int r, int c) { const int st = (r >> 4) * 2 + (c >> 5), rr = r & 15, cc = c & 31, ob = rr * 64 + cc * 2; return st * 1024 + (ob ^ (((ob >> 9) & 1) << 5)); }
__host__ __device__ __forceinline__ void stage_rc(int b, int& R, int& C) { const int st = b / 1024, sb = b % 1024, swz = sb ^ (((sb >> 9) & 1) << 5); R = (st >> 1) * 16 + swz / 64; C = (st & 1) * 32 + (swz % 64) / 2; }
__host__ __device__ __forceinline__ int perm32(int rho) { const int n = rho >> 4, i = rho & 15; return 8 * (i >> 2) + 4 * n + (i & 3); }

struct Unit { int pm, pn; };
struct Gemm { const bf16_t* A; const bf16_t* Bt; int M, N, K; };

struct StaticOrder {
    int nM, nN, nwg, G, c;
    __host__ __device__ void init(int M, int N, int G_, int c_) { nM = M / BM; nN = N / BM; nwg = nM * nN; G = G_; c = c_; }
    __host__ __device__ bool next(int i, Unit& u) const {
        const long L = (long)i * G + c; if (L >= nwg) return false;
        int wgid = (int)L; { const int q = nwg / NXCD, r = nwg % NXCD, xcd = wgid % NXCD, off = wgid / NXCD; wgid = (xcd < r ? xcd * (q + 1) : r * (q + 1) + (xcd - r) * q) + off; }
        const int nig = WGM * nN, gid = wgid / nig, fm = gid * WGM, gsz = (nM - fm) < WGM ? (nM - fm) : WGM;
        u.pm = fm + ((wgid % nig) % gsz); u.pn = (wgid % nig) / gsz; return true;
    }
    __device__ __forceinline__ void a_ready(const Unit&) const {}
    __device__ __forceinline__ void done(const Unit&) const {}
};
typedef float f32x2 __attribute__((ext_vector_type(2)));
template <class Epi, class Sched, bool ALIGN_EPI = false, bool SP2 = false>
__device__ __forceinline__ void gemm_phase(PG8_LAS unsigned char* lds, const Gemm g, const Sched& S, const Epi& E) {
    const int tid = threadIdx.x, wid = __builtin_amdgcn_readfirstlane(tid >> 6), lane = tid & 63, wr = wid >> 2, wc = wid & 3, fr = lane & 15, fq = lane >> 4;
    const int K = g.K, nt = K / BK;
    unsigned voffA[2], voffB[2];
#pragma unroll
    for (int i = 0; i < 2; ++i) { int R, C; stage_rc(tid * 16 + i * 8192, R, C); const int Rb = Epi::PERM ? ((R & ~31) + perm32(R & 31)) : R;
        voffA[i] = (unsigned)(R * K + C) * 2u; voffB[i] = (unsigned)(Rb * K + C) * 2u; }
    const size_t kstep = (size_t)(BK * 2);
    const size_t hstep = (size_t)HALF * K * 2;
    const size_t tstep = 2 * hstep;
    const unsigned ldsw = (unsigned)wid * 1024u;
    const int aoff = lds_byte(wr * 64 + fr, fq * 8), boff = lds_byte(wc * 32 + fr, fq * 8);
#define PG8_SA(b, h) (((b) * 2 + (h)) * HTB)
#define PG8_SB(b, h) ((4 + (b) * 2 + (h)) * HTB)
#define PG8_STAGE(bufoff, gbase, voff) do { _Pragma("unroll") for (int _i = 0; _i < 2; ++_i) \
        __builtin_amdgcn_global_load_lds((const unsigned*)((const char*)(gbase) + (voff)[_i]), (PG8_LAS unsigned*)(lds + (bufoff) + ldsw + _i * 8192), 16, 0, 0); } while (0)
#define PG8_LDA(dst, b, h) do { _Pragma("unroll") for (int m = 0; m < 4; ++m) _Pragma("unroll") for (int k = 0; k < 2; ++k) dst[m][k] = *(const PG8_LAS bf16x8*)(lds + PG8_SA(b, h) + aoff + m * 2048 + k * 1024); } while (0)
#define PG8_LDB(dst, b, h) do { _Pragma("unroll") for (int n = 0; n < 2; ++n) _Pragma("unroll") for (int k = 0; k < 2; ++k) dst[n][k] = *(const PG8_LAS bf16x8*)(lds + PG8_SB(b, h) + boff + n * 2048 + k * 1024); } while (0)
#define PG8_MMA(ai, bj, At, Bt) do { __builtin_amdgcn_s_setprio(1); _Pragma("unroll") for (int m = 0; m < 4; ++m) _Pragma("unroll") for (int n = 0; n < 2; ++n) _Pragma("unroll") for (int k = 0; k < 2; ++k) \
        acc[ai][bj][m][n] = __builtin_amdgcn_mfma_f32_16x16x32_bf16(Bt[n][k], At[m][k], acc[ai][bj][m][n], 0, 0, 0); __builtin_amdgcn_s_setprio(0); } while (0)
#define PG8_WAIT_V(n) asm volatile("s_waitcnt vmcnt(" #n ")" ::: "memory")
#define PG8_WAIT_L(n) asm volatile("s_waitcnt lgkmcnt(" #n ")" ::: "memory")
#define PG8_BAR __builtin_amdgcn_s_barrier()
#define PG8_SCHED __builtin_amdgcn_sched_barrier(0)
    Unit cur, nxt; int ui = 0;
    if (!S.next(0, cur)) return;
    f32x4 acc[2][2][4][2];
#pragma unroll
    for (int a = 0; a < 2; ++a)
#pragma unroll
        for (int b = 0; b < 2; ++b)
#pragma unroll
            for (int m = 0; m < 4; ++m)
#pragma unroll
                for (int n = 0; n < 2; ++n) acc[a][b][m][n] = (f32x4){0.f, 0.f, 0.f, 0.f};
    bf16x8 At[4][2], B0[2][2], B1[2][2];
    const char* cA = (const char*)g.A + (size_t)cur.pm * tstep; const char* cB = (const char*)g.Bt + (size_t)cur.pn * tstep;
    S.a_ready(cur);
    if constexpr (SP2) {
        PG8_STAGE(PG8_SB(0, 0), cB, voffB); PG8_STAGE(PG8_SB(0, 1), cB + hstep, voffB); PG8_STAGE(PG8_SA(0, 0), cA, voffA); PG8_STAGE(PG8_SA(0, 1), cA + hstep, voffA);
        if (wr == 1) PG8_BAR;
        PG8_WAIT_V(2); PG8_BAR;
        PG8_STAGE(PG8_SB(1, 0), cB + kstep, voffB); PG8_STAGE(PG8_SA(1, 0), cA + kstep, voffA); PG8_STAGE(PG8_SB(1, 1), cB + hstep + kstep, voffB);
        PG8_WAIT_V(6); PG8_BAR;
    } else {
        PG8_STAGE(PG8_SB(0, 0), cB, voffB); PG8_STAGE(PG8_SA(0, 0), cA, voffA); PG8_STAGE(PG8_SB(0, 1), cB + hstep, voffB); PG8_STAGE(PG8_SA(0, 1), cA + hstep, voffA);
        if (wr == 1) PG8_BAR;
        PG8_WAIT_V(4); PG8_BAR;
        PG8_STAGE(PG8_SB(1, 0), cB + kstep, voffB); PG8_STAGE(PG8_SA(1, 0), cA + kstep, voffA); PG8_STAGE(PG8_SB(1, 1), cB + hstep + kstep, voffB);
        PG8_WAIT_V(6); PG8_BAR;
    }
    for (;;) {
        const bool has_next = S.next(ui + 1, nxt);
        const char* nA = has_next ? (const char*)g.A + (size_t)nxt.pm * tstep : cA; const char* nB = has_next ? (const char*)g.Bt + (size_t)nxt.pn * tstep : cB;
        for (int t = 0; t < nt; t += 2) {
            const bool last = (t == nt - 2);
            const char* a1 = cA + (size_t)(t + 1) * kstep;
            const char* a2 = last ? nA : cA + (size_t)(t + 2) * kstep; const char* b2 = last ? nB : cB + (size_t)(t + 2) * kstep;
            const char* a3 = a2 + kstep; const char* b3 = b2 + kstep;
            if (last && has_next) S.a_ready(nxt);
            if constexpr (SP2) {
            PG8_LDB(B0, 0, 0); PG8_LDB(B1, 0, 1); PG8_SCHED; PG8_LDA(At, 0, 0); PG8_STAGE(PG8_SA(1, 1), a1 + hstep, voffA);
            PG8_WAIT_V(8); PG8_WAIT_L(0); PG8_BAR; PG8_MMA(0, 0, At, B0); PG8_MMA(0, 1, At, B1); PG8_BAR; PG8_SCHED;
            PG8_LDA(At, 0, 1); PG8_STAGE(PG8_SB(0, 0), b2, voffB); PG8_STAGE(PG8_SB(0, 1), b2 + hstep, voffB); PG8_STAGE(PG8_SA(0, 0), a2, voffA);
            PG8_WAIT_V(8); PG8_WAIT_L(0); PG8_BAR; PG8_MMA(1, 0, At, B0); PG8_MMA(1, 1, At, B1); PG8_BAR; PG8_SCHED;
            PG8_LDB(B0, 1, 0); PG8_LDB(B1, 1, 1); PG8_SCHED; PG8_LDA(At, 1, 0); PG8_STAGE(PG8_SA(0, 1), a2 + hstep, voffA);
            PG8_WAIT_V(8); PG8_WAIT_L(0); PG8_BAR; PG8_MMA(0, 0, At, B0); PG8_MMA(0, 1, At, B1); PG8_BAR; PG8_SCHED;
            PG8_LDA(At, 1, 1); PG8_STAGE(PG8_SB(1, 0), b3, voffB); PG8_STAGE(PG8_SB(1, 1), b3 + hstep, voffB); PG8_STAGE(PG8_SA(1, 0), a3, voffA);
            PG8_WAIT_V(8); PG8_WAIT_L(0); PG8_BAR; PG8_MMA(1, 0, At, B0); PG8_MMA(1, 1, At, B1); PG8_BAR; PG8_SCHED;
            } else {
            PG8_LDB(B0, 0, 0); PG8_SCHED; PG8_LDA(At, 0, 0); PG8_STAGE(PG8_SA(1, 1), a1 + hstep, voffA);
            PG8_WAIT_L(8); PG8_BAR; PG8_WAIT_L(0); PG8_MMA(0, 0, At, B0); PG8_BAR; PG8_SCHED;
            PG8_LDB(B1, 0, 1); PG8_STAGE(PG8_SB(0, 0), b2, voffB);
            PG8_BAR; PG8_WAIT_L(0); PG8_MMA(0, 1, At, B1); PG8_BAR;
            PG8_LDA(At, 0, 1); PG8_STAGE(PG8_SA(0, 0), a2, voffA);
            PG8_BAR; PG8_WAIT_L(0); PG8_MMA(1, 0, At, B0); PG8_BAR; PG8_SCHED;
            PG8_STAGE(PG8_SB(0, 1), b2 + hstep, voffB);
            PG8_WAIT_V(6); PG8_BAR; PG8_MMA(1, 1, At, B1); PG8_BAR;
            PG8_LDB(B0, 1, 0); PG8_SCHED; PG8_LDA(At, 1, 0); PG8_STAGE(PG8_SA(0, 1), a2 + hstep, voffA);
            PG8_WAIT_L(8); PG8_BAR; PG8_WAIT_L(0); PG8_MMA(0, 0, At, B0); PG8_BAR; PG8_SCHED;
            PG8_LDB(B1, 1, 1); PG8_STAGE(PG8_SB(1, 0), b3, voffB);
            PG8_BAR; PG8_WAIT_L(0); PG8_MMA(0, 1, At, B1); PG8_BAR;
            PG8_LDA(At, 1, 1); PG8_STAGE(PG8_SA(1, 0), a3, voffA);
            PG8_BAR; PG8_WAIT_L(0); PG8_MMA(1, 0, At, B0); PG8_BAR; PG8_SCHED;
            PG8_STAGE(PG8_SB(1, 1), b3 + hstep, voffB);
            PG8_WAIT_V(6); PG8_BAR; PG8_MMA(1, 1, At, B1); PG8_BAR;
            }
        }
        if constexpr (ALIGN_EPI) { if (wr == 0) PG8_BAR; }
        if constexpr (!Epi::AFTER_DRAIN) { E(acc, cur, wr, wc, fr, fq); S.done(cur); }
        if (!has_next) break;
#pragma unroll
        for (int a = 0; a < 2; ++a)
#pragma unroll
            for (int b = 0; b < 2; ++b)
#pragma unroll
                for (int m = 0; m < 4; ++m)
#pragma unroll
                    for (int n = 0; n < 2; ++n) acc[a][b][m][n] = (f32x4){0.f, 0.f, 0.f, 0.f};
        cur = nxt; cA = nA; cB = nB; ++ui;
        if constexpr (ALIGN_EPI) { if (wr == 1) PG8_BAR; }
    }
    PG8_WAIT_V(0);
    if constexpr (!ALIGN_EPI) { if (wr == 0) PG8_BAR; }
    PG8_BAR;
    if constexpr (Epi::AFTER_DRAIN) { E.fused(acc, cur, wr, wc, fr, fq, lds, wid, lane); S.done(cur); }
#undef PG8_SA
#undef PG8_SB
#undef PG8_STAGE
#undef PG8_LDA
#undef PG8_LDB
#undef PG8_MMA
#undef PG8_WAIT_V
#undef PG8_WAIT_L
#undef PG8_BAR
#undef PG8_SCHED
}
}

namespace cg = cooperative_groups;
using pg8::bf16_t; using pg8::bf16x8; using pg8::f32x4; using pg8::u32x4; using pg8::Unit;
__device__ __forceinline__ unsigned cvt_pk_bf16(float lo, float hi) { unsigned r; asm volatile("v_cvt_pk_bf16_f32 %0, %1, %2" : "=v"(r) : "v"(lo), "v"(hi)); return r; }
#define LAS __attribute__((address_space(3)))
typedef unsigned u32x2 __attribute__((ext_vector_type(2)));
typedef float f32x2v __attribute__((ext_vector_type(2)));

constexpr int M_TOK = 8192, DM = 2048, FF = 5632, HW = 1024, CW = 1024, MIXIN = 7168, PLE = 256, SEQ = 2048;
constexpr float EPS = 1e-6f;
constexpr size_t MiB = 1ull << 20;
constexpr size_t WS_W1GU = 0, WS_W1D = 44 * MiB, WS_WIN = 66 * MiB, WS_WOUT = 94 * MiB, WS_W2GU = 102 * MiB, WS_W2D = 146 * MiB,
                 WS_WPG = 168 * MiB, WS_WPE = 176 * MiB, WS_PB = 177 * MiB, WS_XB = 181 * MiB, WS_MIX = 213 * MiB, WS_G = 245 * MiB,
                 WS_QS = 245 * MiB, WS_VH = 261 * MiB, WS_GH = 277 * MiB, WS_BC = 293 * MiB, WS_UC = 309 * MiB, WS_LF = 325 * MiB,
                 WS_S = 357 * MiB, WS_PLE = 245 * MiB, WS_SS = 389 * MiB, WS_DD = 389 * MiB + 512 * 1024, WS_END = 390 * MiB + 512 * 1024, WS_U = 0;
constexpr int LDS_BYTES = 144 * 1024;
constexpr int NPHASE = 12;

__device__ __forceinline__ float bf2f(bf16_t b) { return __uint_as_float(((unsigned)b) << 16); }
__device__ __forceinline__ float bflo(unsigned w) { return __uint_as_float(w << 16); }
__device__ __forceinline__ float bfhi(unsigned w) { return __uint_as_float(w & 0xffff0000u); }
__device__ __forceinline__ float wave_sum(float v) {
#pragma unroll
    for (int o = 1; o < 64; o <<= 1) v += __shfl_xor(v, o);
    return v;
}
__device__ __forceinline__ float fsigmoid(float x) { return __builtin_amdgcn_rcpf(1.0f + __expf(-x)); }
__device__ __forceinline__ float fsilu(float x) { return x * fsigmoid(x); }
__device__ __forceinline__ float rinv_of(float ss) { return rsqrtf(ss * (1.0f / DM) + EPS); }

struct EpiGateUp {
    static constexpr bool PERM = true, AFTER_DRAIN = false;
    bf16_t* G; const float* ss;
    __device__ __forceinline__ void operator()(const f32x4 (&acc)[2][2][4][2], const Unit& u, int wr, int wc, int fr, int fq) const {
        const int row0 = u.pm * 256 + wr * 64 + fr, col0 = u.pn * 128 + wc * 32 + 8 * fq;
#pragma unroll
        for (int ai = 0; ai < 2; ++ai)
#pragma unroll
            for (int m = 0; m < 4; ++m) {
                const int r = row0 + ai * 128 + m * 16; const float ri = rinv_of(ss[r]);
                float v[8];
#pragma unroll
                for (int n = 0; n < 2; ++n)
#pragma unroll
                    for (int j = 0; j < 4; ++j) v[n * 4 + j] = fsilu(acc[ai][0][m][n][j] * ri) * (acc[ai][1][m][n][j] * ri);
                u32x4 w; w.x = cvt_pk_bf16(v[0], v[1]); w.y = cvt_pk_bf16(v[2], v[3]); w.z = cvt_pk_bf16(v[4], v[5]); w.w = cvt_pk_bf16(v[6], v[7]);
                *(u32x4*)(G + (size_t)r * FF + col0) = w;
            }
    }
};
struct EpiResid {
    static constexpr bool PERM = true, AFTER_DRAIN = false;
    const float* R; float* H; bf16_t* XB; float* ss_out; float scale;
    __device__ __forceinline__ void operator()(const f32x4 (&acc)[2][2][4][2], const Unit& u, int wr, int wc, int fr, int fq) const {
        const int row0 = u.pm * 256 + wr * 64 + fr, col0 = u.pn * 256 + wc * 32 + 8 * fq;
#pragma unroll
        for (int ai = 0; ai < 2; ++ai)
#pragma unroll
            for (int m = 0; m < 4; ++m) {
                const int r = row0 + ai * 128 + m * 16; float sq = 0.f;
#pragma unroll
                for (int bj = 0; bj < 2; ++bj) {
                    const size_t off = (size_t)r * DM + col0 + bj * 128;
                    f32x4 v0 = *(const f32x4*)(R + off) + acc[ai][bj][m][0] * scale, v1 = *(const f32x4*)(R + off + 4) + acc[ai][bj][m][1] * scale;
                    *(f32x4*)(H + off) = v0; *(f32x4*)(H + off + 4) = v1;
                    u32x4 w; w.x = cvt_pk_bf16(v0[0], v0[1]); w.y = cvt_pk_bf16(v0[2], v0[3]); w.z = cvt_pk_bf16(v1[0], v1[1]); w.w = cvt_pk_bf16(v1[2], v1[3]);
                    *(u32x4*)(XB + off) = w;
                    sq += (v0[0] * v0[0] + v0[1] * v0[1]) + (v0[2] * v0[2] + v0[3] * v0[3]) + (v1[0] * v1[0] + v1[1] * v1[1]) + (v1[2] * v1[2] + v1[3] * v1[3]);
                }
                sq += __shfl_xor(sq, 16); sq += __shfl_xor(sq, 32);
                if (fq == 0) atomicAdd(ss_out + r, sq);
            }
    }
};
struct EpiMixIn {
    static constexpr bool PERM = true, AFTER_DRAIN = false;
    const float* ss; const float* lbl;
    bf16_t *QS, *UC; float* LF;
    __device__ __forceinline__ void operator()(const f32x4 (&acc)[2][2][4][2], const Unit& u, int wr, int wc, int fr, int fq) const {
        const int row0 = u.pm * 256 + wr * 64 + fr; const int sec = u.pn >> 2;
        if (u.pn >= 20) {
            const int col0 = (u.pn - 20) * 128 + wc * 32 + 8 * fq;
#pragma unroll
            for (int ai = 0; ai < 2; ++ai)
#pragma unroll
                for (int m = 0; m < 4; ++m) {
                    const int r = row0 + ai * 128 + m * 16; const float ri = rinv_of(ss[r]); const float ri2 = ri * ri;
                    float v[8];
#pragma unroll
                    for (int n = 0; n < 2; ++n)
#pragma unroll
                        for (int j = 0; j < 4; ++j) v[n * 4 + j] = acc[ai][0][m][n][j] * acc[ai][1][m][n][j] * ri2;
                    u32x4 w; w.x = cvt_pk_bf16(v[0], v[1]); w.y = cvt_pk_bf16(v[2], v[3]); w.z = cvt_pk_bf16(v[4], v[5]); w.w = cvt_pk_bf16(v[6], v[7]);
                    *(u32x4*)(UC + (size_t)r * CW + col0) = w;
                }
            return;
        }
        const int col0 = (u.pn & 3) * 256 + wc * 32 + 8 * fq;
        if (sec == 1) {
#pragma unroll
            for (int bj = 0; bj < 2; ++bj)
#pragma unroll
                for (int n = 0; n < 2; ++n) {
                    const int c = col0 + bj * 128 + 4 * n; const f32x4 l0 = *(const f32x4*)(lbl + c), l1 = *(const f32x4*)(lbl + 1024 + c);
                    f32x4 lb; lb[0] = fsigmoid(l0[0] - l1[0]); lb[1] = fsigmoid(l0[1] - l1[1]); lb[2] = fsigmoid(l0[2] - l1[2]); lb[3] = fsigmoid(l0[3] - l1[3]);
#pragma unroll
                    for (int ai = 0; ai < 2; ++ai)
#pragma unroll
                        for (int m = 0; m < 4; ++m) {
                            const int r = row0 + ai * 128 + m * 16; const float ri = rinv_of(ss[r]);
                            const f32x4 x = acc[ai][bj][m][n]; f32x4 o;
                            o[0] = __logf(lb[0] + (1.0f - lb[0]) * fsigmoid(x[0] * ri)); o[1] = __logf(lb[1] + (1.0f - lb[1]) * fsigmoid(x[1] * ri));
                            o[2] = __logf(lb[2] + (1.0f - lb[2]) * fsigmoid(x[2] * ri)); o[3] = __logf(lb[3] + (1.0f - lb[3]) * fsigmoid(x[3] * ri));
                            *(f32x4*)(LF + (size_t)r * HW + c) = o;
                        }
                }
            return;
        }
        bf16_t* dst = QS + (size_t)(sec == 0 ? 0 : sec - 1) * ((size_t)M_TOK * HW);
        const bool act = (sec == 0 || sec == 3);
#pragma unroll
        for (int ai = 0; ai < 2; ++ai)
#pragma unroll
            for (int m = 0; m < 4; ++m) {
                const int r = row0 + ai * 128 + m * 16; const float ri = rinv_of(ss[r]);
#pragma unroll
                for (int bj = 0; bj < 2; ++bj) {
                    float v[8];
#pragma unroll
                    for (int n = 0; n < 2; ++n)
#pragma unroll
                        for (int j = 0; j < 4; ++j) { const float x = acc[ai][bj][m][n][j] * ri; v[n * 4 + j] = act ? fsilu(x) : x; }
                    u32x4 w; w.x = cvt_pk_bf16(v[0], v[1]); w.y = cvt_pk_bf16(v[2], v[3]); w.z = cvt_pk_bf16(v[4], v[5]); w.w = cvt_pk_bf16(v[6], v[7]);
                    *(u32x4*)(dst + (size_t)r * HW + col0 + bj * 128) = w;
                }
            }
    }
};
struct EpiStoreBf16 {
    static constexpr bool PERM = true, AFTER_DRAIN = false;
    bf16_t* O;
    __device__ __forceinline__ void operator()(const f32x4 (&acc)[2][2][4][2], const Unit& u, int wr, int wc, int fr, int fq) const {
        const int row0 = u.pm * 256 + wr * 64 + fr, col0 = u.pn * 256 + wc * 32 + 8 * fq;
#pragma unroll
        for (int ai = 0; ai < 2; ++ai)
#pragma unroll
            for (int m = 0; m < 4; ++m) {
                const int r = row0 + ai * 128 + m * 16;
#pragma unroll
                for (int bj = 0; bj < 2; ++bj) {
                    const f32x4 v0 = acc[ai][bj][m][0], v1 = acc[ai][bj][m][1];
                    u32x4 w; w.x = cvt_pk_bf16(v0[0], v0[1]); w.y = cvt_pk_bf16(v0[2], v0[3]); w.z = cvt_pk_bf16(v1[0], v1[1]); w.w = cvt_pk_bf16(v1[2], v1[3]);
                    *(u32x4*)(O + (size_t)r * DM + col0 + bj * 128) = w;
                }
            }
    }
};
struct EpiPleGate {
    static constexpr bool PERM = true, AFTER_DRAIN = false;
    float* H; const bf16_t* P; const float* ss;
    __device__ __forceinline__ void operator()(const f32x4 (&acc)[2][2][4][2], const Unit& u, int wr, int wc, int fr, int fq) const {
        const int row0 = u.pm * 256 + wr * 64 + fr, col0 = u.pn * 256 + wc * 32 + 8 * fq;
#pragma unroll
        for (int ai = 0; ai < 2; ++ai)
#pragma unroll
            for (int m = 0; m < 4; ++m) {
                const int r = row0 + ai * 128 + m * 16; const float ri = rinv_of(ss[r]);
#pragma unroll
                for (int bj = 0; bj < 2; ++bj) {
                    const size_t off = (size_t)r * DM + col0 + bj * 128;
                    const u32x4 pw = *(const u32x4*)(P + off);
                    f32x4 v0 = *(const f32x4*)(H + off), v1 = *(const f32x4*)(H + off + 4);
                    const f32x4 a0 = acc[ai][bj][m][0], a1 = acc[ai][bj][m][1];
                    v0[0] += fsigmoid(a0[0] * ri) * bflo(pw.x); v0[1] += fsigmoid(a0[1] * ri) * bfhi(pw.x);
                    v0[2] += fsigmoid(a0[2] * ri) * bflo(pw.y); v0[3] += fsigmoid(a0[3] * ri) * bfhi(pw.y);
                    v1[0] += fsigmoid(a1[0] * ri) * bflo(pw.z); v1[1] += fsigmoid(a1[1] * ri) * bfhi(pw.z);
                    v1[2] += fsigmoid(a1[2] * ri) * bflo(pw.w); v1[3] += fsigmoid(a1[3] * ri) * bfhi(pw.w);
                    *(f32x4*)(H + off) = v0; *(f32x4*)(H + off + 4) = v1;
                }
            }
    }
};

template <int MODE>
__device__ __forceinline__ void p0_item(const float* W, const float* W2, const float* gain, int K, int N, bf16_t* WT, LAS float* scr, int item, int lane) {
    const int nblk_k = K / 64; const int nb = item / nblk_k, kb = item % nblk_k; const int k0 = 64 * kb, n0 = 32 * nb;
    const float* src = W; int c0 = n0;
    if (MODE == 1) { const int t = n0 >> 8, bj = (n0 >> 7) & 1, c = n0 & 127; src = bj ? W2 : W; c0 = 128 * t + c; }
    if (MODE == 2) { if (n0 >= 5120) { const int tt = n0 - 5120; const int t = tt >> 8, bj = (tt >> 7) & 1, c = tt & 127; c0 = 5120 + 1024 * bj + 128 * t + c; } }
#pragma unroll 8
    for (int i = 0; i < 32; ++i) { const int kk = 2 * i + (lane >> 5); float v = src[(size_t)(k0 + kk) * N + c0 + (lane & 31)]; if (gain) v *= gain[k0 + kk]; scr[kk * 33 + (lane & 31)] = v; }
    asm volatile("s_waitcnt lgkmcnt(0)" ::: "memory");
    const int c = lane & 7;
#pragma unroll
    for (int j = 0; j < 4; ++j) { const int n = (lane >> 3) + 8 * j; const LAS float* s = scr + (8 * c) * 33 + n;
        u32x4 o; o.x = cvt_pk_bf16(s[0 * 33], s[1 * 33]); o.y = cvt_pk_bf16(s[2 * 33], s[3 * 33]); o.z = cvt_pk_bf16(s[4 * 33], s[5 * 33]); o.w = cvt_pk_bf16(s[6 * 33], s[7 * 33]);
        *(u32x4*)(WT + (size_t)(n0 + n) * K + k0 + 8 * c) = o; }
    asm volatile("s_waitcnt lgkmcnt(0)" ::: "memory");
}

struct Args { const float* in[21]; float* out; unsigned char* ws; int ph_lo, ph_hi; };

__device__ __forceinline__ void phase0(const Args& a, LAS unsigned char* lds, int wave, int lane) {
    unsigned char* ws = a.ws;
    LAS float* scr = (LAS float*)(lds + wave * 16384);
    const int gw = blockIdx.x * 8 + wave, NGW = gridDim.x * 8;
    constexpr int I0 = 32 * 352, I1 = 88 * 64, I2 = 32 * 224, I3 = 32 * 64, I7 = 4 * 64;
    constexpr int NIT = 2 * I0 + 2 * I1 + I2 + 2 * I3 + I7;
    for (int it = gw; it < NIT; it += NGW) {
        int r = it;
        if (r < I0) { p0_item<1>(a.in[3], a.in[4], a.in[2], DM, FF, (bf16_t*)(ws + WS_W1GU), scr, r, lane); continue; } r -= I0;
        if (r < I0) { p0_item<1>(a.in[14], a.in[15], a.in[13], DM, FF, (bf16_t*)(ws + WS_W2GU), scr, r, lane); continue; } r -= I0;
        if (r < I1) { p0_item<0>(a.in[5], nullptr, nullptr, FF, DM, (bf16_t*)(ws + WS_W1D), scr, r, lane); continue; } r -= I1;
        if (r < I1) { p0_item<0>(a.in[16], nullptr, nullptr, FF, DM, (bf16_t*)(ws + WS_W2D), scr, r, lane); continue; } r -= I1;
        if (r < I2) { p0_item<2>(a.in[7], nullptr, a.in[6], DM, MIXIN, (bf16_t*)(ws + WS_WIN), scr, r, lane); continue; } r -= I2;
        if (r < I3) { p0_item<0>(a.in[12], nullptr, nullptr, DM, DM, (bf16_t*)(ws + WS_WOUT), scr, r, lane); continue; } r -= I3;
        if (r < I3) { p0_item<0>(a.in[19], nullptr, a.in[17], DM, DM, (bf16_t*)(ws + WS_WPG), scr, r, lane); continue; } r -= I3;
        p0_item<0>(a.in[18], nullptr, nullptr, PLE, DM, (bf16_t*)(ws + WS_WPE), scr, r, lane);
    }
    float* SS = (float*)(ws + WS_SS);
    for (int m = gw; m < M_TOK; m += NGW) {
        const f32x4* xr = (const f32x4*)(a.in[0] + (size_t)m * DM) + lane; u32x2* xb = (u32x2*)((bf16_t*)(ws + WS_XB) + (size_t)m * DM) + lane;
        float s = 0.f;
#pragma unroll
        for (int j = 0; j < 8; ++j) { const f32x4 v = xr[64 * j]; s += (v[0] * v[0] + v[1] * v[1]) + (v[2] * v[2] + v[3] * v[3]);
            u32x2 w; w.x = cvt_pk_bf16(v[0], v[1]); w.y = cvt_pk_bf16(v[2], v[3]); xb[64 * j] = w; }
        s = wave_sum(s);
        if (lane == 0) { SS[m] = s; SS[8192 + m] = 0.f; SS[16384 + m] = 0.f; SS[24576 + m] = 0.f; }
    }
    { const int gt = blockIdx.x * 512 + threadIdx.x, NT = gridDim.x * 512;
      for (int i = gt; i < M_TOK * PLE / 4; i += NT) { const f32x4 v = ((const f32x4*)a.in[1])[i]; u32x2 w; w.x = cvt_pk_bf16(v[0], v[1]); w.y = cvt_pk_bf16(v[2], v[3]); ((u32x2*)(ws + WS_PB))[i] = w; } }
}

constexpr int HP = 136, VP = 72;
constexpr int L_QT = 0, L_QH = L_QT + 64 * HP * 2, L_KA = L_QH + 64 * HP * 2, L_KB = L_KA + 64 * HP * 2, L_ST = L_KB + 32 * HP * 2, L_VT = L_ST + 128 * HP * 2,
              L_P = L_VT + 128 * VP * 2, L_SEG = L_P + 64 * VP * 2, L_PART = L_SEG + 4 * 128 * 4, L_RINV = L_PART + 8 * 64 * 4, L_HEND = L_RINV + 256, L_KT = 0;
static_assert(L_HEND <= LDS_BYTES, "LDS");
#define MFMA16(a, b, c) __builtin_amdgcn_mfma_f32_16x16x32_bf16((a), (b), (c), 0, 0, 0)
__device__ __forceinline__ bf16_t f2bf(float x) { return (bf16_t)(cvt_pk_bf16(x, 0.f) & 0xffffu); }

__device__ __forceinline__ void hgrn_pass_a(const Args& a, LAS unsigned char* lds, int wave, int lane) {
    unsigned char* ws = a.ws;
    const float* LF = (const float*)(ws + WS_LF); const bf16_t* VH = (const bf16_t*)(ws + WS_VH); float* U = (float*)(ws + WS_U); float* Dd = (float*)(ws + WS_DD);
    const int tid = threadIdx.x, k = tid & 127, sg = tid >> 7, fr = lane & 15, fq = lane >> 4;
    LAS bf16_t* VT = (LAS bf16_t*)(lds + L_VT); LAS bf16_t* KT = (LAS bf16_t*)(lds + L_KT); LAS float* SEG = (LAS float*)(lds + L_SEG);
    for (int item = blockIdx.x; item < 1024; item += gridDim.x) {
        const int row0 = (item >> 3) * 64, cb = (item & 7) * 128;
        float lf[16], b[16];
#pragma unroll
        for (int i = 0; i < 16; ++i) lf[i] = LF[(size_t)(row0 + 16 * sg + i) * HW + cb + k];
        u32x4 vv[2];
#pragma unroll
        for (int j = 0; j < 2; ++j) { const int idx = tid + 512 * j; vv[j] = *(const u32x4*)(VH + (size_t)(row0 + (idx >> 4)) * HW + cb + 8 * (idx & 15)); }
        float run = 0.f;
#pragma unroll
        for (int i = 0; i < 16; ++i) { run += lf[i]; b[i] = run; }
        SEG[sg * 128 + k] = run;
        __syncthreads();
        const float s0 = SEG[k], s1 = SEG[128 + k], s2 = SEG[256 + k], s3 = SEG[384 + k];
        const float pre = sg == 0 ? 0.f : (sg == 1 ? s0 : (sg == 2 ? s0 + s1 : s0 + s1 + s2));
        const float blast = s0 + s1 + s2 + s3;
        unsigned pk[8];
#pragma unroll
        for (int i = 0; i < 8; ++i) {
            const float e0 = (1.0f - __expf(lf[2 * i])) * __expf(blast - (pre + b[2 * i])), e1 = (1.0f - __expf(lf[2 * i + 1])) * __expf(blast - (pre + b[2 * i + 1]));
            pk[i] = cvt_pk_bf16(e0, e1); }
        { u32x4 w0, w1; w0.x = pk[0]; w0.y = pk[1]; w0.z = pk[2]; w0.w = pk[3]; w1.x = pk[4]; w1.y = pk[5]; w1.z = pk[6]; w1.w = pk[7];
          *(LAS u32x4*)(KT + k * VP + 16 * sg) = w0; *(LAS u32x4*)(KT + k * VP + 16 * sg + 8) = w1; }
#pragma unroll
        for (int j = 0; j < 2; ++j) { const int idx = tid + 512 * j, s = idx >> 4, v0 = 8 * (idx & 15);
            VT[(v0 + 0) * VP + s] = (bf16_t)(vv[j].x & 0xffffu); VT[(v0 + 1) * VP + s] = (bf16_t)(vv[j].x >> 16);
            VT[(v0 + 2) * VP + s] = (bf16_t)(vv[j].y & 0xffffu); VT[(v0 + 3) * VP + s] = (bf16_t)(vv[j].y >> 16);
            VT[(v0 + 4) * VP + s] = (bf16_t)(vv[j].z & 0xffffu); VT[(v0 + 5) * VP + s] = (bf16_t)(vv[j].z >> 16);
            VT[(v0 + 6) * VP + s] = (bf16_t)(vv[j].w & 0xffffu); VT[(v0 + 7) * VP + s] = (bf16_t)(vv[j].w >> 16); }
        if (sg == 0) Dd[item * 128 + k] = __expf(blast);
        __syncthreads();
        const bf16x8 a0 = *(const LAS bf16x8*)(VT + (16 * wave + fr) * VP + fq * 8), a1 = *(const LAS bf16x8*)(VT + (16 * wave + fr) * VP + 32 + fq * 8);
        float* up = U + (size_t)item * 16384 + (16 * wave + 4 * fq) * 128 + fr;
#pragma unroll
        for (int kt = 0; kt < 8; ++kt) {
            const bf16x8 b0 = *(const LAS bf16x8*)(KT + (16 * kt + fr) * VP + fq * 8), b1 = *(const LAS bf16x8*)(KT + (16 * kt + fr) * VP + 32 + fq * 8);
            f32x4 acc = {0.f, 0.f, 0.f, 0.f};
            acc = MFMA16(a0, b0, acc); acc = MFMA16(a1, b1, acc);
            up[16 * kt] = acc[0]; up[16 * kt + 128] = acc[1]; up[16 * kt + 256] = acc[2]; up[16 * kt + 384] = acc[3];
        }
        __syncthreads();
    }
}

__device__ __forceinline__ void hgrn_scan(const Args& a) {
    unsigned char* ws = a.ws;
    const float* U = (const float*)(ws + WS_U); const float* Dd = (const float*)(ws + WS_DD); bf16_t* SP = (bf16_t*)(ws + WS_S);
    for (int e = (blockIdx.x * 512 + threadIdx.x) * 4; e < 32 * 16384; e += gridDim.x * 512 * 4) {
        const int bh = e >> 14, vk = e & 16383, bb = bh >> 3, h = bh & 7;
        f32x4 S = {0.f, 0.f, 0.f, 0.f};
#pragma unroll 8
        for (int ci = 0; ci < 32; ++ci) {
            const size_t item = (size_t)((bb * 32 + ci) * 8 + h);
            const f32x4 u = *(const f32x4*)(U + item * 16384 + vk); const f32x4 d = *(const f32x4*)(Dd + item * 128 + (vk & 127));
            u32x2 w; w.x = cvt_pk_bf16(S[0], S[1]); w.y = cvt_pk_bf16(S[2], S[3]); *(u32x2*)(SP + item * 16384 + vk) = w;
            S = d * S + u;
        }
    }
}

__device__ __forceinline__ void conv_mixer(const Args& a, int wave, int lane) {
    unsigned char* ws = a.ws;
    const bf16_t* BC = (const bf16_t*)(ws + WS_BC); const bf16_t* UC = (const bf16_t*)(ws + WS_UC); bf16_t* MIX = (bf16_t*)(ws + WS_MIX);
    const float* cn = a.in[11]; const float* cw = a.in[8];
    const int gw = blockIdx.x * 8 + wave, NGW = gridDim.x * 8;
    for (int it = gw; it < M_TOK * 2; it += NGW) {
        const int row = it >> 1, c = (it & 1) * 512 + lane * 8, t = row & (SEQ - 1);
        const size_t off = (size_t)row * CW + c;
        const u32x4 z = {0u, 0u, 0u, 0u};
        const u32x4 u0 = *(const u32x4*)(UC + off), u1 = t >= 1 ? *(const u32x4*)(UC + off - CW) : z, u2 = t >= 2 ? *(const u32x4*)(UC + off - 2 * CW) : z, bg = *(const u32x4*)(BC + off);
        float y[8]; float ssq = 0.f;
#pragma unroll
        for (int q = 0; q < 4; ++q) {
            const unsigned a0 = u0[q], a1 = u1[q], a2 = u2[q], bb = bg[q]; const int cc = c + 2 * q;
            y[2 * q] = bflo(bb) * (cw[cc] * bflo(a2) + cw[CW + cc] * bflo(a1) + cw[2 * CW + cc] * bflo(a0));
            y[2 * q + 1] = bfhi(bb) * (cw[cc + 1] * bfhi(a2) + cw[CW + cc + 1] * bfhi(a1) + cw[2 * CW + cc + 1] * bfhi(a0));
            ssq += y[2 * q] * y[2 * q] + y[2 * q + 1] * y[2 * q + 1];
        }
        ssq += __shfl_xor(ssq, 1); ssq += __shfl_xor(ssq, 2); ssq += __shfl_xor(ssq, 4); ssq += __shfl_xor(ssq, 8);
        const float ri = rsqrtf(ssq * (1.0f / 128) + EPS);
        u32x4 w;
        w.x = cvt_pk_bf16(y[0] * ri * cn[c], y[1] * ri * cn[c + 1]); w.y = cvt_pk_bf16(y[2] * ri * cn[c + 2], y[3] * ri * cn[c + 3]);
        w.z = cvt_pk_bf16(y[4] * ri * cn[c + 4], y[5] * ri * cn[c + 5]); w.w = cvt_pk_bf16(y[6] * ri * cn[c + 6], y[7] * ri * cn[c + 7]);
        *(u32x4*)(MIX + (size_t)row * DM + HW + c) = w;
    }
}

__device__ __forceinline__ void hgrn_pass_c(const Args& a, LAS unsigned char* lds, int wave, int lane) {
    unsigned char* ws = a.ws;
    const float* LF = (const float*)(ws + WS_LF); const bf16_t* VH = (const bf16_t*)(ws + WS_VH); const bf16_t* QS = (const bf16_t*)(ws + WS_QS); const bf16_t* GH = (const bf16_t*)(ws + WS_GH);
    const bf16_t* SP = (const bf16_t*)(ws + WS_S); bf16_t* MIX = (bf16_t*)(ws + WS_MIX); const float* hn = a.in[10];
    const int tid = threadIdx.x, k = tid & 127, sg = tid >> 7, fr = lane & 15, fq = lane >> 4;
    LAS bf16_t* QT = (LAS bf16_t*)(lds + L_QT); LAS bf16_t* QH = (LAS bf16_t*)(lds + L_QH); LAS bf16_t* KA = (LAS bf16_t*)(lds + L_KA); LAS bf16_t* KB = (LAS bf16_t*)(lds + L_KB);
    LAS bf16_t* ST = (LAS bf16_t*)(lds + L_ST); LAS bf16_t* VT = (LAS bf16_t*)(lds + L_VT); LAS bf16_t* P = (LAS bf16_t*)(lds + L_P);
    LAS float* SEG = (LAS float*)(lds + L_SEG); LAS float* PART = (LAS float*)(lds + L_PART); LAS float* RINV = (LAS float*)(lds + L_RINV);
    for (int item = blockIdx.x; item < 1024; item += gridDim.x) {
        const int row0 = (item >> 3) * 64, cb = (item & 7) * 128;
        float lf[16], b[16]; bf16_t qh[16];
#pragma unroll
        for (int i = 0; i < 16; ++i) { lf[i] = LF[(size_t)(row0 + 16 * sg + i) * HW + cb + k]; qh[i] = QS[(size_t)(row0 + 16 * sg + i) * HW + cb + k]; }
        u32x4 vv[2], sv[4];
#pragma unroll
        for (int j = 0; j < 2; ++j) { const int idx = tid + 512 * j; vv[j] = *(const u32x4*)(VH + (size_t)(row0 + (idx >> 4)) * HW + cb + 8 * (idx & 15)); }
#pragma unroll
        for (int j = 0; j < 4; ++j) { const int idx = tid + 512 * j; sv[j] = *(const u32x4*)(SP + (size_t)item * 16384 + (idx >> 4) * 128 + 8 * (idx & 15)); }
        float run = 0.f;
#pragma unroll
        for (int i = 0; i < 16; ++i) { run += lf[i]; b[i] = run; }
        SEG[sg * 128 + k] = run;
        __syncthreads();
        const float s0 = SEG[k], s1 = SEG[128 + k], s2 = SEG[256 + k];
        const float pre = sg == 0 ? 0.f : (sg == 1 ? s0 : (sg == 2 ? s0 + s1 : s0 + s1 + s2));
        const float beta1 = s0 + s1, beta = sg >= 2 ? beta1 : 0.f;
#pragma unroll
        for (int i = 0; i < 16; ++i) {
            const int s = 16 * sg + i; const float bi = pre + b[i], kk = 1.0f - __expf(lf[i]), qv = bf2f(qh[i]);
            QT[s * HP + k] = f2bf(qv * __expf(bi - beta)); QH[s * HP + k] = f2bf(qv * __expf(bi));
            KA[s * HP + k] = f2bf(kk * __expf(fminf(beta - bi, 80.f)));
            if (sg < 2) KB[s * HP + k] = f2bf(kk * __expf(beta1 - bi));
        }
#pragma unroll
        for (int j = 0; j < 2; ++j) { const int idx = tid + 512 * j, s = idx >> 4, v0 = 8 * (idx & 15);
            VT[(v0 + 0) * VP + s] = (bf16_t)(vv[j].x & 0xffffu); VT[(v0 + 1) * VP + s] = (bf16_t)(vv[j].x >> 16);
            VT[(v0 + 2) * VP + s] = (bf16_t)(vv[j].y & 0xffffu); VT[(v0 + 3) * VP + s] = (bf16_t)(vv[j].y >> 16);
            VT[(v0 + 4) * VP + s] = (bf16_t)(vv[j].z & 0xffffu); VT[(v0 + 5) * VP + s] = (bf16_t)(vv[j].z >> 16);
            VT[(v0 + 6) * VP + s] = (bf16_t)(vv[j].w & 0xffffu); VT[(v0 + 7) * VP + s] = (bf16_t)(vv[j].w >> 16); }
#pragma unroll
        for (int j = 0; j < 4; ++j) { const int idx = tid + 512 * j; *(LAS u32x4*)(ST + (idx >> 4) * HP + 8 * (idx & 15)) = sv[j]; }
        __syncthreads();
#pragma unroll
        for (int pp = 0; pp < 2; ++pp) {
            const int p = wave + 8 * pp, tt = p >> 2, st = p & 3;
            f32x4 acc = {0.f, 0.f, 0.f, 0.f};
            if (st <= tt) {
                const LAS bf16_t* kb = (tt >= 2 && st < 2) ? KB : KA;
#pragma unroll
                for (int ks = 0; ks < 4; ++ks) { const bf16x8 af = *(const LAS bf16x8*)(QT + (16 * tt + fr) * HP + ks * 32 + fq * 8), bfr = *(const LAS bf16x8*)(kb + (16 * st + fr) * HP + ks * 32 + fq * 8);
                    acc = MFMA16(af, bfr, acc); }
            }
#pragma unroll
            for (int r = 0; r < 4; ++r) { const bool keep = (st < tt) || (st == tt && fr <= 4 * fq + r); P[(16 * tt + 4 * fq + r) * VP + 16 * st + fr] = f2bf(keep ? acc[r] : 0.f); }
        }
        __syncthreads();
        bf16x8 bs[4], bv[2];
#pragma unroll
        for (int ks = 0; ks < 4; ++ks) bs[ks] = *(const LAS bf16x8*)(ST + (16 * wave + fr) * HP + ks * 32 + fq * 8);
#pragma unroll
        for (int ks = 0; ks < 2; ++ks) bv[ks] = *(const LAS bf16x8*)(VT + (16 * wave + fr) * VP + ks * 32 + fq * 8);
        f32x4 o[4];
#pragma unroll
        for (int tt = 0; tt < 4; ++tt) {
            f32x4 acc = {0.f, 0.f, 0.f, 0.f};
#pragma unroll
            for (int ks = 0; ks < 4; ++ks) { const bf16x8 af = *(const LAS bf16x8*)(QH + (16 * tt + fr) * HP + ks * 32 + fq * 8); acc = MFMA16(af, bs[ks], acc); }
            { const bf16x8 af = *(const LAS bf16x8*)(P + (16 * tt + fr) * VP + fq * 8); acc = MFMA16(af, bv[0], acc); }
            if (tt >= 2) { const bf16x8 af = *(const LAS bf16x8*)(P + (16 * tt + fr) * VP + 32 + fq * 8); acc = MFMA16(af, bv[1], acc); }
            o[tt] = acc;
        }
#pragma unroll
        for (int tt = 0; tt < 4; ++tt)
#pragma unroll
            for (int r = 0; r < 4; ++r) { float x = o[tt][r] * o[tt][r]; x += __shfl_xor(x, 1); x += __shfl_xor(x, 2); x += __shfl_xor(x, 4); x += __shfl_xor(x, 8);
                if (fr == 0) PART[wave * 64 + 16 * tt + 4 * fq + r] = x; }
        __syncthreads();
        if (tid < 64) { float s = 0.f;
#pragma unroll
            for (int w = 0; w < 8; ++w) s += PART[w * 64 + tid];
            RINV[tid] = rsqrtf(s * (1.0f / 128) + EPS); }
        __syncthreads();
        const float hnv = hn[16 * wave + fr];
#pragma unroll
        for (int tt = 0; tt < 4; ++tt)
#pragma unroll
            for (int r = 0; r < 4; ++r) { const int t = 16 * tt + 4 * fq + r; const size_t row = (size_t)(row0 + t);
                const float g = bf2f(GH[row * HW + cb + 16 * wave + fr]);
                MIX[row * DM + cb + 16 * wave + fr] = f2bf(o[tt][r] * RINV[t] * hnv * g); }
        __syncthreads();
    }
}

__device__ __forceinline__ void phase_final(const Args& a, int wave, int lane) {
    const int gw = blockIdx.x * 8 + wave, NGW = gridDim.x * 8; const float* gF = a.in[20];
    for (int m = gw; m < M_TOK; m += NGW) {
        f32x4* xr = (f32x4*)(a.out + (size_t)m * DM) + lane; f32x4 v[8]; float s = 0.f;
#pragma unroll
        for (int j = 0; j < 8; ++j) { v[j] = xr[64 * j]; s += (v[j][0] * v[j][0] + v[j][1] * v[j][1]) + (v[j][2] * v[j][2] + v[j][3] * v[j][3]); }
        const float ri = rinv_of(wave_sum(s));
#pragma unroll
        for (int j = 0; j < 8; ++j) { const f32x4 g = ((const f32x4*)gF)[64 * j + lane]; xr[64 * j] = v[j] * ri * g; }
    }
}

template <class Epi>
__device__ __forceinline__ void run_gemm(LAS unsigned char* lds, const bf16_t* A, const bf16_t* Bt, int N, int K, const Epi& E) {
    pg8::Gemm g; g.A = A; g.Bt = Bt; g.M = M_TOK; g.N = N; g.K = K;
    pg8::StaticOrder S; S.init(M_TOK, N, (int)gridDim.x, (int)blockIdx.x);
    pg8::gemm_phase<Epi, pg8::StaticOrder, true, true>(lds, g, S, E);
}

__global__ void __launch_bounds__(512, 2) fwd_kernel(Args a) {
    extern __shared__ __attribute__((aligned(16))) unsigned char lds_raw[];
    LAS unsigned char* lds = (LAS unsigned char*)lds_raw;
    cg::grid_group grid = cg::this_grid();
    const int tid = threadIdx.x, lane = tid & 63, wave = __builtin_amdgcn_readfirstlane(tid >> 6);
    unsigned char* ws = a.ws;
    float* SS = (float*)(ws + WS_SS);
    bf16_t* XB = (bf16_t*)(ws + WS_XB); bf16_t* G = (bf16_t*)(ws + WS_G); bf16_t* MIX = (bf16_t*)(ws + WS_MIX);
#define PH(i) if (a.ph_lo <= (i) && (i) < a.ph_hi)
#define SYNC(i) if (a.ph_lo <= (i) && (i) + 1 < a.ph_hi) grid.sync();
    PH(0) { phase0(a, lds, wave, lane); } SYNC(0)
    PH(1) { EpiGateUp E; E.G = G; E.ss = SS; run_gemm(lds, XB, (const bf16_t*)(ws + WS_W1GU), 2 * FF, DM, E); } SYNC(1)
    PH(2) { EpiResid E; E.R = a.in[0]; E.H = a.out; E.XB = XB; E.ss_out = SS + 8192; E.scale = 0.5f; run_gemm(lds, G, (const bf16_t*)(ws + WS_W1D), DM, FF, E); } SYNC(2)
    PH(3) { EpiMixIn E; E.ss = SS + 8192; E.lbl = a.in[9]; E.QS = (bf16_t*)(ws + WS_QS);
            E.UC = (bf16_t*)(ws + WS_UC); E.LF = (float*)(ws + WS_LF); run_gemm(lds, XB, (const bf16_t*)(ws + WS_WIN), MIXIN, DM, E); } SYNC(3)
    PH(4) { hgrn_pass_a(a, lds, wave, lane); } SYNC(4)
    PH(5) { hgrn_scan(a); conv_mixer(a, wave, lane); } SYNC(5)
    PH(6) { hgrn_pass_c(a, lds, wave, lane); } SYNC(6)
    PH(7) { EpiResid E; E.R = a.out; E.H = a.out; E.XB = XB; E.ss_out = SS + 16384; E.scale = 1.0f; run_gemm(lds, MIX, (const bf16_t*)(ws + WS_WOUT), DM, DM, E); } SYNC(7)
    PH(8) { EpiGateUp E; E.G = G; E.ss = SS + 16384; run_gemm(lds, XB, (const bf16_t*)(ws + WS_W2GU), 2 * FF, DM, E); } SYNC(8)
    PH(9) { EpiResid E; E.R = a.out; E.H = a.out; E.XB = XB; E.ss_out = SS + 24576; E.scale = 0.5f; run_gemm(lds, G, (const bf16_t*)(ws + WS_W2D), DM, FF, E); } SYNC(9)
    PH(10) { { EpiStoreBf16 E; E.O = (bf16_t*)(ws + WS_PLE); int kp = PLE; asm volatile("" : "+s"(kp)); run_gemm(lds, (const bf16_t*)(ws + WS_PB), (const bf16_t*)(ws + WS_WPE), DM, kp, E); }
             { EpiPleGate E; E.H = a.out; E.P = (const bf16_t*)(ws + WS_PLE); E.ss = SS + 24576; run_gemm(lds, XB, (const bf16_t*)(ws + WS_WPG), DM, DM, E); } } SYNC(10)
    PH(11) { phase_final(a, wave, lane); }
#undef PH
#undef SYNC
}

#ifndef MK_MULTI
#define MK_MULTI 0
#endif
extern "C" void kernel_launch(void* const* d_in, const int* in_sizes, int n_in, void* d_out, int out_size, void* d_ws, size_t ws_size, hipStream_t stream) {
    static int grid = 0;
    if (grid == 0) {
        if (n_in != 21 || out_size != M_TOK * DM || ws_size < WS_END) { fprintf(stderr, "kernel_launch: unexpected shapes (n_in %d out %d ws %zu need %zu)\n", n_in, out_size, ws_size, (size_t)WS_END); grid = -1; return; }
        int dev = 0, cus = 0, per_cu = 0;
        hipGetDevice(&dev); hipDeviceGetAttribute(&cus, hipDeviceAttributeMultiprocessorCount, dev);
        if (hipFuncSetAttribute((const void*)fwd_kernel, hipFuncAttributeMaxDynamicSharedMemorySize, LDS_BYTES) != hipSuccess) { fprintf(stderr, "kernel_launch: hipFuncSetAttribute failed\n"); grid = -1; return; }
        if (hipOccupancyMaxActiveBlocksPerMultiprocessor(&per_cu, (const void*)fwd_kernel, 512, LDS_BYTES) != hipSuccess || per_cu < 1) { fprintf(stderr, "kernel_launch: occupancy query failed (%d)\n", per_cu); grid = -1; return; }
        grid = cus * per_cu;
    }
    if (grid < 0) return;
    Args a{};
    for (int i = 0; i < 21; ++i) a.in[i] = (const float*)d_in[i];
    a.out = (float*)d_out; a.ws = (unsigned char*)d_ws;
#if MK_MULTI
    for (int p = 0; p < NPHASE; ++p) { a.ph_lo = p; a.ph_hi = p + 1; hipLaunchKernelGGL(fwd_kernel, dim3(grid), dim3(512), LDS_BYTES, stream, a); }
#else
    a.ph_lo = 0; a.ph_hi = NPHASE;
    void* args[] = {&a};
    hipError_t e = hipLaunchCooperativeKernel((void*)fwd_kernel, dim3(grid), dim3(512), args, LDS_BYTES, stream);
    if (e != hipSuccess) fprintf(stderr, "cooperative launch failed: %s (grid %d)\n", hipGetErrorString(e), grid);
#endif
}
```

```cpp
#include <hip/hip_runtime.h>
#include <hip/hip_cooperative_groups.h>
#include <cstdio>
#include <cstdint>
namespace pg8 {
#define PG8_LAS __attribute__((address_space(3)))
typedef unsigned short bf16_t;
typedef short bf16x8 __attribute__((ext_vector_type(8)));
typedef float f32x4 __attribute__((ext_vector_type(4)));
typedef unsigned u32x4 __attribute__((ext_vector_type(4)));
constexpr int BM = 256, BK = 64, HALF = 128, HTB = HALF * BK * 2  , STAGE_BYTES = 8 * HTB, NXCD = 8, WGM = 8;

__host__ __device__ __forceinline__ int lds_byte(int r, int c) { const int st = (r >> 4) * 2 + (c >> 5), rr = r & 15, cc = c & 31, ob = rr * 64 + cc * 2; return st * 1024 + (ob ^ (((ob >> 9) & 1) << 5)); }
__host__ __device__ __forceinline__ void stage_rc(int b, int& R, int& C) { const int st = b / 1024, sb = b % 1024, swz = sb ^ (((sb >> 9) & 1) << 5); R = (st >> 1) * 16 + swz / 64; C = (st & 1) * 32 + (swz % 64) / 2; }
__host__ __device__ __forceinline__ int perm32(int rho) { const int n = rho >> 4, i = rho & 15; return 8 * (i >> 2) + 4 * n + (i & 3); }

struct Unit { int pm, pn; };
struct Gemm { const bf16_t* A; const bf16_t* Bt; int M, N, K; };

struct StaticOrder {
    int nM, nN, nwg, G, c;
    __host__ __device__ void init(int M, int N, int G_, int c_) { nM = M / BM; nN = N / BM; nwg = nM * nN; G = G_; c = c_; }
    __host__ __device__ bool next(int i, Unit& u) const {
        const long L = (long)i * G + c; if (L >= nwg) return false;
        int wgid = (int)L; { const int q = nwg / NXCD, r = nwg % NXCD, xcd = wgid % NXCD, off = wgid / NXCD; wgid = (xcd < r ? xcd * (q + 1) : r * (q + 1) + (xcd - r) * q) + off; }
        const int nig = WGM * nN, gid = wgid / nig, fm = gid * WGM, gsz = (nM - fm) < WGM ? (nM - fm) : WGM;
        u.pm = fm + ((wgid % nig) % gsz); u.pn = (wgid % nig) / gsz; return true;
    }
    __device__ __forceinline__ void a_ready(const Unit&) const {}
    __device__ __forceinline__ void done(const Unit&) const {}
};
typedef float f32x2 __attribute__((ext_vector_type(2)));
template <class Epi, class Sched, bool ALIGN_EPI = false, bool SP2 = false>
__device__ __forceinline__ void gemm_phase(PG8_LAS unsigned char* lds, const Gemm g, const Sched& S, const Epi& E) {
    const int tid = threadIdx.x, wid = __builtin_amdgcn_readfirstlane(tid >> 6), lane = tid & 63, wr = wid >> 2, wc = wid & 3, fr = lane & 15, fq = lane >> 4;
    const int K = g.K, nt = K / BK;
    unsigned voffA[2], voffB[2];
#pragma unroll
    for (int i = 0; i < 2; ++i) { int R, C; stage_rc(tid * 16 + i * 8192, R, C); const int Rb = Epi::PERM ? ((R & ~31) + perm32(R & 31)) : R;
        voffA[i] = (unsigned)(R * K + C) * 2u; voffB[i] = (unsigned)(Rb * K + C) * 2u; }
    const size_t kstep = (size_t)(BK * 2);
    const size_t hstep = (size_t)HALF * K * 2;
    const size_t tstep = 2 * hstep;
    const unsigned ldsw = (unsigned)wid * 1024u;
    const int aoff = lds_byte(wr * 64 + fr, fq * 8), boff = lds_byte(wc * 32 + fr, fq * 8);
#define PG8_SA(b, h) (((b) * 2 + (h)) * HTB)
#define PG8_SB(b, h) ((4 + (b) * 2 + (h)) * HTB)
#define PG8_STAGE(bufoff, gbase, voff) do { _Pragma("unroll") for (int _i = 0; _i < 2; ++_i) \
        __builtin_amdgcn_global_load_lds((const unsigned*)((const char*)(gbase) + (voff)[_i]), (PG8_LAS unsigned*)(lds + (bufoff) + ldsw + _i * 8192), 16, 0, 0); } while (0)
#define PG8_LDA(dst, b, h) do { _Pragma("unroll") for (int m = 0; m < 4; ++m) _Pragma("unroll") for (int k = 0; k < 2; ++k) dst[m][k] = *(const PG8_LAS bf16x8*)(lds + PG8_SA(b, h) + aoff + m * 2048 + k * 1024); } while (0)
#define PG8_LDB(dst, b, h) do { _Pragma("unroll") for (int n = 0; n < 2; ++n) _Pragma("unroll") for (int k = 0; k < 2; ++k) dst[n][k] = *(const PG8_LAS bf16x8*)(lds + PG8_SB(b, h) + boff + n * 2048 + k * 1024); } while (0)
#define PG8_MMA(ai, bj, At, Bt) do { __builtin_amdgcn_s_setprio(1); _Pragma("unroll") for (int m = 0; m < 4; ++m) _Pragma("unroll") for (int n = 0; n < 2; ++n) _Pragma("unroll") for (int k = 0; k < 2; ++k) \
        acc[ai][bj][m][n] = __builtin_amdgcn_mfma_f32_16x16x32_bf16(Bt[n][k], At[m][k], acc[ai][bj][m][n], 0, 0, 0); __builtin_amdgcn_s_setprio(0); } while (0)
#define PG8_WAIT_V(n) asm volatile("s_waitcnt vmcnt(" #n ")" ::: "memory")
#define PG8_WAIT_L(n) asm volatile("s_waitcnt lgkmcnt(" #n ")" ::: "memory")
#define PG8_BAR __builtin_amdgcn_s_barrier()
#define PG8_SCHED __builtin_amdgcn_sched_barrier(0)
    Unit cur, nxt; int ui = 0;
    if (!S.next(0, cur)) return;
    f32x4 acc[2][2][4][2];
#pragma unroll
    for (int a = 0; a < 2; ++a)
#pragma unroll
        for (int b = 0; b < 2; ++b)
#pragma unroll
            for (int m = 0; m < 4; ++m)
#pragma unroll
                for (int n = 0; n < 2; ++n) acc[a][b][m][n] = (f32x4){0.f, 0.f, 0.f, 0.f};
    bf16x8 At[4][2], B0[2][2], B1[2][2];
    const char* cA = (const char*)g.A + (size_t)cur.pm * tstep; const char* cB = (const char*)g.Bt + (size_t)cur.pn * tstep;
    S.a_ready(cur);
    if constexpr (SP2) {
        PG8_STAGE(PG8_SB(0, 0), cB, voffB); PG8_STAGE(PG8_SB(0, 1), cB + hstep, voffB); PG8_STAGE(PG8_SA(0, 0), cA, voffA); PG8_STAGE(PG8_SA(0, 1), cA + hstep, voffA);
        if (wr == 1) PG8_BAR;
        PG8_WAIT_V(2); PG8_BAR;
        PG8_STAGE(PG8_SB(1, 0), cB + kstep, voffB); PG8_STAGE(PG8_SA(1, 0), cA + kstep, voffA); PG8_STAGE(PG8_SB(1, 1), cB + hstep + kstep, voffB);
        PG8_WAIT_V(6); PG8_BAR;
    } else {
        PG8_STAGE(PG8_SB(0, 0), cB, voffB); PG8_STAGE(PG8_SA(0, 0), cA, voffA); PG8_STAGE(PG8_SB(0, 1), cB + hstep, voffB); PG8_STAGE(PG8_SA(0, 1), cA + hstep, voffA);
        if (wr == 1) PG8_BAR;
        PG8_WAIT_V(4); PG8_BAR;
        PG8_STAGE(PG8_SB(1, 0), cB + kstep, voffB); PG8_STAGE(PG8_SA(1, 0), cA + kstep, voffA); PG8_STAGE(PG8_SB(1, 1), cB + hstep + kstep, voffB);
        PG8_WAIT_V(6); PG8_BAR;
    }
    for (;;) {
        const bool has_next = S.next(ui + 1, nxt);
        const char* nA = has_next ? (const char*)g.A + (size_t)nxt.pm * tstep : cA; const char* nB = has_next ? (const char*)g.Bt + (size_t)nxt.pn * tstep : cB;
        for (int t = 0; t < nt; t += 2) {
            const bool last = (t == nt - 2);
            const char* a1 = cA + (size_t)(t + 1) * kstep;
            const char* a2 = last ? nA : cA + (size_t)(t + 2) * kstep; const char* b2 = last ? nB : cB + (size_t)(t + 2) * kstep;
            const char* a3 = a2 + kstep; const char* b3 = b2 + kstep;
            if (last && has_next) S.a_ready(nxt);
            if constexpr (SP2) {
            PG8_LDB(B0, 0, 0); PG8_LDB(B1, 0, 1); PG8_SCHED; PG8_LDA(At, 0, 0); PG8_STAGE(PG8_SA(1, 1), a1 + hstep, voffA);
            PG8_WAIT_V(8); PG8_WAIT_L(0); PG8_BAR; PG8_MMA(0, 0, At, B0); PG8_MMA(0, 1, At, B1); PG8_BAR; PG8_SCHED;
            PG8_LDA(At, 0, 1); PG8_STAGE(PG8_SB(0, 0), b2, voffB); PG8_STAGE(PG8_SB(0, 1), b2 + hstep, voffB); PG8_STAGE(PG8_SA(0, 0), a2, voffA);
            PG8_WAIT_V(8); PG8_WAIT_L(0); PG8_BAR; PG8_MMA(1, 0, At, B0); PG8_MMA(1, 1, At, B1); PG8_BAR; PG8_SCHED;
            PG8_LDB(B0, 1, 0); PG8_LDB(B1, 1, 1); PG8_SCHED; PG8_LDA(At, 1, 0); PG8_STAGE(PG8_SA(0, 1), a2 + hstep, voffA);
            PG8_WAIT_V(8); PG8_WAIT_L(0); PG8_BAR; PG8_MMA(0, 0, At, B0); PG8_MMA(0, 1, At, B1); PG8_BAR; PG8_SCHED;
            PG8_LDA(At, 1, 1); PG8_STAGE(PG8_SB(1, 0), b3, voffB); PG8_STAGE(PG8_SB(1, 1), b3 + hstep, voffB); PG8_STAGE(PG8_SA(1, 0), a3, voffA);
            PG8_WAIT_V(8); PG8_WAIT_L(0); PG8_BAR; PG8_MMA(1, 0, At, B0); PG8_MMA(1, 1, At, B1); PG8_BAR; PG8_SCHED;
            } else {
            PG8_LDB(B0, 0, 0); PG8_SCHED; PG8_LDA(At, 0, 0); PG8_STAGE(PG8_SA(1, 1), a1 + hstep, voffA);
            PG8_WAIT_L(8); PG8_BAR; PG8_WAIT_L(0); PG8_MMA(0, 0, At, B0); PG8_BAR; PG8_SCHED;
            PG8_LDB(B1, 0, 1); PG8_STAGE(PG8_SB(0, 0), b2, voffB);
            PG8_BAR; PG8_WAIT_L(0); PG8_MMA(0, 1, At, B1); PG8_BAR;
            PG8_LDA(At, 0, 1); PG8_STAGE(PG8_SA(0, 0), a2, voffA);
            PG8_BAR; PG8_WAIT_L(0); PG8_MMA(1, 0, At, B0); PG8_BAR; PG8_SCHED;
            PG8_STAGE(PG8_SB(0, 1), b2 + hstep, voffB);
            PG8_WAIT_V(6); PG8_BAR; PG8_MMA(1, 1, At, B1); PG8_BAR;
            PG8_LDB(B0, 1, 0); PG8_SCHED; PG8_LDA(At, 1, 0); PG8_STAGE(PG8_SA(0, 1), a2 + hstep, voffA);
            PG8_WAIT_L(8); PG8_BAR; PG8_WAIT_L(0); PG8_MMA(0, 0, At, B0); PG8_BAR; PG8_SCHED;
            PG8_LDB(B1, 1, 1); PG8_STAGE(PG8_SB(1, 0), b3, voffB);
            PG8_BAR; PG8_WAIT_L(0); PG8_MMA(0, 1, At, B1); PG8_BAR;
            PG8_LDA(At, 1, 1); PG8_STAGE(PG8_SA(1, 0), a3, voffA);
            PG8_BAR; PG8_WAIT_L(0); PG8_MMA(1, 0, At, B0); PG8_BAR; PG8_SCHED;
            PG8_STAGE(PG8_SB(1, 1), b3 + hstep, voffB);
            PG8_WAIT_V(6); PG8_BAR; PG8_MMA(1, 1, At, B1); PG8_BAR;
            }
        }
        if constexpr (ALIGN_EPI) { if (wr == 0) PG8_BAR; }
        if constexpr (!Epi::AFTER_DRAIN) { E(acc, cur, wr, wc, fr, fq); S.done(cur); }
        if (!has_next) break;
#pragma unroll
        for (int a = 0; a < 2; ++a)
#pragma unroll
            for (int b = 0; b < 2; ++b)
#pragma unroll
                for (int m = 0; m < 4; ++m)
#pragma unroll
                    for (int n = 0; n < 2; ++n) acc[a][b][m][n] = (f32x4){0.f, 0.f, 0.f, 0.f};
        cur = nxt; cA = nA; cB = nB; ++ui;
        if constexpr (ALIGN_EPI) { if (wr == 1) PG8_BAR; }
    }
    PG8_WAIT_V(0);
    if constexpr (!ALIGN_EPI) { if (wr == 0) PG8_BAR; }
    PG8_BAR;
    if constexpr (Epi::AFTER_DRAIN) { E.fused(acc, cur, wr, wc, fr, fq, lds, wid, lane); S.done(cur); }
#undef PG8_SA
#undef PG8_SB
#undef PG8_STAGE
#undef PG8_LDA
#undef PG8_LDB
#undef PG8_MMA
#undef PG8_WAIT_V
#undef PG8_WAIT_L
#undef PG8_BAR
#undef PG8_SCHED
}
}

namespace cg = cooperative_groups;
using pg8::bf16_t; using pg8::bf16x8; using pg8::f32x4; using pg8::u32x4; using pg8::Unit;
__device__ __forceinline__ unsigned cvt_pk_bf16(float lo, float hi) { unsigned r; asm volatile("v_cvt_pk_bf16_f32 %0, %1, %2" : "=v"(r) : "v"(lo), "v"(hi)); return r; }
#define LAS __attribute__((address_space(3)))
typedef unsigned u32x2 __attribute__((ext_vector_type(2)));
typedef float f32x2v __attribute__((ext_vector_type(2)));

constexpr int M_TOK = 8192, DM = 2048, FF = 5632, HW = 1024, CW = 1024, MIXIN = 7168, PLE = 256, SEQ = 2048;
constexpr float EPS = 1e-6f;
constexpr size_t MiB = 1ull << 20;
constexpr size_t WS_W1GU = 0, WS_W1D = 44 * MiB, WS_WIN = 66 * MiB, WS_WOUT = 94 * MiB, WS_W2GU = 102 * MiB, WS_W2D = 146 * MiB,
                 WS_WPG = 168 * MiB, WS_WPE = 176 * MiB, WS_PB = 177 * MiB, WS_XB = 181 * MiB, WS_MIX = 213 * MiB, WS_G = 245 * MiB,
                 WS_QS = 245 * MiB, WS_VH = 261 * MiB, WS_GH = 277 * MiB, WS_BC = 293 * MiB, WS_UC = 309 * MiB, WS_LF = 325 * MiB,
                 WS_S = 357 * MiB, WS_PLE = 245 * MiB, WS_SS = 389 * MiB, WS_DD = 389 * MiB + 512 * 1024, WS_BAR = 390 * MiB + 512 * 1024, WS_END = 391 * MiB, WS_U = 0;
constexpr int LDS_BYTES = 144 * 1024;
constexpr int NPHASE = 12;

__device__ __forceinline__ float bf2f(bf16_t b) { return __uint_as_float(((unsigned)b) << 16); }
__device__ __forceinline__ float bflo(unsigned w) { return __uint_as_float(w << 16); }
__device__ __forceinline__ float bfhi(unsigned w) { return __uint_as_float(w & 0xffff0000u); }
__device__ __forceinline__ float wave_sum(float v) {
#pragma unroll
    for (int o = 1; o < 64; o <<= 1) v += __shfl_xor(v, o);
    return v;
}
__device__ __forceinline__ float fsigmoid(float x) { return __builtin_amdgcn_rcpf(1.0f + __expf(-x)); }
__device__ __forceinline__ float fsilu(float x) { return x * fsigmoid(x); }
__device__ __forceinline__ float rinv_of(float ss) { return rsqrtf(ss * (1.0f / DM) + EPS); }

struct EpiGateUp {
    static constexpr bool PERM = true, AFTER_DRAIN = false;
    bf16_t* G; const float* ss;
    __device__ __forceinline__ void operator()(const f32x4 (&acc)[2][2][4][2], const Unit& u, int wr, int wc, int fr, int fq) const {
        const int row0 = u.pm * 256 + wr * 64 + fr, col0 = u.pn * 128 + wc * 32 + 8 * fq;
#pragma unroll
        for (int ai = 0; ai < 2; ++ai)
#pragma unroll
            for (int m = 0; m < 4; ++m) {
                const int r = row0 + ai * 128 + m * 16; const float ri = rinv_of(ss[r]);
                float v[8];
#pragma unroll
                for (int n = 0; n < 2; ++n)
#pragma unroll
                    for (int j = 0; j < 4; ++j) v[n * 4 + j] = fsilu(acc[ai][0][m][n][j] * ri) * (acc[ai][1][m][n][j] * ri);
                u32x4 w; w.x = cvt_pk_bf16(v[0], v[1]); w.y = cvt_pk_bf16(v[2], v[3]); w.z = cvt_pk_bf16(v[4], v[5]); w.w = cvt_pk_bf16(v[6], v[7]);
                *(u32x4*)(G + (size_t)r * FF + col0) = w;
            }
    }
};
struct EpiResid {
    static constexpr bool PERM = true, AFTER_DRAIN = false;
    const float* R; float* H; bf16_t* XB; float* ss_out; float scale;
    __device__ __forceinline__ void operator()(const f32x4 (&acc)[2][2][4][2], const Unit& u, int wr, int wc, int fr, int fq) const {
        const int row0 = u.pm * 256 + wr * 64 + fr, col0 = u.pn * 256 + wc * 32 + 8 * fq;
#pragma unroll
        for (int ai = 0; ai < 2; ++ai)
#pragma unroll
            for (int m = 0; m < 4; ++m) {
                const int r = row0 + ai * 128 + m * 16; float sq = 0.f;
#pragma unroll
                for (int bj = 0; bj < 2; ++bj) {
                    const size_t off = (size_t)r * DM + col0 + bj * 128;
                    f32x4 v0 = *(const f32x4*)(R + off) + acc[ai][bj][m][0] * scale, v1 = *(const f32x4*)(R + off + 4) + acc[ai][bj][m][1] * scale;
                    *(f32x4*)(H + off) = v0; *(f32x4*)(H + off + 4) = v1;
                    u32x4 w; w.x = cvt_pk_bf16(v0[0], v0[1]); w.y = cvt_pk_bf16(v0[2], v0[3]); w.z = cvt_pk_bf16(v1[0], v1[1]); w.w = cvt_pk_bf16(v1[2], v1[3]);
                    *(u32x4*)(XB + off) = w;
                    sq += (v0[0] * v0[0] + v0[1] * v0[1]) + (v0[2] * v0[2] + v0[3] * v0[3]) + (v1[0] * v1[0] + v1[1] * v1[1]) + (v1[2] * v1[2] + v1[3] * v1[3]);
                }
                sq += __shfl_xor(sq, 16); sq += __shfl_xor(sq, 32);
                if (fq == 0) atomicAdd(ss_out + r, sq);
            }
    }
};
struct EpiMixIn {
    static constexpr bool PERM = true, AFTER_DRAIN = false;
    const float* ss; const float* lbl;
    bf16_t *QS, *UC; float* LF;
    __device__ __forceinline__ void operator()(const f32x4 (&acc)[2][2][4][2], const Unit& u, int wr, int wc, int fr, int fq) const {
        const int row0 = u.pm * 256 + wr * 64 + fr; const int sec = u.pn >> 2;
        if (u.pn >= 20) {
            const int col0 = (u.pn - 20) * 128 + wc * 32 + 8 * fq;
#pragma unroll
            for (int ai = 0; ai < 2; ++ai)
#pragma unroll
                for (int m = 0; m < 4; ++m) {
                    const int r = row0 + ai * 128 + m * 16; const float ri = rinv_of(ss[r]); const float ri2 = ri * ri;
                    float v[8];
#pragma unroll
                    for (int n = 0; n < 2; ++n)
#pragma unroll
                        for (int j = 0; j < 4; ++j) v[n * 4 + j] = acc[ai][0][m][n][j] * acc[ai][1][m][n][j] * ri2;
                    u32x4 w; w.x = cvt_pk_bf16(v[0], v[1]); w.y = cvt_pk_bf16(v[2], v[3]); w.z = cvt_pk_bf16(v[4], v[5]); w.w = cvt_pk_bf16(v[6], v[7]);
                    *(u32x4*)(UC + (size_t)r * CW + col0) = w;
                }
            return;
        }
        const int col0 = (u.pn & 3) * 256 + wc * 32 + 8 * fq;
        if (sec == 1) {
#pragma unroll
            for (int bj = 0; bj < 2; ++bj)
#pragma unroll
                for (int n = 0; n < 2; ++n) {
                    const int c = col0 + bj * 128 + 4 * n; const f32x4 l0 = *(const f32x4*)(lbl + c), l1 = *(const f32x4*)(lbl + 1024 + c);
                    f32x4 lb; lb[0] = fsigmoid(l0[0] - l1[0]); lb[1] = fsigmoid(l0[1] - l1[1]); lb[2] = fsigmoid(l0[2] - l1[2]); lb[3] = fsigmoid(l0[3] - l1[3]);
#pragma unroll
                    for (int ai = 0; ai < 2; ++ai)
#pragma unroll
                        for (int m = 0; m < 4; ++m) {
                            const int r = row0 + ai * 128 + m * 16; const float ri = rinv_of(ss[r]);
                            const f32x4 x = acc[ai][bj][m][n]; f32x4 o;
                            o[0] = __logf(lb[0] + (1.0f - lb[0]) * fsigmoid(x[0] * ri)); o[1] = __logf(lb[1] + (1.0f - lb[1]) * fsigmoid(x[1] * ri));
                            o[2] = __logf(lb[2] + (1.0f - lb[2]) * fsigmoid(x[2] * ri)); o[3] = __logf(lb[3] + (1.0f - lb[3]) * fsigmoid(x[3] * ri));
                            *(f32x4*)(LF + (size_t)r * HW + c) = o;
                        }
                }
            return;
        }
        bf16_t* dst = QS + (size_t)(sec == 0 ? 0 : sec - 1) * ((size_t)M_TOK * HW);
        const bool act = (sec == 0 || sec == 3);
#pragma unroll
        for (int ai = 0; ai < 2; ++ai)
#pragma unroll
            for (int m = 0; m < 4; ++m) {
                const int r = row0 + ai * 128 + m * 16; const float ri = rinv_of(ss[r]);
#pragma unroll
                for (int bj = 0; bj < 2; ++bj) {
                    float v[8];
#pragma unroll
                    for (int n = 0; n < 2; ++n)
#pragma unroll
                        for (int j = 0; j < 4; ++j) { const float x = acc[ai][bj][m][n][j] * ri; v[n * 4 + j] = act ? fsilu(x) : x; }
                    u32x4 w; w.x = cvt_pk_bf16(v[0], v[1]); w.y = cvt_pk_bf16(v[2], v[3]); w.z = cvt_pk_bf16(v[4], v[5]); w.w = cvt_pk_bf16(v[6], v[7]);
                    *(u32x4*)(dst + (size_t)r * HW + col0 + bj * 128) = w;
                }
            }
    }
};
struct EpiStoreBf16 {
    static constexpr bool PERM = true, AFTER_DRAIN = false;
    bf16_t* O;
    __device__ __forceinline__ void operator()(const f32x4 (&acc)[2][2][4][2], const Unit& u, int wr, int wc, int fr, int fq) const {
        const int row0 = u.pm * 256 + wr * 64 + fr, col0 = u.pn * 256 + wc * 32 + 8 * fq;
#pragma unroll
        for (int ai = 0; ai < 2; ++ai)
#pragma unroll
            for (int m = 0; m < 4; ++m) {
                const int r = row0 + ai * 128 + m * 16;
#pragma unroll
                for (int bj = 0; bj < 2; ++bj) {
                    const f32x4 v0 = acc[ai][bj][m][0], v1 = acc[ai][bj][m][1];
                    u32x4 w; w.x = cvt_pk_bf16(v0[0], v0[1]); w.y = cvt_pk_bf16(v0[2], v0[3]); w.z = cvt_pk_bf16(v1[0], v1[1]); w.w = cvt_pk_bf16(v1[2], v1[3]);
                    *(u32x4*)(O + (size_t)r * DM + col0 + bj * 128) = w;
                }
            }
    }
};
struct EpiPleGate {
    static constexpr bool PERM = true, AFTER_DRAIN = false;
    float* H; const bf16_t* P; const float* ss;
    __device__ __forceinline__ void operator()(const f32x4 (&acc)[2][2][4][2], const Unit& u, int wr, int wc, int fr, int fq) const {
        const int row0 = u.pm * 256 + wr * 64 + fr, col0 = u.pn * 256 + wc * 32 + 8 * fq;
#pragma unroll
        for (int ai = 0; ai < 2; ++ai)
#pragma unroll
            for (int m = 0; m < 4; ++m) {
                const int r = row0 + ai * 128 + m * 16; const float ri = rinv_of(ss[r]);
#pragma unroll
                for (int bj = 0; bj < 2; ++bj) {
                    const size_t off = (size_t)r * DM + col0 + bj * 128;
                    const u32x4 pw = *(const u32x4*)(P + off);
                    f32x4 v0 = *(const f32x4*)(H + off), v1 = *(const f32x4*)(H + off + 4);
                    const f32x4 a0 = acc[ai][bj][m][0], a1 = acc[ai][bj][m][1];
                    v0[0] += fsigmoid(a0[0] * ri) * bflo(pw.x); v0[1] += fsigmoid(a0[1] * ri) * bfhi(pw.x);
                    v0[2] += fsigmoid(a0[2] * ri) * bflo(pw.y); v0[3] += fsigmoid(a0[3] * ri) * bfhi(pw.y);
                    v1[0] += fsigmoid(a1[0] * ri) * bflo(pw.z); v1[1] += fsigmoid(a1[1] * ri) * bfhi(pw.z);
                    v1[2] += fsigmoid(a1[2] * ri) * bflo(pw.w); v1[3] += fsigmoid(a1[3] * ri) * bfhi(pw.w);
                    *(f32x4*)(H + off) = v0; *(f32x4*)(H + off + 4) = v1;
                }
            }
    }
};

template <int MODE>
__device__ __forceinline__ void p0_item(const float* W, const float* W2, const float* gain, int K, int N, bf16_t* WT, LAS float* scr, int item, int lane) {
    const int nblk_k = K / 64; const int nb = item / nblk_k, kb = item % nblk_k; const int k0 = 64 * kb, n0 = 32 * nb;
    const float* src = W; int c0 = n0;
    if (MODE == 1) { const int t = n0 >> 8, bj = (n0 >> 7) & 1, c = n0 & 127; src = bj ? W2 : W; c0 = 128 * t + c; }
    if (MODE == 2) { if (n0 >= 5120) { const int tt = n0 - 5120; const int t = tt >> 8, bj = (tt >> 7) & 1, c = tt & 127; c0 = 5120 + 1024 * bj + 128 * t + c; } }
#pragma unroll 8
    for (int i = 0; i < 32; ++i) { const int kk = 2 * i + (lane >> 5); float v = src[(size_t)(k0 + kk) * N + c0 + (lane & 31)]; if (gain) v *= gain[k0 + kk]; scr[kk * 33 + (lane & 31)] = v; }
    asm volatile("s_waitcnt lgkmcnt(0)" ::: "memory");
    const int c = lane & 7;
#pragma unroll
    for (int j = 0; j < 4; ++j) { const int n = (lane >> 3) + 8 * j; const LAS float* s = scr + (8 * c) * 33 + n;
        u32x4 o; o.x = cvt_pk_bf16(s[0 * 33], s[1 * 33]); o.y = cvt_pk_bf16(s[2 * 33], s[3 * 33]); o.z = cvt_pk_bf16(s[4 * 33], s[5 * 33]); o.w = cvt_pk_bf16(s[6 * 33], s[7 * 33]);
        *(u32x4*)(WT + (size_t)(n0 + n) * K + k0 + 8 * c) = o; }
    asm volatile("s_waitcnt lgkmcnt(0)" ::: "memory");
}

struct Args { const float* in[21]; float* out; unsigned char* ws; int ph_lo, ph_hi; };

__device__ __forceinline__ void phase0(const Args& a, LAS unsigned char* lds, int wave, int lane) {
    unsigned char* ws = a.ws;
    LAS float* scr = (LAS float*)(lds + wave * 16384);
    const int gw = blockIdx.x * 8 + wave, NGW = gridDim.x * 8;
    constexpr int I0 = 32 * 352, I1 = 88 * 64, I2 = 32 * 224, I3 = 32 * 64, I7 = 4 * 64;
    constexpr int NIT = 2 * I0 + 2 * I1 + I2 + 2 * I3 + I7;
    for (int it = gw; it < NIT; it += NGW) {
        int r = it;
        if (r < I0) { p0_item<1>(a.in[3], a.in[4], a.in[2], DM, FF, (bf16_t*)(ws + WS_W1GU), scr, r, lane); continue; } r -= I0;
        if (r < I0) { p0_item<1>(a.in[14], a.in[15], a.in[13], DM, FF, (bf16_t*)(ws + WS_W2GU), scr, r, lane); continue; } r -= I0;
        if (r < I1) { p0_item<0>(a.in[5], nullptr, nullptr, FF, DM, (bf16_t*)(ws + WS_W1D), scr, r, lane); continue; } r -= I1;
        if (r < I1) { p0_item<0>(a.in[16], nullptr, nullptr, FF, DM, (bf16_t*)(ws + WS_W2D), scr, r, lane); continue; } r -= I1;
        if (r < I2) { p0_item<2>(a.in[7], nullptr, a.in[6], DM, MIXIN, (bf16_t*)(ws + WS_WIN), scr, r, lane); continue; } r -= I2;
        if (r < I3) { p0_item<0>(a.in[12], nullptr, nullptr, DM, DM, (bf16_t*)(ws + WS_WOUT), scr, r, lane); continue; } r -= I3;
        if (r < I3) { p0_item<0>(a.in[19], nullptr, a.in[17], DM, DM, (bf16_t*)(ws + WS_WPG), scr, r, lane); continue; } r -= I3;
        p0_item<0>(a.in[18], nullptr, nullptr, PLE, DM, (bf16_t*)(ws + WS_WPE), scr, r, lane);
    }
    float* SS = (float*)(ws + WS_SS);
    for (int m = gw; m < M_TOK; m += NGW) {
        const f32x4* xr = (const f32x4*)(a.in[0] + (size_t)m * DM) + lane; u32x2* xb = (u32x2*)((bf16_t*)(ws + WS_XB) + (size_t)m * DM) + lane;
        float s = 0.f;
#pragma unroll
        for (int j = 0; j < 8; ++j) { const f32x4 v = xr[64 * j]; s += (v[0] * v[0] + v[1] * v[1]) + (v[2] * v[2] + v[3] * v[3]);
            u32x2 w; w.x = cvt_pk_bf16(v[0], v[1]); w.y = cvt_pk_bf16(v[2], v[3]); xb[64 * j] = w; }
        s = wave_sum(s);
        if (lane == 0) { SS[m] = s; SS[8192 + m] = 0.f; SS[16384 + m] = 0.f; SS[24576 + m] = 0.f; }
    }
    { const int gt = blockIdx.x * 512 + threadIdx.x, NT = gridDim.x * 512;
      for (int i = gt; i < M_TOK * PLE / 4; i += NT) { const f32x4 v = ((const f32x4*)a.in[1])[i]; u32x2 w; w.x = cvt_pk_bf16(v[0], v[1]); w.y = cvt_pk_bf16(v[2], v[3]); ((u32x2*)(ws + WS_PB))[i] = w; } }
}

constexpr int HP = 136, VP = 72;
constexpr int L_QT = 0, L_QH = L_QT + 64 * HP * 2, L_KA = L_QH + 64 * HP * 2, L_KB = L_KA + 64 * HP * 2, L_ST = L_KB + 32 * HP * 2, L_VT = L_ST + 128 * HP * 2,
              L_P = L_VT + 128 * VP * 2, L_SEG = L_P + 64 * VP * 2, L_PART = L_SEG + 4 * 128 * 4, L_RINV = L_PART + 8 * 64 * 4, L_HEND = L_RINV + 256, L_KT = 0;
static_assert(L_HEND <= LDS_BYTES, "LDS");
#define MFMA16(a, b, c) __builtin_amdgcn_mfma_f32_16x16x32_bf16((a), (b), (c), 0, 0, 0)
__device__ __forceinline__ bf16_t f2bf(float x) { return (bf16_t)(cvt_pk_bf16(x, 0.f) & 0xffffu); }

__device__ __forceinline__ void hgrn_pass_a(const Args& a, LAS unsigned char* lds, int wave, int lane) {
    unsigned char* ws = a.ws;
    const float* LF = (const float*)(ws + WS_LF); const bf16_t* VH = (const bf16_t*)(ws + WS_VH); float* U = (float*)(ws + WS_U); float* Dd = (float*)(ws + WS_DD);
    const int tid = threadIdx.x, k = tid & 127, sg = tid >> 7, fr = lane & 15, fq = lane >> 4;
    LAS bf16_t* VT = (LAS bf16_t*)(lds + L_VT); LAS bf16_t* KT = (LAS bf16_t*)(lds + L_KT); LAS float* SEG = (LAS float*)(lds + L_SEG);
    for (int item = blockIdx.x; item < 1024; item += gridDim.x) {
        const int row0 = (item >> 3) * 64, cb = (item & 7) * 128;
        float lf[16], b[16];
#pragma unroll
        for (int i = 0; i < 16; ++i) lf[i] = LF[(size_t)(row0 + 16 * sg + i) * HW + cb + k];
        u32x4 vv[2];
#pragma unroll
        for (int j = 0; j < 2; ++j) { const int idx = tid + 512 * j; vv[j] = *(const u32x4*)(VH + (size_t)(row0 + (idx >> 4)) * HW + cb + 8 * (idx & 15)); }
        float run = 0.f;
#pragma unroll
        for (int i = 0; i < 16; ++i) { run += lf[i]; b[i] = run; }
        SEG[sg * 128 + k] = run;
        __syncthreads();
        const float s0 = SEG[k], s1 = SEG[128 + k], s2 = SEG[256 + k], s3 = SEG[384 + k];
        const float pre = sg == 0 ? 0.f : (sg == 1 ? s0 : (sg == 2 ? s0 + s1 : s0 + s1 + s2));
        const float blast = s0 + s1 + s2 + s3;
        unsigned pk[8];
#pragma unroll
        for (int i = 0; i < 8; ++i) {
            const float e0 = (1.0f - __expf(lf[2 * i])) * __expf(blast - (pre + b[2 * i])), e1 = (1.0f - __expf(lf[2 * i + 1])) * __expf(blast - (pre + b[2 * i + 1]));
            pk[i] = cvt_pk_bf16(e0, e1); }
        { u32x4 w0, w1; w0.x = pk[0]; w0.y = pk[1]; w0.z = pk[2]; w0.w = pk[3]; w1.x = pk[4]; w1.y = pk[5]; w1.z = pk[6]; w1.w = pk[7];
          *(LAS u32x4*)(KT + k * VP + 16 * sg) = w0; *(LAS u32x4*)(KT + k * VP + 16 * sg + 8) = w1; }
#pragma unroll
        for (int j = 0; j < 2; ++j) { const int idx = tid + 512 * j, s = idx >> 4, v0 = 8 * (idx & 15);
            VT[(v0 + 0) * VP + s] = (bf16_t)(vv[j].x & 0xffffu); VT[(v0 + 1) * VP + s] = (bf16_t)(vv[j].x >> 16);
            VT[(v0 + 2) * VP + s] = (bf16_t)(vv[j].y & 0xffffu); VT[(v0 + 3) * VP + s] = (bf16_t)(vv[j].y >> 16);
            VT[(v0 + 4) * VP + s] = (bf16_t)(vv[j].z & 0xffffu); VT[(v0 + 5) * VP + s] = (bf16_t)(vv[j].z >> 16);
            VT[(v0 + 6) * VP + s] = (bf16_t)(vv[j].w & 0xffffu); VT[(v0 + 7) * VP + s] = (bf16_t)(vv[j].w >> 16); }
        if (sg == 0) Dd[item * 128 + k] = __expf(blast);
        __syncthreads();
        const bf16x8 a0 = *(const LAS bf16x8*)(VT + (16 * wave + fr) * VP + fq * 8), a1 = *(const LAS bf16x8*)(VT + (16 * wave + fr) * VP + 32 + fq * 8);
        float* up = U + (size_t)item * 16384 + (16 * wave + 4 * fq) * 128 + fr;
#pragma unroll
        for (int kt = 0; kt < 8; ++kt) {
            const bf16x8 b0 = *(const LAS bf16x8*)(KT + (16 * kt + fr) * VP + fq * 8), b1 = *(const LAS bf16x8*)(KT + (16 * kt + fr) * VP + 32 + fq * 8);
            f32x4 acc = {0.f, 0.f, 0.f, 0.f};
            acc = MFMA16(a0, b0, acc); acc = MFMA16(a1, b1, acc);
            up[16 * kt] = acc[0]; up[16 * kt + 128] = acc[1]; up[16 * kt + 256] = acc[2]; up[16 * kt + 384] = acc[3];
        }
        __syncthreads();
    }
}

__device__ __forceinline__ void hgrn_scan(const Args& a) {
    unsigned char* ws = a.ws;
    const float* U = (const float*)(ws + WS_U); const float* Dd = (const float*)(ws + WS_DD); bf16_t* SP = (bf16_t*)(ws + WS_S);
    for (int e = (blockIdx.x * 512 + threadIdx.x) * 4; e < 32 * 16384; e += gridDim.x * 512 * 4) {
        const int bh = e >> 14, vk = e & 16383, bb = bh >> 3, h = bh & 7;
        f32x4 S = {0.f, 0.f, 0.f, 0.f};
#pragma unroll 8
        for (int ci = 0; ci < 32; ++ci) {
            const size_t item = (size_t)((bb * 32 + ci) * 8 + h);
            const f32x4 u = *(const f32x4*)(U + item * 16384 + vk); const f32x4 d = *(const f32x4*)(Dd + item * 128 + (vk & 127));
            u32x2 w; w.x = cvt_pk_bf16(S[0], S[1]); w.y = cvt_pk_bf16(S[2], S[3]); *(u32x2*)(SP + item * 16384 + vk) = w;
            S = d * S + u;
        }
    }
}

__device__ __forceinline__ void conv_mixer(const Args& a, int wave, int lane) {
    unsigned char* ws = a.ws;
    const bf16_t* BC = (const bf16_t*)(ws + WS_BC); const bf16_t* UC = (const bf16_t*)(ws + WS_UC); bf16_t* MIX = (bf16_t*)(ws + WS_MIX);
    const float* cn = a.in[11]; const float* cw = a.in[8];
    const int gw = blockIdx.x * 8 + wave, NGW = gridDim.x * 8;
    for (int it = gw; it < M_TOK * 2; it += NGW) {
        const int row = it >> 1, c = (it & 1) * 512 + lane * 8, t = row & (SEQ - 1);
        const size_t off = (size_t)row * CW + c;
        const u32x4 z = {0u, 0u, 0u, 0u};
        const u32x4 u0 = *(const u32x4*)(UC + off), u1 = t >= 1 ? *(const u32x4*)(UC + off - CW) : z, u2 = t >= 2 ? *(const u32x4*)(UC + off - 2 * CW) : z, bg = *(const u32x4*)(BC + off);
        float y[8]; float ssq = 0.f;
#pragma unroll
        for (int q = 0; q < 4; ++q) {
            const unsigned a0 = u0[q], a1 = u1[q], a2 = u2[q], bb = bg[q]; const int cc = c + 2 * q;
            y[2 * q] = bflo(bb) * (cw[cc] * bflo(a2) + cw[CW + cc] * bflo(a1) + cw[2 * CW + cc] * bflo(a0));
            y[2 * q + 1] = bfhi(bb) * (cw[cc + 1] * bfhi(a2) + cw[CW + cc + 1] * bfhi(a1) + cw[2 * CW + cc + 1] * bfhi(a0));
            ssq += y[2 * q] * y[2 * q] + y[2 * q + 1] * y[2 * q + 1];
        }
        ssq += __shfl_xor(ssq, 1); ssq += __shfl_xor(ssq, 2); ssq += __shfl_xor(ssq, 4); ssq += __shfl_xor(ssq, 8);
        const float ri = rsqrtf(ssq * (1.0f / 128) + EPS);
        u32x4 w;
        w.x = cvt_pk_bf16(y[0] * ri * cn[c], y[1] * ri * cn[c + 1]); w.y = cvt_pk_bf16(y[2] * ri * cn[c + 2], y[3] * ri * cn[c + 3]);
        w.z = cvt_pk_bf16(y[4] * ri * cn[c + 4], y[5] * ri * cn[c + 5]); w.w = cvt_pk_bf16(y[6] * ri * cn[c + 6], y[7] * ri * cn[c + 7]);
        *(u32x4*)(MIX + (size_t)row * DM + HW + c) = w;
    }
}

__device__ __forceinline__ void hgrn_pass_c(const Args& a, LAS unsigned char* lds, int wave, int lane) {
    unsigned char* ws = a.ws;
    const float* LF = (const float*)(ws + WS_LF); const bf16_t* VH = (const bf16_t*)(ws + WS_VH); const bf16_t* QS = (const bf16_t*)(ws + WS_QS); const bf16_t* GH = (const bf16_t*)(ws + WS_GH);
    const bf16_t* SP = (const bf16_t*)(ws + WS_S); bf16_t* MIX = (bf16_t*)(ws + WS_MIX); const float* hn = a.in[10];
    const int tid = threadIdx.x, k = tid & 127, sg = tid >> 7, fr = lane & 15, fq = lane >> 4;
    LAS bf16_t* QT = (LAS bf16_t*)(lds + L_QT); LAS bf16_t* QH = (LAS bf16_t*)(lds + L_QH); LAS bf16_t* KA = (LAS bf16_t*)(lds + L_KA); LAS bf16_t* KB = (LAS bf16_t*)(lds + L_KB);
    LAS bf16_t* ST = (LAS bf16_t*)(lds + L_ST); LAS bf16_t* VT = (LAS bf16_t*)(lds + L_VT); LAS bf16_t* P = (LAS bf16_t*)(lds + L_P);
    LAS float* SEG = (LAS float*)(lds + L_SEG); LAS float* PART = (LAS float*)(lds + L_PART); LAS float* RINV = (LAS float*)(lds + L_RINV);
    for (int item = blockIdx.x; item < 1024; item += gridDim.x) {
        const int row0 = (item >> 3) * 64, cb = (item & 7) * 128;
        float lf[16], b[16]; bf16_t qh[16];
#pragma unroll
        for (int i = 0; i < 16; ++i) { lf[i] = LF[(size_t)(row0 + 16 * sg + i) * HW + cb + k]; qh[i] = QS[(size_t)(row0 + 16 * sg + i) * HW + cb + k]; }
        u32x4 vv[2], sv[4];
#pragma unroll
        for (int j = 0; j < 2; ++j) { const int idx = tid + 512 * j; vv[j] = *(const u32x4*)(VH + (size_t)(row0 + (idx >> 4)) * HW + cb + 8 * (idx & 15)); }
#pragma unroll
        for (int j = 0; j < 4; ++j) { const int idx = tid + 512 * j; sv[j] = *(const u32x4*)(SP + (size_t)item * 16384 + (idx >> 4) * 128 + 8 * (idx & 15)); }
        float run = 0.f;
#pragma unroll
        for (int i = 0; i < 16; ++i) { run += lf[i]; b[i] = run; }
        SEG[sg * 128 + k] = run;
        __syncthreads();
        const float s0 = SEG[k], s1 = SEG[128 + k], s2 = SEG[256 + k];
        const float pre = sg == 0 ? 0.f : (sg == 1 ? s0 : (sg == 2 ? s0 + s1 : s0 + s1 + s2));
        const float beta1 = s0 + s1, beta = sg >= 2 ? beta1 : 0.f;
#pragma unroll
        for (int i = 0; i < 16; ++i) {
            const int s = 16 * sg + i; const float bi = pre + b[i], kk = 1.0f - __expf(lf[i]), qv = bf2f(qh[i]);
            QT[s * HP + k] = f2bf(qv * __expf(bi - beta)); QH[s * HP + k] = f2bf(qv * __expf(bi));
            KA[s * HP + k] = f2bf(kk * __expf(fminf(beta - bi, 80.f)));
            if (sg < 2) KB[s * HP + k] = f2bf(kk * __expf(beta1 - bi));
        }
#pragma unroll
        for (int j = 0; j < 2; ++j) { const int idx = tid + 512 * j, s = idx >> 4, v0 = 8 * (idx & 15);
            VT[(v0 + 0) * VP + s] = (bf16_t)(vv[j].x & 0xffffu); VT[(v0 + 1) * VP + s] = (bf16_t)(vv[j].x >> 16);
            VT[(v0 + 2) * VP + s] = (bf16_t)(vv[j].y & 0xffffu); VT[(v0 + 3) * VP + s] = (bf16_t)(vv[j].y >> 16);
            VT[(v0 + 4) * VP + s] = (bf16_t)(vv[j].z & 0xffffu); VT[(v0 + 5) * VP + s] = (bf16_t)(vv[j].z >> 16);
            VT[(v0 + 6) * VP + s] = (bf16_t)(vv[j].w & 0xffffu); VT[(v0 + 7) * VP + s] = (bf16_t)(vv[j].w >> 16); }
#pragma unroll
        for (int j = 0; j < 4; ++j) { const int idx = tid + 512 * j; *(LAS u32x4*)(ST + (idx >> 4) * HP + 8 * (idx & 15)) = sv[j]; }
        __syncthreads();
#pragma unroll
        for (int pp = 0; pp < 2; ++pp) {
            const int p = wave + 8 * pp, tt = p >> 2, st = p & 3;
            f32x4 acc = {0.f, 0.f, 0.f, 0.f};
            if (st <= tt) {
                const LAS bf16_t* kb = (tt >= 2 && st < 2) ? KB : KA;
#pragma unroll
                for (int ks = 0; ks < 4; ++ks) { const bf16x8 af = *(const LAS bf16x8*)(QT + (16 * tt + fr) * HP + ks * 32 + fq * 8), bfr = *(const LAS bf16x8*)(kb + (16 * st + fr) * HP + ks * 32 + fq * 8);
                    acc = MFMA16(af, bfr, acc); }
            }
#pragma unroll
            for (int r = 0; r < 4; ++r) { const bool keep = (st < tt) || (st == tt && fr <= 4 * fq + r); P[(16 * tt + 4 * fq + r) * VP + 16 * st + fr] = f2bf(keep ? acc[r] : 0.f); }
        }
        __syncthreads();
        bf16x8 bs[4], bv[2];
#pragma unroll
        for (int ks = 0; ks < 4; ++ks) bs[ks] = *(const LAS bf16x8*)(ST + (16 * wave + fr) * HP + ks * 32 + fq * 8);
#pragma unroll
        for (int ks = 0; ks < 2; ++ks) bv[ks] = *(const LAS bf16x8*)(VT + (16 * wave + fr) * VP + ks * 32 + fq * 8);
        f32x4 o[4];
#pragma unroll
        for (int tt = 0; tt < 4; ++tt) {
            f32x4 acc = {0.f, 0.f, 0.f, 0.f};
#pragma unroll
            for (int ks = 0; ks < 4; ++ks) { const bf16x8 af = *(const LAS bf16x8*)(QH + (16 * tt + fr) * HP + ks * 32 + fq * 8); acc = MFMA16(af, bs[ks], acc); }
            { const bf16x8 af = *(const LAS bf16x8*)(P + (16 * tt + fr) * VP + fq * 8); acc = MFMA16(af, bv[0], acc); }
            if (tt >= 2) { const bf16x8 af = *(const LAS bf16x8*)(P + (16 * tt + fr) * VP + 32 + fq * 8); acc = MFMA16(af, bv[1], acc); }
            o[tt] = acc;
        }
#pragma unroll
        for (int tt = 0; tt < 4; ++tt)
#pragma unroll
            for (int r = 0; r < 4; ++r) { float x = o[tt][r] * o[tt][r]; x += __shfl_xor(x, 1); x += __shfl_xor(x, 2); x += __shfl_xor(x, 4); x += __shfl_xor(x, 8);
                if (fr == 0) PART[wave * 64 + 16 * tt + 4 * fq + r] = x; }
        __syncthreads();
        if (tid < 64) { float s = 0.f;
#pragma unroll
            for (int w = 0; w < 8; ++w) s += PART[w * 64 + tid];
            RINV[tid] = rsqrtf(s * (1.0f / 128) + EPS); }
        __syncthreads();
        const float hnv = hn[16 * wave + fr];
#pragma unroll
        for (int tt = 0; tt < 4; ++tt)
#pragma unroll
            for (int r = 0; r < 4; ++r) { const int t = 16 * tt + 4 * fq + r; const size_t row = (size_t)(row0 + t);
                const float g = bf2f(GH[row * HW + cb + 16 * wave + fr]);
                MIX[row * DM + cb + 16 * wave + fr] = f2bf(o[tt][r] * RINV[t] * hnv * g); }
        __syncthreads();
    }
}

__device__ __forceinline__ void phase_final(const Args& a, int wave, int lane) {
    const int gw = blockIdx.x * 8 + wave, NGW = gridDim.x * 8; const float* gF = a.in[20];
    for (int m = gw; m < M_TOK; m += NGW) {
        f32x4* xr = (f32x4*)(a.out + (size_t)m * DM) + lane; f32x4 v[8]; float s = 0.f;
#pragma unroll
        for (int j = 0; j < 8; ++j) { v[j] = xr[64 * j]; s += (v[j][0] * v[j][0] + v[j][1] * v[j][1]) + (v[j][2] * v[j][2] + v[j][3] * v[j][3]); }
        const float ri = rinv_of(wave_sum(s));
#pragma unroll
        for (int j = 0; j < 8; ++j) { const f32x4 g = ((const f32x4*)gF)[64 * j + lane]; xr[64 * j] = v[j] * ri * g; }
    }
}

#define XB_TMO      128
#define XB_XCNT(j)  (256  + 64 * (j))
#define XB_XSUB(j)  (1280 + 64 * (j))
#define XB_XGEN(j)  (2304 + 64 * (j))
#define XB_TOP      3328
#define XB_TOPGEN   3392
#define XCD_BAR_WORDS 3456
#define XB_SPIN_CAP (1u << 18)

__device__ __forceinline__ unsigned xb_ld(unsigned* p)              { return __hip_atomic_load(p, __ATOMIC_RELAXED, __HIP_MEMORY_SCOPE_AGENT); }
__device__ __forceinline__ unsigned xb_add(unsigned* p, unsigned v) { return __hip_atomic_fetch_add(p, v, __ATOMIC_RELAXED, __HIP_MEMORY_SCOPE_AGENT); }
__device__ __forceinline__ unsigned xb_xcc_id() { return (unsigned)__builtin_amdgcn_s_getreg((3 << 11) | 20) & 0xFu; }
#define XB_SPIN(cond, bar) do { unsigned _sp = 0; while (cond) { __builtin_amdgcn_s_sleep(1); \
    if ((++_sp & 255u) == 0u) { if (xb_ld(&(bar)[XB_TMO])) break; if (_sp > XB_SPIN_CAP) { atomicAdd(&(bar)[XB_TMO], 1u); break; } } } } while (0)

struct XcdBarrier {
    unsigned* bar; unsigned x;
    volatile LAS unsigned* st;
};

__device__ __forceinline__ XcdBarrier xcd_barrier_post(unsigned* bar, volatile LAS unsigned* st) {
    XcdBarrier b; b.bar = bar; b.x = xb_xcc_id(); b.st = st;
    if (threadIdx.x == 0) (void)xb_add(&bar[XB_XCNT(b.x)], 1u);
    return b;
}
__device__ __forceinline__ void xcd_barrier_complete(unsigned* bar, unsigned x, unsigned& nloc, unsigned& nx) {
    const unsigned G = gridDim.x * gridDim.y * gridDim.z;
    unsigned sum, cnt, mine, sp = 0u;
    for (;;) {
        sum = 0u; cnt = 0u; mine = 0u;
#pragma unroll
        for (unsigned j = 0; j < 16; ++j) { const unsigned c = xb_ld(&bar[XB_XCNT(j)]); sum += c; cnt += (c > 0u) ? 1u : 0u; mine = (j == x) ? c : mine; }
        if (sum == G) break;
        __builtin_amdgcn_s_sleep(1);
        if ((++sp & 255u) == 0u) { if (xb_ld(&bar[XB_TMO])) break; if (sp > XB_SPIN_CAP) { atomicAdd(&bar[XB_TMO], 1u); break; } }
    }
    nloc = mine > 0u ? mine : 1u; nx = cnt > 0u ? cnt : 1u;
}

__device__ __forceinline__ void xcd_barrier(const XcdBarrier& b) {
    asm volatile("s_waitcnt vmcnt(0)" ::: "memory");
    __syncthreads();
    if (threadIdx.x == 0) {
        unsigned* bar = b.bar;
        __builtin_amdgcn_s_waitcnt(0);
        unsigned nloc = b.st[0], nx = b.st[1];
        if (nloc == 0u) { xcd_barrier_complete(bar, b.x, nloc, nx); b.st[0] = nloc; b.st[1] = nx; }
        const unsigned old = xb_add(&bar[XB_XSUB(b.x)], 1u);
        const unsigned gen = old / nloc;
        if (old + 1u == (gen + 1u) * nloc) {
            __builtin_amdgcn_fence(__ATOMIC_RELEASE, "agent");
            asm volatile("s_waitcnt vmcnt(0)" ::: "memory");
            const unsigned og = xb_add(&bar[XB_TOP], 1u);
            const unsigned tg = og / nx;
            if (og + 1u == (tg + 1u) * nx) xb_add(&bar[XB_TOPGEN], 1u);
            else XB_SPIN(xb_ld(&bar[XB_TOPGEN]) == tg, bar);
            __builtin_amdgcn_fence(__ATOMIC_ACQUIRE, "agent");
            xb_add(&bar[XB_XGEN(b.x)], 1u);
            asm volatile("s_waitcnt vmcnt(0)" ::: "memory");
        } else {
            XB_SPIN(xb_ld(&bar[XB_XGEN(b.x)]) == gen, bar);
            __builtin_amdgcn_fence(__ATOMIC_ACQUIRE, "agent");
            asm volatile("s_waitcnt vmcnt(0)" ::: "memory");
        }
    }
    __syncthreads();
}


template <class Epi>
__device__ __forceinline__ void run_gemm(LAS unsigned char* lds, const bf16_t* A, const bf16_t* Bt, int N, int K, const Epi& E) {
    pg8::Gemm g; g.A = A; g.Bt = Bt; g.M = M_TOK; g.N = N; g.K = K;
    pg8::StaticOrder S; S.init(M_TOK, N, (int)gridDim.x, (int)blockIdx.x);
    pg8::gemm_phase<Epi, pg8::StaticOrder, true, true>(lds, g, S, E);
}

__global__ void __launch_bounds__(512, 2) fwd_kernel(Args a) {
    extern __shared__ __attribute__((aligned(16))) unsigned char lds_raw[];
    LAS unsigned char* lds = (LAS unsigned char*)lds_raw;
    cg::grid_group grid = cg::this_grid();
    volatile LAS unsigned* xst = (volatile LAS unsigned*)(lds + LDS_BYTES - 16);
    if (threadIdx.x < 4) xst[threadIdx.x] = 0u;
    __syncthreads();
    XcdBarrier xbar = xcd_barrier_post((unsigned*)(a.ws + WS_BAR), xst);
    const int tid = threadIdx.x, lane = tid & 63, wave = __builtin_amdgcn_readfirstlane(tid >> 6);
    unsigned char* ws = a.ws;
    float* SS = (float*)(ws + WS_SS);
    bf16_t* XB = (bf16_t*)(ws + WS_XB); bf16_t* G = (bf16_t*)(ws + WS_G); bf16_t* MIX = (bf16_t*)(ws + WS_MIX);
#define PH(i) if (a.ph_lo <= (i) && (i) < a.ph_hi)
#define SYNC(i) if (a.ph_lo <= (i) && (i) + 1 < a.ph_hi) { if ((i) == 0) grid.sync(); else xcd_barrier(xbar); }
    PH(0) { phase0(a, lds, wave, lane); } SYNC(0)
    PH(1) { EpiGateUp E; E.G = G; E.ss = SS; run_gemm(lds, XB, (const bf16_t*)(ws + WS_W1GU), 2 * FF, DM, E); } SYNC(1)
    PH(2) { EpiResid E; E.R = a.in[0]; E.H = a.out; E.XB = XB; E.ss_out = SS + 8192; E.scale = 0.5f; run_gemm(lds, G, (const bf16_t*)(ws + WS_W1D), DM, FF, E); } SYNC(2)
    PH(3) { EpiMixIn E; E.ss = SS + 8192; E.lbl = a.in[9]; E.QS = (bf16_t*)(ws + WS_QS);
            E.UC = (bf16_t*)(ws + WS_UC); E.LF = (float*)(ws + WS_LF); run_gemm(lds, XB, (const bf16_t*)(ws + WS_WIN), MIXIN, DM, E); } SYNC(3)
    PH(4) { hgrn_pass_a(a, lds, wave, lane); } SYNC(4)
    PH(5) { hgrn_scan(a); conv_mixer(a, wave, lane); } SYNC(5)
    PH(6) { hgrn_pass_c(a, lds, wave, lane); } SYNC(6)
    PH(7) { EpiResid E; E.R = a.out; E.H = a.out; E.XB = XB; E.ss_out = SS + 16384; E.scale = 1.0f; run_gemm(lds, MIX, (const bf16_t*)(ws + WS_WOUT), DM, DM, E); } SYNC(7)
    PH(8) { EpiGateUp E; E.G = G; E.ss = SS + 16384; run_gemm(lds, XB, (const bf16_t*)(ws + WS_W2GU), 2 * FF, DM, E); } SYNC(8)
    PH(9) { EpiResid E; E.R = a.out; E.H = a.out; E.XB = XB; E.ss_out = SS + 24576; E.scale = 0.5f; run_gemm(lds, G, (const bf16_t*)(ws + WS_W2D), DM, FF, E); } SYNC(9)
    PH(10) { { EpiStoreBf16 E; E.O = (bf16_t*)(ws + WS_PLE); int kp = PLE; asm volatile("" : "+s"(kp)); run_gemm(lds, (const bf16_t*)(ws + WS_PB), (const bf16_t*)(ws + WS_WPE), DM, kp, E); }
             { EpiPleGate E; E.H = a.out; E.P = (const bf16_t*)(ws + WS_PLE); E.ss = SS + 24576; run_gemm(lds, XB, (const bf16_t*)(ws + WS_WPG), DM, DM, E); } } SYNC(10)
    PH(11) { phase_final(a, wave, lane); }
#undef PH
#undef SYNC
}

#ifndef MK_MULTI
#define MK_MULTI 0
#endif
extern "C" void kernel_launch(void* const* d_in, const int* in_sizes, int n_in, void* d_out, int out_size, void* d_ws, size_t ws_size, hipStream_t stream) {
    static int grid = 0;
    if (grid == 0) {
        if (n_in != 21 || out_size != M_TOK * DM || ws_size < WS_END) { fprintf(stderr, "kernel_launch: unexpected shapes (n_in %d out %d ws %zu need %zu)\n", n_in, out_size, ws_size, (size_t)WS_END); grid = -1; return; }
        int dev = 0, cus = 0, per_cu = 0;
        hipGetDevice(&dev); hipDeviceGetAttribute(&cus, hipDeviceAttributeMultiprocessorCount, dev);
        if (hipFuncSetAttribute((const void*)fwd_kernel, hipFuncAttributeMaxDynamicSharedMemorySize, LDS_BYTES) != hipSuccess) { fprintf(stderr, "kernel_launch: hipFuncSetAttribute failed\n"); grid = -1; return; }
        if (hipOccupancyMaxActiveBlocksPerMultiprocessor(&per_cu, (const void*)fwd_kernel, 512, LDS_BYTES) != hipSuccess || per_cu < 1) { fprintf(stderr, "kernel_launch: occupancy query failed (%d)\n", per_cu); grid = -1; return; }
        grid = cus * per_cu;
    }
    if (grid < 0) return;
    Args a{};
    for (int i = 0; i < 21; ++i) a.in[i] = (const float*)d_in[i];
    a.out = (float*)d_out; a.ws = (unsigned char*)d_ws;
#if MK_MULTI
    for (int p = 0; p < NPHASE; ++p) { a.ph_lo = p; a.ph_hi = p + 1; hipLaunchKernelGGL(fwd_kernel, dim3(grid), dim3(512), LDS_BYTES, stream, a); }
#else
    a.ph_lo = 0; a.ph_hi = NPHASE;
    if (hipMemsetAsync((char*)d_ws + WS_BAR, 0, XCD_BAR_WORDS * 4, stream) != hipSuccess) { fprintf(stderr, "kernel_launch: memset failed\n"); return; }
    void* args[] = {&a};
    hipError_t e = hipLaunchCooperativeKernel((void*)fwd_kernel, dim3(grid), dim3(512), args, LDS_BYTES, stream);
    if (e != hipSuccess) fprintf(stderr, "cooperative launch failed: %s (grid %d)\n", hipGetErrorString(e), grid);
#endif
}
```

```cpp
#include <hip/hip_runtime.h>
#include <hip/hip_cooperative_groups.h>
#include <cstdio>
#include <cstdint>
namespace pg8 {
#define PG8_LAS __attribute__((address_space(3)))
typedef unsigned short bf16_t;
typedef short bf16x8 __attribute__((ext_vector_type(8)));
typedef float f32x4 __attribute__((ext_vector_type(4)));
typedef unsigned u32x4 __attribute__((ext_vector_type(4)));
constexpr int BM = 256, BK = 64, HALF = 128, HTB = HALF * BK * 2  , STAGE_BYTES = 8 * HTB, NXCD = 8, WGM = 8;

__host__ __device__ __forceinline__ int lds_byte(int r, int c) { const int st = (r >> 4) * 2 + (c >> 5), rr = r & 15, cc = c & 31, ob = rr * 64 + cc * 2; return st * 1024 + (ob ^ (((ob >> 9) & 1) << 5)); }
__host__ __device__ __forceinline__ void stage_rc(int b, int& R, int& C) { const int st = b / 1024, sb = b % 1024, swz = sb ^ (((sb >> 9) & 1) << 5); R = (st >> 1) * 16 + swz / 64; C = (st & 1) * 32 + (swz % 64) / 2; }
__host__ __device__ __forceinline__ int perm32(int rho) { const int n = rho >> 4, i = rho & 15; return 8 * (i >> 2) + 4 * n + (i & 3); }

struct Unit { int pm, pn; };
struct Gemm { const bf16_t* A; const bf16_t* Bt; int M, N, K; };

struct StaticOrder {
    int nM, nN, nwg, G, c;
    __host__ __device__ void init(int M, int N, int G_, int c_) { nM = M / BM; nN = N / BM; nwg = nM * nN; G = G_; c = c_; }
    __host__ __device__ bool next(int i, Unit& u) const {
        const long L = (long)i * G + c; if (L >= nwg) return false;
        int wgid = (int)L; { const int q = nwg / NXCD, r = nwg % NXCD, xcd = wgid % NXCD, off = wgid / NXCD; wgid = (xcd < r ? xcd * (q + 1) : r * (q + 1) + (xcd - r) * q) + off; }
        const int nig = WGM * nN, gid = wgid / nig, fm = gid * WGM, gsz = (nM - fm) < WGM ? (nM - fm) : WGM;
        u.pm = fm + ((wgid % nig) % gsz); u.pn = (wgid % nig) / gsz; return true;
    }
    __device__ __forceinline__ void a_ready(const Unit&) const {}
    __device__ __forceinline__ void done(const Unit&) const {}
};
typedef float f32x2 __attribute__((ext_vector_type(2)));
template <class Epi, class Sched, bool ALIGN_EPI = false, bool SP2 = false>
__device__ __forceinline__ void gemm_phase(PG8_LAS unsigned char* lds, const Gemm g, const Sched& S, const Epi& E) {
    const int tid = threadIdx.x, wid = __builtin_amdgcn_readfirstlane(tid >> 6), lane = tid & 63, wr = wid >> 2, wc = wid & 3, fr = lane & 15, fq = lane >> 4;
    const int K = g.K, nt = K / BK;
    unsigned voffA[2], voffB[2];
#pragma unroll
    for (int i = 0; i < 2; ++i) { int R, C; stage_rc(tid * 16 + i * 8192, R, C); const int Rb = Epi::PERM ? ((R & ~31) + perm32(R & 31)) : R;
        voffA[i] = (unsigned)(R * K + C) * 2u; voffB[i] = (unsigned)(Rb * K + C) * 2u; }
    const size_t kstep = (size_t)(BK * 2);
    const size_t hstep = (size_t)HALF * K * 2;
    const size_t tstep = 2 * hstep;
    const unsigned ldsw = (unsigned)wid * 1024u;
    const int aoff = lds_byte(wr * 64 + fr, fq * 8), boff = lds_byte(wc * 32 + fr, fq * 8);
#define PG8_SA(b, h) (((b) * 2 + (h)) * HTB)
#define PG8_SB(b, h) ((4 + (b) * 2 + (h)) * HTB)
#define PG8_STAGE(bufoff, gbase, voff) do { _Pragma("unroll") for (int _i = 0; _i < 2; ++_i) \
        __builtin_amdgcn_global_load_lds((const unsigned*)((const char*)(gbase) + (voff)[_i]), (PG8_LAS unsigned*)(lds + (bufoff) + ldsw + _i * 8192), 16, 0, 0); } while (0)
#define PG8_LDA(dst, b, h) do { _Pragma("unroll") for (int m = 0; m < 4; ++m) _Pragma("unroll") for (int k = 0; k < 2; ++k) dst[m][k] = *(const PG8_LAS bf16x8*)(lds + PG8_SA(b, h) + aoff + m * 2048 + k * 1024); } while (0)
#define PG8_LDB(dst, b, h) do { _Pragma("unroll") for (int n = 0; n < 2; ++n) _Pragma("unroll") for (int k = 0; k < 2; ++k) dst[n][k] = *(const PG8_LAS bf16x8*)(lds + PG8_SB(b, h) + boff + n * 2048 + k * 1024); } while (0)
#define PG8_MMA(ai, bj, At, Bt) do { __builtin_amdgcn_s_setprio(1); _Pragma("unroll") for (int m = 0; m < 4; ++m) _Pragma("unroll") for (int n = 0; n < 2; ++n) _Pragma("unroll") for (int k = 0; k < 2; ++k) \
        acc[ai][bj][m][n] = __builtin_amdgcn_mfma_f32_16x16x32_bf16(Bt[n][k], At[m][k], acc[ai][bj][m][n], 0, 0, 0); __builtin_amdgcn_s_setprio(0); } while (0)
#define PG8_WAIT_V(n) asm volatile("s_waitcnt vmcnt(" #n ")" ::: "memory")
#define PG8_WAIT_L(n) asm volatile("s_waitcnt lgkmcnt(" #n ")" ::: "memory")
#define PG8_BAR __builtin_amdgcn_s_barrier()
#define PG8_SCHED __builtin_amdgcn_sched_barrier(0)
    Unit cur, nxt; int ui = 0;
    if (!S.next(0, cur)) return;
    f32x4 acc[2][2][4][2];
#pragma unroll
    for (int a = 0; a < 2; ++a)
#pragma unroll
        for (int b = 0; b < 2; ++b)
#pragma unroll
            for (int m = 0; m < 4; ++m)
#pragma unroll
                for (int n = 0; n < 2; ++n) acc[a][b][m][n] = (f32x4){0.f, 0.f, 0.f, 0.f};
    bf16x8 At[4][2], B0[2][2], B1[2][2];
    const char* cA = (const char*)g.A + (size_t)cur.pm * tstep; const char* cB = (const char*)g.Bt + (size_t)cur.pn * tstep;
    S.a_ready(cur);
    if constexpr (SP2) {
        PG8_STAGE(PG8_SB(0, 0), cB, voffB); PG8_STAGE(PG8_SB(0, 1), cB + hstep, voffB); PG8_STAGE(PG8_SA(0, 0), cA, voffA); PG8_STAGE(PG8_SA(0, 1), cA + hstep, voffA);
        if (wr == 1) PG8_BAR;
        PG8_WAIT_V(2); PG8_BAR;
        PG8_STAGE(PG8_SB(1, 0), cB + kstep, voffB); PG8_STAGE(PG8_SA(1, 0), cA + kstep, voffA); PG8_STAGE(PG8_SB(1, 1), cB + hstep + kstep, voffB);
        PG8_WAIT_V(6); PG8_BAR;
    } else {
        PG8_STAGE(PG8_SB(0, 0), cB, voffB); PG8_STAGE(PG8_SA(0, 0), cA, voffA); PG8_STAGE(PG8_SB(0, 1), cB + hstep, voffB); PG8_STAGE(PG8_SA(0, 1), cA + hstep, voffA);
        if (wr == 1) PG8_BAR;
        PG8_WAIT_V(4); PG8_BAR;
        PG8_STAGE(PG8_SB(1, 0), cB + kstep, voffB); PG8_STAGE(PG8_SA(1, 0), cA + kstep, voffA); PG8_STAGE(PG8_SB(1, 1), cB + hstep + kstep, voffB);
        PG8_WAIT_V(6); PG8_BAR;
    }
    for (;;) {
        const bool has_next = S.next(ui + 1, nxt);
        const char* nA = has_next ? (const char*)g.A + (size_t)nxt.pm * tstep : cA; const char* nB = has_next ? (const char*)g.Bt + (size_t)nxt.pn * tstep : cB;
        for (int t = 0; t < nt; t += 2) {
            const bool last = (t == nt - 2);
            const char* a1 = cA + (size_t)(t + 1) * kstep;
            const char* a2 = last ? nA : cA + (size_t)(t + 2) * kstep; const char* b2 = last ? nB : cB + (size_t)(t + 2) * kstep;
            const char* a3 = a2 + kstep; const char* b3 = b2 + kstep;
            if (last && has_next) S.a_ready(nxt);
            if constexpr (SP2) {
            PG8_LDB(B0, 0, 0); PG8_LDB(B1, 0, 1); PG8_SCHED; PG8_LDA(At, 0, 0); PG8_STAGE(PG8_SA(1, 1), a1 + hstep, voffA);
            PG8_WAIT_V(8); PG8_WAIT_L(0); PG8_BAR; PG8_MMA(0, 0, At, B0); PG8_MMA(0, 1, At, B1); PG8_BAR; PG8_SCHED;
            PG8_LDA(At, 0, 1); PG8_STAGE(PG8_SB(0, 0), b2, voffB); PG8_STAGE(PG8_SB(0, 1), b2 + hstep, voffB); PG8_STAGE(PG8_SA(0, 0), a2, voffA);
            PG8_WAIT_V(8); PG8_WAIT_L(0); PG8_BAR; PG8_MMA(1, 0, At, B0); PG8_MMA(1, 1, At, B1); PG8_BAR; PG8_SCHED;
            PG8_LDB(B0, 1, 0); PG8_LDB(B1, 1, 1); PG8_SCHED; PG8_LDA(At, 1, 0); PG8_STAGE(PG8_SA(0, 1), a2 + hstep, voffA);
            PG8_WAIT_V(8); PG8_WAIT_L(0); PG8_BAR; PG8_MMA(0, 0, At, B0); PG8_MMA(0, 1, At, B1); PG8_BAR; PG8_SCHED;
            PG8_LDA(At, 1, 1); PG8_STAGE(PG8_SB(1, 0), b3, voffB); PG8_STAGE(PG8_SB(1, 1), b3 + hstep, voffB); PG8_STAGE(PG8_SA(1, 0), a3, voffA);
            PG8_WAIT_V(8); PG8_WAIT_L(0); PG8_BAR; PG8_MMA(1, 0, At, B0); PG8_MMA(1, 1, At, B1); PG8_BAR; PG8_SCHED;
            } else {
            PG8_LDB(B0, 0, 0); PG8_SCHED; PG8_LDA(At, 0, 0); PG8_STAGE(PG8_SA(1, 1), a1 + hstep, voffA);
            PG8_WAIT_L(8); PG8_BAR; PG8_WAIT_L(0); PG8_MMA(0, 0, At, B0); PG8_BAR; PG8_SCHED;
            PG8_LDB(B1, 0, 1); PG8_STAGE(PG8_SB(0, 0), b2, voffB);
            PG8_BAR; PG8_WAIT_L(0); PG8_MMA(0, 1, At, B1); PG8_BAR;
            PG8_LDA(At, 0, 1); PG8_STAGE(PG8_SA(0, 0), a2, voffA);
            PG8_BAR; PG8_WAIT_L(0); PG8_MMA(1, 0, At, B0); PG8_BAR; PG8_SCHED;
            PG8_STAGE(PG8_SB(0, 1), b2 + hstep, voffB);
            PG8_WAIT_V(6); PG8_BAR; PG8_MMA(1, 1, At, B1); PG8_BAR;
            PG8_LDB(B0, 1, 0); PG8_SCHED; PG8_LDA(At, 1, 0); PG8_STAGE(PG8_SA(0, 1), a2 + hstep, voffA);
            PG8_WAIT_L(8); PG8_BAR; PG8_WAIT_L(0); PG8_MMA(0, 0, At, B0); PG8_BAR; PG8_SCHED;
            PG8_LDB(B1, 1, 1); PG8_STAGE(PG8_SB(1, 0), b3, voffB);
            PG8_BAR; PG8_WAIT_L(0); PG8_MMA(0, 1, At, B1); PG8_BAR;
            PG8_LDA(At, 1, 1); PG8_STAGE(PG8_SA(1, 0), a3, voffA);
            PG8_BAR; PG8_WAIT_L(0); PG8_MMA(1, 0, At, B0); PG8_BAR; PG8_SCHED;
            PG8_STAGE(PG8_SB(1, 1), b3 + hstep, voffB);
            PG8_WAIT_V(6); PG8_BAR; PG8_MMA(1, 1, At, B1); PG8_BAR;
            }
        }
        if constexpr (ALIGN_EPI) { if (wr == 0) PG8_BAR; }
        if constexpr (!Epi::AFTER_DRAIN) { E(acc, cur, wr, wc, fr, fq); S.done(cur); }
        if (!has_next) break;
#pragma unroll
        for (int a = 0; a < 2; ++a)
#pragma unroll
            for (int b = 0; b < 2; ++b)
#pragma unroll
                for (int m = 0; m < 4; ++m)
#pragma unroll
                    for (int n = 0; n < 2; ++n) acc[a][b][m][n] = (f32x4){0.f, 0.f, 0.f, 0.f};
        cur = nxt; cA = nA; cB = nB; ++ui;
        if constexpr (ALIGN_EPI) { if (wr == 1) PG8_BAR; }
    }
    PG8_WAIT_V(0);
    if constexpr (!ALIGN_EPI) { if (wr == 0) PG8_BAR; }
    PG8_BAR;
    if constexpr (Epi::AFTER_DRAIN) { E.fused(acc, cur, wr, wc, fr, fq, lds, wid, lane); S.done(cur); }
#undef PG8_SA
#undef PG8_SB
#undef PG8_STAGE
#undef PG8_LDA
#undef PG8_LDB
#undef PG8_MMA
#undef PG8_WAIT_V
#undef PG8_WAIT_L
#undef PG8_BAR
#undef PG8_SCHED
}
}

namespace cg = cooperative_groups;
using pg8::bf16_t; using pg8::bf16x8; using pg8::f32x4; using pg8::u32x4; using pg8::Unit;
__device__ __forceinline__ unsigned cvt_pk_bf16(float lo, float hi) { unsigned r; asm volatile("v_cvt_pk_bf16_f32 %0, %1, %2" : "=v"(r) : "v"(lo), "v"(hi)); return r; }
#define LAS __attribute__((address_space(3)))
typedef unsigned u32x2 __attribute__((ext_vector_type(2)));
typedef float f32x2v __attribute__((ext_vector_type(2)));

constexpr int M_TOK = 8192, DM = 2048, FF = 5632, HW = 1024, CW = 1024, MIXIN = 7168, PLE = 256, SEQ = 2048;
constexpr float EPS = 1e-6f;
constexpr size_t MiB = 1ull << 20;
constexpr size_t WS_W1GU = 0, WS_W1D = 44 * MiB, WS_WIN = 66 * MiB, WS_WOUT = 94 * MiB, WS_W2GU = 102 * MiB, WS_W2D = 146 * MiB,
                 WS_WPG = 168 * MiB, WS_WPE = 176 * MiB, WS_PB = 177 * MiB, WS_XB = 181 * MiB, WS_MIX = 213 * MiB, WS_G = 245 * MiB,
                 WS_QS = 245 * MiB, WS_VH = 261 * MiB, WS_GH = 277 * MiB, WS_BC = 293 * MiB, WS_UC = 309 * MiB, WS_LF = 325 * MiB,
                 WS_S = 357 * MiB, WS_PLE = 245 * MiB, WS_SS = 389 * MiB, WS_DD = 389 * MiB + 512 * 1024, WS_BAR = 390 * MiB + 512 * 1024, WS_END = 391 * MiB, WS_U = 0;
constexpr int LDS_BYTES = 144 * 1024;
constexpr int NPHASE = 12;

__device__ __forceinline__ float bf2f(bf16_t b) { return __uint_as_float(((unsigned)b) << 16); }
__device__ __forceinline__ float bflo(unsigned w) { return __uint_as_float(w << 16); }
__device__ __forceinline__ float bfhi(unsigned w) { return __uint_as_float(w & 0xffff0000u); }
__device__ __forceinline__ float wave_sum(float v) {
#pragma unroll
    for (int o = 1; o < 64; o <<= 1) v += __shfl_xor(v, o);
    return v;
}
__device__ __forceinline__ float fsigmoid(float x) { return __builtin_amdgcn_rcpf(1.0f + __expf(-x)); }
__device__ __forceinline__ float fsilu(float x) { return x * fsigmoid(x); }
__device__ __forceinline__ float rinv_of(float ss) { return rsqrtf(ss * (1.0f / DM) + EPS); }

struct EpiGateUp {
    static constexpr bool PERM = true, AFTER_DRAIN = false;
    bf16_t* G; const float* ss;
    __device__ __forceinline__ void operator()(const f32x4 (&acc)[2][2][4][2], const Unit& u, int wr, int wc, int fr, int fq) const {
        const int row0 = u.pm * 256 + wr * 64 + fr, col0 = u.pn * 128 + wc * 32 + 8 * fq;
#pragma unroll
        for (int ai = 0; ai < 2; ++ai)
#pragma unroll
            for (int m = 0; m < 4; ++m) {
                const int r = row0 + ai * 128 + m * 16; const float ri = rinv_of(ss[r]);
                float v[8];
#pragma unroll
                for (int n = 0; n < 2; ++n)
#pragma unroll
                    for (int j = 0; j < 4; ++j) v[n * 4 + j] = fsilu(acc[ai][0][m][n][j] * ri) * (acc[ai][1][m][n][j] * ri);
                u32x4 w; w.x = cvt_pk_bf16(v[0], v[1]); w.y = cvt_pk_bf16(v[2], v[3]); w.z = cvt_pk_bf16(v[4], v[5]); w.w = cvt_pk_bf16(v[6], v[7]);
                *(u32x4*)(G + (size_t)r * FF + col0) = w;
            }
    }
};
struct EpiResid {
    static constexpr bool PERM = true, AFTER_DRAIN = false;
    const float* R; float* H; bf16_t* XB; float* ss_out; float scale;
    __device__ __forceinline__ void operator()(const f32x4 (&acc)[2][2][4][2], const Unit& u, int wr, int wc, int fr, int fq) const {
        const int row0 = u.pm * 256 + wr * 64 + fr, col0 = u.pn * 256 + wc * 32 + 8 * fq;
#pragma unroll
        for (int ai = 0; ai < 2; ++ai)
#pragma unroll
            for (int m = 0; m < 4; ++m) {
                const int r = row0 + ai * 128 + m * 16; float sq = 0.f;
#pragma unroll
                for (int bj = 0; bj < 2; ++bj) {
                    const size_t off = (size_t)r * DM + col0 + bj * 128;
                    f32x4 v0 = *(const f32x4*)(R + off) + acc[ai][bj][m][0] * scale, v1 = *(const f32x4*)(R + off + 4) + acc[ai][bj][m][1] * scale;
                    *(f32x4*)(H + off) = v0; *(f32x4*)(H + off + 4) = v1;
                    u32x4 w; w.x = cvt_pk_bf16(v0[0], v0[1]); w.y = cvt_pk_bf16(v0[2], v0[3]); w.z = cvt_pk_bf16(v1[0], v1[1]); w.w = cvt_pk_bf16(v1[2], v1[3]);
                    *(u32x4*)(XB + off) = w;
                    sq += (v0[0] * v0[0] + v0[1] * v0[1]) + (v0[2] * v0[2] + v0[3] * v0[3]) + (v1[0] * v1[0] + v1[1] * v1[1]) + (v1[2] * v1[2] + v1[3] * v1[3]);
                }
                sq += __shfl_xor(sq, 16); sq += __shfl_xor(sq, 32);
                if (fq == 0) atomicAdd(ss_out + r, sq);
            }
    }
};
struct EpiMixIn {
    static constexpr bool PERM = true, AFTER_DRAIN = false;
    const float* ss; const float* lbl;
    bf16_t *QS, *UC; float* LF;
    __device__ __forceinline__ void operator()(const f32x4 (&acc)[2][2][4][2], const Unit& u, int wr, int wc, int fr, int fq) const {
        const int row0 = u.pm * 256 + wr * 64 + fr; const int sec = u.pn >> 2;
        if (u.pn >= 20) {
            const int col0 = (u.pn - 20) * 128 + wc * 32 + 8 * fq;
#pragma unroll
            for (int ai = 0; ai < 2; ++ai)
#pragma unroll
                for (int m = 0; m < 4; ++m) {
                    const int r = row0 + ai * 128 + m * 16; const float ri = rinv_of(ss[r]); const float ri2 = ri * ri;
                    float v[8];
#pragma unroll
                    for (int n = 0; n < 2; ++n)
#pragma unroll
                        for (int j = 0; j < 4; ++j) v[n * 4 + j] = acc[ai][0][m][n][j] * acc[ai][1][m][n][j] * ri2;
                    u32x4 w; w.x = cvt_pk_bf16(v[0], v[1]); w.y = cvt_pk_bf16(v[2], v[3]); w.z = cvt_pk_bf16(v[4], v[5]); w.w = cvt_pk_bf16(v[6], v[7]);
                    *(u32x4*)(UC + (size_t)r * CW + col0) = w;
                }
            return;
        }
        const int col0 = (u.pn & 3) * 256 + wc * 32 + 8 * fq;
        if (sec == 1) {
#pragma unroll
            for (int bj = 0; bj < 2; ++bj)
#pragma unroll
                for (int n = 0; n < 2; ++n) {
                    const int c = col0 + bj * 128 + 4 * n; const f32x4 l0 = *(const f32x4*)(lbl + c), l1 = *(const f32x4*)(lbl + 1024 + c);
                    f32x4 lb; lb[0] = fsigmoid(l0[0] - l1[0]); lb[1] = fsigmoid(l0[1] - l1[1]); lb[2] = fsigmoid(l0[2] - l1[2]); lb[3] = fsigmoid(l0[3] - l1[3]);
#pragma unroll
                    for (int ai = 0; ai < 2; ++ai)
#pragma unroll
                        for (int m = 0; m < 4; ++m) {
                            const int r = row0 + ai * 128 + m * 16; const float ri = rinv_of(ss[r]);
                            const f32x4 x = acc[ai][bj][m][n]; f32x4 o;
                            o[0] = __logf(lb[0] + (1.0f - lb[0]) * fsigmoid(x[0] * ri)); o[1] = __logf(lb[1] + (1.0f - lb[1]) * fsigmoid(x[1] * ri));
                            o[2] = __logf(lb[2] + (1.0f - lb[2]) * fsigmoid(x[2] * ri)); o[3] = __logf(lb[3] + (1.0f - lb[3]) * fsigmoid(x[3] * ri));
                            *(f32x4*)(LF + (size_t)r * HW + c) = o;
                        }
                }
            return;
        }
        bf16_t* dst = QS + (size_t)(sec == 0 ? 0 : sec - 1) * ((size_t)M_TOK * HW);
        const bool act = (sec == 0 || sec == 3);
#pragma unroll
        for (int ai = 0; ai < 2; ++ai)
#pragma unroll
            for (int m = 0; m < 4; ++m) {
                const int r = row0 + ai * 128 + m * 16; const float ri = rinv_of(ss[r]);
#pragma unroll
                for (int bj = 0; bj < 2; ++bj) {
                    float v[8];
#pragma unroll
                    for (int n = 0; n < 2; ++n)
#pragma unroll
                        for (int j = 0; j < 4; ++j) { const float x = acc[ai][bj][m][n][j] * ri; v[n * 4 + j] = act ? fsilu(x) : x; }
                    u32x4 w; w.x = cvt_pk_bf16(v[0], v[1]); w.y = cvt_pk_bf16(v[2], v[3]); w.z = cvt_pk_bf16(v[4], v[5]); w.w = cvt_pk_bf16(v[6], v[7]);
                    *(u32x4*)(dst + (size_t)r * HW + col0 + bj * 128) = w;
                }
            }
    }
};
struct EpiStoreBf16 {
    static constexpr bool PERM = true, AFTER_DRAIN = false;
    bf16_t* O;
    __device__ __forceinline__ void operator()(const f32x4 (&acc)[2][2][4][2], const Unit& u, int wr, int wc, int fr, int fq) const {
        const int row0 = u.pm * 256 + wr * 64 + fr, col0 = u.pn * 256 + wc * 32 + 8 * fq;
#pragma unroll
        for (int ai = 0; ai < 2; ++ai)
#pragma unroll
            for (int m = 0; m < 4; ++m) {
                const int r = row0 + ai * 128 + m * 16;
#pragma unroll
                for (int bj = 0; bj < 2; ++bj) {
                    const f32x4 v0 = acc[ai][bj][m][0], v1 = acc[ai][bj][m][1];
                    u32x4 w; w.x = cvt_pk_bf16(v0[0], v0[1]); w.y = cvt_pk_bf16(v0[2], v0[3]); w.z = cvt_pk_bf16(v1[0], v1[1]); w.w = cvt_pk_bf16(v1[2], v1[3]);
                    *(u32x4*)(O + (size_t)r * DM + col0 + bj * 128) = w;
                }
            }
    }
};
struct EpiPleGate {
    static constexpr bool PERM = true, AFTER_DRAIN = false;
    float* H; const bf16_t* P; const float* ss;
    __device__ __forceinline__ void operator()(const f32x4 (&acc)[2][2][4][2], const Unit& u, int wr, int wc, int fr, int fq) const {
        const int row0 = u.pm * 256 + wr * 64 + fr, col0 = u.pn * 256 + wc * 32 + 8 * fq;
#pragma unroll
        for (int ai = 0; ai < 2; ++ai)
#pragma unroll
            for (int m = 0; m < 4; ++m) {
                const int r = row0 + ai * 128 + m * 16; const float ri = rinv_of(ss[r]);
#pragma unroll
                for (int bj = 0; bj < 2; ++bj) {
                    const size_t off = (size_t)r * DM + col0 + bj * 128;
                    const u32x4 pw = *(const u32x4*)(P + off);
                    f32x4 v0 = *(const f32x4*)(H + off), v1 = *(const f32x4*)(H + off + 4);
                    const f32x4 a0 = acc[ai][bj][m][0], a1 = acc[ai][bj][m][1];
                    v0[0] += fsigmoid(a0[0] * ri) * bflo(pw.x); v0[1] += fsigmoid(a0[1] * ri) * bfhi(pw.x);
                    v0[2] += fsigmoid(a0[2] * ri) * bflo(pw.y); v0[3] += fsigmoid(a0[3] * ri) * bfhi(pw.y);
                    v1[0] += fsigmoid(a1[0] * ri) * bflo(pw.z); v1[1] += fsigmoid(a1[1] * ri) * bfhi(pw.z);
                    v1[2] += fsigmoid(a1[2] * ri) * bflo(pw.w); v1[3] += fsigmoid(a1[3] * ri) * bfhi(pw.w);
                    *(f32x4*)(H + off) = v0; *(f32x4*)(H + off + 4) = v1;
                }
            }
    }
};

template <int MODE>
__device__ __forceinline__ void p0_item(const float* W, const float* W2, const float* gain, int K, int N, bf16_t* WT, LAS float* scr, int item, int lane) {
    const int nblk_k = K / 64; const int nb = item / nblk_k, kb = item % nblk_k; const int k0 = 64 * kb, n0 = 32 * nb;
    const float* src = W; int c0 = n0;
    if (MODE == 1) { const int t = n0 >> 8, bj = (n0 >> 7) & 1, c = n0 & 127; src = bj ? W2 : W; c0 = 128 * t + c; }
    if (MODE == 2) { if (n0 >= 5120) { const int tt = n0 - 5120; const int t = tt >> 8, bj = (tt >> 7) & 1, c = tt & 127; c0 = 5120 + 1024 * bj + 128 * t + c; } }
    float v[32], gg[32];
    const float* sp = src + (size_t)(k0 + (lane >> 5)) * N + c0 + (lane & 31);
#pragma unroll
    for (int i = 0; i < 32; ++i) v[i] = sp[(size_t)(2 * i) * N];
    if (gain) {
#pragma unroll
        for (int i = 0; i < 32; ++i) gg[i] = gain[k0 + 2 * i + (lane >> 5)];
#pragma unroll
        for (int i = 0; i < 32; ++i) v[i] *= gg[i];
    }
#pragma unroll
    for (int i = 0; i < 32; ++i) scr[(2 * i + (lane >> 5)) * 33 + (lane & 31)] = v[i];
    asm volatile("s_waitcnt lgkmcnt(0)" ::: "memory");
    const int c = lane & 7;
#pragma unroll
    for (int j = 0; j < 4; ++j) { const int n = (lane >> 3) + 8 * j; const LAS float* s = scr + (8 * c) * 33 + n;
        u32x4 o; o.x = cvt_pk_bf16(s[0 * 33], s[1 * 33]); o.y = cvt_pk_bf16(s[2 * 33], s[3 * 33]); o.z = cvt_pk_bf16(s[4 * 33], s[5 * 33]); o.w = cvt_pk_bf16(s[6 * 33], s[7 * 33]);
        *(u32x4*)(WT + (size_t)(n0 + n) * K + k0 + 8 * c) = o; }
    asm volatile("s_waitcnt lgkmcnt(0)" ::: "memory");
}

struct Args { const float* in[21]; float* out; unsigned char* ws; int ph_lo, ph_hi; };

__device__ __forceinline__ void phase0(const Args& a, LAS unsigned char* lds, int wave, int lane) {
    unsigned char* ws = a.ws;
    LAS float* scr = (LAS float*)(lds + wave * 16384);
    const int gw = blockIdx.x * 8 + wave, NGW = gridDim.x * 8;
    constexpr int I0 = 32 * 352, I1 = 88 * 64, I2 = 32 * 224, I3 = 32 * 64, I7 = 4 * 64;
    constexpr int NIT = 2 * I0 + 2 * I1 + I2 + 2 * I3 + I7;
    for (int it = gw; it < NIT; it += NGW) {
        int r = it;
        if (r < I0) { p0_item<1>(a.in[3], a.in[4], a.in[2], DM, FF, (bf16_t*)(ws + WS_W1GU), scr, r, lane); continue; } r -= I0;
        if (r < I0) { p0_item<1>(a.in[14], a.in[15], a.in[13], DM, FF, (bf16_t*)(ws + WS_W2GU), scr, r, lane); continue; } r -= I0;
        if (r < I1) { p0_item<0>(a.in[5], nullptr, nullptr, FF, DM, (bf16_t*)(ws + WS_W1D), scr, r, lane); continue; } r -= I1;
        if (r < I1) { p0_item<0>(a.in[16], nullptr, nullptr, FF, DM, (bf16_t*)(ws + WS_W2D), scr, r, lane); continue; } r -= I1;
        if (r < I2) { p0_item<2>(a.in[7], nullptr, a.in[6], DM, MIXIN, (bf16_t*)(ws + WS_WIN), scr, r, lane); continue; } r -= I2;
        if (r < I3) { p0_item<0>(a.in[12], nullptr, nullptr, DM, DM, (bf16_t*)(ws + WS_WOUT), scr, r, lane); continue; } r -= I3;
        if (r < I3) { p0_item<0>(a.in[19], nullptr, a.in[17], DM, DM, (bf16_t*)(ws + WS_WPG), scr, r, lane); continue; } r -= I3;
        p0_item<0>(a.in[18], nullptr, nullptr, PLE, DM, (bf16_t*)(ws + WS_WPE), scr, r, lane);
    }
    float* SS = (float*)(ws + WS_SS);
    for (int m = gw; m < M_TOK; m += NGW) {
        const f32x4* xr = (const f32x4*)(a.in[0] + (size_t)m * DM) + lane; u32x2* xb = (u32x2*)((bf16_t*)(ws + WS_XB) + (size_t)m * DM) + lane;
        float s = 0.f;
#pragma unroll
        for (int j = 0; j < 8; ++j) { const f32x4 v = xr[64 * j]; s += (v[0] * v[0] + v[1] * v[1]) + (v[2] * v[2] + v[3] * v[3]);
            u32x2 w; w.x = cvt_pk_bf16(v[0], v[1]); w.y = cvt_pk_bf16(v[2], v[3]); xb[64 * j] = w; }
        s = wave_sum(s);
        if (lane == 0) { SS[m] = s; SS[8192 + m] = 0.f; SS[16384 + m] = 0.f; SS[24576 + m] = 0.f; }
    }
    { const int gt = blockIdx.x * 512 + threadIdx.x, NT = gridDim.x * 512;
      for (int i = gt; i < M_TOK * PLE / 4; i += NT) { const f32x4 v = ((const f32x4*)a.in[1])[i]; u32x2 w; w.x = cvt_pk_bf16(v[0], v[1]); w.y = cvt_pk_bf16(v[2], v[3]); ((u32x2*)(ws + WS_PB))[i] = w; } }
}

constexpr int HP = 136, VP = 72;
constexpr int L_QT = 0, L_QH = L_QT + 64 * HP * 2, L_KA = L_QH + 64 * HP * 2, L_KB = L_KA + 64 * HP * 2, L_ST = L_KB + 32 * HP * 2, L_VT = L_ST + 128 * HP * 2,
              L_P = L_VT + 128 * VP * 2, L_SEG = L_P + 64 * VP * 2, L_PART = L_SEG + 4 * 128 * 4, L_RINV = L_PART + 8 * 64 * 4, L_HEND = L_RINV + 256, L_KT = 0;
static_assert(L_HEND <= LDS_BYTES, "LDS");
#define MFMA16(a, b, c) __builtin_amdgcn_mfma_f32_16x16x32_bf16((a), (b), (c), 0, 0, 0)
__device__ __forceinline__ bf16_t f2bf(float x) { return (bf16_t)(cvt_pk_bf16(x, 0.f) & 0xffffu); }

__device__ __forceinline__ void hgrn_pass_a(const Args& a, LAS unsigned char* lds, int wave, int lane) {
    unsigned char* ws = a.ws;
    const float* LF = (const float*)(ws + WS_LF); const bf16_t* VH = (const bf16_t*)(ws + WS_VH); float* U = (float*)(ws + WS_U); float* Dd = (float*)(ws + WS_DD);
    const int tid = threadIdx.x, k = tid & 127, sg = tid >> 7, fr = lane & 15, fq = lane >> 4;
    LAS bf16_t* VT = (LAS bf16_t*)(lds + L_VT); LAS bf16_t* KT = (LAS bf16_t*)(lds + L_KT); LAS float* SEG = (LAS float*)(lds + L_SEG);
    for (int item = blockIdx.x; item < 1024; item += gridDim.x) {
        const int row0 = (item >> 3) * 64, cb = (item & 7) * 128;
        float lf[16], b[16];
#pragma unroll
        for (int i = 0; i < 16; ++i) lf[i] = LF[(size_t)(row0 + 16 * sg + i) * HW + cb + k];
        u32x4 vv[2];
#pragma unroll
        for (int j = 0; j < 2; ++j) { const int idx = tid + 512 * j; vv[j] = *(const u32x4*)(VH + (size_t)(row0 + (idx >> 4)) * HW + cb + 8 * (idx & 15)); }
        float run = 0.f;
#pragma unroll
        for (int i = 0; i < 16; ++i) { run += lf[i]; b[i] = run; }
        SEG[sg * 128 + k] = run;
        __syncthreads();
        const float s0 = SEG[k], s1 = SEG[128 + k], s2 = SEG[256 + k], s3 = SEG[384 + k];
        const float pre = sg == 0 ? 0.f : (sg == 1 ? s0 : (sg == 2 ? s0 + s1 : s0 + s1 + s2));
        const float blast = s0 + s1 + s2 + s3;
        unsigned pk[8];
#pragma unroll
        for (int i = 0; i < 8; ++i) {
            const float e0 = (1.0f - __expf(lf[2 * i])) * __expf(blast - (pre + b[2 * i])), e1 = (1.0f - __expf(lf[2 * i + 1])) * __expf(blast - (pre + b[2 * i + 1]));
            pk[i] = cvt_pk_bf16(e0, e1); }
        { u32x4 w0, w1; w0.x = pk[0]; w0.y = pk[1]; w0.z = pk[2]; w0.w = pk[3]; w1.x = pk[4]; w1.y = pk[5]; w1.z = pk[6]; w1.w = pk[7];
          *(LAS u32x4*)(KT + k * VP + 16 * sg) = w0; *(LAS u32x4*)(KT + k * VP + 16 * sg + 8) = w1; }
#pragma unroll
        for (int j = 0; j < 2; ++j) { const int idx = tid + 512 * j, s = idx >> 4, v0 = 8 * (idx & 15);
            VT[(v0 + 0) * VP + s] = (bf16_t)(vv[j].x & 0xffffu); VT[(v0 + 1) * VP + s] = (bf16_t)(vv[j].x >> 16);
            VT[(v0 + 2) * VP + s] = (bf16_t)(vv[j].y & 0xffffu); VT[(v0 + 3) * VP + s] = (bf16_t)(vv[j].y >> 16);
            VT[(v0 + 4) * VP + s] = (bf16_t)(vv[j].z & 0xffffu); VT[(v0 + 5) * VP + s] = (bf16_t)(vv[j].z >> 16);
            VT[(v0 + 6) * VP + s] = (bf16_t)(vv[j].w & 0xffffu); VT[(v0 + 7) * VP + s] = (bf16_t)(vv[j].w >> 16); }
        if (sg == 0) Dd[item * 128 + k] = __expf(blast);
        __syncthreads();
        const bf16x8 a0 = *(const LAS bf16x8*)(VT + (16 * wave + fr) * VP + fq * 8), a1 = *(const LAS bf16x8*)(VT + (16 * wave + fr) * VP + 32 + fq * 8);
        float* up = U + (size_t)item * 16384 + (16 * wave + 4 * fq) * 128 + fr;
#pragma unroll
        for (int kt = 0; kt < 8; ++kt) {
            const bf16x8 b0 = *(const LAS bf16x8*)(KT + (16 * kt + fr) * VP + fq * 8), b1 = *(const LAS bf16x8*)(KT + (16 * kt + fr) * VP + 32 + fq * 8);
            f32x4 acc = {0.f, 0.f, 0.f, 0.f};
            acc = MFMA16(a0, b0, acc); acc = MFMA16(a1, b1, acc);
            up[16 * kt] = acc[0]; up[16 * kt + 128] = acc[1]; up[16 * kt + 256] = acc[2]; up[16 * kt + 384] = acc[3];
        }
        __syncthreads();
    }
}

__device__ __forceinline__ void hgrn_scan(const Args& a) {
    unsigned char* ws = a.ws;
    const float* U = (const float*)(ws + WS_U); const float* Dd = (const float*)(ws + WS_DD); bf16_t* SP = (bf16_t*)(ws + WS_S);
    for (int e = (blockIdx.x * 512 + threadIdx.x) * 4; e < 32 * 16384; e += gridDim.x * 512 * 4) {
        const int bh = e >> 14, vk = e & 16383, bb = bh >> 3, h = bh & 7;
        f32x4 S = {0.f, 0.f, 0.f, 0.f};
#pragma unroll 8
        for (int ci = 0; ci < 32; ++ci) {
            const size_t item = (size_t)((bb * 32 + ci) * 8 + h);
            const f32x4 u = *(const f32x4*)(U + item * 16384 + vk); const f32x4 d = *(const f32x4*)(Dd + item * 128 + (vk & 127));
            u32x2 w; w.x = cvt_pk_bf16(S[0], S[1]); w.y = cvt_pk_bf16(S[2], S[3]); *(u32x2*)(SP + item * 16384 + vk) = w;
            S = d * S + u;
        }
    }
}

__device__ __forceinline__ void conv_mixer(const Args& a, int wave, int lane) {
    unsigned char* ws = a.ws;
    const bf16_t* BC = (const bf16_t*)(ws + WS_BC); const bf16_t* UC = (const bf16_t*)(ws + WS_UC); bf16_t* MIX = (bf16_t*)(ws + WS_MIX);
    const float* cn = a.in[11]; const float* cw = a.in[8];
    const int gw = blockIdx.x * 8 + wave, NGW = gridDim.x * 8;
    for (int it = gw; it < M_TOK * 2; it += NGW) {
        const int row = it >> 1, c = (it & 1) * 512 + lane * 8, t = row & (SEQ - 1);
        const size_t off = (size_t)row * CW + c;
        const u32x4 z = {0u, 0u, 0u, 0u};
        const u32x4 u0 = *(const u32x4*)(UC + off), u1 = t >= 1 ? *(const u32x4*)(UC + off - CW) : z, u2 = t >= 2 ? *(const u32x4*)(UC + off - 2 * CW) : z, bg = *(const u32x4*)(BC + off);
        float y[8]; float ssq = 0.f;
#pragma unroll
        for (int q = 0; q < 4; ++q) {
            const unsigned a0 = u0[q], a1 = u1[q], a2 = u2[q], bb = bg[q]; const int cc = c + 2 * q;
            y[2 * q] = bflo(bb) * (cw[cc] * bflo(a2) + cw[CW + cc] * bflo(a1) + cw[2 * CW + cc] * bflo(a0));
            y[2 * q + 1] = bfhi(bb) * (cw[cc + 1] * bfhi(a2) + cw[CW + cc + 1] * bfhi(a1) + cw[2 * CW + cc + 1] * bfhi(a0));
            ssq += y[2 * q] * y[2 * q] + y[2 * q + 1] * y[2 * q + 1];
        }
        ssq += __shfl_xor(ssq, 1); ssq += __shfl_xor(ssq, 2); ssq += __shfl_xor(ssq, 4); ssq += __shfl_xor(ssq, 8);
        const float ri = rsqrtf(ssq * (1.0f / 128) + EPS);
        u32x4 w;
        w.x = cvt_pk_bf16(y[0] * ri * cn[c], y[1] * ri * cn[c + 1]); w.y = cvt_pk_bf16(y[2] * ri * cn[c + 2], y[3] * ri * cn[c + 3]);
        w.z = cvt_pk_bf16(y[4] * ri * cn[c + 4], y[5] * ri * cn[c + 5]); w.w = cvt_pk_bf16(y[6] * ri * cn[c + 6], y[7] * ri * cn[c + 7]);
        *(u32x4*)(MIX + (size_t)row * DM + HW + c) = w;
    }
}

__device__ __forceinline__ void hgrn_pass_c(const Args& a, LAS unsigned char* lds, int wave, int lane) {
    unsigned char* ws = a.ws;
    const float* LF = (const float*)(ws + WS_LF); const bf16_t* VH = (const bf16_t*)(ws + WS_VH); const bf16_t* QS = (const bf16_t*)(ws + WS_QS); const bf16_t* GH = (const bf16_t*)(ws + WS_GH);
    const bf16_t* SP = (const bf16_t*)(ws + WS_S); bf16_t* MIX = (bf16_t*)(ws + WS_MIX); const float* hn = a.in[10];
    const int tid = threadIdx.x, k = tid & 127, sg = tid >> 7, fr = lane & 15, fq = lane >> 4;
    LAS bf16_t* QT = (LAS bf16_t*)(lds + L_QT); LAS bf16_t* QH = (LAS bf16_t*)(lds + L_QH); LAS bf16_t* KA = (LAS bf16_t*)(lds + L_KA); LAS bf16_t* KB = (LAS bf16_t*)(lds + L_KB);
    LAS bf16_t* ST = (LAS bf16_t*)(lds + L_ST); LAS bf16_t* VT = (LAS bf16_t*)(lds + L_VT); LAS bf16_t* P = (LAS bf16_t*)(lds + L_P);
    LAS float* SEG = (LAS float*)(lds + L_SEG); LAS float* PART = (LAS float*)(lds + L_PART); LAS float* RINV = (LAS float*)(lds + L_RINV);
    for (int item = blockIdx.x; item < 1024; item += gridDim.x) {
        const int row0 = (item >> 3) * 64, cb = (item & 7) * 128;
        float lf[16], b[16]; bf16_t qh[16];
#pragma unroll
        for (int i = 0; i < 16; ++i) { lf[i] = LF[(size_t)(row0 + 16 * sg + i) * HW + cb + k]; qh[i] = QS[(size_t)(row0 + 16 * sg + i) * HW + cb + k]; }
        u32x4 vv[2], sv[4];
#pragma unroll
        for (int j = 0; j < 2; ++j) { const int idx = tid + 512 * j; vv[j] = *(const u32x4*)(VH + (size_t)(row0 + (idx >> 4)) * HW + cb + 8 * (idx & 15)); }
#pragma unroll
        for (int j = 0; j < 4; ++j) { const int idx = tid + 512 * j; sv[j] = *(const u32x4*)(SP + (size_t)item * 16384 + (idx >> 4) * 128 + 8 * (idx & 15)); }
        float run = 0.f;
#pragma unroll
        for (int i = 0; i < 16; ++i) { run += lf[i]; b[i] = run; }
        SEG[sg * 128 + k] = run;
        __syncthreads();
        const float s0 = SEG[k], s1 = SEG[128 + k], s2 = SEG[256 + k];
        const float pre = sg == 0 ? 0.f : (sg == 1 ? s0 : (sg == 2 ? s0 + s1 : s0 + s1 + s2));
        const float beta1 = s0 + s1, beta = sg >= 2 ? beta1 : 0.f;
#pragma unroll
        for (int i = 0; i < 16; ++i) {
            const int s = 16 * sg + i; const float bi = pre + b[i], kk = 1.0f - __expf(lf[i]), qv = bf2f(qh[i]);
            QT[s * HP + k] = f2bf(qv * __expf(bi - beta)); QH[s * HP + k] = f2bf(qv * __expf(bi));
            KA[s * HP + k] = f2bf(kk * __expf(fminf(beta - bi, 80.f)));
            if (sg < 2) KB[s * HP + k] = f2bf(kk * __expf(beta1 - bi));
        }
#pragma unroll
        for (int j = 0; j < 2; ++j) { const int idx = tid + 512 * j, s = idx >> 4, v0 = 8 * (idx & 15);
            VT[(v0 + 0) * VP + s] = (bf16_t)(vv[j].x & 0xffffu); VT[(v0 + 1) * VP + s] = (bf16_t)(vv[j].x >> 16);
            VT[(v0 + 2) * VP + s] = (bf16_t)(vv[j].y & 0xffffu); VT[(v0 + 3) * VP + s] = (bf16_t)(vv[j].y >> 16);
            VT[(v0 + 4) * VP + s] = (bf16_t)(vv[j].z & 0xffffu); VT[(v0 + 5) * VP + s] = (bf16_t)(vv[j].z >> 16);
            VT[(v0 + 6) * VP + s] = (bf16_t)(vv[j].w & 0xffffu); VT[(v0 + 7) * VP + s] = (bf16_t)(vv[j].w >> 16); }
#pragma unroll
        for (int j = 0; j < 4; ++j) { const int idx = tid + 512 * j; *(LAS u32x4*)(ST + (idx >> 4) * HP + 8 * (idx & 15)) = sv[j]; }
        __syncthreads();
#pragma unroll
        for (int pp = 0; pp < 2; ++pp) {
            const int p = wave + 8 * pp, tt = p >> 2, st = p & 3;
            f32x4 acc = {0.f, 0.f, 0.f, 0.f};
            if (st <= tt) {
                const LAS bf16_t* kb = (tt >= 2 && st < 2) ? KB : KA;
#pragma unroll
                for (int ks = 0; ks < 4; ++ks) { const bf16x8 af = *(const LAS bf16x8*)(QT + (16 * tt + fr) * HP + ks * 32 + fq * 8), bfr = *(const LAS bf16x8*)(kb + (16 * st + fr) * HP + ks * 32 + fq * 8);
                    acc = MFMA16(af, bfr, acc); }
            }
#pragma unroll
            for (int r = 0; r < 4; ++r) { const bool keep = (st < tt) || (st == tt && fr <= 4 * fq + r); P[(16 * tt + 4 * fq + r) * VP + 16 * st + fr] = f2bf(keep ? acc[r] : 0.f); }
        }
        __syncthreads();
        bf16x8 bs[4], bv[2];
#pragma unroll
        for (int ks = 0; ks < 4; ++ks) bs[ks] = *(const LAS bf16x8*)(ST + (16 * wave + fr) * HP + ks * 32 + fq * 8);
#pragma unroll
        for (int ks = 0; ks < 2; ++ks) bv[ks] = *(const LAS bf16x8*)(VT + (16 * wave + fr) * VP + ks * 32 + fq * 8);
        f32x4 o[4];
#pragma unroll
        for (int tt = 0; tt < 4; ++tt) {
            f32x4 acc = {0.f, 0.f, 0.f, 0.f};
#pragma unroll
            for (int ks = 0; ks < 4; ++ks) { const bf16x8 af = *(const LAS bf16x8*)(QH + (16 * tt + fr) * HP + ks * 32 + fq * 8); acc = MFMA16(af, bs[ks], acc); }
            { const bf16x8 af = *(const LAS bf16x8*)(P + (16 * tt + fr) * VP + fq * 8); acc = MFMA16(af, bv[0], acc); }
            if (tt >= 2) { const bf16x8 af = *(const LAS bf16x8*)(P + (16 * tt + fr) * VP + 32 + fq * 8); acc = MFMA16(af, bv[1], acc); }
            o[tt] = acc;
        }
#pragma unroll
        for (int tt = 0; tt < 4; ++tt)
#pragma unroll
            for (int r = 0; r < 4; ++r) { float x = o[tt][r] * o[tt][r]; x += __shfl_xor(x, 1); x += __shfl_xor(x, 2); x += __shfl_xor(x, 4); x += __shfl_xor(x, 8);
                if (fr == 0) PART[wave * 64 + 16 * tt + 4 * fq + r] = x; }
        __syncthreads();
        if (tid < 64) { float s = 0.f;
#pragma unroll
            for (int w = 0; w < 8; ++w) s += PART[w * 64 + tid];
            RINV[tid] = rsqrtf(s * (1.0f / 128) + EPS); }
        __syncthreads();
        const float hnv = hn[16 * wave + fr];
#pragma unroll
        for (int tt = 0; tt < 4; ++tt)
#pragma unroll
            for (int r = 0; r < 4; ++r) { const int t = 16 * tt + 4 * fq + r; const size_t row = (size_t)(row0 + t);
                const float g = bf2f(GH[row * HW + cb + 16 * wave + fr]);
                MIX[row * DM + cb + 16 * wave + fr] = f2bf(o[tt][r] * RINV[t] * hnv * g); }
        __syncthreads();
    }
}

__device__ __forceinline__ void phase_final(const Args& a, int wave, int lane) {
    const int gw = blockIdx.x * 8 + wave, NGW = gridDim.x * 8; const float* gF = a.in[20];
    for (int m = gw; m < M_TOK; m += NGW) {
        f32x4* xr = (f32x4*)(a.out + (size_t)m * DM) + lane; f32x4 v[8]; float s = 0.f;
#pragma unroll
        for (int j = 0; j < 8; ++j) { v[j] = xr[64 * j]; s += (v[j][0] * v[j][0] + v[j][1] * v[j][1]) + (v[j][2] * v[j][2] + v[j][3] * v[j][3]); }
        const float ri = rinv_of(wave_sum(s));
#pragma unroll
        for (int j = 0; j < 8; ++j) { const f32x4 g = ((const f32x4*)gF)[64 * j + lane]; xr[64 * j] = v[j] * ri * g; }
    }
}

#define XB_TMO      128
#define XB_XCNT(j)  (256  + 64 * (j))
#define XB_XSUB(j)  (1280 + 64 * (j))
#define XB_XGEN(j)  (2304 + 64 * (j))
#define XB_TOP      3328
#define XB_TOPGEN   3392
#define XCD_BAR_WORDS 3456
#define XB_SPIN_CAP (1u << 18)

__device__ __forceinline__ unsigned xb_ld(unsigned* p)              { return __hip_atomic_load(p, __ATOMIC_RELAXED, __HIP_MEMORY_SCOPE_AGENT); }
__device__ __forceinline__ unsigned xb_add(unsigned* p, unsigned v) { return __hip_atomic_fetch_add(p, v, __ATOMIC_RELAXED, __HIP_MEMORY_SCOPE_AGENT); }
__device__ __forceinline__ unsigned xb_xcc_id() { return (unsigned)__builtin_amdgcn_s_getreg((3 << 11) | 20) & 0xFu; }
#define XB_SPIN(cond, bar) do { unsigned _sp = 0; while (cond) { __builtin_amdgcn_s_sleep(1); \
    if ((++_sp & 255u) == 0u) { if (xb_ld(&(bar)[XB_TMO])) break; if (_sp > XB_SPIN_CAP) { atomicAdd(&(bar)[XB_TMO], 1u); break; } } } } while (0)

struct XcdBarrier {
    unsigned* bar; unsigned x;
    volatile LAS unsigned* st;
};

__device__ __forceinline__ XcdBarrier xcd_barrier_post(unsigned* bar, volatile LAS unsigned* st) {
    XcdBarrier b; b.bar = bar; b.x = xb_xcc_id(); b.st = st;
    if (threadIdx.x == 0) (void)xb_add(&bar[XB_XCNT(b.x)], 1u);
    return b;
}
__device__ __forceinline__ void xcd_barrier_complete(unsigned* bar, unsigned x, unsigned& nloc, unsigned& nx) {
    const unsigned G = gridDim.x * gridDim.y * gridDim.z;
    unsigned sum, cnt, mine, sp = 0u;
    for (;;) {
        sum = 0u; cnt = 0u; mine = 0u;
#pragma unroll
        for (unsigned j = 0; j < 16; ++j) { const unsigned c = xb_ld(&bar[XB_XCNT(j)]); sum += c; cnt += (c > 0u) ? 1u : 0u; mine = (j == x) ? c : mine; }
        if (sum == G) break;
        __builtin_amdgcn_s_sleep(1);
        if ((++sp & 255u) == 0u) { if (xb_ld(&bar[XB_TMO])) break; if (sp > XB_SPIN_CAP) { atomicAdd(&bar[XB_TMO], 1u); break; } }
    }
    nloc = mine > 0u ? mine : 1u; nx = cnt > 0u ? cnt : 1u;
}

__device__ __forceinline__ void xcd_barrier(const XcdBarrier& b) {
    asm volatile("s_waitcnt vmcnt(0)" ::: "memory");
    __syncthreads();
    if (threadIdx.x == 0) {
        unsigned* bar = b.bar;
        __builtin_amdgcn_s_waitcnt(0);
        unsigned nloc = b.st[0], nx = b.st[1];
        if (nloc == 0u) { xcd_barrier_complete(bar, b.x, nloc, nx); b.st[0] = nloc; b.st[1] = nx; }
        const unsigned old = xb_add(&bar[XB_XSUB(b.x)], 1u);
        const unsigned gen = old / nloc;
        if (old + 1u == (gen + 1u) * nloc) {
            __builtin_amdgcn_fence(__ATOMIC_RELEASE, "agent");
            asm volatile("s_waitcnt vmcnt(0)" ::: "memory");
            const unsigned og = xb_add(&bar[XB_TOP], 1u);
            const unsigned tg = og / nx;
            if (og + 1u == (tg + 1u) * nx) xb_add(&bar[XB_TOPGEN], 1u);
            else XB_SPIN(xb_ld(&bar[XB_TOPGEN]) == tg, bar);
            __builtin_amdgcn_fence(__ATOMIC_ACQUIRE, "agent");
            xb_add(&bar[XB_XGEN(b.x)], 1u);
            asm volatile("s_waitcnt vmcnt(0)" ::: "memory");
        } else {
            XB_SPIN(xb_ld(&bar[XB_XGEN(b.x)]) == gen, bar);
            __builtin_amdgcn_fence(__ATOMIC_ACQUIRE, "agent");
            asm volatile("s_waitcnt vmcnt(0)" ::: "memory");
        }
    }
    __syncthreads();
}


template <class Epi>
__device__ __forceinline__ void run_gemm(LAS unsigned char* lds, const bf16_t* A, const bf16_t* Bt, int N, int K, const Epi& E) {
    pg8::Gemm g; g.A = A; g.Bt = Bt; g.M = M_TOK; g.N = N; g.K = K;
    pg8::StaticOrder S; S.init(M_TOK, N, (int)gridDim.x, (int)blockIdx.x);
    pg8::gemm_phase<Epi, pg8::StaticOrder, true, true>(lds, g, S, E);
}

__global__ void __launch_bounds__(512, 2) fwd_kernel(Args a) {
    extern __shared__ __attribute__((aligned(16))) unsigned char lds_raw[];
    LAS unsigned char* lds = (LAS unsigned char*)lds_raw;
    cg::grid_group grid = cg::this_grid();
    volatile LAS unsigned* xst = (volatile LAS unsigned*)(lds + LDS_BYTES - 16);
    if (threadIdx.x < 4) xst[threadIdx.x] = 0u;
    __syncthreads();
    XcdBarrier xbar = xcd_barrier_post((unsigned*)(a.ws + WS_BAR), xst);
    const int tid = threadIdx.x, lane = tid & 63, wave = __builtin_amdgcn_readfirstlane(tid >> 6);
    unsigned char* ws = a.ws;
    float* SS = (float*)(ws + WS_SS);
    bf16_t* XB = (bf16_t*)(ws + WS_XB); bf16_t* G = (bf16_t*)(ws + WS_G); bf16_t* MIX = (bf16_t*)(ws + WS_MIX);
#define PH(i) if (a.ph_lo <= (i) && (i) < a.ph_hi)
#define SYNC(i) if (a.ph_lo <= (i) && (i) + 1 < a.ph_hi) { if ((i) == 0) grid.sync(); else xcd_barrier(xbar); }
    PH(0) { phase0(a, lds, wave, lane); } SYNC(0)
    PH(1) { EpiGateUp E; E.G = G; E.ss = SS; run_gemm(lds, XB, (const bf16_t*)(ws + WS_W1GU), 2 * FF, DM, E); } SYNC(1)
    PH(2) { EpiResid E; E.R = a.in[0]; E.H = a.out; E.XB = XB; E.ss_out = SS + 8192; E.scale = 0.5f; run_gemm(lds, G, (const bf16_t*)(ws + WS_W1D), DM, FF, E); } SYNC(2)
    PH(3) { EpiMixIn E; E.ss = SS + 8192; E.lbl = a.in[9]; E.QS = (bf16_t*)(ws + WS_QS);
            E.UC = (bf16_t*)(ws + WS_UC); E.LF = (float*)(ws + WS_LF); run_gemm(lds, XB, (const bf16_t*)(ws + WS_WIN), MIXIN, DM, E); } SYNC(3)
    PH(4) { hgrn_pass_a(a, lds, wave, lane); } SYNC(4)
    PH(5) { hgrn_scan(a); conv_mixer(a, wave, lane); } SYNC(5)
    PH(6) { hgrn_pass_c(a, lds, wave, lane); } SYNC(6)
    PH(7) { EpiResid E; E.R = a.out; E.H = a.out; E.XB = XB; E.ss_out = SS + 16384; E.scale = 1.0f; run_gemm(lds, MIX, (const bf16_t*)(ws + WS_WOUT), DM, DM, E); } SYNC(7)
    PH(8) { EpiGateUp E; E.G = G; E.ss = SS + 16384; run_gemm(lds, XB, (const bf16_t*)(ws + WS_W2GU), 2 * FF, DM, E); } SYNC(8)
    PH(9) { EpiResid E; E.R = a.out; E.H = a.out; E.XB = XB; E.ss_out = SS + 24576; E.scale = 0.5f; run_gemm(lds, G, (const bf16_t*)(ws + WS_W2D), DM, FF, E); } SYNC(9)
    PH(10) { { EpiStoreBf16 E; E.O = (bf16_t*)(ws + WS_PLE); int kp = PLE; asm volatile("" : "+s"(kp)); run_gemm(lds, (const bf16_t*)(ws + WS_PB), (const bf16_t*)(ws + WS_WPE), DM, kp, E); }
             { EpiPleGate E; E.H = a.out; E.P = (const bf16_t*)(ws + WS_PLE); E.ss = SS + 24576; run_gemm(lds, XB, (const bf16_t*)(ws + WS_WPG), DM, DM, E); } } SYNC(10)
    PH(11) { phase_final(a, wave, lane); }
#undef PH
#undef SYNC
}

#ifndef MK_MULTI
#define MK_MULTI 0
#endif
extern "C" void kernel_launch(void* const* d_in, const int* in_sizes, int n_in, void* d_out, int out_size, void* d_ws, size_t ws_size, hipStream_t stream) {
    static int grid = 0;
    if (grid == 0) {
        if (n_in != 21 || out_size != M_TOK * DM || ws_size < WS_END) { fprintf(stderr, "kernel_launch: unexpected shapes (n_in %d out %d ws %zu need %zu)\n", n_in, out_size, ws_size, (size_t)WS_END); grid = -1; return; }
        int dev = 0, cus = 0, per_cu = 0;
        hipGetDevice(&dev); hipDeviceGetAttribute(&cus, hipDeviceAttributeMultiprocessorCount, dev);
        if (hipFuncSetAttribute((const void*)fwd_kernel, hipFuncAttributeMaxDynamicSharedMemorySize, LDS_BYTES) != hipSuccess) { fprintf(stderr, "kernel_launch: hipFuncSetAttribute failed\n"); grid = -1; return; }
        if (hipOccupancyMaxActiveBlocksPerMultiprocessor(&per_cu, (const void*)fwd_kernel, 512, LDS_BYTES) != hipSuccess || per_cu < 1) { fprintf(stderr, "kernel_launch: occupancy query failed (%d)\n", per_cu); grid = -1; return; }
        grid = cus * per_cu;
    }
    if (grid < 0) return;
    Args a{};
    for (int i = 0; i < 21; ++i) a.in[i] = (const float*)d_in[i];
    a.out = (float*)d_out; a.ws = (unsigned char*)d_ws;
#if MK_MULTI
    for (int p = 0; p < NPHASE; ++p) { a.ph_lo = p; a.ph_hi = p + 1; hipLaunchKernelGGL(fwd_kernel, dim3(grid), dim3(512), LDS_BYTES, stream, a); }
#else
    a.ph_lo = 0; a.ph_hi = NPHASE;
    if (hipMemsetAsync((char*)d_ws + WS_BAR, 0, XCD_BAR_WORDS * 4, stream) != hipSuccess) { fprintf(stderr, "kernel_launch: memset failed\n"); return; }
    void* args[] = {&a};
    hipError_t e = hipLaunchCooperativeKernel((void*)fwd_kernel, dim3(grid), dim3(512), args, LDS_BYTES, stream);
    if (e != hipSuccess) fprintf(stderr, "cooperative launch failed: %s (grid %d)\n", hipGetErrorString(e), grid);
#endif
}
```

```cpp
#include <hip/hip_runtime.h>
#include <hip/hip_cooperative_groups.h>
#include <cstdio>
#include <cstdint>
namespace pg8 {
#define PG8_LAS __attribute__((address_space(3)))
typedef unsigned short bf16_t;
typedef short bf16x8 __attribute__((ext_vector_type(8)));
typedef float f32x4 __attribute__((ext_vector_type(4)));
typedef unsigned u32x4 __attribute__((ext_vector_type(4)));
constexpr int BM = 256, BK = 64, HALF = 128, HTB = HALF * BK * 2  , STAGE_BYTES = 8 * HTB, NXCD = 8, WGM = 8;

__host__ __device__ __forceinline__ int lds_byte(int r, int c) { const int st = (r >> 4) * 2 + (c >> 5), rr = r & 15, cc = c & 31, ob = rr * 64 + cc * 2; return st * 1024 + (ob ^ (((ob >> 9) & 1) << 5)); }
__host__ __device__ __forceinline__ void stage_rc(int b, int& R, int& C) { const int st = b / 1024, sb = b % 1024, swz = sb ^ (((sb >> 9) & 1) << 5); R = (st >> 1) * 16 + swz / 64; C = (st & 1) * 32 + (swz % 64) / 2; }
__host__ __device__ __forceinline__ int perm32(int rho) { const int n = rho >> 4, i = rho & 15; return 8 * (i >> 2) + 4 * n + (i & 3); }

struct Unit { int pm, pn; };
struct Gemm { const bf16_t* A; const bf16_t* Bt; int M, N, K; };

struct StaticOrder {
    int nM, nN, nwg, G, c;
    __host__ __device__ void init(int M, int N, int G_, int c_) { nM = M / BM; nN = N / BM; nwg = nM * nN; G = G_; c = c_; }
    __host__ __device__ bool next(int i, Unit& u) const {
        const long L = (long)i * G + c; if (L >= nwg) return false;
        int wgid = (int)L; { const int q = nwg / NXCD, r = nwg % NXCD, xcd = wgid % NXCD, off = wgid / NXCD; wgid = (xcd < r ? xcd * (q + 1) : r * (q + 1) + (xcd - r) * q) + off; }
        const int nig = WGM * nN, gid = wgid / nig, fm = gid * WGM, gsz = (nM - fm) < WGM ? (nM - fm) : WGM;
        u.pm = fm + ((wgid % nig) % gsz); u.pn = (wgid % nig) / gsz; return true;
    }
    __device__ __forceinline__ void a_ready(const Unit&) const {}
    __device__ __forceinline__ void done(const Unit&) const {}
};
typedef float f32x2 __attribute__((ext_vector_type(2)));
template <class Epi, class Sched, bool ALIGN_EPI = false, bool SP2 = false>
__device__ __forceinline__ void gemm_phase(PG8_LAS unsigned char* lds, const Gemm g, const Sched& S, const Epi& E) {
    const int tid = threadIdx.x, wid = __builtin_amdgcn_readfirstlane(tid >> 6), lane = tid & 63, wr = wid >> 2, wc = wid & 3, fr = lane & 15, fq = lane >> 4;
    const int K = g.K, nt = K / BK;
    unsigned voffA[2], voffB[2];
#pragma unroll
    for (int i = 0; i < 2; ++i) { int R, C; stage_rc(tid * 16 + i * 8192, R, C); const int Rb = Epi::PERM ? ((R & ~31) + perm32(R & 31)) : R;
        voffA[i] = (unsigned)(R * K + C) * 2u; voffB[i] = (unsigned)(Rb * K + C) * 2u; }
    const size_t kstep = (size_t)(BK * 2);
    const size_t hstep = (size_t)HALF * K * 2;
    const size_t tstep = 2 * hstep;
    const unsigned ldsw = (unsigned)wid * 1024u;
    const int aoff = lds_byte(wr * 64 + fr, fq * 8), boff = lds_byte(wc * 32 + fr, fq * 8);
#define PG8_SA(b, h) (((b) * 2 + (h)) * HTB)
#define PG8_SB(b, h) ((4 + (b) * 2 + (h)) * HTB)
#define PG8_STAGE(bufoff, gbase, voff) do { _Pragma("unroll") for (int _i = 0; _i < 2; ++_i) \
        __builtin_amdgcn_global_load_lds((const unsigned*)((const char*)(gbase) + (voff)[_i]), (PG8_LAS unsigned*)(lds + (bufoff) + ldsw + _i * 8192), 16, 0, 0); } while (0)
#define PG8_LDA(dst, b, h) do { _Pragma("unroll") for (int m = 0; m < 4; ++m) _Pragma("unroll") for (int k = 0; k < 2; ++k) dst[m][k] = *(const PG8_LAS bf16x8*)(lds + PG8_SA(b, h) + aoff + m * 2048 + k * 1024); } while (0)
#define PG8_LDB(dst, b, h) do { _Pragma("unroll") for (int n = 0; n < 2; ++n) _Pragma("unroll") for (int k = 0; k < 2; ++k) dst[n][k] = *(const PG8_LAS bf16x8*)(lds + PG8_SB(b, h) + boff + n * 2048 + k * 1024); } while (0)
#define PG8_MMA(ai, bj, At, Bt) do { __builtin_amdgcn_s_setprio(1); _Pragma("unroll") for (int m = 0; m < 4; ++m) _Pragma("unroll") for (int n = 0; n < 2; ++n) _Pragma("unroll") for (int k = 0; k < 2; ++k) \
        acc[ai][bj][m][n] = __builtin_amdgcn_mfma_f32_16x16x32_bf16(Bt[n][k], At[m][k], acc[ai][bj][m][n], 0, 0, 0); __builtin_amdgcn_s_setprio(0); } while (0)
#define PG8_WAIT_V(n) asm volatile("s_waitcnt vmcnt(" #n ")" ::: "memory")
#define PG8_WAIT_L(n) asm volatile("s_waitcnt lgkmcnt(" #n ")" ::: "memory")
#define PG8_BAR __builtin_amdgcn_s_barrier()
#define PG8_SCHED __builtin_amdgcn_sched_barrier(0)
    Unit cur, nxt; int ui = 0;
    if (!S.next(0, cur)) return;
    f32x4 acc[2][2][4][2];
#pragma unroll
    for (int a = 0; a < 2; ++a)
#pragma unroll
        for (int b = 0; b < 2; ++b)
#pragma unroll
            for (int m = 0; m < 4; ++m)
#pragma unroll
                for (int n = 0; n < 2; ++n) acc[a][b][m][n] = (f32x4){0.f, 0.f, 0.f, 0.f};
    bf16x8 At[4][2], B0[2][2], B1[2][2];
    const char* cA = (const char*)g.A + (size_t)cur.pm * tstep; const char* cB = (const char*)g.Bt + (size_t)cur.pn * tstep;
    S.a_ready(cur);
    if constexpr (SP2) {
        PG8_STAGE(PG8_SB(0, 0), cB, voffB); PG8_STAGE(PG8_SB(0, 1), cB + hstep, voffB); PG8_STAGE(PG8_SA(0, 0), cA, voffA); PG8_STAGE(PG8_SA(0, 1), cA + hstep, voffA);
        if (wr == 1) PG8_BAR;
        PG8_WAIT_V(2); PG8_BAR;
        PG8_STAGE(PG8_SB(1, 0), cB + kstep, voffB); PG8_STAGE(PG8_SA(1, 0), cA + kstep, voffA); PG8_STAGE(PG8_SB(1, 1), cB + hstep + kstep, voffB);
        PG8_WAIT_V(6); PG8_BAR;
    } else {
        PG8_STAGE(PG8_SB(0, 0), cB, voffB); PG8_STAGE(PG8_SA(0, 0), cA, voffA); PG8_STAGE(PG8_SB(0, 1), cB + hstep, voffB); PG8_STAGE(PG8_SA(0, 1), cA + hstep, voffA);
        if (wr == 1) PG8_BAR;
        PG8_WAIT_V(4); PG8_BAR;
        PG8_STAGE(PG8_SB(1, 0), cB + kstep, voffB); PG8_STAGE(PG8_SA(1, 0), cA + kstep, voffA); PG8_STAGE(PG8_SB(1, 1), cB + hstep + kstep, voffB);
        PG8_WAIT_V(6); PG8_BAR;
    }
    for (;;) {
        const bool has_next = S.next(ui + 1, nxt);
        const char* nA = has_next ? (const char*)g.A + (size_t)nxt.pm * tstep : cA; const char* nB = has_next ? (const char*)g.Bt + (size_t)nxt.pn * tstep : cB;
        for (int t = 0; t < nt; t += 2) {
            const bool last = (t == nt - 2);
            const char* a1 = cA + (size_t)(t + 1) * kstep;
            const char* a2 = last ? nA : cA + (size_t)(t + 2) * kstep; const char* b2 = last ? nB : cB + (size_t)(t + 2) * kstep;
            const char* a3 = a2 + kstep; const char* b3 = b2 + kstep;
            if (last && has_next) S.a_ready(nxt);
            if constexpr (SP2) {
            PG8_LDB(B0, 0, 0); PG8_LDB(B1, 0, 1); PG8_SCHED; PG8_LDA(At, 0, 0); PG8_STAGE(PG8_SA(1, 1), a1 + hstep, voffA);
            PG8_WAIT_V(8); PG8_WAIT_L(0); PG8_BAR; PG8_MMA(0, 0, At, B0); PG8_MMA(0, 1, At, B1); PG8_BAR; PG8_SCHED;
            PG8_LDA(At, 0, 1); PG8_STAGE(PG8_SB(0, 0), b2, voffB); PG8_STAGE(PG8_SB(0, 1), b2 + hstep, voffB); PG8_STAGE(PG8_SA(0, 0), a2, voffA);
            PG8_WAIT_V(8); PG8_WAIT_L(0); PG8_BAR; PG8_MMA(1, 0, At, B0); PG8_MMA(1, 1, At, B1); PG8_BAR; PG8_SCHED;
            PG8_LDB(B0, 1, 0); PG8_LDB(B1, 1, 1); PG8_SCHED; PG8_LDA(At, 1, 0); PG8_STAGE(PG8_SA(0, 1), a2 + hstep, voffA);
            PG8_WAIT_V(8); PG8_WAIT_L(0); PG8_BAR; PG8_MMA(0, 0, At, B0); PG8_MMA(0, 1, At, B1); PG8_BAR; PG8_SCHED;
            PG8_LDA(At, 1, 1); PG8_STAGE(PG8_SB(1, 0), b3, voffB); PG8_STAGE(PG8_SB(1, 1), b3 + hstep, voffB); PG8_STAGE(PG8_SA(1, 0), a3, voffA);
            PG8_WAIT_V(8); PG8_WAIT_L(0); PG8_BAR; PG8_MMA(1, 0, At, B0); PG8_MMA(1, 1, At, B1); PG8_BAR; PG8_SCHED;
            } else {
            PG8_LDB(B0, 0, 0); PG8_SCHED; PG8_LDA(At, 0, 0); PG8_STAGE(PG8_SA(1, 1), a1 + hstep, voffA);
            PG8_WAIT_L(8); PG8_BAR; PG8_WAIT_L(0); PG8_MMA(0, 0, At, B0); PG8_BAR; PG8_SCHED;
            PG8_LDB(B1, 0, 1); PG8_STAGE(PG8_SB(0, 0), b2, voffB);
            PG8_BAR; PG8_WAIT_L(0); PG8_MMA(0, 1, At, B1); PG8_BAR;
            PG8_LDA(At, 0, 1); PG8_STAGE(PG8_SA(0, 0), a2, voffA);
            PG8_BAR; PG8_WAIT_L(0); PG8_MMA(1, 0, At, B0); PG8_BAR; PG8_SCHED;
            PG8_STAGE(PG8_SB(0, 1), b2 + hstep, voffB);
            PG8_WAIT_V(6); PG8_BAR; PG8_MMA(1, 1, At, B1); PG8_BAR;
            PG8_LDB(B0, 1, 0); PG8_SCHED; PG8_LDA(At, 1, 0); PG8_STAGE(PG8_SA(0, 1), a2 + hstep, voffA);
            PG8_WAIT_L(8); PG8_BAR; PG8_WAIT_L(0); PG8_MMA(0, 0, At, B0); PG8_BAR; PG8_SCHED;
            PG8_LDB(B1, 1, 1); PG8_STAGE(PG8_SB(1, 0), b3, voffB);
            PG8_BAR; PG8_WAIT_L(0); PG8_MMA(0, 1, At, B1); PG8_BAR;
            PG8_LDA(At, 1, 1); PG8_STAGE(PG8_SA(1, 0), a3, voffA);
            PG8_BAR; PG8_WAIT_L(0); PG8_MMA(1, 0, At, B0); PG8_BAR; PG8_SCHED;
            PG8_STAGE(PG8_SB(1, 1), b3 + hstep, voffB);
            PG8_WAIT_V(6); PG8_BAR; PG8_MMA(1, 1, At, B1); PG8_BAR;
            }
        }
        if constexpr (ALIGN_EPI) { if (wr == 0) PG8_BAR; }
        if constexpr (!Epi::AFTER_DRAIN) { E(acc, cur, wr, wc, fr, fq); S.done(cur); }
        if (!has_next) break;
#pragma unroll
        for (int a = 0; a < 2; ++a)
#pragma unroll
            for (int b = 0; b < 2; ++b)
#pragma unroll
                for (int m = 0; m < 4; ++m)
#pragma unroll
                    for (int n = 0; n < 2; ++n) acc[a][b][m][n] = (f32x4){0.f, 0.f, 0.f, 0.f};
        cur = nxt; cA = nA; cB = nB; ++ui;
        if constexpr (ALIGN_EPI) { if (wr == 1) PG8_BAR; }
    }
    PG8_WAIT_V(0);
    if constexpr (!ALIGN_EPI) { if (wr == 0) PG8_BAR; }
    PG8_BAR;
    if constexpr (Epi::AFTER_DRAIN) { E.fused(acc, cur, wr, wc, fr, fq, lds, wid, lane); S.done(cur); }
#undef PG8_SA
#undef PG8_SB
#undef PG8_STAGE
#undef PG8_LDA
#undef PG8_LDB
#undef PG8_MMA
#undef PG8_WAIT_V
#undef PG8_WAIT_L
#undef PG8_BAR
#undef PG8_SCHED
}
}

namespace cg = cooperative_groups;
using pg8::bf16_t; using pg8::bf16x8; using pg8::f32x4; using pg8::u32x4; using pg8::Unit;
__device__ __forceinline__ unsigned cvt_pk_bf16(float lo, float hi) { unsigned r; asm volatile("v_cvt_pk_bf16_f32 %0, %1, %2" : "=v"(r) : "v"(lo), "v"(hi)); return r; }
#define LAS __attribute__((address_space(3)))
typedef unsigned u32x2 __attribute__((ext_vector_type(2)));
typedef float f32x2v __attribute__((ext_vector_type(2)));

constexpr int M_TOK = 8192, DM = 2048, FF = 5632, HW = 1024, CW = 1024, MIXIN = 7168, PLE = 256, SEQ = 2048;
constexpr float EPS = 1e-6f;
constexpr size_t MiB = 1ull << 20;
constexpr size_t WS_W1GU = 0, WS_W1D = 44 * MiB, WS_WIN = 66 * MiB, WS_WOUT = 94 * MiB, WS_W2GU = 102 * MiB, WS_W2D = 146 * MiB,
                 WS_WPG = 168 * MiB, WS_WPE = 176 * MiB, WS_PB = 177 * MiB, WS_XB = 181 * MiB, WS_MIX = 213 * MiB, WS_G = 245 * MiB,
                 WS_QS = 245 * MiB, WS_VH = 261 * MiB, WS_GH = 277 * MiB, WS_BC = 293 * MiB, WS_UC = 309 * MiB, WS_LF = 325 * MiB,
                 WS_S = 357 * MiB, WS_PLE = 245 * MiB, WS_SS = 389 * MiB, WS_DD = 389 * MiB + 512 * 1024, WS_BAR = 390 * MiB + 512 * 1024, WS_END = 391 * MiB, WS_U = 0;
constexpr int LDS_BYTES = 144 * 1024;
constexpr int NPHASE = 12;

__device__ __forceinline__ float bf2f(bf16_t b) { return __uint_as_float(((unsigned)b) << 16); }
__device__ __forceinline__ float bflo(unsigned w) { return __uint_as_float(w << 16); }
__device__ __forceinline__ float bfhi(unsigned w) { return __uint_as_float(w & 0xffff0000u); }
__device__ __forceinline__ float wave_sum(float v) {
#pragma unroll
    for (int o = 1; o < 64; o <<= 1) v += __shfl_xor(v, o);
    return v;
}
__device__ __forceinline__ float fsigmoid(float x) { return __builtin_amdgcn_rcpf(1.0f + __expf(-x)); }
__device__ __forceinline__ float fsilu(float x) { return x * fsigmoid(x); }
__device__ __forceinline__ float rinv_of(float ss) { return rsqrtf(ss * (1.0f / DM) + EPS); }

struct EpiGateUp {
    static constexpr bool PERM = true, AFTER_DRAIN = false;
    bf16_t* G; const float* ss;
    __device__ __forceinline__ void operator()(const f32x4 (&acc)[2][2][4][2], const Unit& u, int wr, int wc, int fr, int fq) const {
        const int row0 = u.pm * 256 + wr * 64 + fr, col0 = u.pn * 128 + wc * 32 + 8 * fq;
#pragma unroll
        for (int ai = 0; ai < 2; ++ai)
#pragma unroll
            for (int m = 0; m < 4; ++m) {
                const int r = row0 + ai * 128 + m * 16; const float ri = rinv_of(ss[r]);
                float v[8];
#pragma unroll
                for (int n = 0; n < 2; ++n)
#pragma unroll
                    for (int j = 0; j < 4; ++j) v[n * 4 + j] = fsilu(acc[ai][0][m][n][j] * ri) * (acc[ai][1][m][n][j] * ri);
                u32x4 w; w.x = cvt_pk_bf16(v[0], v[1]); w.y = cvt_pk_bf16(v[2], v[3]); w.z = cvt_pk_bf16(v[4], v[5]); w.w = cvt_pk_bf16(v[6], v[7]);
                *(u32x4*)(G + (size_t)r * FF + col0) = w;
            }
    }
};
struct EpiResid {
    static constexpr bool PERM = true, AFTER_DRAIN = false;
    const float* R; float* H; bf16_t* XB; float* ss_out; float scale;
    __device__ __forceinline__ void operator()(const f32x4 (&acc)[2][2][4][2], const Unit& u, int wr, int wc, int fr, int fq) const {
        const int row0 = u.pm * 256 + wr * 64 + fr, col0 = u.pn * 256 + wc * 32 + 8 * fq;
#pragma unroll
        for (int ai = 0; ai < 2; ++ai)
#pragma unroll
            for (int m = 0; m < 4; ++m) {
                const int r = row0 + ai * 128 + m * 16; float sq = 0.f;
#pragma unroll
                for (int bj = 0; bj < 2; ++bj) {
                    const size_t off = (size_t)r * DM + col0 + bj * 128;
                    f32x4 v0 = *(const f32x4*)(R + off) + acc[ai][bj][m][0] * scale, v1 = *(const f32x4*)(R + off + 4) + acc[ai][bj][m][1] * scale;
                    *(f32x4*)(H + off) = v0; *(f32x4*)(H + off + 4) = v1;
                    u32x4 w; w.x = cvt_pk_bf16(v0[0], v0[1]); w.y = cvt_pk_bf16(v0[2], v0[3]); w.z = cvt_pk_bf16(v1[0], v1[1]); w.w = cvt_pk_bf16(v1[2], v1[3]);
                    *(u32x4*)(XB + off) = w;
                    sq += (v0[0] * v0[0] + v0[1] * v0[1]) + (v0[2] * v0[2] + v0[3] * v0[3]) + (v1[0] * v1[0] + v1[1] * v1[1]) + (v1[2] * v1[2] + v1[3] * v1[3]);
                }
                sq += __shfl_xor(sq, 16); sq += __shfl_xor(sq, 32);
                if (fq == 0) atomicAdd(ss_out + r, sq);
            }
    }
};
struct EpiMixIn {
    static constexpr bool PERM = true, AFTER_DRAIN = false;
    const float* ss; const float* lbl;
    bf16_t *QS, *UC; float* LF;
    __device__ __forceinline__ void operator()(const f32x4 (&acc)[2][2][4][2], const Unit& u, int wr, int wc, int fr, int fq) const {
        const int row0 = u.pm * 256 + wr * 64 + fr; const int sec = u.pn >> 2;
        if (u.pn >= 20) {
            const int col0 = (u.pn - 20) * 128 + wc * 32 + 8 * fq;
#pragma unroll
            for (int ai = 0; ai < 2; ++ai)
#pragma unroll
                for (int m = 0; m < 4; ++m) {
                    const int r = row0 + ai * 128 + m * 16; const float ri = rinv_of(ss[r]); const float ri2 = ri * ri;
                    float v[8];
#pragma unroll
                    for (int n = 0; n < 2; ++n)
#pragma unroll
                        for (int j = 0; j < 4; ++j) v[n * 4 + j] = acc[ai][0][m][n][j] * acc[ai][1][m][n][j] * ri2;
                    u32x4 w; w.x = cvt_pk_bf16(v[0], v[1]); w.y = cvt_pk_bf16(v[2], v[3]); w.z = cvt_pk_bf16(v[4], v[5]); w.w = cvt_pk_bf16(v[6], v[7]);
                    *(u32x4*)(UC + (size_t)r * CW + col0) = w;
                }
            return;
        }
        const int col0 = (u.pn & 3) * 256 + wc * 32 + 8 * fq;
        if (sec == 1) {
#pragma unroll
            for (int bj = 0; bj < 2; ++bj)
#pragma unroll
                for (int n = 0; n < 2; ++n) {
                    const int c = col0 + bj * 128 + 4 * n; const f32x4 l0 = *(const f32x4*)(lbl + c), l1 = *(const f32x4*)(lbl + 1024 + c);
                    f32x4 lb; lb[0] = fsigmoid(l0[0] - l1[0]); lb[1] = fsigmoid(l0[1] - l1[1]); lb[2] = fsigmoid(l0[2] - l1[2]); lb[3] = fsigmoid(l0[3] - l1[3]);
#pragma unroll
                    for (int ai = 0; ai < 2; ++ai)
#pragma unroll
                        for (int m = 0; m < 4; ++m) {
                            const int r = row0 + ai * 128 + m * 16; const float ri = rinv_of(ss[r]);
                            const f32x4 x = acc[ai][bj][m][n]; f32x4 o;
                            o[0] = __logf(lb[0] + (1.0f - lb[0]) * fsigmoid(x[0] * ri)); o[1] = __logf(lb[1] + (1.0f - lb[1]) * fsigmoid(x[1] * ri));
                            o[2] = __logf(lb[2] + (1.0f - lb[2]) * fsigmoid(x[2] * ri)); o[3] = __logf(lb[3] + (1.0f - lb[3]) * fsigmoid(x[3] * ri));
                            *(f32x4*)(LF + (size_t)r * HW + c) = o;
                        }
                }
            return;
        }
        bf16_t* dst = QS + (size_t)(sec == 0 ? 0 : sec - 1) * ((size_t)M_TOK * HW);
        const bool act = (sec == 0 || sec == 3);
#pragma unroll
        for (int ai = 0; ai < 2; ++ai)
#pragma unroll
            for (int m = 0; m < 4; ++m) {
                const int r = row0 + ai * 128 + m * 16; const float ri = rinv_of(ss[r]);
#pragma unroll
                for (int bj = 0; bj < 2; ++bj) {
                    float v[8];
#pragma unroll
                    for (int n = 0; n < 2; ++n)
#pragma unroll
                        for (int j = 0; j < 4; ++j) { const float x = acc[ai][bj][m][n][j] * ri; v[n * 4 + j] = act ? fsilu(x) : x; }
                    u32x4 w; w.x = cvt_pk_bf16(v[0], v[1]); w.y = cvt_pk_bf16(v[2], v[3]); w.z = cvt_pk_bf16(v[4], v[5]); w.w = cvt_pk_bf16(v[6], v[7]);
                    *(u32x4*)(dst + (size_t)r * HW + col0 + bj * 128) = w;
                }
            }
    }
};
struct EpiStoreBf16 {
    static constexpr bool PERM = true, AFTER_DRAIN = false;
    bf16_t* O;
    __device__ __forceinline__ void operator()(const f32x4 (&acc)[2][2][4][2], const Unit& u, int wr, int wc, int fr, int fq) const {
        const int row0 = u.pm * 256 + wr * 64 + fr, col0 = u.pn * 256 + wc * 32 + 8 * fq;
#pragma unroll
        for (int ai = 0; ai < 2; ++ai)
#pragma unroll
            for (int m = 0; m < 4; ++m) {
                const int r = row0 + ai * 128 + m * 16;
#pragma unroll
                for (int bj = 0; bj < 2; ++bj) {
                    const f32x4 v0 = acc[ai][bj][m][0], v1 = acc[ai][bj][m][1];
                    u32x4 w; w.x = cvt_pk_bf16(v0[0], v0[1]); w.y = cvt_pk_bf16(v0[2], v0[3]); w.z = cvt_pk_bf16(v1[0], v1[1]); w.w = cvt_pk_bf16(v1[2], v1[3]);
                    *(u32x4*)(O + (size_t)r * DM + col0 + bj * 128) = w;
                }
            }
    }
};
struct EpiPleGate {
    static constexpr bool PERM = true, AFTER_DRAIN = false;
    float* H; const bf16_t* P; const float* ss;
    __device__ __forceinline__ void operator()(const f32x4 (&acc)[2][2][4][2], const Unit& u, int wr, int wc, int fr, int fq) const {
        const int row0 = u.pm * 256 + wr * 64 + fr, col0 = u.pn * 256 + wc * 32 + 8 * fq;
#pragma unroll
        for (int ai = 0; ai < 2; ++ai)
#pragma unroll
            for (int m = 0; m < 4; ++m) {
                const int r = row0 + ai * 128 + m * 16; const float ri = rinv_of(ss[r]);
#pragma unroll
                for (int bj = 0; bj < 2; ++bj) {
                    const size_t off = (size_t)r * DM + col0 + bj * 128;
                    const u32x4 pw = *(const u32x4*)(P + off);
                    f32x4 v0 = *(const f32x4*)(H + off), v1 = *(const f32x4*)(H + off + 4);
                    const f32x4 a0 = acc[ai][bj][m][0], a1 = acc[ai][bj][m][1];
                    v0[0] += fsigmoid(a0[0] * ri) * bflo(pw.x); v0[1] += fsigmoid(a0[1] * ri) * bfhi(pw.x);
                    v0[2] += fsigmoid(a0[2] * ri) * bflo(pw.y); v0[3] += fsigmoid(a0[3] * ri) * bfhi(pw.y);
                    v1[0] += fsigmoid(a1[0] * ri) * bflo(pw.z); v1[1] += fsigmoid(a1[1] * ri) * bfhi(pw.z);
                    v1[2] += fsigmoid(a1[2] * ri) * bflo(pw.w); v1[3] += fsigmoid(a1[3] * ri) * bfhi(pw.w);
                    *(f32x4*)(H + off) = v0; *(f32x4*)(H + off + 4) = v1;
                }
            }
    }
};

template <int MODE>
__device__ __forceinline__ void p0_item(const float* W, const float* W2, const float* gain, int K, int N, bf16_t* WT, LAS float* scr, int item, int lane) {
    const int nblk_k = K / 64; const int nb = item / nblk_k, kb = item % nblk_k; const int k0 = 64 * kb, n0 = 32 * nb;
    const float* src = W; int c0 = n0;
    if (MODE == 1) { const int t = n0 >> 8, bj = (n0 >> 7) & 1, c = n0 & 127; src = bj ? W2 : W; c0 = 128 * t + c; }
    if (MODE == 2) { if (n0 >= 5120) { const int tt = n0 - 5120; const int t = tt >> 8, bj = (tt >> 7) & 1, c = tt & 127; c0 = 5120 + 1024 * bj + 128 * t + c; } }
    float v[32], gg[32];
    const float* sp = src + (size_t)(k0 + (lane >> 5)) * N + c0 + (lane & 31);
#pragma unroll
    for (int i = 0; i < 32; ++i) v[i] = sp[(size_t)(2 * i) * N];
    if (gain) {
#pragma unroll
        for (int i = 0; i < 32; ++i) gg[i] = gain[k0 + 2 * i + (lane >> 5)];
#pragma unroll
        for (int i = 0; i < 32; ++i) v[i] *= gg[i];
    }
#pragma unroll
    for (int i = 0; i < 32; ++i) scr[(2 * i + (lane >> 5)) * 33 + (lane & 31)] = v[i];
    asm volatile("s_waitcnt lgkmcnt(0)" ::: "memory");
    const int c = lane & 7;
#pragma unroll
    for (int j = 0; j < 4; ++j) { const int n = (lane >> 3) + 8 * j; const LAS float* s = scr + (8 * c) * 33 + n;
        u32x4 o; o.x = cvt_pk_bf16(s[0 * 33], s[1 * 33]); o.y = cvt_pk_bf16(s[2 * 33], s[3 * 33]); o.z = cvt_pk_bf16(s[4 * 33], s[5 * 33]); o.w = cvt_pk_bf16(s[6 * 33], s[7 * 33]);
        *(u32x4*)(WT + (size_t)(n0 + n) * K + k0 + 8 * c) = o; }
    asm volatile("s_waitcnt lgkmcnt(0)" ::: "memory");
}

struct Args { const float* in[21]; float* out; unsigned char* ws; int ph_lo, ph_hi; };

constexpr int CV_I0 = 32 * 352, CV_I1 = 88 * 64, CV_I2 = 32 * 224, CV_I3 = 32 * 64, CV_I7 = 4 * 64;
constexpr int CV_END = 2 * CV_I0 + 2 * CV_I1 + CV_I2 + 2 * CV_I3 + CV_I7, CV_T1 = CV_END - 10000, CV_T0 = CV_T1 - 10000;
__device__ __forceinline__ void conv_range(const Args& a, LAS unsigned char* lds, int wave, int lane, int lo, int hi, int w0, int nw) {
    unsigned char* ws = a.ws;
    LAS float* scr = (LAS float*)(lds + wave * 16384);
    for (int it = lo + w0; it < hi; it += nw) {
        int r = it;
        if (r < CV_I0) { p0_item<1>(a.in[3], a.in[4], a.in[2], DM, FF, (bf16_t*)(ws + WS_W1GU), scr, r, lane); continue; } r -= CV_I0;
        if (r < CV_I2) { p0_item<2>(a.in[7], nullptr, a.in[6], DM, MIXIN, (bf16_t*)(ws + WS_WIN), scr, r, lane); continue; } r -= CV_I2;
        if (r < CV_I3) { p0_item<0>(a.in[12], nullptr, nullptr, DM, DM, (bf16_t*)(ws + WS_WOUT), scr, r, lane); continue; } r -= CV_I3;
        if (r < CV_I3) { p0_item<0>(a.in[19], nullptr, a.in[17], DM, DM, (bf16_t*)(ws + WS_WPG), scr, r, lane); continue; } r -= CV_I3;
        if (r < CV_I7) { p0_item<0>(a.in[18], nullptr, nullptr, PLE, DM, (bf16_t*)(ws + WS_WPE), scr, r, lane); continue; } r -= CV_I7;
        if (r < CV_I1) { p0_item<0>(a.in[16], nullptr, nullptr, FF, DM, (bf16_t*)(ws + WS_W2D), scr, r, lane); continue; } r -= CV_I1;
        if (r < CV_I0) { p0_item<1>(a.in[14], a.in[15], a.in[13], DM, FF, (bf16_t*)(ws + WS_W2GU), scr, r, lane); continue; } r -= CV_I0;
        p0_item<0>(a.in[5], nullptr, nullptr, FF, DM, (bf16_t*)(ws + WS_W1D), scr, r, lane);
    }
}
__device__ __forceinline__ bool tail_block(int nunits) { const int r = nunits % (int)gridDim.x; return r != 0 && (int)blockIdx.x >= r; }
__device__ __forceinline__ void conv_tail(const Args& a, LAS unsigned char* lds, int wave, int lane, int nunits, int lo, int hi) {
    const int r = nunits % (int)gridDim.x;
    if (r == 0) { conv_range(a, lds, wave, lane, lo, hi, blockIdx.x * 8 + wave, gridDim.x * 8); return; }
    if ((int)blockIdx.x >= r) conv_range(a, lds, wave, lane, lo, hi, ((int)blockIdx.x - r) * 8 + wave, ((int)gridDim.x - r) * 8);
}

__device__ __forceinline__ void phase0(const Args& a, LAS unsigned char* lds, int wave, int lane) {
    unsigned char* ws = a.ws;
    const int gw = blockIdx.x * 8 + wave, NGW = gridDim.x * 8;
    conv_range(a, lds, wave, lane, 0, CV_T0, gw, NGW);
    float* SS = (float*)(ws + WS_SS);
    for (int m = gw; m < M_TOK; m += NGW) {
        const f32x4* xr = (const f32x4*)(a.in[0] + (size_t)m * DM) + lane; u32x2* xb = (u32x2*)((bf16_t*)(ws + WS_XB) + (size_t)m * DM) + lane;
        float s = 0.f;
#pragma unroll
        for (int j = 0; j < 8; ++j) { const f32x4 v = xr[64 * j]; s += (v[0] * v[0] + v[1] * v[1]) + (v[2] * v[2] + v[3] * v[3]);
            u32x2 w; w.x = cvt_pk_bf16(v[0], v[1]); w.y = cvt_pk_bf16(v[2], v[3]); xb[64 * j] = w; }
        s = wave_sum(s);
        if (lane == 0) { SS[m] = s; SS[8192 + m] = 0.f; SS[16384 + m] = 0.f; SS[24576 + m] = 0.f; }
    }
    { const int gt = blockIdx.x * 512 + threadIdx.x, NT = gridDim.x * 512;
      for (int i = gt; i < M_TOK * PLE / 4; i += NT) { const f32x4 v = ((const f32x4*)a.in[1])[i]; u32x2 w; w.x = cvt_pk_bf16(v[0], v[1]); w.y = cvt_pk_bf16(v[2], v[3]); ((u32x2*)(ws + WS_PB))[i] = w; } }
}

constexpr int HP = 136, VP = 72;
constexpr int L_QT = 0, L_QH = L_QT + 64 * HP * 2, L_KA = L_QH + 64 * HP * 2, L_KB = L_KA + 64 * HP * 2, L_ST = L_KB + 32 * HP * 2, L_VT = L_ST + 128 * HP * 2,
              L_P = L_VT + 128 * VP * 2, L_SEG = L_P + 64 * VP * 2, L_PART = L_SEG + 4 * 128 * 4, L_RINV = L_PART + 8 * 64 * 4, L_HEND = L_RINV + 256, L_KT = 0;
static_assert(L_HEND <= LDS_BYTES, "LDS");
#define MFMA16(a, b, c) __builtin_amdgcn_mfma_f32_16x16x32_bf16((a), (b), (c), 0, 0, 0)
__device__ __forceinline__ bf16_t f2bf(float x) { return (bf16_t)(cvt_pk_bf16(x, 0.f) & 0xffffu); }

__device__ __forceinline__ void hgrn_pass_a(const Args& a, LAS unsigned char* lds, int wave, int lane) {
    unsigned char* ws = a.ws;
    const float* LF = (const float*)(ws + WS_LF); const bf16_t* VH = (const bf16_t*)(ws + WS_VH); float* U = (float*)(ws + WS_U); float* Dd = (float*)(ws + WS_DD);
    const int tid = threadIdx.x, k = tid & 127, sg = tid >> 7, fr = lane & 15, fq = lane >> 4;
    LAS bf16_t* VT = (LAS bf16_t*)(lds + L_VT); LAS bf16_t* KT = (LAS bf16_t*)(lds + L_KT); LAS float* SEG = (LAS float*)(lds + L_SEG);
    for (int item = blockIdx.x; item < 1024; item += gridDim.x) {
        const int row0 = (item >> 3) * 64, cb = (item & 7) * 128;
        float lf[16], b[16];
#pragma unroll
        for (int i = 0; i < 16; ++i) lf[i] = LF[(size_t)(row0 + 16 * sg + i) * HW + cb + k];
        u32x4 vv[2];
#pragma unroll
        for (int j = 0; j < 2; ++j) { const int idx = tid + 512 * j; vv[j] = *(const u32x4*)(VH + (size_t)(row0 + (idx >> 4)) * HW + cb + 8 * (idx & 15)); }
        float run = 0.f;
#pragma unroll
        for (int i = 0; i < 16; ++i) { run += lf[i]; b[i] = run; }
        SEG[sg * 128 + k] = run;
        __syncthreads();
        const float s0 = SEG[k], s1 = SEG[128 + k], s2 = SEG[256 + k], s3 = SEG[384 + k];
        const float pre = sg == 0 ? 0.f : (sg == 1 ? s0 : (sg == 2 ? s0 + s1 : s0 + s1 + s2));
        const float blast = s0 + s1 + s2 + s3;
        unsigned pk[8];
#pragma unroll
        for (int i = 0; i < 8; ++i) {
            const float e0 = (1.0f - __expf(lf[2 * i])) * __expf(blast - (pre + b[2 * i])), e1 = (1.0f - __expf(lf[2 * i + 1])) * __expf(blast - (pre + b[2 * i + 1]));
            pk[i] = cvt_pk_bf16(e0, e1); }
        { u32x4 w0, w1; w0.x = pk[0]; w0.y = pk[1]; w0.z = pk[2]; w0.w = pk[3]; w1.x = pk[4]; w1.y = pk[5]; w1.z = pk[6]; w1.w = pk[7];
          *(LAS u32x4*)(KT + k * VP + 16 * sg) = w0; *(LAS u32x4*)(KT + k * VP + 16 * sg + 8) = w1; }
#pragma unroll
        for (int j = 0; j < 2; ++j) { const int idx = tid + 512 * j, s = idx >> 4, v0 = 8 * (idx & 15);
            VT[(v0 + 0) * VP + s] = (bf16_t)(vv[j].x & 0xffffu); VT[(v0 + 1) * VP + s] = (bf16_t)(vv[j].x >> 16);
            VT[(v0 + 2) * VP + s] = (bf16_t)(vv[j].y & 0xffffu); VT[(v0 + 3) * VP + s] = (bf16_t)(vv[j].y >> 16);
            VT[(v0 + 4) * VP + s] = (bf16_t)(vv[j].z & 0xffffu); VT[(v0 + 5) * VP + s] = (bf16_t)(vv[j].z >> 16);
            VT[(v0 + 6) * VP + s] = (bf16_t)(vv[j].w & 0xffffu); VT[(v0 + 7) * VP + s] = (bf16_t)(vv[j].w >> 16); }
        if (sg == 0) Dd[item * 128 + k] = __expf(blast);
        __syncthreads();
        const bf16x8 a0 = *(const LAS bf16x8*)(VT + (16 * wave + fr) * VP + fq * 8), a1 = *(const LAS bf16x8*)(VT + (16 * wave + fr) * VP + 32 + fq * 8);
        float* up = U + (size_t)item * 16384 + (16 * wave + 4 * fq) * 128 + fr;
#pragma unroll
        for (int kt = 0; kt < 8; ++kt) {
            const bf16x8 b0 = *(const LAS bf16x8*)(KT + (16 * kt + fr) * VP + fq * 8), b1 = *(const LAS bf16x8*)(KT + (16 * kt + fr) * VP + 32 + fq * 8);
            f32x4 acc = {0.f, 0.f, 0.f, 0.f};
            acc = MFMA16(a0, b0, acc); acc = MFMA16(a1, b1, acc);
            up[16 * kt] = acc[0]; up[16 * kt + 128] = acc[1]; up[16 * kt + 256] = acc[2]; up[16 * kt + 384] = acc[3];
        }
        __syncthreads();
    }
}

__device__ __forceinline__ void hgrn_scan(const Args& a) {
    unsigned char* ws = a.ws;
    const float* U = (const float*)(ws + WS_U); const float* Dd = (const float*)(ws + WS_DD); bf16_t* SP = (bf16_t*)(ws + WS_S);
    for (int e = (blockIdx.x * 512 + threadIdx.x) * 4; e < 32 * 16384; e += gridDim.x * 512 * 4) {
        const int bh = e >> 14, vk = e & 16383, bb = bh >> 3, h = bh & 7;
        f32x4 S = {0.f, 0.f, 0.f, 0.f};
#pragma unroll 8
        for (int ci = 0; ci < 32; ++ci) {
            const size_t item = (size_t)((bb * 32 + ci) * 8 + h);
            const f32x4 u = *(const f32x4*)(U + item * 16384 + vk); const f32x4 d = *(const f32x4*)(Dd + item * 128 + (vk & 127));
            u32x2 w; w.x = cvt_pk_bf16(S[0], S[1]); w.y = cvt_pk_bf16(S[2], S[3]); *(u32x2*)(SP + item * 16384 + vk) = w;
            S = d * S + u;
        }
    }
}

__device__ __forceinline__ void conv_mixer(const Args& a, int wave, int lane) {
    unsigned char* ws = a.ws;
    const bf16_t* BC = (const bf16_t*)(ws + WS_BC); const bf16_t* UC = (const bf16_t*)(ws + WS_UC); bf16_t* MIX = (bf16_t*)(ws + WS_MIX);
    const float* cn = a.in[11]; const float* cw = a.in[8];
    const int gw = blockIdx.x * 8 + wave, NGW = gridDim.x * 8;
    for (int it = gw; it < M_TOK * 2; it += NGW) {
        const int row = it >> 1, c = (it & 1) * 512 + lane * 8, t = row & (SEQ - 1);
        const size_t off = (size_t)row * CW + c;
        const u32x4 z = {0u, 0u, 0u, 0u};
        const u32x4 u0 = *(const u32x4*)(UC + off), u1 = t >= 1 ? *(const u32x4*)(UC + off - CW) : z, u2 = t >= 2 ? *(const u32x4*)(UC + off - 2 * CW) : z, bg = *(const u32x4*)(BC + off);
        float y[8]; float ssq = 0.f;
#pragma unroll
        for (int q = 0; q < 4; ++q) {
            const unsigned a0 = u0[q], a1 = u1[q], a2 = u2[q], bb = bg[q]; const int cc = c + 2 * q;
            y[2 * q] = bflo(bb) * (cw[cc] * bflo(a2) + cw[CW + cc] * bflo(a1) + cw[2 * CW + cc] * bflo(a0));
            y[2 * q + 1] = bfhi(bb) * (cw[cc + 1] * bfhi(a2) + cw[CW + cc + 1] * bfhi(a1) + cw[2 * CW + cc + 1] * bfhi(a0));
            ssq += y[2 * q] * y[2 * q] + y[2 * q + 1] * y[2 * q + 1];
        }
        ssq += __shfl_xor(ssq, 1); ssq += __shfl_xor(ssq, 2); ssq += __shfl_xor(ssq, 4); ssq += __shfl_xor(ssq, 8);
        const float ri = rsqrtf(ssq * (1.0f / 128) + EPS);
        u32x4 w;
        w.x = cvt_pk_bf16(y[0] * ri * cn[c], y[1] * ri * cn[c + 1]); w.y = cvt_pk_bf16(y[2] * ri * cn[c + 2], y[3] * ri * cn[c + 3]);
        w.z = cvt_pk_bf16(y[4] * ri * cn[c + 4], y[5] * ri * cn[c + 5]); w.w = cvt_pk_bf16(y[6] * ri * cn[c + 6], y[7] * ri * cn[c + 7]);
        *(u32x4*)(MIX + (size_t)row * DM + HW + c) = w;
    }
}

__device__ __forceinline__ void hgrn_pass_c(const Args& a, LAS unsigned char* lds, int wave, int lane) {
    unsigned char* ws = a.ws;
    const float* LF = (const float*)(ws + WS_LF); const bf16_t* VH = (const bf16_t*)(ws + WS_VH); const bf16_t* QS = (const bf16_t*)(ws + WS_QS); const bf16_t* GH = (const bf16_t*)(ws + WS_GH);
    const bf16_t* SP = (const bf16_t*)(ws + WS_S); bf16_t* MIX = (bf16_t*)(ws + WS_MIX); const float* hn = a.in[10];
    const int tid = threadIdx.x, k = tid & 127, sg = tid >> 7, fr = lane & 15, fq = lane >> 4;
    LAS bf16_t* QT = (LAS bf16_t*)(lds + L_QT); LAS bf16_t* QH = (LAS bf16_t*)(lds + L_QH); LAS bf16_t* KA = (LAS bf16_t*)(lds + L_KA); LAS bf16_t* KB = (LAS bf16_t*)(lds + L_KB);
    LAS bf16_t* ST = (LAS bf16_t*)(lds + L_ST); LAS bf16_t* VT = (LAS bf16_t*)(lds + L_VT); LAS bf16_t* P = (LAS bf16_t*)(lds + L_P);
    LAS float* SEG = (LAS float*)(lds + L_SEG); LAS float* PART = (LAS float*)(lds + L_PART); LAS float* RINV = (LAS float*)(lds + L_RINV);
    for (int item = blockIdx.x; item < 1024; item += gridDim.x) {
        const int row0 = (item >> 3) * 64, cb = (item & 7) * 128;
        float lf[16], b[16]; bf16_t qh[16];
#pragma unroll
        for (int i = 0; i < 16; ++i) { lf[i] = LF[(size_t)(row0 + 16 * sg + i) * HW + cb + k]; qh[i] = QS[(size_t)(row0 + 16 * sg + i) * HW + cb + k]; }
        u32x4 vv[2], sv[4];
#pragma unroll
        for (int j = 0; j < 2; ++j) { const int idx = tid + 512 * j; vv[j] = *(const u32x4*)(VH + (size_t)(row0 + (idx >> 4)) * HW + cb + 8 * (idx & 15)); }
#pragma unroll
        for (int j = 0; j < 4; ++j) { const int idx = tid + 512 * j; sv[j] = *(const u32x4*)(SP + (size_t)item * 16384 + (idx >> 4) * 128 + 8 * (idx & 15)); }
        float run = 0.f;
#pragma unroll
        for (int i = 0; i < 16; ++i) { run += lf[i]; b[i] = run; }
        SEG[sg * 128 + k] = run;
        __syncthreads();
        const float s0 = SEG[k], s1 = SEG[128 + k], s2 = SEG[256 + k];
        const float pre = sg == 0 ? 0.f : (sg == 1 ? s0 : (sg == 2 ? s0 + s1 : s0 + s1 + s2));
        const float beta1 = s0 + s1, beta = sg >= 2 ? beta1 : 0.f;
#pragma unroll
        for (int i = 0; i < 16; ++i) {
            const int s = 16 * sg + i; const float bi = pre + b[i], kk = 1.0f - __expf(lf[i]), qv = bf2f(qh[i]);
            QT[s * HP + k] = f2bf(qv * __expf(bi - beta)); QH[s * HP + k] = f2bf(qv * __expf(bi));
            KA[s * HP + k] = f2bf(kk * __expf(fminf(beta - bi, 80.f)));
            if (sg < 2) KB[s * HP + k] = f2bf(kk * __expf(beta1 - bi));
        }
#pragma unroll
        for (int j = 0; j < 2; ++j) { const int idx = tid + 512 * j, s = idx >> 4, v0 = 8 * (idx & 15);
            VT[(v0 + 0) * VP + s] = (bf16_t)(vv[j].x & 0xffffu); VT[(v0 + 1) * VP + s] = (bf16_t)(vv[j].x >> 16);
            VT[(v0 + 2) * VP + s] = (bf16_t)(vv[j].y & 0xffffu); VT[(v0 + 3) * VP + s] = (bf16_t)(vv[j].y >> 16);
            VT[(v0 + 4) * VP + s] = (bf16_t)(vv[j].z & 0xffffu); VT[(v0 + 5) * VP + s] = (bf16_t)(vv[j].z >> 16);
            VT[(v0 + 6) * VP + s] = (bf16_t)(vv[j].w & 0xffffu); VT[(v0 + 7) * VP + s] = (bf16_t)(vv[j].w >> 16); }
#pragma unroll
        for (int j = 0; j < 4; ++j) { const int idx = tid + 512 * j; *(LAS u32x4*)(ST + (idx >> 4) * HP + 8 * (idx & 15)) = sv[j]; }
        __syncthreads();
#pragma unroll
        for (int pp = 0; pp < 2; ++pp) {
            const int p = wave + 8 * pp, tt = p >> 2, st = p & 3;
            f32x4 acc = {0.f, 0.f, 0.f, 0.f};
            if (st <= tt) {
                const LAS bf16_t* kb = (tt >= 2 && st < 2) ? KB : KA;
#pragma unroll
                for (int ks = 0; ks < 4; ++ks) { const bf16x8 af = *(const LAS bf16x8*)(QT + (16 * tt + fr) * HP + ks * 32 + fq * 8), bfr = *(const LAS bf16x8*)(kb + (16 * st + fr) * HP + ks * 32 + fq * 8);
                    acc = MFMA16(af, bfr, acc); }
            }
#pragma unroll
            for (int r = 0; r < 4; ++r) { const bool keep = (st < tt) || (st == tt && fr <= 4 * fq + r); P[(16 * tt + 4 * fq + r) * VP + 16 * st + fr] = f2bf(keep ? acc[r] : 0.f); }
        }
        __syncthreads();
        bf16x8 bs[4], bv[2];
#pragma unroll
        for (int ks = 0; ks < 4; ++ks) bs[ks] = *(const LAS bf16x8*)(ST + (16 * wave + fr) * HP + ks * 32 + fq * 8);
#pragma unroll
        for (int ks = 0; ks < 2; ++ks) bv[ks] = *(const LAS bf16x8*)(VT + (16 * wave + fr) * VP + ks * 32 + fq * 8);
        f32x4 o[4];
#pragma unroll
        for (int tt = 0; tt < 4; ++tt) {
            f32x4 acc = {0.f, 0.f, 0.f, 0.f};
#pragma unroll
            for (int ks = 0; ks < 4; ++ks) { const bf16x8 af = *(const LAS bf16x8*)(QH + (16 * tt + fr) * HP + ks * 32 + fq * 8); acc = MFMA16(af, bs[ks], acc); }
            { const bf16x8 af = *(const LAS bf16x8*)(P + (16 * tt + fr) * VP + fq * 8); acc = MFMA16(af, bv[0], acc); }
            if (tt >= 2) { const bf16x8 af = *(const LAS bf16x8*)(P + (16 * tt + fr) * VP + 32 + fq * 8); acc = MFMA16(af, bv[1], acc); }
            o[tt] = acc;
        }
#pragma unroll
        for (int tt = 0; tt < 4; ++tt)
#pragma unroll
            for (int r = 0; r < 4; ++r) { float x = o[tt][r] * o[tt][r]; x += __shfl_xor(x, 1); x += __shfl_xor(x, 2); x += __shfl_xor(x, 4); x += __shfl_xor(x, 8);
                if (fr == 0) PART[wave * 64 + 16 * tt + 4 * fq + r] = x; }
        __syncthreads();
        if (tid < 64) { float s = 0.f;
#pragma unroll
            for (int w = 0; w < 8; ++w) s += PART[w * 64 + tid];
            RINV[tid] = rsqrtf(s * (1.0f / 128) + EPS); }
        __syncthreads();
        const float hnv = hn[16 * wave + fr];
#pragma unroll
        for (int tt = 0; tt < 4; ++tt)
#pragma unroll
            for (int r = 0; r < 4; ++r) { const int t = 16 * tt + 4 * fq + r; const size_t row = (size_t)(row0 + t);
                const float g = bf2f(GH[row * HW + cb + 16 * wave + fr]);
                MIX[row * DM + cb + 16 * wave + fr] = f2bf(o[tt][r] * RINV[t] * hnv * g); }
        __syncthreads();
    }
}

__device__ __forceinline__ void phase_final(const Args& a, int wave, int lane) {
    const int gw = blockIdx.x * 8 + wave, NGW = gridDim.x * 8; const float* gF = a.in[20];
    for (int m = gw; m < M_TOK; m += NGW) {
        f32x4* xr = (f32x4*)(a.out + (size_t)m * DM) + lane; f32x4 v[8]; float s = 0.f;
#pragma unroll
        for (int j = 0; j < 8; ++j) { v[j] = xr[64 * j]; s += (v[j][0] * v[j][0] + v[j][1] * v[j][1]) + (v[j][2] * v[j][2] + v[j][3] * v[j][3]); }
        const float ri = rinv_of(wave_sum(s));
#pragma unroll
        for (int j = 0; j < 8; ++j) { const f32x4 g = ((const f32x4*)gF)[64 * j + lane]; xr[64 * j] = v[j] * ri * g; }
    }
}

#define XB_TMO      128
#define XB_XCNT(j)  (256  + 64 * (j))
#define XB_XSUB(j)  (1280 + 64 * (j))
#define XB_XGEN(j)  (2304 + 64 * (j))
#define XB_TOP      3328
#define XB_TOPGEN   3392
#define XCD_BAR_WORDS 3456
#define XB_SPIN_CAP (1u << 18)

__device__ __forceinline__ unsigned xb_ld(unsigned* p)              { return __hip_atomic_load(p, __ATOMIC_RELAXED, __HIP_MEMORY_SCOPE_AGENT); }
__device__ __forceinline__ unsigned xb_add(unsigned* p, unsigned v) { return __hip_atomic_fetch_add(p, v, __ATOMIC_RELAXED, __HIP_MEMORY_SCOPE_AGENT); }
__device__ __forceinline__ unsigned xb_xcc_id() { return (unsigned)__builtin_amdgcn_s_getreg((3 << 11) | 20) & 0xFu; }
#define XB_SPIN(cond, bar) do { unsigned _sp = 0; while (cond) { __builtin_amdgcn_s_sleep(1); \
    if ((++_sp & 255u) == 0u) { if (xb_ld(&(bar)[XB_TMO])) break; if (_sp > XB_SPIN_CAP) { atomicAdd(&(bar)[XB_TMO], 1u); break; } } } } while (0)

struct XcdBarrier {
    unsigned* bar; unsigned x;
    volatile LAS unsigned* st;
};

__device__ __forceinline__ XcdBarrier xcd_barrier_post(unsigned* bar, volatile LAS unsigned* st) {
    XcdBarrier b; b.bar = bar; b.x = xb_xcc_id(); b.st = st;
    if (threadIdx.x == 0) (void)xb_add(&bar[XB_XCNT(b.x)], 1u);
    return b;
}
__device__ __forceinline__ void xcd_barrier_complete(unsigned* bar, unsigned x, unsigned& nloc, unsigned& nx) {
    const unsigned G = gridDim.x * gridDim.y * gridDim.z;
    unsigned sum, cnt, mine, sp = 0u;
    for (;;) {
        sum = 0u; cnt = 0u; mine = 0u;
#pragma unroll
        for (unsigned j = 0; j < 16; ++j) { const unsigned c = xb_ld(&bar[XB_XCNT(j)]); sum += c; cnt += (c > 0u) ? 1u : 0u; mine = (j == x) ? c : mine; }
        if (sum == G) break;
        __builtin_amdgcn_s_sleep(1);
        if ((++sp & 255u) == 0u) { if (xb_ld(&bar[XB_TMO])) break; if (sp > XB_SPIN_CAP) { atomicAdd(&bar[XB_TMO], 1u); break; } }
    }
    nloc = mine > 0u ? mine : 1u; nx = cnt > 0u ? cnt : 1u;
}

__device__ __forceinline__ void xcd_barrier(const XcdBarrier& b) {
    asm volatile("s_waitcnt vmcnt(0)" ::: "memory");
    __syncthreads();
    if (threadIdx.x == 0) {
        unsigned* bar = b.bar;
        __builtin_amdgcn_s_waitcnt(0);
        unsigned nloc = b.st[0], nx = b.st[1];
        if (nloc == 0u) { xcd_barrier_complete(bar, b.x, nloc, nx); b.st[0] = nloc; b.st[1] = nx; }
        const unsigned old = xb_add(&bar[XB_XSUB(b.x)], 1u);
        const unsigned gen = old / nloc;
        if (old + 1u == (gen + 1u) * nloc) {
            __builtin_amdgcn_fence(__ATOMIC_RELEASE, "agent");
            asm volatile("s_waitcnt vmcnt(0)" ::: "memory");
            const unsigned og = xb_add(&bar[XB_TOP], 1u);
            const unsigned tg = og / nx;
            if (og + 1u == (tg + 1u) * nx) xb_add(&bar[XB_TOPGEN], 1u);
            else XB_SPIN(xb_ld(&bar[XB_TOPGEN]) == tg, bar);
            __builtin_amdgcn_fence(__ATOMIC_ACQUIRE, "agent");
            xb_add(&bar[XB_XGEN(b.x)], 1u);
            asm volatile("s_waitcnt vmcnt(0)" ::: "memory");
        } else {
            XB_SPIN(xb_ld(&bar[XB_XGEN(b.x)]) == gen, bar);
            __builtin_amdgcn_fence(__ATOMIC_ACQUIRE, "agent");
            asm volatile("s_waitcnt vmcnt(0)" ::: "memory");
        }
    }
    __syncthreads();
}


template <class Epi>
__device__ __forceinline__ void run_gemm(LAS unsigned char* lds, const bf16_t* A, const bf16_t* Bt, int N, int K, const Epi& E) {
    pg8::Gemm g; g.A = A; g.Bt = Bt; g.M = M_TOK; g.N = N; g.K = K;
    pg8::StaticOrder S; S.init(M_TOK, N, (int)gridDim.x, (int)blockIdx.x);
    pg8::gemm_phase<Epi, pg8::StaticOrder, true, true>(lds, g, S, E);
}

__global__ void __launch_bounds__(512, 2) fwd_kernel(Args a) {
    extern __shared__ __attribute__((aligned(16))) unsigned char lds_raw[];
    LAS unsigned char* lds = (LAS unsigned char*)lds_raw;
    cg::grid_group grid = cg::this_grid();
    volatile LAS unsigned* xst = (volatile LAS unsigned*)(lds + LDS_BYTES - 16);
    if (threadIdx.x < 4) xst[threadIdx.x] = 0u;
    __syncthreads();
    XcdBarrier xbar = xcd_barrier_post((unsigned*)(a.ws + WS_BAR), xst);
    if (a.ph_lo == 0 && a.ph_hi == NPHASE) grid.sync();
    const int tid = threadIdx.x, lane = tid & 63, wave = __builtin_amdgcn_readfirstlane(tid >> 6);
    unsigned char* ws = a.ws;
    float* SS = (float*)(ws + WS_SS);
    bf16_t* XB = (bf16_t*)(ws + WS_XB); bf16_t* G = (bf16_t*)(ws + WS_G); bf16_t* MIX = (bf16_t*)(ws + WS_MIX);
#define PH(i) if (a.ph_lo <= (i) && (i) < a.ph_hi)
#define SYNC(i) if (a.ph_lo <= (i) && (i) + 1 < a.ph_hi) { xcd_barrier(xbar); }
    PH(0) { phase0(a, lds, wave, lane); } SYNC(0)
    PH(1) { EpiGateUp E; E.G = G; E.ss = SS; run_gemm(lds, XB, (const bf16_t*)(ws + WS_W1GU), 2 * FF, DM, E); conv_tail(a, lds, wave, lane, 32 * 44, CV_T1, CV_END); } SYNC(1)
    PH(2) { EpiResid E; E.R = a.in[0]; E.H = a.out; E.XB = XB; E.ss_out = SS + 8192; E.scale = 0.5f; run_gemm(lds, G, (const bf16_t*)(ws + WS_W1D), DM, FF, E); } SYNC(2)
    PH(3) { EpiMixIn E; E.ss = SS + 8192; E.lbl = a.in[9]; E.QS = (bf16_t*)(ws + WS_QS);
            E.UC = (bf16_t*)(ws + WS_UC); E.LF = (float*)(ws + WS_LF); run_gemm(lds, XB, (const bf16_t*)(ws + WS_WIN), MIXIN, DM, E); conv_tail(a, lds, wave, lane, 32 * 28, CV_T0, CV_T1); } SYNC(3)
    PH(4) { hgrn_pass_a(a, lds, wave, lane); } SYNC(4)
    PH(5) { hgrn_scan(a); conv_mixer(a, wave, lane); } SYNC(5)
    PH(6) { hgrn_pass_c(a, lds, wave, lane); } SYNC(6)
    PH(7) { EpiResid E; E.R = a.out; E.H = a.out; E.XB = XB; E.ss_out = SS + 16384; E.scale = 1.0f; run_gemm(lds, MIX, (const bf16_t*)(ws + WS_WOUT), DM, DM, E); } SYNC(7)
    PH(8) { EpiGateUp E; E.G = G; E.ss = SS + 16384; run_gemm(lds, XB, (const bf16_t*)(ws + WS_W2GU), 2 * FF, DM, E); } SYNC(8)
    PH(9) { EpiResid E; E.R = a.out; E.H = a.out; E.XB = XB; E.ss_out = SS + 24576; E.scale = 0.5f; run_gemm(lds, G, (const bf16_t*)(ws + WS_W2D), DM, FF, E); } SYNC(9)
    PH(10) { { EpiStoreBf16 E; E.O = (bf16_t*)(ws + WS_PLE); int kp = PLE; asm volatile("" : "+s"(kp)); run_gemm(lds, (const bf16_t*)(ws + WS_PB), (const bf16_t*)(ws + WS_WPE), DM, kp, E); }
             { EpiPleGate E; E.H = a.out; E.P = (const bf16_t*)(ws + WS_PLE); E.ss = SS + 24576; run_gemm(lds, XB, (const bf16_t*)(ws + WS_WPG), DM, DM, E); } } SYNC(10)
    PH(11) { phase_final(a, wave, lane); }
#undef PH
#undef SYNC
}

#ifndef MK_MULTI
#define MK_MULTI 0
#endif
extern "C" void kernel_launch(void* const* d_in, const int* in_sizes, int n_in, void* d_out, int out_size, void* d_ws, size_t ws_size, hipStream_t stream) {
    static int grid = 0;
    if (grid == 0) {
        if (n_in != 21 || out_size != M_TOK * DM || ws_size < WS_END) { fprintf(stderr, "kernel_launch: unexpected shapes (n_in %d out %d ws %zu need %zu)\n", n_in, out_size, ws_size, (size_t)WS_END); grid = -1; return; }
        int dev = 0, cus = 0, per_cu = 0;
        hipGetDevice(&dev); hipDeviceGetAttribute(&cus, hipDeviceAttributeMultiprocessorCount, dev);
        if (hipFuncSetAttribute((const void*)fwd_kernel, hipFuncAttributeMaxDynamicSharedMemorySize, LDS_BYTES) != hipSuccess) { fprintf(stderr, "kernel_launch: hipFuncSetAttribute failed\n"); grid = -1; return; }
        if (hipOccupancyMaxActiveBlocksPerMultiprocessor(&per_cu, (const void*)fwd_kernel, 512, LDS_BYTES) != hipSuccess || per_cu < 1) { fprintf(stderr, "kernel_launch: occupancy query failed (%d)\n", per_cu); grid = -1; return; }
        grid = cus * per_cu;
    }
    if (grid < 0) return;
    Args a{};
    for (int i = 0; i < 21; ++i) a.in[i] = (const float*)d_in[i];
    a.out = (float*)d_out; a.ws = (unsigned char*)d_ws;
#if MK_MULTI
    for (int p = 0; p < NPHASE; ++p) { a.ph_lo = p; a.ph_hi = p + 1; hipLaunchKernelGGL(fwd_kernel, dim3(grid), dim3(512), LDS_BYTES, stream, a); }
#else
    a.ph_lo = 0; a.ph_hi = NPHASE;
    if (hipMemsetAsync((char*)d_ws + WS_BAR, 0, XCD_BAR_WORDS * 4, stream) != hipSuccess) { fprintf(stderr, "kernel_launch: memset failed\n"); return; }
    void* args[] = {&a};
    hipError_t e = hipLaunchCooperativeKernel((void*)fwd_kernel, dim3(grid), dim3(512), args, LDS_BYTES, stream);
    if (e != hipSuccess) fprintf(stderr, "cooperative launch failed: %s (grid %d)\n", hipGetErrorString(e), grid);
#endif
}
```

```cpp
#include <hip/hip_runtime.h>
#include <hip/hip_cooperative_groups.h>
#include <cstdio>
#include <cstdint>
namespace pg8 {
#define PG8_LAS __attribute__((address_space(3)))
typedef unsigned short bf16_t;
typedef short bf16x8 __attribute__((ext_vector_type(8)));
typedef float f32x4 __attribute__((ext_vector_type(4)));
typedef unsigned u32x4 __attribute__((ext_vector_type(4)));
constexpr int BM = 256, BK = 64, HALF = 128, HTB = HALF * BK * 2  , STAGE_BYTES = 8 * HTB, NXCD = 8, WGM = 8;

__host__ __device__ __forceinline__ int lds_byte(int r, int c) { const int st = (r >> 4) * 2 + (c >> 5), rr = r & 15, cc = c & 31, ob = rr * 64 + cc * 2; return st * 1024 + (ob ^ (((ob >> 9) & 1) << 5)); }
__host__ __device__ __forceinline__ void stage_rc(int b, int& R, int& C) { const int st = b / 1024, sb = b % 1024, swz = sb ^ (((sb >> 9) & 1) << 5); R = (st >> 1) * 16 + swz / 64; C = (st & 1) * 32 + (swz % 64) / 2; }
__host__ __device__ __forceinline__ int perm32(int rho) { const int n = rho >> 4, i = rho & 15; return 8 * (i >> 2) + 4 * n + (i & 3); }

struct Unit { int pm, pn; };
struct Gemm { const bf16_t* A; const bf16_t* Bt; int M, N, K; };

struct StaticOrder {
    int nM, nN, nwg, G, c;
    __host__ __device__ void init(int M, int N, int G_, int c_) { nM = M / BM; nN = N / BM; nwg = nM * nN; G = G_; c = c_; }
    __host__ __device__ bool next(int i, Unit& u) const {
        const long L = (long)i * G + c; if (L >= nwg) return false;
        int wgid = (int)L; { const int q = nwg / NXCD, r = nwg % NXCD, xcd = wgid % NXCD, off = wgid / NXCD; wgid = (xcd < r ? xcd * (q + 1) : r * (q + 1) + (xcd - r) * q) + off; }
        const int nig = WGM * nN, gid = wgid / nig, fm = gid * WGM, gsz = (nM - fm) < WGM ? (nM - fm) : WGM;
        u.pm = fm + ((wgid % nig) % gsz); u.pn = (wgid % nig) / gsz; return true;
    }
    __device__ __forceinline__ void a_ready(const Unit&) const {}
    __device__ __forceinline__ void done(const Unit&) const {}
};
typedef float f32x2 __attribute__((ext_vector_type(2)));
template <class Epi, class Sched, bool ALIGN_EPI = false, bool SP2 = false>
__device__ __forceinline__ void gemm_phase(PG8_LAS unsigned char* lds, const Gemm g, const Sched& S, const Epi& E) {
    const int tid = threadIdx.x, wid = __builtin_amdgcn_readfirstlane(tid >> 6), lane = tid & 63, wr = wid >> 2, wc = wid & 3, fr = lane & 15, fq = lane >> 4;
    const int K = g.K, nt = K / BK;
    unsigned voffA[2], voffB[2];
#pragma unroll
    for (int i = 0; i < 2; ++i) { int R, C; stage_rc(tid * 16 + i * 8192, R, C); const int Rb = Epi::PERM ? ((R & ~31) + perm32(R & 31)) : R;
        voffA[i] = (unsigned)(R * K + C) * 2u; voffB[i] = (unsigned)(Rb * K + C) * 2u; }
    const size_t kstep = (size_t)(BK * 2);
    const size_t hstep = (size_t)HALF * K * 2;
    const size_t tstep = 2 * hstep;
    const unsigned ldsw = (unsigned)wid * 1024u;
    const int aoff = lds_byte(wr * 64 + fr, fq * 8), boff = lds_byte(wc * 32 + fr, fq * 8);
#define PG8_SA(b, h) (((b) * 2 + (h)) * HTB)
#define PG8_SB(b, h) ((4 + (b) * 2 + (h)) * HTB)
#define PG8_STAGE(bufoff, gbase, voff) do { _Pragma("unroll") for (int _i = 0; _i < 2; ++_i) \
        __builtin_amdgcn_global_load_lds((const unsigned*)((const char*)(gbase) + (voff)[_i]), (PG8_LAS unsigned*)(lds + (bufoff) + ldsw + _i * 8192), 16, 0, 0); } while (0)
#define PG8_LDA(dst, b, h) do { _Pragma("unroll") for (int m = 0; m < 4; ++m) _Pragma("unroll") for (int k = 0; k < 2; ++k) dst[m][k] = *(const PG8_LAS bf16x8*)(lds + PG8_SA(b, h) + aoff + m * 2048 + k * 1024); } while (0)
#define PG8_LDB(dst, b, h) do { _Pragma("unroll") for (int n = 0; n < 2; ++n) _Pragma("unroll") for (int k = 0; k < 2; ++k) dst[n][k] = *(const PG8_LAS bf16x8*)(lds + PG8_SB(b, h) + boff + n * 2048 + k * 1024); } while (0)
#define PG8_MMA(ai, bj, At, Bt) do { __builtin_amdgcn_s_setprio(1); _Pragma("unroll") for (int m = 0; m < 4; ++m) _Pragma("unroll") for (int n = 0; n < 2; ++n) _Pragma("unroll") for (int k = 0; k < 2; ++k) \
        acc[ai][bj][m][n] = __builtin_amdgcn_mfma_f32_16x16x32_bf16(Bt[n][k], At[m][k], acc[ai][bj][m][n], 0, 0, 0); __builtin_amdgcn_s_setprio(0); } while (0)
#define PG8_WAIT_V(n) asm volatile("s_waitcnt vmcnt(" #n ")" ::: "memory")
#define PG8_WAIT_L(n) asm volatile("s_waitcnt lgkmcnt(" #n ")" ::: "memory")
#define PG8_BAR __builtin_amdgcn_s_barrier()
#define PG8_SCHED __builtin_amdgcn_sched_barrier(0)
    Unit cur, nxt; int ui = 0;
    if (!S.next(0, cur)) return;
    f32x4 acc[2][2][4][2];
#pragma unroll
    for (int a = 0; a < 2; ++a)
#pragma unroll
        for (int b = 0; b < 2; ++b)
#pragma unroll
            for (int m = 0; m < 4; ++m)
#pragma unroll
                for (int n = 0; n < 2; ++n) acc[a][b][m][n] = (f32x4){0.f, 0.f, 0.f, 0.f};
    bf16x8 At[4][2], B0[2][2], B1[2][2];
    const char* cA = (const char*)g.A + (size_t)cur.pm * tstep; const char* cB = (const char*)g.Bt + (size_t)cur.pn * tstep;
    S.a_ready(cur);
    if constexpr (SP2) {
        PG8_STAGE(PG8_SB(0, 0), cB, voffB); PG8_STAGE(PG8_SB(0, 1), cB + hstep, voffB); PG8_STAGE(PG8_SA(0, 0), cA, voffA); PG8_STAGE(PG8_SA(0, 1), cA + hstep, voffA);
        if (wr == 1) PG8_BAR;
        PG8_WAIT_V(2); PG8_BAR;
        PG8_STAGE(PG8_SB(1, 0), cB + kstep, voffB); PG8_STAGE(PG8_SA(1, 0), cA + kstep, voffA); PG8_STAGE(PG8_SB(1, 1), cB + hstep + kstep, voffB);
        PG8_WAIT_V(6); PG8_BAR;
    } else {
        PG8_STAGE(PG8_SB(0, 0), cB, voffB); PG8_STAGE(PG8_SA(0, 0), cA, voffA); PG8_STAGE(PG8_SB(0, 1), cB + hstep, voffB); PG8_STAGE(PG8_SA(0, 1), cA + hstep, voffA);
        if (wr == 1) PG8_BAR;
        PG8_WAIT_V(4); PG8_BAR;
        PG8_STAGE(PG8_SB(1, 0), cB + kstep, voffB); PG8_STAGE(PG8_SA(1, 0), cA + kstep, voffA); PG8_STAGE(PG8_SB(1, 1), cB + hstep + kstep, voffB);
        PG8_WAIT_V(6); PG8_BAR;
    }
    for (;;) {
        const bool has_next = S.next(ui + 1, nxt);
        const char* nA = has_next ? (const char*)g.A + (size_t)nxt.pm * tstep : cA; const char* nB = has_next ? (const char*)g.Bt + (size_t)nxt.pn * tstep : cB;
        for (int t = 0; t < nt; t += 2) {
            const bool last = (t == nt - 2);
            const char* a1 = cA + (size_t)(t + 1) * kstep;
            const char* a2 = last ? nA : cA + (size_t)(t + 2) * kstep; const char* b2 = last ? nB : cB + (size_t)(t + 2) * kstep;
            const char* a3 = a2 + kstep; const char* b3 = b2 + kstep;
            if (last && has_next) S.a_ready(nxt);
            if constexpr (SP2) {
            PG8_LDB(B0, 0, 0); PG8_LDB(B1, 0, 1); PG8_SCHED; PG8_LDA(At, 0, 0); PG8_STAGE(PG8_SA(1, 1), a1 + hstep, voffA);
            PG8_WAIT_V(8); PG8_WAIT_L(0); PG8_BAR; PG8_MMA(0, 0, At, B0); PG8_MMA(0, 1, At, B1); PG8_BAR; PG8_SCHED;
            PG8_LDA(At, 0, 1); PG8_STAGE(PG8_SB(0, 0), b2, voffB); PG8_STAGE(PG8_SB(0, 1), b2 + hstep, voffB); PG8_STAGE(PG8_SA(0, 0), a2, voffA);
            PG8_WAIT_V(8); PG8_WAIT_L(0); PG8_BAR; PG8_MMA(1, 0, At, B0); PG8_MMA(1, 1, At, B1); PG8_BAR; PG8_SCHED;
            PG8_LDB(B0, 1, 0); PG8_LDB(B1, 1, 1); PG8_SCHED; PG8_LDA(At, 1, 0); PG8_STAGE(PG8_SA(0, 1), a2 + hstep, voffA);
            PG8_WAIT_V(8); PG8_WAIT_L(0); PG8_BAR; PG8_MMA(0, 0, At, B0); PG8_MMA(0, 1, At, B1); PG8_BAR; PG8_SCHED;
            PG8_LDA(At, 1, 1); PG8_STAGE(PG8_SB(1, 0), b3, voffB); PG8_STAGE(PG8_SB(1, 1), b3 + hstep, voffB); PG8_STAGE(PG8_SA(1, 0), a3, voffA);
            PG8_WAIT_V(8); PG8_WAIT_L(0); PG8_BAR; PG8_MMA(1, 0, At, B0); PG8_MMA(1, 1, At, B1); PG8_BAR; PG8_SCHED;
            } else {
            PG8_LDB(B0, 0, 0); PG8_SCHED; PG8_LDA(At, 0, 0); PG8_STAGE(PG8_SA(1, 1), a1 + hstep, voffA);
            PG8_WAIT_L(8); PG8_BAR; PG8_WAIT_L(0); PG8_MMA(0, 0, At, B0); PG8_BAR; PG8_SCHED;
            PG8_LDB(B1, 0, 1); PG8_STAGE(PG8_SB(0, 0), b2, voffB);
            PG8_BAR; PG8_WAIT_L(0); PG8_MMA(0, 1, At, B1); PG8_BAR;
            PG8_LDA(At, 0, 1); PG8_STAGE(PG8_SA(0, 0), a2, voffA);
            PG8_BAR; PG8_WAIT_L(0); PG8_MMA(1, 0, At, B0); PG8_BAR; PG8_SCHED;
            PG8_STAGE(PG8_SB(0, 1), b2 + hstep, voffB);
            PG8_WAIT_V(6); PG8_BAR; PG8_MMA(1, 1, At, B1); PG8_BAR;
            PG8_LDB(B0, 1, 0); PG8_SCHED; PG8_LDA(At, 1, 0); PG8_STAGE(PG8_SA(0, 1), a2 + hstep, voffA);
            PG8_WAIT_L(8); PG8_BAR; PG8_WAIT_L(0); PG8_MMA(0, 0, At, B0); PG8_BAR; PG8_SCHED;
            PG8_LDB(B1, 1, 1); PG8_STAGE(PG8_SB(1, 0), b3, voffB);
            PG8_BAR; PG8_WAIT_L(0); PG8_MMA(0, 1, At, B1); PG8_BAR;
            PG8_LDA(At, 1, 1); PG8_STAGE(PG8_SA(1, 0), a3, voffA);
            PG8_BAR; PG8_WAIT_L(0); PG8_MMA(1, 0, At, B0); PG8_BAR; PG8_SCHED;
            PG8_STAGE(PG8_SB(1, 1), b3 + hstep, voffB);
            PG8_WAIT_V(6); PG8_BAR; PG8_MMA(1, 1, At, B1); PG8_BAR;
            }
        }
        if constexpr (ALIGN_EPI) { if (wr == 0) PG8_BAR; }
        if constexpr (!Epi::AFTER_DRAIN) { E(acc, cur, wr, wc, fr, fq); S.done(cur); }
        if (!has_next) break;
#pragma unroll
        for (int a = 0; a < 2; ++a)
#pragma unroll
            for (int b = 0; b < 2; ++b)
#pragma unroll
                for (int m = 0; m < 4; ++m)
#pragma unroll
                    for (int n = 0; n < 2; ++n) acc[a][b][m][n] = (f32x4){0.f, 0.f, 0.f, 0.f};
        cur = nxt; cA = nA; cB = nB; ++ui;
        if constexpr (ALIGN_EPI) { if (wr == 1) PG8_BAR; }
    }
    PG8_WAIT_V(0);
    if constexpr (!ALIGN_EPI) { if (wr == 0) PG8_BAR; }
    PG8_BAR;
    if constexpr (Epi::AFTER_DRAIN) { E.fused(acc, cur, wr, wc, fr, fq, lds, wid, lane); S.done(cur); }
#undef PG8_SA
#undef PG8_SB
#undef PG8_STAGE
#undef PG8_LDA
#undef PG8_LDB
#undef PG8_MMA
#undef PG8_WAIT_V
#undef PG8_WAIT_L
#undef PG8_BAR
#undef PG8_SCHED
}
}

namespace cg = cooperative_groups;
using pg8::bf16_t; using pg8::bf16x8; using pg8::f32x4; using pg8::u32x4; using pg8::Unit;
__device__ __forceinline__ unsigned cvt_pk_bf16(float lo, float hi) { unsigned r; asm volatile("v_cvt_pk_bf16_f32 %0, %1, %2" : "=v"(r) : "v"(lo), "v"(hi)); return r; }
#define LAS __attribute__((address_space(3)))
typedef unsigned u32x2 __attribute__((ext_vector_type(2)));
typedef float f32x2v __attribute__((ext_vector_type(2)));

constexpr int M_TOK = 8192, DM = 2048, FF = 5632, HW = 1024, CW = 1024, MIXIN = 7168, PLE = 256, SEQ = 2048;
constexpr float EPS = 1e-6f;
constexpr size_t MiB = 1ull << 20;
constexpr size_t WS_W1GU = 0, WS_W1D = 44 * MiB, WS_WIN = 66 * MiB, WS_WOUT = 94 * MiB, WS_W2GU = 102 * MiB, WS_W2D = 146 * MiB,
                 WS_WPG = 168 * MiB, WS_WPE = 176 * MiB, WS_PB = 177 * MiB, WS_XB = 181 * MiB, WS_MIX = 213 * MiB, WS_G = 245 * MiB,
                 WS_QS = 245 * MiB, WS_VH = 261 * MiB, WS_GH = 277 * MiB, WS_BC = 293 * MiB, WS_UC = 309 * MiB, WS_LF = 325 * MiB,
                 WS_S = 357 * MiB, WS_PLE = 0, WS_SS = 389 * MiB, WS_DD = 389 * MiB + 512 * 1024, WS_BAR = 390 * MiB + 512 * 1024, WS_END = 391 * MiB, WS_U = 0;
constexpr int LDS_BYTES = 144 * 1024;
constexpr int NPHASE = 12;

__device__ __forceinline__ float bf2f(bf16_t b) { return __uint_as_float(((unsigned)b) << 16); }
__device__ __forceinline__ float bflo(unsigned w) { return __uint_as_float(w << 16); }
__device__ __forceinline__ float bfhi(unsigned w) { return __uint_as_float(w & 0xffff0000u); }
__device__ __forceinline__ float wave_sum(float v) {
#pragma unroll
    for (int o = 1; o < 64; o <<= 1) v += __shfl_xor(v, o);
    return v;
}
__device__ __forceinline__ float fsigmoid(float x) { return __builtin_amdgcn_rcpf(1.0f + __expf(-x)); }
__device__ __forceinline__ float fsilu(float x) { return x * fsigmoid(x); }
__device__ __forceinline__ float rinv_of(float ss) { return rsqrtf(ss * (1.0f / DM) + EPS); }

struct EpiGateUp {
    static constexpr bool PERM = true, AFTER_DRAIN = false;
    bf16_t* G; const float* ss;
    __device__ __forceinline__ void operator()(const f32x4 (&acc)[2][2][4][2], const Unit& u, int wr, int wc, int fr, int fq) const {
        const int row0 = u.pm * 256 + wr * 64 + fr, col0 = u.pn * 128 + wc * 32 + 8 * fq;
#pragma unroll
        for (int ai = 0; ai < 2; ++ai)
#pragma unroll
            for (int m = 0; m < 4; ++m) {
                const int r = row0 + ai * 128 + m * 16; const float ri = rinv_of(ss[r]);
                float v[8];
#pragma unroll
                for (int n = 0; n < 2; ++n)
#pragma unroll
                    for (int j = 0; j < 4; ++j) v[n * 4 + j] = fsilu(acc[ai][0][m][n][j] * ri) * (acc[ai][1][m][n][j] * ri);
                u32x4 w; w.x = cvt_pk_bf16(v[0], v[1]); w.y = cvt_pk_bf16(v[2], v[3]); w.z = cvt_pk_bf16(v[4], v[5]); w.w = cvt_pk_bf16(v[6], v[7]);
                *(u32x4*)(G + (size_t)r * FF + col0) = w;
            }
    }
};
struct EpiResid {
    static constexpr bool PERM = true, AFTER_DRAIN = false;
    const float* R; float* H; bf16_t* XB; float* ss_out; float scale;
    __device__ __forceinline__ void operator()(f32x4 (&acc)[2][2][4][2], const Unit& u, int wr, int wc, int fr, int fq) const {
        const int row0 = u.pm * 256 + wr * 64 + fr, col0 = u.pn * 256 + wc * 32 + 8 * fq;
#pragma unroll
        for (int ai = 0; ai < 2; ++ai) {
#pragma unroll
            for (int m = 0; m < 4; ++m)
#pragma unroll
                for (int bj = 0; bj < 2; ++bj) {
                    const size_t off = (size_t)(row0 + ai * 128 + m * 16) * DM + col0 + bj * 128;
                    acc[ai][bj][m][0] = *(const f32x4*)(R + off) + acc[ai][bj][m][0] * scale; acc[ai][bj][m][1] = *(const f32x4*)(R + off + 4) + acc[ai][bj][m][1] * scale;
                }
            asm volatile("" ::: "memory");
#pragma unroll
            for (int m = 0; m < 4; ++m) {
                const int r = row0 + ai * 128 + m * 16; float sq = 0.f;
#pragma unroll
                for (int bj = 0; bj < 2; ++bj) {
                    const size_t off = (size_t)r * DM + col0 + bj * 128;
                    const f32x4 v0 = acc[ai][bj][m][0], v1 = acc[ai][bj][m][1];
                    *(f32x4*)(H + off) = v0; *(f32x4*)(H + off + 4) = v1;
                    u32x4 w; w.x = cvt_pk_bf16(v0[0], v0[1]); w.y = cvt_pk_bf16(v0[2], v0[3]); w.z = cvt_pk_bf16(v1[0], v1[1]); w.w = cvt_pk_bf16(v1[2], v1[3]);
                    *(u32x4*)(XB + off) = w;
                    sq += (v0[0] * v0[0] + v0[1] * v0[1]) + (v0[2] * v0[2] + v0[3] * v0[3]) + (v1[0] * v1[0] + v1[1] * v1[1]) + (v1[2] * v1[2] + v1[3] * v1[3]);
                }
                sq += __shfl_xor(sq, 16); sq += __shfl_xor(sq, 32);
                if (fq == 0) atomicAdd(ss_out + r, sq);
            }
            asm volatile("" ::: "memory");
        }
    }
};
struct EpiMixIn {
    static constexpr bool PERM = true, AFTER_DRAIN = false;
    const float* ss; const float* lbl;
    bf16_t *QS, *UC; float* LF;
    __device__ __forceinline__ void operator()(const f32x4 (&acc)[2][2][4][2], const Unit& u, int wr, int wc, int fr, int fq) const {
        const int row0 = u.pm * 256 + wr * 64 + fr; const int sec = u.pn >> 2;
        if (u.pn >= 20) {
            const int col0 = (u.pn - 20) * 128 + wc * 32 + 8 * fq;
#pragma unroll
            for (int ai = 0; ai < 2; ++ai)
#pragma unroll
                for (int m = 0; m < 4; ++m) {
                    const int r = row0 + ai * 128 + m * 16; const float ri = rinv_of(ss[r]); const float ri2 = ri * ri;
                    float v[8];
#pragma unroll
                    for (int n = 0; n < 2; ++n)
#pragma unroll
                        for (int j = 0; j < 4; ++j) v[n * 4 + j] = acc[ai][0][m][n][j] * acc[ai][1][m][n][j] * ri2;
                    u32x4 w; w.x = cvt_pk_bf16(v[0], v[1]); w.y = cvt_pk_bf16(v[2], v[3]); w.z = cvt_pk_bf16(v[4], v[5]); w.w = cvt_pk_bf16(v[6], v[7]);
                    *(u32x4*)(UC + (size_t)r * CW + col0) = w;
                }
            return;
        }
        const int col0 = (u.pn & 3) * 256 + wc * 32 + 8 * fq;
        if (sec == 1) {
#pragma unroll
            for (int bj = 0; bj < 2; ++bj)
#pragma unroll
                for (int n = 0; n < 2; ++n) {
                    const int c = col0 + bj * 128 + 4 * n; const f32x4 l0 = *(const f32x4*)(lbl + c), l1 = *(const f32x4*)(lbl + 1024 + c);
                    f32x4 lb; lb[0] = fsigmoid(l0[0] - l1[0]); lb[1] = fsigmoid(l0[1] - l1[1]); lb[2] = fsigmoid(l0[2] - l1[2]); lb[3] = fsigmoid(l0[3] - l1[3]);
#pragma unroll
                    for (int ai = 0; ai < 2; ++ai)
#pragma unroll
                        for (int m = 0; m < 4; ++m) {
                            const int r = row0 + ai * 128 + m * 16; const float ri = rinv_of(ss[r]);
                            const f32x4 x = acc[ai][bj][m][n]; f32x4 o;
                            o[0] = __logf(lb[0] + (1.0f - lb[0]) * fsigmoid(x[0] * ri)); o[1] = __logf(lb[1] + (1.0f - lb[1]) * fsigmoid(x[1] * ri));
                            o[2] = __logf(lb[2] + (1.0f - lb[2]) * fsigmoid(x[2] * ri)); o[3] = __logf(lb[3] + (1.0f - lb[3]) * fsigmoid(x[3] * ri));
                            *(f32x4*)(LF + (size_t)r * HW + c) = o;
                        }
                }
            return;
        }
        bf16_t* dst = QS + (size_t)(sec == 0 ? 0 : sec - 1) * ((size_t)M_TOK * HW);
        const bool act = (sec == 0 || sec == 3);
#pragma unroll
        for (int ai = 0; ai < 2; ++ai)
#pragma unroll
            for (int m = 0; m < 4; ++m) {
                const int r = row0 + ai * 128 + m * 16; const float ri = rinv_of(ss[r]);
#pragma unroll
                for (int bj = 0; bj < 2; ++bj) {
                    float v[8];
#pragma unroll
                    for (int n = 0; n < 2; ++n)
#pragma unroll
                        for (int j = 0; j < 4; ++j) { const float x = acc[ai][bj][m][n][j] * ri; v[n * 4 + j] = act ? fsilu(x) : x; }
                    u32x4 w; w.x = cvt_pk_bf16(v[0], v[1]); w.y = cvt_pk_bf16(v[2], v[3]); w.z = cvt_pk_bf16(v[4], v[5]); w.w = cvt_pk_bf16(v[6], v[7]);
                    *(u32x4*)(dst + (size_t)r * HW + col0 + bj * 128) = w;
                }
            }
    }
};
struct EpiStoreBf16 {
    static constexpr bool PERM = true, AFTER_DRAIN = false;
    bf16_t* O;
    __device__ __forceinline__ void operator()(const f32x4 (&acc)[2][2][4][2], const Unit& u, int wr, int wc, int fr, int fq) const {
        const int row0 = u.pm * 256 + wr * 64 + fr, col0 = u.pn * 256 + wc * 32 + 8 * fq;
#pragma unroll
        for (int ai = 0; ai < 2; ++ai)
#pragma unroll
            for (int m = 0; m < 4; ++m) {
                const int r = row0 + ai * 128 + m * 16;
#pragma unroll
                for (int bj = 0; bj < 2; ++bj) {
                    const f32x4 v0 = acc[ai][bj][m][0], v1 = acc[ai][bj][m][1];
                    u32x4 w; w.x = cvt_pk_bf16(v0[0], v0[1]); w.y = cvt_pk_bf16(v0[2], v0[3]); w.z = cvt_pk_bf16(v1[0], v1[1]); w.w = cvt_pk_bf16(v1[2], v1[3]);
                    *(u32x4*)(O + (size_t)r * DM + col0 + bj * 128) = w;
                }
            }
    }
};
struct EpiPleGate {
    static constexpr bool PERM = true, AFTER_DRAIN = false;
    float* H; const bf16_t* P; const float* ss;
    __device__ __forceinline__ void operator()(f32x4 (&acc)[2][2][4][2], const Unit& u, int wr, int wc, int fr, int fq) const {
        const int row0 = u.pm * 256 + wr * 64 + fr, col0 = u.pn * 256 + wc * 32 + 8 * fq;
#pragma unroll
        for (int ai = 0; ai < 2; ++ai) {
#pragma unroll
            for (int m = 0; m < 4; ++m) {
                const int r = row0 + ai * 128 + m * 16; const float ri = rinv_of(ss[r]);
#pragma unroll
                for (int bj = 0; bj < 2; ++bj) {
                    const size_t off = (size_t)r * DM + col0 + bj * 128;
                    const u32x4 pw = *(const u32x4*)(P + off);
                    f32x4 v0 = *(const f32x4*)(H + off), v1 = *(const f32x4*)(H + off + 4);
                    const f32x4 a0 = acc[ai][bj][m][0], a1 = acc[ai][bj][m][1];
                    v0[0] += fsigmoid(a0[0] * ri) * bflo(pw.x); v0[1] += fsigmoid(a0[1] * ri) * bfhi(pw.x);
                    v0[2] += fsigmoid(a0[2] * ri) * bflo(pw.y); v0[3] += fsigmoid(a0[3] * ri) * bfhi(pw.y);
                    v1[0] += fsigmoid(a1[0] * ri) * bflo(pw.z); v1[1] += fsigmoid(a1[1] * ri) * bfhi(pw.z);
                    v1[2] += fsigmoid(a1[2] * ri) * bflo(pw.w); v1[3] += fsigmoid(a1[3] * ri) * bfhi(pw.w);
                    acc[ai][bj][m][0] = v0; acc[ai][bj][m][1] = v1;
                }
            }
            asm volatile("" ::: "memory");
#pragma unroll
            for (int m = 0; m < 4; ++m)
#pragma unroll
                for (int bj = 0; bj < 2; ++bj) {
                    const size_t off = (size_t)(row0 + ai * 128 + m * 16) * DM + col0 + bj * 128;
                    *(f32x4*)(H + off) = acc[ai][bj][m][0]; *(f32x4*)(H + off + 4) = acc[ai][bj][m][1];
                }
            asm volatile("" ::: "memory");
        }
    }
};

template <int MODE>
__device__ __forceinline__ void p0_item(const float* W, const float* W2, const float* gain, int K, int N, bf16_t* WT, LAS float* scr, int item, int lane) {
    const int nblk_k = K / 64; const int nb = item / nblk_k, kb = item % nblk_k; const int k0 = 64 * kb, n0 = 32 * nb;
    const float* src = W; int c0 = n0;
    if (MODE == 1) { const int t = n0 >> 8, bj = (n0 >> 7) & 1, c = n0 & 127; src = bj ? W2 : W; c0 = 128 * t + c; }
    if (MODE == 2) { if (n0 >= 5120) { const int tt = n0 - 5120; const int t = tt >> 8, bj = (tt >> 7) & 1, c = tt & 127; c0 = 5120 + 1024 * bj + 128 * t + c; } }
    float v[32], gg[32];
    const float* sp = src + (size_t)(k0 + (lane >> 5)) * N + c0 + (lane & 31);
#pragma unroll
    for (int i = 0; i < 32; ++i) v[i] = sp[(size_t)(2 * i) * N];
    if (gain) {
#pragma unroll
        for (int i = 0; i < 32; ++i) gg[i] = gain[k0 + 2 * i + (lane >> 5)];
#pragma unroll
        for (int i = 0; i < 32; ++i) v[i] *= gg[i];
    }
#pragma unroll
    for (int i = 0; i < 32; ++i) scr[(2 * i + (lane >> 5)) * 33 + (lane & 31)] = v[i];
    asm volatile("s_waitcnt lgkmcnt(0)" ::: "memory");
    const int c = lane & 7;
#pragma unroll
    for (int j = 0; j < 4; ++j) { const int n = (lane >> 3) + 8 * j; const LAS float* s = scr + (8 * c) * 33 + n;
        u32x4 o; o.x = cvt_pk_bf16(s[0 * 33], s[1 * 33]); o.y = cvt_pk_bf16(s[2 * 33], s[3 * 33]); o.z = cvt_pk_bf16(s[4 * 33], s[5 * 33]); o.w = cvt_pk_bf16(s[6 * 33], s[7 * 33]);
        *(u32x4*)(WT + (size_t)(n0 + n) * K + k0 + 8 * c) = o; }
    asm volatile("s_waitcnt lgkmcnt(0)" ::: "memory");
}

struct Args { const float* in[21]; float* out; unsigned char* ws; int ph_lo, ph_hi; };

constexpr int CV_I0 = 32 * 352, CV_I1 = 88 * 64, CV_I2 = 32 * 224, CV_I3 = 32 * 64, CV_I7 = 4 * 64;
constexpr int CV_END = 2 * CV_I0 + 2 * CV_I1 + CV_I2 + 2 * CV_I3 + CV_I7, CV_T1 = CV_END - 10000, CV_T0 = CV_T1 - 10000;
__device__ __forceinline__ void conv_range(const Args& a, LAS unsigned char* lds, int wave, int lane, int lo, int hi, int w0, int nw) {
    unsigned char* ws = a.ws;
    LAS float* scr = (LAS float*)(lds + wave * 16384);
    for (int it = lo + w0; it < hi; it += nw) {
        int r = it;
        if (r < CV_I0) { p0_item<1>(a.in[3], a.in[4], a.in[2], DM, FF, (bf16_t*)(ws + WS_W1GU), scr, r, lane); continue; } r -= CV_I0;
        if (r < CV_I2) { p0_item<2>(a.in[7], nullptr, a.in[6], DM, MIXIN, (bf16_t*)(ws + WS_WIN), scr, r, lane); continue; } r -= CV_I2;
        if (r < CV_I3) { p0_item<0>(a.in[12], nullptr, nullptr, DM, DM, (bf16_t*)(ws + WS_WOUT), scr, r, lane); continue; } r -= CV_I3;
        if (r < CV_I3) { p0_item<0>(a.in[19], nullptr, a.in[17], DM, DM, (bf16_t*)(ws + WS_WPG), scr, r, lane); continue; } r -= CV_I3;
        if (r < CV_I7) { p0_item<0>(a.in[18], nullptr, nullptr, PLE, DM, (bf16_t*)(ws + WS_WPE), scr, r, lane); continue; } r -= CV_I7;
        if (r < CV_I1) { p0_item<0>(a.in[16], nullptr, nullptr, FF, DM, (bf16_t*)(ws + WS_W2D), scr, r, lane); continue; } r -= CV_I1;
        if (r < CV_I0) { p0_item<1>(a.in[14], a.in[15], a.in[13], DM, FF, (bf16_t*)(ws + WS_W2GU), scr, r, lane); continue; } r -= CV_I0;
        p0_item<0>(a.in[5], nullptr, nullptr, FF, DM, (bf16_t*)(ws + WS_W1D), scr, r, lane);
    }
}
__device__ __forceinline__ void conv_tail(const Args& a, LAS unsigned char* lds, int wave, int lane, int nunits, int lo, int hi, int vc) {
    const int r = nunits % (int)gridDim.x;
    if (r == 0) { conv_range(a, lds, wave, lane, lo, hi, vc * 8 + wave, gridDim.x * 8); return; }
    if (vc >= r) conv_range(a, lds, wave, lane, lo, hi, (vc - r) * 8 + wave, ((int)gridDim.x - r) * 8);
}

__device__ __forceinline__ void phase0(const Args& a, LAS unsigned char* lds, int wave, int lane) {
    unsigned char* ws = a.ws;
    const int gw = blockIdx.x * 8 + wave, NGW = gridDim.x * 8;
    conv_range(a, lds, wave, lane, 0, CV_T0, gw, NGW);
    float* SS = (float*)(ws + WS_SS);
    for (int m = gw; m < M_TOK; m += NGW) {
        const f32x4* xr = (const f32x4*)(a.in[0] + (size_t)m * DM) + lane; u32x2* xb = (u32x2*)((bf16_t*)(ws + WS_XB) + (size_t)m * DM) + lane;
        float s = 0.f;
#pragma unroll
        for (int j = 0; j < 8; ++j) { const f32x4 v = xr[64 * j]; s += (v[0] * v[0] + v[1] * v[1]) + (v[2] * v[2] + v[3] * v[3]);
            u32x2 w; w.x = cvt_pk_bf16(v[0], v[1]); w.y = cvt_pk_bf16(v[2], v[3]); xb[64 * j] = w; }
        s = wave_sum(s);
        if (lane == 0) { SS[m] = s; SS[8192 + m] = 0.f; SS[16384 + m] = 0.f; SS[24576 + m] = 0.f; }
    }
    { const int gt = blockIdx.x * 512 + threadIdx.x, NT = gridDim.x * 512;
      for (int i = gt; i < M_TOK * PLE / 4; i += NT) { const f32x4 v = ((const f32x4*)a.in[1])[i]; u32x2 w; w.x = cvt_pk_bf16(v[0], v[1]); w.y = cvt_pk_bf16(v[2], v[3]); ((u32x2*)(ws + WS_PB))[i] = w; } }
}

constexpr int HP = 136, VP = 72;
constexpr int L_QT = 0, L_QH = L_QT + 64 * HP * 2, L_KA = L_QH + 64 * HP * 2, L_KB = L_KA + 64 * HP * 2, L_ST = L_KB + 32 * HP * 2, L_VT = L_ST + 128 * HP * 2,
              L_P = L_VT + 128 * VP * 2, L_SEG = L_P + 64 * VP * 2, L_PART = L_SEG + 4 * 128 * 4, L_RINV = L_PART + 8 * 64 * 4, L_HEND = L_RINV + 256, L_KT = 0;
static_assert(L_HEND <= LDS_BYTES, "LDS");
#define MFMA16(a, b, c) __builtin_amdgcn_mfma_f32_16x16x32_bf16((a), (b), (c), 0, 0, 0)
__device__ __forceinline__ bf16_t f2bf(float x) { return (bf16_t)(cvt_pk_bf16(x, 0.f) & 0xffffu); }

__device__ __forceinline__ void hgrn_pass_a(const Args& a, LAS unsigned char* lds, int wave, int lane) {
    unsigned char* ws = a.ws;
    const float* LF = (const float*)(ws + WS_LF); const bf16_t* VH = (const bf16_t*)(ws + WS_VH); float* U = (float*)(ws + WS_U); float* Dd = (float*)(ws + WS_DD);
    const int tid = threadIdx.x, k = tid & 127, sg = tid >> 7, fr = lane & 15, fq = lane >> 4;
    LAS bf16_t* VT = (LAS bf16_t*)(lds + L_VT); LAS bf16_t* KT = (LAS bf16_t*)(lds + L_KT); LAS float* SEG = (LAS float*)(lds + L_SEG);
    for (int item = blockIdx.x; item < 1024; item += gridDim.x) {
        const int row0 = (item >> 3) * 64, cb = (item & 7) * 128;
        float lf[16], b[16];
#pragma unroll
        for (int i = 0; i < 16; ++i) lf[i] = LF[(size_t)(row0 + 16 * sg + i) * HW + cb + k];
        u32x4 vv[2];
#pragma unroll
        for (int j = 0; j < 2; ++j) { const int idx = tid + 512 * j; vv[j] = *(const u32x4*)(VH + (size_t)(row0 + (idx >> 4)) * HW + cb + 8 * (idx & 15)); }
        float run = 0.f;
#pragma unroll
        for (int i = 0; i < 16; ++i) { run += lf[i]; b[i] = run; }
        SEG[sg * 128 + k] = run;
        __syncthreads();
        const float s0 = SEG[k], s1 = SEG[128 + k], s2 = SEG[256 + k], s3 = SEG[384 + k];
        const float pre = sg == 0 ? 0.f : (sg == 1 ? s0 : (sg == 2 ? s0 + s1 : s0 + s1 + s2));
        const float blast = s0 + s1 + s2 + s3;
        unsigned pk[8];
#pragma unroll
        for (int i = 0; i < 8; ++i) {
            const float e0 = (1.0f - __expf(lf[2 * i])) * __expf(blast - (pre + b[2 * i])), e1 = (1.0f - __expf(lf[2 * i + 1])) * __expf(blast - (pre + b[2 * i + 1]));
            pk[i] = cvt_pk_bf16(e0, e1); }
        { u32x4 w0, w1; w0.x = pk[0]; w0.y = pk[1]; w0.z = pk[2]; w0.w = pk[3]; w1.x = pk[4]; w1.y = pk[5]; w1.z = pk[6]; w1.w = pk[7];
          *(LAS u32x4*)(KT + k * VP + 16 * sg) = w0; *(LAS u32x4*)(KT + k * VP + 16 * sg + 8) = w1; }
#pragma unroll
        for (int j = 0; j < 2; ++j) { const int idx = tid + 512 * j, s = idx >> 4, v0 = 8 * (idx & 15);
            VT[(v0 + 0) * VP + s] = (bf16_t)(vv[j].x & 0xffffu); VT[(v0 + 1) * VP + s] = (bf16_t)(vv[j].x >> 16);
            VT[(v0 + 2) * VP + s] = (bf16_t)(vv[j].y & 0xffffu); VT[(v0 + 3) * VP + s] = (bf16_t)(vv[j].y >> 16);
            VT[(v0 + 4) * VP + s] = (bf16_t)(vv[j].z & 0xffffu); VT[(v0 + 5) * VP + s] = (bf16_t)(vv[j].z >> 16);
            VT[(v0 + 6) * VP + s] = (bf16_t)(vv[j].w & 0xffffu); VT[(v0 + 7) * VP + s] = (bf16_t)(vv[j].w >> 16); }
        if (sg == 0) Dd[item * 128 + k] = __expf(blast);
        __syncthreads();
        const bf16x8 a0 = *(const LAS bf16x8*)(VT + (16 * wave + fr) * VP + fq * 8), a1 = *(const LAS bf16x8*)(VT + (16 * wave + fr) * VP + 32 + fq * 8);
        float* up = U + (size_t)item * 16384 + (16 * wave + 4 * fq) * 128 + fr;
#pragma unroll
        for (int kt = 0; kt < 8; ++kt) {
            const bf16x8 b0 = *(const LAS bf16x8*)(KT + (16 * kt + fr) * VP + fq * 8), b1 = *(const LAS bf16x8*)(KT + (16 * kt + fr) * VP + 32 + fq * 8);
            f32x4 acc = {0.f, 0.f, 0.f, 0.f};
            acc = MFMA16(a0, b0, acc); acc = MFMA16(a1, b1, acc);
            up[16 * kt] = acc[0]; up[16 * kt + 128] = acc[1]; up[16 * kt + 256] = acc[2]; up[16 * kt + 384] = acc[3];
        }
        __syncthreads();
    }
}

__device__ __forceinline__ void hgrn_scan(const Args& a) {
    unsigned char* ws = a.ws;
    const float* U = (const float*)(ws + WS_U); const float* Dd = (const float*)(ws + WS_DD); bf16_t* SP = (bf16_t*)(ws + WS_S);
    for (int e = (blockIdx.x * 512 + threadIdx.x) * 4; e < 32 * 16384; e += gridDim.x * 512 * 4) {
        const int bh = e >> 14, vk = e & 16383, bb = bh >> 3, h = bh & 7;
        f32x4 S = {0.f, 0.f, 0.f, 0.f};
#pragma unroll 8
        for (int ci = 0; ci < 32; ++ci) {
            const size_t item = (size_t)((bb * 32 + ci) * 8 + h);
            const f32x4 u = *(const f32x4*)(U + item * 16384 + vk); const f32x4 d = *(const f32x4*)(Dd + item * 128 + (vk & 127));
            u32x2 w; w.x = cvt_pk_bf16(S[0], S[1]); w.y = cvt_pk_bf16(S[2], S[3]); *(u32x2*)(SP + item * 16384 + vk) = w;
            S = d * S + u;
        }
    }
}

__device__ __forceinline__ void conv_mixer(const Args& a, int wave, int lane) {
    unsigned char* ws = a.ws;
    const bf16_t* BC = (const bf16_t*)(ws + WS_BC); const bf16_t* UC = (const bf16_t*)(ws + WS_UC); bf16_t* MIX = (bf16_t*)(ws + WS_MIX);
    const float* cn = a.in[11]; const float* cw = a.in[8];
    const int gw = blockIdx.x * 8 + wave, NGW = gridDim.x * 8;
    for (int it = gw; it < M_TOK * 2; it += NGW) {
        const int row = it >> 1, c = (it & 1) * 512 + lane * 8, t = row & (SEQ - 1);
        const size_t off = (size_t)row * CW + c;
        const u32x4 z = {0u, 0u, 0u, 0u};
        const u32x4 u0 = *(const u32x4*)(UC + off), u1 = t >= 1 ? *(const u32x4*)(UC + off - CW) : z, u2 = t >= 2 ? *(const u32x4*)(UC + off - 2 * CW) : z, bg = *(const u32x4*)(BC + off);
        float y[8]; float ssq = 0.f;
#pragma unroll
        for (int q = 0; q < 4; ++q) {
            const unsigned a0 = u0[q], a1 = u1[q], a2 = u2[q], bb = bg[q]; const int cc = c + 2 * q;
            y[2 * q] = bflo(bb) * (cw[cc] * bflo(a2) + cw[CW + cc] * bflo(a1) + cw[2 * CW + cc] * bflo(a0));
            y[2 * q + 1] = bfhi(bb) * (cw[cc + 1] * bfhi(a2) + cw[CW + cc + 1] * bfhi(a1) + cw[2 * CW + cc + 1] * bfhi(a0));
            ssq += y[2 * q] * y[2 * q] + y[2 * q + 1] * y[2 * q + 1];
        }
        ssq += __shfl_xor(ssq, 1); ssq += __shfl_xor(ssq, 2); ssq += __shfl_xor(ssq, 4); ssq += __shfl_xor(ssq, 8);
        const float ri = rsqrtf(ssq * (1.0f / 128) + EPS);
        u32x4 w;
        w.x = cvt_pk_bf16(y[0] * ri * cn[c], y[1] * ri * cn[c + 1]); w.y = cvt_pk_bf16(y[2] * ri * cn[c + 2], y[3] * ri * cn[c + 3]);
        w.z = cvt_pk_bf16(y[4] * ri * cn[c + 4], y[5] * ri * cn[c + 5]); w.w = cvt_pk_bf16(y[6] * ri * cn[c + 6], y[7] * ri * cn[c + 7]);
        *(u32x4*)(MIX + (size_t)row * DM + HW + c) = w;
    }
}

__device__ __forceinline__ void hgrn_pass_c(const Args& a, LAS unsigned char* lds, int wave, int lane) {
    unsigned char* ws = a.ws;
    const float* LF = (const float*)(ws + WS_LF); const bf16_t* VH = (const bf16_t*)(ws + WS_VH); const bf16_t* QS = (const bf16_t*)(ws + WS_QS); const bf16_t* GH = (const bf16_t*)(ws + WS_GH);
    const bf16_t* SP = (const bf16_t*)(ws + WS_S); bf16_t* MIX = (bf16_t*)(ws + WS_MIX); const float* hn = a.in[10];
    const int tid = threadIdx.x, k = tid & 127, sg = tid >> 7, fr = lane & 15, fq = lane >> 4;
    LAS bf16_t* QT = (LAS bf16_t*)(lds + L_QT); LAS bf16_t* QH = (LAS bf16_t*)(lds + L_QH); LAS bf16_t* KA = (LAS bf16_t*)(lds + L_KA); LAS bf16_t* KB = (LAS bf16_t*)(lds + L_KB);
    LAS bf16_t* ST = (LAS bf16_t*)(lds + L_ST); LAS bf16_t* VT = (LAS bf16_t*)(lds + L_VT); LAS bf16_t* P = (LAS bf16_t*)(lds + L_P);
    LAS float* SEG = (LAS float*)(lds + L_SEG); LAS float* PART = (LAS float*)(lds + L_PART); LAS float* RINV = (LAS float*)(lds + L_RINV);
    for (int item = blockIdx.x; item < 1024; item += gridDim.x) {
        const int row0 = (item >> 3) * 64, cb = (item & 7) * 128;
        float lf[16], b[16]; bf16_t qh[16];
#pragma unroll
        for (int i = 0; i < 16; ++i) { lf[i] = LF[(size_t)(row0 + 16 * sg + i) * HW + cb + k]; qh[i] = QS[(size_t)(row0 + 16 * sg + i) * HW + cb + k]; }
        u32x4 vv[2], sv[4];
#pragma unroll
        for (int j = 0; j < 2; ++j) { const int idx = tid + 512 * j; vv[j] = *(const u32x4*)(VH + (size_t)(row0 + (idx >> 4)) * HW + cb + 8 * (idx & 15)); }
#pragma unroll
        for (int j = 0; j < 4; ++j) { const int idx = tid + 512 * j; sv[j] = *(const u32x4*)(SP + (size_t)item * 16384 + (idx >> 4) * 128 + 8 * (idx & 15)); }
        float run = 0.f;
#pragma unroll
        for (int i = 0; i < 16; ++i) { run += lf[i]; b[i] = run; }
        SEG[sg * 128 + k] = run;
        __syncthreads();
        const float s0 = SEG[k], s1 = SEG[128 + k], s2 = SEG[256 + k];
        const float pre = sg == 0 ? 0.f : (sg == 1 ? s0 : (sg == 2 ? s0 + s1 : s0 + s1 + s2));
        const float beta1 = s0 + s1, beta = sg >= 2 ? beta1 : 0.f;
#pragma unroll
        for (int i = 0; i < 16; ++i) {
            const int s = 16 * sg + i; const float bi = pre + b[i], kk = 1.0f - __expf(lf[i]), qv = bf2f(qh[i]);
            QT[s * HP + k] = f2bf(qv * __expf(bi - beta)); QH[s * HP + k] = f2bf(qv * __expf(bi));
            KA[s * HP + k] = f2bf(kk * __expf(fminf(beta - bi, 80.f)));
            if (sg < 2) KB[s * HP + k] = f2bf(kk * __expf(beta1 - bi));
        }
#pragma unroll
        for (int j = 0; j < 2; ++j) { const int idx = tid + 512 * j, s = idx >> 4, v0 = 8 * (idx & 15);
            VT[(v0 + 0) * VP + s] = (bf16_t)(vv[j].x & 0xffffu); VT[(v0 + 1) * VP + s] = (bf16_t)(vv[j].x >> 16);
            VT[(v0 + 2) * VP + s] = (bf16_t)(vv[j].y & 0xffffu); VT[(v0 + 3) * VP + s] = (bf16_t)(vv[j].y >> 16);
            VT[(v0 + 4) * VP + s] = (bf16_t)(vv[j].z & 0xffffu); VT[(v0 + 5) * VP + s] = (bf16_t)(vv[j].z >> 16);
            VT[(v0 + 6) * VP + s] = (bf16_t)(vv[j].w & 0xffffu); VT[(v0 + 7) * VP + s] = (bf16_t)(vv[j].w >> 16); }
#pragma unroll
        for (int j = 0; j < 4; ++j) { const int idx = tid + 512 * j; *(LAS u32x4*)(ST + (idx >> 4) * HP + 8 * (idx & 15)) = sv[j]; }
        __syncthreads();
#pragma unroll
        for (int pp = 0; pp < 2; ++pp) {
            const int p = wave + 8 * pp, tt = p >> 2, st = p & 3;
            f32x4 acc = {0.f, 0.f, 0.f, 0.f};
            if (st <= tt) {
                const LAS bf16_t* kb = (tt >= 2 && st < 2) ? KB : KA;
#pragma unroll
                for (int ks = 0; ks < 4; ++ks) { const bf16x8 af = *(const LAS bf16x8*)(QT + (16 * tt + fr) * HP + ks * 32 + fq * 8), bfr = *(const LAS bf16x8*)(kb + (16 * st + fr) * HP + ks * 32 + fq * 8);
                    acc = MFMA16(af, bfr, acc); }
            }
#pragma unroll
            for (int r = 0; r < 4; ++r) { const bool keep = (st < tt) || (st == tt && fr <= 4 * fq + r); P[(16 * tt + 4 * fq + r) * VP + 16 * st + fr] = f2bf(keep ? acc[r] : 0.f); }
        }
        __syncthreads();
        bf16x8 bs[4], bv[2];
#pragma unroll
        for (int ks = 0; ks < 4; ++ks) bs[ks] = *(const LAS bf16x8*)(ST + (16 * wave + fr) * HP + ks * 32 + fq * 8);
#pragma unroll
        for (int ks = 0; ks < 2; ++ks) bv[ks] = *(const LAS bf16x8*)(VT + (16 * wave + fr) * VP + ks * 32 + fq * 8);
        f32x4 o[4];
#pragma unroll
        for (int tt = 0; tt < 4; ++tt) {
            f32x4 acc = {0.f, 0.f, 0.f, 0.f};
#pragma unroll
            for (int ks = 0; ks < 4; ++ks) { const bf16x8 af = *(const LAS bf16x8*)(QH + (16 * tt + fr) * HP + ks * 32 + fq * 8); acc = MFMA16(af, bs[ks], acc); }
            { const bf16x8 af = *(const LAS bf16x8*)(P + (16 * tt + fr) * VP + fq * 8); acc = MFMA16(af, bv[0], acc); }
            if (tt >= 2) { const bf16x8 af = *(const LAS bf16x8*)(P + (16 * tt + fr) * VP + 32 + fq * 8); acc = MFMA16(af, bv[1], acc); }
            o[tt] = acc;
        }
#pragma unroll
        for (int tt = 0; tt < 4; ++tt)
#pragma unroll
            for (int r = 0; r < 4; ++r) { float x = o[tt][r] * o[tt][r]; x += __shfl_xor(x, 1); x += __shfl_xor(x, 2); x += __shfl_xor(x, 4); x += __shfl_xor(x, 8);
                if (fr == 0) PART[wave * 64 + 16 * tt + 4 * fq + r] = x; }
        __syncthreads();
        if (tid < 64) { float s = 0.f;
#pragma unroll
            for (int w = 0; w < 8; ++w) s += PART[w * 64 + tid];
            RINV[tid] = rsqrtf(s * (1.0f / 128) + EPS); }
        __syncthreads();
        const float hnv = hn[16 * wave + fr];
#pragma unroll
        for (int tt = 0; tt < 4; ++tt)
#pragma unroll
            for (int r = 0; r < 4; ++r) { const int t = 16 * tt + 4 * fq + r; const size_t row = (size_t)(row0 + t);
                const float g = bf2f(GH[row * HW + cb + 16 * wave + fr]);
                MIX[row * DM + cb + 16 * wave + fr] = f2bf(o[tt][r] * RINV[t] * hnv * g); }
        __syncthreads();
    }
}

__device__ __forceinline__ void phase_final(const Args& a, int wave, int lane) {
    const int gw = blockIdx.x * 8 + wave, NGW = gridDim.x * 8; const float* gF = a.in[20];
    for (int m = gw; m < M_TOK; m += NGW) {
        f32x4* xr = (f32x4*)(a.out + (size_t)m * DM) + lane; f32x4 v[8]; float s = 0.f;
#pragma unroll
        for (int j = 0; j < 8; ++j) { v[j] = xr[64 * j]; s += (v[j][0] * v[j][0] + v[j][1] * v[j][1]) + (v[j][2] * v[j][2] + v[j][3] * v[j][3]); }
        const float ri = rinv_of(wave_sum(s));
#pragma unroll
        for (int j = 0; j < 8; ++j) { const f32x4 g = ((const f32x4*)gF)[64 * j + lane]; xr[64 * j] = v[j] * ri * g; }
    }
}

#define XB_TMO      128
#define XB_XCNT(j)  (256  + 64 * (j))
#define XB_XSUB(j)  (1280 + 64 * (j))
#define XB_XGEN(j)  (2304 + 64 * (j))
#define XB_TOP      3328
#define XB_TOPGEN   3392
#define XCD_BAR_WORDS 3456
#define XB_SPIN_CAP (1u << 18)

__device__ __forceinline__ unsigned xb_ld(unsigned* p)              { return __hip_atomic_load(p, __ATOMIC_RELAXED, __HIP_MEMORY_SCOPE_AGENT); }
__device__ __forceinline__ unsigned xb_add(unsigned* p, unsigned v) { return __hip_atomic_fetch_add(p, v, __ATOMIC_RELAXED, __HIP_MEMORY_SCOPE_AGENT); }
__device__ __forceinline__ unsigned xb_xcc_id() { return (unsigned)__builtin_amdgcn_s_getreg((3 << 11) | 20) & 0xFu; }
#define XB_SPIN(cond, bar) do { unsigned _sp = 0; while (cond) { __builtin_amdgcn_s_sleep(1); \
    if ((++_sp & 255u) == 0u) { if (xb_ld(&(bar)[XB_TMO])) break; if (_sp > XB_SPIN_CAP) { atomicAdd(&(bar)[XB_TMO], 1u); break; } } } } while (0)

struct XcdBarrier {
    unsigned* bar; unsigned x;
    volatile LAS unsigned* st;
};

__device__ __forceinline__ XcdBarrier xcd_barrier_post(unsigned* bar, volatile LAS unsigned* st) {
    XcdBarrier b; b.bar = bar; b.x = xb_xcc_id(); b.st = st;
    if (threadIdx.x == 0) (void)xb_add(&bar[XB_XCNT(b.x)], 1u);
    return b;
}
__device__ __forceinline__ void xcd_barrier_complete(unsigned* bar, unsigned x, unsigned& nloc, unsigned& nx) {
    const unsigned G = gridDim.x * gridDim.y * gridDim.z;
    unsigned sum, cnt, mine, sp = 0u;
    for (;;) {
        sum = 0u; cnt = 0u; mine = 0u;
#pragma unroll
        for (unsigned j = 0; j < 16; ++j) { const unsigned c = xb_ld(&bar[XB_XCNT(j)]); sum += c; cnt += (c > 0u) ? 1u : 0u; mine = (j == x) ? c : mine; }
        if (sum == G) break;
        __builtin_amdgcn_s_sleep(1);
        if ((++sp & 255u) == 0u) { if (xb_ld(&bar[XB_TMO])) break; if (sp > XB_SPIN_CAP) { atomicAdd(&bar[XB_TMO], 1u); break; } }
    }
    nloc = mine > 0u ? mine : 1u; nx = cnt > 0u ? cnt : 1u;
}

__device__ __forceinline__ void xcd_barrier(const XcdBarrier& b) {
    asm volatile("s_waitcnt vmcnt(0)" ::: "memory");
    __syncthreads();
    if (threadIdx.x == 0) {
        unsigned* bar = b.bar;
        __builtin_amdgcn_s_waitcnt(0);
        unsigned nloc = b.st[0], nx = b.st[1];
        if (nloc == 0u) { xcd_barrier_complete(bar, b.x, nloc, nx); b.st[0] = nloc; b.st[1] = nx; }
        const unsigned old = xb_add(&bar[XB_XSUB(b.x)], 1u);
        const unsigned gen = old / nloc;
        if (old + 1u == (gen + 1u) * nloc) {
            __builtin_amdgcn_fence(__ATOMIC_RELEASE, "agent");
            asm volatile("s_waitcnt vmcnt(0)" ::: "memory");
            const unsigned og = xb_add(&bar[XB_TOP], 1u);
            const unsigned tg = og / nx;
            if (og + 1u == (tg + 1u) * nx) xb_add(&bar[XB_TOPGEN], 1u);
            else XB_SPIN(xb_ld(&bar[XB_TOPGEN]) == tg, bar);
            __builtin_amdgcn_fence(__ATOMIC_ACQUIRE, "agent");
            xb_add(&bar[XB_XGEN(b.x)], 1u);
            asm volatile("s_waitcnt vmcnt(0)" ::: "memory");
        } else {
            XB_SPIN(xb_ld(&bar[XB_XGEN(b.x)]) == gen, bar);
            __builtin_amdgcn_fence(__ATOMIC_ACQUIRE, "agent");
            asm volatile("s_waitcnt vmcnt(0)" ::: "memory");
        }
    }
    __syncthreads();
}


template <class Epi>
__device__ __forceinline__ void run_gemm(LAS unsigned char* lds, const bf16_t* A, const bf16_t* Bt, int N, int K, const Epi& E, int vc) {
    pg8::Gemm g; g.A = A; g.Bt = Bt; g.M = M_TOK; g.N = N; g.K = K;
    pg8::StaticOrder S; S.init(M_TOK, N, (int)gridDim.x, vc);
    pg8::gemm_phase<Epi, pg8::StaticOrder, true, true>(lds, g, S, E);
}
struct TailOrder {
    int c, n;
    __device__ __forceinline__ bool next(int i, Unit& u) const { if (c < 0) return false; const int L = i * n + c; if (L >= 256) return false; u.pm = L >> 3; u.pn = L & 7; return true; }
    __device__ __forceinline__ void a_ready(const Unit&) const {}
    __device__ __forceinline__ void done(const Unit&) const {}
};

__global__ void __launch_bounds__(512, 2) fwd_kernel(Args a) {
    extern __shared__ __attribute__((aligned(16))) unsigned char lds_raw[];
    LAS unsigned char* lds = (LAS unsigned char*)lds_raw;
    cg::grid_group grid = cg::this_grid();
    volatile LAS unsigned* xst = (volatile LAS unsigned*)(lds + LDS_BYTES - 16);
    if (threadIdx.x < 4) xst[threadIdx.x] = 0u;
    __syncthreads();
    XcdBarrier xbar = xcd_barrier_post((unsigned*)(a.ws + WS_BAR), xst);
    unsigned* cen = (unsigned*)(a.ws + WS_BAR) + 3584;
    if (threadIdx.x == 0) xst[2] = xb_add(&cen[64 * xbar.x], 1u);
    if (a.ph_lo == 0 && a.ph_hi == NPHASE) grid.sync();
    int vc = blockIdx.x;
    if (a.ph_lo == 0 && a.ph_hi == NPHASE && gridDim.x == 256) {
        bool even = true;
#pragma unroll
        for (int j = 0; j < 8; ++j) even = even && (xb_ld(&cen[64 * j]) == 32u);
        if (even) vc = (int)xst[2] * 8 + (int)xbar.x;
    }
    vc = __builtin_amdgcn_readfirstlane(vc);
    const int tid = threadIdx.x, lane = tid & 63, wave = __builtin_amdgcn_readfirstlane(tid >> 6);
    unsigned char* ws = a.ws;
    float* SS = (float*)(ws + WS_SS);
    bf16_t* XB = (bf16_t*)(ws + WS_XB); bf16_t* G = (bf16_t*)(ws + WS_G); bf16_t* MIX = (bf16_t*)(ws + WS_MIX);
#define PH(i) if (a.ph_lo <= (i) && (i) < a.ph_hi)
#define SYNC(i) if (a.ph_lo <= (i) && (i) + 1 < a.ph_hi) { xcd_barrier(xbar); }
    PH(0) { phase0(a, lds, wave, lane); } SYNC(0)
    PH(1) { EpiGateUp E; E.G = G; E.ss = SS; run_gemm(lds, XB, (const bf16_t*)(ws + WS_W1GU), 2 * FF, DM, E, vc); conv_tail(a, lds, wave, lane, 32 * 44, CV_T1, CV_END, vc); } SYNC(1)
    PH(2) { EpiResid E; E.R = a.in[0]; E.H = a.out; E.XB = XB; E.ss_out = SS + 8192; E.scale = 0.5f; run_gemm(lds, G, (const bf16_t*)(ws + WS_W1D), DM, FF, E, vc); } SYNC(2)
    PH(3) { EpiMixIn E; E.ss = SS + 8192; E.lbl = a.in[9]; E.QS = (bf16_t*)(ws + WS_QS);
            E.UC = (bf16_t*)(ws + WS_UC); E.LF = (float*)(ws + WS_LF); run_gemm(lds, XB, (const bf16_t*)(ws + WS_WIN), MIXIN, DM, E, vc); conv_tail(a, lds, wave, lane, 32 * 28, CV_T0, CV_T1, vc); } SYNC(3)
    PH(4) { hgrn_pass_a(a, lds, wave, lane); } SYNC(4)
    PH(5) { hgrn_scan(a); conv_mixer(a, wave, lane); } SYNC(5)
    PH(6) { hgrn_pass_c(a, lds, wave, lane); } SYNC(6)
    PH(7) { EpiResid E; E.R = a.out; E.H = a.out; E.XB = XB; E.ss_out = SS + 16384; E.scale = 1.0f; run_gemm(lds, MIX, (const bf16_t*)(ws + WS_WOUT), DM, DM, E, vc); } SYNC(7)
    PH(8) { EpiGateUp E; E.G = G; E.ss = SS + 16384; run_gemm(lds, XB, (const bf16_t*)(ws + WS_W2GU), 2 * FF, DM, E, vc);
            { const int r = (32 * 44) % (int)gridDim.x; TailOrder T; T.n = (int)gridDim.x - r; T.c = vc - r;
              EpiStoreBf16 E2; E2.O = (bf16_t*)(ws + WS_PLE); int kp = PLE; asm volatile("" : "+s"(kp));
              pg8::Gemm g2; g2.A = (const bf16_t*)(ws + WS_PB); g2.Bt = (const bf16_t*)(ws + WS_WPE); g2.M = M_TOK; g2.N = DM; g2.K = kp;
              pg8::gemm_phase<EpiStoreBf16, TailOrder, true, true>(lds, g2, T, E2); } } SYNC(8)
    PH(9) { EpiResid E; E.R = a.out; E.H = a.out; E.XB = XB; E.ss_out = SS + 24576; E.scale = 0.5f; run_gemm(lds, G, (const bf16_t*)(ws + WS_W2D), DM, FF, E, vc); } SYNC(9)
    PH(10) { EpiPleGate E; E.H = a.out; E.P = (const bf16_t*)(ws + WS_PLE); E.ss = SS + 24576; run_gemm(lds, XB, (const bf16_t*)(ws + WS_WPG), DM, DM, E, vc); } SYNC(10)
    PH(11) { phase_final(a, wave, lane); }
#undef PH
#undef SYNC
}

#ifndef MK_MULTI
#define MK_MULTI 0
#endif
extern "C" void kernel_launch(void* const* d_in, const int* in_sizes, int n_in, void* d_out, int out_size, void* d_ws, size_t ws_size, hipStream_t stream) {
    static int grid = 0;
    if (grid == 0) {
        if (n_in != 21 || out_size != M_TOK * DM || ws_size < WS_END) { fprintf(stderr, "kernel_launch: unexpected shapes (n_in %d out %d ws %zu need %zu)\n", n_in, out_size, ws_size, (size_t)WS_END); grid = -1; return; }
        int dev = 0, cus = 0, per_cu = 0;
        hipGetDevice(&dev); hipDeviceGetAttribute(&cus, hipDeviceAttributeMultiprocessorCount, dev);
        if (hipFuncSetAttribute((const void*)fwd_kernel, hipFuncAttributeMaxDynamicSharedMemorySize, LDS_BYTES) != hipSuccess) { fprintf(stderr, "kernel_launch: hipFuncSetAttribute failed\n"); grid = -1; return; }
        if (hipOccupancyMaxActiveBlocksPerMultiprocessor(&per_cu, (const void*)fwd_kernel, 512, LDS_BYTES) != hipSuccess || per_cu < 1) { fprintf(stderr, "kernel_launch: occupancy query failed (%d)\n", per_cu); grid = -1; return; }
        grid = cus * per_cu;
    }
    if (grid < 0) return;
    Args a{};
    for (int i = 0; i < 21; ++i) a.in[i] = (const float*)d_in[i];
    a.out = (float*)d_out; a.ws = (unsigned char*)d_ws;
#if MK_MULTI
    for (int p = 0; p < NPHASE; ++p) { a.ph_lo = p; a.ph_hi = p + 1; hipLaunchKernelGGL(fwd_kernel, dim3(grid), dim3(512), LDS_BYTES, stream, a); }
#else
    a.ph_lo = 0; a.ph_hi = NPHASE;
    if (hipMemsetAsync((char*)d_ws + WS_BAR, 0, 4096 * 4, stream) != hipSuccess) { fprintf(stderr, "kernel_launch: memset failed\n"); return; }
    void* args[] = {&a};
    hipError_t e = hipLaunchCooperativeKernel((void*)fwd_kernel, dim3(grid), dim3(512), args, LDS_BYTES, stream);
    if (e != hipSuccess) fprintf(stderr, "cooperative launch failed: %s (grid %d)\n", hipGetErrorString(e), grid);
#endif
}
```

```cpp
#include <hip/hip_runtime.h>
#include <hip/hip_cooperative_groups.h>
#include <cstdio>
#include <cstdint>
namespace pg8 {
#define PG8_LAS __attribute__((address_space(3)))
typedef unsigned short bf16_t;
typedef short bf16x8 __attribute__((ext_vector_type(8)));
typedef float f32x4 __attribute__((ext_vector_type(4)));
typedef unsigned u32x4 __attribute__((ext_vector_type(4)));
constexpr int BM = 256, BK = 64, HALF = 128, HTB = HALF * BK * 2  , STAGE_BYTES = 8 * HTB, NXCD = 8, WGM = 8;

__host__ __device__ __forceinline__ int lds_byte(int r, int c) { const int st = (r >> 4) * 2 + (c >> 5), rr = r & 15, cc = c & 31, ob = rr * 64 + cc * 2; return st * 1024 + (ob ^ (((ob >> 9) & 1) << 5)); }
__host__ __device__ __forceinline__ void stage_rc(int b, int& R, int& C) { const int st = b / 1024, sb = b % 1024, swz = sb ^ (((sb >> 9) & 1) << 5); R = (st >> 1) * 16 + swz / 64; C = (st & 1) * 32 + (swz % 64) / 2; }
__host__ __device__ __forceinline__ int perm32(int rho) { const int n = rho >> 4, i = rho & 15; return 8 * (i >> 2) + 4 * n + (i & 3); }

struct Unit { int pm, pn; };
struct Gemm { const bf16_t* A; const bf16_t* Bt; int M, N, K; };

struct StaticOrder {
    int nM, nN, nwg, G, c;
    __host__ __device__ void init(int M, int N, int G_, int c_) { nM = M / BM; nN = N / BM; nwg = nM * nN; G = G_; c = c_; }
    __host__ __device__ bool next(int i, Unit& u) const {
        const long L = (long)i * G + c; if (L >= nwg) return false;
        int wgid = (int)L; { const int q = nwg / NXCD, r = nwg % NXCD, xcd = wgid % NXCD, off = wgid / NXCD; wgid = (xcd < r ? xcd * (q + 1) : r * (q + 1) + (xcd - r) * q) + off; }
        const int nig = WGM * nN, gid = wgid / nig, fm = gid * WGM, gsz = (nM - fm) < WGM ? (nM - fm) : WGM;
        u.pm = fm + ((wgid % nig) % gsz); u.pn = (wgid % nig) / gsz; return true;
    }
    __device__ __forceinline__ void a_ready(const Unit&) const {}
    __device__ __forceinline__ void done(const Unit&) const {}
};
typedef float f32x2 __attribute__((ext_vector_type(2)));
template <class Epi, class Sched, bool ALIGN_EPI = false, bool SP2 = false>
__device__ __forceinline__ void gemm_phase(PG8_LAS unsigned char* lds, const Gemm g, const Sched& S, const Epi& E) {
    const int tid = threadIdx.x, wid = __builtin_amdgcn_readfirstlane(tid >> 6), lane = tid & 63, wr = wid >> 2, wc = wid & 3, fr = lane & 15, fq = lane >> 4;
    const int K = g.K, nt = K / BK;
    unsigned voffA[2], voffB[2];
#pragma unroll
    for (int i = 0; i < 2; ++i) { int R, C; stage_rc(tid * 16 + i * 8192, R, C); const int Rb = Epi::PERM ? ((R & ~31) + perm32(R & 31)) : R;
        voffA[i] = (unsigned)(R * K + C) * 2u; voffB[i] = (unsigned)(Rb * K + C) * 2u; }
    const size_t kstep = (size_t)(BK * 2);
    const size_t hstep = (size_t)HALF * K * 2;
    const size_t tstep = 2 * hstep;
    const unsigned ldsw = (unsigned)wid * 1024u;
    const int aoff = lds_byte(wr * 64 + fr, fq * 8), boff = lds_byte(wc * 32 + fr, fq * 8);
#define PG8_SA(b, h) (((b) * 2 + (h)) * HTB)
#define PG8_SB(b, h) ((4 + (b) * 2 + (h)) * HTB)
#define PG8_STAGE(bufoff, gbase, voff) do { _Pragma("unroll") for (int _i = 0; _i < 2; ++_i) \
        __builtin_amdgcn_global_load_lds((const unsigned*)((const char*)(gbase) + (voff)[_i]), (PG8_LAS unsigned*)(lds + (bufoff) + ldsw + _i * 8192), 16, 0, 0); } while (0)
#define PG8_LDA(dst, b, h) do { _Pragma("unroll") for (int m = 0; m < 4; ++m) _Pragma("unroll") for (int k = 0; k < 2; ++k) dst[m][k] = *(const PG8_LAS bf16x8*)(lds + PG8_SA(b, h) + aoff + m * 2048 + k * 1024); } while (0)
#define PG8_LDB(dst, b, h) do { _Pragma("unroll") for (int n = 0; n < 2; ++n) _Pragma("unroll") for (int k = 0; k < 2; ++k) dst[n][k] = *(const PG8_LAS bf16x8*)(lds + PG8_SB(b, h) + boff + n * 2048 + k * 1024); } while (0)
#define PG8_MMA(ai, bj, At, Bt) do { __builtin_amdgcn_s_setprio(1); _Pragma("unroll") for (int m = 0; m < 4; ++m) _Pragma("unroll") for (int n = 0; n < 2; ++n) _Pragma("unroll") for (int k = 0; k < 2; ++k) \
        acc[ai][bj][m][n] = __builtin_amdgcn_mfma_f32_16x16x32_bf16(Bt[n][k], At[m][k], acc[ai][bj][m][n], 0, 0, 0); __builtin_amdgcn_s_setprio(0); } while (0)
#define PG8_WAIT_V(n) asm volatile("s_waitcnt vmcnt(" #n ")" ::: "memory")
#define PG8_WAIT_L(n) asm volatile("s_waitcnt lgkmcnt(" #n ")" ::: "memory")
#define PG8_BAR __builtin_amdgcn_s_barrier()
#define PG8_SCHED __builtin_amdgcn_sched_barrier(0)
    Unit cur, nxt; int ui = 0;
    if (!S.next(0, cur)) return;
    f32x4 acc[2][2][4][2];
#pragma unroll
    for (int a = 0; a < 2; ++a)
#pragma unroll
        for (int b = 0; b < 2; ++b)
#pragma unroll
            for (int m = 0; m < 4; ++m)
#pragma unroll
                for (int n = 0; n < 2; ++n) acc[a][b][m][n] = (f32x4){0.f, 0.f, 0.f, 0.f};
    bf16x8 At[4][2], B0[2][2], B1[2][2];
    const char* cA = (const char*)g.A + (size_t)cur.pm * tstep; const char* cB = (const char*)g.Bt + (size_t)cur.pn * tstep;
    S.a_ready(cur);
    if constexpr (SP2) {
        PG8_STAGE(PG8_SB(0, 0), cB, voffB); PG8_STAGE(PG8_SB(0, 1), cB + hstep, voffB); PG8_STAGE(PG8_SA(0, 0), cA, voffA); PG8_STAGE(PG8_SA(0, 1), cA + hstep, voffA);
        if (wr == 1) PG8_BAR;
        PG8_WAIT_V(2); PG8_BAR;
        PG8_STAGE(PG8_SB(1, 0), cB + kstep, voffB); PG8_STAGE(PG8_SA(1, 0), cA + kstep, voffA); PG8_STAGE(PG8_SB(1, 1), cB + hstep + kstep, voffB);
        PG8_WAIT_V(6); PG8_BAR;
    } else {
        PG8_STAGE(PG8_SB(0, 0), cB, voffB); PG8_STAGE(PG8_SA(0, 0), cA, voffA); PG8_STAGE(PG8_SB(0, 1), cB + hstep, voffB); PG8_STAGE(PG8_SA(0, 1), cA + hstep, voffA);
        if (wr == 1) PG8_BAR;
        PG8_WAIT_V(4); PG8_BAR;
        PG8_STAGE(PG8_SB(1, 0), cB + kstep, voffB); PG8_STAGE(PG8_SA(1, 0), cA + kstep, voffA); PG8_STAGE(PG8_SB(1, 1), cB + hstep + kstep, voffB);
        PG8_WAIT_V(6); PG8_BAR;
    }
    for (;;) {
        const bool has_next = S.next(ui + 1, nxt);
        const char* nA = has_next ? (const char*)g.A + (size_t)nxt.pm * tstep : cA; const char* nB = has_next ? (const char*)g.Bt + (size_t)nxt.pn * tstep : cB;
        for (int t = 0; t < nt; t += 2) {
            const bool last = (t == nt - 2);
            const char* a1 = cA + (size_t)(t + 1) * kstep;
            const char* a2 = last ? nA : cA + (size_t)(t + 2) * kstep; const char* b2 = last ? nB : cB + (size_t)(t + 2) * kstep;
            const char* a3 = a2 + kstep; const char* b3 = b2 + kstep;
            if (last && has_next) S.a_ready(nxt);
            if constexpr (SP2) {
            PG8_LDB(B0, 0, 0); PG8_LDB(B1, 0, 1); PG8_SCHED; PG8_LDA(At, 0, 0); PG8_STAGE(PG8_SA(1, 1), a1 + hstep, voffA);
            PG8_WAIT_V(8); PG8_WAIT_L(0); PG8_BAR; PG8_MMA(0, 0, At, B0); PG8_MMA(0, 1, At, B1); PG8_BAR; PG8_SCHED;
            PG8_LDA(At, 0, 1); PG8_STAGE(PG8_SB(0, 0), b2, voffB); PG8_STAGE(PG8_SB(0, 1), b2 + hstep, voffB); PG8_STAGE(PG8_SA(0, 0), a2, voffA);
            PG8_WAIT_V(8); PG8_WAIT_L(0); PG8_BAR; PG8_MMA(1, 0, At, B0); PG8_MMA(1, 1, At, B1); PG8_BAR; PG8_SCHED;
            PG8_LDB(B0, 1, 0); PG8_LDB(B1, 1, 1); PG8_SCHED; PG8_LDA(At, 1, 0); PG8_STAGE(PG8_SA(0, 1), a2 + hstep, voffA);
            PG8_WAIT_V(8); PG8_WAIT_L(0); PG8_BAR; PG8_MMA(0, 0, At, B0); PG8_MMA(0, 1, At, B1); PG8_BAR; PG8_SCHED;
            PG8_LDA(At, 1, 1); PG8_STAGE(PG8_SB(1, 0), b3, voffB); PG8_STAGE(PG8_SB(1, 1), b3 + hstep, voffB); PG8_STAGE(PG8_SA(1, 0), a3, voffA);
            PG8_WAIT_V(8); PG8_WAIT_L(0); PG8_BAR; PG8_MMA(1, 0, At, B0); PG8_MMA(1, 1, At, B1); PG8_BAR; PG8_SCHED;
            } else {
            PG8_LDB(B0, 0, 0); PG8_SCHED; PG8_LDA(At, 0, 0); PG8_STAGE(PG8_SA(1, 1), a1 + hstep, voffA);
            PG8_WAIT_L(8); PG8_BAR; PG8_WAIT_L(0); PG8_MMA(0, 0, At, B0); PG8_BAR; PG8_SCHED;
            PG8_LDB(B1, 0, 1); PG8_STAGE(PG8_SB(0, 0), b2, voffB);
            PG8_BAR; PG8_WAIT_L(0); PG8_MMA(0, 1, At, B1); PG8_BAR;
            PG8_LDA(At, 0, 1); PG8_STAGE(PG8_SA(0, 0), a2, voffA);
            PG8_BAR; PG8_WAIT_L(0); PG8_MMA(1, 0, At, B0); PG8_BAR; PG8_SCHED;
            PG8_STAGE(PG8_SB(0, 1), b2 + hstep, voffB);
            PG8_WAIT_V(6); PG8_BAR; PG8_MMA(1, 1, At, B1); PG8_BAR;
            PG8_LDB(B0, 1, 0); PG8_SCHED; PG8_LDA(At, 1, 0); PG8_STAGE(PG8_SA(0, 1), a2 + hstep, voffA);
            PG8_WAIT_L(8); PG8_BAR; PG8_WAIT_L(0); PG8_MMA(0, 0, At, B0); PG8_BAR; PG8_SCHED;
            PG8_LDB(B1, 1, 1); PG8_STAGE(PG8_SB(1, 0), b3, voffB);
            PG8_BAR; PG8_WAIT_L(0); PG8_MMA(0, 1, At, B1); PG8_BAR;
            PG8_LDA(At, 1, 1); PG8_STAGE(PG8_SA(1, 0), a3, voffA);
            PG8_BAR; PG8_WAIT_L(0); PG8_MMA(1, 0, At, B0); PG8_BAR; PG8_SCHED;
            PG8_STAGE(PG8_SB(1, 1), b3 + hstep, voffB);
            PG8_WAIT_V(6); PG8_BAR; PG8_MMA(1, 1, At, B1); PG8_BAR;
            }
        }
        if constexpr (ALIGN_EPI) { if (wr == 0) PG8_BAR; }
        if constexpr (!Epi::AFTER_DRAIN) { E(acc, cur, wr, wc, fr, fq); S.done(cur); }
        if (!has_next) break;
#pragma unroll
        for (int a = 0; a < 2; ++a)
#pragma unroll
            for (int b = 0; b < 2; ++b)
#pragma unroll
                for (int m = 0; m < 4; ++m)
#pragma unroll
                    for (int n = 0; n < 2; ++n) acc[a][b][m][n] = (f32x4){0.f, 0.f, 0.f, 0.f};
        cur = nxt; cA = nA; cB = nB; ++ui;
        if constexpr (ALIGN_EPI) { if (wr == 1) PG8_BAR; }
    }
    PG8_WAIT_V(0);
    if constexpr (!ALIGN_EPI) { if (wr == 0) PG8_BAR; }
    PG8_BAR;
    if constexpr (Epi::AFTER_DRAIN) { E.fused(acc, cur, wr, wc, fr, fq, lds, wid, lane); S.done(cur); }
#undef PG8_SA
#undef PG8_SB
#undef PG8_STAGE
#undef PG8_LDA
#undef PG8_LDB
#undef PG8_MMA
#undef PG8_WAIT_V
#undef PG8_WAIT_L
#undef PG8_BAR
#undef PG8_SCHED
}
}

namespace cg = cooperative_groups;
using pg8::bf16_t; using pg8::bf16x8; using pg8::f32x4; using pg8::u32x4; using pg8::Unit;
__device__ __forceinline__ unsigned cvt_pk_bf16(float lo, float hi) { unsigned r; asm volatile("v_cvt_pk_bf16_f32 %0, %1, %2" : "=v"(r) : "v"(lo), "v"(hi)); return r; }
#define LAS __attribute__((address_space(3)))
typedef unsigned u32x2 __attribute__((ext_vector_type(2)));
typedef float f32x2v __attribute__((ext_vector_type(2)));

constexpr int M_TOK = 8192, DM = 2048, FF = 5632, HW = 1024, CW = 1024, MIXIN = 7168, PLE = 256, SEQ = 2048;
constexpr float EPS = 1e-6f;
constexpr size_t MiB = 1ull << 20;
constexpr size_t WS_W1GU = 0, WS_W1D = 44 * MiB, WS_WIN = 66 * MiB, WS_WOUT = 94 * MiB, WS_W2GU = 102 * MiB, WS_W2D = 146 * MiB,
                 WS_WPG = 168 * MiB, WS_WPE = 176 * MiB, WS_PB = 177 * MiB, WS_XB = 181 * MiB, WS_MIX = 213 * MiB, WS_G = 245 * MiB,
                 WS_QS = 245 * MiB, WS_VH = 261 * MiB, WS_GH = 277 * MiB, WS_BC = 293 * MiB, WS_UC = 309 * MiB, WS_LF = 325 * MiB,
                 WS_S = 357 * MiB, WS_PLE = 0, WS_SS = 389 * MiB, WS_DD = 389 * MiB + 512 * 1024, WS_BAR = 390 * MiB + 512 * 1024, WS_END = 391 * MiB, WS_U = 0;
constexpr int LDS_BYTES = 144 * 1024;
constexpr int NPHASE = 12;

__device__ __forceinline__ float bf2f(bf16_t b) { return __uint_as_float(((unsigned)b) << 16); }
__device__ __forceinline__ float bflo(unsigned w) { return __uint_as_float(w << 16); }
__device__ __forceinline__ float bfhi(unsigned w) { return __uint_as_float(w & 0xffff0000u); }
__device__ __forceinline__ float wave_sum(float v) {
#pragma unroll
    for (int o = 1; o < 64; o <<= 1) v += __shfl_xor(v, o);
    return v;
}
__device__ __forceinline__ float fsigmoid(float x) { return __builtin_amdgcn_rcpf(1.0f + __expf(-x)); }
__device__ __forceinline__ float fsilu(float x) { return x * fsigmoid(x); }
__device__ __forceinline__ float rinv_of(float ss) { return rsqrtf(ss * (1.0f / DM) + EPS); }

struct EpiGateUp {
    static constexpr bool PERM = true, AFTER_DRAIN = false;
    bf16_t* G; const float* ss;
    __device__ __forceinline__ void operator()(const f32x4 (&acc)[2][2][4][2], const Unit& u, int wr, int wc, int fr, int fq) const {
        const int row0 = u.pm * 256 + wr * 64 + fr, col0 = u.pn * 128 + wc * 32 + 8 * fq;
#pragma unroll
        for (int ai = 0; ai < 2; ++ai)
#pragma unroll
            for (int m = 0; m < 4; ++m) {
                const int r = row0 + ai * 128 + m * 16; const float ri = rinv_of(ss[r]);
                float v[8];
#pragma unroll
                for (int n = 0; n < 2; ++n)
#pragma unroll
                    for (int j = 0; j < 4; ++j) v[n * 4 + j] = fsilu(acc[ai][0][m][n][j] * ri) * (acc[ai][1][m][n][j] * ri);
                u32x4 w; w.x = cvt_pk_bf16(v[0], v[1]); w.y = cvt_pk_bf16(v[2], v[3]); w.z = cvt_pk_bf16(v[4], v[5]); w.w = cvt_pk_bf16(v[6], v[7]);
                *(u32x4*)(G + (size_t)r * FF + col0) = w;
            }
    }
};
struct EpiResid {
    static constexpr bool PERM = true, AFTER_DRAIN = false;
    bf16_t* XB; float* ss_out; float scale;
    __device__ __forceinline__ void operator()(f32x4 (&acc)[2][2][4][2], const Unit& u, int wr, int wc, int fr, int fq) const {
        const int row0 = u.pm * 256 + wr * 64 + fr, col0 = u.pn * 256 + wc * 32 + 8 * fq;
#pragma unroll
        for (int ai = 0; ai < 2; ++ai) {
#pragma unroll
            for (int m = 0; m < 4; ++m)
#pragma unroll
                for (int bj = 0; bj < 2; ++bj) {
                    const size_t off = (size_t)(row0 + ai * 128 + m * 16) * DM + col0 + bj * 128;
                    const u32x4 xw = *(const u32x4*)(XB + off);
                    f32x4 r0, r1; r0[0] = bflo(xw.x); r0[1] = bfhi(xw.x); r0[2] = bflo(xw.y); r0[3] = bfhi(xw.y); r1[0] = bflo(xw.z); r1[1] = bfhi(xw.z); r1[2] = bflo(xw.w); r1[3] = bfhi(xw.w);
                    acc[ai][bj][m][0] = r0 + acc[ai][bj][m][0] * scale; acc[ai][bj][m][1] = r1 + acc[ai][bj][m][1] * scale;
                }
            asm volatile("" ::: "memory");
#pragma unroll
            for (int m = 0; m < 4; ++m) {
                const int r = row0 + ai * 128 + m * 16; float sq = 0.f;
#pragma unroll
                for (int bj = 0; bj < 2; ++bj) {
                    const size_t off = (size_t)r * DM + col0 + bj * 128;
                    const f32x4 v0 = acc[ai][bj][m][0], v1 = acc[ai][bj][m][1];
                    u32x4 w; w.x = cvt_pk_bf16(v0[0], v0[1]); w.y = cvt_pk_bf16(v0[2], v0[3]); w.z = cvt_pk_bf16(v1[0], v1[1]); w.w = cvt_pk_bf16(v1[2], v1[3]);
                    *(u32x4*)(XB + off) = w;
                    sq += (v0[0] * v0[0] + v0[1] * v0[1]) + (v0[2] * v0[2] + v0[3] * v0[3]) + (v1[0] * v1[0] + v1[1] * v1[1]) + (v1[2] * v1[2] + v1[3] * v1[3]);
                }
                sq += __shfl_xor(sq, 16); sq += __shfl_xor(sq, 32);
                if (fq == 0) atomicAdd(ss_out + r, sq);
            }
            asm volatile("" ::: "memory");
        }
    }
};
struct EpiMixIn {
    static constexpr bool PERM = true, AFTER_DRAIN = false;
    const float* ss; const float* lbl;
    bf16_t *QS, *UC; float* LF;
    __device__ __forceinline__ void operator()(const f32x4 (&acc)[2][2][4][2], const Unit& u, int wr, int wc, int fr, int fq) const {
        const int row0 = u.pm * 256 + wr * 64 + fr; const int sec = u.pn >> 2;
        if (u.pn >= 20) {
            const int col0 = (u.pn - 20) * 128 + wc * 32 + 8 * fq;
#pragma unroll
            for (int ai = 0; ai < 2; ++ai)
#pragma unroll
                for (int m = 0; m < 4; ++m) {
                    const int r = row0 + ai * 128 + m * 16; const float ri = rinv_of(ss[r]); const float ri2 = ri * ri;
                    float v[8];
#pragma unroll
                    for (int n = 0; n < 2; ++n)
#pragma unroll
                        for (int j = 0; j < 4; ++j) v[n * 4 + j] = acc[ai][0][m][n][j] * acc[ai][1][m][n][j] * ri2;
                    u32x4 w; w.x = cvt_pk_bf16(v[0], v[1]); w.y = cvt_pk_bf16(v[2], v[3]); w.z = cvt_pk_bf16(v[4], v[5]); w.w = cvt_pk_bf16(v[6], v[7]);
                    *(u32x4*)(UC + (size_t)r * CW + col0) = w;
                }
            return;
        }
        const int col0 = (u.pn & 3) * 256 + wc * 32 + 8 * fq;
        if (sec == 1) {
#pragma unroll
            for (int bj = 0; bj < 2; ++bj)
#pragma unroll
                for (int n = 0; n < 2; ++n) {
                    const int c = col0 + bj * 128 + 4 * n; const f32x4 l0 = *(const f32x4*)(lbl + c), l1 = *(const f32x4*)(lbl + 1024 + c);
                    f32x4 lb; lb[0] = fsigmoid(l0[0] - l1[0]); lb[1] = fsigmoid(l0[1] - l1[1]); lb[2] = fsigmoid(l0[2] - l1[2]); lb[3] = fsigmoid(l0[3] - l1[3]);
#pragma unroll
                    for (int ai = 0; ai < 2; ++ai)
#pragma unroll
                        for (int m = 0; m < 4; ++m) {
                            const int r = row0 + ai * 128 + m * 16; const float ri = rinv_of(ss[r]);
                            const f32x4 x = acc[ai][bj][m][n]; f32x4 o;
                            o[0] = __logf(lb[0] + (1.0f - lb[0]) * fsigmoid(x[0] * ri)); o[1] = __logf(lb[1] + (1.0f - lb[1]) * fsigmoid(x[1] * ri));
                            o[2] = __logf(lb[2] + (1.0f - lb[2]) * fsigmoid(x[2] * ri)); o[3] = __logf(lb[3] + (1.0f - lb[3]) * fsigmoid(x[3] * ri));
                            *(f32x4*)(LF + (size_t)r * HW + c) = o;
                        }
                }
            return;
        }
        bf16_t* dst = QS + (size_t)(sec == 0 ? 0 : sec - 1) * ((size_t)M_TOK * HW);
        const bool act = (sec == 0 || sec == 3);
#pragma unroll
        for (int ai = 0; ai < 2; ++ai)
#pragma unroll
            for (int m = 0; m < 4; ++m) {
                const int r = row0 + ai * 128 + m * 16; const float ri = rinv_of(ss[r]);
#pragma unroll
                for (int bj = 0; bj < 2; ++bj) {
                    float v[8];
#pragma unroll
                    for (int n = 0; n < 2; ++n)
#pragma unroll
                        for (int j = 0; j < 4; ++j) { const float x = acc[ai][bj][m][n][j] * ri; v[n * 4 + j] = act ? fsilu(x) : x; }
                    u32x4 w; w.x = cvt_pk_bf16(v[0], v[1]); w.y = cvt_pk_bf16(v[2], v[3]); w.z = cvt_pk_bf16(v[4], v[5]); w.w = cvt_pk_bf16(v[6], v[7]);
                    *(u32x4*)(dst + (size_t)r * HW + col0 + bj * 128) = w;
                }
            }
    }
};
struct EpiStoreBf16 {
    static constexpr bool PERM = true, AFTER_DRAIN = false;
    bf16_t* O;
    __device__ __forceinline__ void operator()(const f32x4 (&acc)[2][2][4][2], const Unit& u, int wr, int wc, int fr, int fq) const {
        const int row0 = u.pm * 256 + wr * 64 + fr, col0 = u.pn * 256 + wc * 32 + 8 * fq;
#pragma unroll
        for (int ai = 0; ai < 2; ++ai)
#pragma unroll
            for (int m = 0; m < 4; ++m) {
                const int r = row0 + ai * 128 + m * 16;
#pragma unroll
                for (int bj = 0; bj < 2; ++bj) {
                    const f32x4 v0 = acc[ai][bj][m][0], v1 = acc[ai][bj][m][1];
                    u32x4 w; w.x = cvt_pk_bf16(v0[0], v0[1]); w.y = cvt_pk_bf16(v0[2], v0[3]); w.z = cvt_pk_bf16(v1[0], v1[1]); w.w = cvt_pk_bf16(v1[2], v1[3]);
                    *(u32x4*)(O + (size_t)r * DM + col0 + bj * 128) = w;
                }
            }
    }
};
struct EpiPleGate {
    static constexpr bool PERM = true, AFTER_DRAIN = false;
    const bf16_t* XB; const bf16_t* P; bf16_t* H4; const float* ss;
    __device__ __forceinline__ void operator()(f32x4 (&acc)[2][2][4][2], const Unit& u, int wr, int wc, int fr, int fq) const {
        const int row0 = u.pm * 256 + wr * 64 + fr, col0 = u.pn * 256 + wc * 32 + 8 * fq;
#pragma unroll
        for (int ai = 0; ai < 2; ++ai)
#pragma unroll
            for (int m = 0; m < 4; ++m) {
                const int r = row0 + ai * 128 + m * 16; const float ri = rinv_of(ss[r]);
#pragma unroll
                for (int bj = 0; bj < 2; ++bj) {
                    const size_t off = (size_t)r * DM + col0 + bj * 128;
                    const u32x4 pw = *(const u32x4*)(P + off), xw = *(const u32x4*)(XB + off);
                    const f32x4 a0 = acc[ai][bj][m][0], a1 = acc[ai][bj][m][1];
                    u32x4 w;
                    w.x = cvt_pk_bf16(bflo(xw.x) + fsigmoid(a0[0] * ri) * bflo(pw.x), bfhi(xw.x) + fsigmoid(a0[1] * ri) * bfhi(pw.x));
                    w.y = cvt_pk_bf16(bflo(xw.y) + fsigmoid(a0[2] * ri) * bflo(pw.y), bfhi(xw.y) + fsigmoid(a0[3] * ri) * bfhi(pw.y));
                    w.z = cvt_pk_bf16(bflo(xw.z) + fsigmoid(a1[0] * ri) * bflo(pw.z), bfhi(xw.z) + fsigmoid(a1[1] * ri) * bfhi(pw.z));
                    w.w = cvt_pk_bf16(bflo(xw.w) + fsigmoid(a1[2] * ri) * bflo(pw.w), bfhi(xw.w) + fsigmoid(a1[3] * ri) * bfhi(pw.w));
                    *(u32x4*)(H4 + off) = w;
                }
            }
    }
};

template <int MODE>
__device__ __forceinline__ void p0_item(const float* W, const float* W2, const float* gain, int K, int N, bf16_t* WT, LAS float* scr, int item, int lane) {
    const int nblk_k = K / 64; const int nb = item / nblk_k, kb = item % nblk_k; const int k0 = 64 * kb, n0 = 32 * nb;
    const float* src = W; int c0 = n0;
    if (MODE == 1) { const int t = n0 >> 8, bj = (n0 >> 7) & 1, c = n0 & 127; src = bj ? W2 : W; c0 = 128 * t + c; }
    if (MODE == 2) { if (n0 >= 5120) { const int tt = n0 - 5120; const int t = tt >> 8, bj = (tt >> 7) & 1, c = tt & 127; c0 = 5120 + 1024 * bj + 128 * t + c; } }
    float v[32], gg[32];
    const float* sp = src + (size_t)(k0 + (lane >> 5)) * N + c0 + (lane & 31);
#pragma unroll
    for (int i = 0; i < 32; ++i) v[i] = sp[(size_t)(2 * i) * N];
    if (gain) {
#pragma unroll
        for (int i = 0; i < 32; ++i) gg[i] = gain[k0 + 2 * i + (lane >> 5)];
#pragma unroll
        for (int i = 0; i < 32; ++i) v[i] *= gg[i];
    }
#pragma unroll
    for (int i = 0; i < 32; ++i) scr[(2 * i + (lane >> 5)) * 33 + (lane & 31)] = v[i];
    asm volatile("s_waitcnt lgkmcnt(0)" ::: "memory");
    const int c = lane & 7;
#pragma unroll
    for (int j = 0; j < 4; ++j) { const int n = (lane >> 3) + 8 * j; const LAS float* s = scr + (8 * c) * 33 + n;
        u32x4 o; o.x = cvt_pk_bf16(s[0 * 33], s[1 * 33]); o.y = cvt_pk_bf16(s[2 * 33], s[3 * 33]); o.z = cvt_pk_bf16(s[4 * 33], s[5 * 33]); o.w = cvt_pk_bf16(s[6 * 33], s[7 * 33]);
        *(u32x4*)(WT + (size_t)(n0 + n) * K + k0 + 8 * c) = o; }
    asm volatile("s_waitcnt lgkmcnt(0)" ::: "memory");
}

struct Args { const float* in[21]; float* out; unsigned char* ws; int ph_lo, ph_hi; };

constexpr int CV_I0 = 32 * 352, CV_I1 = 88 * 64, CV_I2 = 32 * 224, CV_I3 = 32 * 64, CV_I7 = 4 * 64;
constexpr int CV_END = 2 * CV_I0 + 2 * CV_I1 + CV_I2 + 2 * CV_I3 + CV_I7, CV_T1 = CV_END - 10000, CV_T0 = CV_T1 - 10000;
__device__ __forceinline__ void conv_range(const Args& a, LAS unsigned char* lds, int wave, int lane, int lo, int hi, int w0, int nw) {
    unsigned char* ws = a.ws;
    LAS float* scr = (LAS float*)(lds + wave * 16384);
    for (int it = lo + w0; it < hi; it += nw) {
        int r = it;
        if (r < CV_I0) { p0_item<1>(a.in[3], a.in[4], a.in[2], DM, FF, (bf16_t*)(ws + WS_W1GU), scr, r, lane); continue; } r -= CV_I0;
        if (r < CV_I2) { p0_item<2>(a.in[7], nullptr, a.in[6], DM, MIXIN, (bf16_t*)(ws + WS_WIN), scr, r, lane); continue; } r -= CV_I2;
        if (r < CV_I3) { p0_item<0>(a.in[12], nullptr, nullptr, DM, DM, (bf16_t*)(ws + WS_WOUT), scr, r, lane); continue; } r -= CV_I3;
        if (r < CV_I3) { p0_item<0>(a.in[19], nullptr, a.in[17], DM, DM, (bf16_t*)(ws + WS_WPG), scr, r, lane); continue; } r -= CV_I3;
        if (r < CV_I7) { p0_item<0>(a.in[18], nullptr, nullptr, PLE, DM, (bf16_t*)(ws + WS_WPE), scr, r, lane); continue; } r -= CV_I7;
        if (r < CV_I1) { p0_item<0>(a.in[16], nullptr, nullptr, FF, DM, (bf16_t*)(ws + WS_W2D), scr, r, lane); continue; } r -= CV_I1;
        if (r < CV_I0) { p0_item<1>(a.in[14], a.in[15], a.in[13], DM, FF, (bf16_t*)(ws + WS_W2GU), scr, r, lane); continue; } r -= CV_I0;
        p0_item<0>(a.in[5], nullptr, nullptr, FF, DM, (bf16_t*)(ws + WS_W1D), scr, r, lane);
    }
}
__device__ __forceinline__ void conv_tail(const Args& a, LAS unsigned char* lds, int wave, int lane, int nunits, int lo, int hi, int vc) {
    const int r = nunits % (int)gridDim.x;
    if (r == 0) { conv_range(a, lds, wave, lane, lo, hi, vc * 8 + wave, gridDim.x * 8); return; }
    if (vc >= r) conv_range(a, lds, wave, lane, lo, hi, (vc - r) * 8 + wave, ((int)gridDim.x - r) * 8);
}

__device__ __forceinline__ void phase0(const Args& a, LAS unsigned char* lds, int wave, int lane) {
    unsigned char* ws = a.ws;
    const int gw = blockIdx.x * 8 + wave, NGW = gridDim.x * 8;
    conv_range(a, lds, wave, lane, 0, CV_T0, gw, NGW);
    float* SS = (float*)(ws + WS_SS);
    for (int m = gw; m < M_TOK; m += NGW) {
        const f32x4* xr = (const f32x4*)(a.in[0] + (size_t)m * DM) + lane; u32x2* xb = (u32x2*)((bf16_t*)(ws + WS_XB) + (size_t)m * DM) + lane;
        float s = 0.f;
#pragma unroll
        for (int j = 0; j < 8; ++j) { const f32x4 v = xr[64 * j]; s += (v[0] * v[0] + v[1] * v[1]) + (v[2] * v[2] + v[3] * v[3]);
            u32x2 w; w.x = cvt_pk_bf16(v[0], v[1]); w.y = cvt_pk_bf16(v[2], v[3]); xb[64 * j] = w; }
        s = wave_sum(s);
        if (lane == 0) { SS[m] = s; SS[8192 + m] = 0.f; SS[16384 + m] = 0.f; SS[24576 + m] = 0.f; }
    }
    { const int gt = blockIdx.x * 512 + threadIdx.x, NT = gridDim.x * 512;
      for (int i = gt; i < M_TOK * PLE / 4; i += NT) { const f32x4 v = ((const f32x4*)a.in[1])[i]; u32x2 w; w.x = cvt_pk_bf16(v[0], v[1]); w.y = cvt_pk_bf16(v[2], v[3]); ((u32x2*)(ws + WS_PB))[i] = w; } }
}

constexpr int HP = 136, VP = 72;
constexpr int L_QT = 0, L_QH = L_QT + 64 * HP * 2, L_KA = L_QH + 64 * HP * 2, L_KB = L_KA + 64 * HP * 2, L_ST = L_KB + 32 * HP * 2, L_VT = L_ST + 128 * HP * 2,
              L_P = L_VT + 128 * VP * 2, L_SEG = L_P + 64 * VP * 2, L_PART = L_SEG + 4 * 128 * 4, L_RINV = L_PART + 8 * 64 * 4, L_HEND = L_RINV + 256, L_KT = 0;
static_assert(L_HEND <= LDS_BYTES, "LDS");
#define MFMA16(a, b, c) __builtin_amdgcn_mfma_f32_16x16x32_bf16((a), (b), (c), 0, 0, 0)
__device__ __forceinline__ bf16_t f2bf(float x) { return (bf16_t)(cvt_pk_bf16(x, 0.f) & 0xffffu); }

__device__ __forceinline__ void hgrn_pass_a(const Args& a, LAS unsigned char* lds, int wave, int lane) {
    unsigned char* ws = a.ws;
    const float* LF = (const float*)(ws + WS_LF); const bf16_t* VH = (const bf16_t*)(ws + WS_VH); float* U = (float*)(ws + WS_U); float* Dd = (float*)(ws + WS_DD);
    const int tid = threadIdx.x, k = tid & 127, sg = tid >> 7, fr = lane & 15, fq = lane >> 4;
    LAS bf16_t* VT = (LAS bf16_t*)(lds + L_VT); LAS bf16_t* KT = (LAS bf16_t*)(lds + L_KT); LAS float* SEG = (LAS float*)(lds + L_SEG);
    for (int item = blockIdx.x; item < 1024; item += gridDim.x) {
        const int row0 = (item >> 3) * 64, cb = (item & 7) * 128;
        float lf[16], b[16];
#pragma unroll
        for (int i = 0; i < 16; ++i) lf[i] = LF[(size_t)(row0 + 16 * sg + i) * HW + cb + k];
        u32x4 vv[2];
#pragma unroll
        for (int j = 0; j < 2; ++j) { const int idx = tid + 512 * j; vv[j] = *(const u32x4*)(VH + (size_t)(row0 + (idx >> 4)) * HW + cb + 8 * (idx & 15)); }
        float run = 0.f;
#pragma unroll
        for (int i = 0; i < 16; ++i) { run += lf[i]; b[i] = run; }
        SEG[sg * 128 + k] = run;
        __syncthreads();
        const float s0 = SEG[k], s1 = SEG[128 + k], s2 = SEG[256 + k], s3 = SEG[384 + k];
        const float pre = sg == 0 ? 0.f : (sg == 1 ? s0 : (sg == 2 ? s0 + s1 : s0 + s1 + s2));
        const float blast = s0 + s1 + s2 + s3;
        unsigned pk[8];
#pragma unroll
        for (int i = 0; i < 8; ++i) {
            const float e0 = (1.0f - __expf(lf[2 * i])) * __expf(blast - (pre + b[2 * i])), e1 = (1.0f - __expf(lf[2 * i + 1])) * __expf(blast - (pre + b[2 * i + 1]));
            pk[i] = cvt_pk_bf16(e0, e1); }
        { u32x4 w0, w1; w0.x = pk[0]; w0.y = pk[1]; w0.z = pk[2]; w0.w = pk[3]; w1.x = pk[4]; w1.y = pk[5]; w1.z = pk[6]; w1.w = pk[7];
          *(LAS u32x4*)(KT + k * VP + 16 * sg) = w0; *(LAS u32x4*)(KT + k * VP + 16 * sg + 8) = w1; }
#pragma unroll
        for (int j = 0; j < 2; ++j) { const int idx = tid + 512 * j, s = idx >> 4, v0 = 8 * (idx & 15);
            VT[(v0 + 0) * VP + s] = (bf16_t)(vv[j].x & 0xffffu); VT[(v0 + 1) * VP + s] = (bf16_t)(vv[j].x >> 16);
            VT[(v0 + 2) * VP + s] = (bf16_t)(vv[j].y & 0xffffu); VT[(v0 + 3) * VP + s] = (bf16_t)(vv[j].y >> 16);
            VT[(v0 + 4) * VP + s] = (bf16_t)(vv[j].z & 0xffffu); VT[(v0 + 5) * VP + s] = (bf16_t)(vv[j].z >> 16);
            VT[(v0 + 6) * VP + s] = (bf16_t)(vv[j].w & 0xffffu); VT[(v0 + 7) * VP + s] = (bf16_t)(vv[j].w >> 16); }
        if (sg == 0) Dd[item * 128 + k] = __expf(blast);
        __syncthreads();
        const bf16x8 a0 = *(const LAS bf16x8*)(VT + (16 * wave + fr) * VP + fq * 8), a1 = *(const LAS bf16x8*)(VT + (16 * wave + fr) * VP + 32 + fq * 8);
        float* up = U + (size_t)item * 16384 + (16 * wave + 4 * fq) * 128 + fr;
#pragma unroll
        for (int kt = 0; kt < 8; ++kt) {
            const bf16x8 b0 = *(const LAS bf16x8*)(KT + (16 * kt + fr) * VP + fq * 8), b1 = *(const LAS bf16x8*)(KT + (16 * kt + fr) * VP + 32 + fq * 8);
            f32x4 acc = {0.f, 0.f, 0.f, 0.f};
            acc = MFMA16(a0, b0, acc); acc = MFMA16(a1, b1, acc);
            up[16 * kt] = acc[0]; up[16 * kt + 128] = acc[1]; up[16 * kt + 256] = acc[2]; up[16 * kt + 384] = acc[3];
        }
        __syncthreads();
    }
}

__device__ __forceinline__ void hgrn_scan(const Args& a) {
    unsigned char* ws = a.ws;
    const float* U = (const float*)(ws + WS_U); const float* Dd = (const float*)(ws + WS_DD); bf16_t* SP = (bf16_t*)(ws + WS_S);
    for (int e = (blockIdx.x * 512 + threadIdx.x) * 4; e < 32 * 16384; e += gridDim.x * 512 * 4) {
        const int bh = e >> 14, vk = e & 16383, bb = bh >> 3, h = bh & 7;
        f32x4 S = {0.f, 0.f, 0.f, 0.f};
#pragma unroll 8
        for (int ci = 0; ci < 32; ++ci) {
            const size_t item = (size_t)((bb * 32 + ci) * 8 + h);
            const f32x4 u = *(const f32x4*)(U + item * 16384 + vk); const f32x4 d = *(const f32x4*)(Dd + item * 128 + (vk & 127));
            u32x2 w; w.x = cvt_pk_bf16(S[0], S[1]); w.y = cvt_pk_bf16(S[2], S[3]); *(u32x2*)(SP + item * 16384 + vk) = w;
            S = d * S + u;
        }
    }
}

__device__ __forceinline__ void conv_mixer(const Args& a, int wave, int lane) {
    unsigned char* ws = a.ws;
    const bf16_t* BC = (const bf16_t*)(ws + WS_BC); const bf16_t* UC = (const bf16_t*)(ws + WS_UC); bf16_t* MIX = (bf16_t*)(ws + WS_MIX);
    const float* cn = a.in[11]; const float* cw = a.in[8];
    const int gw = blockIdx.x * 8 + wave, NGW = gridDim.x * 8;
    for (int it = gw; it < M_TOK * 2; it += NGW) {
        const int row = it >> 1, c = (it & 1) * 512 + lane * 8, t = row & (SEQ - 1);
        const size_t off = (size_t)row * CW + c;
        const u32x4 z = {0u, 0u, 0u, 0u};
        const u32x4 u0 = *(const u32x4*)(UC + off), u1 = t >= 1 ? *(const u32x4*)(UC + off - CW) : z, u2 = t >= 2 ? *(const u32x4*)(UC + off - 2 * CW) : z, bg = *(const u32x4*)(BC + off);
        float y[8]; float ssq = 0.f;
#pragma unroll
        for (int q = 0; q < 4; ++q) {
            const unsigned a0 = u0[q], a1 = u1[q], a2 = u2[q], bb = bg[q]; const int cc = c + 2 * q;
            y[2 * q] = bflo(bb) * (cw[cc] * bflo(a2) + cw[CW + cc] * bflo(a1) + cw[2 * CW + cc] * bflo(a0));
            y[2 * q + 1] = bfhi(bb) * (cw[cc + 1] * bfhi(a2) + cw[CW + cc + 1] * bfhi(a1) + cw[2 * CW + cc + 1] * bfhi(a0));
            ssq += y[2 * q] * y[2 * q] + y[2 * q + 1] * y[2 * q + 1];
        }
        ssq += __shfl_xor(ssq, 1); ssq += __shfl_xor(ssq, 2); ssq += __shfl_xor(ssq, 4); ssq += __shfl_xor(ssq, 8);
        const float ri = rsqrtf(ssq * (1.0f / 128) + EPS);
        u32x4 w;
        w.x = cvt_pk_bf16(y[0] * ri * cn[c], y[1] * ri * cn[c + 1]); w.y = cvt_pk_bf16(y[2] * ri * cn[c + 2], y[3] * ri * cn[c + 3]);
        w.z = cvt_pk_bf16(y[4] * ri * cn[c + 4], y[5] * ri * cn[c + 5]); w.w = cvt_pk_bf16(y[6] * ri * cn[c + 6], y[7] * ri * cn[c + 7]);
        *(u32x4*)(MIX + (size_t)row * DM + HW + c) = w;
    }
}

__device__ __forceinline__ void hgrn_pass_c(const Args& a, LAS unsigned char* lds, int wave, int lane) {
    unsigned char* ws = a.ws;
    const float* LF = (const float*)(ws + WS_LF); const bf16_t* VH = (const bf16_t*)(ws + WS_VH); const bf16_t* QS = (const bf16_t*)(ws + WS_QS); const bf16_t* GH = (const bf16_t*)(ws + WS_GH);
    const bf16_t* SP = (const bf16_t*)(ws + WS_S); bf16_t* MIX = (bf16_t*)(ws + WS_MIX); const float* hn = a.in[10];
    const int tid = threadIdx.x, k = tid & 127, sg = tid >> 7, fr = lane & 15, fq = lane >> 4;
    LAS bf16_t* QT = (LAS bf16_t*)(lds + L_QT); LAS bf16_t* QH = (LAS bf16_t*)(lds + L_QH); LAS bf16_t* KA = (LAS bf16_t*)(lds + L_KA); LAS bf16_t* KB = (LAS bf16_t*)(lds + L_KB);
    LAS bf16_t* ST = (LAS bf16_t*)(lds + L_ST); LAS bf16_t* VT = (LAS bf16_t*)(lds + L_VT); LAS bf16_t* P = (LAS bf16_t*)(lds + L_P);
    LAS float* SEG = (LAS float*)(lds + L_SEG); LAS float* PART = (LAS float*)(lds + L_PART); LAS float* RINV = (LAS float*)(lds + L_RINV);
    for (int item = blockIdx.x; item < 1024; item += gridDim.x) {
        const int row0 = (item >> 3) * 64, cb = (item & 7) * 128;
        float lf[16], b[16]; bf16_t qh[16];
#pragma unroll
        for (int i = 0; i < 16; ++i) { lf[i] = LF[(size_t)(row0 + 16 * sg + i) * HW + cb + k]; qh[i] = QS[(size_t)(row0 + 16 * sg + i) * HW + cb + k]; }
        u32x4 vv[2], sv[4];
#pragma unroll
        for (int j = 0; j < 2; ++j) { const int idx = tid + 512 * j; vv[j] = *(const u32x4*)(VH + (size_t)(row0 + (idx >> 4)) * HW + cb + 8 * (idx & 15)); }
#pragma unroll
        for (int j = 0; j < 4; ++j) { const int idx = tid + 512 * j; sv[j] = *(const u32x4*)(SP + (size_t)item * 16384 + (idx >> 4) * 128 + 8 * (idx & 15)); }
        float run = 0.f;
#pragma unroll
        for (int i = 0; i < 16; ++i) { run += lf[i]; b[i] = run; }
        SEG[sg * 128 + k] = run;
        __syncthreads();
        const float s0 = SEG[k], s1 = SEG[128 + k], s2 = SEG[256 + k];
        const float pre = sg == 0 ? 0.f : (sg == 1 ? s0 : (sg == 2 ? s0 + s1 : s0 + s1 + s2));
        const float beta1 = s0 + s1, beta = sg >= 2 ? beta1 : 0.f;
#pragma unroll
        for (int i = 0; i < 16; ++i) {
            const int s = 16 * sg + i; const float bi = pre + b[i], kk = 1.0f - __expf(lf[i]), qv = bf2f(qh[i]);
            QT[s * HP + k] = f2bf(qv * __expf(bi - beta)); QH[s * HP + k] = f2bf(qv * __expf(bi));
            KA[s * HP + k] = f2bf(kk * __expf(fminf(beta - bi, 80.f)));
            if (sg < 2) KB[s * HP + k] = f2bf(kk * __expf(beta1 - bi));
        }
#pragma unroll
        for (int j = 0; j < 2; ++j) { const int idx = tid + 512 * j, s = idx >> 4, v0 = 8 * (idx & 15);
            VT[(v0 + 0) * VP + s] = (bf16_t)(vv[j].x & 0xffffu); VT[(v0 + 1) * VP + s] = (bf16_t)(vv[j].x >> 16);
            VT[(v0 + 2) * VP + s] = (bf16_t)(vv[j].y & 0xffffu); VT[(v0 + 3) * VP + s] = (bf16_t)(vv[j].y >> 16);
            VT[(v0 + 4) * VP + s] = (bf16_t)(vv[j].z & 0xffffu); VT[(v0 + 5) * VP + s] = (bf16_t)(vv[j].z >> 16);
            VT[(v0 + 6) * VP + s] = (bf16_t)(vv[j].w & 0xffffu); VT[(v0 + 7) * VP + s] = (bf16_t)(vv[j].w >> 16); }
#pragma unroll
        for (int j = 0; j < 4; ++j) { const int idx = tid + 512 * j; *(LAS u32x4*)(ST + (idx >> 4) * HP + 8 * (idx & 15)) = sv[j]; }
        __syncthreads();
#pragma unroll
        for (int pp = 0; pp < 2; ++pp) {
            const int p = wave + 8 * pp, tt = p >> 2, st = p & 3;
            f32x4 acc = {0.f, 0.f, 0.f, 0.f};
            if (st <= tt) {
                const LAS bf16_t* kb = (tt >= 2 && st < 2) ? KB : KA;
#pragma unroll
                for (int ks = 0; ks < 4; ++ks) { const bf16x8 af = *(const LAS bf16x8*)(QT + (16 * tt + fr) * HP + ks * 32 + fq * 8), bfr = *(const LAS bf16x8*)(kb + (16 * st + fr) * HP + ks * 32 + fq * 8);
                    acc = MFMA16(af, bfr, acc); }
            }
#pragma unroll
            for (int r = 0; r < 4; ++r) { const bool keep = (st < tt) || (st == tt && fr <= 4 * fq + r); P[(16 * tt + 4 * fq + r) * VP + 16 * st + fr] = f2bf(keep ? acc[r] : 0.f); }
        }
        __syncthreads();
        bf16x8 bs[4], bv[2];
#pragma unroll
        for (int ks = 0; ks < 4; ++ks) bs[ks] = *(const LAS bf16x8*)(ST + (16 * wave + fr) * HP + ks * 32 + fq * 8);
#pragma unroll
        for (int ks = 0; ks < 2; ++ks) bv[ks] = *(const LAS bf16x8*)(VT + (16 * wave + fr) * VP + ks * 32 + fq * 8);
        f32x4 o[4];
#pragma unroll
        for (int tt = 0; tt < 4; ++tt) {
            f32x4 acc = {0.f, 0.f, 0.f, 0.f};
#pragma unroll
            for (int ks = 0; ks < 4; ++ks) { const bf16x8 af = *(const LAS bf16x8*)(QH + (16 * tt + fr) * HP + ks * 32 + fq * 8); acc = MFMA16(af, bs[ks], acc); }
            { const bf16x8 af = *(const LAS bf16x8*)(P + (16 * tt + fr) * VP + fq * 8); acc = MFMA16(af, bv[0], acc); }
            if (tt >= 2) { const bf16x8 af = *(const LAS bf16x8*)(P + (16 * tt + fr) * VP + 32 + fq * 8); acc = MFMA16(af, bv[1], acc); }
            o[tt] = acc;
        }
#pragma unroll
        for (int tt = 0; tt < 4; ++tt)
#pragma unroll
            for (int r = 0; r < 4; ++r) { float x = o[tt][r] * o[tt][r]; x += __shfl_xor(x, 1); x += __shfl_xor(x, 2); x += __shfl_xor(x, 4); x += __shfl_xor(x, 8);
                if (fr == 0) PART[wave * 64 + 16 * tt + 4 * fq + r] = x; }
        __syncthreads();
        if (tid < 64) { float s = 0.f;
#pragma unroll
            for (int w = 0; w < 8; ++w) s += PART[w * 64 + tid];
            RINV[tid] = rsqrtf(s * (1.0f / 128) + EPS); }
        __syncthreads();
        const float hnv = hn[16 * wave + fr];
#pragma unroll
        for (int tt = 0; tt < 4; ++tt)
#pragma unroll
            for (int r = 0; r < 4; ++r) { const int t = 16 * tt + 4 * fq + r; const size_t row = (size_t)(row0 + t);
                const float g = bf2f(GH[row * HW + cb + 16 * wave + fr]);
                MIX[row * DM + cb + 16 * wave + fr] = f2bf(o[tt][r] * RINV[t] * hnv * g); }
        __syncthreads();
    }
}

__device__ __forceinline__ void phase_final(const Args& a, int wave, int lane) {
    const int gw = blockIdx.x * 8 + wave, NGW = gridDim.x * 8; const float* gF = a.in[20]; const bf16_t* H4 = (const bf16_t*)(a.ws + WS_MIX);
    for (int m = gw; m < M_TOK; m += NGW) {
        const u32x4* hr = (const u32x4*)(H4 + (size_t)m * DM) + lane; u32x4 w[4]; float s = 0.f;
#pragma unroll
        for (int j = 0; j < 4; ++j) { w[j] = hr[64 * j];
            s += (bflo(w[j].x) * bflo(w[j].x) + bfhi(w[j].x) * bfhi(w[j].x)) + (bflo(w[j].y) * bflo(w[j].y) + bfhi(w[j].y) * bfhi(w[j].y))
               + (bflo(w[j].z) * bflo(w[j].z) + bfhi(w[j].z) * bfhi(w[j].z)) + (bflo(w[j].w) * bflo(w[j].w) + bfhi(w[j].w) * bfhi(w[j].w)); }
        const float ri = rinv_of(wave_sum(s));
        f32x4* orow = (f32x4*)(a.out + (size_t)m * DM);
#pragma unroll
        for (int j = 0; j < 4; ++j) { const int c = (64 * j + lane) * 8; const f32x4 g0 = *(const f32x4*)(gF + c), g1 = *(const f32x4*)(gF + c + 4);
            f32x4 o0, o1; o0[0] = bflo(w[j].x) * ri * g0[0]; o0[1] = bfhi(w[j].x) * ri * g0[1]; o0[2] = bflo(w[j].y) * ri * g0[2]; o0[3] = bfhi(w[j].y) * ri * g0[3];
            o1[0] = bflo(w[j].z) * ri * g1[0]; o1[1] = bfhi(w[j].z) * ri * g1[1]; o1[2] = bflo(w[j].w) * ri * g1[2]; o1[3] = bfhi(w[j].w) * ri * g1[3];
            orow[c / 4] = o0; orow[c / 4 + 1] = o1; }
    }
}

#define XB_TMO      128
#define XB_XCNT(j)  (256  + 64 * (j))
#define XB_XSUB(j)  (1280 + 64 * (j))
#define XB_XGEN(j)  (2304 + 64 * (j))
#define XB_TOP      3328
#define XB_TOPGEN   3392
#define XCD_BAR_WORDS 3456
#define XB_SPIN_CAP (1u << 18)

__device__ __forceinline__ unsigned xb_ld(unsigned* p)              { return __hip_atomic_load(p, __ATOMIC_RELAXED, __HIP_MEMORY_SCOPE_AGENT); }
__device__ __forceinline__ unsigned xb_add(unsigned* p, unsigned v) { return __hip_atomic_fetch_add(p, v, __ATOMIC_RELAXED, __HIP_MEMORY_SCOPE_AGENT); }
__device__ __forceinline__ unsigned xb_xcc_id() { return (unsigned)__builtin_amdgcn_s_getreg((3 << 11) | 20) & 0xFu; }
#define XB_SPIN(cond, bar) do { unsigned _sp = 0; while (cond) { __builtin_amdgcn_s_sleep(1); \
    if ((++_sp & 255u) == 0u) { if (xb_ld(&(bar)[XB_TMO])) break; if (_sp > XB_SPIN_CAP) { atomicAdd(&(bar)[XB_TMO], 1u); break; } } } } while (0)

struct XcdBarrier {
    unsigned* bar; unsigned x;
    volatile LAS unsigned* st;
};

__device__ __forceinline__ XcdBarrier xcd_barrier_post(unsigned* bar, volatile LAS unsigned* st) {
    XcdBarrier b; b.bar = bar; b.x = xb_xcc_id(); b.st = st;
    if (threadIdx.x == 0) (void)xb_add(&bar[XB_XCNT(b.x)], 1u);
    return b;
}
__device__ __forceinline__ void xcd_barrier_complete(unsigned* bar, unsigned x, unsigned& nloc, unsigned& nx) {
    const unsigned G = gridDim.x * gridDim.y * gridDim.z;
    unsigned sum, cnt, mine, sp = 0u;
    for (;;) {
        sum = 0u; cnt = 0u; mine = 0u;
#pragma unroll
        for (unsigned j = 0; j < 16; ++j) { const unsigned c = xb_ld(&bar[XB_XCNT(j)]); sum += c; cnt += (c > 0u) ? 1u : 0u; mine = (j == x) ? c : mine; }
        if (sum == G) break;
        __builtin_amdgcn_s_sleep(1);
        if ((++sp & 255u) == 0u) { if (xb_ld(&bar[XB_TMO])) break; if (sp > XB_SPIN_CAP) { atomicAdd(&bar[XB_TMO], 1u); break; } }
    }
    nloc = mine > 0u ? mine : 1u; nx = cnt > 0u ? cnt : 1u;
}

__device__ __forceinline__ void xcd_barrier(const XcdBarrier& b) {
    asm volatile("s_waitcnt vmcnt(0)" ::: "memory");
    __syncthreads();
    if (threadIdx.x == 0) {
        unsigned* bar = b.bar;
        __builtin_amdgcn_s_waitcnt(0);
        unsigned nloc = b.st[0], nx = b.st[1];
        if (nloc == 0u) { xcd_barrier_complete(bar, b.x, nloc, nx); b.st[0] = nloc; b.st[1] = nx; }
        const unsigned old = xb_add(&bar[XB_XSUB(b.x)], 1u);
        const unsigned gen = old / nloc;
        if (old + 1u == (gen + 1u) * nloc) {
            __builtin_amdgcn_fence(__ATOMIC_RELEASE, "agent");
            asm volatile("s_waitcnt vmcnt(0)" ::: "memory");
            const unsigned og = xb_add(&bar[XB_TOP], 1u);
            const unsigned tg = og / nx;
            if (og + 1u == (tg + 1u) * nx) xb_add(&bar[XB_TOPGEN], 1u);
            else XB_SPIN(xb_ld(&bar[XB_TOPGEN]) == tg, bar);
            __builtin_amdgcn_fence(__ATOMIC_ACQUIRE, "agent");
            xb_add(&bar[XB_XGEN(b.x)], 1u);
            asm volatile("s_waitcnt vmcnt(0)" ::: "memory");
        } else {
            XB_SPIN(xb_ld(&bar[XB_XGEN(b.x)]) == gen, bar);
            __builtin_amdgcn_fence(__ATOMIC_ACQUIRE, "agent");
            asm volatile("s_waitcnt vmcnt(0)" ::: "memory");
        }
    }
    __syncthreads();
}


template <class Epi>
__device__ __forceinline__ void run_gemm(LAS unsigned char* lds, const bf16_t* A, const bf16_t* Bt, int N, int K, const Epi& E, int vc) {
    pg8::Gemm g; g.A = A; g.Bt = Bt; g.M = M_TOK; g.N = N; g.K = K;
    pg8::StaticOrder S; S.init(M_TOK, N, (int)gridDim.x, vc);
    pg8::gemm_phase<Epi, pg8::StaticOrder, true, true>(lds, g, S, E);
}
struct TailOrder {
    int c, n;
    __device__ __forceinline__ bool next(int i, Unit& u) const { if (c < 0) return false; const int L = i * n + c; if (L >= 256) return false; u.pm = L >> 3; u.pn = L & 7; return true; }
    __device__ __forceinline__ void a_ready(const Unit&) const {}
    __device__ __forceinline__ void done(const Unit&) const {}
};

__global__ void __launch_bounds__(512, 2) fwd_kernel(Args a) {
    extern __shared__ __attribute__((aligned(16))) unsigned char lds_raw[];
    LAS unsigned char* lds = (LAS unsigned char*)lds_raw;
    cg::grid_group grid = cg::this_grid();
    volatile LAS unsigned* xst = (volatile LAS unsigned*)(lds + LDS_BYTES - 16);
    if (threadIdx.x < 4) xst[threadIdx.x] = 0u;
    __syncthreads();
    XcdBarrier xbar = xcd_barrier_post((unsigned*)(a.ws + WS_BAR), xst);
    unsigned* cen = (unsigned*)(a.ws + WS_BAR) + 3584;
    if (threadIdx.x == 0) xst[2] = xb_add(&cen[64 * xbar.x], 1u);
    if (a.ph_lo == 0 && a.ph_hi == NPHASE) grid.sync();
    int vc = blockIdx.x;
    if (a.ph_lo == 0 && a.ph_hi == NPHASE && gridDim.x == 256) {
        bool even = true;
#pragma unroll
        for (int j = 0; j < 8; ++j) even = even && (xb_ld(&cen[64 * j]) == 32u);
        if (even) vc = (int)xst[2] * 8 + (int)xbar.x;
    }
    vc = __builtin_amdgcn_readfirstlane(vc);
    const int tid = threadIdx.x, lane = tid & 63, wave = __builtin_amdgcn_readfirstlane(tid >> 6);
    unsigned char* ws = a.ws;
    float* SS = (float*)(ws + WS_SS);
    bf16_t* XB = (bf16_t*)(ws + WS_XB); bf16_t* G = (bf16_t*)(ws + WS_G); bf16_t* MIX = (bf16_t*)(ws + WS_MIX);
#define PH(i) if (a.ph_lo <= (i) && (i) < a.ph_hi)
#define SYNC(i) if (a.ph_lo <= (i) && (i) + 1 < a.ph_hi) { xcd_barrier(xbar); }
    PH(0) { phase0(a, lds, wave, lane); } SYNC(0)
    PH(1) { EpiGateUp E; E.G = G; E.ss = SS; run_gemm(lds, XB, (const bf16_t*)(ws + WS_W1GU), 2 * FF, DM, E, vc); conv_tail(a, lds, wave, lane, 32 * 44, CV_T1, CV_END, vc); } SYNC(1)
    PH(2) { EpiResid E; E.XB = XB; E.ss_out = SS + 8192; E.scale = 0.5f; run_gemm(lds, G, (const bf16_t*)(ws + WS_W1D), DM, FF, E, vc); } SYNC(2)
    PH(3) { EpiMixIn E; E.ss = SS + 8192; E.lbl = a.in[9]; E.QS = (bf16_t*)(ws + WS_QS);
            E.UC = (bf16_t*)(ws + WS_UC); E.LF = (float*)(ws + WS_LF); run_gemm(lds, XB, (const bf16_t*)(ws + WS_WIN), MIXIN, DM, E, vc); conv_tail(a, lds, wave, lane, 32 * 28, CV_T0, CV_T1, vc); } SYNC(3)
    PH(4) { hgrn_pass_a(a, lds, wave, lane); } SYNC(4)
    PH(5) { hgrn_scan(a); conv_mixer(a, wave, lane); } SYNC(5)
    PH(6) { hgrn_pass_c(a, lds, wave, lane); } SYNC(6)
    PH(7) { EpiResid E; E.XB = XB; E.ss_out = SS + 16384; E.scale = 1.0f; run_gemm(lds, MIX, (const bf16_t*)(ws + WS_WOUT), DM, DM, E, vc); } SYNC(7)
    PH(8) { EpiGateUp E; E.G = G; E.ss = SS + 16384; run_gemm(lds, XB, (const bf16_t*)(ws + WS_W2GU), 2 * FF, DM, E, vc);
            { const int r = (32 * 44) % (int)gridDim.x; TailOrder T; T.n = (int)gridDim.x - r; T.c = vc - r;
              EpiStoreBf16 E2; E2.O = (bf16_t*)(ws + WS_PLE); int kp = PLE; asm volatile("" : "+s"(kp));
              pg8::Gemm g2; g2.A = (const bf16_t*)(ws + WS_PB); g2.Bt = (const bf16_t*)(ws + WS_WPE); g2.M = M_TOK; g2.N = DM; g2.K = kp;
              pg8::gemm_phase<EpiStoreBf16, TailOrder, true, true>(lds, g2, T, E2); } } SYNC(8)
    PH(9) { EpiResid E; E.XB = XB; E.ss_out = SS + 24576; E.scale = 0.5f; run_gemm(lds, G, (const bf16_t*)(ws + WS_W2D), DM, FF, E, vc); } SYNC(9)
    PH(10) { EpiPleGate E; E.XB = XB; E.H4 = MIX; E.P = (const bf16_t*)(ws + WS_PLE); E.ss = SS + 24576; run_gemm(lds, XB, (const bf16_t*)(ws + WS_WPG), DM, DM, E, vc); } SYNC(10)
    PH(11) { phase_final(a, wave, lane); }
#undef PH
#undef SYNC
}

#ifndef MK_MULTI
#define MK_MULTI 0
#endif
extern "C" void kernel_launch(void* const* d_in, const int* in_sizes, int n_in, void* d_out, int out_size, void* d_ws, size_t ws_size, hipStream_t stream) {
    static int grid = 0;
    if (grid == 0) {
        if (n_in != 21 || out_size != M_TOK * DM || ws_size < WS_END) { fprintf(stderr, "kernel_launch: unexpected shapes (n_in %d out %d ws %zu need %zu)\n", n_in, out_size, ws_size, (size_t)WS_END); grid = -1; return; }
        int dev = 0, cus = 0, per_cu = 0;
        hipGetDevice(&dev); hipDeviceGetAttribute(&cus, hipDeviceAttributeMultiprocessorCount, dev);
        if (hipFuncSetAttribute((const void*)fwd_kernel, hipFuncAttributeMaxDynamicSharedMemorySize, LDS_BYTES) != hipSuccess) { fprintf(stderr, "kernel_launch: hipFuncSetAttribute failed\n"); grid = -1; return; }
        if (hipOccupancyMaxActiveBlocksPerMultiprocessor(&per_cu, (const void*)fwd_kernel, 512, LDS_BYTES) != hipSuccess || per_cu < 1) { fprintf(stderr, "kernel_launch: occupancy query failed (%d)\n", per_cu); grid = -1; return; }
        grid = cus * per_cu;
    }
    if (grid < 0) return;
    Args a{};
    for (int i = 0; i < 21; ++i) a.in[i] = (const float*)d_in[i];
    a.out = (float*)d_out; a.ws = (unsigned char*)d_ws;
#if MK_MULTI
    for (int p = 0; p < NPHASE; ++p) { a.ph_lo = p; a.ph_hi = p + 1; hipLaunchKernelGGL(fwd_kernel, dim3(grid), dim3(512), LDS_BYTES, stream, a); }
#else
    a.ph_lo = 0; a.ph_hi = NPHASE;
    if (hipMemsetAsync((char*)d_ws + WS_BAR, 0, 4096 * 4, stream) != hipSuccess) { fprintf(stderr, "kernel_launch: memset failed\n"); return; }
    void* args[] = {&a};
    hipError_t e = hipLaunchCooperativeKernel((void*)fwd_kernel, dim3(grid), dim3(512), args, LDS_BYTES, stream);
    if (e != hipSuccess) fprintf(stderr, "cooperative launch failed: %s (grid %d)\n", hipGetErrorString(e), grid);
#endif
}
```

```cpp
#include <hip/hip_runtime.h>
#include <hip/hip_cooperative_groups.h>
#include <cstdio>
#include <cstdint>
namespace pg8 {
#define PG8_LAS __attribute__((address_space(3)))
typedef unsigned short bf16_t;
typedef short bf16x8 __attribute__((ext_vector_type(8)));
typedef float f32x4 __attribute__((ext_vector_type(4)));
typedef unsigned u32x4 __attribute__((ext_vector_type(4)));
constexpr int BM = 256, BK = 64, HALF = 128, HTB = HALF * BK * 2  , STAGE_BYTES = 8 * HTB, NXCD = 8, WGM = 8;

__host__ __device__ __forceinline__ int lds_byte(int r, int c) { const int st = (r >> 4) * 2 + (c >> 5), rr = r & 15, cc = c & 31, ob = rr * 64 + cc * 2; return st * 1024 + (ob ^ (((ob >> 9) & 1) << 5)); }
__host__ __device__ __forceinline__ void stage_rc(int b, int& R, int& C) { const int st = b / 1024, sb = b % 1024, swz = sb ^ (((sb >> 9) & 1) << 5); R = (st >> 1) * 16 + swz / 64; C = (st & 1) * 32 + (swz % 64) / 2; }
__host__ __device__ __forceinline__ int perm32(int rho) { const int n = rho >> 4, i = rho & 15; return 8 * (i >> 2) + 4 * n + (i & 3); }

struct Unit { int pm, pn; };
struct Gemm { const bf16_t* A; const bf16_t* Bt; int M, N, K; };

struct StaticOrder {
    int nM, nN, nwg, G, c;
    __host__ __device__ void init(int M, int N, int G_, int c_) { nM = M / BM; nN = N / BM; nwg = nM * nN; G = G_; c = c_; }
    __host__ __device__ bool next(int i, Unit& u) const {
        const long L = (long)i * G + c; if (L >= nwg) return false;
        int wgid = (int)L; { const int q = nwg / NXCD, r = nwg % NXCD, xcd = wgid % NXCD, off = wgid / NXCD; wgid = (xcd < r ? xcd * (q + 1) : r * (q + 1) + (xcd - r) * q) + off; }
        const int nig = WGM * nN, gid = wgid / nig, fm = gid * WGM, gsz = (nM - fm) < WGM ? (nM - fm) : WGM;
        u.pm = fm + ((wgid % nig) % gsz); u.pn = (wgid % nig) / gsz; return true;
    }
    __device__ __forceinline__ void a_ready(const Unit&) const {}
    __device__ __forceinline__ void done(const Unit&) const {}
};
typedef float f32x2 __attribute__((ext_vector_type(2)));
template <class Epi, class Sched, bool ALIGN_EPI = false, bool SP2 = false>
__device__ __forceinline__ void gemm_phase(PG8_LAS unsigned char* lds, const Gemm g, const Sched& S, const Epi& E) {
    const int tid = threadIdx.x, wid = __builtin_amdgcn_readfirstlane(tid >> 6), lane = tid & 63, wr = wid >> 2, wc = wid & 3, fr = lane & 15, fq = lane >> 4;
    const int K = g.K, nt = K / BK;
    unsigned voffA[2], voffB[2];
#pragma unroll
    for (int i = 0; i < 2; ++i) { int R, C; stage_rc(tid * 16 + i * 8192, R, C); const int Rb = Epi::PERM ? ((R & ~31) + perm32(R & 31)) : R;
        voffA[i] = (unsigned)(R * K + C) * 2u; voffB[i] = (unsigned)(Rb * K + C) * 2u; }
    const size_t kstep = (size_t)(BK * 2);
    const size_t hstep = (size_t)HALF * K * 2;
    const size_t tstep = 2 * hstep;
    const unsigned ldsw = (unsigned)wid * 1024u;
    const int aoff = lds_byte(wr * 64 + fr, fq * 8), boff = lds_byte(wc * 32 + fr, fq * 8);
#define PG8_SA(b, h) (((b) * 2 + (h)) * HTB)
#define PG8_SB(b, h) ((4 + (b) * 2 + (h)) * HTB)
#define PG8_STAGE(bufoff, gbase, voff) do { _Pragma("unroll") for (int _i = 0; _i < 2; ++_i) \
        __builtin_amdgcn_global_load_lds((const unsigned*)((const char*)(gbase) + (voff)[_i]), (PG8_LAS unsigned*)(lds + (bufoff) + ldsw + _i * 8192), 16, 0, 0); } while (0)
#define PG8_LDA(dst, b, h) do { _Pragma("unroll") for (int m = 0; m < 4; ++m) _Pragma("unroll") for (int k = 0; k < 2; ++k) dst[m][k] = *(const PG8_LAS bf16x8*)(lds + PG8_SA(b, h) + aoff + m * 2048 + k * 1024); } while (0)
#define PG8_LDB(dst, b, h) do { _Pragma("unroll") for (int n = 0; n < 2; ++n) _Pragma("unroll") for (int k = 0; k < 2; ++k) dst[n][k] = *(const PG8_LAS bf16x8*)(lds + PG8_SB(b, h) + boff + n * 2048 + k * 1024); } while (0)
#define PG8_MMA(ai, bj, At, Bt) do { __builtin_amdgcn_s_setprio(1); _Pragma("unroll") for (int m = 0; m < 4; ++m) _Pragma("unroll") for (int n = 0; n < 2; ++n) _Pragma("unroll") for (int k = 0; k < 2; ++k) \
        acc[ai][bj][m][n] = __builtin_amdgcn_mfma_f32_16x16x32_bf16(Bt[n][k], At[m][k], acc[ai][bj][m][n], 0, 0, 0); __builtin_amdgcn_s_setprio(0); } while (0)
#define PG8_WAIT_V(n) asm volatile("s_waitcnt vmcnt(" #n ")" ::: "memory")
#define PG8_WAIT_L(n) asm volatile("s_waitcnt lgkmcnt(" #n ")" ::: "memory")
#define PG8_BAR __builtin_amdgcn_s_barrier()
#define PG8_SCHED __builtin_amdgcn_sched_barrier(0)
    Unit cur, nxt; int ui = 0;
    if (!S.next(0, cur)) return;
    f32x4 acc[2][2][4][2];
#pragma unroll
    for (int a = 0; a < 2; ++a)
#pragma unroll
        for (int b = 0; b < 2; ++b)
#pragma unroll
            for (int m = 0; m < 4; ++m)
#pragma unroll
                for (int n = 0; n < 2; ++n) acc[a][b][m][n] = (f32x4){0.f, 0.f, 0.f, 0.f};
    bf16x8 At[4][2], B0[2][2], B1[2][2];
    const char* cA = (const char*)g.A + (size_t)cur.pm * tstep; const char* cB = (const char*)g.Bt + (size_t)cur.pn * tstep;
    S.a_ready(cur);
    if constexpr (SP2) {
        PG8_STAGE(PG8_SB(0, 0), cB, voffB); PG8_STAGE(PG8_SB(0, 1), cB + hstep, voffB); PG8_STAGE(PG8_SA(0, 0), cA, voffA); PG8_STAGE(PG8_SA(0, 1), cA + hstep, voffA);
        if (wr == 1) PG8_BAR;
        PG8_WAIT_V(2); PG8_BAR;
        PG8_STAGE(PG8_SB(1, 0), cB + kstep, voffB); PG8_STAGE(PG8_SA(1, 0), cA + kstep, voffA); PG8_STAGE(PG8_SB(1, 1), cB + hstep + kstep, voffB);
        PG8_WAIT_V(6); PG8_BAR;
    } else {
        PG8_STAGE(PG8_SB(0, 0), cB, voffB); PG8_STAGE(PG8_SA(0, 0), cA, voffA); PG8_STAGE(PG8_SB(0, 1), cB + hstep, voffB); PG8_STAGE(PG8_SA(0, 1), cA + hstep, voffA);
        if (wr == 1) PG8_BAR;
        PG8_WAIT_V(4); PG8_BAR;
        PG8_STAGE(PG8_SB(1, 0), cB + kstep, voffB); PG8_STAGE(PG8_SA(1, 0), cA + kstep, voffA); PG8_STAGE(PG8_SB(1, 1), cB + hstep + kstep, voffB);
        PG8_WAIT_V(6); PG8_BAR;
    }
    for (;;) {
        const bool has_next = S.next(ui + 1, nxt);
        const char* nA = has_next ? (const char*)g.A + (size_t)nxt.pm * tstep : cA; const char* nB = has_next ? (const char*)g.Bt + (size_t)nxt.pn * tstep : cB;
        for (int t = 0; t < nt; t += 2) {
            const bool last = (t == nt - 2);
            const char* a1 = cA + (size_t)(t + 1) * kstep;
            const char* a2 = last ? nA : cA + (size_t)(t + 2) * kstep; const char* b2 = last ? nB : cB + (size_t)(t + 2) * kstep;
            const char* a3 = a2 + kstep; const char* b3 = b2 + kstep;
            if (last && has_next) S.a_ready(nxt);
            if constexpr (SP2) {
            PG8_LDB(B0, 0, 0); PG8_LDB(B1, 0, 1); PG8_SCHED; PG8_LDA(At, 0, 0); PG8_STAGE(PG8_SA(1, 1), a1 + hstep, voffA);
            PG8_WAIT_V(8); PG8_WAIT_L(0); PG8_BAR; PG8_MMA(0, 0, At, B0); PG8_MMA(0, 1, At, B1); PG8_BAR; PG8_SCHED;
            PG8_LDA(At, 0, 1); PG8_STAGE(PG8_SB(0, 0), b2, voffB); PG8_STAGE(PG8_SB(0, 1), b2 + hstep, voffB); PG8_STAGE(PG8_SA(0, 0), a2, voffA);
            PG8_WAIT_V(8); PG8_WAIT_L(0); PG8_BAR; PG8_MMA(1, 0, At, B0); PG8_MMA(1, 1, At, B1); PG8_BAR; PG8_SCHED;
            PG8_LDB(B0, 1, 0); PG8_LDB(B1, 1, 1); PG8_SCHED; PG8_LDA(At, 1, 0); PG8_STAGE(PG8_SA(0, 1), a2 + hstep, voffA);
            PG8_WAIT_V(8); PG8_WAIT_L(0); PG8_BAR; PG8_MMA(0, 0, At, B0); PG8_MMA(0, 1, At, B1); PG8_BAR; PG8_SCHED;
            PG8_LDA(At, 1, 1); PG8_STAGE(PG8_SB(1, 0), b3, voffB); PG8_STAGE(PG8_SB(1, 1), b3 + hstep, voffB); PG8_STAGE(PG8_SA(1, 0), a3, voffA);
            PG8_WAIT_V(8); PG8_WAIT_L(0); PG8_BAR; PG8_MMA(1, 0, At, B0); PG8_MMA(1, 1, At, B1); PG8_BAR; PG8_SCHED;
            } else {
            PG8_LDB(B0, 0, 0); PG8_SCHED; PG8_LDA(At, 0, 0); PG8_STAGE(PG8_SA(1, 1), a1 + hstep, voffA);
            PG8_WAIT_L(8); PG8_BAR; PG8_WAIT_L(0); PG8_MMA(0, 0, At, B0); PG8_BAR; PG8_SCHED;
            PG8_LDB(B1, 0, 1); PG8_STAGE(PG8_SB(0, 0), b2, voffB);
            PG8_BAR; PG8_WAIT_L(0); PG8_MMA(0, 1, At, B1); PG8_BAR;
            PG8_LDA(At, 0, 1); PG8_STAGE(PG8_SA(0, 0), a2, voffA);
            PG8_BAR; PG8_WAIT_L(0); PG8_MMA(1, 0, At, B0); PG8_BAR; PG8_SCHED;
            PG8_STAGE(PG8_SB(0, 1), b2 + hstep, voffB);
            PG8_WAIT_V(6); PG8_BAR; PG8_MMA(1, 1, At, B1); PG8_BAR;
            PG8_LDB(B0, 1, 0); PG8_SCHED; PG8_LDA(At, 1, 0); PG8_STAGE(PG8_SA(0, 1), a2 + hstep, voffA);
            PG8_WAIT_L(8); PG8_BAR; PG8_WAIT_L(0); PG8_MMA(0, 0, At, B0); PG8_BAR; PG8_SCHED;
            PG8_LDB(B1, 1, 1); PG8_STAGE(PG8_SB(1, 0), b3, voffB);
            PG8_BAR; PG8_WAIT_L(0); PG8_MMA(0, 1, At, B1); PG8_BAR;
            PG8_LDA(At, 1, 1); PG8_STAGE(PG8_SA(1, 0), a3, voffA);
            PG8_BAR; PG8_WAIT_L(0); PG8_MMA(1, 0, At, B0); PG8_BAR; PG8_SCHED;
            PG8_STAGE(PG8_SB(1, 1), b3 + hstep, voffB);
            PG8_WAIT_V(6); PG8_BAR; PG8_MMA(1, 1, At, B1); PG8_BAR;
            }
        }
        if constexpr (ALIGN_EPI) { if (wr == 0) PG8_BAR; }
        if constexpr (!Epi::AFTER_DRAIN) { E(acc, cur, wr, wc, fr, fq); S.done(cur); }
        if (!has_next) break;
#pragma unroll
        for (int a = 0; a < 2; ++a)
#pragma unroll
            for (int b = 0; b < 2; ++b)
#pragma unroll
                for (int m = 0; m < 4; ++m)
#pragma unroll
                    for (int n = 0; n < 2; ++n) acc[a][b][m][n] = (f32x4){0.f, 0.f, 0.f, 0.f};
        cur = nxt; cA = nA; cB = nB; ++ui;
        if constexpr (ALIGN_EPI) { if (wr == 1) PG8_BAR; }
    }
    PG8_WAIT_V(0);
    if constexpr (!ALIGN_EPI) { if (wr == 0) PG8_BAR; }
    PG8_BAR;
    if constexpr (Epi::AFTER_DRAIN) { E.fused(acc, cur, wr, wc, fr, fq, lds, wid, lane); S.done(cur); }
#undef PG8_SA
#undef PG8_SB
#undef PG8_STAGE
#undef PG8_LDA
#undef PG8_LDB
#undef PG8_MMA
#undef PG8_WAIT_V
#undef PG8_WAIT_L
#undef PG8_BAR
#undef PG8_SCHED
}
}

namespace cg = cooperative_groups;
using pg8::bf16_t; using pg8::bf16x8; using pg8::f32x4; using pg8::u32x4; using pg8::Unit;
__device__ __forceinline__ unsigned cvt_pk_bf16(float lo, float hi) { unsigned r; asm volatile("v_cvt_pk_bf16_f32 %0, %1, %2" : "=v"(r) : "v"(lo), "v"(hi)); return r; }
#define LAS __attribute__((address_space(3)))
typedef unsigned u32x2 __attribute__((ext_vector_type(2)));
typedef float f32x2v __attribute__((ext_vector_type(2)));

constexpr int M_TOK = 8192, DM = 2048, FF = 5632, HW = 1024, CW = 1024, MIXIN = 7168, PLE = 256, SEQ = 2048;
constexpr float EPS = 1e-6f;
constexpr size_t MiB = 1ull << 20;
constexpr size_t WS_W1GU = 0, WS_W1D = 44 * MiB, WS_WIN = 66 * MiB, WS_WOUT = 94 * MiB, WS_W2GU = 102 * MiB, WS_W2D = 146 * MiB,
                 WS_WPG = 168 * MiB, WS_WPE = 176 * MiB, WS_PB = 177 * MiB, WS_XB = 181 * MiB, WS_MIX = 213 * MiB, WS_G = 245 * MiB,
                 WS_QS = 245 * MiB, WS_VH = 261 * MiB, WS_GH = 277 * MiB, WS_BC = 293 * MiB, WS_UC = 309 * MiB, WS_LF = 325 * MiB,
                 WS_S = 357 * MiB, WS_PLE = 0, WS_SS = 389 * MiB, WS_DD = 389 * MiB + 512 * 1024, WS_BAR = 390 * MiB + 512 * 1024, WS_END = 391 * MiB, WS_U = 0;
constexpr int LDS_BYTES = 144 * 1024;
constexpr int NPHASE = 12;

__device__ __forceinline__ float bf2f(bf16_t b) { return __uint_as_float(((unsigned)b) << 16); }
__device__ __forceinline__ float bflo(unsigned w) { return __uint_as_float(w << 16); }
__device__ __forceinline__ float bfhi(unsigned w) { return __uint_as_float(w & 0xffff0000u); }
__device__ __forceinline__ float wave_sum(float v) {
#pragma unroll
    for (int o = 1; o < 64; o <<= 1) v += __shfl_xor(v, o);
    return v;
}
__device__ __forceinline__ float fsigmoid(float x) { return __builtin_amdgcn_rcpf(1.0f + __expf(-x)); }
__device__ __forceinline__ float fsilu(float x) { return x * fsigmoid(x); }
__device__ __forceinline__ float rinv_of(float ss) { return rsqrtf(ss * (1.0f / DM) + EPS); }

struct EpiGateUp {
    static constexpr bool PERM = true, AFTER_DRAIN = false;
    bf16_t* G; const float* ss;
    __device__ __forceinline__ void operator()(const f32x4 (&acc)[2][2][4][2], const Unit& u, int wr, int wc, int fr, int fq) const {
        const int row0 = u.pm * 256 + wr * 64 + fr, col0 = u.pn * 128 + wc * 32 + 8 * fq;
#pragma unroll
        for (int ai = 0; ai < 2; ++ai)
#pragma unroll
            for (int m = 0; m < 4; ++m) {
                const int r = row0 + ai * 128 + m * 16; const float ri = rinv_of(ss[r]);
                float v[8];
#pragma unroll
                for (int n = 0; n < 2; ++n)
#pragma unroll
                    for (int j = 0; j < 4; ++j) v[n * 4 + j] = fsilu(acc[ai][0][m][n][j] * ri) * (acc[ai][1][m][n][j] * ri);
                u32x4 w; w.x = cvt_pk_bf16(v[0], v[1]); w.y = cvt_pk_bf16(v[2], v[3]); w.z = cvt_pk_bf16(v[4], v[5]); w.w = cvt_pk_bf16(v[6], v[7]);
                *(u32x4*)(G + (size_t)r * FF + col0) = w;
            }
    }
};
struct EpiResid {
    static constexpr bool PERM = true, AFTER_DRAIN = false;
    bf16_t* XB; float* ss_out; float scale;
    __device__ __forceinline__ void operator()(f32x4 (&acc)[2][2][4][2], const Unit& u, int wr, int wc, int fr, int fq) const {
        const int row0 = u.pm * 256 + wr * 64 + fr, col0 = u.pn * 256 + wc * 32 + 8 * fq;
#pragma unroll
        for (int ai = 0; ai < 2; ++ai) {
#pragma unroll
            for (int m = 0; m < 4; ++m)
#pragma unroll
                for (int bj = 0; bj < 2; ++bj) {
                    const size_t off = (size_t)(row0 + ai * 128 + m * 16) * DM + col0 + bj * 128;
                    const u32x4 xw = *(const u32x4*)(XB + off);
                    f32x4 r0, r1; r0[0] = bflo(xw.x); r0[1] = bfhi(xw.x); r0[2] = bflo(xw.y); r0[3] = bfhi(xw.y); r1[0] = bflo(xw.z); r1[1] = bfhi(xw.z); r1[2] = bflo(xw.w); r1[3] = bfhi(xw.w);
                    acc[ai][bj][m][0] = r0 + acc[ai][bj][m][0] * scale; acc[ai][bj][m][1] = r1 + acc[ai][bj][m][1] * scale;
                }
            asm volatile("" ::: "memory");
#pragma unroll
            for (int m = 0; m < 4; ++m) {
                const int r = row0 + ai * 128 + m * 16; float sq = 0.f;
#pragma unroll
                for (int bj = 0; bj < 2; ++bj) {
                    const size_t off = (size_t)r * DM + col0 + bj * 128;
                    const f32x4 v0 = acc[ai][bj][m][0], v1 = acc[ai][bj][m][1];
                    u32x4 w; w.x = cvt_pk_bf16(v0[0], v0[1]); w.y = cvt_pk_bf16(v0[2], v0[3]); w.z = cvt_pk_bf16(v1[0], v1[1]); w.w = cvt_pk_bf16(v1[2], v1[3]);
                    *(u32x4*)(XB + off) = w;
                    sq += (v0[0] * v0[0] + v0[1] * v0[1]) + (v0[2] * v0[2] + v0[3] * v0[3]) + (v1[0] * v1[0] + v1[1] * v1[1]) + (v1[2] * v1[2] + v1[3] * v1[3]);
                }
                sq += __shfl_xor(sq, 16); sq += __shfl_xor(sq, 32);
                if (fq == 0) atomicAdd(ss_out + r, sq);
            }
            asm volatile("" ::: "memory");
        }
    }
};
struct EpiMixIn {
    static constexpr bool PERM = true, AFTER_DRAIN = false;
    const float* ss; const float* lbl;
    bf16_t *QS, *UC; float* LF;
    __device__ __forceinline__ void operator()(const f32x4 (&acc)[2][2][4][2], const Unit& u, int wr, int wc, int fr, int fq) const {
        const int row0 = u.pm * 256 + wr * 64 + fr; const int sec = u.pn >> 2;
        if (u.pn >= 20) {
            const int col0 = (u.pn - 20) * 128 + wc * 32 + 8 * fq;
#pragma unroll
            for (int ai = 0; ai < 2; ++ai)
#pragma unroll
                for (int m = 0; m < 4; ++m) {
                    const int r = row0 + ai * 128 + m * 16; const float ri = rinv_of(ss[r]); const float ri2 = ri * ri;
                    float v[8];
#pragma unroll
                    for (int n = 0; n < 2; ++n)
#pragma unroll
                        for (int j = 0; j < 4; ++j) v[n * 4 + j] = acc[ai][0][m][n][j] * acc[ai][1][m][n][j] * ri2;
                    u32x4 w; w.x = cvt_pk_bf16(v[0], v[1]); w.y = cvt_pk_bf16(v[2], v[3]); w.z = cvt_pk_bf16(v[4], v[5]); w.w = cvt_pk_bf16(v[6], v[7]);
                    *(u32x4*)(UC + (size_t)r * CW + col0) = w;
                }
            return;
        }
        const int col0 = (u.pn & 3) * 256 + wc * 32 + 8 * fq;
        if (sec == 1) {
#pragma unroll
            for (int bj = 0; bj < 2; ++bj)
#pragma unroll
                for (int n = 0; n < 2; ++n) {
                    const int c = col0 + bj * 128 + 4 * n; const f32x4 l0 = *(const f32x4*)(lbl + c), l1 = *(const f32x4*)(lbl + 1024 + c);
                    f32x4 lb; lb[0] = fsigmoid(l0[0] - l1[0]); lb[1] = fsigmoid(l0[1] - l1[1]); lb[2] = fsigmoid(l0[2] - l1[2]); lb[3] = fsigmoid(l0[3] - l1[3]);
#pragma unroll
                    for (int ai = 0; ai < 2; ++ai)
#pragma unroll
                        for (int m = 0; m < 4; ++m) {
                            const int r = row0 + ai * 128 + m * 16; const float ri = rinv_of(ss[r]);
                            const f32x4 x = acc[ai][bj][m][n]; f32x4 o;
                            o[0] = __logf(lb[0] + (1.0f - lb[0]) * fsigmoid(x[0] * ri)); o[1] = __logf(lb[1] + (1.0f - lb[1]) * fsigmoid(x[1] * ri));
                            o[2] = __logf(lb[2] + (1.0f - lb[2]) * fsigmoid(x[2] * ri)); o[3] = __logf(lb[3] + (1.0f - lb[3]) * fsigmoid(x[3] * ri));
                            *(f32x4*)(LF + (size_t)r * HW + c) = o;
                        }
                }
            return;
        }
        bf16_t* dst = QS + (size_t)(sec == 0 ? 0 : sec - 1) * ((size_t)M_TOK * HW);
        const bool act = (sec == 0 || sec == 3);
#pragma unroll
        for (int ai = 0; ai < 2; ++ai)
#pragma unroll
            for (int m = 0; m < 4; ++m) {
                const int r = row0 + ai * 128 + m * 16; const float ri = rinv_of(ss[r]);
#pragma unroll
                for (int bj = 0; bj < 2; ++bj) {
                    float v[8];
#pragma unroll
                    for (int n = 0; n < 2; ++n)
#pragma unroll
                        for (int j = 0; j < 4; ++j) { const float x = acc[ai][bj][m][n][j] * ri; v[n * 4 + j] = act ? fsilu(x) : x; }
                    u32x4 w; w.x = cvt_pk_bf16(v[0], v[1]); w.y = cvt_pk_bf16(v[2], v[3]); w.z = cvt_pk_bf16(v[4], v[5]); w.w = cvt_pk_bf16(v[6], v[7]);
                    *(u32x4*)(dst + (size_t)r * HW + col0 + bj * 128) = w;
                }
            }
    }
};
struct EpiStoreBf16 {
    static constexpr bool PERM = true, AFTER_DRAIN = false;
    bf16_t* O;
    __device__ __forceinline__ void operator()(const f32x4 (&acc)[2][2][4][2], const Unit& u, int wr, int wc, int fr, int fq) const {
        const int row0 = u.pm * 256 + wr * 64 + fr, col0 = u.pn * 256 + wc * 32 + 8 * fq;
#pragma unroll
        for (int ai = 0; ai < 2; ++ai)
#pragma unroll
            for (int m = 0; m < 4; ++m) {
                const int r = row0 + ai * 128 + m * 16;
#pragma unroll
                for (int bj = 0; bj < 2; ++bj) {
                    const f32x4 v0 = acc[ai][bj][m][0], v1 = acc[ai][bj][m][1];
                    u32x4 w; w.x = cvt_pk_bf16(v0[0], v0[1]); w.y = cvt_pk_bf16(v0[2], v0[3]); w.z = cvt_pk_bf16(v1[0], v1[1]); w.w = cvt_pk_bf16(v1[2], v1[3]);
                    *(u32x4*)(O + (size_t)r * DM + col0 + bj * 128) = w;
                }
            }
    }
};
struct EpiPleGate {
    static constexpr bool PERM = true, AFTER_DRAIN = false;
    const bf16_t* XB; const bf16_t* P; bf16_t* H4; const float* ss;
    __device__ __forceinline__ void operator()(f32x4 (&acc)[2][2][4][2], const Unit& u, int wr, int wc, int fr, int fq) const {
        const int row0 = u.pm * 256 + wr * 64 + fr, col0 = u.pn * 256 + wc * 32 + 8 * fq;
#pragma unroll
        for (int ai = 0; ai < 2; ++ai)
#pragma unroll
            for (int m = 0; m < 4; ++m) {
                const int r = row0 + ai * 128 + m * 16; const float ri = rinv_of(ss[r]);
#pragma unroll
                for (int bj = 0; bj < 2; ++bj) {
                    const size_t off = (size_t)r * DM + col0 + bj * 128;
                    const u32x4 pw = *(const u32x4*)(P + off), xw = *(const u32x4*)(XB + off);
                    const f32x4 a0 = acc[ai][bj][m][0], a1 = acc[ai][bj][m][1];
                    u32x4 w;
                    w.x = cvt_pk_bf16(bflo(xw.x) + fsigmoid(a0[0] * ri) * bflo(pw.x), bfhi(xw.x) + fsigmoid(a0[1] * ri) * bfhi(pw.x));
                    w.y = cvt_pk_bf16(bflo(xw.y) + fsigmoid(a0[2] * ri) * bflo(pw.y), bfhi(xw.y) + fsigmoid(a0[3] * ri) * bfhi(pw.y));
                    w.z = cvt_pk_bf16(bflo(xw.z) + fsigmoid(a1[0] * ri) * bflo(pw.z), bfhi(xw.z) + fsigmoid(a1[1] * ri) * bfhi(pw.z));
                    w.w = cvt_pk_bf16(bflo(xw.w) + fsigmoid(a1[2] * ri) * bflo(pw.w), bfhi(xw.w) + fsigmoid(a1[3] * ri) * bfhi(pw.w));
                    *(u32x4*)(H4 + off) = w;
                }
            }
    }
};

template <int MODE>
__device__ __forceinline__ void p0_item(const float* W, const float* W2, const float* gain, int K, int N, bf16_t* WT, LAS float* scr, int item, int lane) {
    const int nblk_k = K / 64; const int nb = item / nblk_k, kb = item % nblk_k; const int k0 = 64 * kb, n0 = 32 * nb;
    const float* src = W; int c0 = n0;
    if (MODE == 1) { const int t = n0 >> 8, bj = (n0 >> 7) & 1, c = n0 & 127; src = bj ? W2 : W; c0 = 128 * t + c; }
    if (MODE == 2) { if (n0 >= 5120) { const int tt = n0 - 5120; const int t = tt >> 8, bj = (tt >> 7) & 1, c = tt & 127; c0 = 5120 + 1024 * bj + 128 * t + c; } }
    float v[32], gg[32];
    const float* sp = src + (size_t)(k0 + (lane >> 5)) * N + c0 + (lane & 31);
#pragma unroll
    for (int i = 0; i < 32; ++i) v[i] = sp[(size_t)(2 * i) * N];
    if (gain) {
#pragma unroll
        for (int i = 0; i < 32; ++i) gg[i] = gain[k0 + 2 * i + (lane >> 5)];
#pragma unroll
        for (int i = 0; i < 32; ++i) v[i] *= gg[i];
    }
#pragma unroll
    for (int i = 0; i < 32; ++i) scr[(2 * i + (lane >> 5)) * 33 + (lane & 31)] = v[i];
    asm volatile("s_waitcnt lgkmcnt(0)" ::: "memory");
    const int c = lane & 7;
#pragma unroll
    for (int j = 0; j < 4; ++j) { const int n = (lane >> 3) + 8 * j; const LAS float* s = scr + (8 * c) * 33 + n;
        u32x4 o; o.x = cvt_pk_bf16(s[0 * 33], s[1 * 33]); o.y = cvt_pk_bf16(s[2 * 33], s[3 * 33]); o.z = cvt_pk_bf16(s[4 * 33], s[5 * 33]); o.w = cvt_pk_bf16(s[6 * 33], s[7 * 33]);
        *(u32x4*)(WT + (size_t)(n0 + n) * K + k0 + 8 * c) = o; }
    asm volatile("s_waitcnt lgkmcnt(0)" ::: "memory");
}

struct Args { const float* in[21]; float* out; unsigned char* ws; int ph_lo, ph_hi; };

constexpr int CV_I0 = 32 * 352, CV_I1 = 88 * 64, CV_I2 = 32 * 224, CV_I3 = 32 * 64, CV_I7 = 4 * 64;
constexpr int CV_END = 2 * CV_I0 + 2 * CV_I1 + CV_I2 + 2 * CV_I3 + CV_I7, CV_T1 = CV_END - 10000, CV_T0 = CV_T1 - 10000, CV_TA = CV_I0 + CV_I2 + CV_I3 + CV_I7;
__device__ __forceinline__ void conv_range(const Args& a, LAS unsigned char* lds, int wave, int lane, int lo, int hi, int w0, int nw) {
    unsigned char* ws = a.ws;
    LAS float* scr = (LAS float*)(lds + wave * 16384);
    for (int it = lo + w0; it < hi; it += nw) {
        int r = it;
        if (r < CV_I0) { p0_item<1>(a.in[3], a.in[4], a.in[2], DM, FF, (bf16_t*)(ws + WS_W1GU), scr, r, lane); continue; } r -= CV_I0;
        if (r < CV_I2) { p0_item<2>(a.in[7], nullptr, a.in[6], DM, MIXIN, (bf16_t*)(ws + WS_WIN), scr, r, lane); continue; } r -= CV_I2;
        if (r < CV_I3) { p0_item<0>(a.in[12], nullptr, nullptr, DM, DM, (bf16_t*)(ws + WS_WOUT), scr, r, lane); continue; } r -= CV_I3;
        if (r < CV_I7) { p0_item<0>(a.in[18], nullptr, nullptr, PLE, DM, (bf16_t*)(ws + WS_WPE), scr, r, lane); continue; } r -= CV_I7;
        if (r < CV_I3) { p0_item<0>(a.in[19], nullptr, a.in[17], DM, DM, (bf16_t*)(ws + WS_WPG), scr, r, lane); continue; } r -= CV_I3;
        if (r < CV_I1) { p0_item<0>(a.in[16], nullptr, nullptr, FF, DM, (bf16_t*)(ws + WS_W2D), scr, r, lane); continue; } r -= CV_I1;
        if (r < CV_I0) { p0_item<1>(a.in[14], a.in[15], a.in[13], DM, FF, (bf16_t*)(ws + WS_W2GU), scr, r, lane); continue; } r -= CV_I0;
        p0_item<0>(a.in[5], nullptr, nullptr, FF, DM, (bf16_t*)(ws + WS_W1D), scr, r, lane);
    }
}
__device__ __forceinline__ void conv_tail(const Args& a, LAS unsigned char* lds, int wave, int lane, int nunits, int lo, int hi, int vc) {
    const int r = nunits % (int)gridDim.x;
    if (r == 0) { conv_range(a, lds, wave, lane, lo, hi, vc * 8 + wave, gridDim.x * 8); return; }
    if (vc >= r) conv_range(a, lds, wave, lane, lo, hi, (vc - r) * 8 + wave, ((int)gridDim.x - r) * 8);
}

__device__ __forceinline__ void phase0(const Args& a, LAS unsigned char* lds, int wave, int lane) {
    unsigned char* ws = a.ws;
    const int gw = blockIdx.x * 8 + wave, NGW = gridDim.x * 8;
    conv_range(a, lds, wave, lane, 0, CV_TA, gw, NGW);
    float* SS = (float*)(ws + WS_SS);
    for (int m = gw; m < M_TOK; m += NGW) {
        const f32x4* xr = (const f32x4*)(a.in[0] + (size_t)m * DM) + lane; u32x2* xb = (u32x2*)((bf16_t*)(ws + WS_XB) + (size_t)m * DM) + lane;
        float s = 0.f;
#pragma unroll
        for (int j = 0; j < 8; ++j) { const f32x4 v = xr[64 * j]; s += (v[0] * v[0] + v[1] * v[1]) + (v[2] * v[2] + v[3] * v[3]);
            u32x2 w; w.x = cvt_pk_bf16(v[0], v[1]); w.y = cvt_pk_bf16(v[2], v[3]); xb[64 * j] = w; }
        s = wave_sum(s);
        if (lane == 0) { SS[m] = s; SS[8192 + m] = 0.f; SS[16384 + m] = 0.f; SS[24576 + m] = 0.f; }
    }
    { const int gt = blockIdx.x * 512 + threadIdx.x, NT = gridDim.x * 512;
      for (int i = gt; i < M_TOK * PLE / 4; i += NT) { const f32x4 v = ((const f32x4*)a.in[1])[i]; u32x2 w; w.x = cvt_pk_bf16(v[0], v[1]); w.y = cvt_pk_bf16(v[2], v[3]); ((u32x2*)(ws + WS_PB))[i] = w; } }
}

constexpr int HP = 136, VP = 72;
constexpr int L_QT = 0, L_QH = L_QT + 64 * HP * 2, L_KA = L_QH + 64 * HP * 2, L_KB = L_KA + 64 * HP * 2, L_ST = L_KB + 32 * HP * 2, L_VT = L_ST + 128 * HP * 2,
              L_P = L_VT + 128 * VP * 2, L_SEG = L_P + 64 * VP * 2, L_PART = L_SEG + 4 * 128 * 4, L_RINV = L_PART + 8 * 64 * 4, L_HEND = L_RINV + 256, L_KT = 0;
static_assert(L_HEND <= LDS_BYTES, "LDS");
#define MFMA16(a, b, c) __builtin_amdgcn_mfma_f32_16x16x32_bf16((a), (b), (c), 0, 0, 0)
__device__ __forceinline__ bf16_t f2bf(float x) { return (bf16_t)(cvt_pk_bf16(x, 0.f) & 0xffffu); }

__device__ __forceinline__ void hgrn_pass_a(const Args& a, LAS unsigned char* lds, int wave, int lane) {
    unsigned char* ws = a.ws;
    const float* LF = (const float*)(ws + WS_LF); const bf16_t* VH = (const bf16_t*)(ws + WS_VH); float* U = (float*)(ws + WS_U); float* Dd = (float*)(ws + WS_DD);
    const int tid = threadIdx.x, k = tid & 127, sg = tid >> 7, fr = lane & 15, fq = lane >> 4;
    LAS bf16_t* VT = (LAS bf16_t*)(lds + L_VT); LAS bf16_t* KT = (LAS bf16_t*)(lds + L_KT); LAS float* SEG = (LAS float*)(lds + L_SEG);
    for (int item = blockIdx.x; item < 1024; item += gridDim.x) {
        const int row0 = (item >> 3) * 64, cb = (item & 7) * 128;
        float lf[16], b[16];
#pragma unroll
        for (int i = 0; i < 16; ++i) lf[i] = LF[(size_t)(row0 + 16 * sg + i) * HW + cb + k];
        u32x4 vv[2];
#pragma unroll
        for (int j = 0; j < 2; ++j) { const int idx = tid + 512 * j; vv[j] = *(const u32x4*)(VH + (size_t)(row0 + (idx >> 4)) * HW + cb + 8 * (idx & 15)); }
        float run = 0.f;
#pragma unroll
        for (int i = 0; i < 16; ++i) { run += lf[i]; b[i] = run; }
        SEG[sg * 128 + k] = run;
        __syncthreads();
        const float s0 = SEG[k], s1 = SEG[128 + k], s2 = SEG[256 + k], s3 = SEG[384 + k];
        const float pre = sg == 0 ? 0.f : (sg == 1 ? s0 : (sg == 2 ? s0 + s1 : s0 + s1 + s2));
        const float blast = s0 + s1 + s2 + s3;
        unsigned pk[8];
#pragma unroll
        for (int i = 0; i < 8; ++i) {
            const float e0 = (1.0f - __expf(lf[2 * i])) * __expf(blast - (pre + b[2 * i])), e1 = (1.0f - __expf(lf[2 * i + 1])) * __expf(blast - (pre + b[2 * i + 1]));
            pk[i] = cvt_pk_bf16(e0, e1); }
        { u32x4 w0, w1; w0.x = pk[0]; w0.y = pk[1]; w0.z = pk[2]; w0.w = pk[3]; w1.x = pk[4]; w1.y = pk[5]; w1.z = pk[6]; w1.w = pk[7];
          *(LAS u32x4*)(KT + k * VP + 16 * sg) = w0; *(LAS u32x4*)(KT + k * VP + 16 * sg + 8) = w1; }
#pragma unroll
        for (int j = 0; j < 2; ++j) { const int idx = tid + 512 * j, s = idx >> 4, v0 = 8 * (idx & 15);
            VT[(v0 + 0) * VP + s] = (bf16_t)(vv[j].x & 0xffffu); VT[(v0 + 1) * VP + s] = (bf16_t)(vv[j].x >> 16);
            VT[(v0 + 2) * VP + s] = (bf16_t)(vv[j].y & 0xffffu); VT[(v0 + 3) * VP + s] = (bf16_t)(vv[j].y >> 16);
            VT[(v0 + 4) * VP + s] = (bf16_t)(vv[j].z & 0xffffu); VT[(v0 + 5) * VP + s] = (bf16_t)(vv[j].z >> 16);
            VT[(v0 + 6) * VP + s] = (bf16_t)(vv[j].w & 0xffffu); VT[(v0 + 7) * VP + s] = (bf16_t)(vv[j].w >> 16); }
        if (sg == 0) Dd[item * 128 + k] = __expf(blast);
        __syncthreads();
        const bf16x8 a0 = *(const LAS bf16x8*)(VT + (16 * wave + fr) * VP + fq * 8), a1 = *(const LAS bf16x8*)(VT + (16 * wave + fr) * VP + 32 + fq * 8);
        float* up = U + (size_t)item * 16384 + (16 * wave + 4 * fq) * 128 + fr;
#pragma unroll
        for (int kt = 0; kt < 8; ++kt) {
            const bf16x8 b0 = *(const LAS bf16x8*)(KT + (16 * kt + fr) * VP + fq * 8), b1 = *(const LAS bf16x8*)(KT + (16 * kt + fr) * VP + 32 + fq * 8);
            f32x4 acc = {0.f, 0.f, 0.f, 0.f};
            acc = MFMA16(a0, b0, acc); acc = MFMA16(a1, b1, acc);
            up[16 * kt] = acc[0]; up[16 * kt + 128] = acc[1]; up[16 * kt + 256] = acc[2]; up[16 * kt + 384] = acc[3];
        }
        __syncthreads();
    }
}

__device__ __forceinline__ void hgrn_scan(const Args& a) {
    unsigned char* ws = a.ws;
    const float* U = (const float*)(ws + WS_U); const float* Dd = (const float*)(ws + WS_DD); bf16_t* SP = (bf16_t*)(ws + WS_S);
    for (int e = (blockIdx.x * 512 + threadIdx.x) * 4; e < 32 * 16384; e += gridDim.x * 512 * 4) {
        const int bh = e >> 14, vk = e & 16383, bb = bh >> 3, h = bh & 7;
        f32x4 S = {0.f, 0.f, 0.f, 0.f};
#pragma unroll 8
        for (int ci = 0; ci < 32; ++ci) {
            const size_t item = (size_t)((bb * 32 + ci) * 8 + h);
            const f32x4 u = *(const f32x4*)(U + item * 16384 + vk); const f32x4 d = *(const f32x4*)(Dd + item * 128 + (vk & 127));
            u32x2 w; w.x = cvt_pk_bf16(S[0], S[1]); w.y = cvt_pk_bf16(S[2], S[3]); *(u32x2*)(SP + item * 16384 + vk) = w;
            S = d * S + u;
        }
    }
}

__device__ __forceinline__ void conv_mixer(const Args& a, int wave, int lane) {
    unsigned char* ws = a.ws;
    const bf16_t* BC = (const bf16_t*)(ws + WS_BC); const bf16_t* UC = (const bf16_t*)(ws + WS_UC); bf16_t* MIX = (bf16_t*)(ws + WS_MIX);
    const float* cn = a.in[11]; const float* cw = a.in[8];
    const int gw = blockIdx.x * 8 + wave, NGW = gridDim.x * 8;
    for (int it = gw; it < M_TOK * 2; it += NGW) {
        const int row = it >> 1, c = (it & 1) * 512 + lane * 8, t = row & (SEQ - 1);
        const size_t off = (size_t)row * CW + c;
        const u32x4 z = {0u, 0u, 0u, 0u};
        const u32x4 u0 = *(const u32x4*)(UC + off), u1 = t >= 1 ? *(const u32x4*)(UC + off - CW) : z, u2 = t >= 2 ? *(const u32x4*)(UC + off - 2 * CW) : z, bg = *(const u32x4*)(BC + off);
        float y[8]; float ssq = 0.f;
#pragma unroll
        for (int q = 0; q < 4; ++q) {
            const unsigned a0 = u0[q], a1 = u1[q], a2 = u2[q], bb = bg[q]; const int cc = c + 2 * q;
            y[2 * q] = bflo(bb) * (cw[cc] * bflo(a2) + cw[CW + cc] * bflo(a1) + cw[2 * CW + cc] * bflo(a0));
            y[2 * q + 1] = bfhi(bb) * (cw[cc + 1] * bfhi(a2) + cw[CW + cc + 1] * bfhi(a1) + cw[2 * CW + cc + 1] * bfhi(a0));
            ssq += y[2 * q] * y[2 * q] + y[2 * q + 1] * y[2 * q + 1];
        }
        ssq += __shfl_xor(ssq, 1); ssq += __shfl_xor(ssq, 2); ssq += __shfl_xor(ssq, 4); ssq += __shfl_xor(ssq, 8);
        const float ri = rsqrtf(ssq * (1.0f / 128) + EPS);
        u32x4 w;
        w.x = cvt_pk_bf16(y[0] * ri * cn[c], y[1] * ri * cn[c + 1]); w.y = cvt_pk_bf16(y[2] * ri * cn[c + 2], y[3] * ri * cn[c + 3]);
        w.z = cvt_pk_bf16(y[4] * ri * cn[c + 4], y[5] * ri * cn[c + 5]); w.w = cvt_pk_bf16(y[6] * ri * cn[c + 6], y[7] * ri * cn[c + 7]);
        *(u32x4*)(MIX + (size_t)row * DM + HW + c) = w;
    }
}

__device__ __forceinline__ void hgrn_pass_c(const Args& a, LAS unsigned char* lds, int wave, int lane) {
    unsigned char* ws = a.ws;
    const float* LF = (const float*)(ws + WS_LF); const bf16_t* VH = (const bf16_t*)(ws + WS_VH); const bf16_t* QS = (const bf16_t*)(ws + WS_QS); const bf16_t* GH = (const bf16_t*)(ws + WS_GH);
    const bf16_t* SP = (const bf16_t*)(ws + WS_S); bf16_t* MIX = (bf16_t*)(ws + WS_MIX); const float* hn = a.in[10];
    const int tid = threadIdx.x, k = tid & 127, sg = tid >> 7, fr = lane & 15, fq = lane >> 4;
    LAS bf16_t* QT = (LAS bf16_t*)(lds + L_QT); LAS bf16_t* QH = (LAS bf16_t*)(lds + L_QH); LAS bf16_t* KA = (LAS bf16_t*)(lds + L_KA); LAS bf16_t* KB = (LAS bf16_t*)(lds + L_KB);
    LAS bf16_t* ST = (LAS bf16_t*)(lds + L_ST); LAS bf16_t* VT = (LAS bf16_t*)(lds + L_VT); LAS bf16_t* P = (LAS bf16_t*)(lds + L_P);
    LAS float* SEG = (LAS float*)(lds + L_SEG); LAS float* PART = (LAS float*)(lds + L_PART); LAS float* RINV = (LAS float*)(lds + L_RINV);
    for (int item = blockIdx.x; item < 1024; item += gridDim.x) {
        const int row0 = (item >> 3) * 64, cb = (item & 7) * 128;
        float lf[16], b[16]; bf16_t qh[16];
#pragma unroll
        for (int i = 0; i < 16; ++i) { lf[i] = LF[(size_t)(row0 + 16 * sg + i) * HW + cb + k]; qh[i] = QS[(size_t)(row0 + 16 * sg + i) * HW + cb + k]; }
        u32x4 vv[2], sv[4];
#pragma unroll
        for (int j = 0; j < 2; ++j) { const int idx = tid + 512 * j; vv[j] = *(const u32x4*)(VH + (size_t)(row0 + (idx >> 4)) * HW + cb + 8 * (idx & 15)); }
#pragma unroll
        for (int j = 0; j < 4; ++j) { const int idx = tid + 512 * j; sv[j] = *(const u32x4*)(SP + (size_t)item * 16384 + (idx >> 4) * 128 + 8 * (idx & 15)); }
        float run = 0.f;
#pragma unroll
        for (int i = 0; i < 16; ++i) { run += lf[i]; b[i] = run; }
        SEG[sg * 128 + k] = run;
        __syncthreads();
        const float s0 = SEG[k], s1 = SEG[128 + k], s2 = SEG[256 + k];
        const float pre = sg == 0 ? 0.f : (sg == 1 ? s0 : (sg == 2 ? s0 + s1 : s0 + s1 + s2));
        const float beta1 = s0 + s1, beta = sg >= 2 ? beta1 : 0.f;
#pragma unroll
        for (int i = 0; i < 16; ++i) {
            const int s = 16 * sg + i; const float bi = pre + b[i], kk = 1.0f - __expf(lf[i]), qv = bf2f(qh[i]);
            QT[s * HP + k] = f2bf(qv * __expf(bi - beta)); QH[s * HP + k] = f2bf(qv * __expf(bi));
            KA[s * HP + k] = f2bf(kk * __expf(fminf(beta - bi, 80.f)));
            if (sg < 2) KB[s * HP + k] = f2bf(kk * __expf(beta1 - bi));
        }
#pragma unroll
        for (int j = 0; j < 2; ++j) { const int idx = tid + 512 * j, s = idx >> 4, v0 = 8 * (idx & 15);
            VT[(v0 + 0) * VP + s] = (bf16_t)(vv[j].x & 0xffffu); VT[(v0 + 1) * VP + s] = (bf16_t)(vv[j].x >> 16);
            VT[(v0 + 2) * VP + s] = (bf16_t)(vv[j].y & 0xffffu); VT[(v0 + 3) * VP + s] = (bf16_t)(vv[j].y >> 16);
            VT[(v0 + 4) * VP + s] = (bf16_t)(vv[j].z & 0xffffu); VT[(v0 + 5) * VP + s] = (bf16_t)(vv[j].z >> 16);
            VT[(v0 + 6) * VP + s] = (bf16_t)(vv[j].w & 0xffffu); VT[(v0 + 7) * VP + s] = (bf16_t)(vv[j].w >> 16); }
#pragma unroll
        for (int j = 0; j < 4; ++j) { const int idx = tid + 512 * j; *(LAS u32x4*)(ST + (idx >> 4) * HP + 8 * (idx & 15)) = sv[j]; }
        __syncthreads();
#pragma unroll
        for (int pp = 0; pp < 2; ++pp) {
            const int p = wave + 8 * pp, tt = p >> 2, st = p & 3;
            f32x4 acc = {0.f, 0.f, 0.f, 0.f};
            if (st <= tt) {
                const LAS bf16_t* kb = (tt >= 2 && st < 2) ? KB : KA;
#pragma unroll
                for (int ks = 0; ks < 4; ++ks) { const bf16x8 af = *(const LAS bf16x8*)(QT + (16 * tt + fr) * HP + ks * 32 + fq * 8), bfr = *(const LAS bf16x8*)(kb + (16 * st + fr) * HP + ks * 32 + fq * 8);
                    acc = MFMA16(af, bfr, acc); }
            }
#pragma unroll
            for (int r = 0; r < 4; ++r) { const bool keep = (st < tt) || (st == tt && fr <= 4 * fq + r); P[(16 * tt + 4 * fq + r) * VP + 16 * st + fr] = f2bf(keep ? acc[r] : 0.f); }
        }
        __syncthreads();
        bf16x8 bs[4], bv[2];
#pragma unroll
        for (int ks = 0; ks < 4; ++ks) bs[ks] = *(const LAS bf16x8*)(ST + (16 * wave + fr) * HP + ks * 32 + fq * 8);
#pragma unroll
        for (int ks = 0; ks < 2; ++ks) bv[ks] = *(const LAS bf16x8*)(VT + (16 * wave + fr) * VP + ks * 32 + fq * 8);
        f32x4 o[4];
#pragma unroll
        for (int tt = 0; tt < 4; ++tt) {
            f32x4 acc = {0.f, 0.f, 0.f, 0.f};
#pragma unroll
            for (int ks = 0; ks < 4; ++ks) { const bf16x8 af = *(const LAS bf16x8*)(QH + (16 * tt + fr) * HP + ks * 32 + fq * 8); acc = MFMA16(af, bs[ks], acc); }
            { const bf16x8 af = *(const LAS bf16x8*)(P + (16 * tt + fr) * VP + fq * 8); acc = MFMA16(af, bv[0], acc); }
            if (tt >= 2) { const bf16x8 af = *(const LAS bf16x8*)(P + (16 * tt + fr) * VP + 32 + fq * 8); acc = MFMA16(af, bv[1], acc); }
            o[tt] = acc;
        }
#pragma unroll
        for (int tt = 0; tt < 4; ++tt)
#pragma unroll
            for (int r = 0; r < 4; ++r) { float x = o[tt][r] * o[tt][r]; x += __shfl_xor(x, 1); x += __shfl_xor(x, 2); x += __shfl_xor(x, 4); x += __shfl_xor(x, 8);
                if (fr == 0) PART[wave * 64 + 16 * tt + 4 * fq + r] = x; }
        __syncthreads();
        if (tid < 64) { float s = 0.f;
#pragma unroll
            for (int w = 0; w < 8; ++w) s += PART[w * 64 + tid];
            RINV[tid] = rsqrtf(s * (1.0f / 128) + EPS); }
        __syncthreads();
        const float hnv = hn[16 * wave + fr];
#pragma unroll
        for (int tt = 0; tt < 4; ++tt)
#pragma unroll
            for (int r = 0; r < 4; ++r) { const int t = 16 * tt + 4 * fq + r; const size_t row = (size_t)(row0 + t);
                const float g = bf2f(GH[row * HW + cb + 16 * wave + fr]);
                MIX[row * DM + cb + 16 * wave + fr] = f2bf(o[tt][r] * RINV[t] * hnv * g); }
        __syncthreads();
    }
}

__device__ __forceinline__ void phase_final(const Args& a, int wave, int lane) {
    const int gw = blockIdx.x * 8 + wave, NGW = gridDim.x * 8; const float* gF = a.in[20]; const bf16_t* H4 = (const bf16_t*)(a.ws + WS_MIX);
    for (int m = gw; m < M_TOK; m += NGW) {
        const u32x4* hr = (const u32x4*)(H4 + (size_t)m * DM) + lane; u32x4 w[4]; float s = 0.f;
#pragma unroll
        for (int j = 0; j < 4; ++j) { w[j] = hr[64 * j];
            s += (bflo(w[j].x) * bflo(w[j].x) + bfhi(w[j].x) * bfhi(w[j].x)) + (bflo(w[j].y) * bflo(w[j].y) + bfhi(w[j].y) * bfhi(w[j].y))
               + (bflo(w[j].z) * bflo(w[j].z) + bfhi(w[j].z) * bfhi(w[j].z)) + (bflo(w[j].w) * bflo(w[j].w) + bfhi(w[j].w) * bfhi(w[j].w)); }
        const float ri = rinv_of(wave_sum(s));
        f32x4* orow = (f32x4*)(a.out + (size_t)m * DM);
#pragma unroll
        for (int j = 0; j < 4; ++j) { const int c = (64 * j + lane) * 8; const f32x4 g0 = *(const f32x4*)(gF + c), g1 = *(const f32x4*)(gF + c + 4);
            f32x4 o0, o1; o0[0] = bflo(w[j].x) * ri * g0[0]; o0[1] = bfhi(w[j].x) * ri * g0[1]; o0[2] = bflo(w[j].y) * ri * g0[2]; o0[3] = bfhi(w[j].y) * ri * g0[3];
            o1[0] = bflo(w[j].z) * ri * g1[0]; o1[1] = bfhi(w[j].z) * ri * g1[1]; o1[2] = bflo(w[j].w) * ri * g1[2]; o1[3] = bfhi(w[j].w) * ri * g1[3];
            orow[c / 4] = o0; orow[c / 4 + 1] = o1; }
    }
}

#define XB_TMO      128
#define XB_XCNT(j)  (256  + 64 * (j))
#define XB_XSUB(j)  (1280 + 64 * (j))
#define XB_XGEN(j)  (2304 + 64 * (j))
#define XB_TOP      3328
#define XB_TOPGEN   3392
#define XCD_BAR_WORDS 3456
#define XB_SPIN_CAP (1u << 18)

__device__ __forceinline__ unsigned xb_ld(unsigned* p)              { return __hip_atomic_load(p, __ATOMIC_RELAXED, __HIP_MEMORY_SCOPE_AGENT); }
__device__ __forceinline__ unsigned xb_add(unsigned* p, unsigned v) { return __hip_atomic_fetch_add(p, v, __ATOMIC_RELAXED, __HIP_MEMORY_SCOPE_AGENT); }
__device__ __forceinline__ unsigned xb_xcc_id() { return (unsigned)__builtin_amdgcn_s_getreg((3 << 11) | 20) & 0xFu; }
#define XB_SPIN(cond, bar) do { unsigned _sp = 0; while (cond) { __builtin_amdgcn_s_sleep(1); \
    if ((++_sp & 255u) == 0u) { if (xb_ld(&(bar)[XB_TMO])) break; if (_sp > XB_SPIN_CAP) { atomicAdd(&(bar)[XB_TMO], 1u); break; } } } } while (0)

struct XcdBarrier {
    unsigned* bar; unsigned x;
    volatile LAS unsigned* st;
};

__device__ __forceinline__ XcdBarrier xcd_barrier_post(unsigned* bar, volatile LAS unsigned* st) {
    XcdBarrier b; b.bar = bar; b.x = xb_xcc_id(); b.st = st;
    if (threadIdx.x == 0) (void)xb_add(&bar[XB_XCNT(b.x)], 1u);
    return b;
}
__device__ __forceinline__ void xcd_barrier_complete(unsigned* bar, unsigned x, unsigned& nloc, unsigned& nx) {
    const unsigned G = gridDim.x * gridDim.y * gridDim.z;
    unsigned sum, cnt, mine, sp = 0u;
    for (;;) {
        sum = 0u; cnt = 0u; mine = 0u;
#pragma unroll
        for (unsigned j = 0; j < 16; ++j) { const unsigned c = xb_ld(&bar[XB_XCNT(j)]); sum += c; cnt += (c > 0u) ? 1u : 0u; mine = (j == x) ? c : mine; }
        if (sum == G) break;
        __builtin_amdgcn_s_sleep(1);
        if ((++sp & 255u) == 0u) { if (xb_ld(&bar[XB_TMO])) break; if (sp > XB_SPIN_CAP) { atomicAdd(&bar[XB_TMO], 1u); break; } }
    }
    nloc = mine > 0u ? mine : 1u; nx = cnt > 0u ? cnt : 1u;
}

__device__ __forceinline__ void xcd_barrier(const XcdBarrier& b) {
    asm volatile("s_waitcnt vmcnt(0)" ::: "memory");
    __syncthreads();
    if (threadIdx.x == 0) {
        unsigned* bar = b.bar;
        __builtin_amdgcn_s_waitcnt(0);
        unsigned nloc = b.st[0], nx = b.st[1];
        if (nloc == 0u) { xcd_barrier_complete(bar, b.x, nloc, nx); b.st[0] = nloc; b.st[1] = nx; }
        const unsigned old = xb_add(&bar[XB_XSUB(b.x)], 1u);
        const unsigned gen = old / nloc;
        if (old + 1u == (gen + 1u) * nloc) {
            __builtin_amdgcn_fence(__ATOMIC_RELEASE, "agent");
            asm volatile("s_waitcnt vmcnt(0)" ::: "memory");
            const unsigned og = xb_add(&bar[XB_TOP], 1u);
            const unsigned tg = og / nx;
            if (og + 1u == (tg + 1u) * nx) xb_add(&bar[XB_TOPGEN], 1u);
            else XB_SPIN(xb_ld(&bar[XB_TOPGEN]) == tg, bar);
            __builtin_amdgcn_fence(__ATOMIC_ACQUIRE, "agent");
            xb_add(&bar[XB_XGEN(b.x)], 1u);
            asm volatile("s_waitcnt vmcnt(0)" ::: "memory");
        } else {
            XB_SPIN(xb_ld(&bar[XB_XGEN(b.x)]) == gen, bar);
            __builtin_amdgcn_fence(__ATOMIC_ACQUIRE, "agent");
            asm volatile("s_waitcnt vmcnt(0)" ::: "memory");
        }
    }
    __syncthreads();
}


template <class Epi>
__device__ __forceinline__ void run_gemm(LAS unsigned char* lds, const bf16_t* A, const bf16_t* Bt, int N, int K, const Epi& E, int vc) {
    pg8::Gemm g; g.A = A; g.Bt = Bt; g.M = M_TOK; g.N = N; g.K = K;
    pg8::StaticOrder S; S.init(M_TOK, N, (int)gridDim.x, vc);
    pg8::gemm_phase<Epi, pg8::StaticOrder, true, true>(lds, g, S, E);
}
struct TailOrder {
    int c, n;
    __device__ __forceinline__ bool next(int i, Unit& u) const { if (c < 0) return false; const int L = i * n + c; if (L >= 256) return false; u.pm = L >> 3; u.pn = L & 7; return true; }
    __device__ __forceinline__ void a_ready(const Unit&) const {}
    __device__ __forceinline__ void done(const Unit&) const {}
};

__global__ void __launch_bounds__(512, 2) fwd_kernel(Args a) {
    extern __shared__ __attribute__((aligned(16))) unsigned char lds_raw[];
    LAS unsigned char* lds = (LAS unsigned char*)lds_raw;
    cg::grid_group grid = cg::this_grid();
    volatile LAS unsigned* xst = (volatile LAS unsigned*)(lds + LDS_BYTES - 16);
    if (threadIdx.x < 4) xst[threadIdx.x] = 0u;
    __syncthreads();
    XcdBarrier xbar = xcd_barrier_post((unsigned*)(a.ws + WS_BAR), xst);
    unsigned* cen = (unsigned*)(a.ws + WS_BAR) + 3584;
    if (threadIdx.x == 0) xst[2] = xb_add(&cen[64 * xbar.x], 1u);
    if (a.ph_lo == 0 && a.ph_hi == NPHASE) grid.sync();
    int vc = blockIdx.x;
    if (a.ph_lo == 0 && a.ph_hi == NPHASE && gridDim.x == 256) {
        bool even = true;
#pragma unroll
        for (int j = 0; j < 8; ++j) even = even && (xb_ld(&cen[64 * j]) == 32u);
        if (even) vc = (int)xst[2] * 8 + (int)xbar.x;
    }
    vc = __builtin_amdgcn_readfirstlane(vc);
    const int tid = threadIdx.x, lane = tid & 63, wave = __builtin_amdgcn_readfirstlane(tid >> 6);
    unsigned char* ws = a.ws;
    float* SS = (float*)(ws + WS_SS);
    bf16_t* XB = (bf16_t*)(ws + WS_XB); bf16_t* G = (bf16_t*)(ws + WS_G); bf16_t* MIX = (bf16_t*)(ws + WS_MIX);
#define PH(i) if (a.ph_lo <= (i) && (i) < a.ph_hi)
#define SYNC(i) if (a.ph_lo <= (i) && (i) + 1 < a.ph_hi) { xcd_barrier(xbar); }
    PH(0) { phase0(a, lds, wave, lane); } SYNC(0)
    PH(1) { EpiGateUp E; E.G = G; E.ss = SS; run_gemm(lds, XB, (const bf16_t*)(ws + WS_W1GU), 2 * FF, DM, E, vc); conv_tail(a, lds, wave, lane, 32 * 44, CV_T1, CV_END, vc); } SYNC(1)
    PH(2) { EpiResid E; E.XB = XB; E.ss_out = SS + 8192; E.scale = 0.5f; run_gemm(lds, G, (const bf16_t*)(ws + WS_W1D), DM, FF, E, vc); } SYNC(2)
    PH(3) { EpiMixIn E; E.ss = SS + 8192; E.lbl = a.in[9]; E.QS = (bf16_t*)(ws + WS_QS);
            E.UC = (bf16_t*)(ws + WS_UC); E.LF = (float*)(ws + WS_LF); run_gemm(lds, XB, (const bf16_t*)(ws + WS_WIN), MIXIN, DM, E, vc); conv_tail(a, lds, wave, lane, 32 * 28, CV_T0, CV_T1, vc); } SYNC(3)
    PH(4) { hgrn_pass_a(a, lds, wave, lane); } SYNC(4)
    PH(5) { hgrn_scan(a); conv_mixer(a, wave, lane); } SYNC(5)
    PH(6) { hgrn_pass_c(a, lds, wave, lane); } SYNC(6)
    PH(7) { EpiResid E; E.XB = XB; E.ss_out = SS + 16384; E.scale = 1.0f; run_gemm(lds, MIX, (const bf16_t*)(ws + WS_WOUT), DM, DM, E, vc); } SYNC(7)
    PH(8) { EpiGateUp E; E.G = G; E.ss = SS + 16384; run_gemm(lds, XB, (const bf16_t*)(ws + WS_W2GU), 2 * FF, DM, E, vc);
            { const int r = (32 * 44) % (int)gridDim.x; TailOrder T; T.n = (int)gridDim.x - r; T.c = vc - r;
              EpiStoreBf16 E2; E2.O = (bf16_t*)(ws + WS_PLE); int kp = PLE; asm volatile("" : "+s"(kp));
              pg8::Gemm g2; g2.A = (const bf16_t*)(ws + WS_PB); g2.Bt = (const bf16_t*)(ws + WS_WPE); g2.M = M_TOK; g2.N = DM; g2.K = kp;
              pg8::gemm_phase<EpiStoreBf16, TailOrder, true, true>(lds, g2, T, E2); }
            conv_tail(a, lds, wave, lane, 32 * 44, CV_TA, CV_T0, vc); } SYNC(8)
    PH(9) { EpiResid E; E.XB = XB; E.ss_out = SS + 24576; E.scale = 0.5f; run_gemm(lds, G, (const bf16_t*)(ws + WS_W2D), DM, FF, E, vc); } SYNC(9)
    PH(10) { EpiPleGate E; E.XB = XB; E.H4 = MIX; E.P = (const bf16_t*)(ws + WS_PLE); E.ss = SS + 24576; run_gemm(lds, XB, (const bf16_t*)(ws + WS_WPG), DM, DM, E, vc); } SYNC(10)
    PH(11) { phase_final(a, wave, lane); }
#undef PH
#undef SYNC
}

#ifndef MK_MULTI
#define MK_MULTI 0
#endif
extern "C" void kernel_launch(void* const* d_in, const int* in_sizes, int n_in, void* d_out, int out_size, void* d_ws, size_t ws_size, hipStream_t stream) {
    static int grid = 0;
    if (grid == 0) {
        if (n_in != 21 || out_size != M_TOK * DM || ws_size < WS_END) { fprintf(stderr, "kernel_launch: unexpected shapes (n_in %d out %d ws %zu need %zu)\n", n_in, out_size, ws_size, (size_t)WS_END); grid = -1; return; }
        int dev = 0, cus = 0, per_cu = 0;
        hipGetDevice(&dev); hipDeviceGetAttribute(&cus, hipDeviceAttributeMultiprocessorCount, dev);
        if (hipFuncSetAttribute((const void*)fwd_kernel, hipFuncAttributeMaxDynamicSharedMemorySize, LDS_BYTES) != hipSuccess) { fprintf(stderr, "kernel_launch: hipFuncSetAttribute failed\n"); grid = -1; return; }
        if (hipOccupancyMaxActiveBlocksPerMultiprocessor(&per_cu, (const void*)fwd_kernel, 512, LDS_BYTES) != hipSuccess || per_cu < 1) { fprintf(stderr, "kernel_launch: occupancy query failed (%d)\n", per_cu); grid = -1; return; }
        grid = cus * per_cu;
    }
    if (grid < 0) return;
    Args a{};
    for (int i = 0; i < 21; ++i) a.in[i] = (const float*)d_in[i];
    a.out = (float*)d_out; a.ws = (unsigned char*)d_ws;
#if MK_MULTI
    for (int p = 0; p < NPHASE; ++p) { a.ph_lo = p; a.ph_hi = p + 1; hipLaunchKernelGGL(fwd_kernel, dim3(grid), dim3(512), LDS_BYTES, stream, a); }
#else
    a.ph_lo = 0; a.ph_hi = NPHASE;
    if (hipMemsetAsync((char*)d_ws + WS_BAR, 0, 4096 * 4, stream) != hipSuccess) { fprintf(stderr, "kernel_launch: memset failed\n"); return; }
    void* args[] = {&a};
    hipError_t e = hipLaunchCooperativeKernel((void*)fwd_kernel, dim3(grid), dim3(512), args, LDS_BYTES, stream);
    if (e != hipSuccess) fprintf(stderr, "cooperative launch failed: %s (grid %d)\n", hipGetErrorString(e), grid);
#endif
}
```

```cpp
#include <hip/hip_runtime.h>
#include <hip/hip_cooperative_groups.h>
#include <cstdio>
#include <cstdint>
namespace pg8 {
#define PG8_LAS __attribute__((address_space(3)))
typedef unsigned short bf16_t;
typedef short bf16x8 __attribute__((ext_vector_type(8)));
typedef float f32x4 __attribute__((ext_vector_type(4)));
typedef unsigned u32x4 __attribute__((ext_vector_type(4)));
constexpr int BM = 256, BK = 64, HALF = 128, HTB = HALF * BK * 2  , STAGE_BYTES = 8 * HTB, NXCD = 8, WGM = 8;

__host__ __device__ __forceinline__ int lds_byte(int r, int c) { const int st = (r >> 4) * 2 + (c >> 5), rr = r & 15, cc = c & 31, ob = rr * 64 + cc * 2; return st * 1024 + (ob ^ (((ob >> 9) & 1) << 5)); }
__host__ __device__ __forceinline__ void stage_rc(int b, int& R, int& C) { const int st = b / 1024, sb = b % 1024, swz = sb ^ (((sb >> 9) & 1) << 5); R = (st >> 1) * 16 + swz / 64; C = (st & 1) * 32 + (swz % 64) / 2; }
__host__ __device__ __forceinline__ int perm32(int rho) { const int n = rho >> 4, i = rho & 15; return 8 * (i >> 2) + 4 * n + (i & 3); }

struct Unit { int pm, pn; };
struct Gemm { const bf16_t* A; const bf16_t* Bt; int M, N, K; };

struct StaticOrder {
    int nM, nN, nwg, G, c;
    __host__ __device__ void init(int M, int N, int G_, int c_) { nM = M / BM; nN = N / BM; nwg = nM * nN; G = G_; c = c_; }
    __host__ __device__ bool next(int i, Unit& u) const {
        const long L = (long)i * G + c; if (L >= nwg) return false;
        int wgid = (int)L; { const int q = nwg / NXCD, r = nwg % NXCD, xcd = wgid % NXCD, off = wgid / NXCD; wgid = (xcd < r ? xcd * (q + 1) : r * (q + 1) + (xcd - r) * q) + off; }
        const int nig = WGM * nN, gid = wgid / nig, fm = gid * WGM, gsz = (nM - fm) < WGM ? (nM - fm) : WGM;
        u.pm = fm + ((wgid % nig) % gsz); u.pn = (wgid % nig) / gsz; return true;
    }
    __device__ __forceinline__ void a_ready(const Unit&) const {}
    __device__ __forceinline__ void done(const Unit&) const {}
};
typedef float f32x2 __attribute__((ext_vector_type(2)));
template <class Epi, class Sched, bool ALIGN_EPI = false, bool SP2 = false>
__device__ __forceinline__ void gemm_phase(PG8_LAS unsigned char* lds, const Gemm g, const Sched& S, const Epi& E) {
    const int tid = threadIdx.x, wid = __builtin_amdgcn_readfirstlane(tid >> 6), lane = tid & 63, wr = wid >> 2, wc = wid & 3, fr = lane & 15, fq = lane >> 4;
    const int K = g.K, nt = K / BK;
    unsigned voffA[2], voffB[2];
#pragma unroll
    for (int i = 0; i < 2; ++i) { int R, C; stage_rc(tid * 16 + i * 8192, R, C); const int Rb = Epi::PERM ? ((R & ~31) + perm32(R & 31)) : R;
        voffA[i] = (unsigned)(R * K + C) * 2u; voffB[i] = (unsigned)(Rb * K + C) * 2u; }
    const size_t kstep = (size_t)(BK * 2);
    const size_t hstep = (size_t)HALF * K * 2;
    const size_t tstep = 2 * hstep;
    const unsigned ldsw = (unsigned)wid * 1024u;
    const int aoff = lds_byte(wr * 64 + fr, fq * 8), boff = lds_byte(wc * 32 + fr, fq * 8);
#define PG8_SA(b, h) (((b) * 2 + (h)) * HTB)
#define PG8_SB(b, h) ((4 + (b) * 2 + (h)) * HTB)
#define PG8_STAGE(bufoff, gbase, voff) do { _Pragma("unroll") for (int _i = 0; _i < 2; ++_i) \
        __builtin_amdgcn_global_load_lds((const unsigned*)((const char*)(gbase) + (voff)[_i]), (PG8_LAS unsigned*)(lds + (bufoff) + ldsw + _i * 8192), 16, 0, 0); } while (0)
#define PG8_LDA(dst, b, h) do { _Pragma("unroll") for (int m = 0; m < 4; ++m) _Pragma("unroll") for (int k = 0; k < 2; ++k) dst[m][k] = *(const PG8_LAS bf16x8*)(lds + PG8_SA(b, h) + aoff + m * 2048 + k * 1024); } while (0)
#define PG8_LDB(dst, b, h) do { _Pragma("unroll") for (int n = 0; n < 2; ++n) _Pragma("unroll") for (int k = 0; k < 2; ++k) dst[n][k] = *(const PG8_LAS bf16x8*)(lds + PG8_SB(b, h) + boff + n * 2048 + k * 1024); } while (0)
#define PG8_MMA(ai, bj, At, Bt) do { __builtin_amdgcn_s_setprio(1); _Pragma("unroll") for (int m = 0; m < 4; ++m) _Pragma("unroll") for (int n = 0; n < 2; ++n) _Pragma("unroll") for (int k = 0; k < 2; ++k) \
        acc[ai][bj][m][n] = __builtin_amdgcn_mfma_f32_16x16x32_bf16(Bt[n][k], At[m][k], acc[ai][bj][m][n], 0, 0, 0); __builtin_amdgcn_s_setprio(0); } while (0)
#define PG8_WAIT_V(n) asm volatile("s_waitcnt vmcnt(" #n ")" ::: "memory")
#define PG8_WAIT_L(n) asm volatile("s_waitcnt lgkmcnt(" #n ")" ::: "memory")
#define PG8_BAR __builtin_amdgcn_s_barrier()
#define PG8_SCHED __builtin_amdgcn_sched_barrier(0)
    Unit cur, nxt; int ui = 0;
    if (!S.next(0, cur)) return;
    f32x4 acc[2][2][4][2];
#pragma unroll
    for (int a = 0; a < 2; ++a)
#pragma unroll
        for (int b = 0; b < 2; ++b)
#pragma unroll
            for (int m = 0; m < 4; ++m)
#pragma unroll
                for (int n = 0; n < 2; ++n) acc[a][b][m][n] = (f32x4){0.f, 0.f, 0.f, 0.f};
    bf16x8 At[4][2], B0[2][2], B1[2][2];
    const char* cA = (const char*)g.A + (size_t)cur.pm * tstep; const char* cB = (const char*)g.Bt + (size_t)cur.pn * tstep;
    S.a_ready(cur);
    if constexpr (SP2) {
        PG8_STAGE(PG8_SB(0, 0), cB, voffB); PG8_STAGE(PG8_SB(0, 1), cB + hstep, voffB); PG8_STAGE(PG8_SA(0, 0), cA, voffA); PG8_STAGE(PG8_SA(0, 1), cA + hstep, voffA);
        if (wr == 1) PG8_BAR;
        PG8_WAIT_V(2); PG8_BAR;
        PG8_STAGE(PG8_SB(1, 0), cB + kstep, voffB); PG8_STAGE(PG8_SA(1, 0), cA + kstep, voffA); PG8_STAGE(PG8_SB(1, 1), cB + hstep + kstep, voffB);
        PG8_WAIT_V(6); PG8_BAR;
    } else {
        PG8_STAGE(PG8_SB(0, 0), cB, voffB); PG8_STAGE(PG8_SA(0, 0), cA, voffA); PG8_STAGE(PG8_SB(0, 1), cB + hstep, voffB); PG8_STAGE(PG8_SA(0, 1), cA + hstep, voffA);
        if (wr == 1) PG8_BAR;
        PG8_WAIT_V(4); PG8_BAR;
        PG8_STAGE(PG8_SB(1, 0), cB + kstep, voffB); PG8_STAGE(PG8_SA(1, 0), cA + kstep, voffA); PG8_STAGE(PG8_SB(1, 1), cB + hstep + kstep, voffB);
        PG8_WAIT_V(6); PG8_BAR;
    }
    for (;;) {
        const bool has_next = S.next(ui + 1, nxt);
        const char* nA = has_next ? (const char*)g.A + (size_t)nxt.pm * tstep : cA; const char* nB = has_next ? (const char*)g.Bt + (size_t)nxt.pn * tstep : cB;
        for (int t = 0; t < nt; t += 2) {
            const bool last = (t == nt - 2);
            const char* a1 = cA + (size_t)(t + 1) * kstep;
            const char* a2 = last ? nA : cA + (size_t)(t + 2) * kstep; const char* b2 = last ? nB : cB + (size_t)(t + 2) * kstep;
            const char* a3 = a2 + kstep; const char* b3 = b2 + kstep;
            if (last && has_next) S.a_ready(nxt);
            if constexpr (SP2) {
            PG8_LDB(B0, 0, 0); PG8_LDB(B1, 0, 1); PG8_SCHED; PG8_LDA(At, 0, 0); PG8_STAGE(PG8_SA(1, 1), a1 + hstep, voffA);
            PG8_WAIT_V(8); PG8_WAIT_L(0); PG8_BAR; PG8_MMA(0, 0, At, B0); PG8_MMA(0, 1, At, B1); PG8_BAR; PG8_SCHED;
            PG8_LDA(At, 0, 1); PG8_STAGE(PG8_SB(0, 0), b2, voffB); PG8_STAGE(PG8_SB(0, 1), b2 + hstep, voffB); PG8_STAGE(PG8_SA(0, 0), a2, voffA);
            PG8_WAIT_V(8); PG8_WAIT_L(0); PG8_BAR; PG8_MMA(1, 0, At, B0); PG8_MMA(1, 1, At, B1); PG8_BAR; PG8_SCHED;
            PG8_LDB(B0, 1, 0); PG8_LDB(B1, 1, 1); PG8_SCHED; PG8_LDA(At, 1, 0); PG8_STAGE(PG8_SA(0, 1), a2 + hstep, voffA);
            PG8_WAIT_V(8); PG8_WAIT_L(0); PG8_BAR; PG8_MMA(0, 0, At, B0); PG8_MMA(0, 1, At, B1); PG8_BAR; PG8_SCHED;
            PG8_LDA(At, 1, 1); PG8_STAGE(PG8_SB(1, 0), b3, voffB); PG8_STAGE(PG8_SB(1, 1), b3 + hstep, voffB); PG8_STAGE(PG8_SA(1, 0), a3, voffA);
            PG8_WAIT_V(8); PG8_WAIT_L(0); PG8_BAR; PG8_MMA(1, 0, At, B0); PG8_MMA(1, 1, At, B1); PG8_BAR; PG8_SCHED;
            } else {
            PG8_LDB(B0, 0, 0); PG8_SCHED; PG8_LDA(At, 0, 0); PG8_STAGE(PG8_SA(1, 1), a1 + hstep, voffA);
            PG8_WAIT_L(8); PG8_BAR; PG8_WAIT_L(0); PG8_MMA(0, 0, At, B0); PG8_BAR; PG8_SCHED;
            PG8_LDB(B1, 0, 1); PG8_STAGE(PG8_SB(0, 0), b2, voffB);
            PG8_BAR; PG8_WAIT_L(0); PG8_MMA(0, 1, At, B1); PG8_BAR;
            PG8_LDA(At, 0, 1); PG8_STAGE(PG8_SA(0, 0), a2, voffA);
            PG8_BAR; PG8_WAIT_L(0); PG8_MMA(1, 0, At, B0); PG8_BAR; PG8_SCHED;
            PG8_STAGE(PG8_SB(0, 1), b2 + hstep, voffB);
            PG8_WAIT_V(6); PG8_BAR; PG8_MMA(1, 1, At, B1); PG8_BAR;
            PG8_LDB(B0, 1, 0); PG8_SCHED; PG8_LDA(At, 1, 0); PG8_STAGE(PG8_SA(0, 1), a2 + hstep, voffA);
            PG8_WAIT_L(8); PG8_BAR; PG8_WAIT_L(0); PG8_MMA(0, 0, At, B0); PG8_BAR; PG8_SCHED;
            PG8_LDB(B1, 1, 1); PG8_STAGE(PG8_SB(1, 0), b3, voffB);
            PG8_BAR; PG8_WAIT_L(0); PG8_MMA(0, 1, At, B1); PG8_BAR;
            PG8_LDA(At, 1, 1); PG8_STAGE(PG8_SA(1, 0), a3, voffA);
            PG8_BAR; PG8_WAIT_L(0); PG8_MMA(1, 0, At, B0); PG8_BAR; PG8_SCHED;
            PG8_STAGE(PG8_SB(1, 1), b3 + hstep, voffB);
            PG8_WAIT_V(6); PG8_BAR; PG8_MMA(1, 1, At, B1); PG8_BAR;
            }
        }
        if constexpr (ALIGN_EPI) { if (wr == 0) PG8_BAR; }
        if constexpr (!Epi::AFTER_DRAIN) { E(acc, cur, wr, wc, fr, fq); S.done(cur); }
        if (!has_next) break;
#pragma unroll
        for (int a = 0; a < 2; ++a)
#pragma unroll
            for (int b = 0; b < 2; ++b)
#pragma unroll
                for (int m = 0; m < 4; ++m)
#pragma unroll
                    for (int n = 0; n < 2; ++n) acc[a][b][m][n] = (f32x4){0.f, 0.f, 0.f, 0.f};
        cur = nxt; cA = nA; cB = nB; ++ui;
        if constexpr (ALIGN_EPI) { if (wr == 1) PG8_BAR; }
    }
    PG8_WAIT_V(0);
    if constexpr (!ALIGN_EPI) { if (wr == 0) PG8_BAR; }
    PG8_BAR;
    if constexpr (Epi::AFTER_DRAIN) { E.fused(acc, cur, wr, wc, fr, fq, lds, wid, lane); S.done(cur); }
#undef PG8_SA
#undef PG8_SB
#undef PG8_STAGE
#undef PG8_LDA
#undef PG8_LDB
#undef PG8_MMA
#undef PG8_WAIT_V
#undef PG8_WAIT_L
#undef PG8_BAR
#undef PG8_SCHED
}
}

namespace cg = cooperative_groups;
using pg8::bf16_t; using pg8::bf16x8; using pg8::f32x4; using pg8::u32x4; using pg8::Unit;
typedef float f32x2c __attribute__((ext_vector_type(2)));
typedef __bf16 bf16x2c __attribute__((ext_vector_type(2)));
__device__ __forceinline__ unsigned cvt_pk_bf16(float lo, float hi) { const f32x2c v = {lo, hi}; return __builtin_bit_cast(unsigned, __builtin_convertvector(v, bf16x2c)); }
#define LAS __attribute__((address_space(3)))
typedef unsigned u32x2 __attribute__((ext_vector_type(2)));
typedef float f32x2v __attribute__((ext_vector_type(2)));

constexpr int M_TOK = 8192, DM = 2048, FF = 5632, HW = 1024, CW = 1024, MIXIN = 7168, PLE = 256, SEQ = 2048;
constexpr float EPS = 1e-6f;
constexpr size_t MiB = 1ull << 20;
constexpr size_t WS_W1GU = 0, WS_W1D = 44 * MiB, WS_WIN = 66 * MiB, WS_WOUT = 94 * MiB, WS_W2GU = 102 * MiB, WS_W2D = 146 * MiB,
                 WS_WPG = 168 * MiB, WS_WPE = 176 * MiB, WS_PB = 177 * MiB, WS_XB = 181 * MiB, WS_MIX = 213 * MiB, WS_G = 245 * MiB,
                 WS_QS = 245 * MiB, WS_VH = 261 * MiB, WS_GH = 277 * MiB, WS_BC = 293 * MiB, WS_UC = 309 * MiB, WS_LF = 325 * MiB,
                 WS_S = 357 * MiB, WS_PLE = 0, WS_SS = 389 * MiB, WS_DD = 389 * MiB + 512 * 1024, WS_BAR = 390 * MiB + 512 * 1024, WS_END = 391 * MiB, WS_U = 0;
constexpr int LDS_BYTES = 144 * 1024;
constexpr int NPHASE = 12;

__device__ __forceinline__ float bf2f(bf16_t b) { return __uint_as_float(((unsigned)b) << 16); }
__device__ __forceinline__ float bflo(unsigned w) { return __uint_as_float(w << 16); }
__device__ __forceinline__ float bfhi(unsigned w) { return __uint_as_float(w & 0xffff0000u); }
__device__ __forceinline__ float wave_sum(float v) {
#pragma unroll
    for (int o = 1; o < 64; o <<= 1) v += __shfl_xor(v, o);
    return v;
}
__device__ __forceinline__ float fsigmoid(float x) { return __builtin_amdgcn_rcpf(1.0f + __expf(-x)); }
__device__ __forceinline__ float fsilu(float x) { return x * fsigmoid(x); }
__device__ __forceinline__ float rinv_of(float ss) { return rsqrtf(ss * (1.0f / DM) + EPS); }

struct EpiGateUp {
    static constexpr bool PERM = true, AFTER_DRAIN = false;
    bf16_t* G; const float* ss;
    __device__ __forceinline__ void operator()(const f32x4 (&acc)[2][2][4][2], const Unit& u, int wr, int wc, int fr, int fq) const {
        const int row0 = u.pm * 256 + wr * 64 + fr, col0 = u.pn * 128 + wc * 32 + 8 * fq;
#pragma unroll
        for (int ai = 0; ai < 2; ++ai)
#pragma unroll
            for (int m = 0; m < 4; ++m) {
                const int r = row0 + ai * 128 + m * 16; const float ri = rinv_of(ss[r]);
                float v[8];
#pragma unroll
                for (int n = 0; n < 2; ++n)
#pragma unroll
                    for (int j = 0; j < 4; ++j) v[n * 4 + j] = fsilu(acc[ai][0][m][n][j] * ri) * (acc[ai][1][m][n][j] * ri);
                u32x4 w; w.x = cvt_pk_bf16(v[0], v[1]); w.y = cvt_pk_bf16(v[2], v[3]); w.z = cvt_pk_bf16(v[4], v[5]); w.w = cvt_pk_bf16(v[6], v[7]);
                *(u32x4*)(G + (size_t)r * FF + col0) = w;
            }
    }
};
struct EpiResid {
    static constexpr bool PERM = true, AFTER_DRAIN = false;
    bf16_t* XB; float* ss_out; float scale;
    __device__ __forceinline__ void operator()(f32x4 (&acc)[2][2][4][2], const Unit& u, int wr, int wc, int fr, int fq) const {
        const int row0 = u.pm * 256 + wr * 64 + fr, col0 = u.pn * 256 + wc * 32 + 8 * fq;
#pragma unroll
        for (int ai = 0; ai < 2; ++ai) {
#pragma unroll
            for (int m = 0; m < 4; ++m)
#pragma unroll
                for (int bj = 0; bj < 2; ++bj) {
                    const size_t off = (size_t)(row0 + ai * 128 + m * 16) * DM + col0 + bj * 128;
                    const u32x4 xw = *(const u32x4*)(XB + off);
                    f32x4 r0, r1; r0[0] = bflo(xw.x); r0[1] = bfhi(xw.x); r0[2] = bflo(xw.y); r0[3] = bfhi(xw.y); r1[0] = bflo(xw.z); r1[1] = bfhi(xw.z); r1[2] = bflo(xw.w); r1[3] = bfhi(xw.w);
                    acc[ai][bj][m][0] = r0 + acc[ai][bj][m][0] * scale; acc[ai][bj][m][1] = r1 + acc[ai][bj][m][1] * scale;
                }
            asm volatile("" ::: "memory");
#pragma unroll
            for (int m = 0; m < 4; ++m) {
                const int r = row0 + ai * 128 + m * 16; float sq = 0.f;
#pragma unroll
                for (int bj = 0; bj < 2; ++bj) {
                    const size_t off = (size_t)r * DM + col0 + bj * 128;
                    const f32x4 v0 = acc[ai][bj][m][0], v1 = acc[ai][bj][m][1];
                    u32x4 w; w.x = cvt_pk_bf16(v0[0], v0[1]); w.y = cvt_pk_bf16(v0[2], v0[3]); w.z = cvt_pk_bf16(v1[0], v1[1]); w.w = cvt_pk_bf16(v1[2], v1[3]);
                    *(u32x4*)(XB + off) = w;
                    sq += (v0[0] * v0[0] + v0[1] * v0[1]) + (v0[2] * v0[2] + v0[3] * v0[3]) + (v1[0] * v1[0] + v1[1] * v1[1]) + (v1[2] * v1[2] + v1[3] * v1[3]);
                }
                sq += __shfl_xor(sq, 16); sq += __shfl_xor(sq, 32);
                if (fq == 0) atomicAdd(ss_out + r, sq);
            }
            asm volatile("" ::: "memory");
        }
    }
};
struct EpiMixIn {
    static constexpr bool PERM = true, AFTER_DRAIN = false;
    const float* ss; const float* lbl;
    bf16_t *QS, *UC; float* LF;
    __device__ __forceinline__ void operator()(const f32x4 (&acc)[2][2][4][2], const Unit& u, int wr, int wc, int fr, int fq) const {
        const int row0 = u.pm * 256 + wr * 64 + fr; const int sec = u.pn >> 2;
        if (u.pn >= 20) {
            const int col0 = (u.pn - 20) * 128 + wc * 32 + 8 * fq;
#pragma unroll
            for (int ai = 0; ai < 2; ++ai)
#pragma unroll
                for (int m = 0; m < 4; ++m) {
                    const int r = row0 + ai * 128 + m * 16; const float ri = rinv_of(ss[r]); const float ri2 = ri * ri;
                    float v[8];
#pragma unroll
                    for (int n = 0; n < 2; ++n)
#pragma unroll
                        for (int j = 0; j < 4; ++j) v[n * 4 + j] = acc[ai][0][m][n][j] * acc[ai][1][m][n][j] * ri2;
                    u32x4 w; w.x = cvt_pk_bf16(v[0], v[1]); w.y = cvt_pk_bf16(v[2], v[3]); w.z = cvt_pk_bf16(v[4], v[5]); w.w = cvt_pk_bf16(v[6], v[7]);
                    *(u32x4*)(UC + (size_t)r * CW + col0) = w;
                }
            return;
        }
        const int col0 = (u.pn & 3) * 256 + wc * 32 + 8 * fq;
        if (sec == 1) {
#pragma unroll
            for (int bj = 0; bj < 2; ++bj)
#pragma unroll
                for (int n = 0; n < 2; ++n) {
                    const int c = col0 + bj * 128 + 4 * n; const f32x4 l0 = *(const f32x4*)(lbl + c), l1 = *(const f32x4*)(lbl + 1024 + c);
                    f32x4 lb; lb[0] = fsigmoid(l0[0] - l1[0]); lb[1] = fsigmoid(l0[1] - l1[1]); lb[2] = fsigmoid(l0[2] - l1[2]); lb[3] = fsigmoid(l0[3] - l1[3]);
#pragma unroll
                    for (int ai = 0; ai < 2; ++ai)
#pragma unroll
                        for (int m = 0; m < 4; ++m) {
                            const int r = row0 + ai * 128 + m * 16; const float ri = rinv_of(ss[r]);
                            const f32x4 x = acc[ai][bj][m][n]; f32x4 o;
                            o[0] = __logf(lb[0] + (1.0f - lb[0]) * fsigmoid(x[0] * ri)); o[1] = __logf(lb[1] + (1.0f - lb[1]) * fsigmoid(x[1] * ri));
                            o[2] = __logf(lb[2] + (1.0f - lb[2]) * fsigmoid(x[2] * ri)); o[3] = __logf(lb[3] + (1.0f - lb[3]) * fsigmoid(x[3] * ri));
                            *(f32x4*)(LF + (size_t)r * HW + c) = o;
                        }
                }
            return;
        }
        bf16_t* dst = QS + (size_t)(sec == 0 ? 0 : sec - 1) * ((size_t)M_TOK * HW);
        const bool act = (sec == 0 || sec == 3);
#pragma unroll
        for (int ai = 0; ai < 2; ++ai)
#pragma unroll
            for (int m = 0; m < 4; ++m) {
                const int r = row0 + ai * 128 + m * 16; const float ri = rinv_of(ss[r]);
#pragma unroll
                for (int bj = 0; bj < 2; ++bj) {
                    float v[8];
#pragma unroll
                    for (int n = 0; n < 2; ++n)
#pragma unroll
                        for (int j = 0; j < 4; ++j) { const float x = acc[ai][bj][m][n][j] * ri; v[n * 4 + j] = act ? fsilu(x) : x; }
                    u32x4 w; w.x = cvt_pk_bf16(v[0], v[1]); w.y = cvt_pk_bf16(v[2], v[3]); w.z = cvt_pk_bf16(v[4], v[5]); w.w = cvt_pk_bf16(v[6], v[7]);
                    *(u32x4*)(dst + (size_t)r * HW + col0 + bj * 128) = w;
                }
            }
    }
};
struct EpiStoreBf16 {
    static constexpr bool PERM = true, AFTER_DRAIN = false;
    bf16_t* O;
    __device__ __forceinline__ void operator()(const f32x4 (&acc)[2][2][4][2], const Unit& u, int wr, int wc, int fr, int fq) const {
        const int row0 = u.pm * 256 + wr * 64 + fr, col0 = u.pn * 256 + wc * 32 + 8 * fq;
#pragma unroll
        for (int ai = 0; ai < 2; ++ai)
#pragma unroll
            for (int m = 0; m < 4; ++m) {
                const int r = row0 + ai * 128 + m * 16;
#pragma unroll
                for (int bj = 0; bj < 2; ++bj) {
                    const f32x4 v0 = acc[ai][bj][m][0], v1 = acc[ai][bj][m][1];
                    u32x4 w; w.x = cvt_pk_bf16(v0[0], v0[1]); w.y = cvt_pk_bf16(v0[2], v0[3]); w.z = cvt_pk_bf16(v1[0], v1[1]); w.w = cvt_pk_bf16(v1[2], v1[3]);
                    *(u32x4*)(O + (size_t)r * DM + col0 + bj * 128) = w;
                }
            }
    }
};
struct EpiPleGate {
    static constexpr bool PERM = true, AFTER_DRAIN = false;
    const bf16_t* XB; const bf16_t* P; bf16_t* H4; const float* ss;
    __device__ __forceinline__ void operator()(f32x4 (&acc)[2][2][4][2], const Unit& u, int wr, int wc, int fr, int fq) const {
        const int row0 = u.pm * 256 + wr * 64 + fr, col0 = u.pn * 256 + wc * 32 + 8 * fq;
#pragma unroll
        for (int ai = 0; ai < 2; ++ai)
#pragma unroll
            for (int m = 0; m < 4; ++m) {
                const int r = row0 + ai * 128 + m * 16; const float ri = rinv_of(ss[r]);
#pragma unroll
                for (int bj = 0; bj < 2; ++bj) {
                    const size_t off = (size_t)r * DM + col0 + bj * 128;
                    const u32x4 pw = *(const u32x4*)(P + off), xw = *(const u32x4*)(XB + off);
                    const f32x4 a0 = acc[ai][bj][m][0], a1 = acc[ai][bj][m][1];
                    u32x4 w;
                    w.x = cvt_pk_bf16(bflo(xw.x) + fsigmoid(a0[0] * ri) * bflo(pw.x), bfhi(xw.x) + fsigmoid(a0[1] * ri) * bfhi(pw.x));
                    w.y = cvt_pk_bf16(bflo(xw.y) + fsigmoid(a0[2] * ri) * bflo(pw.y), bfhi(xw.y) + fsigmoid(a0[3] * ri) * bfhi(pw.y));
                    w.z = cvt_pk_bf16(bflo(xw.z) + fsigmoid(a1[0] * ri) * bflo(pw.z), bfhi(xw.z) + fsigmoid(a1[1] * ri) * bfhi(pw.z));
                    w.w = cvt_pk_bf16(bflo(xw.w) + fsigmoid(a1[2] * ri) * bflo(pw.w), bfhi(xw.w) + fsigmoid(a1[3] * ri) * bfhi(pw.w));
                    *(u32x4*)(H4 + off) = w;
                }
            }
    }
};

template <int MODE>
__device__ __forceinline__ void p0_item(const float* W, const float* W2, const float* gain, int K, int N, bf16_t* WT, LAS float* scr, int item, int lane) {
    const int nblk_k = K / 64; const int nb = item / nblk_k, kb = item % nblk_k; const int k0 = 64 * kb, n0 = 32 * nb;
    const float* src = W; int c0 = n0;
    if (MODE == 1) { const int t = n0 >> 8, bj = (n0 >> 7) & 1, c = n0 & 127; src = bj ? W2 : W; c0 = 128 * t + c; }
    if (MODE == 2) { if (n0 >= 5120) { const int tt = n0 - 5120; const int t = tt >> 8, bj = (tt >> 7) & 1, c = tt & 127; c0 = 5120 + 1024 * bj + 128 * t + c; } }
    float v[32], gg[32];
    const float* sp = src + (size_t)(k0 + (lane >> 5)) * N + c0 + (lane & 31);
#pragma unroll
    for (int i = 0; i < 32; ++i) v[i] = sp[(size_t)(2 * i) * N];
    if (gain) {
#pragma unroll
        for (int i = 0; i < 32; ++i) gg[i] = gain[k0 + 2 * i + (lane >> 5)];
#pragma unroll
        for (int i = 0; i < 32; ++i) v[i] *= gg[i];
    }
#pragma unroll
    for (int i = 0; i < 32; ++i) scr[(2 * i + (lane >> 5)) * 33 + (lane & 31)] = v[i];
    asm volatile("s_waitcnt lgkmcnt(0)" ::: "memory");
    const int c = lane & 7;
#pragma unroll
    for (int j = 0; j < 4; ++j) { const int n = (lane >> 3) + 8 * j; const LAS float* s = scr + (8 * c) * 33 + n;
        u32x4 o; o.x = cvt_pk_bf16(s[0 * 33], s[1 * 33]); o.y = cvt_pk_bf16(s[2 * 33], s[3 * 33]); o.z = cvt_pk_bf16(s[4 * 33], s[5 * 33]); o.w = cvt_pk_bf16(s[6 * 33], s[7 * 33]);
        *(u32x4*)(WT + (size_t)(n0 + n) * K + k0 + 8 * c) = o; }
    asm volatile("s_waitcnt lgkmcnt(0)" ::: "memory");
}

struct Args { const float* in[21]; float* out; unsigned char* ws; int ph_lo, ph_hi; };

constexpr int CV_I0 = 32 * 352, CV_I1 = 88 * 64, CV_I2 = 32 * 224, CV_I3 = 32 * 64, CV_I7 = 4 * 64;
constexpr int CV_END = 2 * CV_I0 + 2 * CV_I1 + CV_I2 + 2 * CV_I3 + CV_I7, CV_T1 = CV_END - 10000, CV_T0 = CV_T1 - 10000, CV_TA = CV_I0 + CV_I2 + CV_I3 + CV_I7;
__device__ __forceinline__ void conv_range(const Args& a, LAS unsigned char* lds, int wave, int lane, int lo, int hi, int w0, int nw) {
    unsigned char* ws = a.ws;
    LAS float* scr = (LAS float*)(lds + wave * 16384);
    for (int it = lo + w0; it < hi; it += nw) {
        int r = it;
        if (r < CV_I0) { p0_item<1>(a.in[3], a.in[4], a.in[2], DM, FF, (bf16_t*)(ws + WS_W1GU), scr, r, lane); continue; } r -= CV_I0;
        if (r < CV_I2) { p0_item<2>(a.in[7], nullptr, a.in[6], DM, MIXIN, (bf16_t*)(ws + WS_WIN), scr, r, lane); continue; } r -= CV_I2;
        if (r < CV_I3) { p0_item<0>(a.in[12], nullptr, nullptr, DM, DM, (bf16_t*)(ws + WS_WOUT), scr, r, lane); continue; } r -= CV_I3;
        if (r < CV_I7) { p0_item<0>(a.in[18], nullptr, nullptr, PLE, DM, (bf16_t*)(ws + WS_WPE), scr, r, lane); continue; } r -= CV_I7;
        if (r < CV_I3) { p0_item<0>(a.in[19], nullptr, a.in[17], DM, DM, (bf16_t*)(ws + WS_WPG), scr, r, lane); continue; } r -= CV_I3;
        if (r < CV_I1) { p0_item<0>(a.in[16], nullptr, nullptr, FF, DM, (bf16_t*)(ws + WS_W2D), scr, r, lane); continue; } r -= CV_I1;
        if (r < CV_I0) { p0_item<1>(a.in[14], a.in[15], a.in[13], DM, FF, (bf16_t*)(ws + WS_W2GU), scr, r, lane); continue; } r -= CV_I0;
        p0_item<0>(a.in[5], nullptr, nullptr, FF, DM, (bf16_t*)(ws + WS_W1D), scr, r, lane);
    }
}
__device__ __forceinline__ void conv_tail(const Args& a, LAS unsigned char* lds, int wave, int lane, int nunits, int lo, int hi, int vc) {
    const int r = nunits % (int)gridDim.x;
    if (r == 0) { conv_range(a, lds, wave, lane, lo, hi, vc * 8 + wave, gridDim.x * 8); return; }
    if (vc >= r) conv_range(a, lds, wave, lane, lo, hi, (vc - r) * 8 + wave, ((int)gridDim.x - r) * 8);
}

__device__ __forceinline__ void phase0(const Args& a, LAS unsigned char* lds, int wave, int lane) {
    unsigned char* ws = a.ws;
    const int gw = blockIdx.x * 8 + wave, NGW = gridDim.x * 8;
    conv_range(a, lds, wave, lane, 0, CV_TA, gw, NGW);
    float* SS = (float*)(ws + WS_SS);
    for (int m = gw; m < M_TOK; m += NGW) {
        const f32x4* xr = (const f32x4*)(a.in[0] + (size_t)m * DM) + lane; u32x2* xb = (u32x2*)((bf16_t*)(ws + WS_XB) + (size_t)m * DM) + lane;
        float s = 0.f;
#pragma unroll
        for (int j = 0; j < 8; ++j) { const f32x4 v = xr[64 * j]; s += (v[0] * v[0] + v[1] * v[1]) + (v[2] * v[2] + v[3] * v[3]);
            u32x2 w; w.x = cvt_pk_bf16(v[0], v[1]); w.y = cvt_pk_bf16(v[2], v[3]); xb[64 * j] = w; }
        s = wave_sum(s);
        if (lane == 0) { SS[m] = s; SS[8192 + m] = 0.f; SS[16384 + m] = 0.f; SS[24576 + m] = 0.f; }
    }
    { const int gt = blockIdx.x * 512 + threadIdx.x, NT = gridDim.x * 512;
      for (int i = gt; i < M_TOK * PLE / 4; i += NT) { const f32x4 v = ((const f32x4*)a.in[1])[i]; u32x2 w; w.x = cvt_pk_bf16(v[0], v[1]); w.y = cvt_pk_bf16(v[2], v[3]); ((u32x2*)(ws + WS_PB))[i] = w; } }
}

constexpr int HP = 136, VP = 72;
constexpr int L_QT = 0, L_QH = L_QT + 64 * HP * 2, L_KA = L_QH + 64 * HP * 2, L_KB = L_KA + 64 * HP * 2, L_ST = L_KB + 32 * HP * 2, L_VT = L_ST + 128 * HP * 2,
              L_P = L_VT + 128 * VP * 2, L_SEG = L_P + 64 * VP * 2, L_PART = L_SEG + 4 * 128 * 4, L_RINV = L_PART + 8 * 64 * 4, L_HEND = L_RINV + 256, L_KT = 0;
static_assert(L_HEND <= LDS_BYTES, "LDS");
#define MFMA16(a, b, c) __builtin_amdgcn_mfma_f32_16x16x32_bf16((a), (b), (c), 0, 0, 0)
__device__ __forceinline__ bf16_t f2bf(float x) { return (bf16_t)(cvt_pk_bf16(x, 0.f) & 0xffffu); }

__device__ __forceinline__ void hgrn_pass_a(const Args& a, LAS unsigned char* lds, int wave, int lane) {
    unsigned char* ws = a.ws;
    const float* LF = (const float*)(ws + WS_LF); const bf16_t* VH = (const bf16_t*)(ws + WS_VH); bf16_t* U = (bf16_t*)(ws + WS_U); float* Dd = (float*)(ws + WS_DD);
    const int tid = threadIdx.x, k = tid & 127, sg = tid >> 7, fr = lane & 15, fq = lane >> 4;
    LAS bf16_t* VT = (LAS bf16_t*)(lds + L_VT); LAS bf16_t* KT = (LAS bf16_t*)(lds + L_KT); LAS float* SEG = (LAS float*)(lds + L_SEG);
    for (int item = blockIdx.x; item < 1024; item += gridDim.x) {
        const int row0 = (item >> 3) * 64, cb = (item & 7) * 128;
        float lf[16], b[16];
#pragma unroll
        for (int i = 0; i < 16; ++i) lf[i] = LF[(size_t)(row0 + 16 * sg + i) * HW + cb + k];
        u32x4 vv[2];
#pragma unroll
        for (int j = 0; j < 2; ++j) { const int idx = tid + 512 * j; vv[j] = *(const u32x4*)(VH + (size_t)(row0 + (idx >> 4)) * HW + cb + 8 * (idx & 15)); }
        float run = 0.f;
#pragma unroll
        for (int i = 0; i < 16; ++i) { run += lf[i]; b[i] = run; }
        SEG[sg * 128 + k] = run;
        __syncthreads();
        const float s0 = SEG[k], s1 = SEG[128 + k], s2 = SEG[256 + k], s3 = SEG[384 + k];
        const float pre = sg == 0 ? 0.f : (sg == 1 ? s0 : (sg == 2 ? s0 + s1 : s0 + s1 + s2));
        const float blast = s0 + s1 + s2 + s3;
        unsigned pk[8];
#pragma unroll
        for (int i = 0; i < 8; ++i) {
            const float e0 = (1.0f - __expf(lf[2 * i])) * __expf(blast - (pre + b[2 * i])), e1 = (1.0f - __expf(lf[2 * i + 1])) * __expf(blast - (pre + b[2 * i + 1]));
            pk[i] = cvt_pk_bf16(e0, e1); }
        { u32x4 w0, w1; w0.x = pk[0]; w0.y = pk[1]; w0.z = pk[2]; w0.w = pk[3]; w1.x = pk[4]; w1.y = pk[5]; w1.z = pk[6]; w1.w = pk[7];
          *(LAS u32x4*)(KT + k * VP + 16 * sg) = w0; *(LAS u32x4*)(KT + k * VP + 16 * sg + 8) = w1; }
#pragma unroll
        for (int j = 0; j < 2; ++j) { const int idx = tid + 512 * j, s = idx >> 4, v0 = 8 * (idx & 15);
            VT[(v0 + 0) * VP + s] = (bf16_t)(vv[j].x & 0xffffu); VT[(v0 + 1) * VP + s] = (bf16_t)(vv[j].x >> 16);
            VT[(v0 + 2) * VP + s] = (bf16_t)(vv[j].y & 0xffffu); VT[(v0 + 3) * VP + s] = (bf16_t)(vv[j].y >> 16);
            VT[(v0 + 4) * VP + s] = (bf16_t)(vv[j].z & 0xffffu); VT[(v0 + 5) * VP + s] = (bf16_t)(vv[j].z >> 16);
            VT[(v0 + 6) * VP + s] = (bf16_t)(vv[j].w & 0xffffu); VT[(v0 + 7) * VP + s] = (bf16_t)(vv[j].w >> 16); }
        if (sg == 0) Dd[item * 128 + k] = __expf(blast);
        __syncthreads();
        const bf16x8 a0 = *(const LAS bf16x8*)(VT + (16 * wave + fr) * VP + fq * 8), a1 = *(const LAS bf16x8*)(VT + (16 * wave + fr) * VP + 32 + fq * 8);
        bf16_t* up = U + (size_t)item * 16384 + (16 * wave + 4 * fq) * 128 + fr;
#pragma unroll
        for (int kt = 0; kt < 8; ++kt) {
            const bf16x8 b0 = *(const LAS bf16x8*)(KT + (16 * kt + fr) * VP + fq * 8), b1 = *(const LAS bf16x8*)(KT + (16 * kt + fr) * VP + 32 + fq * 8);
            f32x4 acc = {0.f, 0.f, 0.f, 0.f};
            acc = MFMA16(a0, b0, acc); acc = MFMA16(a1, b1, acc);
            up[16 * kt] = f2bf(acc[0]); up[16 * kt + 128] = f2bf(acc[1]); up[16 * kt + 256] = f2bf(acc[2]); up[16 * kt + 384] = f2bf(acc[3]);
        }
        __syncthreads();
    }
}

__device__ __forceinline__ void hgrn_scan(const Args& a) {
    unsigned char* ws = a.ws;
    const bf16_t* U = (const bf16_t*)(ws + WS_U); const float* Dd = (const float*)(ws + WS_DD); bf16_t* SP = (bf16_t*)(ws + WS_S);
    for (int e = (blockIdx.x * 512 + threadIdx.x) * 4; e < 32 * 16384; e += gridDim.x * 512 * 4) {
        const int bh = e >> 14, vk = e & 16383, bb = bh >> 3, h = bh & 7;
        f32x4 S = {0.f, 0.f, 0.f, 0.f};
#pragma unroll 8
        for (int ci = 0; ci < 32; ++ci) {
            const size_t item = (size_t)((bb * 32 + ci) * 8 + h);
            const u32x2 uw = *(const u32x2*)(U + item * 16384 + vk); f32x4 u; u[0] = bflo(uw.x); u[1] = bfhi(uw.x); u[2] = bflo(uw.y); u[3] = bfhi(uw.y); const f32x4 d = *(const f32x4*)(Dd + item * 128 + (vk & 127));
            u32x2 w; w.x = cvt_pk_bf16(S[0], S[1]); w.y = cvt_pk_bf16(S[2], S[3]); *(u32x2*)(SP + item * 16384 + vk) = w;
            S = d * S + u;
        }
    }
}

__device__ __forceinline__ void conv_mixer(const Args& a, int wave, int lane) {
    unsigned char* ws = a.ws;
    const bf16_t* BC = (const bf16_t*)(ws + WS_BC); const bf16_t* UC = (const bf16_t*)(ws + WS_UC); bf16_t* MIX = (bf16_t*)(ws + WS_MIX);
    const float* cn = a.in[11]; const float* cw = a.in[8];
    const int gw = blockIdx.x * 8 + wave, NGW = gridDim.x * 8;
    for (int it = gw; it < M_TOK * 2; it += NGW) {
        const int row = it >> 1, c = (it & 1) * 512 + lane * 8, t = row & (SEQ - 1);
        const size_t off = (size_t)row * CW + c;
        const u32x4 z = {0u, 0u, 0u, 0u};
        const u32x4 u0 = *(const u32x4*)(UC + off), u1 = t >= 1 ? *(const u32x4*)(UC + off - CW) : z, u2 = t >= 2 ? *(const u32x4*)(UC + off - 2 * CW) : z, bg = *(const u32x4*)(BC + off);
        float y[8]; float ssq = 0.f;
#pragma unroll
        for (int q = 0; q < 4; ++q) {
            const unsigned a0 = u0[q], a1 = u1[q], a2 = u2[q], bb = bg[q]; const int cc = c + 2 * q;
            y[2 * q] = bflo(bb) * (cw[cc] * bflo(a2) + cw[CW + cc] * bflo(a1) + cw[2 * CW + cc] * bflo(a0));
            y[2 * q + 1] = bfhi(bb) * (cw[cc + 1] * bfhi(a2) + cw[CW + cc + 1] * bfhi(a1) + cw[2 * CW + cc + 1] * bfhi(a0));
            ssq += y[2 * q] * y[2 * q] + y[2 * q + 1] * y[2 * q + 1];
        }
        ssq += __shfl_xor(ssq, 1); ssq += __shfl_xor(ssq, 2); ssq += __shfl_xor(ssq, 4); ssq += __shfl_xor(ssq, 8);
        const float ri = rsqrtf(ssq * (1.0f / 128) + EPS);
        u32x4 w;
        w.x = cvt_pk_bf16(y[0] * ri * cn[c], y[1] * ri * cn[c + 1]); w.y = cvt_pk_bf16(y[2] * ri * cn[c + 2], y[3] * ri * cn[c + 3]);
        w.z = cvt_pk_bf16(y[4] * ri * cn[c + 4], y[5] * ri * cn[c + 5]); w.w = cvt_pk_bf16(y[6] * ri * cn[c + 6], y[7] * ri * cn[c + 7]);
        *(u32x4*)(MIX + (size_t)row * DM + HW + c) = w;
    }
}

__device__ __forceinline__ void hgrn_pass_c(const Args& a, LAS unsigned char* lds, int wave, int lane) {
    unsigned char* ws = a.ws;
    const float* LF = (const float*)(ws + WS_LF); const bf16_t* VH = (const bf16_t*)(ws + WS_VH); const bf16_t* QS = (const bf16_t*)(ws + WS_QS); const bf16_t* GH = (const bf16_t*)(ws + WS_GH);
    const bf16_t* SP = (const bf16_t*)(ws + WS_S); bf16_t* MIX = (bf16_t*)(ws + WS_MIX); const float* hn = a.in[10];
    const int tid = threadIdx.x, k = tid & 127, sg = tid >> 7, fr = lane & 15, fq = lane >> 4;
    LAS bf16_t* QT = (LAS bf16_t*)(lds + L_QT); LAS bf16_t* QH = (LAS bf16_t*)(lds + L_QH); LAS bf16_t* KA = (LAS bf16_t*)(lds + L_KA); LAS bf16_t* KB = (LAS bf16_t*)(lds + L_KB);
    LAS bf16_t* ST = (LAS bf16_t*)(lds + L_ST); LAS bf16_t* VT = (LAS bf16_t*)(lds + L_VT); LAS bf16_t* P = (LAS bf16_t*)(lds + L_P);
    LAS float* SEG = (LAS float*)(lds + L_SEG); LAS float* PART = (LAS float*)(lds + L_PART); LAS float* RINV = (LAS float*)(lds + L_RINV);
    for (int item = blockIdx.x; item < 1024; item += gridDim.x) {
        const int row0 = (item >> 3) * 64, cb = (item & 7) * 128;
        float lf[16], b[16]; bf16_t qh[16];
#pragma unroll
        for (int i = 0; i < 16; ++i) { lf[i] = LF[(size_t)(row0 + 16 * sg + i) * HW + cb + k]; qh[i] = QS[(size_t)(row0 + 16 * sg + i) * HW + cb + k]; }
        u32x4 vv[2], sv[4];
#pragma unroll
        for (int j = 0; j < 2; ++j) { const int idx = tid + 512 * j; vv[j] = *(const u32x4*)(VH + (size_t)(row0 + (idx >> 4)) * HW + cb + 8 * (idx & 15)); }
#pragma unroll
        for (int j = 0; j < 4; ++j) { const int idx = tid + 512 * j; sv[j] = *(const u32x4*)(SP + (size_t)item * 16384 + (idx >> 4) * 128 + 8 * (idx & 15)); }
        float run = 0.f;
#pragma unroll
        for (int i = 0; i < 16; ++i) { run += lf[i]; b[i] = run; }
        SEG[sg * 128 + k] = run;
        __syncthreads();
        const float s0 = SEG[k], s1 = SEG[128 + k], s2 = SEG[256 + k];
        const float pre = sg == 0 ? 0.f : (sg == 1 ? s0 : (sg == 2 ? s0 + s1 : s0 + s1 + s2));
        const float beta1 = s0 + s1, beta = sg >= 2 ? beta1 : 0.f;
#pragma unroll
        for (int i = 0; i < 16; ++i) {
            const int s = 16 * sg + i; const float bi = pre + b[i], kk = 1.0f - __expf(lf[i]), qv = bf2f(qh[i]);
            QT[s * HP + k] = f2bf(qv * __expf(bi - beta)); QH[s * HP + k] = f2bf(qv * __expf(bi));
            KA[s * HP + k] = f2bf(kk * __expf(fminf(beta - bi, 80.f)));
            if (sg < 2) KB[s * HP + k] = f2bf(kk * __expf(beta1 - bi));
        }
#pragma unroll
        for (int j = 0; j < 2; ++j) { const int idx = tid + 512 * j, s = idx >> 4, v0 = 8 * (idx & 15);
            VT[(v0 + 0) * VP + s] = (bf16_t)(vv[j].x & 0xffffu); VT[(v0 + 1) * VP + s] = (bf16_t)(vv[j].x >> 16);
            VT[(v0 + 2) * VP + s] = (bf16_t)(vv[j].y & 0xffffu); VT[(v0 + 3) * VP + s] = (bf16_t)(vv[j].y >> 16);
            VT[(v0 + 4) * VP + s] = (bf16_t)(vv[j].z & 0xffffu); VT[(v0 + 5) * VP + s] = (bf16_t)(vv[j].z >> 16);
            VT[(v0 + 6) * VP + s] = (bf16_t)(vv[j].w & 0xffffu); VT[(v0 + 7) * VP + s] = (bf16_t)(vv[j].w >> 16); }
#pragma unroll
        for (int j = 0; j < 4; ++j) { const int idx = tid + 512 * j; *(LAS u32x4*)(ST + (idx >> 4) * HP + 8 * (idx & 15)) = sv[j]; }
        __syncthreads();
#pragma unroll
        for (int pp = 0; pp < 2; ++pp) {
            const int p = wave + 8 * pp, tt = p >> 2, st = p & 3;
            f32x4 acc = {0.f, 0.f, 0.f, 0.f};
            if (st <= tt) {
                const LAS bf16_t* kb = (tt >= 2 && st < 2) ? KB : KA;
#pragma unroll
                for (int ks = 0; ks < 4; ++ks) { const bf16x8 af = *(const LAS bf16x8*)(QT + (16 * tt + fr) * HP + ks * 32 + fq * 8), bfr = *(const LAS bf16x8*)(kb + (16 * st + fr) * HP + ks * 32 + fq * 8);
                    acc = MFMA16(af, bfr, acc); }
            }
#pragma unroll
            for (int r = 0; r < 4; ++r) { const bool keep = (st < tt) || (st == tt && fr <= 4 * fq + r); P[(16 * tt + 4 * fq + r) * VP + 16 * st + fr] = f2bf(keep ? acc[r] : 0.f); }
        }
        __syncthreads();
        bf16x8 bs[4], bv[2];
#pragma unroll
        for (int ks = 0; ks < 4; ++ks) bs[ks] = *(const LAS bf16x8*)(ST + (16 * wave + fr) * HP + ks * 32 + fq * 8);
#pragma unroll
        for (int ks = 0; ks < 2; ++ks) bv[ks] = *(const LAS bf16x8*)(VT + (16 * wave + fr) * VP + ks * 32 + fq * 8);
        f32x4 o[4];
#pragma unroll
        for (int tt = 0; tt < 4; ++tt) {
            f32x4 acc = {0.f, 0.f, 0.f, 0.f};
#pragma unroll
            for (int ks = 0; ks < 4; ++ks) { const bf16x8 af = *(const LAS bf16x8*)(QH + (16 * tt + fr) * HP + ks * 32 + fq * 8); acc = MFMA16(af, bs[ks], acc); }
            { const bf16x8 af = *(const LAS bf16x8*)(P + (16 * tt + fr) * VP + fq * 8); acc = MFMA16(af, bv[0], acc); }
            if (tt >= 2) { const bf16x8 af = *(const LAS bf16x8*)(P + (16 * tt + fr) * VP + 32 + fq * 8); acc = MFMA16(af, bv[1], acc); }
            o[tt] = acc;
        }
#pragma unroll
        for (int tt = 0; tt < 4; ++tt)
#pragma unroll
            for (int r = 0; r < 4; ++r) { float x = o[tt][r] * o[tt][r]; x += __shfl_xor(x, 1); x += __shfl_xor(x, 2); x += __shfl_xor(x, 4); x += __shfl_xor(x, 8);
                if (fr == 0) PART[wave * 64 + 16 * tt + 4 * fq + r] = x; }
        __syncthreads();
        if (tid < 64) { float s = 0.f;
#pragma unroll
            for (int w = 0; w < 8; ++w) s += PART[w * 64 + tid];
            RINV[tid] = rsqrtf(s * (1.0f / 128) + EPS); }
        __syncthreads();
        const float hnv = hn[16 * wave + fr];
#pragma unroll
        for (int tt = 0; tt < 4; ++tt)
#pragma unroll
            for (int r = 0; r < 4; ++r) { const int t = 16 * tt + 4 * fq + r; const size_t row = (size_t)(row0 + t);
                const float g = bf2f(GH[row * HW + cb + 16 * wave + fr]);
                MIX[row * DM + cb + 16 * wave + fr] = f2bf(o[tt][r] * RINV[t] * hnv * g); }
        __syncthreads();
    }
}

__device__ __forceinline__ void phase_final(const Args& a, int wave, int lane) {
    const int gw = blockIdx.x * 8 + wave, NGW = gridDim.x * 8; const float* gF = a.in[20]; const bf16_t* H4 = (const bf16_t*)(a.ws + WS_MIX);
    for (int m = gw; m < M_TOK; m += NGW) {
        const u32x4* hr = (const u32x4*)(H4 + (size_t)m * DM) + lane; u32x4 w[4]; float s = 0.f;
#pragma unroll
        for (int j = 0; j < 4; ++j) { w[j] = hr[64 * j];
            s += (bflo(w[j].x) * bflo(w[j].x) + bfhi(w[j].x) * bfhi(w[j].x)) + (bflo(w[j].y) * bflo(w[j].y) + bfhi(w[j].y) * bfhi(w[j].y))
               + (bflo(w[j].z) * bflo(w[j].z) + bfhi(w[j].z) * bfhi(w[j].z)) + (bflo(w[j].w) * bflo(w[j].w) + bfhi(w[j].w) * bfhi(w[j].w)); }
        const float ri = rinv_of(wave_sum(s));
        f32x4* orow = (f32x4*)(a.out + (size_t)m * DM);
#pragma unroll
        for (int j = 0; j < 4; ++j) { const int c = (64 * j + lane) * 8; const f32x4 g0 = *(const f32x4*)(gF + c), g1 = *(const f32x4*)(gF + c + 4);
            f32x4 o0, o1; o0[0] = bflo(w[j].x) * ri * g0[0]; o0[1] = bfhi(w[j].x) * ri * g0[1]; o0[2] = bflo(w[j].y) * ri * g0[2]; o0[3] = bfhi(w[j].y) * ri * g0[3];
            o1[0] = bflo(w[j].z) * ri * g1[0]; o1[1] = bfhi(w[j].z) * ri * g1[1]; o1[2] = bflo(w[j].w) * ri * g1[2]; o1[3] = bfhi(w[j].w) * ri * g1[3];
            orow[c / 4] = o0; orow[c / 4 + 1] = o1; }
    }
}

#define XB_TMO      128
#define XB_XCNT(j)  (256  + 64 * (j))
#define XB_XSUB(j)  (1280 + 64 * (j))
#define XB_XGEN(j)  (2304 + 64 * (j))
#define XB_TOP      3328
#define XB_TOPGEN   3392
#define XCD_BAR_WORDS 3456
#define XB_SPIN_CAP (1u << 18)

__device__ __forceinline__ unsigned xb_ld(unsigned* p)              { return __hip_atomic_load(p, __ATOMIC_RELAXED, __HIP_MEMORY_SCOPE_AGENT); }
__device__ __forceinline__ unsigned xb_add(unsigned* p, unsigned v) { return __hip_atomic_fetch_add(p, v, __ATOMIC_RELAXED, __HIP_MEMORY_SCOPE_AGENT); }
__device__ __forceinline__ unsigned xb_xcc_id() { return (unsigned)__builtin_amdgcn_s_getreg((3 << 11) | 20) & 0xFu; }
#define XB_SPIN(cond, bar) do { unsigned _sp = 0; while (cond) { __builtin_amdgcn_s_sleep(1); \
    if ((++_sp & 255u) == 0u) { if (xb_ld(&(bar)[XB_TMO])) break; if (_sp > XB_SPIN_CAP) { atomicAdd(&(bar)[XB_TMO], 1u); break; } } } } while (0)

struct XcdBarrier {
    unsigned* bar; unsigned x;
    volatile LAS unsigned* st;
};

__device__ __forceinline__ XcdBarrier xcd_barrier_post(unsigned* bar, volatile LAS unsigned* st) {
    XcdBarrier b; b.bar = bar; b.x = xb_xcc_id(); b.st = st;
    if (threadIdx.x == 0) (void)xb_add(&bar[XB_XCNT(b.x)], 1u);
    return b;
}
__device__ __forceinline__ void xcd_barrier_complete(unsigned* bar, unsigned x, unsigned& nloc, unsigned& nx) {
    const unsigned G = gridDim.x * gridDim.y * gridDim.z;
    unsigned sum, cnt, mine, sp = 0u;
    for (;;) {
        sum = 0u; cnt = 0u; mine = 0u;
#pragma unroll
        for (unsigned j = 0; j < 16; ++j) { const unsigned c = xb_ld(&bar[XB_XCNT(j)]); sum += c; cnt += (c > 0u) ? 1u : 0u; mine = (j == x) ? c : mine; }
        if (sum == G) break;
        __builtin_amdgcn_s_sleep(1);
        if ((++sp & 255u) == 0u) { if (xb_ld(&bar[XB_TMO])) break; if (sp > XB_SPIN_CAP) { atomicAdd(&bar[XB_TMO], 1u); break; } }
    }
    nloc = mine > 0u ? mine : 1u; nx = cnt > 0u ? cnt : 1u;
}

__device__ __forceinline__ void xcd_barrier(const XcdBarrier& b) {
    asm volatile("s_waitcnt vmcnt(0)" ::: "memory");
    __syncthreads();
    if (threadIdx.x == 0) {
        unsigned* bar = b.bar;
        __builtin_amdgcn_s_waitcnt(0);
        unsigned nloc = b.st[0], nx = b.st[1];
        if (nloc == 0u) { xcd_barrier_complete(bar, b.x, nloc, nx); b.st[0] = nloc; b.st[1] = nx; }
        const unsigned old = xb_add(&bar[XB_XSUB(b.x)], 1u);
        const unsigned gen = old / nloc;
        if (old + 1u == (gen + 1u) * nloc) {
            __builtin_amdgcn_fence(__ATOMIC_RELEASE, "agent");
            asm volatile("s_waitcnt vmcnt(0)" ::: "memory");
            const unsigned og = xb_add(&bar[XB_TOP], 1u);
            const unsigned tg = og / nx;
            if (og + 1u == (tg + 1u) * nx) xb_add(&bar[XB_TOPGEN], 1u);
            else XB_SPIN(xb_ld(&bar[XB_TOPGEN]) == tg, bar);
            __builtin_amdgcn_fence(__ATOMIC_ACQUIRE, "agent");
            xb_add(&bar[XB_XGEN(b.x)], 1u);
            asm volatile("s_waitcnt vmcnt(0)" ::: "memory");
        } else {
            XB_SPIN(xb_ld(&bar[XB_XGEN(b.x)]) == gen, bar);
            __builtin_amdgcn_fence(__ATOMIC_ACQUIRE, "agent");
            asm volatile("s_waitcnt vmcnt(0)" ::: "memory");
        }
    }
    __syncthreads();
}


template <class Epi>
__device__ __forceinline__ void run_gemm(LAS unsigned char* lds, const bf16_t* A, const bf16_t* Bt, int N, int K, const Epi& E, int vc) {
    pg8::Gemm g; g.A = A; g.Bt = Bt; g.M = M_TOK; g.N = N; g.K = K;
    pg8::StaticOrder S; S.init(M_TOK, N, (int)gridDim.x, vc);
    pg8::gemm_phase<Epi, pg8::StaticOrder, true, true>(lds, g, S, E);
}
struct TailOrder {
    int c, n;
    __device__ __forceinline__ bool next(int i, Unit& u) const { if (c < 0) return false; const int L = i * n + c; if (L >= 256) return false; u.pm = L >> 3; u.pn = L & 7; return true; }
    __device__ __forceinline__ void a_ready(const Unit&) const {}
    __device__ __forceinline__ void done(const Unit&) const {}
};

__global__ void __launch_bounds__(512, 2) fwd_kernel(Args a) {
    extern __shared__ __attribute__((aligned(16))) unsigned char lds_raw[];
    LAS unsigned char* lds = (LAS unsigned char*)lds_raw;
    cg::grid_group grid = cg::this_grid();
    volatile LAS unsigned* xst = (volatile LAS unsigned*)(lds + LDS_BYTES - 16);
    if (threadIdx.x < 4) xst[threadIdx.x] = 0u;
    __syncthreads();
    XcdBarrier xbar = xcd_barrier_post((unsigned*)(a.ws + WS_BAR), xst);
    unsigned* cen = (unsigned*)(a.ws + WS_BAR) + 3584;
    if (threadIdx.x == 0) xst[2] = xb_add(&cen[64 * xbar.x], 1u);
    if (a.ph_lo == 0 && a.ph_hi == NPHASE) grid.sync();
    int vc = blockIdx.x;
    if (a.ph_lo == 0 && a.ph_hi == NPHASE && gridDim.x == 256) {
        bool even = true;
#pragma unroll
        for (int j = 0; j < 8; ++j) even = even && (xb_ld(&cen[64 * j]) == 32u);
        if (even) vc = (int)xst[2] * 8 + (int)xbar.x;
    }
    vc = __builtin_amdgcn_readfirstlane(vc);
    const int tid = threadIdx.x, lane = tid & 63, wave = __builtin_amdgcn_readfirstlane(tid >> 6);
    unsigned char* ws = a.ws;
    float* SS = (float*)(ws + WS_SS);
    bf16_t* XB = (bf16_t*)(ws + WS_XB); bf16_t* G = (bf16_t*)(ws + WS_G); bf16_t* MIX = (bf16_t*)(ws + WS_MIX);
#define PH(i) if (a.ph_lo <= (i) && (i) < a.ph_hi)
#define SYNC(i) if (a.ph_lo <= (i) && (i) + 1 < a.ph_hi) { xcd_barrier(xbar); }
    PH(0) { phase0(a, lds, wave, lane); } SYNC(0)
    PH(1) { EpiGateUp E; E.G = G; E.ss = SS; run_gemm(lds, XB, (const bf16_t*)(ws + WS_W1GU), 2 * FF, DM, E, vc); conv_tail(a, lds, wave, lane, 32 * 44, CV_T1, CV_END, vc); } SYNC(1)
    PH(2) { EpiResid E; E.XB = XB; E.ss_out = SS + 8192; E.scale = 0.5f; run_gemm(lds, G, (const bf16_t*)(ws + WS_W1D), DM, FF, E, vc); } SYNC(2)
    PH(3) { EpiMixIn E; E.ss = SS + 8192; E.lbl = a.in[9]; E.QS = (bf16_t*)(ws + WS_QS);
            E.UC = (bf16_t*)(ws + WS_UC); E.LF = (float*)(ws + WS_LF); run_gemm(lds, XB, (const bf16_t*)(ws + WS_WIN), MIXIN, DM, E, vc); conv_tail(a, lds, wave, lane, 32 * 28, CV_T0, CV_T1, vc); } SYNC(3)
    PH(4) { hgrn_pass_a(a, lds, wave, lane); } SYNC(4)
    PH(5) { hgrn_scan(a); conv_mixer(a, wave, lane); } SYNC(5)
    PH(6) { hgrn_pass_c(a, lds, wave, lane); } SYNC(6)
    PH(7) { EpiResid E; E.XB = XB; E.ss_out = SS + 16384; E.scale = 1.0f; run_gemm(lds, MIX, (const bf16_t*)(ws + WS_WOUT), DM, DM, E, vc); } SYNC(7)
    PH(8) { EpiGateUp E; E.G = G; E.ss = SS + 16384; run_gemm(lds, XB, (const bf16_t*)(ws + WS_W2GU), 2 * FF, DM, E, vc);
            { const int r = (32 * 44) % (int)gridDim.x; TailOrder T; T.n = (int)gridDim.x - r; T.c = vc - r;
              EpiStoreBf16 E2; E2.O = (bf16_t*)(ws + WS_PLE); int kp = PLE; asm volatile("" : "+s"(kp));
              pg8::Gemm g2; g2.A = (const bf16_t*)(ws + WS_PB); g2.Bt = (const bf16_t*)(ws + WS_WPE); g2.M = M_TOK; g2.N = DM; g2.K = kp;
              pg8::gemm_phase<EpiStoreBf16, TailOrder, true, true>(lds, g2, T, E2); }
            conv_tail(a, lds, wave, lane, 32 * 44, CV_TA, CV_T0, vc); } SYNC(8)
    PH(9) { EpiResid E; E.XB = XB; E.ss_out = SS + 24576; E.scale = 0.5f; run_gemm(lds, G, (const bf16_t*)(ws + WS_W2D), DM, FF, E, vc); } SYNC(9)
    PH(10) { EpiPleGate E; E.XB = XB; E.H4 = MIX; E.P = (const bf16_t*)(ws + WS_PLE); E.ss = SS + 24576; run_gemm(lds, XB, (const bf16_t*)(ws + WS_WPG), DM, DM, E, vc); } SYNC(10)
    PH(11) { phase_final(a, wave, lane); }
#undef PH
#undef SYNC
}

#ifndef MK_MULTI
#define MK_MULTI 0
#endif
extern "C" void kernel_launch(void* const* d_in, const int* in_sizes, int n_in, void* d_out, int out_size, void* d_ws, size_t ws_size, hipStream_t stream) {
    static int grid = 0;
    if (grid == 0) {
        if (n_in != 21 || out_size != M_TOK * DM || ws_size < WS_END) { fprintf(stderr, "kernel_launch: unexpected shapes (n_in %d out %d ws %zu need %zu)\n", n_in, out_size, ws_size, (size_t)WS_END); grid = -1; return; }
        int dev = 0, cus = 0, per_cu = 0;
        hipGetDevice(&dev); hipDeviceGetAttribute(&cus, hipDeviceAttributeMultiprocessorCount, dev);
        if (hipFuncSetAttribute((const void*)fwd_kernel, hipFuncAttributeMaxDynamicSharedMemorySize, LDS_BYTES) != hipSuccess) { fprintf(stderr, "kernel_launch: hipFuncSetAttribute failed\n"); grid = -1; return; }
        if (hipOccupancyMaxActiveBlocksPerMultiprocessor(&per_cu, (const void*)fwd_kernel, 512, LDS_BYTES) != hipSuccess || per_cu < 1) { fprintf(stderr, "kernel_launch: occupancy query failed (%d)\n", per_cu); grid = -1; return; }
        grid = cus * per_cu;
    }
    if (grid < 0) return;
    Args a{};
    for (int i = 0; i < 21; ++i) a.in[i] = (const float*)d_in[i];
    a.out = (float*)d_out; a.ws = (unsigned char*)d_ws;
#if MK_MULTI
    for (int p = 0; p < NPHASE; ++p) { a.ph_lo = p; a.ph_hi = p + 1; hipLaunchKernelGGL(fwd_kernel, dim3(grid), dim3(512), LDS_BYTES, stream, a); }
#else
    a.ph_lo = 0; a.ph_hi = NPHASE;
    if (hipMemsetAsync((char*)d_ws + WS_BAR, 0, 4096 * 4, stream) != hipSuccess) { fprintf(stderr, "kernel_launch: memset failed\n"); return; }
    void* args[] = {&a};
    hipError_t e = hipLaunchCooperativeKernel((void*)fwd_kernel, dim3(grid), dim3(512), args, LDS_BYTES, stream);
    if (e != hipSuccess) fprintf(stderr, "cooperative launch failed: %s (grid %d)\n", hipGetErrorString(e), grid);
#endif
}
```

```cpp
#include <hip/hip_runtime.h>
#include <hip/hip_cooperative_groups.h>
#include <cstdio>
#include <cstdint>
namespace pg8 {
#define PG8_LAS __attribute__((address_space(3)))
typedef unsigned short bf16_t;
typedef short bf16x8 __attribute__((ext_vector_type(8)));
typedef float f32x4 __attribute__((ext_vector_type(4)));
typedef unsigned u32x4 __attribute__((ext_vector_type(4)));
constexpr int BM = 256, BK = 64, HALF = 128, HTB = HALF * BK * 2  , STAGE_BYTES = 8 * HTB, NXCD = 8, WGM = 8;

__host__ __device__ __forceinline__ int lds_byte(int r, int c) { const int st = (r >> 4) * 2 + (c >> 5), rr = r & 15, cc = c & 31, ob = rr * 64 + cc * 2; return st * 1024 + (ob ^ (((ob >> 9) & 1) << 5)); }
__host__ __device__ __forceinline__ void stage_rc(int b, int& R, int& C) { const int st = b / 1024, sb = b % 1024, swz = sb ^ (((sb >> 9) & 1) << 5); R = (st >> 1) * 16 + swz / 64; C = (st & 1) * 32 + (swz % 64) / 2; }
__host__ __device__ __forceinline__ int perm32(int rho) { const int n = rho >> 4, i = rho & 15; return 8 * (i >> 2) + 4 * n + (i & 3); }

struct Unit { int pm, pn; };
struct Gemm { const bf16_t* A; const bf16_t* Bt; int M, N, K; };

struct StaticOrder {
    int nM, nN, nwg, G, c;
    __host__ __device__ void init(int M, int N, int G_, int c_) { nM = M / BM; nN = N / BM; nwg = nM * nN; G = G_; c = c_; }
    __host__ __device__ bool next(int i, Unit& u) const {
        const long L = (long)i * G + c; if (L >= nwg) return false;
        int wgid = (int)L; { const int q = nwg / NXCD, r = nwg % NXCD, xcd = wgid % NXCD, off = wgid / NXCD; wgid = (xcd < r ? xcd * (q + 1) : r * (q + 1) + (xcd - r) * q) + off; }
        const int nig = WGM * nN, gid = wgid / nig, fm = gid * WGM, gsz = (nM - fm) < WGM ? (nM - fm) : WGM;
        u.pm = fm + ((wgid % nig) % gsz); u.pn = (wgid % nig) / gsz; return true;
    }
    __device__ __forceinline__ void a_ready(const Unit&) const {}
    __device__ __forceinline__ void done(const Unit&) const {}
};
typedef float f32x2 __attribute__((ext_vector_type(2)));
template <class Epi, class Sched, bool ALIGN_EPI = false, bool SP2 = false>
__device__ __forceinline__ void gemm_phase(PG8_LAS unsigned char* lds, const Gemm g, const Sched& S, const Epi& E) {
    const int tid = threadIdx.x, wid = __builtin_amdgcn_readfirstlane(tid >> 6), lane = tid & 63, wr = wid >> 2, wc = wid & 3, fr = lane & 15, fq = lane >> 4;
    const int K = g.K, nt = K / BK;
    unsigned voffA[2], voffB[2];
#pragma unroll
    for (int i = 0; i < 2; ++i) { int R, C; stage_rc(tid * 16 + i * 8192, R, C); const int Rb = Epi::PERM ? ((R & ~31) + perm32(R & 31)) : R;
        voffA[i] = (unsigned)(R * K + C) * 2u; voffB[i] = (unsigned)(Rb * K + C) * 2u; }
    const size_t kstep = (size_t)(BK * 2);
    const size_t hstep = (size_t)HALF * K * 2;
    const size_t tstep = 2 * hstep;
    const unsigned ldsw = (unsigned)wid * 1024u;
    const int aoff = lds_byte(wr * 64 + fr, fq * 8), boff = lds_byte(wc * 32 + fr, fq * 8);
#define PG8_SA(b, h) (((b) * 2 + (h)) * HTB)
#define PG8_SB(b, h) ((4 + (b) * 2 + (h)) * HTB)
#define PG8_STAGE(bufoff, gbase, voff) do { _Pragma("unroll") for (int _i = 0; _i < 2; ++_i) \
        __builtin_amdgcn_global_load_lds((const unsigned*)((const char*)(gbase) + (voff)[_i]), (PG8_LAS unsigned*)(lds + (bufoff) + ldsw + _i * 8192), 16, 0, 0); } while (0)
#define PG8_LDA(dst, b, h) do { _Pragma("unroll") for (int m = 0; m < 4; ++m) _Pragma("unroll") for (int k = 0; k < 2; ++k) dst[m][k] = *(const PG8_LAS bf16x8*)(lds + PG8_SA(b, h) + aoff + m * 2048 + k * 1024); } while (0)
#define PG8_LDB(dst, b, h) do { _Pragma("unroll") for (int n = 0; n < 2; ++n) _Pragma("unroll") for (int k = 0; k < 2; ++k) dst[n][k] = *(const PG8_LAS bf16x8*)(lds + PG8_SB(b, h) + boff + n * 2048 + k * 1024); } while (0)
#define PG8_MMA(ai, bj, At, Bt) do { __builtin_amdgcn_s_setprio(1); _Pragma("unroll") for (int m = 0; m < 4; ++m) _Pragma("unroll") for (int n = 0; n < 2; ++n) _Pragma("unroll") for (int k = 0; k < 2; ++k) \
        acc[ai][bj][m][n] = __builtin_amdgcn_mfma_f32_16x16x32_bf16(Bt[n][k], At[m][k], acc[ai][bj][m][n], 0, 0, 0); __builtin_amdgcn_s_setprio(0); } while (0)
#define PG8_WAIT_V(n) asm volatile("s_waitcnt vmcnt(" #n ")" ::: "memory")
#define PG8_WAIT_L(n) asm volatile("s_waitcnt lgkmcnt(" #n ")" ::: "memory")
#define PG8_BAR __builtin_amdgcn_s_barrier()
#define PG8_SCHED __builtin_amdgcn_sched_barrier(0)
    Unit cur, nxt; int ui = 0;
    if (!S.next(0, cur)) return;
    f32x4 acc[2][2][4][2];
#pragma unroll
    for (int a = 0; a < 2; ++a)
#pragma unroll
        for (int b = 0; b < 2; ++b)
#pragma unroll
            for (int m = 0; m < 4; ++m)
#pragma unroll
                for (int n = 0; n < 2; ++n) acc[a][b][m][n] = (f32x4){0.f, 0.f, 0.f, 0.f};
    bf16x8 At[4][2], B0[2][2], B1[2][2];
    const char* cA = (const char*)g.A + (size_t)cur.pm * tstep; const char* cB = (const char*)g.Bt + (size_t)cur.pn * tstep;
    S.a_ready(cur);
    if constexpr (SP2) {
        PG8_STAGE(PG8_SB(0, 0), cB, voffB); PG8_STAGE(PG8_SB(0, 1), cB + hstep, voffB); PG8_STAGE(PG8_SA(0, 0), cA, voffA); PG8_STAGE(PG8_SA(0, 1), cA + hstep, voffA);
        if (wr == 1) PG8_BAR;
        PG8_WAIT_V(2); PG8_BAR;
        PG8_STAGE(PG8_SB(1, 0), cB + kstep, voffB); PG8_STAGE(PG8_SA(1, 0), cA + kstep, voffA); PG8_STAGE(PG8_SB(1, 1), cB + hstep + kstep, voffB);
        PG8_WAIT_V(6); PG8_BAR;
    } else {
        PG8_STAGE(PG8_SB(0, 0), cB, voffB); PG8_STAGE(PG8_SA(0, 0), cA, voffA); PG8_STAGE(PG8_SB(0, 1), cB + hstep, voffB); PG8_STAGE(PG8_SA(0, 1), cA + hstep, voffA);
        if (wr == 1) PG8_BAR;
        PG8_WAIT_V(4); PG8_BAR;
        PG8_STAGE(PG8_SB(1, 0), cB + kstep, voffB); PG8_STAGE(PG8_SA(1, 0), cA + kstep, voffA); PG8_STAGE(PG8_SB(1, 1), cB + hstep + kstep, voffB);
        PG8_WAIT_V(6); PG8_BAR;
    }
    for (;;) {
        const bool has_next = S.next(ui + 1, nxt);
        const char* nA = has_next ? (const char*)g.A + (size_t)nxt.pm * tstep : cA; const char* nB = has_next ? (const char*)g.Bt + (size_t)nxt.pn * tstep : cB;
        for (int t = 0; t < nt; t += 2) {
            const bool last = (t == nt - 2);
            const char* a1 = cA + (size_t)(t + 1) * kstep;
            const char* a2 = last ? nA : cA + (size_t)(t + 2) * kstep; const char* b2 = last ? nB : cB + (size_t)(t + 2) * kstep;
            const char* a3 = a2 + kstep; const char* b3 = b2 + kstep;
            if (last && has_next) S.a_ready(nxt);
            if constexpr (SP2) {
            PG8_LDB(B0, 0, 0); PG8_LDB(B1, 0, 1); PG8_SCHED; PG8_LDA(At, 0, 0); PG8_STAGE(PG8_SA(1, 1), a1 + hstep, voffA);
            PG8_WAIT_V(8); PG8_WAIT_L(0); PG8_BAR; PG8_MMA(0, 0, At, B0); PG8_MMA(0, 1, At, B1); PG8_BAR; PG8_SCHED;
            PG8_LDA(At, 0, 1); PG8_STAGE(PG8_SB(0, 0), b2, voffB); PG8_STAGE(PG8_SB(0, 1), b2 + hstep, voffB); PG8_STAGE(PG8_SA(0, 0), a2, voffA);
            PG8_WAIT_V(8); PG8_WAIT_L(0); PG8_BAR; PG8_MMA(1, 0, At, B0); PG8_MMA(1, 1, At, B1); PG8_BAR; PG8_SCHED;
            PG8_LDB(B0, 1, 0); PG8_LDB(B1, 1, 1); PG8_SCHED; PG8_LDA(At, 1, 0); PG8_STAGE(PG8_SA(0, 1), a2 + hstep, voffA);
            PG8_WAIT_V(8); PG8_WAIT_L(0); PG8_BAR; PG8_MMA(0, 0, At, B0); PG8_MMA(0, 1, At, B1); PG8_BAR; PG8_SCHED;
            PG8_LDA(At, 1, 1); PG8_STAGE(PG8_SB(1, 0), b3, voffB); PG8_STAGE(PG8_SB(1, 1), b3 + hstep, voffB); PG8_STAGE(PG8_SA(1, 0), a3, voffA);
            PG8_WAIT_V(8); PG8_WAIT_L(0); PG8_BAR; PG8_MMA(1, 0, At, B0); PG8_MMA(1, 1, At, B1); PG8_BAR; PG8_SCHED;
            } else {
            PG8_LDB(B0, 0, 0); PG8_SCHED; PG8_LDA(At, 0, 0); PG8_STAGE(PG8_SA(1, 1), a1 + hstep, voffA);
            PG8_WAIT_L(8); PG8_BAR; PG8_WAIT_L(0); PG8_MMA(0, 0, At, B0); PG8_BAR; PG8_SCHED;
            PG8_LDB(B1, 0, 1); PG8_STAGE(PG8_SB(0, 0), b2, voffB);
            PG8_BAR; PG8_WAIT_L(0); PG8_MMA(0, 1, At, B1); PG8_BAR;
            PG8_LDA(At, 0, 1); PG8_STAGE(PG8_SA(0, 0), a2, voffA);
            PG8_BAR; PG8_WAIT_L(0); PG8_MMA(1, 0, At, B0); PG8_BAR; PG8_SCHED;
            PG8_STAGE(PG8_SB(0, 1), b2 + hstep, voffB);
            PG8_WAIT_V(6); PG8_BAR; PG8_MMA(1, 1, At, B1); PG8_BAR;
            PG8_LDB(B0, 1, 0); PG8_SCHED; PG8_LDA(At, 1, 0); PG8_STAGE(PG8_SA(0, 1), a2 + hstep, voffA);
            PG8_WAIT_L(8); PG8_BAR; PG8_WAIT_L(0); PG8_MMA(0, 0, At, B0); PG8_BAR; PG8_SCHED;
            PG8_LDB(B1, 1, 1); PG8_STAGE(PG8_SB(1, 0), b3, voffB);
            PG8_BAR; PG8_WAIT_L(0); PG8_MMA(0, 1, At, B1); PG8_BAR;
            PG8_LDA(At, 1, 1); PG8_STAGE(PG8_SA(1, 0), a3, voffA);
            PG8_BAR; PG8_WAIT_L(0); PG8_MMA(1, 0, At, B0); PG8_BAR; PG8_SCHED;
            PG8_STAGE(PG8_SB(1, 1), b3 + hstep, voffB);
            PG8_WAIT_V(6); PG8_BAR; PG8_MMA(1, 1, At, B1); PG8_BAR;
            }
        }
        if constexpr (ALIGN_EPI) { if (wr == 0) PG8_BAR; }
        if constexpr (!Epi::AFTER_DRAIN) { E(acc, cur, wr, wc, fr, fq); S.done(cur); }
        if (!has_next) break;
#pragma unroll
        for (int a = 0; a < 2; ++a)
#pragma unroll
            for (int b = 0; b < 2; ++b)
#pragma unroll
                for (int m = 0; m < 4; ++m)
#pragma unroll
                    for (int n = 0; n < 2; ++n) acc[a][b][m][n] = (f32x4){0.f, 0.f, 0.f, 0.f};
        cur = nxt; cA = nA; cB = nB; ++ui;
        if constexpr (ALIGN_EPI) { if (wr == 1) PG8_BAR; }
    }
    PG8_WAIT_V(0);
    if constexpr (!ALIGN_EPI) { if (wr == 0) PG8_BAR; }
    PG8_BAR;
    if constexpr (Epi::AFTER_DRAIN) { E.fused(acc, cur, wr, wc, fr, fq, lds, wid, lane); S.done(cur); }
#undef PG8_SA
#undef PG8_SB
#undef PG8_STAGE
#undef PG8_LDA
#undef PG8_LDB
#undef PG8_MMA
#undef PG8_WAIT_V
#undef PG8_WAIT_L
#undef PG8_BAR
#undef PG8_SCHED
}
}

namespace cg = cooperative_groups;
using pg8::bf16_t; using pg8::bf16x8; using pg8::f32x4; using pg8::u32x4; using pg8::Unit;
typedef float f32x2c __attribute__((ext_vector_type(2)));
typedef __bf16 bf16x2c __attribute__((ext_vector_type(2)));
__device__ __forceinline__ unsigned cvt_pk_bf16(float lo, float hi) { const f32x2c v = {lo, hi}; return __builtin_bit_cast(unsigned, __builtin_convertvector(v, bf16x2c)); }
#define LAS __attribute__((address_space(3)))
typedef unsigned u32x2 __attribute__((ext_vector_type(2)));
typedef float f32x2v __attribute__((ext_vector_type(2)));

constexpr int M_TOK = 8192, DM = 2048, FF = 5632, HW = 1024, CW = 1024, MIXIN = 7168, PLE = 256, SEQ = 2048;
constexpr float EPS = 1e-6f;
constexpr size_t MiB = 1ull << 20;
constexpr size_t WS_W1GU = 0, WS_W1D = 44 * MiB, WS_WIN = 66 * MiB, WS_WOUT = 94 * MiB, WS_W2GU = 102 * MiB, WS_W2D = 146 * MiB,
                 WS_WPG = 168 * MiB, WS_WPE = 176 * MiB, WS_PB = 177 * MiB, WS_XB = 181 * MiB, WS_MIX = 213 * MiB, WS_G = 245 * MiB,
                 WS_QS = 245 * MiB, WS_VH = 261 * MiB, WS_GH = 277 * MiB, WS_BC = 293 * MiB, WS_UC = 309 * MiB, WS_LF = 325 * MiB,
                 WS_S = 357 * MiB, WS_PLE = 0, WS_SS = 389 * MiB, WS_DD = 389 * MiB + 512 * 1024, WS_BAR = 390 * MiB + 512 * 1024, WS_END = 391 * MiB, WS_U = 0;
constexpr int LDS_BYTES = 144 * 1024;
constexpr int NPHASE = 12;

__device__ __forceinline__ float bf2f(bf16_t b) { return __uint_as_float(((unsigned)b) << 16); }
__device__ __forceinline__ float bflo(unsigned w) { return __uint_as_float(w << 16); }
__device__ __forceinline__ float bfhi(unsigned w) { return __uint_as_float(w & 0xffff0000u); }
__device__ __forceinline__ float wave_sum(float v) {
#pragma unroll
    for (int o = 1; o < 64; o <<= 1) v += __shfl_xor(v, o);
    return v;
}
__device__ __forceinline__ float fsigmoid(float x) { return __builtin_amdgcn_rcpf(1.0f + __expf(-x)); }
__device__ __forceinline__ float fsilu(float x) { return x * fsigmoid(x); }
__device__ __forceinline__ float rinv_of(float ss) { return rsqrtf(ss * (1.0f / DM) + EPS); }

struct EpiGateUp {
    static constexpr bool PERM = true, AFTER_DRAIN = false;
    bf16_t* G; const float* ss;
    __device__ __forceinline__ void operator()(const f32x4 (&acc)[2][2][4][2], const Unit& u, int wr, int wc, int fr, int fq) const {
        const int row0 = u.pm * 256 + wr * 64 + fr, col0 = u.pn * 128 + wc * 32 + 8 * fq;
#pragma unroll
        for (int ai = 0; ai < 2; ++ai)
#pragma unroll
            for (int m = 0; m < 4; ++m) {
                const int r = row0 + ai * 128 + m * 16; const float ri = rinv_of(ss[r]);
                float v[8];
#pragma unroll
                for (int n = 0; n < 2; ++n)
#pragma unroll
                    for (int j = 0; j < 4; ++j) v[n * 4 + j] = fsilu(acc[ai][0][m][n][j] * ri) * (acc[ai][1][m][n][j] * ri);
                u32x4 w; w.x = cvt_pk_bf16(v[0], v[1]); w.y = cvt_pk_bf16(v[2], v[3]); w.z = cvt_pk_bf16(v[4], v[5]); w.w = cvt_pk_bf16(v[6], v[7]);
                *(u32x4*)(G + (size_t)r * FF + col0) = w;
            }
    }
};
struct EpiResid {
    static constexpr bool PERM = true, AFTER_DRAIN = false;
    bf16_t* XB; float* ss_out; float scale;
    __device__ __forceinline__ void operator()(f32x4 (&acc)[2][2][4][2], const Unit& u, int wr, int wc, int fr, int fq) const {
        const int row0 = u.pm * 256 + wr * 64 + fr, col0 = u.pn * 256 + wc * 32 + 8 * fq;
#pragma unroll
        for (int ai = 0; ai < 2; ++ai) {
#pragma unroll
            for (int m = 0; m < 4; ++m)
#pragma unroll
                for (int bj = 0; bj < 2; ++bj) {
                    const size_t off = (size_t)(row0 + ai * 128 + m * 16) * DM + col0 + bj * 128;
                    const u32x4 xw = *(const u32x4*)(XB + off);
                    f32x4 r0, r1; r0[0] = bflo(xw.x); r0[1] = bfhi(xw.x); r0[2] = bflo(xw.y); r0[3] = bfhi(xw.y); r1[0] = bflo(xw.z); r1[1] = bfhi(xw.z); r1[2] = bflo(xw.w); r1[3] = bfhi(xw.w);
                    acc[ai][bj][m][0] = r0 + acc[ai][bj][m][0] * scale; acc[ai][bj][m][1] = r1 + acc[ai][bj][m][1] * scale;
                }
            asm volatile("" ::: "memory");
#pragma unroll
            for (int m = 0; m < 4; ++m) {
                const int r = row0 + ai * 128 + m * 16; float sq = 0.f;
#pragma unroll
                for (int bj = 0; bj < 2; ++bj) {
                    const size_t off = (size_t)r * DM + col0 + bj * 128;
                    const f32x4 v0 = acc[ai][bj][m][0], v1 = acc[ai][bj][m][1];
                    u32x4 w; w.x = cvt_pk_bf16(v0[0], v0[1]); w.y = cvt_pk_bf16(v0[2], v0[3]); w.z = cvt_pk_bf16(v1[0], v1[1]); w.w = cvt_pk_bf16(v1[2], v1[3]);
                    *(u32x4*)(XB + off) = w;
                    sq += (v0[0] * v0[0] + v0[1] * v0[1]) + (v0[2] * v0[2] + v0[3] * v0[3]) + (v1[0] * v1[0] + v1[1] * v1[1]) + (v1[2] * v1[2] + v1[3] * v1[3]);
                }
                sq += __shfl_xor(sq, 16); sq += __shfl_xor(sq, 32);
                if (fq == 0) atomicAdd(ss_out + r, sq);
            }
            asm volatile("" ::: "memory");
        }
    }
};
struct EpiMixIn {
    static constexpr bool PERM = true, AFTER_DRAIN = false;
    const float* ss; const float* lbl;
    bf16_t *QS, *UC; float* LF;
    __device__ __forceinline__ void operator()(const f32x4 (&acc)[2][2][4][2], const Unit& u, int wr, int wc, int fr, int fq) const {
        const int row0 = u.pm * 256 + wr * 64 + fr; const int sec = u.pn >> 2;
        if (u.pn >= 20) {
            const int col0 = (u.pn - 20) * 128 + wc * 32 + 8 * fq;
#pragma unroll
            for (int ai = 0; ai < 2; ++ai)
#pragma unroll
                for (int m = 0; m < 4; ++m) {
                    const int r = row0 + ai * 128 + m * 16; const float ri = rinv_of(ss[r]); const float ri2 = ri * ri;
                    float v[8];
#pragma unroll
                    for (int n = 0; n < 2; ++n)
#pragma unroll
                        for (int j = 0; j < 4; ++j) v[n * 4 + j] = acc[ai][0][m][n][j] * acc[ai][1][m][n][j] * ri2;
                    u32x4 w; w.x = cvt_pk_bf16(v[0], v[1]); w.y = cvt_pk_bf16(v[2], v[3]); w.z = cvt_pk_bf16(v[4], v[5]); w.w = cvt_pk_bf16(v[6], v[7]);
                    *(u32x4*)(UC + (size_t)r * CW + col0) = w;
                }
            return;
        }
        const int col0 = (u.pn & 3) * 256 + wc * 32 + 8 * fq;
        if (sec == 1) {
#pragma unroll
            for (int bj = 0; bj < 2; ++bj)
#pragma unroll
                for (int n = 0; n < 2; ++n) {
                    const int c = col0 + bj * 128 + 4 * n; const f32x4 l0 = *(const f32x4*)(lbl + c), l1 = *(const f32x4*)(lbl + 1024 + c);
                    f32x4 lb; lb[0] = fsigmoid(l0[0] - l1[0]); lb[1] = fsigmoid(l0[1] - l1[1]); lb[2] = fsigmoid(l0[2] - l1[2]); lb[3] = fsigmoid(l0[3] - l1[3]);
#pragma unroll
                    for (int ai = 0; ai < 2; ++ai)
#pragma unroll
                        for (int m = 0; m < 4; ++m) {
                            const int r = row0 + ai * 128 + m * 16; const float ri = rinv_of(ss[r]);
                            const f32x4 x = acc[ai][bj][m][n]; f32x4 o;
                            o[0] = __logf(lb[0] + (1.0f - lb[0]) * fsigmoid(x[0] * ri)); o[1] = __logf(lb[1] + (1.0f - lb[1]) * fsigmoid(x[1] * ri));
                            o[2] = __logf(lb[2] + (1.0f - lb[2]) * fsigmoid(x[2] * ri)); o[3] = __logf(lb[3] + (1.0f - lb[3]) * fsigmoid(x[3] * ri));
                            *(f32x4*)(LF + (size_t)r * HW + c) = o;
                        }
                }
            return;
        }
        bf16_t* dst = QS + (size_t)(sec == 0 ? 0 : sec - 1) * ((size_t)M_TOK * HW);
        const bool act = (sec == 0 || sec == 3);
#pragma unroll
        for (int ai = 0; ai < 2; ++ai)
#pragma unroll
            for (int m = 0; m < 4; ++m) {
                const int r = row0 + ai * 128 + m * 16; const float ri = rinv_of(ss[r]);
#pragma unroll
                for (int bj = 0; bj < 2; ++bj) {
                    float v[8];
#pragma unroll
                    for (int n = 0; n < 2; ++n)
#pragma unroll
                        for (int j = 0; j < 4; ++j) { const float x = acc[ai][bj][m][n][j] * ri; v[n * 4 + j] = act ? fsilu(x) : x; }
                    u32x4 w; w.x = cvt_pk_bf16(v[0], v[1]); w.y = cvt_pk_bf16(v[2], v[3]); w.z = cvt_pk_bf16(v[4], v[5]); w.w = cvt_pk_bf16(v[6], v[7]);
                    *(u32x4*)(dst + (size_t)r * HW + col0 + bj * 128) = w;
                }
            }
    }
};
struct EpiStoreBf16 {
    static constexpr bool PERM = true, AFTER_DRAIN = false;
    bf16_t* O;
    __device__ __forceinline__ void operator()(const f32x4 (&acc)[2][2][4][2], const Unit& u, int wr, int wc, int fr, int fq) const {
        const int row0 = u.pm * 256 + wr * 64 + fr, col0 = u.pn * 256 + wc * 32 + 8 * fq;
#pragma unroll
        for (int ai = 0; ai < 2; ++ai)
#pragma unroll
            for (int m = 0; m < 4; ++m) {
                const int r = row0 + ai * 128 + m * 16;
#pragma unroll
                for (int bj = 0; bj < 2; ++bj) {
                    const f32x4 v0 = acc[ai][bj][m][0], v1 = acc[ai][bj][m][1];
                    u32x4 w; w.x = cvt_pk_bf16(v0[0], v0[1]); w.y = cvt_pk_bf16(v0[2], v0[3]); w.z = cvt_pk_bf16(v1[0], v1[1]); w.w = cvt_pk_bf16(v1[2], v1[3]);
                    *(u32x4*)(O + (size_t)r * DM + col0 + bj * 128) = w;
                }
            }
    }
};
struct EpiPleGate {
    static constexpr bool PERM = true, AFTER_DRAIN = false;
    const bf16_t* XB; const bf16_t* P; bf16_t* H4; const float* ss;
    __device__ __forceinline__ void operator()(f32x4 (&acc)[2][2][4][2], const Unit& u, int wr, int wc, int fr, int fq) const {
        const int row0 = u.pm * 256 + wr * 64 + fr, col0 = u.pn * 256 + wc * 32 + 8 * fq;
#pragma unroll
        for (int ai = 0; ai < 2; ++ai)
#pragma unroll
            for (int m = 0; m < 4; ++m) {
                const int r = row0 + ai * 128 + m * 16; const float ri = rinv_of(ss[r]);
#pragma unroll
                for (int bj = 0; bj < 2; ++bj) {
                    const size_t off = (size_t)r * DM + col0 + bj * 128;
                    const u32x4 pw = *(const u32x4*)(P + off), xw = *(const u32x4*)(XB + off);
                    const f32x4 a0 = acc[ai][bj][m][0], a1 = acc[ai][bj][m][1];
                    u32x4 w;
                    w.x = cvt_pk_bf16(bflo(xw.x) + fsigmoid(a0[0] * ri) * bflo(pw.x), bfhi(xw.x) + fsigmoid(a0[1] * ri) * bfhi(pw.x));
                    w.y = cvt_pk_bf16(bflo(xw.y) + fsigmoid(a0[2] * ri) * bflo(pw.y), bfhi(xw.y) + fsigmoid(a0[3] * ri) * bfhi(pw.y));
                    w.z = cvt_pk_bf16(bflo(xw.z) + fsigmoid(a1[0] * ri) * bflo(pw.z), bfhi(xw.z) + fsigmoid(a1[1] * ri) * bfhi(pw.z));
                    w.w = cvt_pk_bf16(bflo(xw.w) + fsigmoid(a1[2] * ri) * bflo(pw.w), bfhi(xw.w) + fsigmoid(a1[3] * ri) * bfhi(pw.w));
                    *(u32x4*)(H4 + off) = w;
                }
            }
    }
};

template <int MODE>
__device__ __forceinline__ void p0_item(const float* W, const float* W2, const float* gain, int K, int N, bf16_t* WT, LAS float* scr, int item, int lane) {
    const int nblk_k = K / 64; const int nb = item / nblk_k, kb = item % nblk_k; const int k0 = 64 * kb, n0 = 32 * nb;
    const float* src = W; int c0 = n0;
    if (MODE == 1) { const int t = n0 >> 8, bj = (n0 >> 7) & 1, c = n0 & 127; src = bj ? W2 : W; c0 = 128 * t + c; }
    if (MODE == 2) { if (n0 >= 5120) { const int tt = n0 - 5120; const int t = tt >> 8, bj = (tt >> 7) & 1, c = tt & 127; c0 = 5120 + 1024 * bj + 128 * t + c; } }
    float v[32], gg[32];
    const float* sp = src + (size_t)(k0 + (lane >> 5)) * N + c0 + (lane & 31);
#pragma unroll
    for (int i = 0; i < 32; ++i) v[i] = __builtin_nontemporal_load(sp + (size_t)(2 * i) * N);
    if (gain) {
#pragma unroll
        for (int i = 0; i < 32; ++i) gg[i] = gain[k0 + 2 * i + (lane >> 5)];
#pragma unroll
        for (int i = 0; i < 32; ++i) v[i] *= gg[i];
    }
#pragma unroll
    for (int i = 0; i < 32; ++i) scr[(2 * i + (lane >> 5)) * 33 + (lane & 31)] = v[i];
    asm volatile("s_waitcnt lgkmcnt(0)" ::: "memory");
    const int c = lane & 7;
#pragma unroll
    for (int j = 0; j < 4; ++j) { const int n = (lane >> 3) + 8 * j; const LAS float* s = scr + (8 * c) * 33 + n;
        u32x4 o; o.x = cvt_pk_bf16(s[0 * 33], s[1 * 33]); o.y = cvt_pk_bf16(s[2 * 33], s[3 * 33]); o.z = cvt_pk_bf16(s[4 * 33], s[5 * 33]); o.w = cvt_pk_bf16(s[6 * 33], s[7 * 33]);
        *(u32x4*)(WT + (size_t)(n0 + n) * K + k0 + 8 * c) = o; }
    asm volatile("s_waitcnt lgkmcnt(0)" ::: "memory");
}

struct Args { const float* in[21]; float* out; unsigned char* ws; int ph_lo, ph_hi; };

constexpr int CV_I0 = 32 * 352, CV_I1 = 88 * 64, CV_I2 = 32 * 224, CV_I3 = 32 * 64, CV_I7 = 4 * 64;
constexpr int CV_END = 2 * CV_I0 + 2 * CV_I1 + CV_I2 + 2 * CV_I3 + CV_I7, CV_T1 = CV_END - 10000, CV_T0 = CV_T1 - 10000, CV_TA = CV_I0 + CV_I2 + CV_I3 + CV_I7;
__device__ __forceinline__ void conv_range(const Args& a, LAS unsigned char* lds, int wave, int lane, int lo, int hi, int w0, int nw) {
    unsigned char* ws = a.ws;
    LAS float* scr = (LAS float*)(lds + wave * 16384);
    for (int it = lo + w0; it < hi; it += nw) {
        int r = it;
        if (r < CV_I0) { p0_item<1>(a.in[3], a.in[4], a.in[2], DM, FF, (bf16_t*)(ws + WS_W1GU), scr, r, lane); continue; } r -= CV_I0;
        if (r < CV_I2) { p0_item<2>(a.in[7], nullptr, a.in[6], DM, MIXIN, (bf16_t*)(ws + WS_WIN), scr, r, lane); continue; } r -= CV_I2;
        if (r < CV_I3) { p0_item<0>(a.in[12], nullptr, nullptr, DM, DM, (bf16_t*)(ws + WS_WOUT), scr, r, lane); continue; } r -= CV_I3;
        if (r < CV_I7) { p0_item<0>(a.in[18], nullptr, nullptr, PLE, DM, (bf16_t*)(ws + WS_WPE), scr, r, lane); continue; } r -= CV_I7;
        if (r < CV_I3) { p0_item<0>(a.in[19], nullptr, a.in[17], DM, DM, (bf16_t*)(ws + WS_WPG), scr, r, lane); continue; } r -= CV_I3;
        if (r < CV_I1) { p0_item<0>(a.in[16], nullptr, nullptr, FF, DM, (bf16_t*)(ws + WS_W2D), scr, r, lane); continue; } r -= CV_I1;
        if (r < CV_I0) { p0_item<1>(a.in[14], a.in[15], a.in[13], DM, FF, (bf16_t*)(ws + WS_W2GU), scr, r, lane); continue; } r -= CV_I0;
        p0_item<0>(a.in[5], nullptr, nullptr, FF, DM, (bf16_t*)(ws + WS_W1D), scr, r, lane);
    }
}
__device__ __forceinline__ void conv_tail(const Args& a, LAS unsigned char* lds, int wave, int lane, int nunits, int lo, int hi, int vc) {
    const int r = nunits % (int)gridDim.x;
    if (r == 0) { conv_range(a, lds, wave, lane, lo, hi, vc * 8 + wave, gridDim.x * 8); return; }
    if (vc >= r) conv_range(a, lds, wave, lane, lo, hi, (vc - r) * 8 + wave, ((int)gridDim.x - r) * 8);
}

__device__ __forceinline__ void phase0(const Args& a, LAS unsigned char* lds, int wave, int lane) {
    unsigned char* ws = a.ws;
    const int gw = blockIdx.x * 8 + wave, NGW = gridDim.x * 8;
    conv_range(a, lds, wave, lane, 0, CV_TA, gw, NGW);
    float* SS = (float*)(ws + WS_SS);
    for (int m = gw; m < M_TOK; m += NGW) {
        const f32x4* xr = (const f32x4*)(a.in[0] + (size_t)m * DM) + lane; u32x2* xb = (u32x2*)((bf16_t*)(ws + WS_XB) + (size_t)m * DM) + lane;
        float s = 0.f;
#pragma unroll
        for (int j = 0; j < 8; ++j) { const f32x4 v = __builtin_nontemporal_load(xr + 64 * j); s += (v[0] * v[0] + v[1] * v[1]) + (v[2] * v[2] + v[3] * v[3]);
            u32x2 w; w.x = cvt_pk_bf16(v[0], v[1]); w.y = cvt_pk_bf16(v[2], v[3]); xb[64 * j] = w; }
        s = wave_sum(s);
        if (lane == 0) { SS[m] = s; SS[8192 + m] = 0.f; SS[16384 + m] = 0.f; SS[24576 + m] = 0.f; }
    }
    { const int gt = blockIdx.x * 512 + threadIdx.x, NT = gridDim.x * 512;
      for (int i = gt; i < M_TOK * PLE / 4; i += NT) { const f32x4 v = ((const f32x4*)a.in[1])[i]; u32x2 w; w.x = cvt_pk_bf16(v[0], v[1]); w.y = cvt_pk_bf16(v[2], v[3]); ((u32x2*)(ws + WS_PB))[i] = w; } }
}

constexpr int HP = 136, VP = 72;
constexpr int L_QT = 0, L_QH = L_QT + 64 * HP * 2, L_KA = L_QH + 64 * HP * 2, L_KB = L_KA + 64 * HP * 2, L_ST = L_KB + 32 * HP * 2, L_VT = L_ST + 128 * HP * 2,
              L_P = L_VT + 128 * VP * 2, L_SEG = L_P + 64 * VP * 2, L_PART = L_SEG + 4 * 128 * 4, L_RINV = L_PART + 8 * 64 * 4, L_HEND = L_RINV + 256, L_KT = 0;
static_assert(L_HEND <= LDS_BYTES, "LDS");
#define MFMA16(a, b, c) __builtin_amdgcn_mfma_f32_16x16x32_bf16((a), (b), (c), 0, 0, 0)
__device__ __forceinline__ bf16_t f2bf(float x) { return (bf16_t)(cvt_pk_bf16(x, 0.f) & 0xffffu); }

__device__ __forceinline__ void hgrn_pass_a(const Args& a, LAS unsigned char* lds, int wave, int lane) {
    unsigned char* ws = a.ws;
    const float* LF = (const float*)(ws + WS_LF); const bf16_t* VH = (const bf16_t*)(ws + WS_VH); bf16_t* U = (bf16_t*)(ws + WS_U); float* Dd = (float*)(ws + WS_DD);
    const int tid = threadIdx.x, k = tid & 127, sg = tid >> 7, fr = lane & 15, fq = lane >> 4;
    LAS bf16_t* VT = (LAS bf16_t*)(lds + L_VT); LAS bf16_t* KT = (LAS bf16_t*)(lds + L_KT); LAS float* SEG = (LAS float*)(lds + L_SEG);
    for (int item = blockIdx.x; item < 1024; item += gridDim.x) {
        const int row0 = (item >> 3) * 64, cb = (item & 7) * 128;
        float lf[16], b[16];
#pragma unroll
        for (int i = 0; i < 16; ++i) lf[i] = LF[(size_t)(row0 + 16 * sg + i) * HW + cb + k];
        u32x4 vv[2];
#pragma unroll
        for (int j = 0; j < 2; ++j) { const int idx = tid + 512 * j; vv[j] = *(const u32x4*)(VH + (size_t)(row0 + (idx >> 4)) * HW + cb + 8 * (idx & 15)); }
        float run = 0.f;
#pragma unroll
        for (int i = 0; i < 16; ++i) { run += lf[i]; b[i] = run; }
        SEG[sg * 128 + k] = run;
        __syncthreads();
        const float s0 = SEG[k], s1 = SEG[128 + k], s2 = SEG[256 + k], s3 = SEG[384 + k];
        const float pre = sg == 0 ? 0.f : (sg == 1 ? s0 : (sg == 2 ? s0 + s1 : s0 + s1 + s2));
        const float blast = s0 + s1 + s2 + s3;
        unsigned pk[8];
#pragma unroll
        for (int i = 0; i < 8; ++i) {
            const float e0 = (1.0f - __expf(lf[2 * i])) * __expf(blast - (pre + b[2 * i])), e1 = (1.0f - __expf(lf[2 * i + 1])) * __expf(blast - (pre + b[2 * i + 1]));
            pk[i] = cvt_pk_bf16(e0, e1); }
        { u32x4 w0, w1; w0.x = pk[0]; w0.y = pk[1]; w0.z = pk[2]; w0.w = pk[3]; w1.x = pk[4]; w1.y = pk[5]; w1.z = pk[6]; w1.w = pk[7];
          *(LAS u32x4*)(KT + k * VP + 16 * sg) = w0; *(LAS u32x4*)(KT + k * VP + 16 * sg + 8) = w1; }
#pragma unroll
        for (int j = 0; j < 2; ++j) { const int idx = tid + 512 * j, s = idx >> 4, v0 = 8 * (idx & 15);
            VT[(v0 + 0) * VP + s] = (bf16_t)(vv[j].x & 0xffffu); VT[(v0 + 1) * VP + s] = (bf16_t)(vv[j].x >> 16);
            VT[(v0 + 2) * VP + s] = (bf16_t)(vv[j].y & 0xffffu); VT[(v0 + 3) * VP + s] = (bf16_t)(vv[j].y >> 16);
            VT[(v0 + 4) * VP + s] = (bf16_t)(vv[j].z & 0xffffu); VT[(v0 + 5) * VP + s] = (bf16_t)(vv[j].z >> 16);
            VT[(v0 + 6) * VP + s] = (bf16_t)(vv[j].w & 0xffffu); VT[(v0 + 7) * VP + s] = (bf16_t)(vv[j].w >> 16); }
        if (sg == 0) Dd[item * 128 + k] = __expf(blast);
        __syncthreads();
        const bf16x8 a0 = *(const LAS bf16x8*)(VT + (16 * wave + fr) * VP + fq * 8), a1 = *(const LAS bf16x8*)(VT + (16 * wave + fr) * VP + 32 + fq * 8);
        bf16_t* up = U + (size_t)item * 16384 + (16 * wave + 4 * fq) * 128 + fr;
#pragma unroll
        for (int kt = 0; kt < 8; ++kt) {
            const bf16x8 b0 = *(const LAS bf16x8*)(KT + (16 * kt + fr) * VP + fq * 8), b1 = *(const LAS bf16x8*)(KT + (16 * kt + fr) * VP + 32 + fq * 8);
            f32x4 acc = {0.f, 0.f, 0.f, 0.f};
            acc = MFMA16(a0, b0, acc); acc = MFMA16(a1, b1, acc);
            up[16 * kt] = f2bf(acc[0]); up[16 * kt + 128] = f2bf(acc[1]); up[16 * kt + 256] = f2bf(acc[2]); up[16 * kt + 384] = f2bf(acc[3]);
        }
        __syncthreads();
    }
}

__device__ __forceinline__ void hgrn_scan(const Args& a) {
    unsigned char* ws = a.ws;
    const bf16_t* U = (const bf16_t*)(ws + WS_U); const float* Dd = (const float*)(ws + WS_DD); bf16_t* SP = (bf16_t*)(ws + WS_S);
    for (int e = (blockIdx.x * 512 + threadIdx.x) * 4; e < 32 * 16384; e += gridDim.x * 512 * 4) {
        const int bh = e >> 14, vk = e & 16383, bb = bh >> 3, h = bh & 7;
        f32x4 S = {0.f, 0.f, 0.f, 0.f};
#pragma unroll 8
        for (int ci = 0; ci < 32; ++ci) {
            const size_t item = (size_t)((bb * 32 + ci) * 8 + h);
            const u32x2 uw = *(const u32x2*)(U + item * 16384 + vk); f32x4 u; u[0] = bflo(uw.x); u[1] = bfhi(uw.x); u[2] = bflo(uw.y); u[3] = bfhi(uw.y); const f32x4 d = *(const f32x4*)(Dd + item * 128 + (vk & 127));
            u32x2 w; w.x = cvt_pk_bf16(S[0], S[1]); w.y = cvt_pk_bf16(S[2], S[3]); *(u32x2*)(SP + item * 16384 + vk) = w;
            S = d * S + u;
        }
    }
}

__device__ __forceinline__ void conv_mixer(const Args& a, int wave, int lane) {
    unsigned char* ws = a.ws;
    const bf16_t* BC = (const bf16_t*)(ws + WS_BC); const bf16_t* UC = (const bf16_t*)(ws + WS_UC); bf16_t* MIX = (bf16_t*)(ws + WS_MIX);
    const float* cn = a.in[11]; const float* cw = a.in[8];
    const int gw = blockIdx.x * 8 + wave, NGW = gridDim.x * 8;
    for (int it = gw; it < M_TOK * 2; it += NGW) {
        const int row = it >> 1, c = (it & 1) * 512 + lane * 8, t = row & (SEQ - 1);
        const size_t off = (size_t)row * CW + c;
        const u32x4 z = {0u, 0u, 0u, 0u};
        const u32x4 u0 = *(const u32x4*)(UC + off), u1 = t >= 1 ? *(const u32x4*)(UC + off - CW) : z, u2 = t >= 2 ? *(const u32x4*)(UC + off - 2 * CW) : z, bg = *(const u32x4*)(BC + off);
        float y[8]; float ssq = 0.f;
#pragma unroll
        for (int q = 0; q < 4; ++q) {
            const unsigned a0 = u0[q], a1 = u1[q], a2 = u2[q], bb = bg[q]; const int cc = c + 2 * q;
            y[2 * q] = bflo(bb) * (cw[cc] * bflo(a2) + cw[CW + cc] * bflo(a1) + cw[2 * CW + cc] * bflo(a0));
            y[2 * q + 1] = bfhi(bb) * (cw[cc + 1] * bfhi(a2) + cw[CW + cc + 1] * bfhi(a1) + cw[2 * CW + cc + 1] * bfhi(a0));
            ssq += y[2 * q] * y[2 * q] + y[2 * q + 1] * y[2 * q + 1];
        }
        ssq += __shfl_xor(ssq, 1); ssq += __shfl_xor(ssq, 2); ssq += __shfl_xor(ssq, 4); ssq += __shfl_xor(ssq, 8);
        const float ri = rsqrtf(ssq * (1.0f / 128) + EPS);
        u32x4 w;
        w.x = cvt_pk_bf16(y[0] * ri * cn[c], y[1] * ri * cn[c + 1]); w.y = cvt_pk_bf16(y[2] * ri * cn[c + 2], y[3] * ri * cn[c + 3]);
        w.z = cvt_pk_bf16(y[4] * ri * cn[c + 4], y[5] * ri * cn[c + 5]); w.w = cvt_pk_bf16(y[6] * ri * cn[c + 6], y[7] * ri * cn[c + 7]);
        *(u32x4*)(MIX + (size_t)row * DM + HW + c) = w;
    }
}

__device__ __forceinline__ void hgrn_pass_c(const Args& a, LAS unsigned char* lds, int wave, int lane) {
    unsigned char* ws = a.ws;
    const float* LF = (const float*)(ws + WS_LF); const bf16_t* VH = (const bf16_t*)(ws + WS_VH); const bf16_t* QS = (const bf16_t*)(ws + WS_QS); const bf16_t* GH = (const bf16_t*)(ws + WS_GH);
    const bf16_t* SP = (const bf16_t*)(ws + WS_S); bf16_t* MIX = (bf16_t*)(ws + WS_MIX); const float* hn = a.in[10];
    const int tid = threadIdx.x, k = tid & 127, sg = tid >> 7, fr = lane & 15, fq = lane >> 4;
    LAS bf16_t* QT = (LAS bf16_t*)(lds + L_QT); LAS bf16_t* QH = (LAS bf16_t*)(lds + L_QH); LAS bf16_t* KA = (LAS bf16_t*)(lds + L_KA); LAS bf16_t* KB = (LAS bf16_t*)(lds + L_KB);
    LAS bf16_t* ST = (LAS bf16_t*)(lds + L_ST); LAS bf16_t* VT = (LAS bf16_t*)(lds + L_VT); LAS bf16_t* P = (LAS bf16_t*)(lds + L_P);
    LAS float* SEG = (LAS float*)(lds + L_SEG); LAS float* PART = (LAS float*)(lds + L_PART); LAS float* RINV = (LAS float*)(lds + L_RINV);
    for (int item = blockIdx.x; item < 1024; item += gridDim.x) {
        const int row0 = (item >> 3) * 64, cb = (item & 7) * 128;
        float lf[16], b[16]; bf16_t qh[16];
#pragma unroll
        for (int i = 0; i < 16; ++i) { lf[i] = LF[(size_t)(row0 + 16 * sg + i) * HW + cb + k]; qh[i] = QS[(size_t)(row0 + 16 * sg + i) * HW + cb + k]; }
        u32x4 vv[2], sv[4];
#pragma unroll
        for (int j = 0; j < 2; ++j) { const int idx = tid + 512 * j; vv[j] = *(const u32x4*)(VH + (size_t)(row0 + (idx >> 4)) * HW + cb + 8 * (idx & 15)); }
#pragma unroll
        for (int j = 0; j < 4; ++j) { const int idx = tid + 512 * j; sv[j] = *(const u32x4*)(SP + (size_t)item * 16384 + (idx >> 4) * 128 + 8 * (idx & 15)); }
        float run = 0.f;
#pragma unroll
        for (int i = 0; i < 16; ++i) { run += lf[i]; b[i] = run; }
        SEG[sg * 128 + k] = run;
        __syncthreads();
        const float s0 = SEG[k], s1 = SEG[128 + k], s2 = SEG[256 + k];
        const float pre = sg == 0 ? 0.f : (sg == 1 ? s0 : (sg == 2 ? s0 + s1 : s0 + s1 + s2));
        const float beta1 = s0 + s1, beta = sg >= 2 ? beta1 : 0.f;
#pragma unroll
        for (int i = 0; i < 16; ++i) {
            const int s = 16 * sg + i; const float bi = pre + b[i], kk = 1.0f - __expf(lf[i]), qv = bf2f(qh[i]);
            QT[s * HP + k] = f2bf(qv * __expf(bi - beta)); QH[s * HP + k] = f2bf(qv * __expf(bi));
            KA[s * HP + k] = f2bf(kk * __expf(fminf(beta - bi, 80.f)));
            if (sg < 2) KB[s * HP + k] = f2bf(kk * __expf(beta1 - bi));
        }
#pragma unroll
        for (int j = 0; j < 2; ++j) { const int idx = tid + 512 * j, s = idx >> 4, v0 = 8 * (idx & 15);
            VT[(v0 + 0) * VP + s] = (bf16_t)(vv[j].x & 0xffffu); VT[(v0 + 1) * VP + s] = (bf16_t)(vv[j].x >> 16);
            VT[(v0 + 2) * VP + s] = (bf16_t)(vv[j].y & 0xffffu); VT[(v0 + 3) * VP + s] = (bf16_t)(vv[j].y >> 16);
            VT[(v0 + 4) * VP + s] = (bf16_t)(vv[j].z & 0xffffu); VT[(v0 + 5) * VP + s] = (bf16_t)(vv[j].z >> 16);
            VT[(v0 + 6) * VP + s] = (bf16_t)(vv[j].w & 0xffffu); VT[(v0 + 7) * VP + s] = (bf16_t)(vv[j].w >> 16); }
#pragma unroll
        for (int j = 0; j < 4; ++j) { const int idx = tid + 512 * j; *(LAS u32x4*)(ST + (idx >> 4) * HP + 8 * (idx & 15)) = sv[j]; }
        __syncthreads();
#pragma unroll
        for (int pp = 0; pp < 2; ++pp) {
            const int p = wave + 8 * pp, tt = p >> 2, st = p & 3;
            f32x4 acc = {0.f, 0.f, 0.f, 0.f};
            if (st <= tt) {
                const LAS bf16_t* kb = (tt >= 2 && st < 2) ? KB : KA;
#pragma unroll
                for (int ks = 0; ks < 4; ++ks) { const bf16x8 af = *(const LAS bf16x8*)(QT + (16 * tt + fr) * HP + ks * 32 + fq * 8), bfr = *(const LAS bf16x8*)(kb + (16 * st + fr) * HP + ks * 32 + fq * 8);
                    acc = MFMA16(af, bfr, acc); }
            }
#pragma unroll
            for (int r = 0; r < 4; ++r) { const bool keep = (st < tt) || (st == tt && fr <= 4 * fq + r); P[(16 * tt + 4 * fq + r) * VP + 16 * st + fr] = f2bf(keep ? acc[r] : 0.f); }
        }
        __syncthreads();
        bf16x8 bs[4], bv[2];
#pragma unroll
        for (int ks = 0; ks < 4; ++ks) bs[ks] = *(const LAS bf16x8*)(ST + (16 * wave + fr) * HP + ks * 32 + fq * 8);
#pragma unroll
        for (int ks = 0; ks < 2; ++ks) bv[ks] = *(const LAS bf16x8*)(VT + (16 * wave + fr) * VP + ks * 32 + fq * 8);
        f32x4 o[4];
#pragma unroll
        for (int tt = 0; tt < 4; ++tt) {
            f32x4 acc = {0.f, 0.f, 0.f, 0.f};
#pragma unroll
            for (int ks = 0; ks < 4; ++ks) { const bf16x8 af = *(const LAS bf16x8*)(QH + (16 * tt + fr) * HP + ks * 32 + fq * 8); acc = MFMA16(af, bs[ks], acc); }
            { const bf16x8 af = *(const LAS bf16x8*)(P + (16 * tt + fr) * VP + fq * 8); acc = MFMA16(af, bv[0], acc); }
            if (tt >= 2) { const bf16x8 af = *(const LAS bf16x8*)(P + (16 * tt + fr) * VP + 32 + fq * 8); acc = MFMA16(af, bv[1], acc); }
            o[tt] = acc;
        }
#pragma unroll
        for (int tt = 0; tt < 4; ++tt)
#pragma unroll
            for (int r = 0; r < 4; ++r) { float x = o[tt][r] * o[tt][r]; x += __shfl_xor(x, 1); x += __shfl_xor(x, 2); x += __shfl_xor(x, 4); x += __shfl_xor(x, 8);
                if (fr == 0) PART[wave * 64 + 16 * tt + 4 * fq + r] = x; }
        __syncthreads();
        if (tid < 64) { float s = 0.f;
#pragma unroll
            for (int w = 0; w < 8; ++w) s += PART[w * 64 + tid];
            RINV[tid] = rsqrtf(s * (1.0f / 128) + EPS); }
        __syncthreads();
        const float hnv = hn[16 * wave + fr];
#pragma unroll
        for (int tt = 0; tt < 4; ++tt)
#pragma unroll
            for (int r = 0; r < 4; ++r) { const int t = 16 * tt + 4 * fq + r; const size_t row = (size_t)(row0 + t);
                const float g = bf2f(GH[row * HW + cb + 16 * wave + fr]);
                MIX[row * DM + cb + 16 * wave + fr] = f2bf(o[tt][r] * RINV[t] * hnv * g); }
        __syncthreads();
    }
}

__device__ __forceinline__ void phase_final(const Args& a, int wave, int lane) {
    const int gw = blockIdx.x * 8 + wave, NGW = gridDim.x * 8; const float* gF = a.in[20]; const bf16_t* H4 = (const bf16_t*)(a.ws + WS_MIX);
    for (int m = gw; m < M_TOK; m += NGW) {
        const u32x4* hr = (const u32x4*)(H4 + (size_t)m * DM) + lane; u32x4 w[4]; float s = 0.f;
#pragma unroll
        for (int j = 0; j < 4; ++j) { w[j] = hr[64 * j];
            s += (bflo(w[j].x) * bflo(w[j].x) + bfhi(w[j].x) * bfhi(w[j].x)) + (bflo(w[j].y) * bflo(w[j].y) + bfhi(w[j].y) * bfhi(w[j].y))
               + (bflo(w[j].z) * bflo(w[j].z) + bfhi(w[j].z) * bfhi(w[j].z)) + (bflo(w[j].w) * bflo(w[j].w) + bfhi(w[j].w) * bfhi(w[j].w)); }
        const float ri = rinv_of(wave_sum(s));
        f32x4* orow = (f32x4*)(a.out + (size_t)m * DM);
#pragma unroll
        for (int j = 0; j < 4; ++j) { const int c = (64 * j + lane) * 8; const f32x4 g0 = *(const f32x4*)(gF + c), g1 = *(const f32x4*)(gF + c + 4);
            f32x4 o0, o1; o0[0] = bflo(w[j].x) * ri * g0[0]; o0[1] = bfhi(w[j].x) * ri * g0[1]; o0[2] = bflo(w[j].y) * ri * g0[2]; o0[3] = bfhi(w[j].y) * ri * g0[3];
            o1[0] = bflo(w[j].z) * ri * g1[0]; o1[1] = bfhi(w[j].z) * ri * g1[1]; o1[2] = bflo(w[j].w) * ri * g1[2]; o1[3] = bfhi(w[j].w) * ri * g1[3];
            __builtin_nontemporal_store(o0, orow + c / 4); __builtin_nontemporal_store(o1, orow + c / 4 + 1); }
    }
}

#define XB_TMO      128
#define XB_XCNT(j)  (256  + 64 * (j))
#define XB_XSUB(j)  (1280 + 64 * (j))
#define XB_XGEN(j)  (2304 + 64 * (j))
#define XB_TOP      3328
#define XB_TOPGEN   3392
#define XCD_BAR_WORDS 3456
#define XB_SPIN_CAP (1u << 18)

__device__ __forceinline__ unsigned xb_ld(unsigned* p)              { return __hip_atomic_load(p, __ATOMIC_RELAXED, __HIP_MEMORY_SCOPE_AGENT); }
__device__ __forceinline__ unsigned xb_add(unsigned* p, unsigned v) { return __hip_atomic_fetch_add(p, v, __ATOMIC_RELAXED, __HIP_MEMORY_SCOPE_AGENT); }
__device__ __forceinline__ unsigned xb_xcc_id() { return (unsigned)__builtin_amdgcn_s_getreg((3 << 11) | 20) & 0xFu; }
#define XB_SPIN(cond, bar) do { unsigned _sp = 0; while (cond) { __builtin_amdgcn_s_sleep(1); \
    if ((++_sp & 255u) == 0u) { if (xb_ld(&(bar)[XB_TMO])) break; if (_sp > XB_SPIN_CAP) { atomicAdd(&(bar)[XB_TMO], 1u); break; } } } } while (0)

struct XcdBarrier {
    unsigned* bar; unsigned x;
    volatile LAS unsigned* st;
};

__device__ __forceinline__ XcdBarrier xcd_barrier_post(unsigned* bar, volatile LAS unsigned* st) {
    XcdBarrier b; b.bar = bar; b.x = xb_xcc_id(); b.st = st;
    if (threadIdx.x == 0) (void)xb_add(&bar[XB_XCNT(b.x)], 1u);
    return b;
}
__device__ __forceinline__ void xcd_barrier_complete(unsigned* bar, unsigned x, unsigned& nloc, unsigned& nx) {
    const unsigned G = gridDim.x * gridDim.y * gridDim.z;
    unsigned sum, cnt, mine, sp = 0u;
    for (;;) {
        sum = 0u; cnt = 0u; mine = 0u;
#pragma unroll
        for (unsigned j = 0; j < 16; ++j) { const unsigned c = xb_ld(&bar[XB_XCNT(j)]); sum += c; cnt += (c > 0u) ? 1u : 0u; mine = (j == x) ? c : mine; }
        if (sum == G) break;
        __builtin_amdgcn_s_sleep(1);
        if ((++sp & 255u) == 0u) { if (xb_ld(&bar[XB_TMO])) break; if (sp > XB_SPIN_CAP) { atomicAdd(&bar[XB_TMO], 1u); break; } }
    }
    nloc = mine > 0u ? mine : 1u; nx = cnt > 0u ? cnt : 1u;
}

__device__ __forceinline__ void xcd_barrier(const XcdBarrier& b) {
    asm volatile("s_waitcnt vmcnt(0)" ::: "memory");
    __syncthreads();
    if (threadIdx.x == 0) {
        unsigned* bar = b.bar;
        __builtin_amdgcn_s_waitcnt(0);
        unsigned nloc = b.st[0], nx = b.st[1];
        if (nloc == 0u) { xcd_barrier_complete(bar, b.x, nloc, nx); b.st[0] = nloc; b.st[1] = nx; }
        const unsigned old = xb_add(&bar[XB_XSUB(b.x)], 1u);
        const unsigned gen = old / nloc;
        if (old + 1u == (gen + 1u) * nloc) {
            __builtin_amdgcn_fence(__ATOMIC_RELEASE, "agent");
            asm volatile("s_waitcnt vmcnt(0)" ::: "memory");
            const unsigned og = xb_add(&bar[XB_TOP], 1u);
            const unsigned tg = og / nx;
            if (og + 1u == (tg + 1u) * nx) xb_add(&bar[XB_TOPGEN], 1u);
            else XB_SPIN(xb_ld(&bar[XB_TOPGEN]) == tg, bar);
            __builtin_amdgcn_fence(__ATOMIC_ACQUIRE, "agent");
            xb_add(&bar[XB_XGEN(b.x)], 1u);
            asm volatile("s_waitcnt vmcnt(0)" ::: "memory");
        } else {
            XB_SPIN(xb_ld(&bar[XB_XGEN(b.x)]) == gen, bar);
            __builtin_amdgcn_fence(__ATOMIC_ACQUIRE, "agent");
            asm volatile("s_waitcnt vmcnt(0)" ::: "memory");
        }
    }
    __syncthreads();
}


template <class Epi>
__device__ __forceinline__ void run_gemm(LAS unsigned char* lds, const bf16_t* A, const bf16_t* Bt, int N, int K, const Epi& E, int vc) {
    pg8::Gemm g; g.A = A; g.Bt = Bt; g.M = M_TOK; g.N = N; g.K = K;
    pg8::StaticOrder S; S.init(M_TOK, N, (int)gridDim.x, vc);
    pg8::gemm_phase<Epi, pg8::StaticOrder, true, true>(lds, g, S, E);
}
struct TailOrder {
    int c, n;
    __device__ __forceinline__ bool next(int i, Unit& u) const { if (c < 0) return false; const int L = i * n + c; if (L >= 256) return false; u.pm = L >> 3; u.pn = L & 7; return true; }
    __device__ __forceinline__ void a_ready(const Unit&) const {}
    __device__ __forceinline__ void done(const Unit&) const {}
};

__global__ void __launch_bounds__(512, 2) fwd_kernel(Args a) {
    extern __shared__ __attribute__((aligned(16))) unsigned char lds_raw[];
    LAS unsigned char* lds = (LAS unsigned char*)lds_raw;
    cg::grid_group grid = cg::this_grid();
    volatile LAS unsigned* xst = (volatile LAS unsigned*)(lds + LDS_BYTES - 16);
    if (threadIdx.x < 4) xst[threadIdx.x] = 0u;
    __syncthreads();
    XcdBarrier xbar = xcd_barrier_post((unsigned*)(a.ws + WS_BAR), xst);
    unsigned* cen = (unsigned*)(a.ws + WS_BAR) + 3584;
    if (threadIdx.x == 0) xst[2] = xb_add(&cen[64 * xbar.x], 1u);
    if (a.ph_lo == 0 && a.ph_hi == NPHASE) grid.sync();
    int vc = blockIdx.x;
    if (a.ph_lo == 0 && a.ph_hi == NPHASE && gridDim.x == 256) {
        bool even = true;
#pragma unroll
        for (int j = 0; j < 8; ++j) even = even && (xb_ld(&cen[64 * j]) == 32u);
        if (even) vc = (int)xst[2] * 8 + (int)xbar.x;
    }
    vc = __builtin_amdgcn_readfirstlane(vc);
    const int tid = threadIdx.x, lane = tid & 63, wave = __builtin_amdgcn_readfirstlane(tid >> 6);
    unsigned char* ws = a.ws;
    float* SS = (float*)(ws + WS_SS);
    bf16_t* XB = (bf16_t*)(ws + WS_XB); bf16_t* G = (bf16_t*)(ws + WS_G); bf16_t* MIX = (bf16_t*)(ws + WS_MIX);
#define PH(i) if (a.ph_lo <= (i) && (i) < a.ph_hi)
#define SYNC(i) if (a.ph_lo <= (i) && (i) + 1 < a.ph_hi) { xcd_barrier(xbar); }
    PH(0) { phase0(a, lds, wave, lane); } SYNC(0)
    PH(1) { EpiGateUp E; E.G = G; E.ss = SS; run_gemm(lds, XB, (const bf16_t*)(ws + WS_W1GU), 2 * FF, DM, E, vc); conv_tail(a, lds, wave, lane, 32 * 44, CV_T1, CV_END, vc); } SYNC(1)
    PH(2) { EpiResid E; E.XB = XB; E.ss_out = SS + 8192; E.scale = 0.5f; run_gemm(lds, G, (const bf16_t*)(ws + WS_W1D), DM, FF, E, vc); } SYNC(2)
    PH(3) { EpiMixIn E; E.ss = SS + 8192; E.lbl = a.in[9]; E.QS = (bf16_t*)(ws + WS_QS);
            E.UC = (bf16_t*)(ws + WS_UC); E.LF = (float*)(ws + WS_LF); run_gemm(lds, XB, (const bf16_t*)(ws + WS_WIN), MIXIN, DM, E, vc); conv_tail(a, lds, wave, lane, 32 * 28, CV_T0, CV_T1, vc); } SYNC(3)
    PH(4) { hgrn_pass_a(a, lds, wave, lane); } SYNC(4)
    PH(5) { hgrn_scan(a); conv_mixer(a, wave, lane); } SYNC(5)
    PH(6) { hgrn_pass_c(a, lds, wave, lane); } SYNC(6)
    PH(7) { EpiResid E; E.XB = XB; E.ss_out = SS + 16384; E.scale = 1.0f; run_gemm(lds, MIX, (const bf16_t*)(ws + WS_WOUT), DM, DM, E, vc); } SYNC(7)
    PH(8) { EpiGateUp E; E.G = G; E.ss = SS + 16384; run_gemm(lds, XB, (const bf16_t*)(ws + WS_W2GU), 2 * FF, DM, E, vc);
            { const int r = (32 * 44) % (int)gridDim.x; TailOrder T; T.n = (int)gridDim.x - r; T.c = vc - r;
              EpiStoreBf16 E2; E2.O = (bf16_t*)(ws + WS_PLE); int kp = PLE; asm volatile("" : "+s"(kp));
              pg8::Gemm g2; g2.A = (const bf16_t*)(ws + WS_PB); g2.Bt = (const bf16_t*)(ws + WS_WPE); g2.M = M_TOK; g2.N = DM; g2.K = kp;
              pg8::gemm_phase<EpiStoreBf16, TailOrder, true, true>(lds, g2, T, E2); }
            conv_tail(a, lds, wave, lane, 32 * 44, CV_TA, CV_T0, vc); } SYNC(8)
    PH(9) { EpiResid E; E.XB = XB; E.ss_out = SS + 24576; E.scale = 0.5f; run_gemm(lds, G, (const bf16_t*)(ws + WS_W2D), DM, FF, E, vc); } SYNC(9)
    PH(10) { EpiPleGate E; E.XB = XB; E.H4 = MIX; E.P = (const bf16_t*)(ws + WS_PLE); E.ss = SS + 24576; run_gemm(lds, XB, (const bf16_t*)(ws + WS_WPG), DM, DM, E, vc); } SYNC(10)
    PH(11) { phase_final(a, wave, lane); }
#undef PH
#undef SYNC
}

#ifndef MK_MULTI
#define MK_MULTI 0
#endif
extern "C" void kernel_launch(void* const* d_in, const int* in_sizes, int n_in, void* d_out, int out_size, void* d_ws, size_t ws_size, hipStream_t stream) {
    static int grid = 0;
    if (grid == 0) {
        if (n_in != 21 || out_size != M_TOK * DM || ws_size < WS_END) { fprintf(stderr, "kernel_launch: unexpected shapes (n_in %d out %d ws %zu need %zu)\n", n_in, out_size, ws_size, (size_t)WS_END); grid = -1; return; }
        int dev = 0, cus = 0, per_cu = 0;
        hipGetDevice(&dev); hipDeviceGetAttribute(&cus, hipDeviceAttributeMultiprocessorCount, dev);
        if (hipFuncSetAttribute((const void*)fwd_kernel, hipFuncAttributeMaxDynamicSharedMemorySize, LDS_BYTES) != hipSuccess) { fprintf(stderr, "kernel_launch: hipFuncSetAttribute failed\n"); grid = -1; return; }
        if (hipOccupancyMaxActiveBlocksPerMultiprocessor(&per_cu, (const void*)fwd_kernel, 512, LDS_BYTES) != hipSuccess || per_cu < 1) { fprintf(stderr, "kernel_launch: occupancy query failed (%d)\n", per_cu); grid = -1; return; }
        grid = cus * per_cu;
    }
    if (grid < 0) return;
    Args a{};
    for (int i = 0; i < 21; ++i) a.in[i] = (const float*)d_in[i];
    a.out = (float*)d_out; a.ws = (unsigned char*)d_ws;
#if MK_MULTI
    for (int p = 0; p < NPHASE; ++p) { a.ph_lo = p; a.ph_hi = p + 1; hipLaunchKernelGGL(fwd_kernel, dim3(grid), dim3(512), LDS_BYTES, stream, a); }
#else
    a.ph_lo = 0; a.ph_hi = NPHASE;
    if (hipMemsetAsync((char*)d_ws + WS_BAR, 0, 4096 * 4, stream) != hipSuccess) { fprintf(stderr, "kernel_launch: memset failed\n"); return; }
    void* args[] = {&a};
    hipError_t e = hipLaunchCooperativeKernel((void*)fwd_kernel, dim3(grid), dim3(512), args, LDS_BYTES, stream);
    if (e != hipSuccess) fprintf(stderr, "cooperative launch failed: %s (grid %d)\n", hipGetErrorString(e), grid);
#endif
}
```

```cpp
#include <hip/hip_runtime.h>
#include <hip/hip_cooperative_groups.h>
#include <cstdio>
#include <cstdint>
namespace pg8 {
#define PG8_LAS __attribute__((address_space(3)))
typedef unsigned short bf16_t;
typedef short bf16x8 __attribute__((ext_vector_type(8)));
typedef float f32x4 __attribute__((ext_vector_type(4)));
typedef unsigned u32x4 __attribute__((ext_vector_type(4)));
constexpr int BM = 256, BK = 64, HALF = 128, HTB = HALF * BK * 2  , STAGE_BYTES = 8 * HTB, NXCD = 8, WGM = 4;

__host__ __device__ __forceinline__ int lds_byte(int r, int c) { const int st = (r >> 4) * 2 + (c >> 5), rr = r & 15, cc = c & 31, ob = rr * 64 + cc * 2; return st * 1024 + (ob ^ (((ob >> 9) & 1) << 5)); }
__host__ __device__ __forceinline__ void stage_rc(int b, int& R, int& C) { const int st = b / 1024, sb = b % 1024, swz = sb ^ (((sb >> 9) & 1) << 5); R = (st >> 1) * 16 + swz / 64; C = (st & 1) * 32 + (swz % 64) / 2; }
__host__ __device__ __forceinline__ int perm32(int rho) { const int n = rho >> 4, i = rho & 15; return 8 * (i >> 2) + 4 * n + (i & 3); }

struct Unit { int pm, pn; };
struct Gemm { const bf16_t* A; const bf16_t* Bt; int M, N, K; };

struct StaticOrder {
    int nM, nN, nwg, G, c;
    __host__ __device__ void init(int M, int N, int G_, int c_) { nM = M / BM; nN = N / BM; nwg = nM * nN; G = G_; c = c_; }
    __host__ __device__ bool next(int i, Unit& u) const {
        const long L = (long)i * G + c; if (L >= nwg) return false;
        int wgid = (int)L; { const int q = nwg / NXCD, r = nwg % NXCD, xcd = wgid % NXCD, off = wgid / NXCD; wgid = (xcd < r ? xcd * (q + 1) : r * (q + 1) + (xcd - r) * q) + off; }
        const int nig = WGM * nN, gid = wgid / nig, fm = gid * WGM, gsz = (nM - fm) < WGM ? (nM - fm) : WGM;
        u.pm = fm + ((wgid % nig) % gsz); u.pn = (wgid % nig) / gsz; return true;
    }
    __device__ __forceinline__ void a_ready(const Unit&) const {}
    __device__ __forceinline__ void done(const Unit&) const {}
};
typedef float f32x2 __attribute__((ext_vector_type(2)));
template <class Epi, class Sched, bool ALIGN_EPI = false, bool SP2 = false>
__device__ __forceinline__ void gemm_phase(PG8_LAS unsigned char* lds, const Gemm g, const Sched& S, const Epi& E) {
    const int tid = threadIdx.x, wid = __builtin_amdgcn_readfirstlane(tid >> 6), lane = tid & 63, wr = wid >> 2, wc = wid & 3, fr = lane & 15, fq = lane >> 4;
    const int K = g.K, nt = K / BK;
    unsigned voffA[2], voffB[2];
#pragma unroll
    for (int i = 0; i < 2; ++i) { int R, C; stage_rc(tid * 16 + i * 8192, R, C); const int Rb = Epi::PERM ? ((R & ~31) + perm32(R & 31)) : R;
        voffA[i] = (unsigned)(R * K + C) * 2u; voffB[i] = (unsigned)(Rb * K + C) * 2u; }
    const size_t kstep = (size_t)(BK * 2);
    const size_t hstep = (size_t)HALF * K * 2;
    const size_t tstep = 2 * hstep;
    const unsigned ldsw = (unsigned)wid * 1024u;
    const int aoff = lds_byte(wr * 64 + fr, fq * 8), boff = lds_byte(wc * 32 + fr, fq * 8);
#define PG8_SA(b, h) (((b) * 2 + (h)) * HTB)
#define PG8_SB(b, h) ((4 + (b) * 2 + (h)) * HTB)
#define PG8_STAGE(bufoff, gbase, voff) do { _Pragma("unroll") for (int _i = 0; _i < 2; ++_i) \
        __builtin_amdgcn_global_load_lds((const unsigned*)((const char*)(gbase) + (voff)[_i]), (PG8_LAS unsigned*)(lds + (bufoff) + ldsw + _i * 8192), 16, 0, 0); } while (0)
#define PG8_LDA(dst, b, h) do { _Pragma("unroll") for (int m = 0; m < 4; ++m) _Pragma("unroll") for (int k = 0; k < 2; ++k) dst[m][k] = *(const PG8_LAS bf16x8*)(lds + PG8_SA(b, h) + aoff + m * 2048 + k * 1024); } while (0)
#define PG8_LDB(dst, b, h) do { _Pragma("unroll") for (int n = 0; n < 2; ++n) _Pragma("unroll") for (int k = 0; k < 2; ++k) dst[n][k] = *(const PG8_LAS bf16x8*)(lds + PG8_SB(b, h) + boff + n * 2048 + k * 1024); } while (0)
#define PG8_MMA(ai, bj, At, Bt) do { __builtin_amdgcn_s_setprio(1); _Pragma("unroll") for (int m = 0; m < 4; ++m) _Pragma("unroll") for (int n = 0; n < 2; ++n) _Pragma("unroll") for (int k = 0; k < 2; ++k) \
        acc[ai][bj][m][n] = __builtin_amdgcn_mfma_f32_16x16x32_bf16(Bt[n][k], At[m][k], acc[ai][bj][m][n], 0, 0, 0); __builtin_amdgcn_s_setprio(0); } while (0)
#define PG8_WAIT_V(n) asm volatile("s_waitcnt vmcnt(" #n ")" ::: "memory")
#define PG8_WAIT_L(n) asm volatile("s_waitcnt lgkmcnt(" #n ")" ::: "memory")
#define PG8_BAR __builtin_amdgcn_s_barrier()
#define PG8_SCHED __builtin_amdgcn_sched_barrier(0)
    Unit cur, nxt; int ui = 0;
    if (!S.next(0, cur)) return;
    f32x4 acc[2][2][4][2];
#pragma unroll
    for (int a = 0; a < 2; ++a)
#pragma unroll
        for (int b = 0; b < 2; ++b)
#pragma unroll
            for (int m = 0; m < 4; ++m)
#pragma unroll
                for (int n = 0; n < 2; ++n) acc[a][b][m][n] = (f32x4){0.f, 0.f, 0.f, 0.f};
    bf16x8 At[4][2], B0[2][2], B1[2][2];
    const char* cA = (const char*)g.A + (size_t)cur.pm * tstep; const char* cB = (const char*)g.Bt + (size_t)cur.pn * tstep;
    S.a_ready(cur);
    if constexpr (SP2) {
        PG8_STAGE(PG8_SB(0, 0), cB, voffB); PG8_STAGE(PG8_SB(0, 1), cB + hstep, voffB); PG8_STAGE(PG8_SA(0, 0), cA, voffA); PG8_STAGE(PG8_SA(0, 1), cA + hstep, voffA);
        if (wr == 1) PG8_BAR;
        PG8_WAIT_V(2); PG8_BAR;
        PG8_STAGE(PG8_SB(1, 0), cB + kstep, voffB); PG8_STAGE(PG8_SA(1, 0), cA + kstep, voffA); PG8_STAGE(PG8_SB(1, 1), cB + hstep + kstep, voffB);
        PG8_WAIT_V(6); PG8_BAR;
    } else {
        PG8_STAGE(PG8_SB(0, 0), cB, voffB); PG8_STAGE(PG8_SA(0, 0), cA, voffA); PG8_STAGE(PG8_SB(0, 1), cB + hstep, voffB); PG8_STAGE(PG8_SA(0, 1), cA + hstep, voffA);
        if (wr == 1) PG8_BAR;
        PG8_WAIT_V(4); PG8_BAR;
        PG8_STAGE(PG8_SB(1, 0), cB + kstep, voffB); PG8_STAGE(PG8_SA(1, 0), cA + kstep, voffA); PG8_STAGE(PG8_SB(1, 1), cB + hstep + kstep, voffB);
        PG8_WAIT_V(6); PG8_BAR;
    }
    for (;;) {
        const bool has_next = S.next(ui + 1, nxt);
        const char* nA = has_next ? (const char*)g.A + (size_t)nxt.pm * tstep : cA; const char* nB = has_next ? (const char*)g.Bt + (size_t)nxt.pn * tstep : cB;
        for (int t = 0; t < nt; t += 2) {
            const bool last = (t == nt - 2);
            const char* a1 = cA + (size_t)(t + 1) * kstep;
            const char* a2 = last ? nA : cA + (size_t)(t + 2) * kstep; const char* b2 = last ? nB : cB + (size_t)(t + 2) * kstep;
            const char* a3 = a2 + kstep; const char* b3 = b2 + kstep;
            if (last && has_next) S.a_ready(nxt);
            if constexpr (SP2) {
            PG8_LDB(B0, 0, 0); PG8_LDB(B1, 0, 1); PG8_SCHED; PG8_LDA(At, 0, 0); PG8_STAGE(PG8_SA(1, 1), a1 + hstep, voffA);
            PG8_WAIT_V(8); PG8_WAIT_L(0); PG8_BAR; PG8_MMA(0, 0, At, B0); PG8_MMA(0, 1, At, B1); PG8_BAR; PG8_SCHED;
            PG8_LDA(At, 0, 1); PG8_STAGE(PG8_SB(0, 0), b2, voffB); PG8_STAGE(PG8_SB(0, 1), b2 + hstep, voffB); PG8_STAGE(PG8_SA(0, 0), a2, voffA);
            PG8_WAIT_V(8); PG8_WAIT_L(0); PG8_BAR; PG8_MMA(1, 0, At, B0); PG8_MMA(1, 1, At, B1); PG8_BAR; PG8_SCHED;
            PG8_LDB(B0, 1, 0); PG8_LDB(B1, 1, 1); PG8_SCHED; PG8_LDA(At, 1, 0); PG8_STAGE(PG8_SA(0, 1), a2 + hstep, voffA);
            PG8_WAIT_V(8); PG8_WAIT_L(0); PG8_BAR; PG8_MMA(0, 0, At, B0); PG8_MMA(0, 1, At, B1); PG8_BAR; PG8_SCHED;
            PG8_LDA(At, 1, 1); PG8_STAGE(PG8_SB(1, 0), b3, voffB); PG8_STAGE(PG8_SB(1, 1), b3 + hstep, voffB); PG8_STAGE(PG8_SA(1, 0), a3, voffA);
            PG8_WAIT_V(8); PG8_WAIT_L(0); PG8_BAR; PG8_MMA(1, 0, At, B0); PG8_MMA(1, 1, At, B1); PG8_BAR; PG8_SCHED;
            } else {
            PG8_LDB(B0, 0, 0); PG8_SCHED; PG8_LDA(At, 0, 0); PG8_STAGE(PG8_SA(1, 1), a1 + hstep, voffA);
            PG8_WAIT_L(8); PG8_BAR; PG8_WAIT_L(0); PG8_MMA(0, 0, At, B0); PG8_BAR; PG8_SCHED;
            PG8_LDB(B1, 0, 1); PG8_STAGE(PG8_SB(0, 0), b2, voffB);
            PG8_BAR; PG8_WAIT_L(0); PG8_MMA(0, 1, At, B1); PG8_BAR;
            PG8_LDA(At, 0, 1); PG8_STAGE(PG8_SA(0, 0), a2, voffA);
            PG8_BAR; PG8_WAIT_L(0); PG8_MMA(1, 0, At, B0); PG8_BAR; PG8_SCHED;
            PG8_STAGE(PG8_SB(0, 1), b2 + hstep, voffB);
            PG8_WAIT_V(6); PG8_BAR; PG8_MMA(1, 1, At, B1); PG8_BAR;
            PG8_LDB(B0, 1, 0); PG8_SCHED; PG8_LDA(At, 1, 0); PG8_STAGE(PG8_SA(0, 1), a2 + hstep, voffA);
            PG8_WAIT_L(8); PG8_BAR; PG8_WAIT_L(0); PG8_MMA(0, 0, At, B0); PG8_BAR; PG8_SCHED;
            PG8_LDB(B1, 1, 1); PG8_STAGE(PG8_SB(1, 0), b3, voffB);
            PG8_BAR; PG8_WAIT_L(0); PG8_MMA(0, 1, At, B1); PG8_BAR;
            PG8_LDA(At, 1, 1); PG8_STAGE(PG8_SA(1, 0), a3, voffA);
            PG8_BAR; PG8_WAIT_L(0); PG8_MMA(1, 0, At, B0); PG8_BAR; PG8_SCHED;
            PG8_STAGE(PG8_SB(1, 1), b3 + hstep, voffB);
            PG8_WAIT_V(6); PG8_BAR; PG8_MMA(1, 1, At, B1); PG8_BAR;
            }
        }
        if constexpr (ALIGN_EPI) { if (wr == 0) PG8_BAR; }
        if constexpr (!Epi::AFTER_DRAIN) { E(acc, cur, wr, wc, fr, fq); S.done(cur); }
        if (!has_next) break;
#pragma unroll
        for (int a = 0; a < 2; ++a)
#pragma unroll
            for (int b = 0; b < 2; ++b)
#pragma unroll
                for (int m = 0; m < 4; ++m)
#pragma unroll
                    for (int n = 0; n < 2; ++n) acc[a][b][m][n] = (f32x4){0.f, 0.f, 0.f, 0.f};
        cur = nxt; cA = nA; cB = nB; ++ui;
        if constexpr (ALIGN_EPI) { if (wr == 1) PG8_BAR; }
    }
    PG8_WAIT_V(0);
    if constexpr (!ALIGN_EPI) { if (wr == 0) PG8_BAR; }
    PG8_BAR;
    if constexpr (Epi::AFTER_DRAIN) { E.fused(acc, cur, wr, wc, fr, fq, lds, wid, lane); S.done(cur); }
#undef PG8_SA
#undef PG8_SB
#undef PG8_STAGE
#undef PG8_LDA
#undef PG8_LDB
#undef PG8_MMA
#undef PG8_WAIT_V
#undef PG8_WAIT_L
#undef PG8_BAR
#undef PG8_SCHED
}
}

namespace cg = cooperative_groups;
using pg8::bf16_t; using pg8::bf16x8; using pg8::f32x4; using pg8::u32x4; using pg8::Unit;
typedef float f32x2c __attribute__((ext_vector_type(2)));
typedef __bf16 bf16x2c __attribute__((ext_vector_type(2)));
__device__ __forceinline__ unsigned cvt_pk_bf16(float lo, float hi) { const f32x2c v = {lo, hi}; return __builtin_bit_cast(unsigned, __builtin_convertvector(v, bf16x2c)); }
#define LAS __attribute__((address_space(3)))
typedef unsigned u32x2 __attribute__((ext_vector_type(2)));
typedef float f32x2v __attribute__((ext_vector_type(2)));

constexpr int M_TOK = 8192, DM = 2048, FF = 5632, HW = 1024, CW = 1024, MIXIN = 7168, PLE = 256, SEQ = 2048;
constexpr float EPS = 1e-6f;
constexpr size_t MiB = 1ull << 20;
constexpr size_t WS_W1GU = 0, WS_W1D = 44 * MiB, WS_WIN = 66 * MiB, WS_WOUT = 94 * MiB, WS_W2GU = 102 * MiB, WS_W2D = 146 * MiB,
                 WS_WPG = 168 * MiB, WS_WPE = 176 * MiB, WS_PB = 177 * MiB, WS_XB = 181 * MiB, WS_MIX = 213 * MiB, WS_G = 245 * MiB,
                 WS_QS = 245 * MiB, WS_VH = 261 * MiB, WS_GH = 277 * MiB, WS_BC = 293 * MiB, WS_UC = 309 * MiB, WS_LF = 325 * MiB,
                 WS_S = 357 * MiB, WS_PLE = 0, WS_SS = 389 * MiB, WS_DD = 389 * MiB + 512 * 1024, WS_BAR = 390 * MiB + 512 * 1024, WS_END = 391 * MiB, WS_U = 0;
constexpr int LDS_BYTES = 144 * 1024;
constexpr int NPHASE = 12;

__device__ __forceinline__ float bf2f(bf16_t b) { return __uint_as_float(((unsigned)b) << 16); }
__device__ __forceinline__ float bflo(unsigned w) { return __uint_as_float(w << 16); }
__device__ __forceinline__ float bfhi(unsigned w) { return __uint_as_float(w & 0xffff0000u); }
__device__ __forceinline__ float wave_sum(float v) {
#pragma unroll
    for (int o = 1; o < 64; o <<= 1) v += __shfl_xor(v, o);
    return v;
}
__device__ __forceinline__ float fsigmoid(float x) { return __builtin_amdgcn_rcpf(1.0f + __expf(-x)); }
__device__ __forceinline__ float fsilu(float x) { return x * fsigmoid(x); }
__device__ __forceinline__ float rinv_of(float ss) { return rsqrtf(ss * (1.0f / DM) + EPS); }

struct EpiGateUp {
    static constexpr bool PERM = true, AFTER_DRAIN = false;
    bf16_t* G; const float* ss;
    __device__ __forceinline__ void operator()(const f32x4 (&acc)[2][2][4][2], const Unit& u, int wr, int wc, int fr, int fq) const {
        const int row0 = u.pm * 256 + wr * 64 + fr, col0 = u.pn * 128 + wc * 32 + 8 * fq;
#pragma unroll
        for (int ai = 0; ai < 2; ++ai)
#pragma unroll
            for (int m = 0; m < 4; ++m) {
                const int r = row0 + ai * 128 + m * 16; const float ri = rinv_of(ss[r]);
                float v[8];
#pragma unroll
                for (int n = 0; n < 2; ++n)
#pragma unroll
                    for (int j = 0; j < 4; ++j) v[n * 4 + j] = fsilu(acc[ai][0][m][n][j] * ri) * (acc[ai][1][m][n][j] * ri);
                u32x4 w; w.x = cvt_pk_bf16(v[0], v[1]); w.y = cvt_pk_bf16(v[2], v[3]); w.z = cvt_pk_bf16(v[4], v[5]); w.w = cvt_pk_bf16(v[6], v[7]);
                *(u32x4*)(G + (size_t)r * FF + col0) = w;
            }
    }
};
struct EpiResid {
    static constexpr bool PERM = true, AFTER_DRAIN = false;
    bf16_t* XB; float* ss_out; float scale;
    __device__ __forceinline__ void operator()(f32x4 (&acc)[2][2][4][2], const Unit& u, int wr, int wc, int fr, int fq) const {
        const int row0 = u.pm * 256 + wr * 64 + fr, col0 = u.pn * 256 + wc * 32 + 8 * fq;
#pragma unroll
        for (int ai = 0; ai < 2; ++ai) {
#pragma unroll
            for (int m = 0; m < 4; ++m)
#pragma unroll
                for (int bj = 0; bj < 2; ++bj) {
                    const size_t off = (size_t)(row0 + ai * 128 + m * 16) * DM + col0 + bj * 128;
                    const u32x4 xw = *(const u32x4*)(XB + off);
                    f32x4 r0, r1; r0[0] = bflo(xw.x); r0[1] = bfhi(xw.x); r0[2] = bflo(xw.y); r0[3] = bfhi(xw.y); r1[0] = bflo(xw.z); r1[1] = bfhi(xw.z); r1[2] = bflo(xw.w); r1[3] = bfhi(xw.w);
                    acc[ai][bj][m][0] = r0 + acc[ai][bj][m][0] * scale; acc[ai][bj][m][1] = r1 + acc[ai][bj][m][1] * scale;
                }
            asm volatile("" ::: "memory");
#pragma unroll
            for (int m = 0; m < 4; ++m) {
                const int r = row0 + ai * 128 + m * 16; float sq = 0.f;
#pragma unroll
                for (int bj = 0; bj < 2; ++bj) {
                    const size_t off = (size_t)r * DM + col0 + bj * 128;
                    const f32x4 v0 = acc[ai][bj][m][0], v1 = acc[ai][bj][m][1];
                    u32x4 w; w.x = cvt_pk_bf16(v0[0], v0[1]); w.y = cvt_pk_bf16(v0[2], v0[3]); w.z = cvt_pk_bf16(v1[0], v1[1]); w.w = cvt_pk_bf16(v1[2], v1[3]);
                    *(u32x4*)(XB + off) = w;
                    sq += (v0[0] * v0[0] + v0[1] * v0[1]) + (v0[2] * v0[2] + v0[3] * v0[3]) + (v1[0] * v1[0] + v1[1] * v1[1]) + (v1[2] * v1[2] + v1[3] * v1[3]);
                }
                sq += __shfl_xor(sq, 16); sq += __shfl_xor(sq, 32);
                if (fq == 0) atomicAdd(ss_out + r, sq);
            }
            asm volatile("" ::: "memory");
        }
    }
};
struct EpiMixIn {
    static constexpr bool PERM = true, AFTER_DRAIN = false;
    const float* ss; const float* lbl;
    bf16_t *QS, *UC; float* LF;
    __device__ __forceinline__ void operator()(const f32x4 (&acc)[2][2][4][2], const Unit& u, int wr, int wc, int fr, int fq) const {
        const int row0 = u.pm * 256 + wr * 64 + fr; const int sec = u.pn >> 2;
        if (u.pn >= 20) {
            const int col0 = (u.pn - 20) * 128 + wc * 32 + 8 * fq;
#pragma unroll
            for (int ai = 0; ai < 2; ++ai)
#pragma unroll
                for (int m = 0; m < 4; ++m) {
                    const int r = row0 + ai * 128 + m * 16; const float ri = rinv_of(ss[r]); const float ri2 = ri * ri;
                    float v[8];
#pragma unroll
                    for (int n = 0; n < 2; ++n)
#pragma unroll
                        for (int j = 0; j < 4; ++j) v[n * 4 + j] = acc[ai][0][m][n][j] * acc[ai][1][m][n][j] * ri2;
                    u32x4 w; w.x = cvt_pk_bf16(v[0], v[1]); w.y = cvt_pk_bf16(v[2], v[3]); w.z = cvt_pk_bf16(v[4], v[5]); w.w = cvt_pk_bf16(v[6], v[7]);
                    *(u32x4*)(UC + (size_t)r * CW + col0) = w;
                }
            return;
        }
        const int col0 = (u.pn & 3) * 256 + wc * 32 + 8 * fq;
        if (sec == 1) {
#pragma unroll
            for (int bj = 0; bj < 2; ++bj)
#pragma unroll
                for (int n = 0; n < 2; ++n) {
                    const int c = col0 + bj * 128 + 4 * n; const f32x4 l0 = *(const f32x4*)(lbl + c), l1 = *(const f32x4*)(lbl + 1024 + c);
                    f32x4 lb; lb[0] = fsigmoid(l0[0] - l1[0]); lb[1] = fsigmoid(l0[1] - l1[1]); lb[2] = fsigmoid(l0[2] - l1[2]); lb[3] = fsigmoid(l0[3] - l1[3]);
#pragma unroll
                    for (int ai = 0; ai < 2; ++ai)
#pragma unroll
                        for (int m = 0; m < 4; ++m) {
                            const int r = row0 + ai * 128 + m * 16; const float ri = rinv_of(ss[r]);
                            const f32x4 x = acc[ai][bj][m][n]; f32x4 o;
                            o[0] = __logf(lb[0] + (1.0f - lb[0]) * fsigmoid(x[0] * ri)); o[1] = __logf(lb[1] + (1.0f - lb[1]) * fsigmoid(x[1] * ri));
                            o[2] = __logf(lb[2] + (1.0f - lb[2]) * fsigmoid(x[2] * ri)); o[3] = __logf(lb[3] + (1.0f - lb[3]) * fsigmoid(x[3] * ri));
                            *(f32x4*)(LF + (size_t)r * HW + c) = o;
                        }
                }
            return;
        }
        bf16_t* dst = QS + (size_t)(sec == 0 ? 0 : sec - 1) * ((size_t)M_TOK * HW);
        const bool act = (sec == 0 || sec == 3);
#pragma unroll
        for (int ai = 0; ai < 2; ++ai)
#pragma unroll
            for (int m = 0; m < 4; ++m) {
                const int r = row0 + ai * 128 + m * 16; const float ri = rinv_of(ss[r]);
#pragma unroll
                for (int bj = 0; bj < 2; ++bj) {
                    float v[8];
#pragma unroll
                    for (int n = 0; n < 2; ++n)
#pragma unroll
                        for (int j = 0; j < 4; ++j) { const float x = acc[ai][bj][m][n][j] * ri; v[n * 4 + j] = act ? fsilu(x) : x; }
                    u32x4 w; w.x = cvt_pk_bf16(v[0], v[1]); w.y = cvt_pk_bf16(v[2], v[3]); w.z = cvt_pk_bf16(v[4], v[5]); w.w = cvt_pk_bf16(v[6], v[7]);
                    *(u32x4*)(dst + (size_t)r * HW + col0 + bj * 128) = w;
                }
            }
    }
};
struct EpiStoreBf16 {
    static constexpr bool PERM = true, AFTER_DRAIN = false;
    bf16_t* O;
    __device__ __forceinline__ void operator()(const f32x4 (&acc)[2][2][4][2], const Unit& u, int wr, int wc, int fr, int fq) const {
        const int row0 = u.pm * 256 + wr * 64 + fr, col0 = u.pn * 256 + wc * 32 + 8 * fq;
#pragma unroll
        for (int ai = 0; ai < 2; ++ai)
#pragma unroll
            for (int m = 0; m < 4; ++m) {
                const int r = row0 + ai * 128 + m * 16;
#pragma unroll
                for (int bj = 0; bj < 2; ++bj) {
                    const f32x4 v0 = acc[ai][bj][m][0], v1 = acc[ai][bj][m][1];
                    u32x4 w; w.x = cvt_pk_bf16(v0[0], v0[1]); w.y = cvt_pk_bf16(v0[2], v0[3]); w.z = cvt_pk_bf16(v1[0], v1[1]); w.w = cvt_pk_bf16(v1[2], v1[3]);
                    *(u32x4*)(O + (size_t)r * DM + col0 + bj * 128) = w;
                }
            }
    }
};
struct EpiPleGate {
    static constexpr bool PERM = true, AFTER_DRAIN = false;
    const bf16_t* XB; const bf16_t* P; bf16_t* H4; const float* ss;
    __device__ __forceinline__ void operator()(f32x4 (&acc)[2][2][4][2], const Unit& u, int wr, int wc, int fr, int fq) const {
        const int row0 = u.pm * 256 + wr * 64 + fr, col0 = u.pn * 256 + wc * 32 + 8 * fq;
#pragma unroll
        for (int ai = 0; ai < 2; ++ai)
#pragma unroll
            for (int m = 0; m < 4; ++m) {
                const int r = row0 + ai * 128 + m * 16; const float ri = rinv_of(ss[r]);
#pragma unroll
                for (int bj = 0; bj < 2; ++bj) {
                    const size_t off = (size_t)r * DM + col0 + bj * 128;
                    const u32x4 pw = *(const u32x4*)(P + off), xw = *(const u32x4*)(XB + off);
                    const f32x4 a0 = acc[ai][bj][m][0], a1 = acc[ai][bj][m][1];
                    u32x4 w;
                    w.x = cvt_pk_bf16(bflo(xw.x) + fsigmoid(a0[0] * ri) * bflo(pw.x), bfhi(xw.x) + fsigmoid(a0[1] * ri) * bfhi(pw.x));
                    w.y = cvt_pk_bf16(bflo(xw.y) + fsigmoid(a0[2] * ri) * bflo(pw.y), bfhi(xw.y) + fsigmoid(a0[3] * ri) * bfhi(pw.y));
                    w.z = cvt_pk_bf16(bflo(xw.z) + fsigmoid(a1[0] * ri) * bflo(pw.z), bfhi(xw.z) + fsigmoid(a1[1] * ri) * bfhi(pw.z));
                    w.w = cvt_pk_bf16(bflo(xw.w) + fsigmoid(a1[2] * ri) * bflo(pw.w), bfhi(xw.w) + fsigmoid(a1[3] * ri) * bfhi(pw.w));
                    *(u32x4*)(H4 + off) = w;
                }
            }
    }
};

template <int MODE>
__device__ __forceinline__ void p0_item(const float* W, const float* W2, const float* gain, int K, int N, bf16_t* WT, LAS float* scr, int item, int lane) {
    const int nblk_k = K / 64; const int nb = item / nblk_k, kb = item % nblk_k; const int k0 = 64 * kb, n0 = 32 * nb;
    const float* src = W; int c0 = n0;
    if (MODE == 1) { const int t = n0 >> 8, bj = (n0 >> 7) & 1, c = n0 & 127; src = bj ? W2 : W; c0 = 128 * t + c; }
    if (MODE == 2) { if (n0 >= 5120) { const int tt = n0 - 5120; const int t = tt >> 8, bj = (tt >> 7) & 1, c = tt & 127; c0 = 5120 + 1024 * bj + 128 * t + c; } }
    float v[32], gg[32];
    const float* sp = src + (size_t)(k0 + (lane >> 5)) * N + c0 + (lane & 31);
#pragma unroll
    for (int i = 0; i < 32; ++i) v[i] = __builtin_nontemporal_load(sp + (size_t)(2 * i) * N);
    if (gain) {
#pragma unroll
        for (int i = 0; i < 32; ++i) gg[i] = gain[k0 + 2 * i + (lane >> 5)];
#pragma unroll
        for (int i = 0; i < 32; ++i) v[i] *= gg[i];
    }
#pragma unroll
    for (int i = 0; i < 32; ++i) scr[(2 * i + (lane >> 5)) * 33 + (lane & 31)] = v[i];
    asm volatile("s_waitcnt lgkmcnt(0)" ::: "memory");
    const int c = lane & 7;
#pragma unroll
    for (int j = 0; j < 4; ++j) { const int n = (lane >> 3) + 8 * j; const LAS float* s = scr + (8 * c) * 33 + n;
        u32x4 o; o.x = cvt_pk_bf16(s[0 * 33], s[1 * 33]); o.y = cvt_pk_bf16(s[2 * 33], s[3 * 33]); o.z = cvt_pk_bf16(s[4 * 33], s[5 * 33]); o.w = cvt_pk_bf16(s[6 * 33], s[7 * 33]);
        *(u32x4*)(WT + (size_t)(n0 + n) * K + k0 + 8 * c) = o; }
    asm volatile("s_waitcnt lgkmcnt(0)" ::: "memory");
}

struct Args { const float* in[21]; float* out; unsigned char* ws; int ph_lo, ph_hi; };

constexpr int CV_I0 = 32 * 352, CV_I1 = 88 * 64, CV_I2 = 32 * 224, CV_I3 = 32 * 64, CV_I7 = 4 * 64;
constexpr int CV_END = 2 * CV_I0 + 2 * CV_I1 + CV_I2 + 2 * CV_I3 + CV_I7, CV_T1 = CV_END - 10000, CV_T0 = CV_T1 - 10000, CV_TA = CV_I0 + CV_I2 + CV_I3 + CV_I7;
__device__ __forceinline__ void conv_range(const Args& a, LAS unsigned char* lds, int wave, int lane, int lo, int hi, int w0, int nw) {
    unsigned char* ws = a.ws;
    LAS float* scr = (LAS float*)(lds + wave * 16384);
    for (int it = lo + w0; it < hi; it += nw) {
        int r = it;
        if (r < CV_I0) { p0_item<1>(a.in[3], a.in[4], a.in[2], DM, FF, (bf16_t*)(ws + WS_W1GU), scr, r, lane); continue; } r -= CV_I0;
        if (r < CV_I2) { p0_item<2>(a.in[7], nullptr, a.in[6], DM, MIXIN, (bf16_t*)(ws + WS_WIN), scr, r, lane); continue; } r -= CV_I2;
        if (r < CV_I3) { p0_item<0>(a.in[12], nullptr, nullptr, DM, DM, (bf16_t*)(ws + WS_WOUT), scr, r, lane); continue; } r -= CV_I3;
        if (r < CV_I7) { p0_item<0>(a.in[18], nullptr, nullptr, PLE, DM, (bf16_t*)(ws + WS_WPE), scr, r, lane); continue; } r -= CV_I7;
        if (r < CV_I3) { p0_item<0>(a.in[19], nullptr, a.in[17], DM, DM, (bf16_t*)(ws + WS_WPG), scr, r, lane); continue; } r -= CV_I3;
        if (r < CV_I1) { p0_item<0>(a.in[16], nullptr, nullptr, FF, DM, (bf16_t*)(ws + WS_W2D), scr, r, lane); continue; } r -= CV_I1;
        if (r < CV_I0) { p0_item<1>(a.in[14], a.in[15], a.in[13], DM, FF, (bf16_t*)(ws + WS_W2GU), scr, r, lane); continue; } r -= CV_I0;
        p0_item<0>(a.in[5], nullptr, nullptr, FF, DM, (bf16_t*)(ws + WS_W1D), scr, r, lane);
    }
}
__device__ __forceinline__ void conv_tail(const Args& a, LAS unsigned char* lds, int wave, int lane, int nunits, int lo, int hi, int vc) {
    const int r = nunits % (int)gridDim.x;
    if (r == 0) { conv_range(a, lds, wave, lane, lo, hi, vc * 8 + wave, gridDim.x * 8); return; }
    if (vc >= r) conv_range(a, lds, wave, lane, lo, hi, (vc - r) * 8 + wave, ((int)gridDim.x - r) * 8);
}

__device__ __forceinline__ void phase0(const Args& a, LAS unsigned char* lds, int wave, int lane) {
    unsigned char* ws = a.ws;
    const int gw = blockIdx.x * 8 + wave, NGW = gridDim.x * 8;
    conv_range(a, lds, wave, lane, 0, CV_TA, gw, NGW);
    float* SS = (float*)(ws + WS_SS);
    for (int m = gw; m < M_TOK; m += NGW) {
        const f32x4* xr = (const f32x4*)(a.in[0] + (size_t)m * DM) + lane; u32x2* xb = (u32x2*)((bf16_t*)(ws + WS_XB) + (size_t)m * DM) + lane;
        float s = 0.f;
#pragma unroll
        for (int j = 0; j < 8; ++j) { const f32x4 v = __builtin_nontemporal_load(xr + 64 * j); s += (v[0] * v[0] + v[1] * v[1]) + (v[2] * v[2] + v[3] * v[3]);
            u32x2 w; w.x = cvt_pk_bf16(v[0], v[1]); w.y = cvt_pk_bf16(v[2], v[3]); xb[64 * j] = w; }
        s = wave_sum(s);
        if (lane == 0) { SS[m] = s; SS[8192 + m] = 0.f; SS[16384 + m] = 0.f; SS[24576 + m] = 0.f; }
    }
    { const int gt = blockIdx.x * 512 + threadIdx.x, NT = gridDim.x * 512;
      for (int i = gt; i < M_TOK * PLE / 4; i += NT) { const f32x4 v = __builtin_nontemporal_load((const f32x4*)a.in[1] + i); u32x2 w; w.x = cvt_pk_bf16(v[0], v[1]); w.y = cvt_pk_bf16(v[2], v[3]); ((u32x2*)(ws + WS_PB))[i] = w; } }
}

constexpr int HP = 136, VP = 72;
constexpr int L_QT = 0, L_QH = L_QT + 64 * HP * 2, L_KA = L_QH + 64 * HP * 2, L_KB = L_KA + 64 * HP * 2, L_ST = L_KB + 32 * HP * 2, L_VT = L_ST + 128 * HP * 2,
              L_P = L_VT + 128 * VP * 2, L_SEG = L_P + 64 * VP * 2, L_PART = L_SEG + 4 * 128 * 4, L_RINV = L_PART + 8 * 64 * 4, L_HEND = L_RINV + 256, L_KT = 0;
static_assert(L_HEND <= LDS_BYTES, "LDS");
#define MFMA16(a, b, c) __builtin_amdgcn_mfma_f32_16x16x32_bf16((a), (b), (c), 0, 0, 0)
__device__ __forceinline__ bf16_t f2bf(float x) { return (bf16_t)(cvt_pk_bf16(x, 0.f) & 0xffffu); }

__device__ __forceinline__ void hgrn_pass_a(const Args& a, LAS unsigned char* lds, int wave, int lane) {
    unsigned char* ws = a.ws;
    const float* LF = (const float*)(ws + WS_LF); const bf16_t* VH = (const bf16_t*)(ws + WS_VH); bf16_t* U = (bf16_t*)(ws + WS_U); float* Dd = (float*)(ws + WS_DD);
    const int tid = threadIdx.x, k = tid & 127, sg = tid >> 7, fr = lane & 15, fq = lane >> 4;
    LAS bf16_t* VT = (LAS bf16_t*)(lds + L_VT); LAS bf16_t* KT = (LAS bf16_t*)(lds + L_KT); LAS float* SEG = (LAS float*)(lds + L_SEG);
    for (int item = blockIdx.x; item < 1024; item += gridDim.x) {
        const int row0 = (item >> 3) * 64, cb = (item & 7) * 128;
        float lf[16], b[16];
#pragma unroll
        for (int i = 0; i < 16; ++i) lf[i] = LF[(size_t)(row0 + 16 * sg + i) * HW + cb + k];
        u32x4 vv[2];
#pragma unroll
        for (int j = 0; j < 2; ++j) { const int idx = tid + 512 * j; vv[j] = *(const u32x4*)(VH + (size_t)(row0 + (idx >> 4)) * HW + cb + 8 * (idx & 15)); }
        float run = 0.f;
#pragma unroll
        for (int i = 0; i < 16; ++i) { run += lf[i]; b[i] = run; }
        SEG[sg * 128 + k] = run;
        __syncthreads();
        const float s0 = SEG[k], s1 = SEG[128 + k], s2 = SEG[256 + k], s3 = SEG[384 + k];
        const float pre = sg == 0 ? 0.f : (sg == 1 ? s0 : (sg == 2 ? s0 + s1 : s0 + s1 + s2));
        const float blast = s0 + s1 + s2 + s3;
        unsigned pk[8];
#pragma unroll
        for (int i = 0; i < 8; ++i) {
            const float e0 = (1.0f - __expf(lf[2 * i])) * __expf(blast - (pre + b[2 * i])), e1 = (1.0f - __expf(lf[2 * i + 1])) * __expf(blast - (pre + b[2 * i + 1]));
            pk[i] = cvt_pk_bf16(e0, e1); }
        { u32x4 w0, w1; w0.x = pk[0]; w0.y = pk[1]; w0.z = pk[2]; w0.w = pk[3]; w1.x = pk[4]; w1.y = pk[5]; w1.z = pk[6]; w1.w = pk[7];
          *(LAS u32x4*)(KT + k * VP + 16 * sg) = w0; *(LAS u32x4*)(KT + k * VP + 16 * sg + 8) = w1; }
#pragma unroll
        for (int j = 0; j < 2; ++j) { const int idx = tid + 512 * j, s = idx >> 4, v0 = 8 * (idx & 15);
            VT[(v0 + 0) * VP + s] = (bf16_t)(vv[j].x & 0xffffu); VT[(v0 + 1) * VP + s] = (bf16_t)(vv[j].x >> 16);
            VT[(v0 + 2) * VP + s] = (bf16_t)(vv[j].y & 0xffffu); VT[(v0 + 3) * VP + s] = (bf16_t)(vv[j].y >> 16);
            VT[(v0 + 4) * VP + s] = (bf16_t)(vv[j].z & 0xffffu); VT[(v0 + 5) * VP + s] = (bf16_t)(vv[j].z >> 16);
            VT[(v0 + 6) * VP + s] = (bf16_t)(vv[j].w & 0xffffu); VT[(v0 + 7) * VP + s] = (bf16_t)(vv[j].w >> 16); }
        if (sg == 0) Dd[item * 128 + k] = __expf(blast);
        __syncthreads();
        const bf16x8 a0 = *(const LAS bf16x8*)(VT + (16 * wave + fr) * VP + fq * 8), a1 = *(const LAS bf16x8*)(VT + (16 * wave + fr) * VP + 32 + fq * 8);
        bf16_t* up = U + (size_t)item * 16384 + (16 * wave + 4 * fq) * 128 + fr;
#pragma unroll
        for (int kt = 0; kt < 8; ++kt) {
            const bf16x8 b0 = *(const LAS bf16x8*)(KT + (16 * kt + fr) * VP + fq * 8), b1 = *(const LAS bf16x8*)(KT + (16 * kt + fr) * VP + 32 + fq * 8);
            f32x4 acc = {0.f, 0.f, 0.f, 0.f};
            acc = MFMA16(a0, b0, acc); acc = MFMA16(a1, b1, acc);
            up[16 * kt] = f2bf(acc[0]); up[16 * kt + 128] = f2bf(acc[1]); up[16 * kt + 256] = f2bf(acc[2]); up[16 * kt + 384] = f2bf(acc[3]);
        }
        __syncthreads();
    }
}

__device__ __forceinline__ void hgrn_scan(const Args& a) {
    unsigned char* ws = a.ws;
    const bf16_t* U = (const bf16_t*)(ws + WS_U); const float* Dd = (const float*)(ws + WS_DD); bf16_t* SP = (bf16_t*)(ws + WS_S);
    for (int e = (blockIdx.x * 512 + threadIdx.x) * 4; e < 32 * 16384; e += gridDim.x * 512 * 4) {
        const int bh = e >> 14, vk = e & 16383, bb = bh >> 3, h = bh & 7;
        f32x4 S = {0.f, 0.f, 0.f, 0.f};
#pragma unroll 8
        for (int ci = 0; ci < 32; ++ci) {
            const size_t item = (size_t)((bb * 32 + ci) * 8 + h);
            const u32x2 uw = *(const u32x2*)(U + item * 16384 + vk); f32x4 u; u[0] = bflo(uw.x); u[1] = bfhi(uw.x); u[2] = bflo(uw.y); u[3] = bfhi(uw.y); const f32x4 d = *(const f32x4*)(Dd + item * 128 + (vk & 127));
            u32x2 w; w.x = cvt_pk_bf16(S[0], S[1]); w.y = cvt_pk_bf16(S[2], S[3]); *(u32x2*)(SP + item * 16384 + vk) = w;
            S = d * S + u;
        }
    }
}

__device__ __forceinline__ void conv_mixer(const Args& a, int wave, int lane) {
    unsigned char* ws = a.ws;
    const bf16_t* BC = (const bf16_t*)(ws + WS_BC); const bf16_t* UC = (const bf16_t*)(ws + WS_UC); bf16_t* MIX = (bf16_t*)(ws + WS_MIX);
    const float* cn = a.in[11]; const float* cw = a.in[8];
    const int gw = blockIdx.x * 8 + wave, NGW = gridDim.x * 8;
    for (int it = gw; it < M_TOK * 2; it += NGW) {
        const int row = it >> 1, c = (it & 1) * 512 + lane * 8, t = row & (SEQ - 1);
        const size_t off = (size_t)row * CW + c;
        const u32x4 z = {0u, 0u, 0u, 0u};
        const u32x4 u0 = *(const u32x4*)(UC + off), u1 = t >= 1 ? *(const u32x4*)(UC + off - CW) : z, u2 = t >= 2 ? *(const u32x4*)(UC + off - 2 * CW) : z, bg = *(const u32x4*)(BC + off);
        float y[8]; float ssq = 0.f;
#pragma unroll
        for (int q = 0; q < 4; ++q) {
            const unsigned a0 = u0[q], a1 = u1[q], a2 = u2[q], bb = bg[q]; const int cc = c + 2 * q;
            y[2 * q] = bflo(bb) * (cw[cc] * bflo(a2) + cw[CW + cc] * bflo(a1) + cw[2 * CW + cc] * bflo(a0));
            y[2 * q + 1] = bfhi(bb) * (cw[cc + 1] * bfhi(a2) + cw[CW + cc + 1] * bfhi(a1) + cw[2 * CW + cc + 1] * bfhi(a0));
            ssq += y[2 * q] * y[2 * q] + y[2 * q + 1] * y[2 * q + 1];
        }
        ssq += __shfl_xor(ssq, 1); ssq += __shfl_xor(ssq, 2); ssq += __shfl_xor(ssq, 4); ssq += __shfl_xor(ssq, 8);
        const float ri = rsqrtf(ssq * (1.0f / 128) + EPS);
        u32x4 w;
        w.x = cvt_pk_bf16(y[0] * ri * cn[c], y[1] * ri * cn[c + 1]); w.y = cvt_pk_bf16(y[2] * ri * cn[c + 2], y[3] * ri * cn[c + 3]);
        w.z = cvt_pk_bf16(y[4] * ri * cn[c + 4], y[5] * ri * cn[c + 5]); w.w = cvt_pk_bf16(y[6] * ri * cn[c + 6], y[7] * ri * cn[c + 7]);
        *(u32x4*)(MIX + (size_t)row * DM + HW + c) = w;
    }
}

__device__ __forceinline__ void hgrn_pass_c(const Args& a, LAS unsigned char* lds, int wave, int lane) {
    unsigned char* ws = a.ws;
    const float* LF = (const float*)(ws + WS_LF); const bf16_t* VH = (const bf16_t*)(ws + WS_VH); const bf16_t* QS = (const bf16_t*)(ws + WS_QS); const bf16_t* GH = (const bf16_t*)(ws + WS_GH);
    const bf16_t* SP = (const bf16_t*)(ws + WS_S); bf16_t* MIX = (bf16_t*)(ws + WS_MIX); const float* hn = a.in[10];
    const int tid = threadIdx.x, k = tid & 127, sg = tid >> 7, fr = lane & 15, fq = lane >> 4;
    LAS bf16_t* QT = (LAS bf16_t*)(lds + L_QT); LAS bf16_t* QH = (LAS bf16_t*)(lds + L_QH); LAS bf16_t* KA = (LAS bf16_t*)(lds + L_KA); LAS bf16_t* KB = (LAS bf16_t*)(lds + L_KB);
    LAS bf16_t* ST = (LAS bf16_t*)(lds + L_ST); LAS bf16_t* VT = (LAS bf16_t*)(lds + L_VT); LAS bf16_t* P = (LAS bf16_t*)(lds + L_P);
    LAS float* SEG = (LAS float*)(lds + L_SEG); LAS float* PART = (LAS float*)(lds + L_PART); LAS float* RINV = (LAS float*)(lds + L_RINV);
    for (int item = blockIdx.x; item < 1024; item += gridDim.x) {
        const int row0 = (item >> 3) * 64, cb = (item & 7) * 128;
        float lf[16], b[16]; bf16_t qh[16];
#pragma unroll
        for (int i = 0; i < 16; ++i) { lf[i] = LF[(size_t)(row0 + 16 * sg + i) * HW + cb + k]; qh[i] = __builtin_nontemporal_load(QS + (size_t)(row0 + 16 * sg + i) * HW + cb + k); }
        u32x4 vv[2], sv[4];
#pragma unroll
        for (int j = 0; j < 2; ++j) { const int idx = tid + 512 * j; vv[j] = *(const u32x4*)(VH + (size_t)(row0 + (idx >> 4)) * HW + cb + 8 * (idx & 15)); }
#pragma unroll
        for (int j = 0; j < 4; ++j) { const int idx = tid + 512 * j; sv[j] = __builtin_nontemporal_load((const u32x4*)(SP + (size_t)item * 16384 + (idx >> 4) * 128 + 8 * (idx & 15))); }
        float run = 0.f;
#pragma unroll
        for (int i = 0; i < 16; ++i) { run += lf[i]; b[i] = run; }
        SEG[sg * 128 + k] = run;
        __syncthreads();
        const float s0 = SEG[k], s1 = SEG[128 + k], s2 = SEG[256 + k];
        const float pre = sg == 0 ? 0.f : (sg == 1 ? s0 : (sg == 2 ? s0 + s1 : s0 + s1 + s2));
        const float beta1 = s0 + s1, beta = sg >= 2 ? beta1 : 0.f;
#pragma unroll
        for (int i = 0; i < 16; ++i) {
            const int s = 16 * sg + i; const float bi = pre + b[i], kk = 1.0f - __expf(lf[i]), qv = bf2f(qh[i]);
            QT[s * HP + k] = f2bf(qv * __expf(bi - beta)); QH[s * HP + k] = f2bf(qv * __expf(bi));
            KA[s * HP + k] = f2bf(kk * __expf(fminf(beta - bi, 80.f)));
            if (sg < 2) KB[s * HP + k] = f2bf(kk * __expf(beta1 - bi));
        }
#pragma unroll
        for (int j = 0; j < 2; ++j) { const int idx = tid + 512 * j, s = idx >> 4, v0 = 8 * (idx & 15);
            VT[(v0 + 0) * VP + s] = (bf16_t)(vv[j].x & 0xffffu); VT[(v0 + 1) * VP + s] = (bf16_t)(vv[j].x >> 16);
            VT[(v0 + 2) * VP + s] = (bf16_t)(vv[j].y & 0xffffu); VT[(v0 + 3) * VP + s] = (bf16_t)(vv[j].y >> 16);
            VT[(v0 + 4) * VP + s] = (bf16_t)(vv[j].z & 0xffffu); VT[(v0 + 5) * VP + s] = (bf16_t)(vv[j].z >> 16);
            VT[(v0 + 6) * VP + s] = (bf16_t)(vv[j].w & 0xffffu); VT[(v0 + 7) * VP + s] = (bf16_t)(vv[j].w >> 16); }
#pragma unroll
        for (int j = 0; j < 4; ++j) { const int idx = tid + 512 * j; *(LAS u32x4*)(ST + (idx >> 4) * HP + 8 * (idx & 15)) = sv[j]; }
        __syncthreads();
#pragma unroll
        for (int pp = 0; pp < 2; ++pp) {
            const int p = wave + 8 * pp, tt = p >> 2, st = p & 3;
            f32x4 acc = {0.f, 0.f, 0.f, 0.f};
            if (st <= tt) {
                const LAS bf16_t* kb = (tt >= 2 && st < 2) ? KB : KA;
#pragma unroll
                for (int ks = 0; ks < 4; ++ks) { const bf16x8 af = *(const LAS bf16x8*)(QT + (16 * tt + fr) * HP + ks * 32 + fq * 8), bfr = *(const LAS bf16x8*)(kb + (16 * st + fr) * HP + ks * 32 + fq * 8);
                    acc = MFMA16(af, bfr, acc); }
            }
#pragma unroll
            for (int r = 0; r < 4; ++r) { const bool keep = (st < tt) || (st == tt && fr <= 4 * fq + r); P[(16 * tt + 4 * fq + r) * VP + 16 * st + fr] = f2bf(keep ? acc[r] : 0.f); }
        }
        __syncthreads();
        bf16x8 bs[4], bv[2];
#pragma unroll
        for (int ks = 0; ks < 4; ++ks) bs[ks] = *(const LAS bf16x8*)(ST + (16 * wave + fr) * HP + ks * 32 + fq * 8);
#pragma unroll
        for (int ks = 0; ks < 2; ++ks) bv[ks] = *(const LAS bf16x8*)(VT + (16 * wave + fr) * VP + ks * 32 + fq * 8);
        f32x4 o[4];
#pragma unroll
        for (int tt = 0; tt < 4; ++tt) {
            f32x4 acc = {0.f, 0.f, 0.f, 0.f};
#pragma unroll
            for (int ks = 0; ks < 4; ++ks) { const bf16x8 af = *(const LAS bf16x8*)(QH + (16 * tt + fr) * HP + ks * 32 + fq * 8); acc = MFMA16(af, bs[ks], acc); }
            { const bf16x8 af = *(const LAS bf16x8*)(P + (16 * tt + fr) * VP + fq * 8); acc = MFMA16(af, bv[0], acc); }
            if (tt >= 2) { const bf16x8 af = *(const LAS bf16x8*)(P + (16 * tt + fr) * VP + 32 + fq * 8); acc = MFMA16(af, bv[1], acc); }
            o[tt] = acc;
        }
#pragma unroll
        for (int tt = 0; tt < 4; ++tt)
#pragma unroll
            for (int r = 0; r < 4; ++r) { float x = o[tt][r] * o[tt][r]; x += __shfl_xor(x, 1); x += __shfl_xor(x, 2); x += __shfl_xor(x, 4); x += __shfl_xor(x, 8);
                if (fr == 0) PART[wave * 64 + 16 * tt + 4 * fq + r] = x; }
        __syncthreads();
        if (tid < 64) { float s = 0.f;
#pragma unroll
            for (int w = 0; w < 8; ++w) s += PART[w * 64 + tid];
            RINV[tid] = rsqrtf(s * (1.0f / 128) + EPS); }
        __syncthreads();
        const float hnv = hn[16 * wave + fr];
#pragma unroll
        for (int tt = 0; tt < 4; ++tt)
#pragma unroll
            for (int r = 0; r < 4; ++r) { const int t = 16 * tt + 4 * fq + r; const size_t row = (size_t)(row0 + t);
                const float g = bf2f(__builtin_nontemporal_load(GH + row * HW + cb + 16 * wave + fr));
                MIX[row * DM + cb + 16 * wave + fr] = f2bf(o[tt][r] * RINV[t] * hnv * g); }
        __syncthreads();
    }
}

__device__ __forceinline__ void phase_final(const Args& a, int wave, int lane) {
    const int gw = blockIdx.x * 8 + wave, NGW = gridDim.x * 8; const float* gF = a.in[20]; const bf16_t* H4 = (const bf16_t*)(a.ws + WS_MIX);
    for (int m = gw; m < M_TOK; m += NGW) {
        const u32x4* hr = (const u32x4*)(H4 + (size_t)m * DM) + lane; u32x4 w[4]; float s = 0.f;
#pragma unroll
        for (int j = 0; j < 4; ++j) { w[j] = __builtin_nontemporal_load(hr + 64 * j);
            s += (bflo(w[j].x) * bflo(w[j].x) + bfhi(w[j].x) * bfhi(w[j].x)) + (bflo(w[j].y) * bflo(w[j].y) + bfhi(w[j].y) * bfhi(w[j].y))
               + (bflo(w[j].z) * bflo(w[j].z) + bfhi(w[j].z) * bfhi(w[j].z)) + (bflo(w[j].w) * bflo(w[j].w) + bfhi(w[j].w) * bfhi(w[j].w)); }
        const float ri = rinv_of(wave_sum(s));
        f32x4* orow = (f32x4*)(a.out + (size_t)m * DM);
#pragma unroll
        for (int j = 0; j < 4; ++j) { const int c = (64 * j + lane) * 8; const f32x4 g0 = *(const f32x4*)(gF + c), g1 = *(const f32x4*)(gF + c + 4);
            f32x4 o0, o1; o0[0] = bflo(w[j].x) * ri * g0[0]; o0[1] = bfhi(w[j].x) * ri * g0[1]; o0[2] = bflo(w[j].y) * ri * g0[2]; o0[3] = bfhi(w[j].y) * ri * g0[3];
            o1[0] = bflo(w[j].z) * ri * g1[0]; o1[1] = bfhi(w[j].z) * ri * g1[1]; o1[2] = bflo(w[j].w) * ri * g1[2]; o1[3] = bfhi(w[j].w) * ri * g1[3];
            __builtin_nontemporal_store(o0, orow + c / 4); __builtin_nontemporal_store(o1, orow + c / 4 + 1); }
    }
}

#define XB_TMO      128
#define XB_XCNT(j)  (256  + 64 * (j))
#define XB_XSUB(j)  (1280 + 64 * (j))
#define XB_XGEN(j)  (2304 + 64 * (j))
#define XB_TOP      3328
#define XB_TOPGEN   3392
#define XCD_BAR_WORDS 3456
#define XB_SPIN_CAP (1u << 18)

__device__ __forceinline__ unsigned xb_ld(unsigned* p)              { return __hip_atomic_load(p, __ATOMIC_RELAXED, __HIP_MEMORY_SCOPE_AGENT); }
__device__ __forceinline__ unsigned xb_add(unsigned* p, unsigned v) { return __hip_atomic_fetch_add(p, v, __ATOMIC_RELAXED, __HIP_MEMORY_SCOPE_AGENT); }
__device__ __forceinline__ unsigned xb_xcc_id() { return (unsigned)__builtin_amdgcn_s_getreg((3 << 11) | 20) & 0xFu; }
#define XB_SPIN(cond, bar) do { unsigned _sp = 0; while (cond) { __builtin_amdgcn_s_sleep(1); \
    if ((++_sp & 255u) == 0u) { if (xb_ld(&(bar)[XB_TMO])) break; if (_sp > XB_SPIN_CAP) { atomicAdd(&(bar)[XB_TMO], 1u); break; } } } } while (0)

struct XcdBarrier {
    unsigned* bar; unsigned x;
    volatile LAS unsigned* st;
};

__device__ __forceinline__ XcdBarrier xcd_barrier_post(unsigned* bar, volatile LAS unsigned* st) {
    XcdBarrier b; b.bar = bar; b.x = xb_xcc_id(); b.st = st;
    if (threadIdx.x == 0) (void)xb_add(&bar[XB_XCNT(b.x)], 1u);
    return b;
}
__device__ __forceinline__ void xcd_barrier_complete(unsigned* bar, unsigned x, unsigned& nloc, unsigned& nx) {
    const unsigned G = gridDim.x * gridDim.y * gridDim.z;
    unsigned sum, cnt, mine, sp = 0u;
    for (;;) {
        sum = 0u; cnt = 0u; mine = 0u;
#pragma unroll
        for (unsigned j = 0; j < 16; ++j) { const unsigned c = xb_ld(&bar[XB_XCNT(j)]); sum += c; cnt += (c > 0u) ? 1u : 0u; mine = (j == x) ? c : mine; }
        if (sum == G) break;
        __builtin_amdgcn_s_sleep(1);
        if ((++sp & 255u) == 0u) { if (xb_ld(&bar[XB_TMO])) break; if (sp > XB_SPIN_CAP) { atomicAdd(&bar[XB_TMO], 1u); break; } }
    }
    nloc = mine > 0u ? mine : 1u; nx = cnt > 0u ? cnt : 1u;
}

__device__ __forceinline__ void xcd_barrier(const XcdBarrier& b) {
    asm volatile("s_waitcnt vmcnt(0)" ::: "memory");
    __syncthreads();
    if (threadIdx.x == 0) {
        unsigned* bar = b.bar;
        __builtin_amdgcn_s_waitcnt(0);
        unsigned nloc = b.st[0], nx = b.st[1];
        if (nloc == 0u) { xcd_barrier_complete(bar, b.x, nloc, nx); b.st[0] = nloc; b.st[1] = nx; }
        const unsigned old = xb_add(&bar[XB_XSUB(b.x)], 1u);
        const unsigned gen = old / nloc;
        if (old + 1u == (gen + 1u) * nloc) {
            __builtin_amdgcn_fence(__ATOMIC_RELEASE, "agent");
            asm volatile("s_waitcnt vmcnt(0)" ::: "memory");
            const unsigned og = xb_add(&bar[XB_TOP], 1u);
            const unsigned tg = og / nx;
            if (og + 1u == (tg + 1u) * nx) xb_add(&bar[XB_TOPGEN], 1u);
            else XB_SPIN(xb_ld(&bar[XB_TOPGEN]) == tg, bar);
            __builtin_amdgcn_fence(__ATOMIC_ACQUIRE, "agent");
            xb_add(&bar[XB_XGEN(b.x)], 1u);
            asm volatile("s_waitcnt vmcnt(0)" ::: "memory");
        } else {
            XB_SPIN(xb_ld(&bar[XB_XGEN(b.x)]) == gen, bar);
            __builtin_amdgcn_fence(__ATOMIC_ACQUIRE, "agent");
            asm volatile("s_waitcnt vmcnt(0)" ::: "memory");
        }
    }
    __syncthreads();
}


template <class Epi>
__device__ __forceinline__ void run_gemm(LAS unsigned char* lds, const bf16_t* A, const bf16_t* Bt, int N, int K, const Epi& E, int vc) {
    pg8::Gemm g; g.A = A; g.Bt = Bt; g.M = M_TOK; g.N = N; g.K = K;
    pg8::StaticOrder S; S.init(M_TOK, N, (int)gridDim.x, vc);
    pg8::gemm_phase<Epi, pg8::StaticOrder, true, true>(lds, g, S, E);
}
struct TailOrder {
    int c, n;
    __device__ __forceinline__ bool next(int i, Unit& u) const { if (c < 0) return false; const int L = i * n + c; if (L >= 256) return false; u.pm = L >> 3; u.pn = L & 7; return true; }
    __device__ __forceinline__ void a_ready(const Unit&) const {}
    __device__ __forceinline__ void done(const Unit&) const {}
};

__global__ void __launch_bounds__(512, 2) fwd_kernel(Args a) {
    extern __shared__ __attribute__((aligned(16))) unsigned char lds_raw[];
    LAS unsigned char* lds = (LAS unsigned char*)lds_raw;
    cg::grid_group grid = cg::this_grid();
    volatile LAS unsigned* xst = (volatile LAS unsigned*)(lds + LDS_BYTES - 16);
    if (threadIdx.x < 4) xst[threadIdx.x] = 0u;
    __syncthreads();
    XcdBarrier xbar = xcd_barrier_post((unsigned*)(a.ws + WS_BAR), xst);
    unsigned* cen = (unsigned*)(a.ws + WS_BAR) + 3584;
    if (threadIdx.x == 0) xst[2] = xb_add(&cen[64 * xbar.x], 1u);
    if (a.ph_lo == 0 && a.ph_hi == NPHASE) grid.sync();
    int vc = blockIdx.x;
    if (a.ph_lo == 0 && a.ph_hi == NPHASE && gridDim.x == 256) {
        bool even = true;
#pragma unroll
        for (int j = 0; j < 8; ++j) even = even && (xb_ld(&cen[64 * j]) == 32u);
        if (even) vc = (int)xst[2] * 8 + (int)xbar.x;
    }
    vc = __builtin_amdgcn_readfirstlane(vc);
    const int tid = threadIdx.x, lane = tid & 63, wave = __builtin_amdgcn_readfirstlane(tid >> 6);
    unsigned char* ws = a.ws;
    float* SS = (float*)(ws + WS_SS);
    bf16_t* XB = (bf16_t*)(ws + WS_XB); bf16_t* G = (bf16_t*)(ws + WS_G); bf16_t* MIX = (bf16_t*)(ws + WS_MIX);
#define PH(i) if (a.ph_lo <= (i) && (i) < a.ph_hi)
#define SYNC(i) if (a.ph_lo <= (i) && (i) + 1 < a.ph_hi) { xcd_barrier(xbar); }
    PH(0) { phase0(a, lds, wave, lane); } SYNC(0)
    PH(1) { EpiGateUp E; E.G = G; E.ss = SS; run_gemm(lds, XB, (const bf16_t*)(ws + WS_W1GU), 2 * FF, DM, E, vc); conv_tail(a, lds, wave, lane, 32 * 44, CV_T1, CV_END, vc); } SYNC(1)
    PH(2) { EpiResid E; E.XB = XB; E.ss_out = SS + 8192; E.scale = 0.5f; run_gemm(lds, G, (const bf16_t*)(ws + WS_W1D), DM, FF, E, vc); } SYNC(2)
    PH(3) { EpiMixIn E; E.ss = SS + 8192; E.lbl = a.in[9]; E.QS = (bf16_t*)(ws + WS_QS);
            E.UC = (bf16_t*)(ws + WS_UC); E.LF = (float*)(ws + WS_LF); run_gemm(lds, XB, (const bf16_t*)(ws + WS_WIN), MIXIN, DM, E, vc); conv_tail(a, lds, wave, lane, 32 * 28, CV_T0, CV_T1, vc); } SYNC(3)
    PH(4) { hgrn_pass_a(a, lds, wave, lane); } SYNC(4)
    PH(5) { hgrn_scan(a); conv_mixer(a, wave, lane); } SYNC(5)
    PH(6) { hgrn_pass_c(a, lds, wave, lane); } SYNC(6)
    PH(7) { EpiResid E; E.XB = XB; E.ss_out = SS + 16384; E.scale = 1.0f; run_gemm(lds, MIX, (const bf16_t*)(ws + WS_WOUT), DM, DM, E, vc); } SYNC(7)
    PH(8) { EpiGateUp E; E.G = G; E.ss = SS + 16384; run_gemm(lds, XB, (const bf16_t*)(ws + WS_W2GU), 2 * FF, DM, E, vc);
            { const int r = (32 * 44) % (int)gridDim.x; TailOrder T; T.n = (int)gridDim.x - r; T.c = vc - r;
              EpiStoreBf16 E2; E2.O = (bf16_t*)(ws + WS_PLE); int kp = PLE; asm volatile("" : "+s"(kp));
              pg8::Gemm g2; g2.A = (const bf16_t*)(ws + WS_PB); g2.Bt = (const bf16_t*)(ws + WS_WPE); g2.M = M_TOK; g2.N = DM; g2.K = kp;
              pg8::gemm_phase<EpiStoreBf16, TailOrder, true, true>(lds, g2, T, E2); }
            conv_tail(a, lds, wave, lane, 32 * 44, CV_TA, CV_T0, vc); } SYNC(8)
    PH(9) { EpiResid E; E.XB = XB; E.ss_out = SS + 24576; E.scale = 0.5f; run_gemm(lds, G, (const bf16_t*)(ws + WS_W2D), DM, FF, E, vc); } SYNC(9)
    PH(10) { EpiPleGate E; E.XB = XB; E.H4 = MIX; E.P = (const bf16_t*)(ws + WS_PLE); E.ss = SS + 24576; run_gemm(lds, XB, (const bf16_t*)(ws + WS_WPG), DM, DM, E, vc); } SYNC(10)
    PH(11) { phase_final(a, wave, lane); }
#undef PH
#undef SYNC
}

#ifndef MK_MULTI
#define MK_MULTI 0
#endif
extern "C" void kernel_launch(void* const* d_in, const int* in_sizes, int n_in, void* d_out, int out_size, void* d_ws, size_t ws_size, hipStream_t stream) {
    static int grid = 0;
    if (grid == 0) {
        if (n_in != 21 || out_size != M_TOK * DM || ws_size < WS_END) { fprintf(stderr, "kernel_launch: unexpected shapes (n_in %d out %d ws %zu need %zu)\n", n_in, out_size, ws_size, (size_t)WS_END); grid = -1; return; }
        int dev = 0, cus = 0, per_cu = 0;
        hipGetDevice(&dev); hipDeviceGetAttribute(&cus, hipDeviceAttributeMultiprocessorCount, dev);
        if (hipFuncSetAttribute((const void*)fwd_kernel, hipFuncAttributeMaxDynamicSharedMemorySize, LDS_BYTES) != hipSuccess) { fprintf(stderr, "kernel_launch: hipFuncSetAttribute failed\n"); grid = -1; return; }
        if (hipOccupancyMaxActiveBlocksPerMultiprocessor(&per_cu, (const void*)fwd_kernel, 512, LDS_BYTES) != hipSuccess || per_cu < 1) { fprintf(stderr, "kernel_launch: occupancy query failed (%d)\n", per_cu); grid = -1; return; }
        grid = cus * per_cu;
    }
    if (grid < 0) return;
    Args a{};
    for (int i = 0; i < 21; ++i) a.in[i] = (const float*)d_in[i];
    a.out = (float*)d_out; a.ws = (unsigned char*)d_ws;
#if MK_MULTI
    for (int p = 0; p < NPHASE; ++p) { a.ph_lo = p; a.ph_hi = p + 1; hipLaunchKernelGGL(fwd_kernel, dim3(grid), dim3(512), LDS_BYTES, stream, a); }
#else
    a.ph_lo = 0; a.ph_hi = NPHASE;
    if (hipMemsetAsync((char*)d_ws + WS_BAR, 0, 4096 * 4, stream) != hipSuccess) { fprintf(stderr, "kernel_launch: memset failed\n"); return; }
    void* args[] = {&a};
    hipError_t e = hipLaunchCooperativeKernel((void*)fwd_kernel, dim3(grid), dim3(512), args, LDS_BYTES, stream);
    if (e != hipSuccess) fprintf(stderr, "cooperative launch failed: %s (grid %d)\n", hipGetErrorString(e), grid);
#endif
}
```

```cpp
#include <hip/hip_runtime.h>
#include <hip/hip_cooperative_groups.h>
#include <cstdio>
#include <cstdint>
namespace pg8 {
#define PG8_LAS __attribute__((address_space(3)))
typedef unsigned short bf16_t;
typedef short bf16x8 __attribute__((ext_vector_type(8)));
typedef float f32x4 __attribute__((ext_vector_type(4)));
typedef unsigned u32x4 __attribute__((ext_vector_type(4)));
constexpr int BM = 256, BK = 64, HALF = 128, HTB = HALF * BK * 2  , STAGE_BYTES = 8 * HTB, NXCD = 8, WGM = 4;

__host__ __device__ __forceinline__ int lds_byte(int r, int c) { const int st = (r >> 4) * 2 + (c >> 5), rr = r & 15, cc = c & 31, ob = rr * 64 + cc * 2; return st * 1024 + (ob ^ (((ob >> 9) & 1) << 5)); }
__host__ __device__ __forceinline__ void stage_rc(int b, int& R, int& C) { const int st = b / 1024, sb = b % 1024, swz = sb ^ (((sb >> 9) & 1) << 5); R = (st >> 1) * 16 + swz / 64; C = (st & 1) * 32 + (swz % 64) / 2; }
__host__ __device__ __forceinline__ int perm32(int rho) { const int n = rho >> 4, i = rho & 15; return 8 * (i >> 2) + 4 * n + (i & 3); }

struct Unit { int pm, pn; };
struct Gemm { const bf16_t* A; const bf16_t* Bt; int M, N, K; };

struct StaticOrder {
    int nM, nN, nwg, G, c;
    __host__ __device__ void init(int M, int N, int G_, int c_) { nM = M / BM; nN = N / BM; nwg = nM * nN; G = G_; c = c_; }
    __host__ __device__ bool next(int i, Unit& u) const {
        const long L = (long)i * G + c; if (L >= nwg) return false;
        int wgid = (int)L; { const int q = nwg / NXCD, r = nwg % NXCD, xcd = wgid % NXCD, off = wgid / NXCD; wgid = (xcd < r ? xcd * (q + 1) : r * (q + 1) + (xcd - r) * q) + off; }
        const int nig = WGM * nN, gid = wgid / nig, fm = gid * WGM, gsz = (nM - fm) < WGM ? (nM - fm) : WGM;
        u.pm = fm + ((wgid % nig) % gsz); u.pn = (wgid % nig) / gsz; return true;
    }
    __device__ __forceinline__ void a_ready(const Unit&) const {}
    __device__ __forceinline__ void done(const Unit&) const {}
};
typedef float f32x2 __attribute__((ext_vector_type(2)));
template <class Epi, class Sched, bool ALIGN_EPI = false, bool SP2 = false>
__device__ __forceinline__ void gemm_phase(PG8_LAS unsigned char* lds, const Gemm g, const Sched& S, const Epi& E) {
    const int tid = threadIdx.x, wid = __builtin_amdgcn_readfirstlane(tid >> 6), lane = tid & 63, wr = wid >> 2, wc = wid & 3, fr = lane & 15, fq = lane >> 4;
    const int K = g.K, nt = K / BK;
    unsigned voffA[2], voffB[2];
#pragma unroll
    for (int i = 0; i < 2; ++i) { int R, C; stage_rc(tid * 16 + i * 8192, R, C); const int Rb = Epi::PERM ? ((R & ~31) + perm32(R & 31)) : R;
        voffA[i] = (unsigned)(R * K + C) * 2u; voffB[i] = (unsigned)(Rb * K + C) * 2u; }
    const size_t kstep = (size_t)(BK * 2);
    const size_t hstep = (size_t)HALF * K * 2;
    const size_t tstep = 2 * hstep;
    const unsigned ldsw = (unsigned)wid * 1024u;
    const int aoff = lds_byte(wr * 64 + fr, fq * 8), boff = lds_byte(wc * 32 + fr, fq * 8);
#define PG8_SA(b, h) (((b) * 2 + (h)) * HTB)
#define PG8_SB(b, h) ((4 + (b) * 2 + (h)) * HTB)
#define PG8_STAGE(bufoff, gbase, voff) do { _Pragma("unroll") for (int _i = 0; _i < 2; ++_i) \
        __builtin_amdgcn_global_load_lds((const unsigned*)((const char*)(gbase) + (voff)[_i]), (PG8_LAS unsigned*)(lds + (bufoff) + ldsw + _i * 8192), 16, 0, 0); } while (0)
#define PG8_LDA(dst, b, h) do { _Pragma("unroll") for (int m = 0; m < 4; ++m) _Pragma("unroll") for (int k = 0; k < 2; ++k) dst[m][k] = *(const PG8_LAS bf16x8*)(lds + PG8_SA(b, h) + aoff + m * 2048 + k * 1024); } while (0)
#define PG8_LDB(dst, b, h) do { _Pragma("unroll") for (int n = 0; n < 2; ++n) _Pragma("unroll") for (int k = 0; k < 2; ++k) dst[n][k] = *(const PG8_LAS bf16x8*)(lds + PG8_SB(b, h) + boff + n * 2048 + k * 1024); } while (0)
#define PG8_MMA(ai, bj, At, Bt) do { __builtin_amdgcn_s_setprio(1); _Pragma("unroll") for (int m = 0; m < 4; ++m) _Pragma("unroll") for (int n = 0; n < 2; ++n) _Pragma("unroll") for (int k = 0; k < 2; ++k) \
        acc[ai][bj][m][n] = __builtin_amdgcn_mfma_f32_16x16x32_bf16(Bt[n][k], At[m][k], acc[ai][bj][m][n], 0, 0, 0); __builtin_amdgcn_s_setprio(0); } while (0)
#define PG8_WAIT_V(n) asm volatile("s_waitcnt vmcnt(" #n ")" ::: "memory")
#define PG8_WAIT_L(n) asm volatile("s_waitcnt lgkmcnt(" #n ")" ::: "memory")
#define PG8_BAR __builtin_amdgcn_s_barrier()
#define PG8_SCHED __builtin_amdgcn_sched_barrier(0)
    Unit cur, nxt; int ui = 0;
    if (!S.next(0, cur)) return;
    f32x4 acc[2][2][4][2];
#pragma unroll
    for (int a = 0; a < 2; ++a)
#pragma unroll
        for (int b = 0; b < 2; ++b)
#pragma unroll
            for (int m = 0; m < 4; ++m)
#pragma unroll
                for (int n = 0; n < 2; ++n) acc[a][b][m][n] = (f32x4){0.f, 0.f, 0.f, 0.f};
    bf16x8 At[4][2], B0[2][2], B1[2][2];
    const char* cA = (const char*)g.A + (size_t)cur.pm * tstep; const char* cB = (const char*)g.Bt + (size_t)cur.pn * tstep;
    S.a_ready(cur);
    if constexpr (SP2) {
        PG8_STAGE(PG8_SB(0, 0), cB, voffB); PG8_STAGE(PG8_SB(0, 1), cB + hstep, voffB); PG8_STAGE(PG8_SA(0, 0), cA, voffA); PG8_STAGE(PG8_SA(0, 1), cA + hstep, voffA);
        if (wr == 1) PG8_BAR;
        PG8_WAIT_V(2); PG8_BAR;
        PG8_STAGE(PG8_SB(1, 0), cB + kstep, voffB); PG8_STAGE(PG8_SA(1, 0), cA + kstep, voffA); PG8_STAGE(PG8_SB(1, 1), cB + hstep + kstep, voffB);
        PG8_WAIT_V(6); PG8_BAR;
    } else {
        PG8_STAGE(PG8_SB(0, 0), cB, voffB); PG8_STAGE(PG8_SA(0, 0), cA, voffA); PG8_STAGE(PG8_SB(0, 1), cB + hstep, voffB); PG8_STAGE(PG8_SA(0, 1), cA + hstep, voffA);
        if (wr == 1) PG8_BAR;
        PG8_WAIT_V(4); PG8_BAR;
        PG8_STAGE(PG8_SB(1, 0), cB + kstep, voffB); PG8_STAGE(PG8_SA(1, 0), cA + kstep, voffA); PG8_STAGE(PG8_SB(1, 1), cB + hstep + kstep, voffB);
        PG8_WAIT_V(6); PG8_BAR;
    }
    for (;;) {
        const bool has_next = S.next(ui + 1, nxt);
        const char* nA = has_next ? (const char*)g.A + (size_t)nxt.pm * tstep : cA; const char* nB = has_next ? (const char*)g.Bt + (size_t)nxt.pn * tstep : cB;
        for (int t = 0; t < nt; t += 2) {
            const bool last = (t == nt - 2);
            const char* a1 = cA + (size_t)(t + 1) * kstep;
            const char* a2 = last ? nA : cA + (size_t)(t + 2) * kstep; const char* b2 = last ? nB : cB + (size_t)(t + 2) * kstep;
            const char* a3 = a2 + kstep; const char* b3 = b2 + kstep;
            if (last && has_next) S.a_ready(nxt);
            if constexpr (SP2) {
            PG8_LDB(B0, 0, 0); PG8_LDB(B1, 0, 1); PG8_SCHED; PG8_LDA(At, 0, 0); PG8_STAGE(PG8_SA(1, 1), a1 + hstep, voffA);
            PG8_WAIT_V(8); PG8_WAIT_L(0); PG8_BAR; PG8_MMA(0, 0, At, B0); PG8_MMA(0, 1, At, B1); PG8_BAR; PG8_SCHED;
            PG8_LDA(At, 0, 1); PG8_STAGE(PG8_SB(0, 0), b2, voffB); PG8_STAGE(PG8_SB(0, 1), b2 + hstep, voffB); PG8_STAGE(PG8_SA(0, 0), a2, voffA);
            PG8_WAIT_V(8); PG8_WAIT_L(0); PG8_BAR; PG8_MMA(1, 0, At, B0); PG8_MMA(1, 1, At, B1); PG8_BAR; PG8_SCHED;
            PG8_LDB(B0, 1, 0); PG8_LDB(B1, 1, 1); PG8_SCHED; PG8_LDA(At, 1, 0); PG8_STAGE(PG8_SA(0, 1), a2 + hstep, voffA);
            PG8_WAIT_V(8); PG8_WAIT_L(0); PG8_BAR; PG8_MMA(0, 0, At, B0); PG8_MMA(0, 1, At, B1); PG8_BAR; PG8_SCHED;
            PG8_LDA(At, 1, 1); PG8_STAGE(PG8_SB(1, 0), b3, voffB); PG8_STAGE(PG8_SB(1, 1), b3 + hstep, voffB); PG8_STAGE(PG8_SA(1, 0), a3, voffA);
            PG8_WAIT_V(8); PG8_WAIT_L(0); PG8_BAR; PG8_MMA(1, 0, At, B0); PG8_MMA(1, 1, At, B1); PG8_BAR; PG8_SCHED;
            } else {
            PG8_LDB(B0, 0, 0); PG8_SCHED; PG8_LDA(At, 0, 0); PG8_STAGE(PG8_SA(1, 1), a1 + hstep, voffA);
            PG8_WAIT_L(8); PG8_BAR; PG8_WAIT_L(0); PG8_MMA(0, 0, At, B0); PG8_BAR; PG8_SCHED;
            PG8_LDB(B1, 0, 1); PG8_STAGE(PG8_SB(0, 0), b2, voffB);
            PG8_BAR; PG8_WAIT_L(0); PG8_MMA(0, 1, At, B1); PG8_BAR;
            PG8_LDA(At, 0, 1); PG8_STAGE(PG8_SA(0, 0), a2, voffA);
            PG8_BAR; PG8_WAIT_L(0); PG8_MMA(1, 0, At, B0); PG8_BAR; PG8_SCHED;
            PG8_STAGE(PG8_SB(0, 1), b2 + hstep, voffB);
            PG8_WAIT_V(6); PG8_BAR; PG8_MMA(1, 1, At, B1); PG8_BAR;
            PG8_LDB(B0, 1, 0); PG8_SCHED; PG8_LDA(At, 1, 0); PG8_STAGE(PG8_SA(0, 1), a2 + hstep, voffA);
            PG8_WAIT_L(8); PG8_BAR; PG8_WAIT_L(0); PG8_MMA(0, 0, At, B0); PG8_BAR; PG8_SCHED;
            PG8_LDB(B1, 1, 1); PG8_STAGE(PG8_SB(1, 0), b3, voffB);
            PG8_BAR; PG8_WAIT_L(0); PG8_MMA(0, 1, At, B1); PG8_BAR;
            PG8_LDA(At, 1, 1); PG8_STAGE(PG8_SA(1, 0), a3, voffA);
            PG8_BAR; PG8_WAIT_L(0); PG8_MMA(1, 0, At, B0); PG8_BAR; PG8_SCHED;
            PG8_STAGE(PG8_SB(1, 1), b3 + hstep, voffB);
            PG8_WAIT_V(6); PG8_BAR; PG8_MMA(1, 1, At, B1); PG8_BAR;
            }
        }
        if constexpr (ALIGN_EPI) { if (wr == 0) PG8_BAR; }
        if constexpr (!Epi::AFTER_DRAIN) { E(acc, cur, wr, wc, fr, fq); S.done(cur); }
        if (!has_next) break;
#pragma unroll
        for (int a = 0; a < 2; ++a)
#pragma unroll
            for (int b = 0; b < 2; ++b)
#pragma unroll
                for (int m = 0; m < 4; ++m)
#pragma unroll
                    for (int n = 0; n < 2; ++n) acc[a][b][m][n] = (f32x4){0.f, 0.f, 0.f, 0.f};
        cur = nxt; cA = nA; cB = nB; ++ui;
        if constexpr (ALIGN_EPI) { if (wr == 1) PG8_BAR; }
    }
    PG8_WAIT_V(0);
    if constexpr (!ALIGN_EPI) { if (wr == 0) PG8_BAR; }
    PG8_BAR;
    if constexpr (Epi::AFTER_DRAIN) { E.fused(acc, cur, wr, wc, fr, fq, lds, wid, lane); S.done(cur); }
#undef PG8_SA
#undef PG8_SB
#undef PG8_STAGE
#undef PG8_LDA
#undef PG8_LDB
#undef PG8_MMA
#undef PG8_WAIT_V
#undef PG8_WAIT_L
#undef PG8_BAR
#undef PG8_SCHED
}
}

namespace cg = cooperative_groups;
using pg8::bf16_t; using pg8::bf16x8; using pg8::f32x4; using pg8::u32x4; using pg8::Unit;
typedef float f32x2c __attribute__((ext_vector_type(2)));
typedef __bf16 bf16x2c __attribute__((ext_vector_type(2)));
__device__ __forceinline__ unsigned cvt_pk_bf16(float lo, float hi) { const f32x2c v = {lo, hi}; return __builtin_bit_cast(unsigned, __builtin_convertvector(v, bf16x2c)); }
#define LAS __attribute__((address_space(3)))
typedef unsigned u32x2 __attribute__((ext_vector_type(2)));
typedef float f32x2v __attribute__((ext_vector_type(2)));

constexpr int M_TOK = 8192, DM = 2048, FF = 5632, HW = 1024, CW = 1024, MIXIN = 7168, PLE = 256, SEQ = 2048;
constexpr float EPS = 1e-6f;
constexpr size_t MiB = 1ull << 20;
constexpr size_t WS_W1GU = 0, WS_W1D = 44 * MiB, WS_WIN = 66 * MiB, WS_WOUT = 94 * MiB, WS_W2GU = 102 * MiB, WS_W2D = 146 * MiB,
                 WS_WPG = 168 * MiB, WS_WPE = 176 * MiB, WS_PB = 177 * MiB, WS_XB = 181 * MiB, WS_MIX = 213 * MiB, WS_G = 245 * MiB,
                 WS_QS = 245 * MiB, WS_VH = 261 * MiB, WS_GH = 277 * MiB, WS_BC = 293 * MiB, WS_UC = 309 * MiB, WS_LF = 325 * MiB,
                 WS_S = 357 * MiB, WS_PLE = 0, WS_SS = 389 * MiB, WS_DD = 389 * MiB + 512 * 1024, WS_BAR = 390 * MiB + 512 * 1024, WS_END = 391 * MiB, WS_U = 0;
constexpr int LDS_BYTES = 144 * 1024;
constexpr int NPHASE = 12;

__device__ __forceinline__ float bf2f(bf16_t b) { return __uint_as_float(((unsigned)b) << 16); }
__device__ __forceinline__ float bflo(unsigned w) { return __uint_as_float(w << 16); }
__device__ __forceinline__ float bfhi(unsigned w) { return __uint_as_float(w & 0xffff0000u); }
__device__ __forceinline__ float wave_sum(float v) {
#pragma unroll
    for (int o = 1; o < 64; o <<= 1) v += __shfl_xor(v, o);
    return v;
}
__device__ __forceinline__ float fsigmoid(float x) { return __builtin_amdgcn_rcpf(1.0f + __expf(-x)); }
__device__ __forceinline__ float fsilu(float x) { return x * fsigmoid(x); }
__device__ __forceinline__ float rinv_of(float ss) { return rsqrtf(ss * (1.0f / DM) + EPS); }

struct EpiGateUp {
    static constexpr bool PERM = true, AFTER_DRAIN = false;
    bf16_t* G; const float* ss;
    __device__ __forceinline__ void operator()(const f32x4 (&acc)[2][2][4][2], const Unit& u, int wr, int wc, int fr, int fq) const {
        const int row0 = u.pm * 256 + wr * 64 + fr, col0 = u.pn * 128 + wc * 32 + 8 * fq;
#pragma unroll
        for (int ai = 0; ai < 2; ++ai)
#pragma unroll
            for (int m = 0; m < 4; ++m) {
                const int r = row0 + ai * 128 + m * 16; const float ri = rinv_of(ss[r]);
                float v[8];
#pragma unroll
                for (int n = 0; n < 2; ++n)
#pragma unroll
                    for (int j = 0; j < 4; ++j) v[n * 4 + j] = fsilu(acc[ai][0][m][n][j] * ri) * (acc[ai][1][m][n][j] * ri);
                u32x4 w; w.x = cvt_pk_bf16(v[0], v[1]); w.y = cvt_pk_bf16(v[2], v[3]); w.z = cvt_pk_bf16(v[4], v[5]); w.w = cvt_pk_bf16(v[6], v[7]);
                *(u32x4*)(G + (size_t)r * FF + col0) = w;
            }
    }
};
struct EpiResid {
    static constexpr bool PERM = true, AFTER_DRAIN = false;
    bf16_t* XB; float* ss_out; float scale;
    __device__ __forceinline__ void operator()(f32x4 (&acc)[2][2][4][2], const Unit& u, int wr, int wc, int fr, int fq) const {
        const int row0 = u.pm * 256 + wr * 64 + fr, col0 = u.pn * 256 + wc * 32 + 8 * fq;
#pragma unroll
        for (int ai = 0; ai < 2; ++ai) {
#pragma unroll
            for (int m = 0; m < 4; ++m)
#pragma unroll
                for (int bj = 0; bj < 2; ++bj) {
                    const size_t off = (size_t)(row0 + ai * 128 + m * 16) * DM + col0 + bj * 128;
                    const u32x4 xw = *(const u32x4*)(XB + off);
                    f32x4 r0, r1; r0[0] = bflo(xw.x); r0[1] = bfhi(xw.x); r0[2] = bflo(xw.y); r0[3] = bfhi(xw.y); r1[0] = bflo(xw.z); r1[1] = bfhi(xw.z); r1[2] = bflo(xw.w); r1[3] = bfhi(xw.w);
                    acc[ai][bj][m][0] = r0 + acc[ai][bj][m][0] * scale; acc[ai][bj][m][1] = r1 + acc[ai][bj][m][1] * scale;
                }
            asm volatile("" ::: "memory");
#pragma unroll
            for (int m = 0; m < 4; ++m) {
                const int r = row0 + ai * 128 + m * 16; float sq = 0.f;
#pragma unroll
                for (int bj = 0; bj < 2; ++bj) {
                    const size_t off = (size_t)r * DM + col0 + bj * 128;
                    const f32x4 v0 = acc[ai][bj][m][0], v1 = acc[ai][bj][m][1];
                    u32x4 w; w.x = cvt_pk_bf16(v0[0], v0[1]); w.y = cvt_pk_bf16(v0[2], v0[3]); w.z = cvt_pk_bf16(v1[0], v1[1]); w.w = cvt_pk_bf16(v1[2], v1[3]);
                    *(u32x4*)(XB + off) = w;
                    sq += (v0[0] * v0[0] + v0[1] * v0[1]) + (v0[2] * v0[2] + v0[3] * v0[3]) + (v1[0] * v1[0] + v1[1] * v1[1]) + (v1[2] * v1[2] + v1[3] * v1[3]);
                }
                sq += __shfl_xor(sq, 16); sq += __shfl_xor(sq, 32);
                if (fq == 0) atomicAdd(ss_out + r, sq);
            }
            asm volatile("" ::: "memory");
        }
    }
};
struct EpiMixIn {
    static constexpr bool PERM = true, AFTER_DRAIN = false;
    const float* ss; const float* lbl;
    bf16_t *QS, *UC; float* LF;
    __device__ __forceinline__ void operator()(const f32x4 (&acc)[2][2][4][2], const Unit& u, int wr, int wc, int fr, int fq) const {
        const int row0 = u.pm * 256 + wr * 64 + fr; const int sec = u.pn >> 2;
        if (u.pn >= 20) {
            const int col0 = (u.pn - 20) * 128 + wc * 32 + 8 * fq;
#pragma unroll
            for (int ai = 0; ai < 2; ++ai)
#pragma unroll
                for (int m = 0; m < 4; ++m) {
                    const int r = row0 + ai * 128 + m * 16; const float ri = rinv_of(ss[r]); const float ri2 = ri * ri;
                    float v[8];
#pragma unroll
                    for (int n = 0; n < 2; ++n)
#pragma unroll
                        for (int j = 0; j < 4; ++j) v[n * 4 + j] = acc[ai][0][m][n][j] * acc[ai][1][m][n][j] * ri2;
                    u32x4 w; w.x = cvt_pk_bf16(v[0], v[1]); w.y = cvt_pk_bf16(v[2], v[3]); w.z = cvt_pk_bf16(v[4], v[5]); w.w = cvt_pk_bf16(v[6], v[7]);
                    *(u32x4*)(UC + (size_t)r * CW + col0) = w;
                }
            return;
        }
        const int col0 = (u.pn & 3) * 256 + wc * 32 + 8 * fq;
        if (sec == 1) {
#pragma unroll
            for (int bj = 0; bj < 2; ++bj)
#pragma unroll
                for (int n = 0; n < 2; ++n) {
                    const int c = col0 + bj * 128 + 4 * n; const f32x4 l0 = *(const f32x4*)(lbl + c), l1 = *(const f32x4*)(lbl + 1024 + c);
                    f32x4 lb; lb[0] = fsigmoid(l0[0] - l1[0]); lb[1] = fsigmoid(l0[1] - l1[1]); lb[2] = fsigmoid(l0[2] - l1[2]); lb[3] = fsigmoid(l0[3] - l1[3]);
#pragma unroll
                    for (int ai = 0; ai < 2; ++ai)
#pragma unroll
                        for (int m = 0; m < 4; ++m) {
                            const int r = row0 + ai * 128 + m * 16; const float ri = rinv_of(ss[r]);
                            const f32x4 x = acc[ai][bj][m][n]; f32x4 o;
                            o[0] = __logf(lb[0] + (1.0f - lb[0]) * fsigmoid(x[0] * ri)); o[1] = __logf(lb[1] + (1.0f - lb[1]) * fsigmoid(x[1] * ri));
                            o[2] = __logf(lb[2] + (1.0f - lb[2]) * fsigmoid(x[2] * ri)); o[3] = __logf(lb[3] + (1.0f - lb[3]) * fsigmoid(x[3] * ri));
                            *(f32x4*)(LF + (size_t)r * HW + c) = o;
                        }
                }
            return;
        }
        bf16_t* dst = QS + (size_t)(sec == 0 ? 0 : sec - 1) * ((size_t)M_TOK * HW);
        const bool act = (sec == 0 || sec == 3);
#pragma unroll
        for (int ai = 0; ai < 2; ++ai)
#pragma unroll
            for (int m = 0; m < 4; ++m) {
                const int r = row0 + ai * 128 + m * 16; const float ri = rinv_of(ss[r]);
#pragma unroll
                for (int bj = 0; bj < 2; ++bj) {
                    float v[8];
#pragma unroll
                    for (int n = 0; n < 2; ++n)
#pragma unroll
                        for (int j = 0; j < 4; ++j) { const float x = acc[ai][bj][m][n][j] * ri; v[n * 4 + j] = act ? fsilu(x) : x; }
                    u32x4 w; w.x = cvt_pk_bf16(v[0], v[1]); w.y = cvt_pk_bf16(v[2], v[3]); w.z = cvt_pk_bf16(v[4], v[5]); w.w = cvt_pk_bf16(v[6], v[7]);
                    *(u32x4*)(dst + (size_t)r * HW + col0 + bj * 128) = w;
                }
            }
    }
};
struct EpiStoreBf16 {
    static constexpr bool PERM = true, AFTER_DRAIN = false;
    bf16_t* O;
    __device__ __forceinline__ void operator()(const f32x4 (&acc)[2][2][4][2], const Unit& u, int wr, int wc, int fr, int fq) const {
        const int row0 = u.pm * 256 + wr * 64 + fr, col0 = u.pn * 256 + wc * 32 + 8 * fq;
#pragma unroll
        for (int ai = 0; ai < 2; ++ai)
#pragma unroll
            for (int m = 0; m < 4; ++m) {
                const int r = row0 + ai * 128 + m * 16;
#pragma unroll
                for (int bj = 0; bj < 2; ++bj) {
                    const f32x4 v0 = acc[ai][bj][m][0], v1 = acc[ai][bj][m][1];
                    u32x4 w; w.x = cvt_pk_bf16(v0[0], v0[1]); w.y = cvt_pk_bf16(v0[2], v0[3]); w.z = cvt_pk_bf16(v1[0], v1[1]); w.w = cvt_pk_bf16(v1[2], v1[3]);
                    *(u32x4*)(O + (size_t)r * DM + col0 + bj * 128) = w;
                }
            }
    }
};
struct EpiPleGate {
    static constexpr bool PERM = true, AFTER_DRAIN = false;
    const bf16_t* XB; const bf16_t* P; bf16_t* H4; const float* ss;
    __device__ __forceinline__ void operator()(f32x4 (&acc)[2][2][4][2], const Unit& u, int wr, int wc, int fr, int fq) const {
        const int row0 = u.pm * 256 + wr * 64 + fr, col0 = u.pn * 256 + wc * 32 + 8 * fq;
#pragma unroll
        for (int ai = 0; ai < 2; ++ai)
#pragma unroll
            for (int m = 0; m < 4; ++m) {
                const int r = row0 + ai * 128 + m * 16; const float ri = rinv_of(ss[r]);
#pragma unroll
                for (int bj = 0; bj < 2; ++bj) {
                    const size_t off = (size_t)r * DM + col0 + bj * 128;
                    const u32x4 pw = *(const u32x4*)(P + off), xw = *(const u32x4*)(XB + off);
                    const f32x4 a0 = acc[ai][bj][m][0], a1 = acc[ai][bj][m][1];
                    u32x4 w;
                    w.x = cvt_pk_bf16(bflo(xw.x) + fsigmoid(a0[0] * ri) * bflo(pw.x), bfhi(xw.x) + fsigmoid(a0[1] * ri) * bfhi(pw.x));
                    w.y = cvt_pk_bf16(bflo(xw.y) + fsigmoid(a0[2] * ri) * bflo(pw.y), bfhi(xw.y) + fsigmoid(a0[3] * ri) * bfhi(pw.y));
                    w.z = cvt_pk_bf16(bflo(xw.z) + fsigmoid(a1[0] * ri) * bflo(pw.z), bfhi(xw.z) + fsigmoid(a1[1] * ri) * bfhi(pw.z));
                    w.w = cvt_pk_bf16(bflo(xw.w) + fsigmoid(a1[2] * ri) * bflo(pw.w), bfhi(xw.w) + fsigmoid(a1[3] * ri) * bfhi(pw.w));
                    *(u32x4*)(H4 + off) = w;
                }
            }
    }
};

template <int MODE>
__device__ __forceinline__ void p0_item(const float* W, const float* W2, const float* gain, int K, int N, bf16_t* WT, LAS float* scr, int item, int lane) {
    const int nblk_k = K / 64; const int nb = item / nblk_k, kb = item % nblk_k; const int k0 = 64 * kb, n0 = 32 * nb;
    const float* src = W; int c0 = n0;
    if (MODE == 1) { const int t = n0 >> 8, bj = (n0 >> 7) & 1, c = n0 & 127; src = bj ? W2 : W; c0 = 128 * t + c; }
    if (MODE == 2) { if (n0 >= 5120) { const int tt = n0 - 5120; const int t = tt >> 8, bj = (tt >> 7) & 1, c = tt & 127; c0 = 5120 + 1024 * bj + 128 * t + c; } }
    float v[32], gg[32];
    const float* sp = src + (size_t)(k0 + (lane >> 5)) * N + c0 + (lane & 31);
#pragma unroll
    for (int i = 0; i < 32; ++i) v[i] = __builtin_nontemporal_load(sp + (size_t)(2 * i) * N);
    if (gain) {
#pragma unroll
        for (int i = 0; i < 32; ++i) gg[i] = gain[k0 + 2 * i + (lane >> 5)];
#pragma unroll
        for (int i = 0; i < 32; ++i) v[i] *= gg[i];
    }
#pragma unroll
    for (int i = 0; i < 32; ++i) scr[(2 * i + (lane >> 5)) * 33 + (lane & 31)] = v[i];
    asm volatile("s_waitcnt lgkmcnt(0)" ::: "memory");
    const int c = lane & 7;
#pragma unroll
    for (int j = 0; j < 4; ++j) { const int n = (lane >> 3) + 8 * j; const LAS float* s = scr + (8 * c) * 33 + n;
        u32x4 o; o.x = cvt_pk_bf16(s[0 * 33], s[1 * 33]); o.y = cvt_pk_bf16(s[2 * 33], s[3 * 33]); o.z = cvt_pk_bf16(s[4 * 33], s[5 * 33]); o.w = cvt_pk_bf16(s[6 * 33], s[7 * 33]);
        *(u32x4*)(WT + (size_t)(n0 + n) * K + k0 + 8 * c) = o; }
    asm volatile("s_waitcnt lgkmcnt(0)" ::: "memory");
}

struct Args { const float* in[21]; float* out; unsigned char* ws; int ph_lo, ph_hi; };

constexpr int CV_I0 = 32 * 352, CV_I1 = 88 * 64, CV_I2 = 32 * 224, CV_I3 = 32 * 64, CV_I7 = 4 * 64;
constexpr int CV_END = 2 * CV_I0 + 2 * CV_I1 + CV_I2 + 2 * CV_I3 + CV_I7, CV_T1 = CV_END - 10000, CV_T0 = CV_T1 - 10000, CV_TA = CV_I0 + CV_I2 + CV_I3 + CV_I7;
__device__ __forceinline__ void conv_range(const Args& a, LAS unsigned char* lds, int wave, int lane, int lo, int hi, int w0, int nw) {
    unsigned char* ws = a.ws;
    LAS float* scr = (LAS float*)(lds + wave * 16384);
    for (int it = lo + w0; it < hi; it += nw) {
        int r = it;
        if (r < CV_I0) { p0_item<1>(a.in[3], a.in[4], a.in[2], DM, FF, (bf16_t*)(ws + WS_W1GU), scr, r, lane); continue; } r -= CV_I0;
        if (r < CV_I2) { p0_item<2>(a.in[7], nullptr, a.in[6], DM, MIXIN, (bf16_t*)(ws + WS_WIN), scr, r, lane); continue; } r -= CV_I2;
        if (r < CV_I3) { p0_item<0>(a.in[12], nullptr, nullptr, DM, DM, (bf16_t*)(ws + WS_WOUT), scr, r, lane); continue; } r -= CV_I3;
        if (r < CV_I7) { p0_item<0>(a.in[18], nullptr, nullptr, PLE, DM, (bf16_t*)(ws + WS_WPE), scr, r, lane); continue; } r -= CV_I7;
        if (r < CV_I3) { p0_item<0>(a.in[19], nullptr, a.in[17], DM, DM, (bf16_t*)(ws + WS_WPG), scr, r, lane); continue; } r -= CV_I3;
        if (r < CV_I1) { p0_item<0>(a.in[16], nullptr, nullptr, FF, DM, (bf16_t*)(ws + WS_W2D), scr, r, lane); continue; } r -= CV_I1;
        if (r < CV_I0) { p0_item<1>(a.in[14], a.in[15], a.in[13], DM, FF, (bf16_t*)(ws + WS_W2GU), scr, r, lane); continue; } r -= CV_I0;
        p0_item<0>(a.in[5], nullptr, nullptr, FF, DM, (bf16_t*)(ws + WS_W1D), scr, r, lane);
    }
}
__device__ __forceinline__ void conv_tail(const Args& a, LAS unsigned char* lds, int wave, int lane, int nunits, int lo, int hi, int vc) {
    const int r = nunits % (int)gridDim.x;
    if (r == 0) { conv_range(a, lds, wave, lane, lo, hi, vc * 8 + wave, gridDim.x * 8); return; }
    if (vc >= r) conv_range(a, lds, wave, lane, lo, hi, (vc - r) * 8 + wave, ((int)gridDim.x - r) * 8);
}

__device__ __forceinline__ void phase0(const Args& a, LAS unsigned char* lds, int wave, int lane) {
    unsigned char* ws = a.ws;
    const int gw = blockIdx.x * 8 + wave, NGW = gridDim.x * 8;
    conv_range(a, lds, wave, lane, 0, CV_TA, gw, NGW);
    float* SS = (float*)(ws + WS_SS);
    for (int m = gw; m < M_TOK; m += NGW) {
        const f32x4* xr = (const f32x4*)(a.in[0] + (size_t)m * DM) + lane; u32x2* xb = (u32x2*)((bf16_t*)(ws + WS_XB) + (size_t)m * DM) + lane;
        float s = 0.f;
#pragma unroll
        for (int j = 0; j < 8; ++j) { const f32x4 v = __builtin_nontemporal_load(xr + 64 * j); s += (v[0] * v[0] + v[1] * v[1]) + (v[2] * v[2] + v[3] * v[3]);
            u32x2 w; w.x = cvt_pk_bf16(v[0], v[1]); w.y = cvt_pk_bf16(v[2], v[3]); xb[64 * j] = w; }
        s = wave_sum(s);
        if (lane == 0) { SS[m] = s; SS[8192 + m] = 0.f; SS[16384 + m] = 0.f; SS[24576 + m] = 0.f; }
    }
    { const int gt = blockIdx.x * 512 + threadIdx.x, NT = gridDim.x * 512;
      for (int i = gt; i < M_TOK * PLE / 4; i += NT) { const f32x4 v = __builtin_nontemporal_load((const f32x4*)a.in[1] + i); u32x2 w; w.x = cvt_pk_bf16(v[0], v[1]); w.y = cvt_pk_bf16(v[2], v[3]); ((u32x2*)(ws + WS_PB))[i] = w; } }
}

constexpr int HP = 136, VP = 72;
constexpr int L_QT = 0, L_QH = L_QT + 64 * HP * 2, L_KA = L_QH + 64 * HP * 2, L_KB = L_KA + 64 * HP * 2, L_ST = L_KB + 32 * HP * 2, L_VT = L_ST + 128 * HP * 2,
              L_P = L_VT + 128 * VP * 2, L_SEG = L_P + 64 * VP * 2, L_PART = L_SEG + 4 * 128 * 4, L_RINV = L_PART + 8 * 64 * 4, L_HEND = L_RINV + 256, L_KT = 0;
static_assert(L_HEND <= LDS_BYTES, "LDS");
#define MFMA16(a, b, c) __builtin_amdgcn_mfma_f32_16x16x32_bf16((a), (b), (c), 0, 0, 0)
__device__ __forceinline__ bf16_t f2bf(float x) { return (bf16_t)(cvt_pk_bf16(x, 0.f) & 0xffffu); }

#define LDSBAR() do { asm volatile("s_waitcnt lgkmcnt(0)" ::: "memory"); __builtin_amdgcn_s_barrier(); asm volatile("" ::: "memory"); } while (0)
__device__ __forceinline__ void hgrn_pass_a(const Args& a, LAS unsigned char* lds, int wave, int lane) {
    unsigned char* ws = a.ws;
    const float* LF = (const float*)(ws + WS_LF); const bf16_t* VH = (const bf16_t*)(ws + WS_VH); bf16_t* U = (bf16_t*)(ws + WS_U); float* Dd = (float*)(ws + WS_DD);
    const int tid = threadIdx.x, k = tid & 127, sg = tid >> 7, fr = lane & 15, fq = lane >> 4;
    LAS bf16_t* VT = (LAS bf16_t*)(lds + L_VT); LAS bf16_t* KT = (LAS bf16_t*)(lds + L_KT); LAS float* SEG = (LAS float*)(lds + L_SEG);
    float lf[16]; u32x4 vv[2];
#define PA_LOAD(it) do { const int r0_ = ((it) >> 3) * 64, c0_ = ((it) & 7) * 128; \
        _Pragma("unroll") for (int i = 0; i < 16; ++i) lf[i] = LF[(size_t)(r0_ + 16 * sg + i) * HW + c0_ + k]; \
        _Pragma("unroll") for (int j = 0; j < 2; ++j) { const int idx = tid + 512 * j; vv[j] = *(const u32x4*)(VH + (size_t)(r0_ + (idx >> 4)) * HW + c0_ + 8 * (idx & 15)); } } while (0)
    int item = blockIdx.x;
    if (item < 1024) PA_LOAD(item);
    for (; item < 1024; item += gridDim.x) {
        float b[16];
        float run = 0.f;
#pragma unroll
        for (int i = 0; i < 16; ++i) { run += lf[i]; b[i] = run; }
        SEG[sg * 128 + k] = run;
        LDSBAR();
        const float s0 = SEG[k], s1 = SEG[128 + k], s2 = SEG[256 + k], s3 = SEG[384 + k];
        const float pre = sg == 0 ? 0.f : (sg == 1 ? s0 : (sg == 2 ? s0 + s1 : s0 + s1 + s2));
        const float blast = s0 + s1 + s2 + s3;
        unsigned pk[8];
#pragma unroll
        for (int i = 0; i < 8; ++i) {
            const float e0 = (1.0f - __expf(lf[2 * i])) * __expf(blast - (pre + b[2 * i])), e1 = (1.0f - __expf(lf[2 * i + 1])) * __expf(blast - (pre + b[2 * i + 1]));
            pk[i] = cvt_pk_bf16(e0, e1); }
        { u32x4 w0, w1; w0.x = pk[0]; w0.y = pk[1]; w0.z = pk[2]; w0.w = pk[3]; w1.x = pk[4]; w1.y = pk[5]; w1.z = pk[6]; w1.w = pk[7];
          *(LAS u32x4*)(KT + k * VP + 16 * sg) = w0; *(LAS u32x4*)(KT + k * VP + 16 * sg + 8) = w1; }
#pragma unroll
        for (int j = 0; j < 2; ++j) { const int idx = tid + 512 * j, s = idx >> 4, v0 = 8 * (idx & 15);
            VT[(v0 + 0) * VP + s] = (bf16_t)(vv[j].x & 0xffffu); VT[(v0 + 1) * VP + s] = (bf16_t)(vv[j].x >> 16);
            VT[(v0 + 2) * VP + s] = (bf16_t)(vv[j].y & 0xffffu); VT[(v0 + 3) * VP + s] = (bf16_t)(vv[j].y >> 16);
            VT[(v0 + 4) * VP + s] = (bf16_t)(vv[j].z & 0xffffu); VT[(v0 + 5) * VP + s] = (bf16_t)(vv[j].z >> 16);
            VT[(v0 + 6) * VP + s] = (bf16_t)(vv[j].w & 0xffffu); VT[(v0 + 7) * VP + s] = (bf16_t)(vv[j].w >> 16); }
        if (sg == 0) Dd[item * 128 + k] = __expf(blast);
        if (item + (int)gridDim.x < 1024) PA_LOAD(item + (int)gridDim.x);
        LDSBAR();
        const bf16x8 a0 = *(const LAS bf16x8*)(VT + (16 * wave + fr) * VP + fq * 8), a1 = *(const LAS bf16x8*)(VT + (16 * wave + fr) * VP + 32 + fq * 8);
        bf16_t* up = U + (size_t)item * 16384 + (16 * wave + 4 * fq) * 128 + fr;
#pragma unroll
        for (int kt = 0; kt < 8; ++kt) {
            const bf16x8 b0 = *(const LAS bf16x8*)(KT + (16 * kt + fr) * VP + fq * 8), b1 = *(const LAS bf16x8*)(KT + (16 * kt + fr) * VP + 32 + fq * 8);
            f32x4 acc = {0.f, 0.f, 0.f, 0.f};
            acc = MFMA16(a0, b0, acc); acc = MFMA16(a1, b1, acc);
            up[16 * kt] = f2bf(acc[0]); up[16 * kt + 128] = f2bf(acc[1]); up[16 * kt + 256] = f2bf(acc[2]); up[16 * kt + 384] = f2bf(acc[3]);
        }
        LDSBAR();
    }
#undef PA_LOAD
}

__device__ __forceinline__ void hgrn_scan(const Args& a) {
    unsigned char* ws = a.ws;
    const bf16_t* U = (const bf16_t*)(ws + WS_U); const float* Dd = (const float*)(ws + WS_DD); bf16_t* SP = (bf16_t*)(ws + WS_S);
    for (int e = (blockIdx.x * 512 + threadIdx.x) * 4; e < 32 * 16384; e += gridDim.x * 512 * 4) {
        const int bh = e >> 14, vk = e & 16383, bb = bh >> 3, h = bh & 7;
        f32x4 S = {0.f, 0.f, 0.f, 0.f};
#pragma unroll 8
        for (int ci = 0; ci < 32; ++ci) {
            const size_t item = (size_t)((bb * 32 + ci) * 8 + h);
            const u32x2 uw = *(const u32x2*)(U + item * 16384 + vk); f32x4 u; u[0] = bflo(uw.x); u[1] = bfhi(uw.x); u[2] = bflo(uw.y); u[3] = bfhi(uw.y); const f32x4 d = *(const f32x4*)(Dd + item * 128 + (vk & 127));
            u32x2 w; w.x = cvt_pk_bf16(S[0], S[1]); w.y = cvt_pk_bf16(S[2], S[3]); *(u32x2*)(SP + item * 16384 + vk) = w;
            S = d * S + u;
        }
    }
}

__device__ __forceinline__ void conv_mixer(const Args& a, int wave, int lane) {
    unsigned char* ws = a.ws;
    const bf16_t* BC = (const bf16_t*)(ws + WS_BC); const bf16_t* UC = (const bf16_t*)(ws + WS_UC); bf16_t* MIX = (bf16_t*)(ws + WS_MIX);
    const float* cn = a.in[11]; const float* cw = a.in[8];
    const int gw = blockIdx.x * 8 + wave, NGW = gridDim.x * 8;
    for (int it = gw; it < M_TOK * 2; it += NGW) {
        const int row = it >> 1, c = (it & 1) * 512 + lane * 8, t = row & (SEQ - 1);
        const size_t off = (size_t)row * CW + c;
        const u32x4 z = {0u, 0u, 0u, 0u};
        const u32x4 u0 = *(const u32x4*)(UC + off), u1 = t >= 1 ? *(const u32x4*)(UC + off - CW) : z, u2 = t >= 2 ? *(const u32x4*)(UC + off - 2 * CW) : z, bg = *(const u32x4*)(BC + off);
        float y[8]; float ssq = 0.f;
#pragma unroll
        for (int q = 0; q < 4; ++q) {
            const unsigned a0 = u0[q], a1 = u1[q], a2 = u2[q], bb = bg[q]; const int cc = c + 2 * q;
            y[2 * q] = bflo(bb) * (cw[cc] * bflo(a2) + cw[CW + cc] * bflo(a1) + cw[2 * CW + cc] * bflo(a0));
            y[2 * q + 1] = bfhi(bb) * (cw[cc + 1] * bfhi(a2) + cw[CW + cc + 1] * bfhi(a1) + cw[2 * CW + cc + 1] * bfhi(a0));
            ssq += y[2 * q] * y[2 * q] + y[2 * q + 1] * y[2 * q + 1];
        }
        ssq += __shfl_xor(ssq, 1); ssq += __shfl_xor(ssq, 2); ssq += __shfl_xor(ssq, 4); ssq += __shfl_xor(ssq, 8);
        const float ri = rsqrtf(ssq * (1.0f / 128) + EPS);
        u32x4 w;
        w.x = cvt_pk_bf16(y[0] * ri * cn[c], y[1] * ri * cn[c + 1]); w.y = cvt_pk_bf16(y[2] * ri * cn[c + 2], y[3] * ri * cn[c + 3]);
        w.z = cvt_pk_bf16(y[4] * ri * cn[c + 4], y[5] * ri * cn[c + 5]); w.w = cvt_pk_bf16(y[6] * ri * cn[c + 6], y[7] * ri * cn[c + 7]);
        *(u32x4*)(MIX + (size_t)row * DM + HW + c) = w;
    }
}

__device__ __forceinline__ void hgrn_pass_c(const Args& a, LAS unsigned char* lds, int wave, int lane) {
    unsigned char* ws = a.ws;
    const float* LF = (const float*)(ws + WS_LF); const bf16_t* VH = (const bf16_t*)(ws + WS_VH); const bf16_t* QS = (const bf16_t*)(ws + WS_QS); const bf16_t* GH = (const bf16_t*)(ws + WS_GH);
    const bf16_t* SP = (const bf16_t*)(ws + WS_S); bf16_t* MIX = (bf16_t*)(ws + WS_MIX); const float* hn = a.in[10];
    const int tid = threadIdx.x, k = tid & 127, sg = tid >> 7, fr = lane & 15, fq = lane >> 4;
    LAS bf16_t* QT = (LAS bf16_t*)(lds + L_QT); LAS bf16_t* QH = (LAS bf16_t*)(lds + L_QH); LAS bf16_t* KA = (LAS bf16_t*)(lds + L_KA); LAS bf16_t* KB = (LAS bf16_t*)(lds + L_KB);
    LAS bf16_t* ST = (LAS bf16_t*)(lds + L_ST); LAS bf16_t* VT = (LAS bf16_t*)(lds + L_VT); LAS bf16_t* P = (LAS bf16_t*)(lds + L_P);
    LAS float* SEG = (LAS float*)(lds + L_SEG); LAS float* PART = (LAS float*)(lds + L_PART); LAS float* RINV = (LAS float*)(lds + L_RINV);
    float lf[16]; bf16_t qh[16]; u32x4 vv[2], sv[4];
#define PC_LOAD(it) do { const int r0_ = ((it) >> 3) * 64, c0_ = ((it) & 7) * 128; \
        _Pragma("unroll") for (int i = 0; i < 16; ++i) { lf[i] = LF[(size_t)(r0_ + 16 * sg + i) * HW + c0_ + k]; qh[i] = __builtin_nontemporal_load(QS + (size_t)(r0_ + 16 * sg + i) * HW + c0_ + k); } \
        _Pragma("unroll") for (int j = 0; j < 2; ++j) { const int idx = tid + 512 * j; vv[j] = *(const u32x4*)(VH + (size_t)(r0_ + (idx >> 4)) * HW + c0_ + 8 * (idx & 15)); } \
        _Pragma("unroll") for (int j = 0; j < 4; ++j) { const int idx = tid + 512 * j; sv[j] = __builtin_nontemporal_load((const u32x4*)(SP + (size_t)(it) * 16384 + (idx >> 4) * 128 + 8 * (idx & 15))); } } while (0)
    int item = blockIdx.x;
    if (item < 1024) PC_LOAD(item);
    for (; item < 1024; item += gridDim.x) {
        const int row0 = (item >> 3) * 64, cb = (item & 7) * 128;
        float b[16];
        float run = 0.f;
#pragma unroll
        for (int i = 0; i < 16; ++i) { run += lf[i]; b[i] = run; }
        SEG[sg * 128 + k] = run;
        LDSBAR();
        const float s0 = SEG[k], s1 = SEG[128 + k], s2 = SEG[256 + k];
        const float pre = sg == 0 ? 0.f : (sg == 1 ? s0 : (sg == 2 ? s0 + s1 : s0 + s1 + s2));
        const float beta1 = s0 + s1, beta = sg >= 2 ? beta1 : 0.f;
#pragma unroll
        for (int i = 0; i < 16; ++i) {
            const int s = 16 * sg + i; const float bi = pre + b[i], kk = 1.0f - __expf(lf[i]), qv = bf2f(qh[i]);
            QT[s * HP + k] = f2bf(qv * __expf(bi - beta)); QH[s * HP + k] = f2bf(qv * __expf(bi));
            KA[s * HP + k] = f2bf(kk * __expf(fminf(beta - bi, 80.f)));
            if (sg < 2) KB[s * HP + k] = f2bf(kk * __expf(beta1 - bi));
        }
#pragma unroll
        for (int j = 0; j < 2; ++j) { const int idx = tid + 512 * j, s = idx >> 4, v0 = 8 * (idx & 15);
            VT[(v0 + 0) * VP + s] = (bf16_t)(vv[j].x & 0xffffu); VT[(v0 + 1) * VP + s] = (bf16_t)(vv[j].x >> 16);
            VT[(v0 + 2) * VP + s] = (bf16_t)(vv[j].y & 0xffffu); VT[(v0 + 3) * VP + s] = (bf16_t)(vv[j].y >> 16);
            VT[(v0 + 4) * VP + s] = (bf16_t)(vv[j].z & 0xffffu); VT[(v0 + 5) * VP + s] = (bf16_t)(vv[j].z >> 16);
            VT[(v0 + 6) * VP + s] = (bf16_t)(vv[j].w & 0xffffu); VT[(v0 + 7) * VP + s] = (bf16_t)(vv[j].w >> 16); }
#pragma unroll
        for (int j = 0; j < 4; ++j) { const int idx = tid + 512 * j; *(LAS u32x4*)(ST + (idx >> 4) * HP + 8 * (idx & 15)) = sv[j]; }
        if (item + (int)gridDim.x < 1024) PC_LOAD(item + (int)gridDim.x);
        LDSBAR();
#pragma unroll
        for (int pp = 0; pp < 2; ++pp) {
            const int p = wave + 8 * pp, tt = p >> 2, st = p & 3;
            f32x4 acc = {0.f, 0.f, 0.f, 0.f};
            if (st <= tt) {
                const LAS bf16_t* kb = (tt >= 2 && st < 2) ? KB : KA;
#pragma unroll
                for (int ks = 0; ks < 4; ++ks) { const bf16x8 af = *(const LAS bf16x8*)(QT + (16 * tt + fr) * HP + ks * 32 + fq * 8), bfr = *(const LAS bf16x8*)(kb + (16 * st + fr) * HP + ks * 32 + fq * 8);
                    acc = MFMA16(af, bfr, acc); }
            }
#pragma unroll
            for (int r = 0; r < 4; ++r) { const bool keep = (st < tt) || (st == tt && fr <= 4 * fq + r); P[(16 * tt + 4 * fq + r) * VP + 16 * st + fr] = f2bf(keep ? acc[r] : 0.f); }
        }
        LDSBAR();
        bf16x8 bs[4], bv[2];
#pragma unroll
        for (int ks = 0; ks < 4; ++ks) bs[ks] = *(const LAS bf16x8*)(ST + (16 * wave + fr) * HP + ks * 32 + fq * 8);
#pragma unroll
        for (int ks = 0; ks < 2; ++ks) bv[ks] = *(const LAS bf16x8*)(VT + (16 * wave + fr) * VP + ks * 32 + fq * 8);
        f32x4 o[4];
#pragma unroll
        for (int tt = 0; tt < 4; ++tt) {
            f32x4 acc = {0.f, 0.f, 0.f, 0.f};
#pragma unroll
            for (int ks = 0; ks < 4; ++ks) { const bf16x8 af = *(const LAS bf16x8*)(QH + (16 * tt + fr) * HP + ks * 32 + fq * 8); acc = MFMA16(af, bs[ks], acc); }
            { const bf16x8 af = *(const LAS bf16x8*)(P + (16 * tt + fr) * VP + fq * 8); acc = MFMA16(af, bv[0], acc); }
            if (tt >= 2) { const bf16x8 af = *(const LAS bf16x8*)(P + (16 * tt + fr) * VP + 32 + fq * 8); acc = MFMA16(af, bv[1], acc); }
            o[tt] = acc;
        }
#pragma unroll
        for (int tt = 0; tt < 4; ++tt)
#pragma unroll
            for (int r = 0; r < 4; ++r) { float x = o[tt][r] * o[tt][r]; x += __shfl_xor(x, 1); x += __shfl_xor(x, 2); x += __shfl_xor(x, 4); x += __shfl_xor(x, 8);
                if (fr == 0) PART[wave * 64 + 16 * tt + 4 * fq + r] = x; }
        LDSBAR();
        if (tid < 64) { float s = 0.f;
#pragma unroll
            for (int w = 0; w < 8; ++w) s += PART[w * 64 + tid];
            RINV[tid] = rsqrtf(s * (1.0f / 128) + EPS); }
        LDSBAR();
        const float hnv = hn[16 * wave + fr];
#pragma unroll
        for (int tt = 0; tt < 4; ++tt)
#pragma unroll
            for (int r = 0; r < 4; ++r) { const int t = 16 * tt + 4 * fq + r; const size_t row = (size_t)(row0 + t);
                const float g = bf2f(__builtin_nontemporal_load(GH + row * HW + cb + 16 * wave + fr));
                MIX[row * DM + cb + 16 * wave + fr] = f2bf(o[tt][r] * RINV[t] * hnv * g); }
        LDSBAR();
    }
#undef PC_LOAD
}

__device__ __forceinline__ void phase_final(const Args& a, int wave, int lane) {
    const int gw = blockIdx.x * 8 + wave, NGW = gridDim.x * 8; const float* gF = a.in[20]; const bf16_t* H4 = (const bf16_t*)(a.ws + WS_MIX);
    for (int m = gw; m < M_TOK; m += NGW) {
        const u32x4* hr = (const u32x4*)(H4 + (size_t)m * DM) + lane; u32x4 w[4]; float s = 0.f;
#pragma unroll
        for (int j = 0; j < 4; ++j) { w[j] = __builtin_nontemporal_load(hr + 64 * j);
            s += (bflo(w[j].x) * bflo(w[j].x) + bfhi(w[j].x) * bfhi(w[j].x)) + (bflo(w[j].y) * bflo(w[j].y) + bfhi(w[j].y) * bfhi(w[j].y))
               + (bflo(w[j].z) * bflo(w[j].z) + bfhi(w[j].z) * bfhi(w[j].z)) + (bflo(w[j].w) * bflo(w[j].w) + bfhi(w[j].w) * bfhi(w[j].w)); }
        const float ri = rinv_of(wave_sum(s));
        f32x4* orow = (f32x4*)(a.out + (size_t)m * DM);
#pragma unroll
        for (int j = 0; j < 4; ++j) { const int c = (64 * j + lane) * 8; const f32x4 g0 = *(const f32x4*)(gF + c), g1 = *(const f32x4*)(gF + c + 4);
            f32x4 o0, o1; o0[0] = bflo(w[j].x) * ri * g0[0]; o0[1] = bfhi(w[j].x) * ri * g0[1]; o0[2] = bflo(w[j].y) * ri * g0[2]; o0[3] = bfhi(w[j].y) * ri * g0[3];
            o1[0] = bflo(w[j].z) * ri * g1[0]; o1[1] = bfhi(w[j].z) * ri * g1[1]; o1[2] = bflo(w[j].w) * ri * g1[2]; o1[3] = bfhi(w[j].w) * ri * g1[3];
            __builtin_nontemporal_store(o0, orow + c / 4); __builtin_nontemporal_store(o1, orow + c / 4 + 1); }
    }
}

#define XB_TMO      128
#define XB_XCNT(j)  (256  + 64 * (j))
#define XB_XSUB(j)  (1280 + 64 * (j))
#define XB_XGEN(j)  (2304 + 64 * (j))
#define XB_TOP      3328
#define XB_TOPGEN   3392
#define XCD_BAR_WORDS 3456
#define XB_SPIN_CAP (1u << 18)

__device__ __forceinline__ unsigned xb_ld(unsigned* p)              { return __hip_atomic_load(p, __ATOMIC_RELAXED, __HIP_MEMORY_SCOPE_AGENT); }
__device__ __forceinline__ unsigned xb_add(unsigned* p, unsigned v) { return __hip_atomic_fetch_add(p, v, __ATOMIC_RELAXED, __HIP_MEMORY_SCOPE_AGENT); }
__device__ __forceinline__ unsigned xb_xcc_id() { return (unsigned)__builtin_amdgcn_s_getreg((3 << 11) | 20) & 0xFu; }
#define XB_SPIN(cond, bar) do { unsigned _sp = 0; while (cond) { __builtin_amdgcn_s_sleep(1); \
    if ((++_sp & 255u) == 0u) { if (xb_ld(&(bar)[XB_TMO])) break; if (_sp > XB_SPIN_CAP) { atomicAdd(&(bar)[XB_TMO], 1u); break; } } } } while (0)

struct XcdBarrier {
    unsigned* bar; unsigned x;
    volatile LAS unsigned* st;
};

__device__ __forceinline__ XcdBarrier xcd_barrier_post(unsigned* bar, volatile LAS unsigned* st) {
    XcdBarrier b; b.bar = bar; b.x = xb_xcc_id(); b.st = st;
    if (threadIdx.x == 0) (void)xb_add(&bar[XB_XCNT(b.x)], 1u);
    return b;
}
__device__ __forceinline__ void xcd_barrier_complete(unsigned* bar, unsigned x, unsigned& nloc, unsigned& nx) {
    const unsigned G = gridDim.x * gridDim.y * gridDim.z;
    unsigned sum, cnt, mine, sp = 0u;
    for (;;) {
        sum = 0u; cnt = 0u; mine = 0u;
#pragma unroll
        for (unsigned j = 0; j < 16; ++j) { const unsigned c = xb_ld(&bar[XB_XCNT(j)]); sum += c; cnt += (c > 0u) ? 1u : 0u; mine = (j == x) ? c : mine; }
        if (sum == G) break;
        __builtin_amdgcn_s_sleep(1);
        if ((++sp & 255u) == 0u) { if (xb_ld(&bar[XB_TMO])) break; if (sp > XB_SPIN_CAP) { atomicAdd(&bar[XB_TMO], 1u); break; } }
    }
    nloc = mine > 0u ? mine : 1u; nx = cnt > 0u ? cnt : 1u;
}

__device__ __forceinline__ void xcd_barrier(const XcdBarrier& b) {
    asm volatile("s_waitcnt vmcnt(0)" ::: "memory");
    __syncthreads();
    if (threadIdx.x == 0) {
        unsigned* bar = b.bar;
        __builtin_amdgcn_s_waitcnt(0);
        unsigned nloc = b.st[0], nx = b.st[1];
        if (nloc == 0u) { xcd_barrier_complete(bar, b.x, nloc, nx); b.st[0] = nloc; b.st[1] = nx; }
        const unsigned old = xb_add(&bar[XB_XSUB(b.x)], 1u);
        const unsigned gen = old / nloc;
        if (old + 1u == (gen + 1u) * nloc) {
            __builtin_amdgcn_fence(__ATOMIC_RELEASE, "agent");
            asm volatile("s_waitcnt vmcnt(0)" ::: "memory");
            const unsigned og = xb_add(&bar[XB_TOP], 1u);
            const unsigned tg = og / nx;
            if (og + 1u == (tg + 1u) * nx) xb_add(&bar[XB_TOPGEN], 1u);
            else XB_SPIN(xb_ld(&bar[XB_TOPGEN]) == tg, bar);
            __builtin_amdgcn_fence(__ATOMIC_ACQUIRE, "agent");
            xb_add(&bar[XB_XGEN(b.x)], 1u);
            asm volatile("s_waitcnt vmcnt(0)" ::: "memory");
        } else {
            XB_SPIN(xb_ld(&bar[XB_XGEN(b.x)]) == gen, bar);
            __builtin_amdgcn_fence(__ATOMIC_ACQUIRE, "agent");
            asm volatile("s_waitcnt vmcnt(0)" ::: "memory");
        }
    }
    __syncthreads();
}


template <class Epi>
__device__ __forceinline__ void run_gemm(LAS unsigned char* lds, const bf16_t* A, const bf16_t* Bt, int N, int K, const Epi& E, int vc) {
    pg8::Gemm g; g.A = A; g.Bt = Bt; g.M = M_TOK; g.N = N; g.K = K;
    pg8::StaticOrder S; S.init(M_TOK, N, (int)gridDim.x, vc);
    pg8::gemm_phase<Epi, pg8::StaticOrder, true, true>(lds, g, S, E);
}
struct TailOrder {
    int c, n;
    __device__ __forceinline__ bool next(int i, Unit& u) const { if (c < 0) return false; const int L = i * n + c; if (L >= 256) return false; u.pm = L >> 3; u.pn = L & 7; return true; }
    __device__ __forceinline__ void a_ready(const Unit&) const {}
    __device__ __forceinline__ void done(const Unit&) const {}
};

__global__ void __launch_bounds__(512, 2) fwd_kernel(Args a) {
    extern __shared__ __attribute__((aligned(16))) unsigned char lds_raw[];
    LAS unsigned char* lds = (LAS unsigned char*)lds_raw;
    cg::grid_group grid = cg::this_grid();
    volatile LAS unsigned* xst = (volatile LAS unsigned*)(lds + LDS_BYTES - 16);
    if (threadIdx.x < 4) xst[threadIdx.x] = 0u;
    __syncthreads();
    XcdBarrier xbar = xcd_barrier_post((unsigned*)(a.ws + WS_BAR), xst);
    unsigned* cen = (unsigned*)(a.ws + WS_BAR) + 3584;
    if (threadIdx.x == 0) xst[2] = xb_add(&cen[64 * xbar.x], 1u);
    if (a.ph_lo == 0 && a.ph_hi == NPHASE) grid.sync();
    int vc = blockIdx.x;
    if (a.ph_lo == 0 && a.ph_hi == NPHASE && gridDim.x == 256) {
        bool even = true;
#pragma unroll
        for (int j = 0; j < 8; ++j) even = even && (xb_ld(&cen[64 * j]) == 32u);
        if (even) vc = (int)xst[2] * 8 + (int)xbar.x;
    }
    vc = __builtin_amdgcn_readfirstlane(vc);
    const int tid = threadIdx.x, lane = tid & 63, wave = __builtin_amdgcn_readfirstlane(tid >> 6);
    unsigned char* ws = a.ws;
    float* SS = (float*)(ws + WS_SS);
    bf16_t* XB = (bf16_t*)(ws + WS_XB); bf16_t* G = (bf16_t*)(ws + WS_G); bf16_t* MIX = (bf16_t*)(ws + WS_MIX);
#define PH(i) if (a.ph_lo <= (i) && (i) < a.ph_hi)
#define SYNC(i) if (a.ph_lo <= (i) && (i) + 1 < a.ph_hi) { xcd_barrier(xbar); }
    PH(0) { phase0(a, lds, wave, lane); } SYNC(0)
    PH(1) { EpiGateUp E; E.G = G; E.ss = SS; run_gemm(lds, XB, (const bf16_t*)(ws + WS_W1GU), 2 * FF, DM, E, vc); conv_tail(a, lds, wave, lane, 32 * 44, CV_T1, CV_END, vc); } SYNC(1)
    PH(2) { EpiResid E; E.XB = XB; E.ss_out = SS + 8192; E.scale = 0.5f; run_gemm(lds, G, (const bf16_t*)(ws + WS_W1D), DM, FF, E, vc); } SYNC(2)
    PH(3) { EpiMixIn E; E.ss = SS + 8192; E.lbl = a.in[9]; E.QS = (bf16_t*)(ws + WS_QS);
            E.UC = (bf16_t*)(ws + WS_UC); E.LF = (float*)(ws + WS_LF); run_gemm(lds, XB, (const bf16_t*)(ws + WS_WIN), MIXIN, DM, E, vc); conv_tail(a, lds, wave, lane, 32 * 28, CV_T0, CV_T1, vc); } SYNC(3)
    PH(4) { hgrn_pass_a(a, lds, wave, lane); } SYNC(4)
    PH(5) { hgrn_scan(a); conv_mixer(a, wave, lane); } SYNC(5)
    PH(6) { hgrn_pass_c(a, lds, wave, lane); } SYNC(6)
    PH(7) { EpiResid E; E.XB = XB; E.ss_out = SS + 16384; E.scale = 1.0f; run_gemm(lds, MIX, (const bf16_t*)(ws + WS_WOUT), DM, DM, E, vc); } SYNC(7)
    PH(8) { EpiGateUp E; E.G = G; E.ss = SS + 16384; run_gemm(lds, XB, (const bf16_t*)(ws + WS_W2GU), 2 * FF, DM, E, vc);
            { const int r = (32 * 44) % (int)gridDim.x; TailOrder T; T.n = (int)gridDim.x - r; T.c = vc - r;
              EpiStoreBf16 E2; E2.O = (bf16_t*)(ws + WS_PLE); int kp = PLE; asm volatile("" : "+s"(kp));
              pg8::Gemm g2; g2.A = (const bf16_t*)(ws + WS_PB); g2.Bt = (const bf16_t*)(ws + WS_WPE); g2.M = M_TOK; g2.N = DM; g2.K = kp;
              pg8::gemm_phase<EpiStoreBf16, TailOrder, true, true>(lds, g2, T, E2); }
            conv_tail(a, lds, wave, lane, 32 * 44, CV_TA, CV_T0, vc); } SYNC(8)
    PH(9) { EpiResid E; E.XB = XB; E.ss_out = SS + 24576; E.scale = 0.5f; run_gemm(lds, G, (const bf16_t*)(ws + WS_W2D), DM, FF, E, vc); } SYNC(9)
    PH(10) { EpiPleGate E; E.XB = XB; E.H4 = MIX; E.P = (const bf16_t*)(ws + WS_PLE); E.ss = SS + 24576; run_gemm(lds, XB, (const bf16_t*)(ws + WS_WPG), DM, DM, E, vc); } SYNC(10)
    PH(11) { phase_final(a, wave, lane); }
#undef PH
#undef SYNC
}

#ifndef MK_MULTI
#define MK_MULTI 0
#endif
extern "C" void kernel_launch(void* const* d_in, const int* in_sizes, int n_in, void* d_out, int out_size, void* d_ws, size_t ws_size, hipStream_t stream) {
    static int grid = 0;
    if (grid == 0) {
        if (n_in != 21 || out_size != M_TOK * DM || ws_size < WS_END) { fprintf(stderr, "kernel_launch: unexpected shapes (n_in %d out %d ws %zu need %zu)\n", n_in, out_size, ws_size, (size_t)WS_END); grid = -1; return; }
        int dev = 0, cus = 0, per_cu = 0;
        hipGetDevice(&dev); hipDeviceGetAttribute(&cus, hipDeviceAttributeMultiprocessorCount, dev);
        if (hipFuncSetAttribute((const void*)fwd_kernel, hipFuncAttributeMaxDynamicSharedMemorySize, LDS_BYTES) != hipSuccess) { fprintf(stderr, "kernel_launch: hipFuncSetAttribute failed\n"); grid = -1; return; }
        if (hipOccupancyMaxActiveBlocksPerMultiprocessor(&per_cu, (const void*)fwd_kernel, 512, LDS_BYTES) != hipSuccess || per_cu < 1) { fprintf(stderr, "kernel_launch: occupancy query failed (%d)\n", per_cu); grid = -1; return; }
        grid = cus * per_cu;
    }
    if (grid < 0) return;
    Args a{};
    for (int i = 0; i < 21; ++i) a.in[i] = (const float*)d_in[i];
    a.out = (float*)d_out; a.ws = (unsigned char*)d_ws;
#if MK_MULTI
    for (int p = 0; p < NPHASE; ++p) { a.ph_lo = p; a.ph_hi = p + 1; hipLaunchKernelGGL(fwd_kernel, dim3(grid), dim3(512), LDS_BYTES, stream, a); }
#else
    a.ph_lo = 0; a.ph_hi = NPHASE;
    if (hipMemsetAsync((char*)d_ws + WS_BAR, 0, 4096 * 4, stream) != hipSuccess) { fprintf(stderr, "kernel_launch: memset failed\n"); return; }
    void* args[] = {&a};
    hipError_t e = hipLaunchCooperativeKernel((void*)fwd_kernel, dim3(grid), dim3(512), args, LDS_BYTES, stream);
    if (e != hipSuccess) fprintf(stderr, "cooperative launch failed: %s (grid %d)\n", hipGetErrorString(e), grid);
#endif
}
```

```cpp
#include <hip/hip_runtime.h>
#include <hip/hip_cooperative_groups.h>
#include <cstdio>
#include <cstdint>
namespace pg8 {
#define PG8_LAS __attribute__((address_space(3)))
typedef unsigned short bf16_t;
typedef short bf16x8 __attribute__((ext_vector_type(8)));
typedef float f32x4 __attribute__((ext_vector_type(4)));
typedef unsigned u32x4 __attribute__((ext_vector_type(4)));
constexpr int BM = 256, BK = 64, HALF = 128, HTB = HALF * BK * 2  , STAGE_BYTES = 8 * HTB, NXCD = 8, WGM = 4;

__host__ __device__ __forceinline__ int lds_byte(int r, int c) { const int st = (r >> 4) * 2 + (c >> 5), rr = r & 15, cc = c & 31, ob = rr * 64 + cc * 2; return st * 1024 + (ob ^ (((ob >> 9) & 1) << 5)); }
__host__ __device__ __forceinline__ void stage_rc(int b, int& R, int& C) { const int st = b / 1024, sb = b % 1024, swz = sb ^ (((sb >> 9) & 1) << 5); R = (st >> 1) * 16 + swz / 64; C = (st & 1) * 32 + (swz % 64) / 2; }
__host__ __device__ __forceinline__ int perm32(int rho) { const int n = rho >> 4, i = rho & 15; return 8 * (i >> 2) + 4 * n + (i & 3); }

struct Unit { int pm, pn; };
struct Gemm { const bf16_t* A; const bf16_t* Bt; int M, N, K; };

struct StaticOrder {
    int nM, nN, nwg, G, c;
    __host__ __device__ void init(int M, int N, int G_, int c_) { nM = M / BM; nN = N / BM; nwg = nM * nN; G = G_; c = c_; }
    __host__ __device__ bool next(int i, Unit& u) const {
        const long L = (long)i * G + c; if (L >= nwg) return false;
        int wgid = (int)L; { const int q = nwg / NXCD, r = nwg % NXCD, xcd = wgid % NXCD, off = wgid / NXCD; wgid = (xcd < r ? xcd * (q + 1) : r * (q + 1) + (xcd - r) * q) + off; }
        const int nig = WGM * nN, gid = wgid / nig, fm = gid * WGM, gsz = (nM - fm) < WGM ? (nM - fm) : WGM;
        u.pm = fm + ((wgid % nig) % gsz); u.pn = (wgid % nig) / gsz; return true;
    }
    __device__ __forceinline__ void a_ready(const Unit&) const {}
    __device__ __forceinline__ void done(const Unit&) const {}
};
typedef float f32x2 __attribute__((ext_vector_type(2)));
template <class Epi, class Sched, bool ALIGN_EPI = false, bool SP2 = false>
__device__ __forceinline__ void gemm_phase(PG8_LAS unsigned char* lds, const Gemm g, const Sched& S, const Epi& E) {
    const int tid = threadIdx.x, wid = __builtin_amdgcn_readfirstlane(tid >> 6), lane = tid & 63, wr = wid >> 2, wc = wid & 3, fr = lane & 15, fq = lane >> 4;
    const int K = g.K, nt = K / BK;
    unsigned voffA[2], voffB[2];
#pragma unroll
    for (int i = 0; i < 2; ++i) { int R, C; stage_rc(tid * 16 + i * 8192, R, C); const int Rb = Epi::PERM ? ((R & ~31) + perm32(R & 31)) : R;
        voffA[i] = (unsigned)(R * K + C) * 2u; voffB[i] = (unsigned)(Rb * K + C) * 2u; }
    const size_t kstep = (size_t)(BK * 2);
    const size_t hstep = (size_t)HALF * K * 2;
    const size_t tstep = 2 * hstep;
    const unsigned ldsw = (unsigned)wid * 1024u;
    const int aoff = lds_byte(wr * 64 + fr, fq * 8), boff = lds_byte(wc * 32 + fr, fq * 8);
#define PG8_SA(b, h) (((b) * 2 + (h)) * HTB)
#define PG8_SB(b, h) ((4 + (b) * 2 + (h)) * HTB)
#define PG8_STAGE(bufoff, gbase, voff) do { _Pragma("unroll") for (int _i = 0; _i < 2; ++_i) \
        __builtin_amdgcn_global_load_lds((const unsigned*)((const char*)(gbase) + (voff)[_i]), (PG8_LAS unsigned*)(lds + (bufoff) + ldsw + _i * 8192), 16, 0, 0); } while (0)
#define PG8_LDA(dst, b, h) do { _Pragma("unroll") for (int m = 0; m < 4; ++m) _Pragma("unroll") for (int k = 0; k < 2; ++k) dst[m][k] = *(const PG8_LAS bf16x8*)(lds + PG8_SA(b, h) + aoff + m * 2048 + k * 1024); } while (0)
#define PG8_LDB(dst, b, h) do { _Pragma("unroll") for (int n = 0; n < 2; ++n) _Pragma("unroll") for (int k = 0; k < 2; ++k) dst[n][k] = *(const PG8_LAS bf16x8*)(lds + PG8_SB(b, h) + boff + n * 2048 + k * 1024); } while (0)
#define PG8_MMA(ai, bj, At, Bt) do { __builtin_amdgcn_s_setprio(1); _Pragma("unroll") for (int m = 0; m < 4; ++m) _Pragma("unroll") for (int n = 0; n < 2; ++n) _Pragma("unroll") for (int k = 0; k < 2; ++k) \
        acc[ai][bj][m][n] = __builtin_amdgcn_mfma_f32_16x16x32_bf16(Bt[n][k], At[m][k], acc[ai][bj][m][n], 0, 0, 0); __builtin_amdgcn_s_setprio(0); } while (0)
#define PG8_WAIT_V(n) asm volatile("s_waitcnt vmcnt(" #n ")" ::: "memory")
#define PG8_WAIT_L(n) asm volatile("s_waitcnt lgkmcnt(" #n ")" ::: "memory")
#define PG8_BAR __builtin_amdgcn_s_barrier()
#define PG8_SCHED __builtin_amdgcn_sched_barrier(0)
    Unit cur, nxt; int ui = 0;
    if (!S.next(0, cur)) return;
    f32x4 acc[2][2][4][2];
#pragma unroll
    for (int a = 0; a < 2; ++a)
#pragma unroll
        for (int b = 0; b < 2; ++b)
#pragma unroll
            for (int m = 0; m < 4; ++m)
#pragma unroll
                for (int n = 0; n < 2; ++n) acc[a][b][m][n] = (f32x4){0.f, 0.f, 0.f, 0.f};
    bf16x8 At[4][2], B0[2][2], B1[2][2];
    const char* cA = (const char*)g.A + (size_t)cur.pm * tstep; const char* cB = (const char*)g.Bt + (size_t)cur.pn * tstep;
    S.a_ready(cur);
    if constexpr (SP2) {
        PG8_STAGE(PG8_SB(0, 0), cB, voffB); PG8_STAGE(PG8_SB(0, 1), cB + hstep, voffB); PG8_STAGE(PG8_SA(0, 0), cA, voffA); PG8_STAGE(PG8_SA(0, 1), cA + hstep, voffA);
        if (wr == 1) PG8_BAR;
        PG8_WAIT_V(2); PG8_BAR;
        PG8_STAGE(PG8_SB(1, 0), cB + kstep, voffB); PG8_STAGE(PG8_SA(1, 0), cA + kstep, voffA); PG8_STAGE(PG8_SB(1, 1), cB + hstep + kstep, voffB);
        PG8_WAIT_V(6); PG8_BAR;
    } else {
        PG8_STAGE(PG8_SB(0, 0), cB, voffB); PG8_STAGE(PG8_SA(0, 0), cA, voffA); PG8_STAGE(PG8_SB(0, 1), cB + hstep, voffB); PG8_STAGE(PG8_SA(0, 1), cA + hstep, voffA);
        if (wr == 1) PG8_BAR;
        PG8_WAIT_V(4); PG8_BAR;
        PG8_STAGE(PG8_SB(1, 0), cB + kstep, voffB); PG8_STAGE(PG8_SA(1, 0), cA + kstep, voffA); PG8_STAGE(PG8_SB(1, 1), cB + hstep + kstep, voffB);
        PG8_WAIT_V(6); PG8_BAR;
    }
    for (;;) {
        const bool has_next = S.next(ui + 1, nxt);
        const char* nA = has_next ? (const char*)g.A + (size_t)nxt.pm * tstep : cA; const char* nB = has_next ? (const char*)g.Bt + (size_t)nxt.pn * tstep : cB;
        for (int t = 0; t < nt; t += 2) {
            const bool last = (t == nt - 2);
            const char* a1 = cA + (size_t)(t + 1) * kstep;
            const char* a2 = last ? nA : cA + (size_t)(t + 2) * kstep; const char* b2 = last ? nB : cB + (size_t)(t + 2) * kstep;
            const char* a3 = a2 + kstep; const char* b3 = b2 + kstep;
            if (last && has_next) S.a_ready(nxt);
            if constexpr (SP2) {
            PG8_LDB(B0, 0, 0); PG8_LDB(B1, 0, 1); PG8_SCHED; PG8_LDA(At, 0, 0); PG8_STAGE(PG8_SA(1, 1), a1 + hstep, voffA);
            PG8_WAIT_V(8); PG8_WAIT_L(0); PG8_BAR; PG8_MMA(0, 0, At, B0); PG8_MMA(0, 1, At, B1); PG8_BAR; PG8_SCHED;
            PG8_LDA(At, 0, 1); PG8_STAGE(PG8_SB(0, 0), b2, voffB); PG8_STAGE(PG8_SB(0, 1), b2 + hstep, voffB); PG8_STAGE(PG8_SA(0, 0), a2, voffA);
            PG8_WAIT_V(8); PG8_WAIT_L(0); PG8_BAR; PG8_MMA(1, 0, At, B0); PG8_MMA(1, 1, At, B1); PG8_BAR; PG8_SCHED;
            PG8_LDB(B0, 1, 0); PG8_LDB(B1, 1, 1); PG8_SCHED; PG8_LDA(At, 1, 0); PG8_STAGE(PG8_SA(0, 1), a2 + hstep, voffA);
            PG8_WAIT_V(8); PG8_WAIT_L(0); PG8_BAR; PG8_MMA(0, 0, At, B0); PG8_MMA(0, 1, At, B1); PG8_BAR; PG8_SCHED;
            PG8_LDA(At, 1, 1); PG8_STAGE(PG8_SB(1, 0), b3, voffB); PG8_STAGE(PG8_SB(1, 1), b3 + hstep, voffB); PG8_STAGE(PG8_SA(1, 0), a3, voffA);
            PG8_WAIT_V(8); PG8_WAIT_L(0); PG8_BAR; PG8_MMA(1, 0, At, B0); PG8_MMA(1, 1, At, B1); PG8_BAR; PG8_SCHED;
            } else {
            PG8_LDB(B0, 0, 0); PG8_SCHED; PG8_LDA(At, 0, 0); PG8_STAGE(PG8_SA(1, 1), a1 + hstep, voffA);
            PG8_WAIT_L(8); PG8_BAR; PG8_WAIT_L(0); PG8_MMA(0, 0, At, B0); PG8_BAR; PG8_SCHED;
            PG8_LDB(B1, 0, 1); PG8_STAGE(PG8_SB(0, 0), b2, voffB);
            PG8_BAR; PG8_WAIT_L(0); PG8_MMA(0, 1, At, B1); PG8_BAR;
            PG8_LDA(At, 0, 1); PG8_STAGE(PG8_SA(0, 0), a2, voffA);
            PG8_BAR; PG8_WAIT_L(0); PG8_MMA(1, 0, At, B0); PG8_BAR; PG8_SCHED;
            PG8_STAGE(PG8_SB(0, 1), b2 + hstep, voffB);
            PG8_WAIT_V(6); PG8_BAR; PG8_MMA(1, 1, At, B1); PG8_BAR;
            PG8_LDB(B0, 1, 0); PG8_SCHED; PG8_LDA(At, 1, 0); PG8_STAGE(PG8_SA(0, 1), a2 + hstep, voffA);
            PG8_WAIT_L(8); PG8_BAR; PG8_WAIT_L(0); PG8_MMA(0, 0, At, B0); PG8_BAR; PG8_SCHED;
            PG8_LDB(B1, 1, 1); PG8_STAGE(PG8_SB(1, 0), b3, voffB);
            PG8_BAR; PG8_WAIT_L(0); PG8_MMA(0, 1, At, B1); PG8_BAR;
            PG8_LDA(At, 1, 1); PG8_STAGE(PG8_SA(1, 0), a3, voffA);
            PG8_BAR; PG8_WAIT_L(0); PG8_MMA(1, 0, At, B0); PG8_BAR; PG8_SCHED;
            PG8_STAGE(PG8_SB(1, 1), b3 + hstep, voffB);
            PG8_WAIT_V(6); PG8_BAR; PG8_MMA(1, 1, At, B1); PG8_BAR;
            }
        }
        if constexpr (ALIGN_EPI) { if (wr == 0) PG8_BAR; }
        if constexpr (!Epi::AFTER_DRAIN) { E(acc, cur, wr, wc, fr, fq); S.done(cur); }
        if (!has_next) break;
#pragma unroll
        for (int a = 0; a < 2; ++a)
#pragma unroll
            for (int b = 0; b < 2; ++b)
#pragma unroll
                for (int m = 0; m < 4; ++m)
#pragma unroll
                    for (int n = 0; n < 2; ++n) acc[a][b][m][n] = (f32x4){0.f, 0.f, 0.f, 0.f};
        cur = nxt; cA = nA; cB = nB; ++ui;
        if constexpr (ALIGN_EPI) { if (wr == 1) PG8_BAR; }
    }
    PG8_WAIT_V(0);
    if constexpr (!ALIGN_EPI) { if (wr == 0) PG8_BAR; }
    PG8_BAR;
    if constexpr (Epi::AFTER_DRAIN) { E.fused(acc, cur, wr, wc, fr, fq, lds, wid, lane); S.done(cur); }
#undef PG8_SA
#undef PG8_SB
#undef PG8_STAGE
#undef PG8_LDA
#undef PG8_LDB
#undef PG8_MMA
#undef PG8_WAIT_V
#undef PG8_WAIT_L
#undef PG8_BAR
#undef PG8_SCHED
}
}

namespace cg = cooperative_groups;
using pg8::bf16_t; using pg8::bf16x8; using pg8::f32x4; using pg8::u32x4; using pg8::Unit;
typedef float f32x2c __attribute__((ext_vector_type(2)));
typedef __bf16 bf16x2c __attribute__((ext_vector_type(2)));
__device__ __forceinline__ unsigned cvt_pk_bf16(float lo, float hi) { const f32x2c v = {lo, hi}; return __builtin_bit_cast(unsigned, __builtin_convertvector(v, bf16x2c)); }
#define LAS __attribute__((address_space(3)))
typedef unsigned u32x2 __attribute__((ext_vector_type(2)));
typedef float f32x2v __attribute__((ext_vector_type(2)));

constexpr int M_TOK = 8192, DM = 2048, FF = 5632, HW = 1024, CW = 1024, MIXIN = 7168, PLE = 256, SEQ = 2048;
constexpr float EPS = 1e-6f;
constexpr size_t MiB = 1ull << 20;
constexpr size_t WS_W1GU = 0, WS_W1D = 44 * MiB, WS_WIN = 66 * MiB, WS_WOUT = 94 * MiB, WS_W2GU = 102 * MiB, WS_W2D = 146 * MiB,
                 WS_WPG = 168 * MiB, WS_WPE = 176 * MiB, WS_PB = 177 * MiB, WS_XB = 181 * MiB, WS_MIX = 213 * MiB, WS_G = 245 * MiB,
                 WS_QS = 245 * MiB, WS_VH = 261 * MiB, WS_GH = 277 * MiB, WS_BC = 293 * MiB, WS_UC = 309 * MiB, WS_LF = 325 * MiB,
                 WS_S = 357 * MiB, WS_PLE = 0, WS_SS = 389 * MiB, WS_DD = 389 * MiB + 512 * 1024, WS_BAR = 390 * MiB + 512 * 1024, WS_END = 391 * MiB, WS_U = 0;
constexpr int LDS_BYTES = 144 * 1024;
constexpr int NPHASE = 12;

__device__ __forceinline__ float bf2f(bf16_t b) { return __uint_as_float(((unsigned)b) << 16); }
__device__ __forceinline__ float bflo(unsigned w) { return __uint_as_float(w << 16); }
__device__ __forceinline__ float bfhi(unsigned w) { return __uint_as_float(w & 0xffff0000u); }
__device__ __forceinline__ float wave_sum(float v) {
#pragma unroll
    for (int o = 1; o < 64; o <<= 1) v += __shfl_xor(v, o);
    return v;
}
__device__ __forceinline__ float fsigmoid(float x) { return __builtin_amdgcn_rcpf(1.0f + __expf(-x)); }
__device__ __forceinline__ float fsilu(float x) { return x * fsigmoid(x); }
__device__ __forceinline__ float rinv_of(float ss) { return rsqrtf(ss * (1.0f / DM) + EPS); }

struct EpiGateUp {
    static constexpr bool PERM = true, AFTER_DRAIN = false;
    bf16_t* G; const float* ss;
    __device__ __forceinline__ void operator()(const f32x4 (&acc)[2][2][4][2], const Unit& u, int wr, int wc, int fr, int fq) const {
        const int row0 = u.pm * 256 + wr * 64 + fr, col0 = u.pn * 128 + wc * 32 + 8 * fq;
#pragma unroll
        for (int ai = 0; ai < 2; ++ai)
#pragma unroll
            for (int m = 0; m < 4; ++m) {
                const int r = row0 + ai * 128 + m * 16; const float ri = rinv_of(ss[r]);
                float v[8];
#pragma unroll
                for (int n = 0; n < 2; ++n)
#pragma unroll
                    for (int j = 0; j < 4; ++j) v[n * 4 + j] = fsilu(acc[ai][0][m][n][j] * ri) * (acc[ai][1][m][n][j] * ri);
                u32x4 w; w.x = cvt_pk_bf16(v[0], v[1]); w.y = cvt_pk_bf16(v[2], v[3]); w.z = cvt_pk_bf16(v[4], v[5]); w.w = cvt_pk_bf16(v[6], v[7]);
                *(u32x4*)(G + (size_t)r * FF + col0) = w;
            }
    }
};
struct EpiResid {
    static constexpr bool PERM = true, AFTER_DRAIN = false;
    bf16_t* XB; float* ss_out; float scale;
    __device__ __forceinline__ void operator()(f32x4 (&acc)[2][2][4][2], const Unit& u, int wr, int wc, int fr, int fq) const {
        const int row0 = u.pm * 256 + wr * 64 + fr, col0 = u.pn * 256 + wc * 32 + 8 * fq;
#pragma unroll
        for (int ai = 0; ai < 2; ++ai) {
#pragma unroll
            for (int m = 0; m < 4; ++m)
#pragma unroll
                for (int bj = 0; bj < 2; ++bj) {
                    const size_t off = (size_t)(row0 + ai * 128 + m * 16) * DM + col0 + bj * 128;
                    const u32x4 xw = *(const u32x4*)(XB + off);
                    f32x4 r0, r1; r0[0] = bflo(xw.x); r0[1] = bfhi(xw.x); r0[2] = bflo(xw.y); r0[3] = bfhi(xw.y); r1[0] = bflo(xw.z); r1[1] = bfhi(xw.z); r1[2] = bflo(xw.w); r1[3] = bfhi(xw.w);
                    acc[ai][bj][m][0] = r0 + acc[ai][bj][m][0] * scale; acc[ai][bj][m][1] = r1 + acc[ai][bj][m][1] * scale;
                }
            asm volatile("" ::: "memory");
#pragma unroll
            for (int m = 0; m < 4; ++m) {
                const int r = row0 + ai * 128 + m * 16; float sq = 0.f;
#pragma unroll
                for (int bj = 0; bj < 2; ++bj) {
                    const size_t off = (size_t)r * DM + col0 + bj * 128;
                    const f32x4 v0 = acc[ai][bj][m][0], v1 = acc[ai][bj][m][1];
                    u32x4 w; w.x = cvt_pk_bf16(v0[0], v0[1]); w.y = cvt_pk_bf16(v0[2], v0[3]); w.z = cvt_pk_bf16(v1[0], v1[1]); w.w = cvt_pk_bf16(v1[2], v1[3]);
                    *(u32x4*)(XB + off) = w;
                    sq += (v0[0] * v0[0] + v0[1] * v0[1]) + (v0[2] * v0[2] + v0[3] * v0[3]) + (v1[0] * v1[0] + v1[1] * v1[1]) + (v1[2] * v1[2] + v1[3] * v1[3]);
                }
                sq += __shfl_xor(sq, 16); sq += __shfl_xor(sq, 32);
                if (fq == 0) atomicAdd(ss_out + r, sq);
            }
            asm volatile("" ::: "memory");
        }
    }
};
struct EpiMixIn {
    static constexpr bool PERM = true, AFTER_DRAIN = false;
    const float* ss; const float* lbl;
    bf16_t *QS, *UC; float* LF;
    __device__ __forceinline__ void operator()(const f32x4 (&acc)[2][2][4][2], const Unit& u, int wr, int wc, int fr, int fq) const {
        const int row0 = u.pm * 256 + wr * 64 + fr; const int sec = u.pn >> 2;
        if (u.pn >= 20) {
            const int col0 = (u.pn - 20) * 128 + wc * 32 + 8 * fq;
#pragma unroll
            for (int ai = 0; ai < 2; ++ai)
#pragma unroll
                for (int m = 0; m < 4; ++m) {
                    const int r = row0 + ai * 128 + m * 16; const float ri = rinv_of(ss[r]); const float ri2 = ri * ri;
                    float v[8];
#pragma unroll
                    for (int n = 0; n < 2; ++n)
#pragma unroll
                        for (int j = 0; j < 4; ++j) v[n * 4 + j] = acc[ai][0][m][n][j] * acc[ai][1][m][n][j] * ri2;
                    u32x4 w; w.x = cvt_pk_bf16(v[0], v[1]); w.y = cvt_pk_bf16(v[2], v[3]); w.z = cvt_pk_bf16(v[4], v[5]); w.w = cvt_pk_bf16(v[6], v[7]);
                    *(u32x4*)(UC + (size_t)r * CW + col0) = w;
                }
            return;
        }
        const int col0 = (u.pn & 3) * 256 + wc * 32 + 8 * fq;
        if (sec == 1) {
#pragma unroll
            for (int bj = 0; bj < 2; ++bj)
#pragma unroll
                for (int n = 0; n < 2; ++n) {
                    const int c = col0 + bj * 128 + 4 * n; const f32x4 l0 = *(const f32x4*)(lbl + c), l1 = *(const f32x4*)(lbl + 1024 + c);
                    f32x4 lb; lb[0] = fsigmoid(l0[0] - l1[0]); lb[1] = fsigmoid(l0[1] - l1[1]); lb[2] = fsigmoid(l0[2] - l1[2]); lb[3] = fsigmoid(l0[3] - l1[3]);
#pragma unroll
                    for (int ai = 0; ai < 2; ++ai)
#pragma unroll
                        for (int m = 0; m < 4; ++m) {
                            const int r = row0 + ai * 128 + m * 16; const float ri = rinv_of(ss[r]);
                            const f32x4 x = acc[ai][bj][m][n]; f32x4 o;
                            o[0] = __logf(lb[0] + (1.0f - lb[0]) * fsigmoid(x[0] * ri)); o[1] = __logf(lb[1] + (1.0f - lb[1]) * fsigmoid(x[1] * ri));
                            o[2] = __logf(lb[2] + (1.0f - lb[2]) * fsigmoid(x[2] * ri)); o[3] = __logf(lb[3] + (1.0f - lb[3]) * fsigmoid(x[3] * ri));
                            *(f32x4*)(LF + (size_t)r * HW + c) = o;
                        }
                }
            return;
        }
        bf16_t* dst = QS + (size_t)(sec == 0 ? 0 : sec - 1) * ((size_t)M_TOK * HW);
        const bool act = (sec == 0 || sec == 3);
#pragma unroll
        for (int ai = 0; ai < 2; ++ai)
#pragma unroll
            for (int m = 0; m < 4; ++m) {
                const int r = row0 + ai * 128 + m * 16; const float ri = rinv_of(ss[r]);
#pragma unroll
                for (int bj = 0; bj < 2; ++bj) {
                    float v[8];
#pragma unroll
                    for (int n = 0; n < 2; ++n)
#pragma unroll
                        for (int j = 0; j < 4; ++j) { const float x = acc[ai][bj][m][n][j] * ri; v[n * 4 + j] = act ? fsilu(x) : x; }
                    u32x4 w; w.x = cvt_pk_bf16(v[0], v[1]); w.y = cvt_pk_bf16(v[2], v[3]); w.z = cvt_pk_bf16(v[4], v[5]); w.w = cvt_pk_bf16(v[6], v[7]);
                    *(u32x4*)(dst + (size_t)r * HW + col0 + bj * 128) = w;
                }
            }
    }
};
struct EpiStoreBf16 {
    static constexpr bool PERM = true, AFTER_DRAIN = false;
    bf16_t* O;
    __device__ __forceinline__ void operator()(const f32x4 (&acc)[2][2][4][2], const Unit& u, int wr, int wc, int fr, int fq) const {
        const int row0 = u.pm * 256 + wr * 64 + fr, col0 = u.pn * 256 + wc * 32 + 8 * fq;
#pragma unroll
        for (int ai = 0; ai < 2; ++ai)
#pragma unroll
            for (int m = 0; m < 4; ++m) {
                const int r = row0 + ai * 128 + m * 16;
#pragma unroll
                for (int bj = 0; bj < 2; ++bj) {
                    const f32x4 v0 = acc[ai][bj][m][0], v1 = acc[ai][bj][m][1];
                    u32x4 w; w.x = cvt_pk_bf16(v0[0], v0[1]); w.y = cvt_pk_bf16(v0[2], v0[3]); w.z = cvt_pk_bf16(v1[0], v1[1]); w.w = cvt_pk_bf16(v1[2], v1[3]);
                    *(u32x4*)(O + (size_t)r * DM + col0 + bj * 128) = w;
                }
            }
    }
};
struct EpiPleGate {
    static constexpr bool PERM = true, AFTER_DRAIN = false;
    const bf16_t* XB; const bf16_t* P; bf16_t* H4; const float* ss;
    __device__ __forceinline__ void operator()(f32x4 (&acc)[2][2][4][2], const Unit& u, int wr, int wc, int fr, int fq) const {
        const int row0 = u.pm * 256 + wr * 64 + fr, col0 = u.pn * 256 + wc * 32 + 8 * fq;
#pragma unroll
        for (int ai = 0; ai < 2; ++ai)
#pragma unroll
            for (int m = 0; m < 4; ++m) {
                const int r = row0 + ai * 128 + m * 16; const float ri = rinv_of(ss[r]);
#pragma unroll
                for (int bj = 0; bj < 2; ++bj) {
                    const size_t off = (size_t)r * DM + col0 + bj * 128;
                    const u32x4 pw = *(const u32x4*)(P + off), xw = *(const u32x4*)(XB + off);
                    const f32x4 a0 = acc[ai][bj][m][0], a1 = acc[ai][bj][m][1];
                    u32x4 w;
                    w.x = cvt_pk_bf16(bflo(xw.x) + fsigmoid(a0[0] * ri) * bflo(pw.x), bfhi(xw.x) + fsigmoid(a0[1] * ri) * bfhi(pw.x));
                    w.y = cvt_pk_bf16(bflo(xw.y) + fsigmoid(a0[2] * ri) * bflo(pw.y), bfhi(xw.y) + fsigmoid(a0[3] * ri) * bfhi(pw.y));
                    w.z = cvt_pk_bf16(bflo(xw.z) + fsigmoid(a1[0] * ri) * bflo(pw.z), bfhi(xw.z) + fsigmoid(a1[1] * ri) * bfhi(pw.z));
                    w.w = cvt_pk_bf16(bflo(xw.w) + fsigmoid(a1[2] * ri) * bflo(pw.w), bfhi(xw.w) + fsigmoid(a1[3] * ri) * bfhi(pw.w));
                    *(u32x4*)(H4 + off) = w;
                }
            }
    }
};

template <int MODE>
__device__ __forceinline__ void p0_item(const float* W, const float* W2, const float* gain, int K, int N, bf16_t* WT, LAS float* scr, int item, int lane) {
    const int nblk_k = K / 64; const int nb = item / nblk_k, kb = item % nblk_k; const int k0 = 64 * kb, n0 = 32 * nb;
    const float* src = W; int c0 = n0;
    if (MODE == 1) { const int t = n0 >> 8, bj = (n0 >> 7) & 1, c = n0 & 127; src = bj ? W2 : W; c0 = 128 * t + c; }
    if (MODE == 2) { if (n0 >= 5120) { const int tt = n0 - 5120; const int t = tt >> 8, bj = (tt >> 7) & 1, c = tt & 127; c0 = 5120 + 1024 * bj + 128 * t + c; } }
    float v[32], gg[32];
    const float* sp = src + (size_t)(k0 + (lane >> 5)) * N + c0 + (lane & 31);
#pragma unroll
    for (int i = 0; i < 32; ++i) v[i] = __builtin_nontemporal_load(sp + (size_t)(2 * i) * N);
    if (gain) {
#pragma unroll
        for (int i = 0; i < 32; ++i) gg[i] = gain[k0 + 2 * i + (lane >> 5)];
#pragma unroll
        for (int i = 0; i < 32; ++i) v[i] *= gg[i];
    }
#pragma unroll
    for (int i = 0; i < 32; ++i) scr[(2 * i + (lane >> 5)) * 33 + (lane & 31)] = v[i];
    asm volatile("s_waitcnt lgkmcnt(0)" ::: "memory");
    const int c = lane & 7;
#pragma unroll
    for (int j = 0; j < 4; ++j) { const int n = (lane >> 3) + 8 * j; const LAS float* s = scr + (8 * c) * 33 + n;
        u32x4 o; o.x = cvt_pk_bf16(s[0 * 33], s[1 * 33]); o.y = cvt_pk_bf16(s[2 * 33], s[3 * 33]); o.z = cvt_pk_bf16(s[4 * 33], s[5 * 33]); o.w = cvt_pk_bf16(s[6 * 33], s[7 * 33]);
        *(u32x4*)(WT + (size_t)(n0 + n) * K + k0 + 8 * c) = o; }
    asm volatile("s_waitcnt lgkmcnt(0)" ::: "memory");
}

struct Args { const float* in[21]; float* out; unsigned char* ws; int ph_lo, ph_hi; };

constexpr int CV_I0 = 32 * 352, CV_I1 = 88 * 64, CV_I2 = 32 * 224, CV_I3 = 32 * 64, CV_I7 = 4 * 64;
constexpr int CV_END = 2 * CV_I0 + 2 * CV_I1 + CV_I2 + 2 * CV_I3 + CV_I7, CV_T1 = CV_END - 10000, CV_T0 = CV_T1 - 10000, CV_TA = CV_I0 + CV_I2 + CV_I3 + CV_I7;
__device__ __forceinline__ void conv_range(const Args& a, LAS unsigned char* lds, int wave, int lane, int lo, int hi, int w0, int nw) {
    unsigned char* ws = a.ws;
    LAS float* scr = (LAS float*)(lds + wave * 16384);
    for (int it = lo + w0; it < hi; it += nw) {
        int r = it;
        if (r < CV_I0) { p0_item<1>(a.in[3], a.in[4], a.in[2], DM, FF, (bf16_t*)(ws + WS_W1GU), scr, r, lane); continue; } r -= CV_I0;
        if (r < CV_I2) { p0_item<2>(a.in[7], nullptr, a.in[6], DM, MIXIN, (bf16_t*)(ws + WS_WIN), scr, r, lane); continue; } r -= CV_I2;
        if (r < CV_I3) { p0_item<0>(a.in[12], nullptr, nullptr, DM, DM, (bf16_t*)(ws + WS_WOUT), scr, r, lane); continue; } r -= CV_I3;
        if (r < CV_I7) { p0_item<0>(a.in[18], nullptr, nullptr, PLE, DM, (bf16_t*)(ws + WS_WPE), scr, r, lane); continue; } r -= CV_I7;
        if (r < CV_I3) { p0_item<0>(a.in[19], nullptr, a.in[17], DM, DM, (bf16_t*)(ws + WS_WPG), scr, r, lane); continue; } r -= CV_I3;
        if (r < CV_I1) { p0_item<0>(a.in[16], nullptr, nullptr, FF, DM, (bf16_t*)(ws + WS_W2D), scr, r, lane); continue; } r -= CV_I1;
        if (r < CV_I0) { p0_item<1>(a.in[14], a.in[15], a.in[13], DM, FF, (bf16_t*)(ws + WS_W2GU), scr, r, lane); continue; } r -= CV_I0;
        p0_item<0>(a.in[5], nullptr, nullptr, FF, DM, (bf16_t*)(ws + WS_W1D), scr, r, lane);
    }
}
__device__ __forceinline__ void conv_tail(const Args& a, LAS unsigned char* lds, int wave, int lane, int nunits, int lo, int hi, int vc) {
    const int r = nunits % (int)gridDim.x;
    if (r == 0) { conv_range(a, lds, wave, lane, lo, hi, vc * 8 + wave, gridDim.x * 8); return; }
    if (vc >= r) conv_range(a, lds, wave, lane, lo, hi, (vc - r) * 8 + wave, ((int)gridDim.x - r) * 8);
}

__device__ __forceinline__ void phase0(const Args& a, LAS unsigned char* lds, int wave, int lane) {
    unsigned char* ws = a.ws;
    const int gw = blockIdx.x * 8 + wave, NGW = gridDim.x * 8;
    conv_range(a, lds, wave, lane, 0, CV_TA, gw, NGW);
    float* SS = (float*)(ws + WS_SS);
    for (int m = gw; m < M_TOK; m += NGW) {
        const f32x4* xr = (const f32x4*)(a.in[0] + (size_t)m * DM) + lane; u32x2* xb = (u32x2*)((bf16_t*)(ws + WS_XB) + (size_t)m * DM) + lane;
        float s = 0.f;
#pragma unroll
        for (int j = 0; j < 8; ++j) { const f32x4 v = __builtin_nontemporal_load(xr + 64 * j); s += (v[0] * v[0] + v[1] * v[1]) + (v[2] * v[2] + v[3] * v[3]);
            u32x2 w; w.x = cvt_pk_bf16(v[0], v[1]); w.y = cvt_pk_bf16(v[2], v[3]); xb[64 * j] = w; }
        s = wave_sum(s);
        if (lane == 0) { SS[m] = s; SS[8192 + m] = 0.f; SS[16384 + m] = 0.f; SS[24576 + m] = 0.f; }
    }
    { const int gt = blockIdx.x * 512 + threadIdx.x, NT = gridDim.x * 512;
      for (int i = gt; i < M_TOK * PLE / 4; i += NT) { const f32x4 v = __builtin_nontemporal_load((const f32x4*)a.in[1] + i); u32x2 w; w.x = cvt_pk_bf16(v[0], v[1]); w.y = cvt_pk_bf16(v[2], v[3]); ((u32x2*)(ws + WS_PB))[i] = w; } }
}

constexpr int HP = 136, VP = 72;
constexpr int L_QT = 0, L_QH = L_QT + 64 * HP * 2, L_KA = L_QH + 64 * HP * 2, L_KB = L_KA + 64 * HP * 2, L_ST = L_KB + 32 * HP * 2, L_VT = L_ST + 128 * HP * 2,
              L_P = L_VT + 128 * VP * 2, L_SEG = L_P + 64 * VP * 2, L_PART = L_SEG + 4 * 128 * 4, L_RINV = L_PART + 8 * 64 * 4, L_HEND = L_RINV + 256, L_KT = 0;
static_assert(L_HEND <= LDS_BYTES, "LDS");
#define MFMA16(a, b, c) __builtin_amdgcn_mfma_f32_16x16x32_bf16((a), (b), (c), 0, 0, 0)
__device__ __forceinline__ bf16_t f2bf(float x) { return (bf16_t)(cvt_pk_bf16(x, 0.f) & 0xffffu); }

#define LDSBAR() do { asm volatile("s_waitcnt lgkmcnt(0)" ::: "memory"); __builtin_amdgcn_s_barrier(); asm volatile("" ::: "memory"); } while (0)
__device__ __forceinline__ void hgrn_pass_a(const Args& a, LAS unsigned char* lds, int wave, int lane) {
    unsigned char* ws = a.ws;
    const float* LF = (const float*)(ws + WS_LF); const bf16_t* VH = (const bf16_t*)(ws + WS_VH); bf16_t* U = (bf16_t*)(ws + WS_U); float* Dd = (float*)(ws + WS_DD);
    const int tid = threadIdx.x, k = tid & 127, sg = tid >> 7, fr = lane & 15, fq = lane >> 4;
    LAS bf16_t* VT = (LAS bf16_t*)(lds + L_VT); LAS bf16_t* KT = (LAS bf16_t*)(lds + L_KT); LAS float* SEG = (LAS float*)(lds + L_SEG);
    float lf[16]; u32x4 vv[2];
#define PA_LOAD(it) do { const int r0_ = ((it) >> 3) * 64, c0_ = ((it) & 7) * 128; \
        _Pragma("unroll") for (int i = 0; i < 16; ++i) lf[i] = LF[(size_t)(r0_ + 16 * sg + i) * HW + c0_ + k]; \
        _Pragma("unroll") for (int j = 0; j < 2; ++j) { const int idx = tid + 512 * j; vv[j] = *(const u32x4*)(VH + (size_t)(r0_ + (idx >> 4)) * HW + c0_ + 8 * (idx & 15)); } } while (0)
    int item = blockIdx.x;
    if (item < 1024) PA_LOAD(item);
    for (; item < 1024; item += gridDim.x) {
        float b[16];
        float run = 0.f;
#pragma unroll
        for (int i = 0; i < 16; ++i) { run += lf[i]; b[i] = run; }
        SEG[sg * 128 + k] = run;
        LDSBAR();
        const float s0 = SEG[k], s1 = SEG[128 + k], s2 = SEG[256 + k], s3 = SEG[384 + k];
        const float pre = sg == 0 ? 0.f : (sg == 1 ? s0 : (sg == 2 ? s0 + s1 : s0 + s1 + s2));
        const float blast = s0 + s1 + s2 + s3;
        unsigned pk[8];
#pragma unroll
        for (int i = 0; i < 8; ++i) {
            const float e0 = (1.0f - __expf(lf[2 * i])) * __expf(blast - (pre + b[2 * i])), e1 = (1.0f - __expf(lf[2 * i + 1])) * __expf(blast - (pre + b[2 * i + 1]));
            pk[i] = cvt_pk_bf16(e0, e1); }
        { u32x4 w0, w1; w0.x = pk[0]; w0.y = pk[1]; w0.z = pk[2]; w0.w = pk[3]; w1.x = pk[4]; w1.y = pk[5]; w1.z = pk[6]; w1.w = pk[7];
          *(LAS u32x4*)(KT + k * VP + 16 * sg) = w0; *(LAS u32x4*)(KT + k * VP + 16 * sg + 8) = w1; }
#pragma unroll
        for (int j = 0; j < 2; ++j) { const int idx = tid + 512 * j, s = idx >> 4, v0 = 8 * (idx & 15);
            VT[(v0 + 0) * VP + s] = (bf16_t)(vv[j].x & 0xffffu); VT[(v0 + 1) * VP + s] = (bf16_t)(vv[j].x >> 16);
            VT[(v0 + 2) * VP + s] = (bf16_t)(vv[j].y & 0xffffu); VT[(v0 + 3) * VP + s] = (bf16_t)(vv[j].y >> 16);
            VT[(v0 + 4) * VP + s] = (bf16_t)(vv[j].z & 0xffffu); VT[(v0 + 5) * VP + s] = (bf16_t)(vv[j].z >> 16);
            VT[(v0 + 6) * VP + s] = (bf16_t)(vv[j].w & 0xffffu); VT[(v0 + 7) * VP + s] = (bf16_t)(vv[j].w >> 16); }
        if (sg == 0) Dd[item * 128 + k] = __expf(blast);
        if (item + (int)gridDim.x < 1024) PA_LOAD(item + (int)gridDim.x);
        LDSBAR();
        const bf16x8 a0 = *(const LAS bf16x8*)(VT + (16 * wave + fr) * VP + fq * 8), a1 = *(const LAS bf16x8*)(VT + (16 * wave + fr) * VP + 32 + fq * 8);
        bf16_t* up = U + (size_t)item * 16384 + (16 * wave + 4 * fq) * 128 + fr;
#pragma unroll
        for (int kt = 0; kt < 8; ++kt) {
            const bf16x8 b0 = *(const LAS bf16x8*)(KT + (16 * kt + fr) * VP + fq * 8), b1 = *(const LAS bf16x8*)(KT + (16 * kt + fr) * VP + 32 + fq * 8);
            f32x4 acc = {0.f, 0.f, 0.f, 0.f};
            acc = MFMA16(a0, b0, acc); acc = MFMA16(a1, b1, acc);
            up[16 * kt] = f2bf(acc[0]); up[16 * kt + 128] = f2bf(acc[1]); up[16 * kt + 256] = f2bf(acc[2]); up[16 * kt + 384] = f2bf(acc[3]);
        }
        LDSBAR();
    }
#undef PA_LOAD
}

__device__ __forceinline__ void hgrn_scan(const Args& a) {
    unsigned char* ws = a.ws;
    const bf16_t* U = (const bf16_t*)(ws + WS_U); const float* Dd = (const float*)(ws + WS_DD); bf16_t* SP = (bf16_t*)(ws + WS_S);
    for (int e = (blockIdx.x * 512 + threadIdx.x) * 4; e < 32 * 16384; e += gridDim.x * 512 * 4) {
        const int bh = e >> 14, vk = e & 16383, bb = bh >> 3, h = bh & 7;
        f32x4 S = {0.f, 0.f, 0.f, 0.f};
#pragma unroll 8
        for (int ci = 0; ci < 32; ++ci) {
            const size_t item = (size_t)((bb * 32 + ci) * 8 + h);
            const u32x2 uw = *(const u32x2*)(U + item * 16384 + vk); f32x4 u; u[0] = bflo(uw.x); u[1] = bfhi(uw.x); u[2] = bflo(uw.y); u[3] = bfhi(uw.y); const f32x4 d = *(const f32x4*)(Dd + item * 128 + (vk & 127));
            u32x2 w; w.x = cvt_pk_bf16(S[0], S[1]); w.y = cvt_pk_bf16(S[2], S[3]); *(u32x2*)(SP + item * 16384 + vk) = w;
            S = d * S + u;
        }
    }
}

__device__ __forceinline__ void conv_mixer(const Args& a, int wave, int lane) {
    unsigned char* ws = a.ws;
    const bf16_t* BC = (const bf16_t*)(ws + WS_BC); const bf16_t* UC = (const bf16_t*)(ws + WS_UC); bf16_t* MIX = (bf16_t*)(ws + WS_MIX);
    const float* cn = a.in[11]; const float* cw = a.in[8];
    const int gw = blockIdx.x * 8 + wave, NGW = gridDim.x * 8;
    for (int it = gw; it < M_TOK * 2; it += NGW) {
        const int row = it >> 1, c = (it & 1) * 512 + lane * 8, t = row & (SEQ - 1);
        const size_t off = (size_t)row * CW + c;
        const u32x4 z = {0u, 0u, 0u, 0u};
        const u32x4 u0 = *(const u32x4*)(UC + off), u1 = t >= 1 ? *(const u32x4*)(UC + off - CW) : z, u2 = t >= 2 ? *(const u32x4*)(UC + off - 2 * CW) : z, bg = *(const u32x4*)(BC + off);
        float y[8]; float ssq = 0.f;
#pragma unroll
        for (int q = 0; q < 4; ++q) {
            const unsigned a0 = u0[q], a1 = u1[q], a2 = u2[q], bb = bg[q]; const int cc = c + 2 * q;
            y[2 * q] = bflo(bb) * (cw[cc] * bflo(a2) + cw[CW + cc] * bflo(a1) + cw[2 * CW + cc] * bflo(a0));
            y[2 * q + 1] = bfhi(bb) * (cw[cc + 1] * bfhi(a2) + cw[CW + cc + 1] * bfhi(a1) + cw[2 * CW + cc + 1] * bfhi(a0));
            ssq += y[2 * q] * y[2 * q] + y[2 * q + 1] * y[2 * q + 1];
        }
        ssq += __shfl_xor(ssq, 1); ssq += __shfl_xor(ssq, 2); ssq += __shfl_xor(ssq, 4); ssq += __shfl_xor(ssq, 8);
        const float ri = rsqrtf(ssq * (1.0f / 128) + EPS);
        u32x4 w;
        w.x = cvt_pk_bf16(y[0] * ri * cn[c], y[1] * ri * cn[c + 1]); w.y = cvt_pk_bf16(y[2] * ri * cn[c + 2], y[3] * ri * cn[c + 3]);
        w.z = cvt_pk_bf16(y[4] * ri * cn[c + 4], y[5] * ri * cn[c + 5]); w.w = cvt_pk_bf16(y[6] * ri * cn[c + 6], y[7] * ri * cn[c + 7]);
        *(u32x4*)(MIX + (size_t)row * DM + HW + c) = w;
    }
}

__device__ __forceinline__ void hgrn_pass_c(const Args& a, LAS unsigned char* lds, int wave, int lane) {
    unsigned char* ws = a.ws;
    const float* LF = (const float*)(ws + WS_LF); const bf16_t* VH = (const bf16_t*)(ws + WS_VH); const bf16_t* QS = (const bf16_t*)(ws + WS_QS); const bf16_t* GH = (const bf16_t*)(ws + WS_GH);
    const bf16_t* SP = (const bf16_t*)(ws + WS_S); bf16_t* MIX = (bf16_t*)(ws + WS_MIX); const float* hn = a.in[10];
    const int tid = threadIdx.x, k = tid & 127, sg = tid >> 7, fr = lane & 15, fq = lane >> 4;
    LAS bf16_t* QT = (LAS bf16_t*)(lds + L_QT); LAS bf16_t* QH = (LAS bf16_t*)(lds + L_QH); LAS bf16_t* KA = (LAS bf16_t*)(lds + L_KA); LAS bf16_t* KB = (LAS bf16_t*)(lds + L_KB);
    LAS bf16_t* ST = (LAS bf16_t*)(lds + L_ST); LAS bf16_t* VT = (LAS bf16_t*)(lds + L_VT); LAS bf16_t* P = (LAS bf16_t*)(lds + L_P);
    LAS float* SEG = (LAS float*)(lds + L_SEG); LAS float* PART = (LAS float*)(lds + L_PART); LAS float* RINV = (LAS float*)(lds + L_RINV);
    float lf[16]; bf16_t qh[16]; u32x4 vv[2], sv[4];
#define PC_LOAD(it) do { const int r0_ = ((it) >> 3) * 64, c0_ = ((it) & 7) * 128; \
        _Pragma("unroll") for (int i = 0; i < 16; ++i) { lf[i] = LF[(size_t)(r0_ + 16 * sg + i) * HW + c0_ + k]; qh[i] = QS[(size_t)(r0_ + 16 * sg + i) * HW + c0_ + k]; } \
        _Pragma("unroll") for (int j = 0; j < 2; ++j) { const int idx = tid + 512 * j; vv[j] = *(const u32x4*)(VH + (size_t)(r0_ + (idx >> 4)) * HW + c0_ + 8 * (idx & 15)); } \
        _Pragma("unroll") for (int j = 0; j < 4; ++j) { const int idx = tid + 512 * j; sv[j] = *(const u32x4*)(SP + (size_t)(it) * 16384 + (idx >> 4) * 128 + 8 * (idx & 15)); } } while (0)
    int item = blockIdx.x;
    if (item < 1024) PC_LOAD(item);
    for (; item < 1024; item += gridDim.x) {
        const int row0 = (item >> 3) * 64, cb = (item & 7) * 128;
        float b[16];
        float run = 0.f;
#pragma unroll
        for (int i = 0; i < 16; ++i) { run += lf[i]; b[i] = run; }
        SEG[sg * 128 + k] = run;
        LDSBAR();
        const float s0 = SEG[k], s1 = SEG[128 + k], s2 = SEG[256 + k];
        const float pre = sg == 0 ? 0.f : (sg == 1 ? s0 : (sg == 2 ? s0 + s1 : s0 + s1 + s2));
        const float beta1 = s0 + s1, beta = sg >= 2 ? beta1 : 0.f;
#pragma unroll
        for (int i = 0; i < 16; ++i) {
            const int s = 16 * sg + i; const float bi = pre + b[i], kk = 1.0f - __expf(lf[i]), qv = bf2f(qh[i]);
            QT[s * HP + k] = f2bf(qv * __expf(bi - beta)); QH[s * HP + k] = f2bf(qv * __expf(bi));
            KA[s * HP + k] = f2bf(kk * __expf(fminf(beta - bi, 80.f)));
            if (sg < 2) KB[s * HP + k] = f2bf(kk * __expf(beta1 - bi));
        }
#pragma unroll
        for (int j = 0; j < 2; ++j) { const int idx = tid + 512 * j, s = idx >> 4, v0 = 8 * (idx & 15);
            VT[(v0 + 0) * VP + s] = (bf16_t)(vv[j].x & 0xffffu); VT[(v0 + 1) * VP + s] = (bf16_t)(vv[j].x >> 16);
            VT[(v0 + 2) * VP + s] = (bf16_t)(vv[j].y & 0xffffu); VT[(v0 + 3) * VP + s] = (bf16_t)(vv[j].y >> 16);
            VT[(v0 + 4) * VP + s] = (bf16_t)(vv[j].z & 0xffffu); VT[(v0 + 5) * VP + s] = (bf16_t)(vv[j].z >> 16);
            VT[(v0 + 6) * VP + s] = (bf16_t)(vv[j].w & 0xffffu); VT[(v0 + 7) * VP + s] = (bf16_t)(vv[j].w >> 16); }
#pragma unroll
        for (int j = 0; j < 4; ++j) { const int idx = tid + 512 * j; *(LAS u32x4*)(ST + (idx >> 4) * HP + 8 * (idx & 15)) = sv[j]; }
        if (item + (int)gridDim.x < 1024) PC_LOAD(item + (int)gridDim.x);
        LDSBAR();
        bf16_t gh[16];
#pragma unroll
        for (int q = 0; q < 16; ++q) gh[q] = GH[(size_t)(row0 + 16 * (q >> 2) + 4 * fq + (q & 3)) * HW + cb + 16 * wave + fr];
#pragma unroll
        for (int pp = 0; pp < 2; ++pp) {
            const int p = wave + 8 * pp, tt = p >> 2, st = p & 3;
            f32x4 acc = {0.f, 0.f, 0.f, 0.f};
            if (st <= tt) {
                const LAS bf16_t* kb = (tt >= 2 && st < 2) ? KB : KA;
#pragma unroll
                for (int ks = 0; ks < 4; ++ks) { const bf16x8 af = *(const LAS bf16x8*)(QT + (16 * tt + fr) * HP + ks * 32 + fq * 8), bfr = *(const LAS bf16x8*)(kb + (16 * st + fr) * HP + ks * 32 + fq * 8);
                    acc = MFMA16(af, bfr, acc); }
            }
#pragma unroll
            for (int r = 0; r < 4; ++r) { const bool keep = (st < tt) || (st == tt && fr <= 4 * fq + r); P[(16 * tt + 4 * fq + r) * VP + 16 * st + fr] = f2bf(keep ? acc[r] : 0.f); }
        }
        LDSBAR();
        bf16x8 bs[4], bv[2];
#pragma unroll
        for (int ks = 0; ks < 4; ++ks) bs[ks] = *(const LAS bf16x8*)(ST + (16 * wave + fr) * HP + ks * 32 + fq * 8);
#pragma unroll
        for (int ks = 0; ks < 2; ++ks) bv[ks] = *(const LAS bf16x8*)(VT + (16 * wave + fr) * VP + ks * 32 + fq * 8);
        f32x4 o[4];
#pragma unroll
        for (int tt = 0; tt < 4; ++tt) {
            f32x4 acc = {0.f, 0.f, 0.f, 0.f};
#pragma unroll
            for (int ks = 0; ks < 4; ++ks) { const bf16x8 af = *(const LAS bf16x8*)(QH + (16 * tt + fr) * HP + ks * 32 + fq * 8); acc = MFMA16(af, bs[ks], acc); }
            { const bf16x8 af = *(const LAS bf16x8*)(P + (16 * tt + fr) * VP + fq * 8); acc = MFMA16(af, bv[0], acc); }
            if (tt >= 2) { const bf16x8 af = *(const LAS bf16x8*)(P + (16 * tt + fr) * VP + 32 + fq * 8); acc = MFMA16(af, bv[1], acc); }
            o[tt] = acc;
        }
#pragma unroll
        for (int tt = 0; tt < 4; ++tt)
#pragma unroll
            for (int r = 0; r < 4; ++r) { float x = o[tt][r] * o[tt][r]; x += __shfl_xor(x, 1); x += __shfl_xor(x, 2); x += __shfl_xor(x, 4); x += __shfl_xor(x, 8);
                if (fr == 0) PART[wave * 64 + 16 * tt + 4 * fq + r] = x; }
        LDSBAR();
        if (tid < 64) { float s = 0.f;
#pragma unroll
            for (int w = 0; w < 8; ++w) s += PART[w * 64 + tid];
            RINV[tid] = rsqrtf(s * (1.0f / 128) + EPS); }
        LDSBAR();
        const float hnv = hn[16 * wave + fr];
#pragma unroll
        for (int tt = 0; tt < 4; ++tt)
#pragma unroll
            for (int r = 0; r < 4; ++r) { const int t = 16 * tt + 4 * fq + r; const size_t row = (size_t)(row0 + t);
                const float g = bf2f(gh[tt * 4 + r]);
                MIX[row * DM + cb + 16 * wave + fr] = f2bf(o[tt][r] * RINV[t] * hnv * g); }
        LDSBAR();
    }
#undef PC_LOAD
}

__device__ __forceinline__ void phase_final(const Args& a, int wave, int lane) {
    const int gw = blockIdx.x * 8 + wave, NGW = gridDim.x * 8; const float* gF = a.in[20]; const bf16_t* H4 = (const bf16_t*)(a.ws + WS_MIX);
    for (int m = gw; m < M_TOK; m += NGW) {
        const u32x4* hr = (const u32x4*)(H4 + (size_t)m * DM) + lane; u32x4 w[4]; float s = 0.f;
#pragma unroll
        for (int j = 0; j < 4; ++j) { w[j] = __builtin_nontemporal_load(hr + 64 * j);
            s += (bflo(w[j].x) * bflo(w[j].x) + bfhi(w[j].x) * bfhi(w[j].x)) + (bflo(w[j].y) * bflo(w[j].y) + bfhi(w[j].y) * bfhi(w[j].y))
               + (bflo(w[j].z) * bflo(w[j].z) + bfhi(w[j].z) * bfhi(w[j].z)) + (bflo(w[j].w) * bflo(w[j].w) + bfhi(w[j].w) * bfhi(w[j].w)); }
        const float ri = rinv_of(wave_sum(s));
        f32x4* orow = (f32x4*)(a.out + (size_t)m * DM);
#pragma unroll
        for (int j = 0; j < 4; ++j) { const int c = (64 * j + lane) * 8; const f32x4 g0 = *(const f32x4*)(gF + c), g1 = *(const f32x4*)(gF + c + 4);
            f32x4 o0, o1; o0[0] = bflo(w[j].x) * ri * g0[0]; o0[1] = bfhi(w[j].x) * ri * g0[1]; o0[2] = bflo(w[j].y) * ri * g0[2]; o0[3] = bfhi(w[j].y) * ri * g0[3];
            o1[0] = bflo(w[j].z) * ri * g1[0]; o1[1] = bfhi(w[j].z) * ri * g1[1]; o1[2] = bflo(w[j].w) * ri * g1[2]; o1[3] = bfhi(w[j].w) * ri * g1[3];
            __builtin_nontemporal_store(o0, orow + c / 4); __builtin_nontemporal_store(o1, orow + c / 4 + 1); }
    }
}

#define XB_TMO      128
#define XB_XCNT(j)  (256  + 64 * (j))
#define XB_XSUB(j)  (1280 + 64 * (j))
#define XB_XGEN(j)  (2304 + 64 * (j))
#define XB_TOP      3328
#define XB_TOPGEN   3392
#define XCD_BAR_WORDS 3456
#define XB_SPIN_CAP (1u << 18)

__device__ __forceinline__ unsigned xb_ld(unsigned* p)              { return __hip_atomic_load(p, __ATOMIC_RELAXED, __HIP_MEMORY_SCOPE_AGENT); }
__device__ __forceinline__ unsigned xb_add(unsigned* p, unsigned v) { return __hip_atomic_fetch_add(p, v, __ATOMIC_RELAXED, __HIP_MEMORY_SCOPE_AGENT); }
__device__ __forceinline__ unsigned xb_xcc_id() { return (unsigned)__builtin_amdgcn_s_getreg((3 << 11) | 20) & 0xFu; }
#define XB_SPIN(cond, bar) do { unsigned _sp = 0; while (cond) { __builtin_amdgcn_s_sleep(1); \
    if ((++_sp & 255u) == 0u) { if (xb_ld(&(bar)[XB_TMO])) break; if (_sp > XB_SPIN_CAP) { atomicAdd(&(bar)[XB_TMO], 1u); break; } } } } while (0)

struct XcdBarrier {
    unsigned* bar; unsigned x;
    volatile LAS unsigned* st;
};

__device__ __forceinline__ XcdBarrier xcd_barrier_post(unsigned* bar, volatile LAS unsigned* st) {
    XcdBarrier b; b.bar = bar; b.x = xb_xcc_id(); b.st = st;
    if (threadIdx.x == 0) (void)xb_add(&bar[XB_XCNT(b.x)], 1u);
    return b;
}
__device__ __forceinline__ void xcd_barrier_complete(unsigned* bar, unsigned x, unsigned& nloc, unsigned& nx) {
    const unsigned G = gridDim.x * gridDim.y * gridDim.z;
    unsigned sum, cnt, mine, sp = 0u;
    for (;;) {
        sum = 0u; cnt = 0u; mine = 0u;
#pragma unroll
        for (unsigned j = 0; j < 16; ++j) { const unsigned c = xb_ld(&bar[XB_XCNT(j)]); sum += c; cnt += (c > 0u) ? 1u : 0u; mine = (j == x) ? c : mine; }
        if (sum == G) break;
        __builtin_amdgcn_s_sleep(1);
        if ((++sp & 255u) == 0u) { if (xb_ld(&bar[XB_TMO])) break; if (sp > XB_SPIN_CAP) { atomicAdd(&bar[XB_TMO], 1u); break; } }
    }
    nloc = mine > 0u ? mine : 1u; nx = cnt > 0u ? cnt : 1u;
}

__device__ __forceinline__ void xcd_barrier(const XcdBarrier& b) {
    asm volatile("s_waitcnt vmcnt(0)" ::: "memory");
    __syncthreads();
    if (threadIdx.x == 0) {
        unsigned* bar = b.bar;
        __builtin_amdgcn_s_waitcnt(0);
        unsigned nloc = b.st[0], nx = b.st[1];
        if (nloc == 0u) { xcd_barrier_complete(bar, b.x, nloc, nx); b.st[0] = nloc; b.st[1] = nx; }
        const unsigned old = xb_add(&bar[XB_XSUB(b.x)], 1u);
        const unsigned gen = old / nloc;
        if (old + 1u == (gen + 1u) * nloc) {
            __builtin_amdgcn_fence(__ATOMIC_RELEASE, "agent");
            asm volatile("s_waitcnt vmcnt(0)" ::: "memory");
            const unsigned og = xb_add(&bar[XB_TOP], 1u);
            const unsigned tg = og / nx;
            if (og + 1u == (tg + 1u) * nx) xb_add(&bar[XB_TOPGEN], 1u);
            else XB_SPIN(xb_ld(&bar[XB_TOPGEN]) == tg, bar);
            __builtin_amdgcn_fence(__ATOMIC_ACQUIRE, "agent");
            xb_add(&bar[XB_XGEN(b.x)], 1u);
            asm volatile("s_waitcnt vmcnt(0)" ::: "memory");
        } else {
            XB_SPIN(xb_ld(&bar[XB_XGEN(b.x)]) == gen, bar);
            __builtin_amdgcn_fence(__ATOMIC_ACQUIRE, "agent");
            asm volatile("s_waitcnt vmcnt(0)" ::: "memory");
        }
    }
    __syncthreads();
}


template <class Epi>
__device__ __forceinline__ void run_gemm(LAS unsigned char* lds, const bf16_t* A, const bf16_t* Bt, int N, int K, const Epi& E, int vc) {
    pg8::Gemm g; g.A = A; g.Bt = Bt; g.M = M_TOK; g.N = N; g.K = K;
    pg8::StaticOrder S; S.init(M_TOK, N, (int)gridDim.x, vc);
    pg8::gemm_phase<Epi, pg8::StaticOrder, true, true>(lds, g, S, E);
}
struct TailOrder {
    int c, n;
    __device__ __forceinline__ bool next(int i, Unit& u) const { if (c < 0) return false; const int L = i * n + c; if (L >= 256) return false; u.pm = L >> 3; u.pn = L & 7; return true; }
    __device__ __forceinline__ void a_ready(const Unit&) const {}
    __device__ __forceinline__ void done(const Unit&) const {}
};

__global__ void __launch_bounds__(512, 2) fwd_kernel(Args a) {
    extern __shared__ __attribute__((aligned(16))) unsigned char lds_raw[];
    LAS unsigned char* lds = (LAS unsigned char*)lds_raw;
    cg::grid_group grid = cg::this_grid();
    volatile LAS unsigned* xst = (volatile LAS unsigned*)(lds + LDS_BYTES - 16);
    if (threadIdx.x < 4) xst[threadIdx.x] = 0u;
    __syncthreads();
    XcdBarrier xbar = xcd_barrier_post((unsigned*)(a.ws + WS_BAR), xst);
    unsigned* cen = (unsigned*)(a.ws + WS_BAR) + 3584;
    if (threadIdx.x == 0) xst[2] = xb_add(&cen[64 * xbar.x], 1u);
    if (a.ph_lo == 0 && a.ph_hi == NPHASE) grid.sync();
    int vc = blockIdx.x;
    if (a.ph_lo == 0 && a.ph_hi == NPHASE && gridDim.x == 256) {
        bool even = true;
#pragma unroll
        for (int j = 0; j < 8; ++j) even = even && (xb_ld(&cen[64 * j]) == 32u);
        if (even) vc = (int)xst[2] * 8 + (int)xbar.x;
    }
    vc = __builtin_amdgcn_readfirstlane(vc);
    const int tid = threadIdx.x, lane = tid & 63, wave = __builtin_amdgcn_readfirstlane(tid >> 6);
    unsigned char* ws = a.ws;
    float* SS = (float*)(ws + WS_SS);
    bf16_t* XB = (bf16_t*)(ws + WS_XB); bf16_t* G = (bf16_t*)(ws + WS_G); bf16_t* MIX = (bf16_t*)(ws + WS_MIX);
#define PH(i) if (a.ph_lo <= (i) && (i) < a.ph_hi)
#define SYNC(i) if (a.ph_lo <= (i) && (i) + 1 < a.ph_hi) { xcd_barrier(xbar); }
    PH(0) { phase0(a, lds, wave, lane); } SYNC(0)
    PH(1) { EpiGateUp E; E.G = G; E.ss = SS; run_gemm(lds, XB, (const bf16_t*)(ws + WS_W1GU), 2 * FF, DM, E, vc); conv_tail(a, lds, wave, lane, 32 * 44, CV_T1, CV_END, vc); } SYNC(1)
    PH(2) { EpiResid E; E.XB = XB; E.ss_out = SS + 8192; E.scale = 0.5f; run_gemm(lds, G, (const bf16_t*)(ws + WS_W1D), DM, FF, E, vc); } SYNC(2)
    PH(3) { EpiMixIn E; E.ss = SS + 8192; E.lbl = a.in[9]; E.QS = (bf16_t*)(ws + WS_QS);
            E.UC = (bf16_t*)(ws + WS_UC); E.LF = (float*)(ws + WS_LF); run_gemm(lds, XB, (const bf16_t*)(ws + WS_WIN), MIXIN, DM, E, vc); conv_tail(a, lds, wave, lane, 32 * 28, CV_T0, CV_T1, vc); } SYNC(3)
    PH(4) { hgrn_pass_a(a, lds, wave, lane); } SYNC(4)
    PH(5) { hgrn_scan(a); conv_mixer(a, wave, lane); } SYNC(5)
    PH(6) { hgrn_pass_c(a, lds, wave, lane); } SYNC(6)
    PH(7) { EpiResid E; E.XB = XB; E.ss_out = SS + 16384; E.scale = 1.0f; run_gemm(lds, MIX, (const bf16_t*)(ws + WS_WOUT), DM, DM, E, vc); } SYNC(7)
    PH(8) { EpiGateUp E; E.G = G; E.ss = SS + 16384; run_gemm(lds, XB, (const bf16_t*)(ws + WS_W2GU), 2 * FF, DM, E, vc);
            { const int r = (32 * 44) % (int)gridDim.x; TailOrder T; T.n = (int)gridDim.x - r; T.c = vc - r;
              EpiStoreBf16 E2; E2.O = (bf16_t*)(ws + WS_PLE); int kp = PLE; asm volatile("" : "+s"(kp));
              pg8::Gemm g2; g2.A = (const bf16_t*)(ws + WS_PB); g2.Bt = (const bf16_t*)(ws + WS_WPE); g2.M = M_TOK; g2.N = DM; g2.K = kp;
              pg8::gemm_phase<EpiStoreBf16, TailOrder, true, true>(lds, g2, T, E2); }
            conv_tail(a, lds, wave, lane, 32 * 44, CV_TA, CV_T0, vc); } SYNC(8)
    PH(9) { EpiResid E; E.XB = XB; E.ss_out = SS + 24576; E.scale = 0.5f; run_gemm(lds, G, (const bf16_t*)(ws + WS_W2D), DM, FF, E, vc); } SYNC(9)
    PH(10) { EpiPleGate E; E.XB = XB; E.H4 = MIX; E.P = (const bf16_t*)(ws + WS_PLE); E.ss = SS + 24576; run_gemm(lds, XB, (const bf16_t*)(ws + WS_WPG), DM, DM, E, vc); } SYNC(10)
    PH(11) { phase_final(a, wave, lane); }
#undef PH
#undef SYNC
}

#ifndef MK_MULTI
#define MK_MULTI 0
#endif
extern "C" void kernel_launch(void* const* d_in, const int* in_sizes, int n_in, void* d_out, int out_size, void* d_ws, size_t ws_size, hipStream_t stream) {
    static int grid = 0;
    if (grid == 0) {
        if (n_in != 21 || out_size != M_TOK * DM || ws_size < WS_END) { fprintf(stderr, "kernel_launch: unexpected shapes (n_in %d out %d ws %zu need %zu)\n", n_in, out_size, ws_size, (size_t)WS_END); grid = -1; return; }
        int dev = 0, cus = 0, per_cu = 0;
        hipGetDevice(&dev); hipDeviceGetAttribute(&cus, hipDeviceAttributeMultiprocessorCount, dev);
        if (hipFuncSetAttribute((const void*)fwd_kernel, hipFuncAttributeMaxDynamicSharedMemorySize, LDS_BYTES) != hipSuccess) { fprintf(stderr, "kernel_launch: hipFuncSetAttribute failed\n"); grid = -1; return; }
        if (hipOccupancyMaxActiveBlocksPerMultiprocessor(&per_cu, (const void*)fwd_kernel, 512, LDS_BYTES) != hipSuccess || per_cu < 1) { fprintf(stderr, "kernel_launch: occupancy query failed (%d)\n", per_cu); grid = -1; return; }
        grid = cus * per_cu;
    }
    if (grid < 0) return;
    Args a{};
    for (int i = 0; i < 21; ++i) a.in[i] = (const float*)d_in[i];
    a.out = (float*)d_out; a.ws = (unsigned char*)d_ws;
#if MK_MULTI
    for (int p = 0; p < NPHASE; ++p) { a.ph_lo = p; a.ph_hi = p + 1; hipLaunchKernelGGL(fwd_kernel, dim3(grid), dim3(512), LDS_BYTES, stream, a); }
#else
    a.ph_lo = 0; a.ph_hi = NPHASE;
    if (hipMemsetAsync((char*)d_ws + WS_BAR, 0, 4096 * 4, stream) != hipSuccess) { fprintf(stderr, "kernel_launch: memset failed\n"); return; }
    void* args[] = {&a};
    hipError_t e = hipLaunchCooperativeKernel((void*)fwd_kernel, dim3(grid), dim3(512), args, LDS_BYTES, stream);
    if (e != hipSuccess) fprintf(stderr, "cooperative launch failed: %s (grid %d)\n", hipGetErrorString(e), grid);
#endif
}
```

```cpp
#include <hip/hip_runtime.h>
#include <hip/hip_cooperative_groups.h>
#include <cstdio>
#include <cstdint>
namespace pg8 {
#define PG8_LAS __attribute__((address_space(3)))
typedef unsigned short bf16_t;
typedef short bf16x8 __attribute__((ext_vector_type(8)));
typedef float f32x4 __attribute__((ext_vector_type(4)));
typedef unsigned u32x4 __attribute__((ext_vector_type(4)));
constexpr int BM = 256, BK = 64, HALF = 128, HTB = HALF * BK * 2  , STAGE_BYTES = 8 * HTB, NXCD = 8, WGM = 4;

__host__ __device__ __forceinline__ int lds_byte(int r, int c) { const int st = (r >> 4) * 2 + (c >> 5), rr = r & 15, cc = c & 31, ob = rr * 64 + cc * 2; return st * 1024 + (ob ^ (((ob >> 9) & 1) << 5)); }
__host__ __device__ __forceinline__ void stage_rc(int b, int& R, int& C) { const int st = b / 1024, sb = b % 1024, swz = sb ^ (((sb >> 9) & 1) << 5); R = (st >> 1) * 16 + swz / 64; C = (st & 1) * 32 + (swz % 64) / 2; }
__host__ __device__ __forceinline__ int perm32(int rho) { const int n = rho >> 4, i = rho & 15; return 8 * (i >> 2) + 4 * n + (i & 3); }

struct Unit { int pm, pn; };
struct Gemm { const bf16_t* A; const bf16_t* Bt; int M, N, K; };

struct StaticOrder {
    int nM, nN, nwg, G, c;
    __host__ __device__ void init(int M, int N, int G_, int c_) { nM = M / BM; nN = N / BM; nwg = nM * nN; G = G_; c = c_; }
    __host__ __device__ bool next(int i, Unit& u) const {
        const long L = (long)i * G + c; if (L >= nwg) return false;
        int wgid = (int)L; { const int q = nwg / NXCD, r = nwg % NXCD, xcd = wgid % NXCD, off = wgid / NXCD; wgid = (xcd < r ? xcd * (q + 1) : r * (q + 1) + (xcd - r) * q) + off; }
        const int nig = WGM * nN, gid = wgid / nig, fm = gid * WGM, gsz = (nM - fm) < WGM ? (nM - fm) : WGM;
        u.pm = fm + ((wgid % nig) % gsz); u.pn = (wgid % nig) / gsz; return true;
    }
    __device__ __forceinline__ void a_ready(const Unit&) const {}
    __device__ __forceinline__ void done(const Unit&) const {}
};
typedef float f32x2 __attribute__((ext_vector_type(2)));
template <class Epi, class Sched, bool ALIGN_EPI = false, bool SP2 = false>
__device__ __forceinline__ void gemm_phase(PG8_LAS unsigned char* lds, const Gemm g, const Sched& S, const Epi& E) {
    const int tid = threadIdx.x, wid = __builtin_amdgcn_readfirstlane(tid >> 6), lane = tid & 63, wr = wid >> 2, wc = wid & 3, fr = lane & 15, fq = lane >> 4;
    const int K = g.K, nt = K / BK;
    unsigned voffA[2], voffB[2];
#pragma unroll
    for (int i = 0; i < 2; ++i) { int R, C; stage_rc(tid * 16 + i * 8192, R, C); const int Rb = Epi::PERM ? ((R & ~31) + perm32(R & 31)) : R;
        voffA[i] = (unsigned)(R * K + C) * 2u; voffB[i] = (unsigned)(Rb * K + C) * 2u; }
    const size_t kstep = (size_t)(BK * 2);
    const size_t hstep = (size_t)HALF * K * 2;
    const size_t tstep = 2 * hstep;
    const unsigned ldsw = (unsigned)wid * 1024u;
    const int aoff = lds_byte(wr * 64 + fr, fq * 8), boff = lds_byte(wc * 32 + fr, fq * 8);
#define PG8_SA(b, h) (((b) * 2 + (h)) * HTB)
#define PG8_SB(b, h) ((4 + (b) * 2 + (h)) * HTB)
#define PG8_STAGE(bufoff, gbase, voff) do { _Pragma("unroll") for (int _i = 0; _i < 2; ++_i) \
        __builtin_amdgcn_global_load_lds((const unsigned*)((const char*)(gbase) + (voff)[_i]), (PG8_LAS unsigned*)(lds + (bufoff) + ldsw + _i * 8192), 16, 0, 0); } while (0)
#define PG8_LDA(dst, b, h) do { _Pragma("unroll") for (int m = 0; m < 4; ++m) _Pragma("unroll") for (int k = 0; k < 2; ++k) dst[m][k] = *(const PG8_LAS bf16x8*)(lds + PG8_SA(b, h) + aoff + m * 2048 + k * 1024); } while (0)
#define PG8_LDB(dst, b, h) do { _Pragma("unroll") for (int n = 0; n < 2; ++n) _Pragma("unroll") for (int k = 0; k < 2; ++k) dst[n][k] = *(const PG8_LAS bf16x8*)(lds + PG8_SB(b, h) + boff + n * 2048 + k * 1024); } while (0)
#define PG8_MMA(ai, bj, At, Bt) do { __builtin_amdgcn_s_setprio(1); _Pragma("unroll") for (int m = 0; m < 4; ++m) _Pragma("unroll") for (int n = 0; n < 2; ++n) _Pragma("unroll") for (int k = 0; k < 2; ++k) \
        acc[ai][bj][m][n] = __builtin_amdgcn_mfma_f32_16x16x32_bf16(Bt[n][k], At[m][k], acc[ai][bj][m][n], 0, 0, 0); __builtin_amdgcn_s_setprio(0); } while (0)
#define PG8_WAIT_V(n) asm volatile("s_waitcnt vmcnt(" #n ")" ::: "memory")
#define PG8_WAIT_L(n) asm volatile("s_waitcnt lgkmcnt(" #n ")" ::: "memory")
#define PG8_BAR __builtin_amdgcn_s_barrier()
#define PG8_SCHED __builtin_amdgcn_sched_barrier(0)
    Unit cur, nxt; int ui = 0;
    if (!S.next(0, cur)) return;
    f32x4 acc[2][2][4][2];
#pragma unroll
    for (int a = 0; a < 2; ++a)
#pragma unroll
        for (int b = 0; b < 2; ++b)
#pragma unroll
            for (int m = 0; m < 4; ++m)
#pragma unroll
                for (int n = 0; n < 2; ++n) acc[a][b][m][n] = (f32x4){0.f, 0.f, 0.f, 0.f};
    bf16x8 At[4][2], B0[2][2], B1[2][2];
    const char* cA = (const char*)g.A + (size_t)cur.pm * tstep; const char* cB = (const char*)g.Bt + (size_t)cur.pn * tstep;
    S.a_ready(cur);
    if constexpr (SP2) {
        PG8_STAGE(PG8_SB(0, 0), cB, voffB); PG8_STAGE(PG8_SB(0, 1), cB + hstep, voffB); PG8_STAGE(PG8_SA(0, 0), cA, voffA); PG8_STAGE(PG8_SA(0, 1), cA + hstep, voffA);
        if (wr == 1) PG8_BAR;
        PG8_WAIT_V(2); PG8_BAR;
        PG8_STAGE(PG8_SB(1, 0), cB + kstep, voffB); PG8_STAGE(PG8_SA(1, 0), cA + kstep, voffA); PG8_STAGE(PG8_SB(1, 1), cB + hstep + kstep, voffB);
        PG8_WAIT_V(6); PG8_BAR;
    } else {
        PG8_STAGE(PG8_SB(0, 0), cB, voffB); PG8_STAGE(PG8_SA(0, 0), cA, voffA); PG8_STAGE(PG8_SB(0, 1), cB + hstep, voffB); PG8_STAGE(PG8_SA(0, 1), cA + hstep, voffA);
        if (wr == 1) PG8_BAR;
        PG8_WAIT_V(4); PG8_BAR;
        PG8_STAGE(PG8_SB(1, 0), cB + kstep, voffB); PG8_STAGE(PG8_SA(1, 0), cA + kstep, voffA); PG8_STAGE(PG8_SB(1, 1), cB + hstep + kstep, voffB);
        PG8_WAIT_V(6); PG8_BAR;
    }
    for (;;) {
        const bool has_next = S.next(ui + 1, nxt);
        const char* nA = has_next ? (const char*)g.A + (size_t)nxt.pm * tstep : cA; const char* nB = has_next ? (const char*)g.Bt + (size_t)nxt.pn * tstep : cB;
        for (int t = 0; t < nt; t += 2) {
            const bool last = (t == nt - 2);
            const char* a1 = cA + (size_t)(t + 1) * kstep;
            const char* a2 = last ? nA : cA + (size_t)(t + 2) * kstep; const char* b2 = last ? nB : cB + (size_t)(t + 2) * kstep;
            const char* a3 = a2 + kstep; const char* b3 = b2 + kstep;
            if (last && has_next) S.a_ready(nxt);
            if constexpr (SP2) {
            PG8_LDB(B0, 0, 0); PG8_LDB(B1, 0, 1); PG8_SCHED; PG8_LDA(At, 0, 0); PG8_STAGE(PG8_SA(1, 1), a1 + hstep, voffA);
            PG8_WAIT_V(8); PG8_WAIT_L(0); PG8_BAR; PG8_MMA(0, 0, At, B0); PG8_MMA(0, 1, At, B1); PG8_BAR; PG8_SCHED;
            PG8_LDA(At, 0, 1); PG8_STAGE(PG8_SB(0, 0), b2, voffB); PG8_STAGE(PG8_SB(0, 1), b2 + hstep, voffB); PG8_STAGE(PG8_SA(0, 0), a2, voffA);
            PG8_WAIT_V(8); PG8_WAIT_L(0); PG8_BAR; PG8_MMA(1, 0, At, B0); PG8_MMA(1, 1, At, B1); PG8_BAR; PG8_SCHED;
            PG8_LDB(B0, 1, 0); PG8_LDB(B1, 1, 1); PG8_SCHED; PG8_LDA(At, 1, 0); PG8_STAGE(PG8_SA(0, 1), a2 + hstep, voffA);
            PG8_WAIT_V(8); PG8_WAIT_L(0); PG8_BAR; PG8_MMA(0, 0, At, B0); PG8_MMA(0, 1, At, B1); PG8_BAR; PG8_SCHED;
            PG8_LDA(At, 1, 1); PG8_STAGE(PG8_SB(1, 0), b3, voffB); PG8_STAGE(PG8_SB(1, 1), b3 + hstep, voffB); PG8_STAGE(PG8_SA(1, 0), a3, voffA);
            PG8_WAIT_V(8); PG8_WAIT_L(0); PG8_BAR; PG8_MMA(1, 0, At, B0); PG8_MMA(1, 1, At, B1); PG8_BAR; PG8_SCHED;
            } else {
            PG8_LDB(B0, 0, 0); PG8_SCHED; PG8_LDA(At, 0, 0); PG8_STAGE(PG8_SA(1, 1), a1 + hstep, voffA);
            PG8_WAIT_L(8); PG8_BAR; PG8_WAIT_L(0); PG8_MMA(0, 0, At, B0); PG8_BAR; PG8_SCHED;
            PG8_LDB(B1, 0, 1); PG8_STAGE(PG8_SB(0, 0), b2, voffB);
            PG8_BAR; PG8_WAIT_L(0); PG8_MMA(0, 1, At, B1); PG8_BAR;
            PG8_LDA(At, 0, 1); PG8_STAGE(PG8_SA(0, 0), a2, voffA);
            PG8_BAR; PG8_WAIT_L(0); PG8_MMA(1, 0, At, B0); PG8_BAR; PG8_SCHED;
            PG8_STAGE(PG8_SB(0, 1), b2 + hstep, voffB);
            PG8_WAIT_V(6); PG8_BAR; PG8_MMA(1, 1, At, B1); PG8_BAR;
            PG8_LDB(B0, 1, 0); PG8_SCHED; PG8_LDA(At, 1, 0); PG8_STAGE(PG8_SA(0, 1), a2 + hstep, voffA);
            PG8_WAIT_L(8); PG8_BAR; PG8_WAIT_L(0); PG8_MMA(0, 0, At, B0); PG8_BAR; PG8_SCHED;
            PG8_LDB(B1, 1, 1); PG8_STAGE(PG8_SB(1, 0), b3, voffB);
            PG8_BAR; PG8_WAIT_L(0); PG8_MMA(0, 1, At, B1); PG8_BAR;
            PG8_LDA(At, 1, 1); PG8_STAGE(PG8_SA(1, 0), a3, voffA);
            PG8_BAR; PG8_WAIT_L(0); PG8_MMA(1, 0, At, B0); PG8_BAR; PG8_SCHED;
            PG8_STAGE(PG8_SB(1, 1), b3 + hstep, voffB);
            PG8_WAIT_V(6); PG8_BAR; PG8_MMA(1, 1, At, B1); PG8_BAR;
            }
        }
        if constexpr (ALIGN_EPI) { if (wr == 0) PG8_BAR; }
        if constexpr (!Epi::AFTER_DRAIN) { E(acc, cur, wr, wc, fr, fq); S.done(cur); }
        if (!has_next) break;
#pragma unroll
        for (int a = 0; a < 2; ++a)
#pragma unroll
            for (int b = 0; b < 2; ++b)
#pragma unroll
                for (int m = 0; m < 4; ++m)
#pragma unroll
                    for (int n = 0; n < 2; ++n) acc[a][b][m][n] = (f32x4){0.f, 0.f, 0.f, 0.f};
        cur = nxt; cA = nA; cB = nB; ++ui;
        if constexpr (ALIGN_EPI) { if (wr == 1) PG8_BAR; }
    }
    PG8_WAIT_V(0);
    if constexpr (!ALIGN_EPI) { if (wr == 0) PG8_BAR; }
    PG8_BAR;
    if constexpr (Epi::AFTER_DRAIN) { E.fused(acc, cur, wr, wc, fr, fq, lds, wid, lane); S.done(cur); }
#undef PG8_SA
#undef PG8_SB
#undef PG8_STAGE
#undef PG8_LDA
#undef PG8_LDB
#undef PG8_MMA
#undef PG8_WAIT_V
#undef PG8_WAIT_L
#undef PG8_BAR
#undef PG8_SCHED
}
}

namespace cg = cooperative_groups;
using pg8::bf16_t; using pg8::bf16x8; using pg8::f32x4; using pg8::u32x4; using pg8::Unit;
typedef float f32x2c __attribute__((ext_vector_type(2)));
typedef __bf16 bf16x2c __attribute__((ext_vector_type(2)));
__device__ __forceinline__ unsigned cvt_pk_bf16(float lo, float hi) { const f32x2c v = {lo, hi}; return __builtin_bit_cast(unsigned, __builtin_convertvector(v, bf16x2c)); }
#define LAS __attribute__((address_space(3)))
typedef unsigned u32x2 __attribute__((ext_vector_type(2)));
typedef float f32x2v __attribute__((ext_vector_type(2)));

constexpr int M_TOK = 8192, DM = 2048, FF = 5632, HW = 1024, CW = 1024, MIXIN = 7168, PLE = 256, SEQ = 2048;
constexpr float EPS = 1e-6f;
constexpr size_t MiB = 1ull << 20;
constexpr size_t WS_W1GU = 0, WS_W1D = 44 * MiB, WS_WIN = 66 * MiB, WS_WOUT = 94 * MiB, WS_W2GU = 102 * MiB, WS_W2D = 146 * MiB,
                 WS_WPG = 168 * MiB, WS_WPE = 176 * MiB, WS_PB = 177 * MiB, WS_XB = 181 * MiB, WS_MIX = 213 * MiB, WS_G = 245 * MiB,
                 WS_QS = 245 * MiB, WS_VH = 261 * MiB, WS_GH = 277 * MiB, WS_BC = 293 * MiB, WS_UC = 309 * MiB, WS_LF = 325 * MiB,
                 WS_S = 357 * MiB, WS_PLE = 0, WS_SS = 389 * MiB, WS_DD = 389 * MiB + 512 * 1024, WS_BAR = 390 * MiB + 512 * 1024, WS_END = 391 * MiB, WS_U = 0;
constexpr int LDS_BYTES = 144 * 1024;
constexpr int NPHASE = 12;

__device__ __forceinline__ float bf2f(bf16_t b) { return __uint_as_float(((unsigned)b) << 16); }
__device__ __forceinline__ float bflo(unsigned w) { return __uint_as_float(w << 16); }
__device__ __forceinline__ float bfhi(unsigned w) { return __uint_as_float(w & 0xffff0000u); }
__device__ __forceinline__ float wave_sum(float v) {
#pragma unroll
    for (int o = 1; o < 64; o <<= 1) v += __shfl_xor(v, o);
    return v;
}
__device__ __forceinline__ float fsigmoid(float x) { return __builtin_amdgcn_rcpf(1.0f + __expf(-x)); }
__device__ __forceinline__ float fsilu(float x) { return x * fsigmoid(x); }
__device__ __forceinline__ float rinv_of(float ss) { return rsqrtf(ss * (1.0f / DM) + EPS); }

struct EpiGateUp {
    static constexpr bool PERM = true, AFTER_DRAIN = false;
    bf16_t* G; const float* ss;
    __device__ __forceinline__ void operator()(const f32x4 (&acc)[2][2][4][2], const Unit& u, int wr, int wc, int fr, int fq) const {
        const int row0 = u.pm * 256 + wr * 64 + fr, col0 = u.pn * 128 + wc * 32 + 8 * fq;
#pragma unroll
        for (int ai = 0; ai < 2; ++ai)
#pragma unroll
            for (int m = 0; m < 4; ++m) {
                const int r = row0 + ai * 128 + m * 16; const float ri = rinv_of(ss[r]);
                float v[8];
#pragma unroll
                for (int n = 0; n < 2; ++n)
#pragma unroll
                    for (int j = 0; j < 4; ++j) v[n * 4 + j] = fsilu(acc[ai][0][m][n][j] * ri) * (acc[ai][1][m][n][j] * ri);
                u32x4 w; w.x = cvt_pk_bf16(v[0], v[1]); w.y = cvt_pk_bf16(v[2], v[3]); w.z = cvt_pk_bf16(v[4], v[5]); w.w = cvt_pk_bf16(v[6], v[7]);
                *(u32x4*)(G + (size_t)r * FF + col0) = w;
            }
    }
};
struct EpiResid {
    static constexpr bool PERM = true, AFTER_DRAIN = false;
    bf16_t* XB; float* ss_out; float scale;
    __device__ __forceinline__ void operator()(f32x4 (&acc)[2][2][4][2], const Unit& u, int wr, int wc, int fr, int fq) const {
        const int row0 = u.pm * 256 + wr * 64 + fr, col0 = u.pn * 256 + wc * 32 + 8 * fq;
#pragma unroll
        for (int ai = 0; ai < 2; ++ai) {
#pragma unroll
            for (int m = 0; m < 4; ++m)
#pragma unroll
                for (int bj = 0; bj < 2; ++bj) {
                    const size_t off = (size_t)(row0 + ai * 128 + m * 16) * DM + col0 + bj * 128;
                    const u32x4 xw = *(const u32x4*)(XB + off);
                    f32x4 r0, r1; r0[0] = bflo(xw.x); r0[1] = bfhi(xw.x); r0[2] = bflo(xw.y); r0[3] = bfhi(xw.y); r1[0] = bflo(xw.z); r1[1] = bfhi(xw.z); r1[2] = bflo(xw.w); r1[3] = bfhi(xw.w);
                    acc[ai][bj][m][0] = r0 + acc[ai][bj][m][0] * scale; acc[ai][bj][m][1] = r1 + acc[ai][bj][m][1] * scale;
                }
            asm volatile("" ::: "memory");
#pragma unroll
            for (int m = 0; m < 4; ++m) {
                const int r = row0 + ai * 128 + m * 16; float sq = 0.f;
#pragma unroll
                for (int bj = 0; bj < 2; ++bj) {
                    const size_t off = (size_t)r * DM + col0 + bj * 128;
                    const f32x4 v0 = acc[ai][bj][m][0], v1 = acc[ai][bj][m][1];
                    u32x4 w; w.x = cvt_pk_bf16(v0[0], v0[1]); w.y = cvt_pk_bf16(v0[2], v0[3]); w.z = cvt_pk_bf16(v1[0], v1[1]); w.w = cvt_pk_bf16(v1[2], v1[3]);
                    *(u32x4*)(XB + off) = w;
                    sq += (v0[0] * v0[0] + v0[1] * v0[1]) + (v0[2] * v0[2] + v0[3] * v0[3]) + (v1[0] * v1[0] + v1[1] * v1[1]) + (v1[2] * v1[2] + v1[3] * v1[3]);
                }
                sq += __shfl_xor(sq, 16); sq += __shfl_xor(sq, 32);
                if (fq == 0) atomicAdd(ss_out + r, sq);
            }
            asm volatile("" ::: "memory");
        }
    }
};
struct EpiMixIn {
    static constexpr bool PERM = true, AFTER_DRAIN = false;
    const float* ss; const float* lbl;
    bf16_t *QS, *UC; float* LF;
    __device__ __forceinline__ void operator()(const f32x4 (&acc)[2][2][4][2], const Unit& u, int wr, int wc, int fr, int fq) const {
        const int row0 = u.pm * 256 + wr * 64 + fr; const int sec = u.pn >> 2;
        if (u.pn >= 20) {
            const int col0 = (u.pn - 20) * 128 + wc * 32 + 8 * fq;
#pragma unroll
            for (int ai = 0; ai < 2; ++ai)
#pragma unroll
                for (int m = 0; m < 4; ++m) {
                    const int r = row0 + ai * 128 + m * 16; const float ri = rinv_of(ss[r]); const float ri2 = ri * ri;
                    float v[8];
#pragma unroll
                    for (int n = 0; n < 2; ++n)
#pragma unroll
                        for (int j = 0; j < 4; ++j) v[n * 4 + j] = acc[ai][0][m][n][j] * acc[ai][1][m][n][j] * ri2;
                    u32x4 w; w.x = cvt_pk_bf16(v[0], v[1]); w.y = cvt_pk_bf16(v[2], v[3]); w.z = cvt_pk_bf16(v[4], v[5]); w.w = cvt_pk_bf16(v[6], v[7]);
                    *(u32x4*)(UC + (size_t)r * CW + col0) = w;
                }
            return;
        }
        const int col0 = (u.pn & 3) * 256 + wc * 32 + 8 * fq;
        if (sec == 1) {
#pragma unroll
            for (int bj = 0; bj < 2; ++bj)
#pragma unroll
                for (int n = 0; n < 2; ++n) {
                    const int c = col0 + bj * 128 + 4 * n; const f32x4 l0 = *(const f32x4*)(lbl + c), l1 = *(const f32x4*)(lbl + 1024 + c);
                    f32x4 lb; lb[0] = fsigmoid(l0[0] - l1[0]); lb[1] = fsigmoid(l0[1] - l1[1]); lb[2] = fsigmoid(l0[2] - l1[2]); lb[3] = fsigmoid(l0[3] - l1[3]);
#pragma unroll
                    for (int ai = 0; ai < 2; ++ai)
#pragma unroll
                        for (int m = 0; m < 4; ++m) {
                            const int r = row0 + ai * 128 + m * 16; const float ri = rinv_of(ss[r]);
                            const f32x4 x = acc[ai][bj][m][n]; f32x4 o;
                            o[0] = __logf(lb[0] + (1.0f - lb[0]) * fsigmoid(x[0] * ri)); o[1] = __logf(lb[1] + (1.0f - lb[1]) * fsigmoid(x[1] * ri));
                            o[2] = __logf(lb[2] + (1.0f - lb[2]) * fsigmoid(x[2] * ri)); o[3] = __logf(lb[3] + (1.0f - lb[3]) * fsigmoid(x[3] * ri));
                            *(f32x4*)(LF + (size_t)r * HW + c) = o;
                        }
                }
            return;
        }
        bf16_t* dst = QS + (size_t)(sec == 0 ? 0 : sec - 1) * ((size_t)M_TOK * HW);
        const bool act = (sec == 0 || sec == 3);
#pragma unroll
        for (int ai = 0; ai < 2; ++ai)
#pragma unroll
            for (int m = 0; m < 4; ++m) {
                const int r = row0 + ai * 128 + m * 16; const float ri = rinv_of(ss[r]);
#pragma unroll
                for (int bj = 0; bj < 2; ++bj) {
                    float v[8];
#pragma unroll
                    for (int n = 0; n < 2; ++n)
#pragma unroll
                        for (int j = 0; j < 4; ++j) { const float x = acc[ai][bj][m][n][j] * ri; v[n * 4 + j] = act ? fsilu(x) : x; }
                    u32x4 w; w.x = cvt_pk_bf16(v[0], v[1]); w.y = cvt_pk_bf16(v[2], v[3]); w.z = cvt_pk_bf16(v[4], v[5]); w.w = cvt_pk_bf16(v[6], v[7]);
                    *(u32x4*)(dst + (size_t)r * HW + col0 + bj * 128) = w;
                }
            }
    }
};
struct EpiStoreBf16 {
    static constexpr bool PERM = true, AFTER_DRAIN = false;
    bf16_t* O;
    __device__ __forceinline__ void operator()(const f32x4 (&acc)[2][2][4][2], const Unit& u, int wr, int wc, int fr, int fq) const {
        const int row0 = u.pm * 256 + wr * 64 + fr, col0 = u.pn * 256 + wc * 32 + 8 * fq;
#pragma unroll
        for (int ai = 0; ai < 2; ++ai)
#pragma unroll
            for (int m = 0; m < 4; ++m) {
                const int r = row0 + ai * 128 + m * 16;
#pragma unroll
                for (int bj = 0; bj < 2; ++bj) {
                    const f32x4 v0 = acc[ai][bj][m][0], v1 = acc[ai][bj][m][1];
                    u32x4 w; w.x = cvt_pk_bf16(v0[0], v0[1]); w.y = cvt_pk_bf16(v0[2], v0[3]); w.z = cvt_pk_bf16(v1[0], v1[1]); w.w = cvt_pk_bf16(v1[2], v1[3]);
                    *(u32x4*)(O + (size_t)r * DM + col0 + bj * 128) = w;
                }
            }
    }
};
struct EpiPleGate {
    static constexpr bool PERM = true, AFTER_DRAIN = false;
    const bf16_t* XB; const bf16_t* P; bf16_t* H4; const float* ss;
    __device__ __forceinline__ void operator()(f32x4 (&acc)[2][2][4][2], const Unit& u, int wr, int wc, int fr, int fq) const {
        const int row0 = u.pm * 256 + wr * 64 + fr, col0 = u.pn * 256 + wc * 32 + 8 * fq;
#pragma unroll
        for (int ai = 0; ai < 2; ++ai)
#pragma unroll
            for (int m = 0; m < 4; ++m) {
                const int r = row0 + ai * 128 + m * 16; const float ri = rinv_of(ss[r]);
#pragma unroll
                for (int bj = 0; bj < 2; ++bj) {
                    const size_t off = (size_t)r * DM + col0 + bj * 128;
                    const u32x4 pw = *(const u32x4*)(P + off), xw = *(const u32x4*)(XB + off);
                    const f32x4 a0 = acc[ai][bj][m][0], a1 = acc[ai][bj][m][1];
                    u32x4 w;
                    w.x = cvt_pk_bf16(bflo(xw.x) + fsigmoid(a0[0] * ri) * bflo(pw.x), bfhi(xw.x) + fsigmoid(a0[1] * ri) * bfhi(pw.x));
                    w.y = cvt_pk_bf16(bflo(xw.y) + fsigmoid(a0[2] * ri) * bflo(pw.y), bfhi(xw.y) + fsigmoid(a0[3] * ri) * bfhi(pw.y));
                    w.z = cvt_pk_bf16(bflo(xw.z) + fsigmoid(a1[0] * ri) * bflo(pw.z), bfhi(xw.z) + fsigmoid(a1[1] * ri) * bfhi(pw.z));
                    w.w = cvt_pk_bf16(bflo(xw.w) + fsigmoid(a1[2] * ri) * bflo(pw.w), bfhi(xw.w) + fsigmoid(a1[3] * ri) * bfhi(pw.w));
                    *(u32x4*)(H4 + off) = w;
                }
            }
    }
};

template <int MODE>
__device__ __forceinline__ void p0_item(const float* W, const float* W2, const float* gain, int K, int N, bf16_t* WT, LAS float* scr, int item, int lane) {
    const int nblk_k = K / 64; const int nb = item / nblk_k, kb = item % nblk_k; const int k0 = 64 * kb, n0 = 32 * nb;
    const float* src = W; int c0 = n0;
    if (MODE == 1) { const int t = n0 >> 8, bj = (n0 >> 7) & 1, c = n0 & 127; src = bj ? W2 : W; c0 = 128 * t + c; }
    if (MODE == 2) { if (n0 >= 5120) { const int tt = n0 - 5120; const int t = tt >> 8, bj = (tt >> 7) & 1, c = tt & 127; c0 = 5120 + 1024 * bj + 128 * t + c; } }
    float v[32], gg[32];
    const float* sp = src + (size_t)(k0 + (lane >> 5)) * N + c0 + (lane & 31);
#pragma unroll
    for (int i = 0; i < 32; ++i) v[i] = __builtin_nontemporal_load(sp + (size_t)(2 * i) * N);
    if (gain) {
#pragma unroll
        for (int i = 0; i < 32; ++i) gg[i] = gain[k0 + 2 * i + (lane >> 5)];
#pragma unroll
        for (int i = 0; i < 32; ++i) v[i] *= gg[i];
    }
#pragma unroll
    for (int i = 0; i < 32; ++i) scr[(2 * i + (lane >> 5)) * 33 + (lane & 31)] = v[i];
    asm volatile("s_waitcnt lgkmcnt(0)" ::: "memory");
    const int c = lane & 7;
#pragma unroll
    for (int j = 0; j < 4; ++j) { const int n = (lane >> 3) + 8 * j; const LAS float* s = scr + (8 * c) * 33 + n;
        u32x4 o; o.x = cvt_pk_bf16(s[0 * 33], s[1 * 33]); o.y = cvt_pk_bf16(s[2 * 33], s[3 * 33]); o.z = cvt_pk_bf16(s[4 * 33], s[5 * 33]); o.w = cvt_pk_bf16(s[6 * 33], s[7 * 33]);
        *(u32x4*)(WT + (size_t)(n0 + n) * K + k0 + 8 * c) = o; }
    asm volatile("s_waitcnt lgkmcnt(0)" ::: "memory");
}

struct Args { const float* in[21]; float* out; unsigned char* ws; int ph_lo, ph_hi; };

constexpr int CV_I0 = 32 * 352, CV_I1 = 88 * 64, CV_I2 = 32 * 224, CV_I3 = 32 * 64, CV_I7 = 4 * 64;
constexpr int CV_END = 2 * CV_I0 + 2 * CV_I1 + CV_I2 + 2 * CV_I3 + CV_I7, CV_T1 = CV_END - 10000, CV_T0 = CV_T1 - 10000, CV_TA = CV_I0 + CV_I2 + CV_I3 + CV_I7, CV_P0 = CV_I0 + CV_I7 + CV_I2 - 2000, CV_WO = CV_I0 + CV_I7 + CV_I2;
__device__ __forceinline__ void conv_range(const Args& a, LAS unsigned char* lds, int wave, int lane, int lo, int hi, int w0, int nw) {
    unsigned char* ws = a.ws;
    LAS float* scr = (LAS float*)(lds + wave * 16384);
    for (int it = lo + w0; it < hi; it += nw) {
        int r = it;
        if (r < CV_I0) { p0_item<1>(a.in[3], a.in[4], a.in[2], DM, FF, (bf16_t*)(ws + WS_W1GU), scr, r, lane); continue; } r -= CV_I0;
        if (r < CV_I7) { p0_item<0>(a.in[18], nullptr, nullptr, PLE, DM, (bf16_t*)(ws + WS_WPE), scr, r, lane); continue; } r -= CV_I7;
        if (r < CV_I2) { p0_item<2>(a.in[7], nullptr, a.in[6], DM, MIXIN, (bf16_t*)(ws + WS_WIN), scr, r, lane); continue; } r -= CV_I2;
        if (r < CV_I3) { p0_item<0>(a.in[12], nullptr, nullptr, DM, DM, (bf16_t*)(ws + WS_WOUT), scr, r, lane); continue; } r -= CV_I3;
        if (r < CV_I3) { p0_item<0>(a.in[19], nullptr, a.in[17], DM, DM, (bf16_t*)(ws + WS_WPG), scr, r, lane); continue; } r -= CV_I3;
        if (r < CV_I1) { p0_item<0>(a.in[16], nullptr, nullptr, FF, DM, (bf16_t*)(ws + WS_W2D), scr, r, lane); continue; } r -= CV_I1;
        if (r < CV_I0) { p0_item<1>(a.in[14], a.in[15], a.in[13], DM, FF, (bf16_t*)(ws + WS_W2GU), scr, r, lane); continue; } r -= CV_I0;
        p0_item<0>(a.in[5], nullptr, nullptr, FF, DM, (bf16_t*)(ws + WS_W1D), scr, r, lane);
    }
}
__device__ __forceinline__ void conv_tail(const Args& a, LAS unsigned char* lds, int wave, int lane, int nunits, int lo, int hi, int vc) {
    const int r = nunits % (int)gridDim.x;
    if (r == 0) { conv_range(a, lds, wave, lane, lo, hi, vc * 8 + wave, gridDim.x * 8); return; }
    if (vc >= r) conv_range(a, lds, wave, lane, lo, hi, (vc - r) * 8 + wave, ((int)gridDim.x - r) * 8);
}

__device__ __forceinline__ void phase0(const Args& a, LAS unsigned char* lds, int wave, int lane) {
    unsigned char* ws = a.ws;
    const int gw = blockIdx.x * 8 + wave, NGW = gridDim.x * 8;
    conv_range(a, lds, wave, lane, 0, CV_P0, gw, NGW);
    float* SS = (float*)(ws + WS_SS);
    for (int m = gw; m < M_TOK; m += NGW) {
        const f32x4* xr = (const f32x4*)(a.in[0] + (size_t)m * DM) + lane; u32x2* xb = (u32x2*)((bf16_t*)(ws + WS_XB) + (size_t)m * DM) + lane;
        float s = 0.f;
#pragma unroll
        for (int j = 0; j < 8; ++j) { const f32x4 v = __builtin_nontemporal_load(xr + 64 * j); s += (v[0] * v[0] + v[1] * v[1]) + (v[2] * v[2] + v[3] * v[3]);
            u32x2 w; w.x = cvt_pk_bf16(v[0], v[1]); w.y = cvt_pk_bf16(v[2], v[3]); xb[64 * j] = w; }
        s = wave_sum(s);
        if (lane == 0) { SS[m] = s; SS[8192 + m] = 0.f; SS[16384 + m] = 0.f; SS[24576 + m] = 0.f; }
    }
    { const int gt = blockIdx.x * 512 + threadIdx.x, NT = gridDim.x * 512;
      for (int i = gt; i < M_TOK * PLE / 4; i += NT) { const f32x4 v = __builtin_nontemporal_load((const f32x4*)a.in[1] + i); u32x2 w; w.x = cvt_pk_bf16(v[0], v[1]); w.y = cvt_pk_bf16(v[2], v[3]); ((u32x2*)(ws + WS_PB))[i] = w; } }
}

constexpr int HP = 136, VP = 72;
constexpr int L_QT = 0, L_QH = L_QT + 64 * HP * 2, L_KA = L_QH + 64 * HP * 2, L_KB = L_KA + 64 * HP * 2, L_ST = L_KB + 32 * HP * 2, L_VT = L_ST + 128 * HP * 2,
              L_P = L_VT + 128 * VP * 2, L_SEG = L_P + 64 * VP * 2, L_PART = L_SEG + 4 * 128 * 4, L_RINV = L_PART + 8 * 64 * 4, L_HEND = L_RINV + 256, L_KT = 0;
static_assert(L_HEND <= LDS_BYTES, "LDS");
#define MFMA16(a, b, c) __builtin_amdgcn_mfma_f32_16x16x32_bf16((a), (b), (c), 0, 0, 0)
__device__ __forceinline__ bf16_t f2bf(float x) { return (bf16_t)(cvt_pk_bf16(x, 0.f) & 0xffffu); }

#define LDSBAR() do { asm volatile("s_waitcnt lgkmcnt(0)" ::: "memory"); __builtin_amdgcn_s_barrier(); asm volatile("" ::: "memory"); } while (0)
__device__ __forceinline__ void hgrn_pass_a(const Args& a, LAS unsigned char* lds, int wave, int lane) {
    unsigned char* ws = a.ws;
    const float* LF = (const float*)(ws + WS_LF); const bf16_t* VH = (const bf16_t*)(ws + WS_VH); bf16_t* U = (bf16_t*)(ws + WS_U); float* Dd = (float*)(ws + WS_DD);
    const int tid = threadIdx.x, k = tid & 127, sg = tid >> 7, fr = lane & 15, fq = lane >> 4;
    LAS bf16_t* VT = (LAS bf16_t*)(lds + L_VT); LAS bf16_t* KT = (LAS bf16_t*)(lds + L_KT); LAS float* SEG = (LAS float*)(lds + L_SEG);
    float lf[16]; u32x4 vv[2];
#define PA_LOAD(it) do { const int r0_ = ((it) >> 3) * 64, c0_ = ((it) & 7) * 128; \
        _Pragma("unroll") for (int i = 0; i < 16; ++i) lf[i] = LF[(size_t)(r0_ + 16 * sg + i) * HW + c0_ + k]; \
        _Pragma("unroll") for (int j = 0; j < 2; ++j) { const int idx = tid + 512 * j; vv[j] = *(const u32x4*)(VH + (size_t)(r0_ + (idx >> 4)) * HW + c0_ + 8 * (idx & 15)); } } while (0)
    int item = blockIdx.x;
    if (item < 1024) PA_LOAD(item);
    for (; item < 1024; item += gridDim.x) {
        float b[16];
        float run = 0.f;
#pragma unroll
        for (int i = 0; i < 16; ++i) { run += lf[i]; b[i] = run; }
        SEG[sg * 128 + k] = run;
        LDSBAR();
        const float s0 = SEG[k], s1 = SEG[128 + k], s2 = SEG[256 + k], s3 = SEG[384 + k];
        const float pre = sg == 0 ? 0.f : (sg == 1 ? s0 : (sg == 2 ? s0 + s1 : s0 + s1 + s2));
        const float blast = s0 + s1 + s2 + s3;
        unsigned pk[8];
#pragma unroll
        for (int i = 0; i < 8; ++i) {
            const float e0 = (1.0f - __expf(lf[2 * i])) * __expf(blast - (pre + b[2 * i])), e1 = (1.0f - __expf(lf[2 * i + 1])) * __expf(blast - (pre + b[2 * i + 1]));
            pk[i] = cvt_pk_bf16(e0, e1); }
        { u32x4 w0, w1; w0.x = pk[0]; w0.y = pk[1]; w0.z = pk[2]; w0.w = pk[3]; w1.x = pk[4]; w1.y = pk[5]; w1.z = pk[6]; w1.w = pk[7];
          *(LAS u32x4*)(KT + k * VP + 16 * sg) = w0; *(LAS u32x4*)(KT + k * VP + 16 * sg + 8) = w1; }
#pragma unroll
        for (int j = 0; j < 2; ++j) { const int idx = tid + 512 * j, s = idx >> 4, v0 = 8 * (idx & 15);
            VT[(v0 + 0) * VP + s] = (bf16_t)(vv[j].x & 0xffffu); VT[(v0 + 1) * VP + s] = (bf16_t)(vv[j].x >> 16);
            VT[(v0 + 2) * VP + s] = (bf16_t)(vv[j].y & 0xffffu); VT[(v0 + 3) * VP + s] = (bf16_t)(vv[j].y >> 16);
            VT[(v0 + 4) * VP + s] = (bf16_t)(vv[j].z & 0xffffu); VT[(v0 + 5) * VP + s] = (bf16_t)(vv[j].z >> 16);
            VT[(v0 + 6) * VP + s] = (bf16_t)(vv[j].w & 0xffffu); VT[(v0 + 7) * VP + s] = (bf16_t)(vv[j].w >> 16); }
        if (sg == 0) Dd[item * 128 + k] = __expf(blast);
        if (item + (int)gridDim.x < 1024) PA_LOAD(item + (int)gridDim.x);
        LDSBAR();
        const bf16x8 a0 = *(const LAS bf16x8*)(VT + (16 * wave + fr) * VP + fq * 8), a1 = *(const LAS bf16x8*)(VT + (16 * wave + fr) * VP + 32 + fq * 8);
        bf16_t* up = U + (size_t)item * 16384 + (16 * wave + 4 * fq) * 128 + fr;
#pragma unroll
        for (int kt = 0; kt < 8; ++kt) {
            const bf16x8 b0 = *(const LAS bf16x8*)(KT + (16 * kt + fr) * VP + fq * 8), b1 = *(const LAS bf16x8*)(KT + (16 * kt + fr) * VP + 32 + fq * 8);
            f32x4 acc = {0.f, 0.f, 0.f, 0.f};
            acc = MFMA16(a0, b0, acc); acc = MFMA16(a1, b1, acc);
            up[16 * kt] = f2bf(acc[0]); up[16 * kt + 128] = f2bf(acc[1]); up[16 * kt + 256] = f2bf(acc[2]); up[16 * kt + 384] = f2bf(acc[3]);
        }
        LDSBAR();
    }
#undef PA_LOAD
}

__device__ __forceinline__ void hgrn_scan(const Args& a) {
    unsigned char* ws = a.ws;
    const bf16_t* U = (const bf16_t*)(ws + WS_U); const float* Dd = (const float*)(ws + WS_DD); bf16_t* SP = (bf16_t*)(ws + WS_S);
    for (int e = (blockIdx.x * 512 + threadIdx.x) * 4; e < 32 * 16384; e += gridDim.x * 512 * 4) {
        const int bh = e >> 14, vk = e & 16383, bb = bh >> 3, h = bh & 7;
        f32x4 S = {0.f, 0.f, 0.f, 0.f};
#pragma unroll 8
        for (int ci = 0; ci < 32; ++ci) {
            const size_t item = (size_t)((bb * 32 + ci) * 8 + h);
            const u32x2 uw = *(const u32x2*)(U + item * 16384 + vk); f32x4 u; u[0] = bflo(uw.x); u[1] = bfhi(uw.x); u[2] = bflo(uw.y); u[3] = bfhi(uw.y); const f32x4 d = *(const f32x4*)(Dd + item * 128 + (vk & 127));
            u32x2 w; w.x = cvt_pk_bf16(S[0], S[1]); w.y = cvt_pk_bf16(S[2], S[3]); *(u32x2*)(SP + item * 16384 + vk) = w;
            S = d * S + u;
        }
    }
}

__device__ __forceinline__ void conv_mixer(const Args& a, int wave, int lane) {
    unsigned char* ws = a.ws;
    const bf16_t* BC = (const bf16_t*)(ws + WS_BC); const bf16_t* UC = (const bf16_t*)(ws + WS_UC); bf16_t* MIX = (bf16_t*)(ws + WS_MIX);
    const float* cn = a.in[11]; const float* cw = a.in[8];
    const int gw = blockIdx.x * 8 + wave, NGW = gridDim.x * 8;
    for (int it = gw; it < M_TOK * 2; it += NGW) {
        const int row = it >> 1, c = (it & 1) * 512 + lane * 8, t = row & (SEQ - 1);
        const size_t off = (size_t)row * CW + c;
        const u32x4 z = {0u, 0u, 0u, 0u};
        const u32x4 u0 = *(const u32x4*)(UC + off), u1 = t >= 1 ? *(const u32x4*)(UC + off - CW) : z, u2 = t >= 2 ? *(const u32x4*)(UC + off - 2 * CW) : z, bg = *(const u32x4*)(BC + off);
        float y[8]; float ssq = 0.f;
#pragma unroll
        for (int q = 0; q < 4; ++q) {
            const unsigned a0 = u0[q], a1 = u1[q], a2 = u2[q], bb = bg[q]; const int cc = c + 2 * q;
            y[2 * q] = bflo(bb) * (cw[cc] * bflo(a2) + cw[CW + cc] * bflo(a1) + cw[2 * CW + cc] * bflo(a0));
            y[2 * q + 1] = bfhi(bb) * (cw[cc + 1] * bfhi(a2) + cw[CW + cc + 1] * bfhi(a1) + cw[2 * CW + cc + 1] * bfhi(a0));
            ssq += y[2 * q] * y[2 * q] + y[2 * q + 1] * y[2 * q + 1];
        }
        ssq += __shfl_xor(ssq, 1); ssq += __shfl_xor(ssq, 2); ssq += __shfl_xor(ssq, 4); ssq += __shfl_xor(ssq, 8);
        const float ri = rsqrtf(ssq * (1.0f / 128) + EPS);
        u32x4 w;
        w.x = cvt_pk_bf16(y[0] * ri * cn[c], y[1] * ri * cn[c + 1]); w.y = cvt_pk_bf16(y[2] * ri * cn[c + 2], y[3] * ri * cn[c + 3]);
        w.z = cvt_pk_bf16(y[4] * ri * cn[c + 4], y[5] * ri * cn[c + 5]); w.w = cvt_pk_bf16(y[6] * ri * cn[c + 6], y[7] * ri * cn[c + 7]);
        *(u32x4*)(MIX + (size_t)row * DM + HW + c) = w;
    }
}

__device__ __forceinline__ void hgrn_pass_c(const Args& a, LAS unsigned char* lds, int wave, int lane) {
    unsigned char* ws = a.ws;
    const float* LF = (const float*)(ws + WS_LF); const bf16_t* VH = (const bf16_t*)(ws + WS_VH); const bf16_t* QS = (const bf16_t*)(ws + WS_QS); const bf16_t* GH = (const bf16_t*)(ws + WS_GH);
    const bf16_t* SP = (const bf16_t*)(ws + WS_S); bf16_t* MIX = (bf16_t*)(ws + WS_MIX); const float* hn = a.in[10];
    const int tid = threadIdx.x, k = tid & 127, sg = tid >> 7, fr = lane & 15, fq = lane >> 4;
    LAS bf16_t* QT = (LAS bf16_t*)(lds + L_QT); LAS bf16_t* QH = (LAS bf16_t*)(lds + L_QH); LAS bf16_t* KA = (LAS bf16_t*)(lds + L_KA); LAS bf16_t* KB = (LAS bf16_t*)(lds + L_KB);
    LAS bf16_t* ST = (LAS bf16_t*)(lds + L_ST); LAS bf16_t* VT = (LAS bf16_t*)(lds + L_VT); LAS bf16_t* P = (LAS bf16_t*)(lds + L_P);
    LAS float* SEG = (LAS float*)(lds + L_SEG); LAS float* PART = (LAS float*)(lds + L_PART); LAS float* RINV = (LAS float*)(lds + L_RINV);
    float lf[16]; bf16_t qh[16]; u32x4 vv[2], sv[4];
#define PC_LOAD(it) do { const int r0_ = ((it) >> 3) * 64, c0_ = ((it) & 7) * 128; \
        _Pragma("unroll") for (int i = 0; i < 16; ++i) { lf[i] = LF[(size_t)(r0_ + 16 * sg + i) * HW + c0_ + k]; qh[i] = QS[(size_t)(r0_ + 16 * sg + i) * HW + c0_ + k]; } \
        _Pragma("unroll") for (int j = 0; j < 2; ++j) { const int idx = tid + 512 * j; vv[j] = *(const u32x4*)(VH + (size_t)(r0_ + (idx >> 4)) * HW + c0_ + 8 * (idx & 15)); } \
        _Pragma("unroll") for (int j = 0; j < 4; ++j) { const int idx = tid + 512 * j; sv[j] = *(const u32x4*)(SP + (size_t)(it) * 16384 + (idx >> 4) * 128 + 8 * (idx & 15)); } } while (0)
    int item = blockIdx.x;
    if (item < 1024) PC_LOAD(item);
    for (; item < 1024; item += gridDim.x) {
        const int row0 = (item >> 3) * 64, cb = (item & 7) * 128;
        float b[16];
        float run = 0.f;
#pragma unroll
        for (int i = 0; i < 16; ++i) { run += lf[i]; b[i] = run; }
        SEG[sg * 128 + k] = run;
        LDSBAR();
        const float s0 = SEG[k], s1 = SEG[128 + k], s2 = SEG[256 + k];
        const float pre = sg == 0 ? 0.f : (sg == 1 ? s0 : (sg == 2 ? s0 + s1 : s0 + s1 + s2));
        const float beta1 = s0 + s1, beta = sg >= 2 ? beta1 : 0.f;
#pragma unroll
        for (int i = 0; i < 16; ++i) {
            const int s = 16 * sg + i; const float bi = pre + b[i], kk = 1.0f - __expf(lf[i]), qv = bf2f(qh[i]);
            QT[s * HP + k] = f2bf(qv * __expf(bi - beta)); QH[s * HP + k] = f2bf(qv * __expf(bi));
            KA[s * HP + k] = f2bf(kk * __expf(fminf(beta - bi, 80.f)));
            if (sg < 2) KB[s * HP + k] = f2bf(kk * __expf(beta1 - bi));
        }
#pragma unroll
        for (int j = 0; j < 2; ++j) { const int idx = tid + 512 * j, s = idx >> 4, v0 = 8 * (idx & 15);
            VT[(v0 + 0) * VP + s] = (bf16_t)(vv[j].x & 0xffffu); VT[(v0 + 1) * VP + s] = (bf16_t)(vv[j].x >> 16);
            VT[(v0 + 2) * VP + s] = (bf16_t)(vv[j].y & 0xffffu); VT[(v0 + 3) * VP + s] = (bf16_t)(vv[j].y >> 16);
            VT[(v0 + 4) * VP + s] = (bf16_t)(vv[j].z & 0xffffu); VT[(v0 + 5) * VP + s] = (bf16_t)(vv[j].z >> 16);
            VT[(v0 + 6) * VP + s] = (bf16_t)(vv[j].w & 0xffffu); VT[(v0 + 7) * VP + s] = (bf16_t)(vv[j].w >> 16); }
#pragma unroll
        for (int j = 0; j < 4; ++j) { const int idx = tid + 512 * j; *(LAS u32x4*)(ST + (idx >> 4) * HP + 8 * (idx & 15)) = sv[j]; }
        if (item + (int)gridDim.x < 1024) PC_LOAD(item + (int)gridDim.x);
        LDSBAR();
        bf16_t gh[16];
#pragma unroll
        for (int q = 0; q < 16; ++q) gh[q] = GH[(size_t)(row0 + 16 * (q >> 2) + 4 * fq + (q & 3)) * HW + cb + 16 * wave + fr];
#pragma unroll
        for (int pp = 0; pp < 2; ++pp) {
            const int p = wave + 8 * pp, tt = p >> 2, st = p & 3;
            f32x4 acc = {0.f, 0.f, 0.f, 0.f};
            if (st <= tt) {
                const LAS bf16_t* kb = (tt >= 2 && st < 2) ? KB : KA;
#pragma unroll
                for (int ks = 0; ks < 4; ++ks) { const bf16x8 af = *(const LAS bf16x8*)(QT + (16 * tt + fr) * HP + ks * 32 + fq * 8), bfr = *(const LAS bf16x8*)(kb + (16 * st + fr) * HP + ks * 32 + fq * 8);
                    acc = MFMA16(af, bfr, acc); }
            }
#pragma unroll
            for (int r = 0; r < 4; ++r) { const bool keep = (st < tt) || (st == tt && fr <= 4 * fq + r); P[(16 * tt + 4 * fq + r) * VP + 16 * st + fr] = f2bf(keep ? acc[r] : 0.f); }
        }
        LDSBAR();
        bf16x8 bs[4], bv[2];
#pragma unroll
        for (int ks = 0; ks < 4; ++ks) bs[ks] = *(const LAS bf16x8*)(ST + (16 * wave + fr) * HP + ks * 32 + fq * 8);
#pragma unroll
        for (int ks = 0; ks < 2; ++ks) bv[ks] = *(const LAS bf16x8*)(VT + (16 * wave + fr) * VP + ks * 32 + fq * 8);
        f32x4 o[4];
#pragma unroll
        for (int tt = 0; tt < 4; ++tt) {
            f32x4 acc = {0.f, 0.f, 0.f, 0.f};
#pragma unroll
            for (int ks = 0; ks < 4; ++ks) { const bf16x8 af = *(const LAS bf16x8*)(QH + (16 * tt + fr) * HP + ks * 32 + fq * 8); acc = MFMA16(af, bs[ks], acc); }
            { const bf16x8 af = *(const LAS bf16x8*)(P + (16 * tt + fr) * VP + fq * 8); acc = MFMA16(af, bv[0], acc); }
            if (tt >= 2) { const bf16x8 af = *(const LAS bf16x8*)(P + (16 * tt + fr) * VP + 32 + fq * 8); acc = MFMA16(af, bv[1], acc); }
            o[tt] = acc;
        }
#pragma unroll
        for (int tt = 0; tt < 4; ++tt)
#pragma unroll
            for (int r = 0; r < 4; ++r) { float x = o[tt][r] * o[tt][r]; x += __shfl_xor(x, 1); x += __shfl_xor(x, 2); x += __shfl_xor(x, 4); x += __shfl_xor(x, 8);
                if (fr == 0) PART[wave * 64 + 16 * tt + 4 * fq + r] = x; }
        LDSBAR();
        if (tid < 64) { float s = 0.f;
#pragma unroll
            for (int w = 0; w < 8; ++w) s += PART[w * 64 + tid];
            RINV[tid] = rsqrtf(s * (1.0f / 128) + EPS); }
        LDSBAR();
        const float hnv = hn[16 * wave + fr];
#pragma unroll
        for (int tt = 0; tt < 4; ++tt)
#pragma unroll
            for (int r = 0; r < 4; ++r) { const int t = 16 * tt + 4 * fq + r; const size_t row = (size_t)(row0 + t);
                const float g = bf2f(gh[tt * 4 + r]);
                MIX[row * DM + cb + 16 * wave + fr] = f2bf(o[tt][r] * RINV[t] * hnv * g); }
        LDSBAR();
    }
#undef PC_LOAD
}

__device__ __forceinline__ void phase_final(const Args& a, int wave, int lane) {
    const int gw = blockIdx.x * 8 + wave, NGW = gridDim.x * 8; const float* gF = a.in[20]; const bf16_t* H4 = (const bf16_t*)(a.ws + WS_MIX);
    for (int m = gw; m < M_TOK; m += NGW) {
        const u32x4* hr = (const u32x4*)(H4 + (size_t)m * DM) + lane; u32x4 w[4]; float s = 0.f;
#pragma unroll
        for (int j = 0; j < 4; ++j) { w[j] = __builtin_nontemporal_load(hr + 64 * j);
            s += (bflo(w[j].x) * bflo(w[j].x) + bfhi(w[j].x) * bfhi(w[j].x)) + (bflo(w[j].y) * bflo(w[j].y) + bfhi(w[j].y) * bfhi(w[j].y))
               + (bflo(w[j].z) * bflo(w[j].z) + bfhi(w[j].z) * bfhi(w[j].z)) + (bflo(w[j].w) * bflo(w[j].w) + bfhi(w[j].w) * bfhi(w[j].w)); }
        const float ri = rinv_of(wave_sum(s));
        f32x4* orow = (f32x4*)(a.out + (size_t)m * DM);
#pragma unroll
        for (int j = 0; j < 4; ++j) { const int c = (64 * j + lane) * 8; const f32x4 g0 = *(const f32x4*)(gF + c), g1 = *(const f32x4*)(gF + c + 4);
            f32x4 o0, o1; o0[0] = bflo(w[j].x) * ri * g0[0]; o0[1] = bfhi(w[j].x) * ri * g0[1]; o0[2] = bflo(w[j].y) * ri * g0[2]; o0[3] = bfhi(w[j].y) * ri * g0[3];
            o1[0] = bflo(w[j].z) * ri * g1[0]; o1[1] = bfhi(w[j].z) * ri * g1[1]; o1[2] = bflo(w[j].w) * ri * g1[2]; o1[3] = bfhi(w[j].w) * ri * g1[3];
            __builtin_nontemporal_store(o0, orow + c / 4); __builtin_nontemporal_store(o1, orow + c / 4 + 1); }
    }
}

#define XB_TMO      128
#define XB_XCNT(j)  (256  + 64 * (j))
#define XB_XSUB(j)  (1280 + 64 * (j))
#define XB_XGEN(j)  (2304 + 64 * (j))
#define XB_TOP      3328
#define XB_TOPGEN   3392
#define XCD_BAR_WORDS 3456
#define XB_SPIN_CAP (1u << 18)

__device__ __forceinline__ unsigned xb_ld(unsigned* p)              { return __hip_atomic_load(p, __ATOMIC_RELAXED, __HIP_MEMORY_SCOPE_AGENT); }
__device__ __forceinline__ unsigned xb_add(unsigned* p, unsigned v) { return __hip_atomic_fetch_add(p, v, __ATOMIC_RELAXED, __HIP_MEMORY_SCOPE_AGENT); }
__device__ __forceinline__ unsigned xb_xcc_id() { return (unsigned)__builtin_amdgcn_s_getreg((3 << 11) | 20) & 0xFu; }
#define XB_SPIN(cond, bar) do { unsigned _sp = 0; while (cond) { __builtin_amdgcn_s_sleep(1); \
    if ((++_sp & 255u) == 0u) { if (xb_ld(&(bar)[XB_TMO])) break; if (_sp > XB_SPIN_CAP) { atomicAdd(&(bar)[XB_TMO], 1u); break; } } } } while (0)

struct XcdBarrier {
    unsigned* bar; unsigned x;
    volatile LAS unsigned* st;
};

__device__ __forceinline__ XcdBarrier xcd_barrier_post(unsigned* bar, volatile LAS unsigned* st) {
    XcdBarrier b; b.bar = bar; b.x = xb_xcc_id(); b.st = st;
    if (threadIdx.x == 0) (void)xb_add(&bar[XB_XCNT(b.x)], 1u);
    return b;
}
__device__ __forceinline__ void xcd_barrier_complete(unsigned* bar, unsigned x, unsigned& nloc, unsigned& nx) {
    const unsigned G = gridDim.x * gridDim.y * gridDim.z;
    unsigned sum, cnt, mine, sp = 0u;
    for (;;) {
        sum = 0u; cnt = 0u; mine = 0u;
#pragma unroll
        for (unsigned j = 0; j < 16; ++j) { const unsigned c = xb_ld(&bar[XB_XCNT(j)]); sum += c; cnt += (c > 0u) ? 1u : 0u; mine = (j == x) ? c : mine; }
        if (sum == G) break;
        __builtin_amdgcn_s_sleep(1);
        if ((++sp & 255u) == 0u) { if (xb_ld(&bar[XB_TMO])) break; if (sp > XB_SPIN_CAP) { atomicAdd(&bar[XB_TMO], 1u); break; } }
    }
    nloc = mine > 0u ? mine : 1u; nx = cnt > 0u ? cnt : 1u;
}

__device__ __forceinline__ void xcd_barrier(const XcdBarrier& b) {
    asm volatile("s_waitcnt vmcnt(0)" ::: "memory");
    __syncthreads();
    if (threadIdx.x == 0) {
        unsigned* bar = b.bar;
        __builtin_amdgcn_s_waitcnt(0);
        unsigned nloc = b.st[0], nx = b.st[1];
        if (nloc == 0u) { xcd_barrier_complete(bar, b.x, nloc, nx); b.st[0] = nloc; b.st[1] = nx; }
        const unsigned old = xb_add(&bar[XB_XSUB(b.x)], 1u);
        const unsigned gen = old / nloc;
        if (old + 1u == (gen + 1u) * nloc) {
            __builtin_amdgcn_fence(__ATOMIC_RELEASE, "agent");
            asm volatile("s_waitcnt vmcnt(0)" ::: "memory");
            const unsigned og = xb_add(&bar[XB_TOP], 1u);
            const unsigned tg = og / nx;
            if (og + 1u == (tg + 1u) * nx) xb_add(&bar[XB_TOPGEN], 1u);
            else XB_SPIN(xb_ld(&bar[XB_TOPGEN]) == tg, bar);
            __builtin_amdgcn_fence(__ATOMIC_ACQUIRE, "agent");
            xb_add(&bar[XB_XGEN(b.x)], 1u);
            asm volatile("s_waitcnt vmcnt(0)" ::: "memory");
        } else {
            XB_SPIN(xb_ld(&bar[XB_XGEN(b.x)]) == gen, bar);
            __builtin_amdgcn_fence(__ATOMIC_ACQUIRE, "agent");
            asm volatile("s_waitcnt vmcnt(0)" ::: "memory");
        }
    }
    __syncthreads();
}


template <class Epi>
__device__ __forceinline__ void run_gemm(LAS unsigned char* lds, const bf16_t* A, const bf16_t* Bt, int N, int K, const Epi& E, int vc) {
    pg8::Gemm g; g.A = A; g.Bt = Bt; g.M = M_TOK; g.N = N; g.K = K;
    pg8::StaticOrder S; S.init(M_TOK, N, (int)gridDim.x, vc);
    pg8::gemm_phase<Epi, pg8::StaticOrder, true, true>(lds, g, S, E);
}
struct TailOrder {
    int c, n;
    __device__ __forceinline__ bool next(int i, Unit& u) const { if (c < 0) return false; const int L = i * n + c; if (L >= 256) return false; u.pm = L >> 3; u.pn = L & 7; return true; }
    __device__ __forceinline__ void a_ready(const Unit&) const {}
    __device__ __forceinline__ void done(const Unit&) const {}
};

__global__ void __launch_bounds__(512, 2) fwd_kernel(Args a) {
    extern __shared__ __attribute__((aligned(16))) unsigned char lds_raw[];
    LAS unsigned char* lds = (LAS unsigned char*)lds_raw;
    cg::grid_group grid = cg::this_grid();
    volatile LAS unsigned* xst = (volatile LAS unsigned*)(lds + LDS_BYTES - 16);
    if (threadIdx.x < 4) xst[threadIdx.x] = 0u;
    __syncthreads();
    XcdBarrier xbar = xcd_barrier_post((unsigned*)(a.ws + WS_BAR), xst);
    unsigned* cen = (unsigned*)(a.ws + WS_BAR) + 3584;
    if (threadIdx.x == 0) xst[2] = xb_add(&cen[64 * xbar.x], 1u);
    if (a.ph_lo == 0 && a.ph_hi == NPHASE) grid.sync();
    int vc = blockIdx.x;
    if (a.ph_lo == 0 && a.ph_hi == NPHASE && gridDim.x == 256) {
        bool even = true;
#pragma unroll
        for (int j = 0; j < 8; ++j) even = even && (xb_ld(&cen[64 * j]) == 32u);
        if (even) vc = (int)xst[2] * 8 + (int)xbar.x;
    }
    vc = __builtin_amdgcn_readfirstlane(vc);
    const int tid = threadIdx.x, lane = tid & 63, wave = __builtin_amdgcn_readfirstlane(tid >> 6);
    unsigned char* ws = a.ws;
    float* SS = (float*)(ws + WS_SS);
    bf16_t* XB = (bf16_t*)(ws + WS_XB); bf16_t* G = (bf16_t*)(ws + WS_G); bf16_t* MIX = (bf16_t*)(ws + WS_MIX);
#define PH(i) if (a.ph_lo <= (i) && (i) < a.ph_hi)
#define SYNC(i) if (a.ph_lo <= (i) && (i) + 1 < a.ph_hi) { xcd_barrier(xbar); }
    PH(0) { phase0(a, lds, wave, lane); } SYNC(0)
    PH(1) { EpiGateUp E; E.G = G; E.ss = SS; run_gemm(lds, XB, (const bf16_t*)(ws + WS_W1GU), 2 * FF, DM, E, vc); conv_tail(a, lds, wave, lane, 32 * 44, CV_P0, CV_WO, vc); conv_tail(a, lds, wave, lane, 32 * 44, CV_T1, CV_END, vc); } SYNC(1)
    PH(2) { EpiResid E; E.XB = XB; E.ss_out = SS + 8192; E.scale = 0.5f; run_gemm(lds, G, (const bf16_t*)(ws + WS_W1D), DM, FF, E, vc); } SYNC(2)
    PH(3) { EpiMixIn E; E.ss = SS + 8192; E.lbl = a.in[9]; E.QS = (bf16_t*)(ws + WS_QS);
            E.UC = (bf16_t*)(ws + WS_UC); E.LF = (float*)(ws + WS_LF); run_gemm(lds, XB, (const bf16_t*)(ws + WS_WIN), MIXIN, DM, E, vc); conv_tail(a, lds, wave, lane, 32 * 28, CV_WO, CV_TA, vc); conv_tail(a, lds, wave, lane, 32 * 28, CV_T0, CV_T1, vc); } SYNC(3)
    PH(4) { hgrn_pass_a(a, lds, wave, lane); } SYNC(4)
    PH(5) { hgrn_scan(a); conv_mixer(a, wave, lane); } SYNC(5)
    PH(6) { hgrn_pass_c(a, lds, wave, lane); } SYNC(6)
    PH(7) { EpiResid E; E.XB = XB; E.ss_out = SS + 16384; E.scale = 1.0f; run_gemm(lds, MIX, (const bf16_t*)(ws + WS_WOUT), DM, DM, E, vc); } SYNC(7)
    PH(8) { EpiGateUp E; E.G = G; E.ss = SS + 16384; run_gemm(lds, XB, (const bf16_t*)(ws + WS_W2GU), 2 * FF, DM, E, vc);
            { const int r = (32 * 44) % (int)gridDim.x; TailOrder T; T.n = (int)gridDim.x - r; T.c = vc - r;
              EpiStoreBf16 E2; E2.O = (bf16_t*)(ws + WS_PLE); int kp = PLE; asm volatile("" : "+s"(kp));
              pg8::Gemm g2; g2.A = (const bf16_t*)(ws + WS_PB); g2.Bt = (const bf16_t*)(ws + WS_WPE); g2.M = M_TOK; g2.N = DM; g2.K = kp;
              pg8::gemm_phase<EpiStoreBf16, TailOrder, true, true>(lds, g2, T, E2); }
            conv_tail(a, lds, wave, lane, 32 * 44, CV_TA, CV_T0, vc); } SYNC(8)
    PH(9) { EpiResid E; E.XB = XB; E.ss_out = SS + 24576; E.scale = 0.5f; run_gemm(lds, G, (const bf16_t*)(ws + WS_W2D), DM, FF, E, vc); } SYNC(9)
    PH(10) { EpiPleGate E; E.XB = XB; E.H4 = MIX; E.P = (const bf16_t*)(ws + WS_PLE); E.ss = SS + 24576; run_gemm(lds, XB, (const bf16_t*)(ws + WS_WPG), DM, DM, E, vc); } SYNC(10)
    PH(11) { phase_final(a, wave, lane); }
#undef PH
#undef SYNC
}

#ifndef MK_MULTI
#define MK_MULTI 0
#endif
extern "C" void kernel_launch(void* const* d_in, const int* in_sizes, int n_in, void* d_out, int out_size, void* d_ws, size_t ws_size, hipStream_t stream) {
    static int grid = 0;
    if (grid == 0) {
        if (n_in != 21 || out_size != M_TOK * DM || ws_size < WS_END) { fprintf(stderr, "kernel_launch: unexpected shapes (n_in %d out %d ws %zu need %zu)\n", n_in, out_size, ws_size, (size_t)WS_END); grid = -1; return; }
        int dev = 0, cus = 0, per_cu = 0;
        hipGetDevice(&dev); hipDeviceGetAttribute(&cus, hipDeviceAttributeMultiprocessorCount, dev);
        if (hipFuncSetAttribute((const void*)fwd_kernel, hipFuncAttributeMaxDynamicSharedMemorySize, LDS_BYTES) != hipSuccess) { fprintf(stderr, "kernel_launch: hipFuncSetAttribute failed\n"); grid = -1; return; }
        if (hipOccupancyMaxActiveBlocksPerMultiprocessor(&per_cu, (const void*)fwd_kernel, 512, LDS_BYTES) != hipSuccess || per_cu < 1) { fprintf(stderr, "kernel_launch: occupancy query failed (%d)\n", per_cu); grid = -1; return; }
        grid = cus * per_cu;
    }
    if (grid < 0) return;
    Args a{};
    for (int i = 0; i < 21; ++i) a.in[i] = (const float*)d_in[i];
    a.out = (float*)d_out; a.ws = (unsigned char*)d_ws;
#if MK_MULTI
    for (int p = 0; p < NPHASE; ++p) { a.ph_lo = p; a.ph_hi = p + 1; hipLaunchKernelGGL(fwd_kernel, dim3(grid), dim3(512), LDS_BYTES, stream, a); }
#else
    a.ph_lo = 0; a.ph_hi = NPHASE;
    if (hipMemsetAsync((char*)d_ws + WS_BAR, 0, 4096 * 4, stream) != hipSuccess) { fprintf(stderr, "kernel_launch: memset failed\n"); return; }
    void* args[] = {&a};
    hipError_t e = hipLaunchCooperativeKernel((void*)fwd_kernel, dim3(grid), dim3(512), args, LDS_BYTES, stream);
    if (e != hipSuccess) fprintf(stderr, "cooperative launch failed: %s (grid %d)\n", hipGetErrorString(e), grid);
#endif
}
```

```cpp
#include <hip/hip_runtime.h>
#include <hip/hip_cooperative_groups.h>
#include <cstdio>
#include <cstdint>
namespace pg8 {
#define PG8_LAS __attribute__((address_space(3)))
typedef unsigned short bf16_t;
typedef short bf16x8 __attribute__((ext_vector_type(8)));
typedef float f32x4 __attribute__((ext_vector_type(4)));
typedef unsigned u32x4 __attribute__((ext_vector_type(4)));
constexpr int BM = 256, BK = 64, HALF = 128, HTB = HALF * BK * 2  , STAGE_BYTES = 8 * HTB, NXCD = 8, WGM = 4;

__host__ __device__ __forceinline__ int lds_byte(int r, int c) { const int st = (r >> 4) * 2 + (c >> 5), rr = r & 15, cc = c & 31, ob = rr * 64 + cc * 2; return st * 1024 + (ob ^ (((ob >> 9) & 1) << 5)); }
__host__ __device__ __forceinline__ void stage_rc(int b, int& R, int& C) { const int st = b / 1024, sb = b % 1024, swz = sb ^ (((sb >> 9) & 1) << 5); R = (st >> 1) * 16 + swz / 64; C = (st & 1) * 32 + (swz % 64) / 2; }
__host__ __device__ __forceinline__ int perm32(int rho) { const int n = rho >> 4, i = rho & 15; return 8 * (i >> 2) + 4 * n + (i & 3); }

struct Unit { int pm, pn; };
struct Gemm { const bf16_t* A; const bf16_t* Bt; int M, N, K; };

struct StaticOrder {
    int nM, nN, nwg, G, c;
    __host__ __device__ void init(int M, int N, int G_, int c_) { nM = M / BM; nN = N / BM; nwg = nM * nN; G = G_; c = c_; }
    __host__ __device__ bool next(int i, Unit& u) const {
        const long L = (long)i * G + c; if (L >= nwg) return false;
        int wgid = (int)L; { const int q = nwg / NXCD, r = nwg % NXCD, xcd = wgid % NXCD, off = wgid / NXCD; wgid = (xcd < r ? xcd * (q + 1) : r * (q + 1) + (xcd - r) * q) + off; }
        const int nig = WGM * nN, gid = wgid / nig, fm = gid * WGM, gsz = (nM - fm) < WGM ? (nM - fm) : WGM;
        u.pm = fm + ((wgid % nig) % gsz); u.pn = (wgid % nig) / gsz; return true;
    }
    __device__ __forceinline__ void a_ready(const Unit&) const {}
    __device__ __forceinline__ void done(const Unit&) const {}
};
typedef float f32x2 __attribute__((ext_vector_type(2)));
template <class Epi, class Sched, bool ALIGN_EPI = false, bool SP2 = false>
__device__ __forceinline__ void gemm_phase(PG8_LAS unsigned char* lds, const Gemm g, const Sched& S, const Epi& E) {
    const int tid = threadIdx.x, wid = __builtin_amdgcn_readfirstlane(tid >> 6), lane = tid & 63, wr = wid >> 2, wc = wid & 3, fr = lane & 15, fq = lane >> 4;
    const int K = g.K, nt = K / BK;
    unsigned voffA[2], voffB[2];
#pragma unroll
    for (int i = 0; i < 2; ++i) { int R, C; stage_rc(tid * 16 + i * 8192, R, C); const int Rb = Epi::PERM ? ((R & ~31) + perm32(R & 31)) : R;
        voffA[i] = (unsigned)(R * K + C) * 2u; voffB[i] = (unsigned)(Rb * K + C) * 2u; }
    const size_t kstep = (size_t)(BK * 2);
    const size_t hstep = (size_t)HALF * K * 2;
    const size_t tstep = 2 * hstep;
    const unsigned ldsw = (unsigned)wid * 1024u;
    const int aoff = lds_byte(wr * 64 + fr, fq * 8), boff = lds_byte(wc * 32 + fr, fq * 8);
#define PG8_SA(b, h) (((b) * 2 + (h)) * HTB)
#define PG8_SB(b, h) ((4 + (b) * 2 + (h)) * HTB)
#define PG8_STAGE(bufoff, gbase, voff) do { _Pragma("unroll") for (int _i = 0; _i < 2; ++_i) \
        __builtin_amdgcn_global_load_lds((const unsigned*)((const char*)(gbase) + (voff)[_i]), (PG8_LAS unsigned*)(lds + (bufoff) + ldsw + _i * 8192), 16, 0, 0); } while (0)
#define PG8_LDA(dst, b, h) do { _Pragma("unroll") for (int m = 0; m < 4; ++m) _Pragma("unroll") for (int k = 0; k < 2; ++k) dst[m][k] = *(const PG8_LAS bf16x8*)(lds + PG8_SA(b, h) + aoff + m * 2048 + k * 1024); } while (0)
#define PG8_LDB(dst, b, h) do { _Pragma("unroll") for (int n = 0; n < 2; ++n) _Pragma("unroll") for (int k = 0; k < 2; ++k) dst[n][k] = *(const PG8_LAS bf16x8*)(lds + PG8_SB(b, h) + boff + n * 2048 + k * 1024); } while (0)
#define PG8_MMA(ai, bj, At, Bt) do { __builtin_amdgcn_s_setprio(1); _Pragma("unroll") for (int m = 0; m < 4; ++m) _Pragma("unroll") for (int n = 0; n < 2; ++n) _Pragma("unroll") for (int k = 0; k < 2; ++k) \
        acc[ai][bj][m][n] = __builtin_amdgcn_mfma_f32_16x16x32_bf16(Bt[n][k], At[m][k], acc[ai][bj][m][n], 0, 0, 0); __builtin_amdgcn_s_setprio(0); } while (0)
#define PG8_WAIT_V(n) asm volatile("s_waitcnt vmcnt(" #n ")" ::: "memory")
#define PG8_WAIT_L(n) asm volatile("s_waitcnt lgkmcnt(" #n ")" ::: "memory")
#define PG8_BAR __builtin_amdgcn_s_barrier()
#define PG8_SCHED __builtin_amdgcn_sched_barrier(0)
    Unit cur, nxt; int ui = 0;
    if (!S.next(0, cur)) return;
    f32x4 acc[2][2][4][2];
#pragma unroll
    for (int a = 0; a < 2; ++a)
#pragma unroll
        for (int b = 0; b < 2; ++b)
#pragma unroll
            for (int m = 0; m < 4; ++m)
#pragma unroll
                for (int n = 0; n < 2; ++n) acc[a][b][m][n] = (f32x4){0.f, 0.f, 0.f, 0.f};
    bf16x8 At[4][2], B0[2][2], B1[2][2];
    const char* cA = (const char*)g.A + (size_t)cur.pm * tstep; const char* cB = (const char*)g.Bt + (size_t)cur.pn * tstep;
    S.a_ready(cur);
    if constexpr (SP2) {
        PG8_STAGE(PG8_SB(0, 0), cB, voffB); PG8_STAGE(PG8_SB(0, 1), cB + hstep, voffB); PG8_STAGE(PG8_SA(0, 0), cA, voffA); PG8_STAGE(PG8_SA(0, 1), cA + hstep, voffA);
        if (wr == 1) PG8_BAR;
        PG8_WAIT_V(2); PG8_BAR;
        PG8_STAGE(PG8_SB(1, 0), cB + kstep, voffB); PG8_STAGE(PG8_SA(1, 0), cA + kstep, voffA); PG8_STAGE(PG8_SB(1, 1), cB + hstep + kstep, voffB);
        PG8_WAIT_V(6); PG8_BAR;
    } else {
        PG8_STAGE(PG8_SB(0, 0), cB, voffB); PG8_STAGE(PG8_SA(0, 0), cA, voffA); PG8_STAGE(PG8_SB(0, 1), cB + hstep, voffB); PG8_STAGE(PG8_SA(0, 1), cA + hstep, voffA);
        if (wr == 1) PG8_BAR;
        PG8_WAIT_V(4); PG8_BAR;
        PG8_STAGE(PG8_SB(1, 0), cB + kstep, voffB); PG8_STAGE(PG8_SA(1, 0), cA + kstep, voffA); PG8_STAGE(PG8_SB(1, 1), cB + hstep + kstep, voffB);
        PG8_WAIT_V(6); PG8_BAR;
    }
    for (;;) {
        const bool has_next = S.next(ui + 1, nxt);
        const char* nA = has_next ? (const char*)g.A + (size_t)nxt.pm * tstep : cA; const char* nB = has_next ? (const char*)g.Bt + (size_t)nxt.pn * tstep : cB;
        for (int t = 0; t < nt; t += 2) {
            const bool last = (t == nt - 2);
            const char* a1 = cA + (size_t)(t + 1) * kstep;
            const char* a2 = last ? nA : cA + (size_t)(t + 2) * kstep; const char* b2 = last ? nB : cB + (size_t)(t + 2) * kstep;
            const char* a3 = a2 + kstep; const char* b3 = b2 + kstep;
            if (last && has_next) S.a_ready(nxt);
            if constexpr (SP2) {
            PG8_LDB(B0, 0, 0); PG8_LDB(B1, 0, 1); PG8_SCHED; PG8_LDA(At, 0, 0); PG8_STAGE(PG8_SA(1, 1), a1 + hstep, voffA);
            PG8_WAIT_V(8); PG8_WAIT_L(0); PG8_BAR; PG8_MMA(0, 0, At, B0); PG8_MMA(0, 1, At, B1); PG8_BAR; PG8_SCHED;
            PG8_LDA(At, 0, 1); PG8_STAGE(PG8_SB(0, 0), b2, voffB); PG8_STAGE(PG8_SB(0, 1), b2 + hstep, voffB); PG8_STAGE(PG8_SA(0, 0), a2, voffA);
            PG8_WAIT_V(8); PG8_WAIT_L(0); PG8_BAR; PG8_MMA(1, 0, At, B0); PG8_MMA(1, 1, At, B1); PG8_BAR; PG8_SCHED;
            PG8_LDB(B0, 1, 0); PG8_LDB(B1, 1, 1); PG8_SCHED; PG8_LDA(At, 1, 0); PG8_STAGE(PG8_SA(0, 1), a2 + hstep, voffA);
            PG8_WAIT_V(8); PG8_WAIT_L(0); PG8_BAR; PG8_MMA(0, 0, At, B0); PG8_MMA(0, 1, At, B1); PG8_BAR; PG8_SCHED;
            PG8_LDA(At, 1, 1); PG8_STAGE(PG8_SB(1, 0), b3, voffB); PG8_STAGE(PG8_SB(1, 1), b3 + hstep, voffB); PG8_STAGE(PG8_SA(1, 0), a3, voffA);
            PG8_WAIT_V(8); PG8_WAIT_L(0); PG8_BAR; PG8_MMA(1, 0, At, B0); PG8_MMA(1, 1, At, B1); PG8_BAR; PG8_SCHED;
            } else {
            PG8_LDB(B0, 0, 0); PG8_SCHED; PG8_LDA(At, 0, 0); PG8_STAGE(PG8_SA(1, 1), a1 + hstep, voffA);
            PG8_WAIT_L(8); PG8_BAR; PG8_WAIT_L(0); PG8_MMA(0, 0, At, B0); PG8_BAR; PG8_SCHED;
            PG8_LDB(B1, 0, 1); PG8_STAGE(PG8_SB(0, 0), b2, voffB);
            PG8_BAR; PG8_WAIT_L(0); PG8_MMA(0, 1, At, B1); PG8_BAR;
            PG8_LDA(At, 0, 1); PG8_STAGE(PG8_SA(0, 0), a2, voffA);
            PG8_BAR; PG8_WAIT_L(0); PG8_MMA(1, 0, At, B0); PG8_BAR; PG8_SCHED;
            PG8_STAGE(PG8_SB(0, 1), b2 + hstep, voffB);
            PG8_WAIT_V(6); PG8_BAR; PG8_MMA(1, 1, At, B1); PG8_BAR;
            PG8_LDB(B0, 1, 0); PG8_SCHED; PG8_LDA(At, 1, 0); PG8_STAGE(PG8_SA(0, 1), a2 + hstep, voffA);
            PG8_WAIT_L(8); PG8_BAR; PG8_WAIT_L(0); PG8_MMA(0, 0, At, B0); PG8_BAR; PG8_SCHED;
            PG8_LDB(B1, 1, 1); PG8_STAGE(PG8_SB(1, 0), b3, voffB);
            PG8_BAR; PG8_WAIT_L(0); PG8_MMA(0, 1, At, B1); PG8_BAR;
            PG8_LDA(At, 1, 1); PG8_STAGE(PG8_SA(1, 0), a3, voffA);
            PG8_BAR; PG8_WAIT_L(0); PG8_MMA(1, 0, At, B0); PG8_BAR; PG8_SCHED;
            PG8_STAGE(PG8_SB(1, 1), b3 + hstep, voffB);
            PG8_WAIT_V(6); PG8_BAR; PG8_MMA(1, 1, At, B1); PG8_BAR;
            }
        }
        if constexpr (ALIGN_EPI) { if (wr == 0) PG8_BAR; }
        if constexpr (!Epi::AFTER_DRAIN) { E(acc, cur, wr, wc, fr, fq); S.done(cur); }
        if (!has_next) break;
#pragma unroll
        for (int a = 0; a < 2; ++a)
#pragma unroll
            for (int b = 0; b < 2; ++b)
#pragma unroll
                for (int m = 0; m < 4; ++m)
#pragma unroll
                    for (int n = 0; n < 2; ++n) acc[a][b][m][n] = (f32x4){0.f, 0.f, 0.f, 0.f};
        cur = nxt; cA = nA; cB = nB; ++ui;
        if constexpr (ALIGN_EPI) { if (wr == 1) PG8_BAR; }
    }
    PG8_WAIT_V(0);
    if constexpr (!ALIGN_EPI) { if (wr == 0) PG8_BAR; }
    PG8_BAR;
    if constexpr (Epi::AFTER_DRAIN) { E.fused(acc, cur, wr, wc, fr, fq, lds, wid, lane); S.done(cur); }
#undef PG8_SA
#undef PG8_SB
#undef PG8_STAGE
#undef PG8_LDA
#undef PG8_LDB
#undef PG8_MMA
#undef PG8_WAIT_V
#undef PG8_WAIT_L
#undef PG8_BAR
#undef PG8_SCHED
}
}

namespace cg = cooperative_groups;
using pg8::bf16_t; using pg8::bf16x8; using pg8::f32x4; using pg8::u32x4; using pg8::Unit;
typedef float f32x2c __attribute__((ext_vector_type(2)));
typedef __bf16 bf16x2c __attribute__((ext_vector_type(2)));
__device__ __forceinline__ unsigned cvt_pk_bf16(float lo, float hi) { const f32x2c v = {lo, hi}; return __builtin_bit_cast(unsigned, __builtin_convertvector(v, bf16x2c)); }
#define LAS __attribute__((address_space(3)))
typedef unsigned u32x2 __attribute__((ext_vector_type(2)));
typedef float f32x2v __attribute__((ext_vector_type(2)));

constexpr int M_TOK = 8192, DM = 2048, FF = 5632, HW = 1024, CW = 1024, MIXIN = 7168, PLE = 256, SEQ = 2048;
constexpr float EPS = 1e-6f;
constexpr size_t MiB = 1ull << 20;
constexpr size_t WS_W1GU = 0, WS_W1D = 44 * MiB, WS_WIN = 66 * MiB, WS_WOUT = 94 * MiB, WS_W2GU = 102 * MiB, WS_W2D = 146 * MiB,
                 WS_WPG = 168 * MiB, WS_WPE = 176 * MiB, WS_PB = 177 * MiB, WS_XB = 181 * MiB, WS_MIX = 213 * MiB, WS_G = 245 * MiB,
                 WS_QS = 245 * MiB, WS_VH = 261 * MiB, WS_GH = 277 * MiB, WS_BC = 293 * MiB, WS_UC = 309 * MiB, WS_LF = 325 * MiB,
                 WS_S = 357 * MiB, WS_PLE = 0, WS_SS = 389 * MiB, WS_DD = 389 * MiB + 512 * 1024, WS_BAR = 390 * MiB + 512 * 1024, WS_END = 391 * MiB, WS_U = 0;
constexpr int LDS_BYTES = 150 * 1024;
constexpr int NPHASE = 12;

__device__ __forceinline__ float bf2f(bf16_t b) { return __uint_as_float(((unsigned)b) << 16); }
__device__ __forceinline__ float bflo(unsigned w) { return __uint_as_float(w << 16); }
__device__ __forceinline__ float bfhi(unsigned w) { return __uint_as_float(w & 0xffff0000u); }
__device__ __forceinline__ float wave_sum(float v) {
#pragma unroll
    for (int o = 1; o < 64; o <<= 1) v += __shfl_xor(v, o);
    return v;
}
__device__ __forceinline__ float row16_sum(float x) {
    x += __builtin_bit_cast(float, __builtin_amdgcn_update_dpp(0, __builtin_bit_cast(int, x), 0xB1, 0xF, 0xF, true));
    x += __builtin_bit_cast(float, __builtin_amdgcn_update_dpp(0, __builtin_bit_cast(int, x), 0x4E, 0xF, 0xF, true));
    x += __builtin_bit_cast(float, __builtin_amdgcn_update_dpp(0, __builtin_bit_cast(int, x), 0x141, 0xF, 0xF, true));
    x += __builtin_bit_cast(float, __builtin_amdgcn_update_dpp(0, __builtin_bit_cast(int, x), 0x140, 0xF, 0xF, true));
    return x;
}
__device__ __forceinline__ float fsigmoid(float x) { return __builtin_amdgcn_rcpf(1.0f + __expf(-x)); }
__device__ __forceinline__ float fsilu(float x) { return x * fsigmoid(x); }
__device__ __forceinline__ float rinv_of(float ss) { return rsqrtf(ss * (1.0f / DM) + EPS); }

struct EpiGateUp {
    static constexpr bool PERM = true, AFTER_DRAIN = false;
    bf16_t* G; const float* ss;
    __device__ __forceinline__ void operator()(const f32x4 (&acc)[2][2][4][2], const Unit& u, int wr, int wc, int fr, int fq) const {
        const int row0 = u.pm * 256 + wr * 64 + fr, col0 = u.pn * 128 + wc * 32 + 8 * fq;
#pragma unroll
        for (int ai = 0; ai < 2; ++ai)
#pragma unroll
            for (int m = 0; m < 4; ++m) {
                const int r = row0 + ai * 128 + m * 16; const float ri = rinv_of(ss[r]);
                float v[8];
#pragma unroll
                for (int n = 0; n < 2; ++n)
#pragma unroll
                    for (int j = 0; j < 4; ++j) v[n * 4 + j] = fsilu(acc[ai][0][m][n][j] * ri) * (acc[ai][1][m][n][j] * ri);
                u32x4 w; w.x = cvt_pk_bf16(v[0], v[1]); w.y = cvt_pk_bf16(v[2], v[3]); w.z = cvt_pk_bf16(v[4], v[5]); w.w = cvt_pk_bf16(v[6], v[7]);
                *(u32x4*)(G + (size_t)r * FF + col0) = w;
            }
    }
};
struct EpiResid {
    static constexpr bool PERM = true, AFTER_DRAIN = false;
    bf16_t* XB; float* ss_out; float scale;
    __device__ __forceinline__ void operator()(f32x4 (&acc)[2][2][4][2], const Unit& u, int wr, int wc, int fr, int fq) const {
        const int row0 = u.pm * 256 + wr * 64 + fr, col0 = u.pn * 256 + wc * 32 + 8 * fq;
#pragma unroll
        for (int ai = 0; ai < 2; ++ai) {
#pragma unroll
            for (int m = 0; m < 4; ++m)
#pragma unroll
                for (int bj = 0; bj < 2; ++bj) {
                    const size_t off = (size_t)(row0 + ai * 128 + m * 16) * DM + col0 + bj * 128;
                    const u32x4 xw = *(const u32x4*)(XB + off);
                    f32x4 r0, r1; r0[0] = bflo(xw.x); r0[1] = bfhi(xw.x); r0[2] = bflo(xw.y); r0[3] = bfhi(xw.y); r1[0] = bflo(xw.z); r1[1] = bfhi(xw.z); r1[2] = bflo(xw.w); r1[3] = bfhi(xw.w);
                    acc[ai][bj][m][0] = r0 + acc[ai][bj][m][0] * scale; acc[ai][bj][m][1] = r1 + acc[ai][bj][m][1] * scale;
                }
            asm volatile("" ::: "memory");
#pragma unroll
            for (int m = 0; m < 4; ++m) {
                const int r = row0 + ai * 128 + m * 16; float sq = 0.f;
#pragma unroll
                for (int bj = 0; bj < 2; ++bj) {
                    const size_t off = (size_t)r * DM + col0 + bj * 128;
                    const f32x4 v0 = acc[ai][bj][m][0], v1 = acc[ai][bj][m][1];
                    u32x4 w; w.x = cvt_pk_bf16(v0[0], v0[1]); w.y = cvt_pk_bf16(v0[2], v0[3]); w.z = cvt_pk_bf16(v1[0], v1[1]); w.w = cvt_pk_bf16(v1[2], v1[3]);
                    *(u32x4*)(XB + off) = w;
                    sq += (v0[0] * v0[0] + v0[1] * v0[1]) + (v0[2] * v0[2] + v0[3] * v0[3]) + (v1[0] * v1[0] + v1[1] * v1[1]) + (v1[2] * v1[2] + v1[3] * v1[3]);
                }
                sq += __shfl_xor(sq, 16); sq += __shfl_xor(sq, 32);
                if (fq == 0) atomicAdd(ss_out + r, sq);
            }
            asm volatile("" ::: "memory");
        }
    }
};
struct EpiMixIn {
    static constexpr bool PERM = true, AFTER_DRAIN = false;
    const float* ss; const float* lbl;
    bf16_t *QS, *UC; float* LF;
    __device__ __forceinline__ void operator()(const f32x4 (&acc)[2][2][4][2], const Unit& u, int wr, int wc, int fr, int fq) const {
        const int row0 = u.pm * 256 + wr * 64 + fr; const int sec = u.pn >> 2;
        if (u.pn >= 20) {
            const int col0 = (u.pn - 20) * 128 + wc * 32 + 8 * fq;
#pragma unroll
            for (int ai = 0; ai < 2; ++ai)
#pragma unroll
                for (int m = 0; m < 4; ++m) {
                    const int r = row0 + ai * 128 + m * 16; const float ri = rinv_of(ss[r]); const float ri2 = ri * ri;
                    float v[8];
#pragma unroll
                    for (int n = 0; n < 2; ++n)
#pragma unroll
                        for (int j = 0; j < 4; ++j) v[n * 4 + j] = acc[ai][0][m][n][j] * acc[ai][1][m][n][j] * ri2;
                    u32x4 w; w.x = cvt_pk_bf16(v[0], v[1]); w.y = cvt_pk_bf16(v[2], v[3]); w.z = cvt_pk_bf16(v[4], v[5]); w.w = cvt_pk_bf16(v[6], v[7]);
                    *(u32x4*)(UC + (size_t)r * CW + col0) = w;
                }
            return;
        }
        const int col0 = (u.pn & 3) * 256 + wc * 32 + 8 * fq;
        if (sec == 1) {
#pragma unroll
            for (int bj = 0; bj < 2; ++bj)
#pragma unroll
                for (int n = 0; n < 2; ++n) {
                    const int c = col0 + bj * 128 + 4 * n; const f32x4 l0 = *(const f32x4*)(lbl + c), l1 = *(const f32x4*)(lbl + 1024 + c);
                    f32x4 lb; lb[0] = fsigmoid(l0[0] - l1[0]); lb[1] = fsigmoid(l0[1] - l1[1]); lb[2] = fsigmoid(l0[2] - l1[2]); lb[3] = fsigmoid(l0[3] - l1[3]);
#pragma unroll
                    for (int ai = 0; ai < 2; ++ai)
#pragma unroll
                        for (int m = 0; m < 4; ++m) {
                            const int r = row0 + ai * 128 + m * 16; const float ri = rinv_of(ss[r]);
                            const f32x4 x = acc[ai][bj][m][n]; f32x4 o;
                            o[0] = __logf(lb[0] + (1.0f - lb[0]) * fsigmoid(x[0] * ri)); o[1] = __logf(lb[1] + (1.0f - lb[1]) * fsigmoid(x[1] * ri));
                            o[2] = __logf(lb[2] + (1.0f - lb[2]) * fsigmoid(x[2] * ri)); o[3] = __logf(lb[3] + (1.0f - lb[3]) * fsigmoid(x[3] * ri));
                            *(f32x4*)(LF + (size_t)r * HW + c) = o;
                        }
                }
            return;
        }
        bf16_t* dst = QS + (size_t)(sec == 0 ? 0 : sec - 1) * ((size_t)M_TOK * HW);
        const bool act = (sec == 0 || sec == 3);
#pragma unroll
        for (int ai = 0; ai < 2; ++ai)
#pragma unroll
            for (int m = 0; m < 4; ++m) {
                const int r = row0 + ai * 128 + m * 16; const float ri = rinv_of(ss[r]);
#pragma unroll
                for (int bj = 0; bj < 2; ++bj) {
                    float v[8];
#pragma unroll
                    for (int n = 0; n < 2; ++n)
#pragma unroll
                        for (int j = 0; j < 4; ++j) { const float x = acc[ai][bj][m][n][j] * ri; v[n * 4 + j] = act ? fsilu(x) : x; }
                    u32x4 w; w.x = cvt_pk_bf16(v[0], v[1]); w.y = cvt_pk_bf16(v[2], v[3]); w.z = cvt_pk_bf16(v[4], v[5]); w.w = cvt_pk_bf16(v[6], v[7]);
                    *(u32x4*)(dst + (size_t)r * HW + col0 + bj * 128) = w;
                }
            }
    }
};
struct EpiStoreBf16 {
    static constexpr bool PERM = true, AFTER_DRAIN = false;
    bf16_t* O;
    __device__ __forceinline__ void operator()(const f32x4 (&acc)[2][2][4][2], const Unit& u, int wr, int wc, int fr, int fq) const {
        const int row0 = u.pm * 256 + wr * 64 + fr, col0 = u.pn * 256 + wc * 32 + 8 * fq;
#pragma unroll
        for (int ai = 0; ai < 2; ++ai)
#pragma unroll
            for (int m = 0; m < 4; ++m) {
                const int r = row0 + ai * 128 + m * 16;
#pragma unroll
                for (int bj = 0; bj < 2; ++bj) {
                    const f32x4 v0 = acc[ai][bj][m][0], v1 = acc[ai][bj][m][1];
                    u32x4 w; w.x = cvt_pk_bf16(v0[0], v0[1]); w.y = cvt_pk_bf16(v0[2], v0[3]); w.z = cvt_pk_bf16(v1[0], v1[1]); w.w = cvt_pk_bf16(v1[2], v1[3]);
                    *(u32x4*)(O + (size_t)r * DM + col0 + bj * 128) = w;
                }
            }
    }
};
struct EpiPleGate {
    static constexpr bool PERM = true, AFTER_DRAIN = false;
    const bf16_t* XB; const bf16_t* P; bf16_t* H4; const float* ss;
    __device__ __forceinline__ void operator()(f32x4 (&acc)[2][2][4][2], const Unit& u, int wr, int wc, int fr, int fq) const {
        const int row0 = u.pm * 256 + wr * 64 + fr, col0 = u.pn * 256 + wc * 32 + 8 * fq;
#pragma unroll
        for (int ai = 0; ai < 2; ++ai)
#pragma unroll
            for (int m = 0; m < 4; ++m) {
                const int r = row0 + ai * 128 + m * 16; const float ri = rinv_of(ss[r]);
#pragma unroll
                for (int bj = 0; bj < 2; ++bj) {
                    const size_t off = (size_t)r * DM + col0 + bj * 128;
                    const u32x4 pw = *(const u32x4*)(P + off), xw = *(const u32x4*)(XB + off);
                    const f32x4 a0 = acc[ai][bj][m][0], a1 = acc[ai][bj][m][1];
                    u32x4 w;
                    w.x = cvt_pk_bf16(bflo(xw.x) + fsigmoid(a0[0] * ri) * bflo(pw.x), bfhi(xw.x) + fsigmoid(a0[1] * ri) * bfhi(pw.x));
                    w.y = cvt_pk_bf16(bflo(xw.y) + fsigmoid(a0[2] * ri) * bflo(pw.y), bfhi(xw.y) + fsigmoid(a0[3] * ri) * bfhi(pw.y));
                    w.z = cvt_pk_bf16(bflo(xw.z) + fsigmoid(a1[0] * ri) * bflo(pw.z), bfhi(xw.z) + fsigmoid(a1[1] * ri) * bfhi(pw.z));
                    w.w = cvt_pk_bf16(bflo(xw.w) + fsigmoid(a1[2] * ri) * bflo(pw.w), bfhi(xw.w) + fsigmoid(a1[3] * ri) * bfhi(pw.w));
                    *(u32x4*)(H4 + off) = w;
                }
            }
    }
};

template <int MODE>
__device__ __forceinline__ void p0_item(const float* W, const float* W2, const float* gain, int K, int N, bf16_t* WT, LAS float* scr, int item, int lane) {
    const int nblk_k = K / 64; const int nb = item / nblk_k, kb = item % nblk_k; const int k0 = 64 * kb, n0 = 32 * nb;
    const float* src = W; int c0 = n0;
    if (MODE == 1) { const int t = n0 >> 8, bj = (n0 >> 7) & 1, c = n0 & 127; src = bj ? W2 : W; c0 = 128 * t + c; }
    if (MODE == 2) { if (n0 >= 5120) { const int tt = n0 - 5120; const int t = tt >> 8, bj = (tt >> 7) & 1, c = tt & 127; c0 = 5120 + 1024 * bj + 128 * t + c; } }
    float v[32], gg[32];
    const float* sp = src + (size_t)(k0 + (lane >> 5)) * N + c0 + (lane & 31);
#pragma unroll
    for (int i = 0; i < 32; ++i) v[i] = __builtin_nontemporal_load(sp + (size_t)(2 * i) * N);
    if (gain) {
#pragma unroll
        for (int i = 0; i < 32; ++i) gg[i] = gain[k0 + 2 * i + (lane >> 5)];
#pragma unroll
        for (int i = 0; i < 32; ++i) v[i] *= gg[i];
    }
#pragma unroll
    for (int i = 0; i < 32; ++i) scr[(2 * i + (lane >> 5)) * 33 + (lane & 31)] = v[i];
    asm volatile("s_waitcnt lgkmcnt(0)" ::: "memory");
    const int c = lane & 7;
#pragma unroll
    for (int j = 0; j < 4; ++j) { const int n = (lane >> 3) + 8 * j; const LAS float* s = scr + (8 * c) * 33 + n;
        u32x4 o; o.x = cvt_pk_bf16(s[0 * 33], s[1 * 33]); o.y = cvt_pk_bf16(s[2 * 33], s[3 * 33]); o.z = cvt_pk_bf16(s[4 * 33], s[5 * 33]); o.w = cvt_pk_bf16(s[6 * 33], s[7 * 33]);
        *(u32x4*)(WT + (size_t)(n0 + n) * K + k0 + 8 * c) = o; }
    asm volatile("s_waitcnt lgkmcnt(0)" ::: "memory");
}

struct Args { const float* in[21]; float* out; unsigned char* ws; int ph_lo, ph_hi; };

constexpr int CV_I0 = 32 * 352, CV_I1 = 88 * 64, CV_I2 = 32 * 224, CV_I3 = 32 * 64, CV_I7 = 4 * 64;
constexpr int CV_END = 2 * CV_I0 + 2 * CV_I1 + CV_I2 + 2 * CV_I3 + CV_I7, CV_T1 = CV_END - 10000, CV_T0 = CV_T1 - 10000, CV_TA = CV_I0 + CV_I2 + CV_I3 + CV_I7, CV_P0 = CV_I0 + CV_I7 + CV_I2 - 2000, CV_WO = CV_I0 + CV_I7 + CV_I2;
__device__ __forceinline__ void conv_range(const Args& a, LAS unsigned char* lds, int wave, int lane, int lo, int hi, int w0, int nw) {
    unsigned char* ws = a.ws;
    LAS float* scr = (LAS float*)(lds + wave * 16384);
    for (int it = lo + w0; it < hi; it += nw) {
        int r = it;
        if (r < CV_I0) { p0_item<1>(a.in[3], a.in[4], a.in[2], DM, FF, (bf16_t*)(ws + WS_W1GU), scr, r, lane); continue; } r -= CV_I0;
        if (r < CV_I7) { p0_item<0>(a.in[18], nullptr, nullptr, PLE, DM, (bf16_t*)(ws + WS_WPE), scr, r, lane); continue; } r -= CV_I7;
        if (r < CV_I2) { p0_item<2>(a.in[7], nullptr, a.in[6], DM, MIXIN, (bf16_t*)(ws + WS_WIN), scr, r, lane); continue; } r -= CV_I2;
        if (r < CV_I3) { p0_item<0>(a.in[12], nullptr, nullptr, DM, DM, (bf16_t*)(ws + WS_WOUT), scr, r, lane); continue; } r -= CV_I3;
        if (r < CV_I3) { p0_item<0>(a.in[19], nullptr, a.in[17], DM, DM, (bf16_t*)(ws + WS_WPG), scr, r, lane); continue; } r -= CV_I3;
        if (r < CV_I1) { p0_item<0>(a.in[16], nullptr, nullptr, FF, DM, (bf16_t*)(ws + WS_W2D), scr, r, lane); continue; } r -= CV_I1;
        if (r < CV_I0) { p0_item<1>(a.in[14], a.in[15], a.in[13], DM, FF, (bf16_t*)(ws + WS_W2GU), scr, r, lane); continue; } r -= CV_I0;
        p0_item<0>(a.in[5], nullptr, nullptr, FF, DM, (bf16_t*)(ws + WS_W1D), scr, r, lane);
    }
}
__device__ __forceinline__ void conv_tail(const Args& a, LAS unsigned char* lds, int wave, int lane, int nunits, int lo, int hi, int vc) {
    const int r = nunits % (int)gridDim.x;
    if (r == 0) { conv_range(a, lds, wave, lane, lo, hi, vc * 8 + wave, gridDim.x * 8); return; }
    if (vc >= r) conv_range(a, lds, wave, lane, lo, hi, (vc - r) * 8 + wave, ((int)gridDim.x - r) * 8);
}

__device__ __forceinline__ void phase0(const Args& a, LAS unsigned char* lds, int wave, int lane) {
    unsigned char* ws = a.ws;
    const int gw = blockIdx.x * 8 + wave, NGW = gridDim.x * 8;
    conv_range(a, lds, wave, lane, 0, CV_P0, gw, NGW);
    float* SS = (float*)(ws + WS_SS);
    for (int m = gw; m < M_TOK; m += NGW) {
        const f32x4* xr = (const f32x4*)(a.in[0] + (size_t)m * DM) + lane; u32x2* xb = (u32x2*)((bf16_t*)(ws + WS_XB) + (size_t)m * DM) + lane;
        float s = 0.f;
#pragma unroll
        for (int j = 0; j < 8; ++j) { const f32x4 v = __builtin_nontemporal_load(xr + 64 * j); s += (v[0] * v[0] + v[1] * v[1]) + (v[2] * v[2] + v[3] * v[3]);
            u32x2 w; w.x = cvt_pk_bf16(v[0], v[1]); w.y = cvt_pk_bf16(v[2], v[3]); xb[64 * j] = w; }
        s = wave_sum(s);
        if (lane == 0) { SS[m] = s; SS[8192 + m] = 0.f; SS[16384 + m] = 0.f; SS[24576 + m] = 0.f; }
    }
    { const int gt = blockIdx.x * 512 + threadIdx.x, NT = gridDim.x * 512;
      for (int i = gt; i < M_TOK * PLE / 4; i += NT) { const f32x4 v = __builtin_nontemporal_load((const f32x4*)a.in[1] + i); u32x2 w; w.x = cvt_pk_bf16(v[0], v[1]); w.y = cvt_pk_bf16(v[2], v[3]); ((u32x2*)(ws + WS_PB))[i] = w; } }
}

constexpr int HP = 136, VP = 72;
constexpr int L_QT = 0, L_QH = L_QT + 64 * HP * 2, L_KA = L_QH + 64 * HP * 2, L_KB = L_KA + 64 * HP * 2, L_ST = L_KB + 32 * HP * 2, L_VT = L_ST + 128 * HP * 2,
              L_P = L_VT + 128 * VP * 2, L_SEG = L_P + 64 * VP * 2, L_PART = L_SEG + 8 * 128 * 4, L_RINV = L_PART + 8 * 64 * 4, L_HEND = L_RINV + 256, L_KT = 0;
static_assert(L_HEND <= LDS_BYTES, "LDS");
#define MFMA16(a, b, c) __builtin_amdgcn_mfma_f32_16x16x32_bf16((a), (b), (c), 0, 0, 0)
__device__ __forceinline__ bf16_t f2bf(float x) { return (bf16_t)(cvt_pk_bf16(x, 0.f) & 0xffffu); }

#define LDSBAR() do { asm volatile("s_waitcnt lgkmcnt(0)" ::: "memory"); __builtin_amdgcn_s_barrier(); asm volatile("" ::: "memory"); } while (0)
__device__ __forceinline__ void hgrn_pass_a(const Args& a, LAS unsigned char* lds, int wave, int lane) {
    unsigned char* ws = a.ws;
    const float* LF = (const float*)(ws + WS_LF); const bf16_t* VH = (const bf16_t*)(ws + WS_VH); bf16_t* U = (bf16_t*)(ws + WS_U); float* Dd = (float*)(ws + WS_DD);
    const int tid = threadIdx.x, k = tid & 127, sg = tid >> 7, fr = lane & 15, fq = lane >> 4;
    LAS bf16_t* VT = (LAS bf16_t*)(lds + L_VT); LAS bf16_t* KT = (LAS bf16_t*)(lds + L_KT); LAS float* SEG = (LAS float*)(lds + L_SEG);
    float lf[16]; u32x4 vv[2];
#define PA_LOAD(it) do { const int r0_ = ((it) >> 3) * 64, c0_ = ((it) & 7) * 128; \
        _Pragma("unroll") for (int i = 0; i < 16; ++i) lf[i] = LF[(size_t)(r0_ + 16 * sg + i) * HW + c0_ + k]; \
        _Pragma("unroll") for (int j = 0; j < 2; ++j) { const int idx = tid + 512 * j; vv[j] = *(const u32x4*)(VH + (size_t)(r0_ + (idx >> 4)) * HW + c0_ + 8 * (idx & 15)); } } while (0)
    int item = blockIdx.x;
    if (item < 1024) PA_LOAD(item);
    for (; item < 1024; item += gridDim.x) {
        float b[16];
        float run = 0.f;
#pragma unroll
        for (int i = 0; i < 16; ++i) { run += lf[i]; b[i] = run; }
        SEG[sg * 128 + k] = run;
        LDSBAR();
        const float s0 = SEG[k], s1 = SEG[128 + k], s2 = SEG[256 + k], s3 = SEG[384 + k];
        const float pre = sg == 0 ? 0.f : (sg == 1 ? s0 : (sg == 2 ? s0 + s1 : s0 + s1 + s2));
        const float blast = s0 + s1 + s2 + s3;
        unsigned pk[8];
#pragma unroll
        for (int i = 0; i < 8; ++i) {
            const float e0 = (1.0f - __expf(lf[2 * i])) * __expf(blast - (pre + b[2 * i])), e1 = (1.0f - __expf(lf[2 * i + 1])) * __expf(blast - (pre + b[2 * i + 1]));
            pk[i] = cvt_pk_bf16(e0, e1); }
        { u32x4 w0, w1; w0.x = pk[0]; w0.y = pk[1]; w0.z = pk[2]; w0.w = pk[3]; w1.x = pk[4]; w1.y = pk[5]; w1.z = pk[6]; w1.w = pk[7];
          *(LAS u32x4*)(KT + k * VP + 16 * sg) = w0; *(LAS u32x4*)(KT + k * VP + 16 * sg + 8) = w1; }
#pragma unroll
        for (int j = 0; j < 2; ++j) { const int idx = tid + 512 * j, s = idx >> 4, v0 = 8 * (idx & 15);
            VT[(v0 + 0) * VP + s] = (bf16_t)(vv[j].x & 0xffffu); VT[(v0 + 1) * VP + s] = (bf16_t)(vv[j].x >> 16);
            VT[(v0 + 2) * VP + s] = (bf16_t)(vv[j].y & 0xffffu); VT[(v0 + 3) * VP + s] = (bf16_t)(vv[j].y >> 16);
            VT[(v0 + 4) * VP + s] = (bf16_t)(vv[j].z & 0xffffu); VT[(v0 + 5) * VP + s] = (bf16_t)(vv[j].z >> 16);
            VT[(v0 + 6) * VP + s] = (bf16_t)(vv[j].w & 0xffffu); VT[(v0 + 7) * VP + s] = (bf16_t)(vv[j].w >> 16); }
        if (sg == 0) Dd[item * 128 + k] = __expf(blast);
        if (item + (int)gridDim.x < 1024) PA_LOAD(item + (int)gridDim.x);
        LDSBAR();
        const bf16x8 a0 = *(const LAS bf16x8*)(VT + (16 * wave + fr) * VP + fq * 8), a1 = *(const LAS bf16x8*)(VT + (16 * wave + fr) * VP + 32 + fq * 8);
        bf16_t* up = U + (size_t)item * 16384 + (16 * wave + 4 * fq) * 128 + fr;
#pragma unroll
        for (int kt = 0; kt < 8; ++kt) {
            const bf16x8 b0 = *(const LAS bf16x8*)(KT + (16 * kt + fr) * VP + fq * 8), b1 = *(const LAS bf16x8*)(KT + (16 * kt + fr) * VP + 32 + fq * 8);
            f32x4 acc = {0.f, 0.f, 0.f, 0.f};
            acc = MFMA16(a0, b0, acc); acc = MFMA16(a1, b1, acc);
            up[16 * kt] = f2bf(acc[0]); up[16 * kt + 128] = f2bf(acc[1]); up[16 * kt + 256] = f2bf(acc[2]); up[16 * kt + 384] = f2bf(acc[3]);
        }
        LDSBAR();
    }
#undef PA_LOAD
}

__device__ __forceinline__ void hgrn_scan(const Args& a) {
    unsigned char* ws = a.ws;
    const bf16_t* U = (const bf16_t*)(ws + WS_U); const float* Dd = (const float*)(ws + WS_DD); bf16_t* SP = (bf16_t*)(ws + WS_S);
    for (int e = (blockIdx.x * 512 + threadIdx.x) * 4; e < 32 * 16384; e += gridDim.x * 512 * 4) {
        const int bh = e >> 14, vk = e & 16383, bb = bh >> 3, h = bh & 7;
        f32x4 S = {0.f, 0.f, 0.f, 0.f};
#pragma unroll 8
        for (int ci = 0; ci < 32; ++ci) {
            const size_t item = (size_t)((bb * 32 + ci) * 8 + h);
            const u32x2 uw = *(const u32x2*)(U + item * 16384 + vk); f32x4 u; u[0] = bflo(uw.x); u[1] = bfhi(uw.x); u[2] = bflo(uw.y); u[3] = bfhi(uw.y); const f32x4 d = *(const f32x4*)(Dd + item * 128 + (vk & 127));
            u32x2 w; w.x = cvt_pk_bf16(S[0], S[1]); w.y = cvt_pk_bf16(S[2], S[3]); *(u32x2*)(SP + item * 16384 + vk) = w;
            S = d * S + u;
        }
    }
}

__device__ __forceinline__ void conv_mixer(const Args& a, int wave, int lane) {
    unsigned char* ws = a.ws;
    const bf16_t* BC = (const bf16_t*)(ws + WS_BC); const bf16_t* UC = (const bf16_t*)(ws + WS_UC); bf16_t* MIX = (bf16_t*)(ws + WS_MIX);
    const float* cn = a.in[11]; const float* cw = a.in[8];
    const int gw = blockIdx.x * 8 + wave, NGW = gridDim.x * 8;
    for (int it = gw; it < M_TOK * 2; it += NGW) {
        const int row = it >> 1, c = (it & 1) * 512 + lane * 8, t = row & (SEQ - 1);
        const size_t off = (size_t)row * CW + c;
        const u32x4 z = {0u, 0u, 0u, 0u};
        const u32x4 u0 = *(const u32x4*)(UC + off), u1 = t >= 1 ? *(const u32x4*)(UC + off - CW) : z, u2 = t >= 2 ? *(const u32x4*)(UC + off - 2 * CW) : z, bg = *(const u32x4*)(BC + off);
        float y[8]; float ssq = 0.f;
#pragma unroll
        for (int q = 0; q < 4; ++q) {
            const unsigned a0 = u0[q], a1 = u1[q], a2 = u2[q], bb = bg[q]; const int cc = c + 2 * q;
            y[2 * q] = bflo(bb) * (cw[cc] * bflo(a2) + cw[CW + cc] * bflo(a1) + cw[2 * CW + cc] * bflo(a0));
            y[2 * q + 1] = bfhi(bb) * (cw[cc + 1] * bfhi(a2) + cw[CW + cc + 1] * bfhi(a1) + cw[2 * CW + cc + 1] * bfhi(a0));
            ssq += y[2 * q] * y[2 * q] + y[2 * q + 1] * y[2 * q + 1];
        }
        ssq = row16_sum(ssq);
        const float ri = rsqrtf(ssq * (1.0f / 128) + EPS);
        u32x4 w;
        w.x = cvt_pk_bf16(y[0] * ri * cn[c], y[1] * ri * cn[c + 1]); w.y = cvt_pk_bf16(y[2] * ri * cn[c + 2], y[3] * ri * cn[c + 3]);
        w.z = cvt_pk_bf16(y[4] * ri * cn[c + 4], y[5] * ri * cn[c + 5]); w.w = cvt_pk_bf16(y[6] * ri * cn[c + 6], y[7] * ri * cn[c + 7]);
        *(u32x4*)(MIX + (size_t)row * DM + HW + c) = w;
    }
}

__device__ __forceinline__ void hgrn_pass_c(const Args& a, LAS unsigned char* lds, int wave, int lane) {
    unsigned char* ws = a.ws;
    const float* LF = (const float*)(ws + WS_LF); const bf16_t* VH = (const bf16_t*)(ws + WS_VH); const bf16_t* QS = (const bf16_t*)(ws + WS_QS); const bf16_t* GH = (const bf16_t*)(ws + WS_GH);
    const bf16_t* SP = (const bf16_t*)(ws + WS_S); bf16_t* MIX = (bf16_t*)(ws + WS_MIX); const float* hn = a.in[10];
    const int tid = threadIdx.x, k = tid & 127, sg = tid >> 7, fr = lane & 15, fq = lane >> 4;
    LAS bf16_t* QT = (LAS bf16_t*)(lds + L_QT); LAS bf16_t* QH = (LAS bf16_t*)(lds + L_QH); LAS bf16_t* KA = (LAS bf16_t*)(lds + L_KA); LAS bf16_t* KB = (LAS bf16_t*)(lds + L_KB);
    LAS bf16_t* ST = (LAS bf16_t*)(lds + L_ST); LAS bf16_t* VT = (LAS bf16_t*)(lds + L_VT); LAS bf16_t* P = (LAS bf16_t*)(lds + L_P);
    LAS float* SEG = (LAS float*)(lds + L_SEG); LAS float* PART = (LAS float*)(lds + L_PART); LAS float* RINV = (LAS float*)(lds + L_RINV);
    const int k0 = 2 * (tid & 63);
    f32x2v lf2[8]; unsigned q2[8]; u32x4 vv[2], sv[4];
#define PC_LOAD(it) do { const int r0_ = ((it) >> 3) * 64, c0_ = ((it) & 7) * 128; \
        _Pragma("unroll") for (int i = 0; i < 8; ++i) { lf2[i] = *(const f32x2v*)(LF + (size_t)(r0_ + 8 * wave + i) * HW + c0_ + k0); q2[i] = *(const unsigned*)(QS + (size_t)(r0_ + 8 * wave + i) * HW + c0_ + k0); } \
        _Pragma("unroll") for (int j = 0; j < 2; ++j) { const int idx = tid + 512 * j; vv[j] = *(const u32x4*)(VH + (size_t)(r0_ + (idx >> 4)) * HW + c0_ + 8 * (idx & 15)); } \
        _Pragma("unroll") for (int j = 0; j < 4; ++j) { const int idx = tid + 512 * j; sv[j] = *(const u32x4*)(SP + (size_t)(it) * 16384 + (idx >> 4) * 128 + 8 * (idx & 15)); } } while (0)
    int item = blockIdx.x;
    if (item < 1024) PC_LOAD(item);
    for (; item < 1024; item += gridDim.x) {
        const int row0 = (item >> 3) * 64, cb = (item & 7) * 128;
        f32x2v b2[8]; f32x2v run = {0.f, 0.f};
#pragma unroll
        for (int i = 0; i < 8; ++i) { run += lf2[i]; b2[i] = run; }
        *(LAS f32x2v*)(SEG + wave * 128 + k0) = run;
        LDSBAR();
        f32x2v pre = {0.f, 0.f}, beta1 = {0.f, 0.f};
#pragma unroll
        for (int j = 0; j < 8; ++j) { const f32x2v sj = *(const LAS f32x2v*)(SEG + j * 128 + k0); if (j < wave) pre += sj; if (j < 4) beta1 += sj; }
        if (wave < 4) {
#pragma unroll
            for (int i = 0; i < 8; ++i) {
                const int so = (8 * wave + i) * HP + k0; const f32x2v bi = pre + b2[i];
                const float kk0 = 1.0f - __expf(lf2[i][0]), kk1 = 1.0f - __expf(lf2[i][1]);
                const unsigned qw = cvt_pk_bf16(bflo(q2[i]) * __expf(bi[0]), bfhi(q2[i]) * __expf(bi[1]));
                *(LAS unsigned*)(QT + so) = qw; *(LAS unsigned*)(QH + so) = qw;
                *(LAS unsigned*)(KA + so) = cvt_pk_bf16(kk0 * __expf(fminf(-bi[0], 80.f)), kk1 * __expf(fminf(-bi[1], 80.f)));
                *(LAS unsigned*)(KB + so) = cvt_pk_bf16(kk0 * __expf(beta1[0] - bi[0]), kk1 * __expf(beta1[1] - bi[1]));
            }
        } else {
#pragma unroll
            for (int i = 0; i < 8; ++i) {
                const int so = (8 * wave + i) * HP + k0; const f32x2v bi = pre + b2[i];
                const float kk0 = 1.0f - __expf(lf2[i][0]), kk1 = 1.0f - __expf(lf2[i][1]);
                const float q0 = bflo(q2[i]), q1 = bfhi(q2[i]);
                *(LAS unsigned*)(QH + so) = cvt_pk_bf16(q0 * __expf(bi[0]), q1 * __expf(bi[1]));
                *(LAS unsigned*)(QT + so) = cvt_pk_bf16(q0 * __expf(bi[0] - beta1[0]), q1 * __expf(bi[1] - beta1[1]));
                *(LAS unsigned*)(KA + so) = cvt_pk_bf16(kk0 * __expf(fminf(beta1[0] - bi[0], 80.f)), kk1 * __expf(fminf(beta1[1] - bi[1], 80.f)));
            }
        }
#pragma unroll
        for (int j = 0; j < 2; ++j) { const int idx = tid + 512 * j, s = idx >> 4, v0 = 8 * (idx & 15);
            VT[(v0 + 0) * VP + s] = (bf16_t)(vv[j].x & 0xffffu); VT[(v0 + 1) * VP + s] = (bf16_t)(vv[j].x >> 16);
            VT[(v0 + 2) * VP + s] = (bf16_t)(vv[j].y & 0xffffu); VT[(v0 + 3) * VP + s] = (bf16_t)(vv[j].y >> 16);
            VT[(v0 + 4) * VP + s] = (bf16_t)(vv[j].z & 0xffffu); VT[(v0 + 5) * VP + s] = (bf16_t)(vv[j].z >> 16);
            VT[(v0 + 6) * VP + s] = (bf16_t)(vv[j].w & 0xffffu); VT[(v0 + 7) * VP + s] = (bf16_t)(vv[j].w >> 16); }
#pragma unroll
        for (int j = 0; j < 4; ++j) { const int idx = tid + 512 * j; *(LAS u32x4*)(ST + (idx >> 4) * HP + 8 * (idx & 15)) = sv[j]; }
        if (item + (int)gridDim.x < 1024) PC_LOAD(item + (int)gridDim.x);
        LDSBAR();
        bf16_t gh[16];
#pragma unroll
        for (int q = 0; q < 16; ++q) gh[q] = GH[(size_t)(row0 + 16 * (q >> 2) + 4 * fq + (q & 3)) * HW + cb + 16 * wave + fr];
#pragma unroll
        for (int pp = 0; pp < 2; ++pp) {
            const int p = wave + 8 * pp, tt = p >> 2, st = p & 3;
            f32x4 acc = {0.f, 0.f, 0.f, 0.f};
            if (st <= tt) {
                const LAS bf16_t* kb = (tt >= 2 && st < 2) ? KB : KA;
#pragma unroll
                for (int ks = 0; ks < 4; ++ks) { const bf16x8 af = *(const LAS bf16x8*)(QT + (16 * tt + fr) * HP + ks * 32 + fq * 8), bfr = *(const LAS bf16x8*)(kb + (16 * st + fr) * HP + ks * 32 + fq * 8);
                    acc = MFMA16(af, bfr, acc); }
            }
#pragma unroll
            for (int r = 0; r < 4; ++r) { const bool keep = (st < tt) || (st == tt && fr <= 4 * fq + r); P[(16 * tt + 4 * fq + r) * VP + 16 * st + fr] = f2bf(keep ? acc[r] : 0.f); }
        }
        LDSBAR();
        bf16x8 bs[4], bv[2];
#pragma unroll
        for (int ks = 0; ks < 4; ++ks) bs[ks] = *(const LAS bf16x8*)(ST + (16 * wave + fr) * HP + ks * 32 + fq * 8);
#pragma unroll
        for (int ks = 0; ks < 2; ++ks) bv[ks] = *(const LAS bf16x8*)(VT + (16 * wave + fr) * VP + ks * 32 + fq * 8);
        f32x4 o[4];
#pragma unroll
        for (int tt = 0; tt < 4; ++tt) {
            f32x4 acc = {0.f, 0.f, 0.f, 0.f};
#pragma unroll
            for (int ks = 0; ks < 4; ++ks) { const bf16x8 af = *(const LAS bf16x8*)(QH + (16 * tt + fr) * HP + ks * 32 + fq * 8); acc = MFMA16(af, bs[ks], acc); }
            { const bf16x8 af = *(const LAS bf16x8*)(P + (16 * tt + fr) * VP + fq * 8); acc = MFMA16(af, bv[0], acc); }
            if (tt >= 2) { const bf16x8 af = *(const LAS bf16x8*)(P + (16 * tt + fr) * VP + 32 + fq * 8); acc = MFMA16(af, bv[1], acc); }
            o[tt] = acc;
        }
#pragma unroll
        for (int tt = 0; tt < 4; ++tt)
#pragma unroll
            for (int r = 0; r < 4; ++r) { const float x = row16_sum(o[tt][r] * o[tt][r]);
                if (fr == 0) PART[wave * 64 + 16 * tt + 4 * fq + r] = x; }
        LDSBAR();
        if (tid < 64) { float s = 0.f;
#pragma unroll
            for (int w = 0; w < 8; ++w) s += PART[w * 64 + tid];
            RINV[tid] = rsqrtf(s * (1.0f / 128) + EPS); }
        LDSBAR();
        const float hnv = hn[16 * wave + fr];
#pragma unroll
        for (int tt = 0; tt < 4; ++tt)
#pragma unroll
            for (int r = 0; r < 4; ++r) { const int t = 16 * tt + 4 * fq + r; const size_t row = (size_t)(row0 + t);
                const float g = bf2f(gh[tt * 4 + r]);
                MIX[row * DM + cb + 16 * wave + fr] = f2bf(o[tt][r] * RINV[t] * hnv * g); }
        LDSBAR();
    }
#undef PC_LOAD
}

__device__ __forceinline__ void phase_final(const Args& a, int wave, int lane) {
    const int gw = blockIdx.x * 8 + wave, NGW = gridDim.x * 8; const float* gF = a.in[20]; const bf16_t* H4 = (const bf16_t*)(a.ws + WS_MIX);
    for (int m = gw; m < M_TOK; m += NGW) {
        const u32x4* hr = (const u32x4*)(H4 + (size_t)m * DM) + lane; u32x4 w[4]; float s = 0.f;
#pragma unroll
        for (int j = 0; j < 4; ++j) { w[j] = __builtin_nontemporal_load(hr + 64 * j);
            s += (bflo(w[j].x) * bflo(w[j].x) + bfhi(w[j].x) * bfhi(w[j].x)) + (bflo(w[j].y) * bflo(w[j].y) + bfhi(w[j].y) * bfhi(w[j].y))
               + (bflo(w[j].z) * bflo(w[j].z) + bfhi(w[j].z) * bfhi(w[j].z)) + (bflo(w[j].w) * bflo(w[j].w) + bfhi(w[j].w) * bfhi(w[j].w)); }
        const float ri = rinv_of(wave_sum(s));
        f32x4* orow = (f32x4*)(a.out + (size_t)m * DM);
#pragma unroll
        for (int j = 0; j < 4; ++j) { const int c = (64 * j + lane) * 8; const f32x4 g0 = *(const f32x4*)(gF + c), g1 = *(const f32x4*)(gF + c + 4);
            f32x4 o0, o1; o0[0] = bflo(w[j].x) * ri * g0[0]; o0[1] = bfhi(w[j].x) * ri * g0[1]; o0[2] = bflo(w[j].y) * ri * g0[2]; o0[3] = bfhi(w[j].y) * ri * g0[3];
            o1[0] = bflo(w[j].z) * ri * g1[0]; o1[1] = bfhi(w[j].z) * ri * g1[1]; o1[2] = bflo(w[j].w) * ri * g1[2]; o1[3] = bfhi(w[j].w) * ri * g1[3];
            __builtin_nontemporal_store(o0, orow + c / 4); __builtin_nontemporal_store(o1, orow + c / 4 + 1); }
    }
}

#define XB_TMO      128
#define XB_XCNT(j)  (256  + 64 * (j))
#define XB_XSUB(j)  (1280 + 64 * (j))
#define XB_XGEN(j)  (2304 + 64 * (j))
#define XB_TOP      3328
#define XB_TOPGEN   3392
#define XCD_BAR_WORDS 3456
#define XB_SPIN_CAP (1u << 18)

__device__ __forceinline__ unsigned xb_ld(unsigned* p)              { return __hip_atomic_load(p, __ATOMIC_RELAXED, __HIP_MEMORY_SCOPE_AGENT); }
__device__ __forceinline__ unsigned xb_add(unsigned* p, unsigned v) { return __hip_atomic_fetch_add(p, v, __ATOMIC_RELAXED, __HIP_MEMORY_SCOPE_AGENT); }
__device__ __forceinline__ unsigned xb_xcc_id() { return (unsigned)__builtin_amdgcn_s_getreg((3 << 11) | 20) & 0xFu; }
#define XB_SPIN(cond, bar) do { unsigned _sp = 0; while (cond) { __builtin_amdgcn_s_sleep(1); \
    if ((++_sp & 255u) == 0u) { if (xb_ld(&(bar)[XB_TMO])) break; if (_sp > XB_SPIN_CAP) { atomicAdd(&(bar)[XB_TMO], 1u); break; } } } } while (0)

struct XcdBarrier {
    unsigned* bar; unsigned x;
    volatile LAS unsigned* st;
};

__device__ __forceinline__ XcdBarrier xcd_barrier_post(unsigned* bar, volatile LAS unsigned* st) {
    XcdBarrier b; b.bar = bar; b.x = xb_xcc_id(); b.st = st;
    if (threadIdx.x == 0) (void)xb_add(&bar[XB_XCNT(b.x)], 1u);
    return b;
}
__device__ __forceinline__ void xcd_barrier_complete(unsigned* bar, unsigned x, unsigned& nloc, unsigned& nx) {
    const unsigned G = gridDim.x * gridDim.y * gridDim.z;
    unsigned sum, cnt, mine, sp = 0u;
    for (;;) {
        sum = 0u; cnt = 0u; mine = 0u;
#pragma unroll
        for (unsigned j = 0; j < 16; ++j) { const unsigned c = xb_ld(&bar[XB_XCNT(j)]); sum += c; cnt += (c > 0u) ? 1u : 0u; mine = (j == x) ? c : mine; }
        if (sum == G) break;
        __builtin_amdgcn_s_sleep(1);
        if ((++sp & 255u) == 0u) { if (xb_ld(&bar[XB_TMO])) break; if (sp > XB_SPIN_CAP) { atomicAdd(&bar[XB_TMO], 1u); break; } }
    }
    nloc = mine > 0u ? mine : 1u; nx = cnt > 0u ? cnt : 1u;
}

__device__ __forceinline__ void xcd_barrier(const XcdBarrier& b) {
    asm volatile("s_waitcnt vmcnt(0)" ::: "memory");
    __syncthreads();
    if (threadIdx.x == 0) {
        unsigned* bar = b.bar;
        __builtin_amdgcn_s_waitcnt(0);
        unsigned nloc = b.st[0], nx = b.st[1];
        if (nloc == 0u) { xcd_barrier_complete(bar, b.x, nloc, nx); b.st[0] = nloc; b.st[1] = nx; }
        const unsigned old = xb_add(&bar[XB_XSUB(b.x)], 1u);
        const unsigned gen = old / nloc;
        if (old + 1u == (gen + 1u) * nloc) {
            __builtin_amdgcn_fence(__ATOMIC_RELEASE, "agent");
            asm volatile("s_waitcnt vmcnt(0)" ::: "memory");
            const unsigned og = xb_add(&bar[XB_TOP], 1u);
            const unsigned tg = og / nx;
            if (og + 1u == (tg + 1u) * nx) xb_add(&bar[XB_TOPGEN], 1u);
            else XB_SPIN(xb_ld(&bar[XB_TOPGEN]) == tg, bar);
            __builtin_amdgcn_fence(__ATOMIC_ACQUIRE, "agent");
            xb_add(&bar[XB_XGEN(b.x)], 1u);
            asm volatile("s_waitcnt vmcnt(0)" ::: "memory");
        } else {
            XB_SPIN(xb_ld(&bar[XB_XGEN(b.x)]) == gen, bar);
            __builtin_amdgcn_fence(__ATOMIC_ACQUIRE, "agent");
            asm volatile("s_waitcnt vmcnt(0)" ::: "memory");
        }
    }
    __syncthreads();
}


template <class Epi>
__device__ __forceinline__ void run_gemm(LAS unsigned char* lds, const bf16_t* A, const bf16_t* Bt, int N, int K, const Epi& E, int vc) {
    pg8::Gemm g; g.A = A; g.Bt = Bt; g.M = M_TOK; g.N = N; g.K = K;
    pg8::StaticOrder S; S.init(M_TOK, N, (int)gridDim.x, vc);
    pg8::gemm_phase<Epi, pg8::StaticOrder, true, true>(lds, g, S, E);
}
struct TailOrder {
    int c, n;
    __device__ __forceinline__ bool next(int i, Unit& u) const { if (c < 0) return false; const int L = i * n + c; if (L >= 256) return false; u.pm = L >> 3; u.pn = L & 7; return true; }
    __device__ __forceinline__ void a_ready(const Unit&) const {}
    __device__ __forceinline__ void done(const Unit&) const {}
};

__global__ void __launch_bounds__(512, 2) fwd_kernel(Args a) {
    extern __shared__ __attribute__((aligned(16))) unsigned char lds_raw[];
    LAS unsigned char* lds = (LAS unsigned char*)lds_raw;
    cg::grid_group grid = cg::this_grid();
    volatile LAS unsigned* xst = (volatile LAS unsigned*)(lds + LDS_BYTES - 16);
    if (threadIdx.x < 4) xst[threadIdx.x] = 0u;
    __syncthreads();
    XcdBarrier xbar = xcd_barrier_post((unsigned*)(a.ws + WS_BAR), xst);
    unsigned* cen = (unsigned*)(a.ws + WS_BAR) + 3584;
    if (threadIdx.x == 0) xst[2] = xb_add(&cen[64 * xbar.x], 1u);
    if (a.ph_lo == 0 && a.ph_hi == NPHASE) grid.sync();
    int vc = blockIdx.x;
    if (a.ph_lo == 0 && a.ph_hi == NPHASE && gridDim.x == 256) {
        bool even = true;
#pragma unroll
        for (int j = 0; j < 8; ++j) even = even && (xb_ld(&cen[64 * j]) == 32u);
        if (even) vc = (int)xst[2] * 8 + (int)xbar.x;
    }
    vc = __builtin_amdgcn_readfirstlane(vc);
    const int tid = threadIdx.x, lane = tid & 63, wave = __builtin_amdgcn_readfirstlane(tid >> 6);
    unsigned char* ws = a.ws;
    float* SS = (float*)(ws + WS_SS);
    bf16_t* XB = (bf16_t*)(ws + WS_XB); bf16_t* G = (bf16_t*)(ws + WS_G); bf16_t* MIX = (bf16_t*)(ws + WS_MIX);
#define PH(i) if (a.ph_lo <= (i) && (i) < a.ph_hi)
#define SYNC(i) if (a.ph_lo <= (i) && (i) + 1 < a.ph_hi) { xcd_barrier(xbar); }
    PH(0) { phase0(a, lds, wave, lane); } SYNC(0)
    PH(1) { EpiGateUp E; E.G = G; E.ss = SS; run_gemm(lds, XB, (const bf16_t*)(ws + WS_W1GU), 2 * FF, DM, E, vc); conv_tail(a, lds, wave, lane, 32 * 44, CV_P0, CV_WO, vc); conv_tail(a, lds, wave, lane, 32 * 44, CV_T1, CV_END, vc); } SYNC(1)
    PH(2) { EpiResid E; E.XB = XB; E.ss_out = SS + 8192; E.scale = 0.5f; run_gemm(lds, G, (const bf16_t*)(ws + WS_W1D), DM, FF, E, vc); } SYNC(2)
    PH(3) { EpiMixIn E; E.ss = SS + 8192; E.lbl = a.in[9]; E.QS = (bf16_t*)(ws + WS_QS);
            E.UC = (bf16_t*)(ws + WS_UC); E.LF = (float*)(ws + WS_LF); run_gemm(lds, XB, (const bf16_t*)(ws + WS_WIN), MIXIN, DM, E, vc); conv_tail(a, lds, wave, lane, 32 * 28, CV_WO, CV_TA, vc); conv_tail(a, lds, wave, lane, 32 * 28, CV_T0, CV_T1, vc); } SYNC(3)
    PH(4) { hgrn_pass_a(a, lds, wave, lane); } SYNC(4)
    PH(5) { hgrn_scan(a); conv_mixer(a, wave, lane); } SYNC(5)
    PH(6) { hgrn_pass_c(a, lds, wave, lane); } SYNC(6)
    PH(7) { EpiResid E; E.XB = XB; E.ss_out = SS + 16384; E.scale = 1.0f; run_gemm(lds, MIX, (const bf16_t*)(ws + WS_WOUT), DM, DM, E, vc); } SYNC(7)
    PH(8) { EpiGateUp E; E.G = G; E.ss = SS + 16384; run_gemm(lds, XB, (const bf16_t*)(ws + WS_W2GU), 2 * FF, DM, E, vc);
            { const int r = (32 * 44) % (int)gridDim.x; TailOrder T; T.n = (int)gridDim.x - r; T.c = vc - r;
              EpiStoreBf16 E2; E2.O = (bf16_t*)(ws + WS_PLE); int kp = PLE; asm volatile("" : "+s"(kp));
              pg8::Gemm g2; g2.A = (const bf16_t*)(ws + WS_PB); g2.Bt = (const bf16_t*)(ws + WS_WPE); g2.M = M_TOK; g2.N = DM; g2.K = kp;
              pg8::gemm_phase<EpiStoreBf16, TailOrder, true, true>(lds, g2, T, E2); }
            conv_tail(a, lds, wave, lane, 32 * 44, CV_TA, CV_T0, vc); } SYNC(8)
    PH(9) { EpiResid E; E.XB = XB; E.ss_out = SS + 24576; E.scale = 0.5f; run_gemm(lds, G, (const bf16_t*)(ws + WS_W2D), DM, FF, E, vc); } SYNC(9)
    PH(10) { EpiPleGate E; E.XB = XB; E.H4 = MIX; E.P = (const bf16_t*)(ws + WS_PLE); E.ss = SS + 24576; run_gemm(lds, XB, (const bf16_t*)(ws + WS_WPG), DM, DM, E, vc); } SYNC(10)
    PH(11) { phase_final(a, wave, lane); }
#undef PH
#undef SYNC
}

#ifndef MK_MULTI
#define MK_MULTI 0
#endif
extern "C" void kernel_launch(void* const* d_in, const int* in_sizes, int n_in, void* d_out, int out_size, void* d_ws, size_t ws_size, hipStream_t stream) {
    static int grid = 0;
    if (grid == 0) {
        if (n_in != 21 || out_size != M_TOK * DM || ws_size < WS_END) { fprintf(stderr, "kernel_launch: unexpected shapes (n_in %d out %d ws %zu need %zu)\n", n_in, out_size, ws_size, (size_t)WS_END); grid = -1; return; }
        int dev = 0, cus = 0, per_cu = 0;
        hipGetDevice(&dev); hipDeviceGetAttribute(&cus, hipDeviceAttributeMultiprocessorCount, dev);
        if (hipFuncSetAttribute((const void*)fwd_kernel, hipFuncAttributeMaxDynamicSharedMemorySize, LDS_BYTES) != hipSuccess) { fprintf(stderr, "kernel_launch: hipFuncSetAttribute failed\n"); grid = -1; return; }
        if (hipOccupancyMaxActiveBlocksPerMultiprocessor(&per_cu, (const void*)fwd_kernel, 512, LDS_BYTES) != hipSuccess || per_cu < 1) { fprintf(stderr, "kernel_launch: occupancy query failed (%d)\n", per_cu); grid = -1; return; }
        grid = cus * per_cu;
    }
    if (grid < 0) return;
    Args a{};
    for (int i = 0; i < 21; ++i) a.in[i] = (const float*)d_in[i];
    a.out = (float*)d_out; a.ws = (unsigned char*)d_ws;
#if MK_MULTI
    for (int p = 0; p < NPHASE; ++p) { a.ph_lo = p; a.ph_hi = p + 1; hipLaunchKernelGGL(fwd_kernel, dim3(grid), dim3(512), LDS_BYTES, stream, a); }
#else
    a.ph_lo = 0; a.ph_hi = NPHASE;
    if (hipMemsetAsync((char*)d_ws + WS_BAR, 0, 4096 * 4, stream) != hipSuccess) { fprintf(stderr, "kernel_launch: memset failed\n"); return; }
    void* args[] = {&a};
    hipError_t e = hipLaunchCooperativeKernel((void*)fwd_kernel, dim3(grid), dim3(512), args, LDS_BYTES, stream);
    if (e != hipSuccess) fprintf(stderr, "cooperative launch failed: %s (grid %d)\n", hipGetErrorString(e), grid);
#endif
}
```

```cpp
#include <hip/hip_runtime.h>
#include <hip/hip_cooperative_groups.h>
#include <cstdio>
#include <cstdint>
namespace pg8 {
#define PG8_LAS __attribute__((address_space(3)))
typedef unsigned short bf16_t;
typedef short bf16x8 __attribute__((ext_vector_type(8)));
typedef float f32x4 __attribute__((ext_vector_type(4)));
typedef unsigned u32x4 __attribute__((ext_vector_type(4)));
constexpr int BM = 256, BK = 64, HALF = 128, HTB = HALF * BK * 2  , STAGE_BYTES = 8 * HTB, NXCD = 8, WGM = 4;

__host__ __device__ __forceinline__ int lds_byte(int r, int c) { const int st = (r >> 4) * 2 + (c >> 5), rr = r & 15, cc = c & 31, ob = rr * 64 + cc * 2; return st * 1024 + (ob ^ (((ob >> 9) & 1) << 5)); }
__host__ __device__ __forceinline__ void stage_rc(int b, int& R, int& C) { const int st = b / 1024, sb = b % 1024, swz = sb ^ (((sb >> 9) & 1) << 5); R = (st >> 1) * 16 + swz / 64; C = (st & 1) * 32 + (swz % 64) / 2; }
__host__ __device__ __forceinline__ int perm32(int rho) { const int n = rho >> 4, i = rho & 15; return 8 * (i >> 2) + 4 * n + (i & 3); }

struct Unit { int pm, pn; };
struct Gemm { const bf16_t* A; const bf16_t* Bt; int M, N, K; };

struct StaticOrder {
    int nM, nN, nwg, G, c;
    __host__ __device__ void init(int M, int N, int G_, int c_) { nM = M / BM; nN = N / BM; nwg = nM * nN; G = G_; c = c_; }
    __host__ __device__ bool next(int i, Unit& u) const {
        const long L = (long)i * G + c; if (L >= nwg) return false;
        int wgid = (int)L; { const int q = nwg / NXCD, r = nwg % NXCD, xcd = wgid % NXCD, off = wgid / NXCD; wgid = (xcd < r ? xcd * (q + 1) : r * (q + 1) + (xcd - r) * q) + off; }
        const int nig = WGM * nN, gid = wgid / nig, fm = gid * WGM, gsz = (nM - fm) < WGM ? (nM - fm) : WGM;
        u.pm = fm + ((wgid % nig) % gsz); u.pn = (wgid % nig) / gsz; return true;
    }
    __device__ __forceinline__ void a_ready(const Unit&) const {}
    __device__ __forceinline__ void done(const Unit&) const {}
};
typedef float f32x2 __attribute__((ext_vector_type(2)));
template <class Epi, class Sched, bool ALIGN_EPI = false, bool SP2 = false>
__device__ __forceinline__ void gemm_phase(PG8_LAS unsigned char* lds, const Gemm g, const Sched& S, const Epi& E) {
    const int tid = threadIdx.x, wid = __builtin_amdgcn_readfirstlane(tid >> 6), lane = tid & 63, wr = wid >> 2, wc = wid & 3, fr = lane & 15, fq = lane >> 4;
    const int K = g.K, nt = K / BK;
    unsigned voffA[2], voffB[2];
#pragma unroll
    for (int i = 0; i < 2; ++i) { int R, C; stage_rc(tid * 16 + i * 8192, R, C); const int Rb = Epi::PERM ? ((R & ~31) + perm32(R & 31)) : R;
        voffA[i] = (unsigned)(R * K + C) * 2u; voffB[i] = (unsigned)(Rb * K + C) * 2u; }
    const size_t kstep = (size_t)(BK * 2);
    const size_t hstep = (size_t)HALF * K * 2;
    const size_t tstep = 2 * hstep;
    const unsigned ldsw = (unsigned)wid * 1024u;
    const int aoff = lds_byte(wr * 64 + fr, fq * 8), boff = lds_byte(wc * 32 + fr, fq * 8);
#define PG8_SA(b, h) (((b) * 2 + (h)) * HTB)
#define PG8_SB(b, h) ((4 + (b) * 2 + (h)) * HTB)
#define PG8_STAGE(bufoff, gbase, voff) do { _Pragma("unroll") for (int _i = 0; _i < 2; ++_i) \
        __builtin_amdgcn_global_load_lds((const unsigned*)((const char*)(gbase) + (voff)[_i]), (PG8_LAS unsigned*)(lds + (bufoff) + ldsw + _i * 8192), 16, 0, 0); } while (0)
#define PG8_LDA(dst, b, h) do { _Pragma("unroll") for (int m = 0; m < 4; ++m) _Pragma("unroll") for (int k = 0; k < 2; ++k) dst[m][k] = *(const PG8_LAS bf16x8*)(lds + PG8_SA(b, h) + aoff + m * 2048 + k * 1024); } while (0)
#define PG8_LDB(dst, b, h) do { _Pragma("unroll") for (int n = 0; n < 2; ++n) _Pragma("unroll") for (int k = 0; k < 2; ++k) dst[n][k] = *(const PG8_LAS bf16x8*)(lds + PG8_SB(b, h) + boff + n * 2048 + k * 1024); } while (0)
#define PG8_MMA(ai, bj, At, Bt) do { __builtin_amdgcn_s_setprio(1); _Pragma("unroll") for (int m = 0; m < 4; ++m) _Pragma("unroll") for (int n = 0; n < 2; ++n) _Pragma("unroll") for (int k = 0; k < 2; ++k) \
        acc[ai][bj][m][n] = __builtin_amdgcn_mfma_f32_16x16x32_bf16(Bt[n][k], At[m][k], acc[ai][bj][m][n], 0, 0, 0); __builtin_amdgcn_s_setprio(0); } while (0)
#define PG8_WAIT_V(n) asm volatile("s_waitcnt vmcnt(" #n ")" ::: "memory")
#define PG8_WAIT_L(n) asm volatile("s_waitcnt lgkmcnt(" #n ")" ::: "memory")
#define PG8_BAR __builtin_amdgcn_s_barrier()
#define PG8_SCHED __builtin_amdgcn_sched_barrier(0)
    Unit cur, nxt; int ui = 0;
    if (!S.next(0, cur)) return;
    f32x4 acc[2][2][4][2];
#pragma unroll
    for (int a = 0; a < 2; ++a)
#pragma unroll
        for (int b = 0; b < 2; ++b)
#pragma unroll
            for (int m = 0; m < 4; ++m)
#pragma unroll
                for (int n = 0; n < 2; ++n) acc[a][b][m][n] = (f32x4){0.f, 0.f, 0.f, 0.f};
    bf16x8 At[4][2], B0[2][2], B1[2][2];
    const char* cA = (const char*)g.A + (size_t)cur.pm * tstep; const char* cB = (const char*)g.Bt + (size_t)cur.pn * tstep;
    S.a_ready(cur);
    if constexpr (SP2) {
        PG8_STAGE(PG8_SB(0, 0), cB, voffB); PG8_STAGE(PG8_SB(0, 1), cB + hstep, voffB); PG8_STAGE(PG8_SA(0, 0), cA, voffA); PG8_STAGE(PG8_SA(0, 1), cA + hstep, voffA);
        if (wr == 1) PG8_BAR;
        PG8_WAIT_V(2); PG8_BAR;
        PG8_STAGE(PG8_SB(1, 0), cB + kstep, voffB); PG8_STAGE(PG8_SA(1, 0), cA + kstep, voffA); PG8_STAGE(PG8_SB(1, 1), cB + hstep + kstep, voffB);
        PG8_WAIT_V(6); PG8_BAR;
    } else {
        PG8_STAGE(PG8_SB(0, 0), cB, voffB); PG8_STAGE(PG8_SA(0, 0), cA, voffA); PG8_STAGE(PG8_SB(0, 1), cB + hstep, voffB); PG8_STAGE(PG8_SA(0, 1), cA + hstep, voffA);
        if (wr == 1) PG8_BAR;
        PG8_WAIT_V(4); PG8_BAR;
        PG8_STAGE(PG8_SB(1, 0), cB + kstep, voffB); PG8_STAGE(PG8_SA(1, 0), cA + kstep, voffA); PG8_STAGE(PG8_SB(1, 1), cB + hstep + kstep, voffB);
        PG8_WAIT_V(6); PG8_BAR;
    }
    for (;;) {
        const bool has_next = S.next(ui + 1, nxt);
        const char* nA = has_next ? (const char*)g.A + (size_t)nxt.pm * tstep : cA; const char* nB = has_next ? (const char*)g.Bt + (size_t)nxt.pn * tstep : cB;
        for (int t = 0; t < nt; t += 2) {
            const bool last = (t == nt - 2);
            const char* a1 = cA + (size_t)(t + 1) * kstep;
            const char* a2 = last ? nA : cA + (size_t)(t + 2) * kstep; const char* b2 = last ? nB : cB + (size_t)(t + 2) * kstep;
            const char* a3 = a2 + kstep; const char* b3 = b2 + kstep;
            if (last && has_next) S.a_ready(nxt);
            if constexpr (SP2) {
            PG8_LDB(B0, 0, 0); PG8_LDB(B1, 0, 1); PG8_SCHED; PG8_LDA(At, 0, 0); PG8_STAGE(PG8_SA(1, 1), a1 + hstep, voffA);
            PG8_WAIT_V(8); PG8_WAIT_L(0); PG8_BAR; PG8_MMA(0, 0, At, B0); PG8_MMA(0, 1, At, B1); PG8_BAR; PG8_SCHED;
            PG8_LDA(At, 0, 1); PG8_STAGE(PG8_SB(0, 0), b2, voffB); PG8_STAGE(PG8_SB(0, 1), b2 + hstep, voffB); PG8_STAGE(PG8_SA(0, 0), a2, voffA);
            PG8_WAIT_V(8); PG8_WAIT_L(0); PG8_BAR; PG8_MMA(1, 0, At, B0); PG8_MMA(1, 1, At, B1); PG8_BAR; PG8_SCHED;
            PG8_LDB(B0, 1, 0); PG8_LDB(B1, 1, 1); PG8_SCHED; PG8_LDA(At, 1, 0); PG8_STAGE(PG8_SA(0, 1), a2 + hstep, voffA);
            PG8_WAIT_V(8); PG8_WAIT_L(0); PG8_BAR; PG8_MMA(0, 0, At, B0); PG8_MMA(0, 1, At, B1); PG8_BAR; PG8_SCHED;
            PG8_LDA(At, 1, 1); PG8_STAGE(PG8_SB(1, 0), b3, voffB); PG8_STAGE(PG8_SB(1, 1), b3 + hstep, voffB); PG8_STAGE(PG8_SA(1, 0), a3, voffA);
            PG8_WAIT_V(8); PG8_WAIT_L(0); PG8_BAR; PG8_MMA(1, 0, At, B0); PG8_MMA(1, 1, At, B1); PG8_BAR; PG8_SCHED;
            } else {
            PG8_LDB(B0, 0, 0); PG8_SCHED; PG8_LDA(At, 0, 0); PG8_STAGE(PG8_SA(1, 1), a1 + hstep, voffA);
            PG8_WAIT_L(8); PG8_BAR; PG8_WAIT_L(0); PG8_MMA(0, 0, At, B0); PG8_BAR; PG8_SCHED;
            PG8_LDB(B1, 0, 1); PG8_STAGE(PG8_SB(0, 0), b2, voffB);
            PG8_BAR; PG8_WAIT_L(0); PG8_MMA(0, 1, At, B1); PG8_BAR;
            PG8_LDA(At, 0, 1); PG8_STAGE(PG8_SA(0, 0), a2, voffA);
            PG8_BAR; PG8_WAIT_L(0); PG8_MMA(1, 0, At, B0); PG8_BAR; PG8_SCHED;
            PG8_STAGE(PG8_SB(0, 1), b2 + hstep, voffB);
            PG8_WAIT_V(6); PG8_BAR; PG8_MMA(1, 1, At, B1); PG8_BAR;
            PG8_LDB(B0, 1, 0); PG8_SCHED; PG8_LDA(At, 1, 0); PG8_STAGE(PG8_SA(0, 1), a2 + hstep, voffA);
            PG8_WAIT_L(8); PG8_BAR; PG8_WAIT_L(0); PG8_MMA(0, 0, At, B0); PG8_BAR; PG8_SCHED;
            PG8_LDB(B1, 1, 1); PG8_STAGE(PG8_SB(1, 0), b3, voffB);
            PG8_BAR; PG8_WAIT_L(0); PG8_MMA(0, 1, At, B1); PG8_BAR;
            PG8_LDA(At, 1, 1); PG8_STAGE(PG8_SA(1, 0), a3, voffA);
            PG8_BAR; PG8_WAIT_L(0); PG8_MMA(1, 0, At, B0); PG8_BAR; PG8_SCHED;
            PG8_STAGE(PG8_SB(1, 1), b3 + hstep, voffB);
            PG8_WAIT_V(6); PG8_BAR; PG8_MMA(1, 1, At, B1); PG8_BAR;
            }
        }
        if constexpr (ALIGN_EPI) { if (wr == 0) PG8_BAR; }
        if constexpr (!Epi::AFTER_DRAIN) { E(acc, cur, wr, wc, fr, fq); S.done(cur); }
        if (!has_next) break;
#pragma unroll
        for (int a = 0; a < 2; ++a)
#pragma unroll
            for (int b = 0; b < 2; ++b)
#pragma unroll
                for (int m = 0; m < 4; ++m)
#pragma unroll
                    for (int n = 0; n < 2; ++n) acc[a][b][m][n] = (f32x4){0.f, 0.f, 0.f, 0.f};
        cur = nxt; cA = nA; cB = nB; ++ui;
        if constexpr (ALIGN_EPI) { if (wr == 1) PG8_BAR; }
    }
    PG8_WAIT_V(0);
    if constexpr (!ALIGN_EPI) { if (wr == 0) PG8_BAR; }
    PG8_BAR;
    if constexpr (Epi::AFTER_DRAIN) { E.fused(acc, cur, wr, wc, fr, fq, lds, wid, lane); S.done(cur); }
#undef PG8_SA
#undef PG8_SB
#undef PG8_STAGE
#undef PG8_LDA
#undef PG8_LDB
#undef PG8_MMA
#undef PG8_WAIT_V
#undef PG8_WAIT_L
#undef PG8_BAR
#undef PG8_SCHED
}
}

namespace cg = cooperative_groups;
using pg8::bf16_t; using pg8::bf16x8; using pg8::f32x4; using pg8::u32x4; using pg8::Unit;
typedef float f32x2c __attribute__((ext_vector_type(2)));
typedef __bf16 bf16x2c __attribute__((ext_vector_type(2)));
__device__ __forceinline__ unsigned cvt_pk_bf16(float lo, float hi) { const f32x2c v = {lo, hi}; return __builtin_bit_cast(unsigned, __builtin_convertvector(v, bf16x2c)); }
#define LAS __attribute__((address_space(3)))
typedef unsigned u32x2 __attribute__((ext_vector_type(2)));
typedef float f32x2v __attribute__((ext_vector_type(2)));

constexpr int M_TOK = 8192, DM = 2048, FF = 5632, HW = 1024, CW = 1024, MIXIN = 7168, PLE = 256, SEQ = 2048;
constexpr float EPS = 1e-6f;
constexpr size_t MiB = 1ull << 20;
constexpr size_t WS_W1GU = 0, WS_W1D = 44 * MiB, WS_WIN = 66 * MiB, WS_WOUT = 94 * MiB, WS_W2GU = 102 * MiB, WS_W2D = 146 * MiB,
                 WS_WPG = 168 * MiB, WS_WPE = 176 * MiB, WS_PB = 177 * MiB, WS_XB = 181 * MiB, WS_MIX = 213 * MiB, WS_G = 245 * MiB,
                 WS_QS = 245 * MiB, WS_VH = 261 * MiB, WS_GH = 277 * MiB, WS_BC = 293 * MiB, WS_UC = 309 * MiB, WS_LF = 325 * MiB,
                 WS_S = 357 * MiB, WS_PLE = 0, WS_SS = 389 * MiB, WS_DD = 389 * MiB + 512 * 1024, WS_BAR = 390 * MiB + 512 * 1024, WS_END = 391 * MiB, WS_U = 0;
constexpr int LDS_BYTES = 150 * 1024;
constexpr int NPHASE = 12;

__device__ __forceinline__ float bf2f(bf16_t b) { return __uint_as_float(((unsigned)b) << 16); }
__device__ __forceinline__ float bflo(unsigned w) { return __uint_as_float(w << 16); }
__device__ __forceinline__ float bfhi(unsigned w) { return __uint_as_float(w & 0xffff0000u); }
__device__ __forceinline__ float wave_sum(float v) {
#pragma unroll
    for (int o = 1; o < 64; o <<= 1) v += __shfl_xor(v, o);
    return v;
}
__device__ __forceinline__ float row16_sum(float x) {
    x += __builtin_bit_cast(float, __builtin_amdgcn_update_dpp(0, __builtin_bit_cast(int, x), 0xB1, 0xF, 0xF, true));
    x += __builtin_bit_cast(float, __builtin_amdgcn_update_dpp(0, __builtin_bit_cast(int, x), 0x4E, 0xF, 0xF, true));
    x += __builtin_bit_cast(float, __builtin_amdgcn_update_dpp(0, __builtin_bit_cast(int, x), 0x141, 0xF, 0xF, true));
    x += __builtin_bit_cast(float, __builtin_amdgcn_update_dpp(0, __builtin_bit_cast(int, x), 0x140, 0xF, 0xF, true));
    return x;
}
__device__ __forceinline__ float fsigmoid(float x) { return __builtin_amdgcn_rcpf(1.0f + __expf(-x)); }
__device__ __forceinline__ float fsilu(float x) { return x * fsigmoid(x); }
__device__ __forceinline__ float rinv_of(float ss) { return rsqrtf(ss * (1.0f / DM) + EPS); }

struct EpiGateUp {
    static constexpr bool PERM = true, AFTER_DRAIN = false;
    bf16_t* G; const float* ss;
    __device__ __forceinline__ void operator()(const f32x4 (&acc)[2][2][4][2], const Unit& u, int wr, int wc, int fr, int fq) const {
        const int row0 = u.pm * 256 + wr * 64 + fr, col0 = u.pn * 128 + wc * 32 + 8 * fq;
#pragma unroll
        for (int ai = 0; ai < 2; ++ai)
#pragma unroll
            for (int m = 0; m < 4; ++m) {
                const int r = row0 + ai * 128 + m * 16; const float ri = rinv_of(ss[r]);
                float v[8];
#pragma unroll
                for (int n = 0; n < 2; ++n)
#pragma unroll
                    for (int j = 0; j < 4; ++j) v[n * 4 + j] = fsilu(acc[ai][0][m][n][j] * ri) * (acc[ai][1][m][n][j] * ri);
                u32x4 w; w.x = cvt_pk_bf16(v[0], v[1]); w.y = cvt_pk_bf16(v[2], v[3]); w.z = cvt_pk_bf16(v[4], v[5]); w.w = cvt_pk_bf16(v[6], v[7]);
                *(u32x4*)(G + (size_t)r * FF + col0) = w;
            }
    }
};
struct EpiResid {
    static constexpr bool PERM = true, AFTER_DRAIN = false;
    bf16_t* XB; float* ss_out; float scale;
    __device__ __forceinline__ void operator()(f32x4 (&acc)[2][2][4][2], const Unit& u, int wr, int wc, int fr, int fq) const {
        const int row0 = u.pm * 256 + wr * 64 + fr, col0 = u.pn * 256 + wc * 32 + 8 * fq;
#pragma unroll
        for (int ai = 0; ai < 2; ++ai) {
#pragma unroll
            for (int m = 0; m < 4; ++m)
#pragma unroll
                for (int bj = 0; bj < 2; ++bj) {
                    const size_t off = (size_t)(row0 + ai * 128 + m * 16) * DM + col0 + bj * 128;
                    const u32x4 xw = *(const u32x4*)(XB + off);
                    f32x4 r0, r1; r0[0] = bflo(xw.x); r0[1] = bfhi(xw.x); r0[2] = bflo(xw.y); r0[3] = bfhi(xw.y); r1[0] = bflo(xw.z); r1[1] = bfhi(xw.z); r1[2] = bflo(xw.w); r1[3] = bfhi(xw.w);
                    acc[ai][bj][m][0] = r0 + acc[ai][bj][m][0] * scale; acc[ai][bj][m][1] = r1 + acc[ai][bj][m][1] * scale;
                }
            asm volatile("" ::: "memory");
#pragma unroll
            for (int m = 0; m < 4; ++m) {
                const int r = row0 + ai * 128 + m * 16; float sq = 0.f;
#pragma unroll
                for (int bj = 0; bj < 2; ++bj) {
                    const size_t off = (size_t)r * DM + col0 + bj * 128;
                    const f32x4 v0 = acc[ai][bj][m][0], v1 = acc[ai][bj][m][1];
                    u32x4 w; w.x = cvt_pk_bf16(v0[0], v0[1]); w.y = cvt_pk_bf16(v0[2], v0[3]); w.z = cvt_pk_bf16(v1[0], v1[1]); w.w = cvt_pk_bf16(v1[2], v1[3]);
                    *(u32x4*)(XB + off) = w;
                    sq += (v0[0] * v0[0] + v0[1] * v0[1]) + (v0[2] * v0[2] + v0[3] * v0[3]) + (v1[0] * v1[0] + v1[1] * v1[1]) + (v1[2] * v1[2] + v1[3] * v1[3]);
                }
                sq += __shfl_xor(sq, 16); sq += __shfl_xor(sq, 32);
                if (fq == 0) atomicAdd(ss_out + r, sq);
            }
            asm volatile("" ::: "memory");
        }
    }
};
struct EpiMixIn {
    static constexpr bool PERM = true, AFTER_DRAIN = false;
    const float* ss; const float* lbl;
    bf16_t *QS, *UC; float* LF;
    __device__ __forceinline__ void operator()(const f32x4 (&acc)[2][2][4][2], const Unit& u, int wr, int wc, int fr, int fq) const {
        const int row0 = u.pm * 256 + wr * 64 + fr; const int sec = u.pn >> 2;
        if (u.pn >= 20) {
            const int col0 = (u.pn - 20) * 128 + wc * 32 + 8 * fq;
#pragma unroll
            for (int ai = 0; ai < 2; ++ai)
#pragma unroll
                for (int m = 0; m < 4; ++m) {
                    const int r = row0 + ai * 128 + m * 16; const float ri = rinv_of(ss[r]); const float ri2 = ri * ri;
                    float v[8];
#pragma unroll
                    for (int n = 0; n < 2; ++n)
#pragma unroll
                        for (int j = 0; j < 4; ++j) v[n * 4 + j] = acc[ai][0][m][n][j] * acc[ai][1][m][n][j] * ri2;
                    u32x4 w; w.x = cvt_pk_bf16(v[0], v[1]); w.y = cvt_pk_bf16(v[2], v[3]); w.z = cvt_pk_bf16(v[4], v[5]); w.w = cvt_pk_bf16(v[6], v[7]);
                    *(u32x4*)(UC + (size_t)r * CW + col0) = w;
                }
            return;
        }
        const int col0 = (u.pn & 3) * 256 + wc * 32 + 8 * fq;
        if (sec == 1) {
#pragma unroll
            for (int bj = 0; bj < 2; ++bj)
#pragma unroll
                for (int n = 0; n < 2; ++n) {
                    const int c = col0 + bj * 128 + 4 * n; const f32x4 l0 = *(const f32x4*)(lbl + c), l1 = *(const f32x4*)(lbl + 1024 + c);
                    f32x4 lb; lb[0] = fsigmoid(l0[0] - l1[0]); lb[1] = fsigmoid(l0[1] - l1[1]); lb[2] = fsigmoid(l0[2] - l1[2]); lb[3] = fsigmoid(l0[3] - l1[3]);
#pragma unroll
                    for (int ai = 0; ai < 2; ++ai)
#pragma unroll
                        for (int m = 0; m < 4; ++m) {
                            const int r = row0 + ai * 128 + m * 16; const float ri = rinv_of(ss[r]);
                            const f32x4 x = acc[ai][bj][m][n]; f32x4 o;
                            o[0] = __logf(lb[0] + (1.0f - lb[0]) * fsigmoid(x[0] * ri)); o[1] = __logf(lb[1] + (1.0f - lb[1]) * fsigmoid(x[1] * ri));
                            o[2] = __logf(lb[2] + (1.0f - lb[2]) * fsigmoid(x[2] * ri)); o[3] = __logf(lb[3] + (1.0f - lb[3]) * fsigmoid(x[3] * ri));
                            *(f32x4*)(LF + (size_t)r * HW + c) = o;
                        }
                }
            return;
        }
        bf16_t* dst = QS + (size_t)(sec == 0 ? 0 : sec - 1) * ((size_t)M_TOK * HW);
        const bool act = (sec == 0 || sec == 3);
#pragma unroll
        for (int ai = 0; ai < 2; ++ai)
#pragma unroll
            for (int m = 0; m < 4; ++m) {
                const int r = row0 + ai * 128 + m * 16; const float ri = rinv_of(ss[r]);
#pragma unroll
                for (int bj = 0; bj < 2; ++bj) {
                    float v[8];
#pragma unroll
                    for (int n = 0; n < 2; ++n)
#pragma unroll
                        for (int j = 0; j < 4; ++j) { const float x = acc[ai][bj][m][n][j] * ri; v[n * 4 + j] = act ? fsilu(x) : x; }
                    u32x4 w; w.x = cvt_pk_bf16(v[0], v[1]); w.y = cvt_pk_bf16(v[2], v[3]); w.z = cvt_pk_bf16(v[4], v[5]); w.w = cvt_pk_bf16(v[6], v[7]);
                    *(u32x4*)(dst + (size_t)r * HW + col0 + bj * 128) = w;
                }
            }
    }
};
struct EpiStoreBf16 {
    static constexpr bool PERM = true, AFTER_DRAIN = false;
    bf16_t* O;
    __device__ __forceinline__ void operator()(const f32x4 (&acc)[2][2][4][2], const Unit& u, int wr, int wc, int fr, int fq) const {
        const int row0 = u.pm * 256 + wr * 64 + fr, col0 = u.pn * 256 + wc * 32 + 8 * fq;
#pragma unroll
        for (int ai = 0; ai < 2; ++ai)
#pragma unroll
            for (int m = 0; m < 4; ++m) {
                const int r = row0 + ai * 128 + m * 16;
#pragma unroll
                for (int bj = 0; bj < 2; ++bj) {
                    const f32x4 v0 = acc[ai][bj][m][0], v1 = acc[ai][bj][m][1];
                    u32x4 w; w.x = cvt_pk_bf16(v0[0], v0[1]); w.y = cvt_pk_bf16(v0[2], v0[3]); w.z = cvt_pk_bf16(v1[0], v1[1]); w.w = cvt_pk_bf16(v1[2], v1[3]);
                    *(u32x4*)(O + (size_t)r * DM + col0 + bj * 128) = w;
                }
            }
    }
};
struct EpiPleGate {
    static constexpr bool PERM = true, AFTER_DRAIN = false;
    const bf16_t* XB; const bf16_t* P; bf16_t* H4; const float* ss;
    __device__ __forceinline__ void operator()(f32x4 (&acc)[2][2][4][2], const Unit& u, int wr, int wc, int fr, int fq) const {
        const int row0 = u.pm * 256 + wr * 64 + fr, col0 = u.pn * 256 + wc * 32 + 8 * fq;
#pragma unroll
        for (int ai = 0; ai < 2; ++ai)
#pragma unroll
            for (int m = 0; m < 4; ++m) {
                const int r = row0 + ai * 128 + m * 16; const float ri = rinv_of(ss[r]);
#pragma unroll
                for (int bj = 0; bj < 2; ++bj) {
                    const size_t off = (size_t)r * DM + col0 + bj * 128;
                    const u32x4 pw = *(const u32x4*)(P + off), xw = *(const u32x4*)(XB + off);
                    const f32x4 a0 = acc[ai][bj][m][0], a1 = acc[ai][bj][m][1];
                    u32x4 w;
                    w.x = cvt_pk_bf16(bflo(xw.x) + fsigmoid(a0[0] * ri) * bflo(pw.x), bfhi(xw.x) + fsigmoid(a0[1] * ri) * bfhi(pw.x));
                    w.y = cvt_pk_bf16(bflo(xw.y) + fsigmoid(a0[2] * ri) * bflo(pw.y), bfhi(xw.y) + fsigmoid(a0[3] * ri) * bfhi(pw.y));
                    w.z = cvt_pk_bf16(bflo(xw.z) + fsigmoid(a1[0] * ri) * bflo(pw.z), bfhi(xw.z) + fsigmoid(a1[1] * ri) * bfhi(pw.z));
                    w.w = cvt_pk_bf16(bflo(xw.w) + fsigmoid(a1[2] * ri) * bflo(pw.w), bfhi(xw.w) + fsigmoid(a1[3] * ri) * bfhi(pw.w));
                    *(u32x4*)(H4 + off) = w;
                }
            }
    }
};

template <int MODE>
__device__ __forceinline__ void p0_item(const float* W, const float* W2, const float* gain, int K, int N, bf16_t* WT, LAS float* scr, int item, int lane) {
    const int nblk_k = K / 64; const int nb = item / nblk_k, kb = item % nblk_k; const int k0 = 64 * kb, n0 = 32 * nb;
    const float* src = W; int c0 = n0;
    if (MODE == 1) { const int t = n0 >> 8, bj = (n0 >> 7) & 1, c = n0 & 127; src = bj ? W2 : W; c0 = 128 * t + c; }
    if (MODE == 2) { if (n0 >= 5120) { const int tt = n0 - 5120; const int t = tt >> 8, bj = (tt >> 7) & 1, c = tt & 127; c0 = 5120 + 1024 * bj + 128 * t + c; } }
    float v[32], gg[32];
    const float* sp = src + (size_t)(k0 + (lane >> 5)) * N + c0 + (lane & 31);
#pragma unroll
    for (int i = 0; i < 32; ++i) v[i] = __builtin_nontemporal_load(sp + (size_t)(2 * i) * N);
    if (gain) {
#pragma unroll
        for (int i = 0; i < 32; ++i) gg[i] = gain[k0 + 2 * i + (lane >> 5)];
#pragma unroll
        for (int i = 0; i < 32; ++i) v[i] *= gg[i];
    }
#pragma unroll
    for (int i = 0; i < 32; ++i) scr[(2 * i + (lane >> 5)) * 33 + (lane & 31)] = v[i];
    asm volatile("s_waitcnt lgkmcnt(0)" ::: "memory");
    const int c = lane & 7;
#pragma unroll
    for (int j = 0; j < 4; ++j) { const int n = (lane >> 3) + 8 * j; const LAS float* s = scr + (8 * c) * 33 + n;
        u32x4 o; o.x = cvt_pk_bf16(s[0 * 33], s[1 * 33]); o.y = cvt_pk_bf16(s[2 * 33], s[3 * 33]); o.z = cvt_pk_bf16(s[4 * 33], s[5 * 33]); o.w = cvt_pk_bf16(s[6 * 33], s[7 * 33]);
        *(u32x4*)(WT + (size_t)(n0 + n) * K + k0 + 8 * c) = o; }
    asm volatile("s_waitcnt lgkmcnt(0)" ::: "memory");
}

struct Args { const float* in[21]; float* out; unsigned char* ws; int ph_lo, ph_hi; };

constexpr int CV_I0 = 32 * 352, CV_I1 = 88 * 64, CV_I2 = 32 * 224, CV_I3 = 32 * 64, CV_I7 = 4 * 64;
constexpr int CV_END = 2 * CV_I0 + 2 * CV_I1 + CV_I2 + 2 * CV_I3 + CV_I7, CV_T1 = CV_END - 10000, CV_T0 = CV_T1 - 10000, CV_TA = CV_I0 + CV_I2 + CV_I3 + CV_I7, CV_P0 = CV_I0 + CV_I7 + CV_I2 - 2000, CV_WO = CV_I0 + CV_I7 + CV_I2;
__device__ __forceinline__ void conv_range(const Args& a, LAS unsigned char* lds, int wave, int lane, int lo, int hi, int w0, int nw) {
    unsigned char* ws = a.ws;
    LAS float* scr = (LAS float*)(lds + wave * 16384);
    for (int it = lo + w0; it < hi; it += nw) {
        int r = it;
        if (r < CV_I0) { p0_item<1>(a.in[3], a.in[4], a.in[2], DM, FF, (bf16_t*)(ws + WS_W1GU), scr, r, lane); continue; } r -= CV_I0;
        if (r < CV_I7) { p0_item<0>(a.in[18], nullptr, nullptr, PLE, DM, (bf16_t*)(ws + WS_WPE), scr, r, lane); continue; } r -= CV_I7;
        if (r < CV_I2) { p0_item<2>(a.in[7], nullptr, a.in[6], DM, MIXIN, (bf16_t*)(ws + WS_WIN), scr, r, lane); continue; } r -= CV_I2;
        if (r < CV_I3) { p0_item<0>(a.in[12], nullptr, nullptr, DM, DM, (bf16_t*)(ws + WS_WOUT), scr, r, lane); continue; } r -= CV_I3;
        if (r < CV_I3) { p0_item<0>(a.in[19], nullptr, a.in[17], DM, DM, (bf16_t*)(ws + WS_WPG), scr, r, lane); continue; } r -= CV_I3;
        if (r < CV_I1) { p0_item<0>(a.in[16], nullptr, nullptr, FF, DM, (bf16_t*)(ws + WS_W2D), scr, r, lane); continue; } r -= CV_I1;
        if (r < CV_I0) { p0_item<1>(a.in[14], a.in[15], a.in[13], DM, FF, (bf16_t*)(ws + WS_W2GU), scr, r, lane); continue; } r -= CV_I0;
        p0_item<0>(a.in[5], nullptr, nullptr, FF, DM, (bf16_t*)(ws + WS_W1D), scr, r, lane);
    }
}
__device__ __forceinline__ void conv_tail(const Args& a, LAS unsigned char* lds, int wave, int lane, int nunits, int lo, int hi, int vc) {
    const int r = nunits % (int)gridDim.x;
    if (r == 0) { conv_range(a, lds, wave, lane, lo, hi, vc * 8 + wave, gridDim.x * 8); return; }
    if (vc >= r) conv_range(a, lds, wave, lane, lo, hi, (vc - r) * 8 + wave, ((int)gridDim.x - r) * 8);
}

__device__ __forceinline__ void phase0(const Args& a, LAS unsigned char* lds, int wave, int lane) {
    unsigned char* ws = a.ws;
    const int gw = blockIdx.x * 8 + wave, NGW = gridDim.x * 8;
    conv_range(a, lds, wave, lane, 0, CV_P0, gw, NGW);
    float* SS = (float*)(ws + WS_SS);
    for (int m = gw; m < M_TOK; m += NGW) {
        const f32x4* xr = (const f32x4*)(a.in[0] + (size_t)m * DM) + lane; u32x2* xb = (u32x2*)((bf16_t*)(ws + WS_XB) + (size_t)m * DM) + lane;
        float s = 0.f;
#pragma unroll
        for (int j = 0; j < 8; ++j) { const f32x4 v = __builtin_nontemporal_load(xr + 64 * j); s += (v[0] * v[0] + v[1] * v[1]) + (v[2] * v[2] + v[3] * v[3]);
            u32x2 w; w.x = cvt_pk_bf16(v[0], v[1]); w.y = cvt_pk_bf16(v[2], v[3]); xb[64 * j] = w; }
        s = wave_sum(s);
        if (lane == 0) { SS[m] = s; SS[8192 + m] = 0.f; SS[16384 + m] = 0.f; SS[24576 + m] = 0.f; }
    }
    { const int gt = blockIdx.x * 512 + threadIdx.x, NT = gridDim.x * 512;
      for (int i = gt; i < M_TOK * PLE / 4; i += NT) { const f32x4 v = __builtin_nontemporal_load((const f32x4*)a.in[1] + i); u32x2 w; w.x = cvt_pk_bf16(v[0], v[1]); w.y = cvt_pk_bf16(v[2], v[3]); ((u32x2*)(ws + WS_PB))[i] = w; } }
}

constexpr int HP = 136, VP = 72;
constexpr int L_QT = 0, L_QH = L_QT + 64 * HP * 2, L_KA = L_QH + 64 * HP * 2, L_KB = L_KA + 64 * HP * 2, L_ST = L_KB + 32 * HP * 2, L_VT = L_ST + 128 * HP * 2,
              L_P = L_VT + 128 * VP * 2, L_SEG = L_P + 64 * VP * 2, L_PART = L_SEG + 8 * 128 * 4, L_RINV = L_PART + 8 * 64 * 4, L_HEND = L_RINV + 256, L_KT = 0;
static_assert(L_HEND <= LDS_BYTES, "LDS");
#define MFMA16(a, b, c) __builtin_amdgcn_mfma_f32_16x16x32_bf16((a), (b), (c), 0, 0, 0)
__device__ __forceinline__ bf16_t f2bf(float x) { return (bf16_t)(cvt_pk_bf16(x, 0.f) & 0xffffu); }

#define LDSBAR() do { asm volatile("s_waitcnt lgkmcnt(0)" ::: "memory"); __builtin_amdgcn_s_barrier(); asm volatile("" ::: "memory"); } while (0)
__device__ __forceinline__ void hgrn_pass_a(const Args& a, LAS unsigned char* lds, int wave, int lane) {
    unsigned char* ws = a.ws;
    const float* LF = (const float*)(ws + WS_LF); const bf16_t* VH = (const bf16_t*)(ws + WS_VH); bf16_t* U = (bf16_t*)(ws + WS_U); float* Dd = (float*)(ws + WS_DD);
    const int tid = threadIdx.x, k = tid & 127, sg = tid >> 7, fr = lane & 15, fq = lane >> 4;
    LAS bf16_t* VT = (LAS bf16_t*)(lds + L_VT); LAS bf16_t* KT = (LAS bf16_t*)(lds + L_KT); LAS float* SEG = (LAS float*)(lds + L_SEG);
    float lf[16]; u32x4 vv[2];
#define PA_LOAD(it) do { const int r0_ = ((it) >> 3) * 64, c0_ = ((it) & 7) * 128; \
        _Pragma("unroll") for (int i = 0; i < 16; ++i) lf[i] = LF[(size_t)(r0_ + 16 * sg + i) * HW + c0_ + k]; \
        _Pragma("unroll") for (int j = 0; j < 2; ++j) { const int idx = tid + 512 * j; vv[j] = *(const u32x4*)(VH + (size_t)(r0_ + (idx >> 4)) * HW + c0_ + 8 * (idx & 15)); } } while (0)
    int item = blockIdx.x;
    if (item < 1024) PA_LOAD(item);
    for (; item < 1024; item += gridDim.x) {
        float b[16];
        float run = 0.f;
#pragma unroll
        for (int i = 0; i < 16; ++i) { run += lf[i]; b[i] = run; }
        SEG[sg * 128 + k] = run;
        LDSBAR();
        const float s0 = SEG[k], s1 = SEG[128 + k], s2 = SEG[256 + k], s3 = SEG[384 + k];
        const float pre = sg == 0 ? 0.f : (sg == 1 ? s0 : (sg == 2 ? s0 + s1 : s0 + s1 + s2));
        const float blast = s0 + s1 + s2 + s3;
        unsigned pk[8];
#pragma unroll
        for (int i = 0; i < 8; ++i) {
            const float e0 = (1.0f - __expf(lf[2 * i])) * __expf(blast - (pre + b[2 * i])), e1 = (1.0f - __expf(lf[2 * i + 1])) * __expf(blast - (pre + b[2 * i + 1]));
            pk[i] = cvt_pk_bf16(e0, e1); }
        { u32x4 w0, w1; w0.x = pk[0]; w0.y = pk[1]; w0.z = pk[2]; w0.w = pk[3]; w1.x = pk[4]; w1.y = pk[5]; w1.z = pk[6]; w1.w = pk[7];
          *(LAS u32x4*)(KT + k * VP + 16 * sg) = w0; *(LAS u32x4*)(KT + k * VP + 16 * sg + 8) = w1; }
#pragma unroll
        for (int j = 0; j < 2; ++j) { const int idx = tid + 512 * j, s = idx >> 4, v0 = 8 * (idx & 15);
            VT[(v0 + 0) * VP + s] = (bf16_t)(vv[j].x & 0xffffu); VT[(v0 + 1) * VP + s] = (bf16_t)(vv[j].x >> 16);
            VT[(v0 + 2) * VP + s] = (bf16_t)(vv[j].y & 0xffffu); VT[(v0 + 3) * VP + s] = (bf16_t)(vv[j].y >> 16);
            VT[(v0 + 4) * VP + s] = (bf16_t)(vv[j].z & 0xffffu); VT[(v0 + 5) * VP + s] = (bf16_t)(vv[j].z >> 16);
            VT[(v0 + 6) * VP + s] = (bf16_t)(vv[j].w & 0xffffu); VT[(v0 + 7) * VP + s] = (bf16_t)(vv[j].w >> 16); }
        if (sg == 0) Dd[item * 128 + k] = __expf(blast);
        if (item + (int)gridDim.x < 1024) PA_LOAD(item + (int)gridDim.x);
        LDSBAR();
        const bf16x8 a0 = *(const LAS bf16x8*)(VT + (16 * wave + fr) * VP + fq * 8), a1 = *(const LAS bf16x8*)(VT + (16 * wave + fr) * VP + 32 + fq * 8);
        bf16_t* up = U + (size_t)item * 16384 + (16 * wave + fr) * 128 + 4 * fq;
#pragma unroll
        for (int kt = 0; kt < 8; ++kt) {
            const bf16x8 b0 = *(const LAS bf16x8*)(KT + (16 * kt + fr) * VP + fq * 8), b1 = *(const LAS bf16x8*)(KT + (16 * kt + fr) * VP + 32 + fq * 8);
            f32x4 acc = {0.f, 0.f, 0.f, 0.f};
            acc = MFMA16(b0, a0, acc); acc = MFMA16(b1, a1, acc);
            u32x2 w; w.x = cvt_pk_bf16(acc[0], acc[1]); w.y = cvt_pk_bf16(acc[2], acc[3]);
            *(u32x2*)(up + 16 * kt) = w;
        }
        LDSBAR();
    }
#undef PA_LOAD
}

__device__ __forceinline__ void hgrn_scan(const Args& a) {
    unsigned char* ws = a.ws;
    const bf16_t* U = (const bf16_t*)(ws + WS_U); const float* Dd = (const float*)(ws + WS_DD); bf16_t* SP = (bf16_t*)(ws + WS_S);
    for (int e = (blockIdx.x * 512 + threadIdx.x) * 4; e < 32 * 16384; e += gridDim.x * 512 * 4) {
        const int bh = e >> 14, vk = e & 16383, bb = bh >> 3, h = bh & 7;
        f32x4 S = {0.f, 0.f, 0.f, 0.f};
#pragma unroll 8
        for (int ci = 0; ci < 32; ++ci) {
            const size_t item = (size_t)((bb * 32 + ci) * 8 + h);
            const u32x2 uw = *(const u32x2*)(U + item * 16384 + vk); f32x4 u; u[0] = bflo(uw.x); u[1] = bfhi(uw.x); u[2] = bflo(uw.y); u[3] = bfhi(uw.y); const f32x4 d = *(const f32x4*)(Dd + item * 128 + (vk & 127));
            u32x2 w; w.x = cvt_pk_bf16(S[0], S[1]); w.y = cvt_pk_bf16(S[2], S[3]); *(u32x2*)(SP + item * 16384 + vk) = w;
            S = d * S + u;
        }
    }
}

__device__ __forceinline__ void conv_mixer(const Args& a, int wave, int lane) {
    unsigned char* ws = a.ws;
    const bf16_t* BC = (const bf16_t*)(ws + WS_BC); const bf16_t* UC = (const bf16_t*)(ws + WS_UC); bf16_t* MIX = (bf16_t*)(ws + WS_MIX);
    const float* cn = a.in[11]; const float* cw = a.in[8];
    const int gw = blockIdx.x * 8 + wave, NGW = gridDim.x * 8;
    for (int it = gw; it < M_TOK * 2; it += NGW) {
        const int row = it >> 1, c = (it & 1) * 512 + lane * 8, t = row & (SEQ - 1);
        const size_t off = (size_t)row * CW + c;
        const u32x4 z = {0u, 0u, 0u, 0u};
        const u32x4 u0 = *(const u32x4*)(UC + off), u1 = t >= 1 ? *(const u32x4*)(UC + off - CW) : z, u2 = t >= 2 ? *(const u32x4*)(UC + off - 2 * CW) : z, bg = *(const u32x4*)(BC + off);
        float y[8]; float ssq = 0.f;
#pragma unroll
        for (int q = 0; q < 4; ++q) {
            const unsigned a0 = u0[q], a1 = u1[q], a2 = u2[q], bb = bg[q]; const int cc = c + 2 * q;
            y[2 * q] = bflo(bb) * (cw[cc] * bflo(a2) + cw[CW + cc] * bflo(a1) + cw[2 * CW + cc] * bflo(a0));
            y[2 * q + 1] = bfhi(bb) * (cw[cc + 1] * bfhi(a2) + cw[CW + cc + 1] * bfhi(a1) + cw[2 * CW + cc + 1] * bfhi(a0));
            ssq += y[2 * q] * y[2 * q] + y[2 * q + 1] * y[2 * q + 1];
        }
        ssq = row16_sum(ssq);
        const float ri = rsqrtf(ssq * (1.0f / 128) + EPS);
        u32x4 w;
        w.x = cvt_pk_bf16(y[0] * ri * cn[c], y[1] * ri * cn[c + 1]); w.y = cvt_pk_bf16(y[2] * ri * cn[c + 2], y[3] * ri * cn[c + 3]);
        w.z = cvt_pk_bf16(y[4] * ri * cn[c + 4], y[5] * ri * cn[c + 5]); w.w = cvt_pk_bf16(y[6] * ri * cn[c + 6], y[7] * ri * cn[c + 7]);
        *(u32x4*)(MIX + (size_t)row * DM + HW + c) = w;
    }
}

__device__ __forceinline__ void hgrn_pass_c(const Args& a, LAS unsigned char* lds, int wave, int lane) {
    unsigned char* ws = a.ws;
    const float* LF = (const float*)(ws + WS_LF); const bf16_t* VH = (const bf16_t*)(ws + WS_VH); const bf16_t* QS = (const bf16_t*)(ws + WS_QS); const bf16_t* GH = (const bf16_t*)(ws + WS_GH);
    const bf16_t* SP = (const bf16_t*)(ws + WS_S); bf16_t* MIX = (bf16_t*)(ws + WS_MIX); const float* hn = a.in[10];
    const int tid = threadIdx.x, k = tid & 127, sg = tid >> 7, fr = lane & 15, fq = lane >> 4;
    LAS bf16_t* QT = (LAS bf16_t*)(lds + L_QT); LAS bf16_t* QH = (LAS bf16_t*)(lds + L_QH); LAS bf16_t* KA = (LAS bf16_t*)(lds + L_KA); LAS bf16_t* KB = (LAS bf16_t*)(lds + L_KB);
    LAS bf16_t* ST = (LAS bf16_t*)(lds + L_ST); LAS bf16_t* VT = (LAS bf16_t*)(lds + L_VT); LAS bf16_t* P = (LAS bf16_t*)(lds + L_P);
    LAS float* SEG = (LAS float*)(lds + L_SEG); LAS float* PART = (LAS float*)(lds + L_PART); LAS float* RINV = (LAS float*)(lds + L_RINV);
    const f32x4 hnv = *(const f32x4*)(hn + 16 * wave + 4 * fq);
    const int k0 = 2 * (tid & 63);
    f32x2v lf2[8]; unsigned q2[8]; u32x4 vv[2], sv[4];
#define PC_LOAD(it) do { const int r0_ = ((it) >> 3) * 64, c0_ = ((it) & 7) * 128; \
        _Pragma("unroll") for (int i = 0; i < 8; ++i) { lf2[i] = *(const f32x2v*)(LF + (size_t)(r0_ + 8 * wave + i) * HW + c0_ + k0); q2[i] = *(const unsigned*)(QS + (size_t)(r0_ + 8 * wave + i) * HW + c0_ + k0); } \
        _Pragma("unroll") for (int j = 0; j < 2; ++j) { const int idx = tid + 512 * j; vv[j] = *(const u32x4*)(VH + (size_t)(r0_ + (idx >> 4)) * HW + c0_ + 8 * (idx & 15)); } \
        _Pragma("unroll") for (int j = 0; j < 4; ++j) { const int idx = tid + 512 * j; sv[j] = *(const u32x4*)(SP + (size_t)(it) * 16384 + (idx >> 4) * 128 + 8 * (idx & 15)); } } while (0)
    int item = blockIdx.x;
    if (item < 1024) PC_LOAD(item);
    for (; item < 1024; item += gridDim.x) {
        const int row0 = (item >> 3) * 64, cb = (item & 7) * 128;
        f32x2v b2[8]; f32x2v run = {0.f, 0.f};
#pragma unroll
        for (int i = 0; i < 8; ++i) { run += lf2[i]; b2[i] = run; }
        *(LAS f32x2v*)(SEG + wave * 128 + k0) = run;
        LDSBAR();
        f32x2v pre = {0.f, 0.f}, beta1 = {0.f, 0.f};
#pragma unroll
        for (int j = 0; j < 8; ++j) { const f32x2v sj = *(const LAS f32x2v*)(SEG + j * 128 + k0); if (j < wave) pre += sj; if (j < 4) beta1 += sj; }
        if (wave < 4) {
#pragma unroll
            for (int i = 0; i < 8; ++i) {
                const int so = (8 * wave + i) * HP + k0; const f32x2v bi = pre + b2[i];
                const float kk0 = 1.0f - __expf(lf2[i][0]), kk1 = 1.0f - __expf(lf2[i][1]);
                const unsigned qw = cvt_pk_bf16(bflo(q2[i]) * __expf(bi[0]), bfhi(q2[i]) * __expf(bi[1]));
                *(LAS unsigned*)(QT + so) = qw; *(LAS unsigned*)(QH + so) = qw;
                *(LAS unsigned*)(KA + so) = cvt_pk_bf16(kk0 * __expf(fminf(-bi[0], 80.f)), kk1 * __expf(fminf(-bi[1], 80.f)));
                *(LAS unsigned*)(KB + so) = cvt_pk_bf16(kk0 * __expf(beta1[0] - bi[0]), kk1 * __expf(beta1[1] - bi[1]));
            }
        } else {
#pragma unroll
            for (int i = 0; i < 8; ++i) {
                const int so = (8 * wave + i) * HP + k0; const f32x2v bi = pre + b2[i];
                const float kk0 = 1.0f - __expf(lf2[i][0]), kk1 = 1.0f - __expf(lf2[i][1]);
                const float q0 = bflo(q2[i]), q1 = bfhi(q2[i]);
                *(LAS unsigned*)(QH + so) = cvt_pk_bf16(q0 * __expf(bi[0]), q1 * __expf(bi[1]));
                *(LAS unsigned*)(QT + so) = cvt_pk_bf16(q0 * __expf(bi[0] - beta1[0]), q1 * __expf(bi[1] - beta1[1]));
                *(LAS unsigned*)(KA + so) = cvt_pk_bf16(kk0 * __expf(fminf(beta1[0] - bi[0], 80.f)), kk1 * __expf(fminf(beta1[1] - bi[1], 80.f)));
            }
        }
#pragma unroll
        for (int j = 0; j < 2; ++j) { const int idx = tid + 512 * j, s = idx >> 4, v0 = 8 * (idx & 15);
            VT[(v0 + 0) * VP + s] = (bf16_t)(vv[j].x & 0xffffu); VT[(v0 + 1) * VP + s] = (bf16_t)(vv[j].x >> 16);
            VT[(v0 + 2) * VP + s] = (bf16_t)(vv[j].y & 0xffffu); VT[(v0 + 3) * VP + s] = (bf16_t)(vv[j].y >> 16);
            VT[(v0 + 4) * VP + s] = (bf16_t)(vv[j].z & 0xffffu); VT[(v0 + 5) * VP + s] = (bf16_t)(vv[j].z >> 16);
            VT[(v0 + 6) * VP + s] = (bf16_t)(vv[j].w & 0xffffu); VT[(v0 + 7) * VP + s] = (bf16_t)(vv[j].w >> 16); }
#pragma unroll
        for (int j = 0; j < 4; ++j) { const int idx = tid + 512 * j; *(LAS u32x4*)(ST + (idx >> 4) * HP + 8 * (idx & 15)) = sv[j]; }
        if (item + (int)gridDim.x < 1024) PC_LOAD(item + (int)gridDim.x);
        LDSBAR();
        u32x2 gh[4];
#pragma unroll
        for (int tt = 0; tt < 4; ++tt) gh[tt] = *(const u32x2*)(GH + (size_t)(row0 + 16 * tt + fr) * HW + cb + 16 * wave + 4 * fq);
#pragma unroll
        for (int pp = 0; pp < 2; ++pp) {
            const int p = wave + 8 * pp, tt = p >> 2, st = p & 3;
            f32x4 acc = {0.f, 0.f, 0.f, 0.f};
            if (st <= tt) {
                const LAS bf16_t* kb = (tt >= 2 && st < 2) ? KB : KA;
#pragma unroll
                for (int ks = 0; ks < 4; ++ks) { const bf16x8 af = *(const LAS bf16x8*)(QT + (16 * tt + fr) * HP + ks * 32 + fq * 8), bfr = *(const LAS bf16x8*)(kb + (16 * st + fr) * HP + ks * 32 + fq * 8);
                    acc = MFMA16(af, bfr, acc); }
            }
#pragma unroll
            for (int r = 0; r < 4; ++r) { const bool keep = (st < tt) || (st == tt && fr <= 4 * fq + r); P[(16 * tt + 4 * fq + r) * VP + 16 * st + fr] = f2bf(keep ? acc[r] : 0.f); }
        }
        LDSBAR();
        bf16x8 bs[4], bv[2];
#pragma unroll
        for (int ks = 0; ks < 4; ++ks) bs[ks] = *(const LAS bf16x8*)(ST + (16 * wave + fr) * HP + ks * 32 + fq * 8);
#pragma unroll
        for (int ks = 0; ks < 2; ++ks) bv[ks] = *(const LAS bf16x8*)(VT + (16 * wave + fr) * VP + ks * 32 + fq * 8);
        f32x4 o[4];
#pragma unroll
        for (int tt = 0; tt < 4; ++tt) {
            f32x4 acc = {0.f, 0.f, 0.f, 0.f};
#pragma unroll
            for (int ks = 0; ks < 4; ++ks) { const bf16x8 af = *(const LAS bf16x8*)(QH + (16 * tt + fr) * HP + ks * 32 + fq * 8); acc = MFMA16(bs[ks], af, acc); }
            { const bf16x8 af = *(const LAS bf16x8*)(P + (16 * tt + fr) * VP + fq * 8); acc = MFMA16(bv[0], af, acc); }
            if (tt >= 2) { const bf16x8 af = *(const LAS bf16x8*)(P + (16 * tt + fr) * VP + 32 + fq * 8); acc = MFMA16(bv[1], af, acc); }
            o[tt] = acc;
        }
#pragma unroll
        for (int tt = 0; tt < 4; ++tt) { float x = (o[tt][0] * o[tt][0] + o[tt][1] * o[tt][1]) + (o[tt][2] * o[tt][2] + o[tt][3] * o[tt][3]);
            x += __shfl_xor(x, 16); x += __shfl_xor(x, 32);
            if (fq == 0) PART[wave * 64 + 16 * tt + fr] = x; }
        LDSBAR();
        if (tid < 64) { float s = 0.f;
#pragma unroll
            for (int w = 0; w < 8; ++w) s += PART[w * 64 + tid];
            RINV[tid] = rsqrtf(s * (1.0f / 128) + EPS); }
        LDSBAR();
#pragma unroll
        for (int tt = 0; tt < 4; ++tt) { const float ri = RINV[16 * tt + fr];
            u32x2 w; w.x = cvt_pk_bf16(o[tt][0] * ri * hnv[0] * bflo(gh[tt].x), o[tt][1] * ri * hnv[1] * bfhi(gh[tt].x));
            w.y = cvt_pk_bf16(o[tt][2] * ri * hnv[2] * bflo(gh[tt].y), o[tt][3] * ri * hnv[3] * bfhi(gh[tt].y));
            *(u32x2*)(MIX + (size_t)(row0 + 16 * tt + fr) * DM + cb + 16 * wave + 4 * fq) = w; }
        LDSBAR();
    }
#undef PC_LOAD
}

__device__ __forceinline__ void phase_final(const Args& a, int wave, int lane) {
    const int gw = blockIdx.x * 8 + wave, NGW = gridDim.x * 8; const float* gF = a.in[20]; const bf16_t* H4 = (const bf16_t*)(a.ws + WS_MIX);
    for (int m = gw; m < M_TOK; m += NGW) {
        const u32x4* hr = (const u32x4*)(H4 + (size_t)m * DM) + lane; u32x4 w[4]; float s = 0.f;
#pragma unroll
        for (int j = 0; j < 4; ++j) { w[j] = __builtin_nontemporal_load(hr + 64 * j);
            s += (bflo(w[j].x) * bflo(w[j].x) + bfhi(w[j].x) * bfhi(w[j].x)) + (bflo(w[j].y) * bflo(w[j].y) + bfhi(w[j].y) * bfhi(w[j].y))
               + (bflo(w[j].z) * bflo(w[j].z) + bfhi(w[j].z) * bfhi(w[j].z)) + (bflo(w[j].w) * bflo(w[j].w) + bfhi(w[j].w) * bfhi(w[j].w)); }
        const float ri = rinv_of(wave_sum(s));
        f32x4* orow = (f32x4*)(a.out + (size_t)m * DM);
#pragma unroll
        for (int j = 0; j < 4; ++j) { const int c = (64 * j + lane) * 8; const f32x4 g0 = *(const f32x4*)(gF + c), g1 = *(const f32x4*)(gF + c + 4);
            f32x4 o0, o1; o0[0] = bflo(w[j].x) * ri * g0[0]; o0[1] = bfhi(w[j].x) * ri * g0[1]; o0[2] = bflo(w[j].y) * ri * g0[2]; o0[3] = bfhi(w[j].y) * ri * g0[3];
            o1[0] = bflo(w[j].z) * ri * g1[0]; o1[1] = bfhi(w[j].z) * ri * g1[1]; o1[2] = bflo(w[j].w) * ri * g1[2]; o1[3] = bfhi(w[j].w) * ri * g1[3];
            __builtin_nontemporal_store(o0, orow + c / 4); __builtin_nontemporal_store(o1, orow + c / 4 + 1); }
    }
}

#define XB_TMO      128
#define XB_XCNT(j)  (256  + 64 * (j))
#define XB_XSUB(j)  (1280 + 64 * (j))
#define XB_XGEN(j)  (2304 + 64 * (j))
#define XB_TOP      3328
#define XB_TOPGEN   3392
#define XCD_BAR_WORDS 3456
#define XB_SPIN_CAP (1u << 18)

__device__ __forceinline__ unsigned xb_ld(unsigned* p)              { return __hip_atomic_load(p, __ATOMIC_RELAXED, __HIP_MEMORY_SCOPE_AGENT); }
__device__ __forceinline__ unsigned xb_add(unsigned* p, unsigned v) { return __hip_atomic_fetch_add(p, v, __ATOMIC_RELAXED, __HIP_MEMORY_SCOPE_AGENT); }
__device__ __forceinline__ unsigned xb_xcc_id() { return (unsigned)__builtin_amdgcn_s_getreg((3 << 11) | 20) & 0xFu; }
#define XB_SPIN(cond, bar) do { unsigned _sp = 0; while (cond) { __builtin_amdgcn_s_sleep(1); \
    if ((++_sp & 255u) == 0u) { if (xb_ld(&(bar)[XB_TMO])) break; if (_sp > XB_SPIN_CAP) { atomicAdd(&(bar)[XB_TMO], 1u); break; } } } } while (0)

struct XcdBarrier {
    unsigned* bar; unsigned x;
    volatile LAS unsigned* st;
};

__device__ __forceinline__ XcdBarrier xcd_barrier_post(unsigned* bar, volatile LAS unsigned* st) {
    XcdBarrier b; b.bar = bar; b.x = xb_xcc_id(); b.st = st;
    if (threadIdx.x == 0) (void)xb_add(&bar[XB_XCNT(b.x)], 1u);
    return b;
}
__device__ __forceinline__ void xcd_barrier_complete(unsigned* bar, unsigned x, unsigned& nloc, unsigned& nx) {
    const unsigned G = gridDim.x * gridDim.y * gridDim.z;
    unsigned sum, cnt, mine, sp = 0u;
    for (;;) {
        sum = 0u; cnt = 0u; mine = 0u;
#pragma unroll
        for (unsigned j = 0; j < 16; ++j) { const unsigned c = xb_ld(&bar[XB_XCNT(j)]); sum += c; cnt += (c > 0u) ? 1u : 0u; mine = (j == x) ? c : mine; }
        if (sum == G) break;
        __builtin_amdgcn_s_sleep(1);
        if ((++sp & 255u) == 0u) { if (xb_ld(&bar[XB_TMO])) break; if (sp > XB_SPIN_CAP) { atomicAdd(&bar[XB_TMO], 1u); break; } }
    }
    nloc = mine > 0u ? mine : 1u; nx = cnt > 0u ? cnt : 1u;
}

__device__ __forceinline__ void xcd_barrier(const XcdBarrier& b) {
    asm volatile("s_waitcnt vmcnt(0)" ::: "memory");
    __syncthreads();
    if (threadIdx.x == 0) {
        unsigned* bar = b.bar;
        __builtin_amdgcn_s_waitcnt(0);
        unsigned nloc = b.st[0], nx = b.st[1];
        if (nloc == 0u) { xcd_barrier_complete(bar, b.x, nloc, nx); b.st[0] = nloc; b.st[1] = nx; }
        const unsigned old = xb_add(&bar[XB_XSUB(b.x)], 1u);
        const unsigned gen = old / nloc;
        if (old + 1u == (gen + 1u) * nloc) {
            __builtin_amdgcn_fence(__ATOMIC_RELEASE, "agent");
            asm volatile("s_waitcnt vmcnt(0)" ::: "memory");
            const unsigned og = xb_add(&bar[XB_TOP], 1u);
            const unsigned tg = og / nx;
            if (og + 1u == (tg + 1u) * nx) xb_add(&bar[XB_TOPGEN], 1u);
            else XB_SPIN(xb_ld(&bar[XB_TOPGEN]) == tg, bar);
            __builtin_amdgcn_fence(__ATOMIC_ACQUIRE, "agent");
            xb_add(&bar[XB_XGEN(b.x)], 1u);
            asm volatile("s_waitcnt vmcnt(0)" ::: "memory");
        } else {
            XB_SPIN(xb_ld(&bar[XB_XGEN(b.x)]) == gen, bar);
            __builtin_amdgcn_fence(__ATOMIC_ACQUIRE, "agent");
            asm volatile("s_waitcnt vmcnt(0)" ::: "memory");
        }
    }
    __syncthreads();
}


template <class Epi>
__device__ __forceinline__ void run_gemm(LAS unsigned char* lds, const bf16_t* A, const bf16_t* Bt, int N, int K, const Epi& E, int vc) {
    pg8::Gemm g; g.A = A; g.Bt = Bt; g.M = M_TOK; g.N = N; g.K = K;
    pg8::StaticOrder S; S.init(M_TOK, N, (int)gridDim.x, vc);
    pg8::gemm_phase<Epi, pg8::StaticOrder, true, true>(lds, g, S, E);
}
struct TailOrder {
    int c, n;
    __device__ __forceinline__ bool next(int i, Unit& u) const { if (c < 0) return false; const int L = i * n + c; if (L >= 256) return false; u.pm = L >> 3; u.pn = L & 7; return true; }
    __device__ __forceinline__ void a_ready(const Unit&) const {}
    __device__ __forceinline__ void done(const Unit&) const {}
};

__global__ void __launch_bounds__(512, 2) fwd_kernel(Args a) {
    extern __shared__ __attribute__((aligned(16))) unsigned char lds_raw[];
    LAS unsigned char* lds = (LAS unsigned char*)lds_raw;
    cg::grid_group grid = cg::this_grid();
    volatile LAS unsigned* xst = (volatile LAS unsigned*)(lds + LDS_BYTES - 16);
    if (threadIdx.x < 4) xst[threadIdx.x] = 0u;
    __syncthreads();
    XcdBarrier xbar = xcd_barrier_post((unsigned*)(a.ws + WS_BAR), xst);
    unsigned* cen = (unsigned*)(a.ws + WS_BAR) + 3584;
    if (threadIdx.x == 0) xst[2] = xb_add(&cen[64 * xbar.x], 1u);
    if (a.ph_lo == 0 && a.ph_hi == NPHASE) grid.sync();
    int vc = blockIdx.x;
    if (a.ph_lo == 0 && a.ph_hi == NPHASE && gridDim.x == 256) {
        bool even = true;
#pragma unroll
        for (int j = 0; j < 8; ++j) even = even && (xb_ld(&cen[64 * j]) == 32u);
        if (even) vc = (int)xst[2] * 8 + (int)xbar.x;
    }
    vc = __builtin_amdgcn_readfirstlane(vc);
    const int tid = threadIdx.x, lane = tid & 63, wave = __builtin_amdgcn_readfirstlane(tid >> 6);
    unsigned char* ws = a.ws;
    float* SS = (float*)(ws + WS_SS);
    bf16_t* XB = (bf16_t*)(ws + WS_XB); bf16_t* G = (bf16_t*)(ws + WS_G); bf16_t* MIX = (bf16_t*)(ws + WS_MIX);
#define PH(i) if (a.ph_lo <= (i) && (i) < a.ph_hi)
#define SYNC(i) if (a.ph_lo <= (i) && (i) + 1 < a.ph_hi) { xcd_barrier(xbar); }
    PH(0) { phase0(a, lds, wave, lane); } SYNC(0)
    PH(1) { EpiGateUp E; E.G = G; E.ss = SS; run_gemm(lds, XB, (const bf16_t*)(ws + WS_W1GU), 2 * FF, DM, E, vc); conv_tail(a, lds, wave, lane, 32 * 44, CV_P0, CV_WO, vc); conv_tail(a, lds, wave, lane, 32 * 44, CV_T1, CV_END, vc); } SYNC(1)
    PH(2) { EpiResid E; E.XB = XB; E.ss_out = SS + 8192; E.scale = 0.5f; run_gemm(lds, G, (const bf16_t*)(ws + WS_W1D), DM, FF, E, vc); } SYNC(2)
    PH(3) { EpiMixIn E; E.ss = SS + 8192; E.lbl = a.in[9]; E.QS = (bf16_t*)(ws + WS_QS);
            E.UC = (bf16_t*)(ws + WS_UC); E.LF = (float*)(ws + WS_LF); run_gemm(lds, XB, (const bf16_t*)(ws + WS_WIN), MIXIN, DM, E, vc); conv_tail(a, lds, wave, lane, 32 * 28, CV_WO, CV_TA, vc); conv_tail(a, lds, wave, lane, 32 * 28, CV_T0, CV_T1, vc); } SYNC(3)
    PH(4) { hgrn_pass_a(a, lds, wave, lane); } SYNC(4)
    PH(5) { hgrn_scan(a); conv_mixer(a, wave, lane); } SYNC(5)
    PH(6) { hgrn_pass_c(a, lds, wave, lane); } SYNC(6)
    PH(7) { EpiResid E; E.XB = XB; E.ss_out = SS + 16384; E.scale = 1.0f; run_gemm(lds, MIX, (const bf16_t*)(ws + WS_WOUT), DM, DM, E, vc); } SYNC(7)
    PH(8) { EpiGateUp E; E.G = G; E.ss = SS + 16384; run_gemm(lds, XB, (const bf16_t*)(ws + WS_W2GU), 2 * FF, DM, E, vc);
            { const int r = (32 * 44) % (int)gridDim.x; TailOrder T; T.n = (int)gridDim.x - r; T.c = vc - r;
              EpiStoreBf16 E2; E2.O = (bf16_t*)(ws + WS_PLE); int kp = PLE; asm volatile("" : "+s"(kp));
              pg8::Gemm g2; g2.A = (const bf16_t*)(ws + WS_PB); g2.Bt = (const bf16_t*)(ws + WS_WPE); g2.M = M_TOK; g2.N = DM; g2.K = kp;
              pg8::gemm_phase<EpiStoreBf16, TailOrder, true, true>(lds, g2, T, E2); }
            conv_tail(a, lds, wave, lane, 32 * 44, CV_TA, CV_T0, vc); } SYNC(8)
    PH(9) { EpiResid E; E.XB = XB; E.ss_out = SS + 24576; E.scale = 0.5f; run_gemm(lds, G, (const bf16_t*)(ws + WS_W2D), DM, FF, E, vc); } SYNC(9)
    PH(10) { EpiPleGate E; E.XB = XB; E.H4 = MIX; E.P = (const bf16_t*)(ws + WS_PLE); E.ss = SS + 24576; run_gemm(lds, XB, (const bf16_t*)(ws + WS_WPG), DM, DM, E, vc); } SYNC(10)
    PH(11) { phase_final(a, wave, lane); }
#undef PH
#undef SYNC
}

#ifndef MK_MULTI
#define MK_MULTI 0
#endif
extern "C" void kernel_launch(void* const* d_in, const int* in_sizes, int n_in, void* d_out, int out_size, void* d_ws, size_t ws_size, hipStream_t stream) {
    static int grid = 0;
    if (grid == 0) {
        if (n_in != 21 || out_size != M_TOK * DM || ws_size < WS_END) { fprintf(stderr, "kernel_launch: unexpected shapes (n_in %d out %d ws %zu need %zu)\n", n_in, out_size, ws_size, (size_t)WS_END); grid = -1; return; }
        int dev = 0, cus = 0, per_cu = 0;
        hipGetDevice(&dev); hipDeviceGetAttribute(&cus, hipDeviceAttributeMultiprocessorCount, dev);
        if (hipFuncSetAttribute((const void*)fwd_kernel, hipFuncAttributeMaxDynamicSharedMemorySize, LDS_BYTES) != hipSuccess) { fprintf(stderr, "kernel_launch: hipFuncSetAttribute failed\n"); grid = -1; return; }
        if (hipOccupancyMaxActiveBlocksPerMultiprocessor(&per_cu, (const void*)fwd_kernel, 512, LDS_BYTES) != hipSuccess || per_cu < 1) { fprintf(stderr, "kernel_launch: occupancy query failed (%d)\n", per_cu); grid = -1; return; }
        grid = cus * per_cu;
    }
    if (grid < 0) return;
    Args a{};
    for (int i = 0; i < 21; ++i) a.in[i] = (const float*)d_in[i];
    a.out = (float*)d_out; a.ws = (unsigned char*)d_ws;
#if MK_MULTI
    for (int p = 0; p < NPHASE; ++p) { a.ph_lo = p; a.ph_hi = p + 1; hipLaunchKernelGGL(fwd_kernel, dim3(grid), dim3(512), LDS_BYTES, stream, a); }
#else
    a.ph_lo = 0; a.ph_hi = NPHASE;
    if (hipMemsetAsync((char*)d_ws + WS_BAR, 0, 4096 * 4, stream) != hipSuccess) { fprintf(stderr, "kernel_launch: memset failed\n"); return; }
    void* args[] = {&a};
    hipError_t e = hipLaunchCooperativeKernel((void*)fwd_kernel, dim3(grid), dim3(512), args, LDS_BYTES, stream);
    if (e != hipSuccess) fprintf(stderr, "cooperative launch failed: %s (grid %d)\n", hipGetErrorString(e), grid);
#endif
}
```

```cpp
#include <hip/hip_runtime.h>
#include <hip/hip_cooperative_groups.h>
#include <cstdio>
#include <cstdint>
namespace pg8 {
#define PG8_LAS __attribute__((address_space(3)))
typedef unsigned short bf16_t;
typedef short bf16x8 __attribute__((ext_vector_type(8)));
typedef float f32x4 __attribute__((ext_vector_type(4)));
typedef unsigned u32x4 __attribute__((ext_vector_type(4)));
constexpr int BM = 256, BK = 64, HALF = 128, HTB = HALF * BK * 2  , STAGE_BYTES = 8 * HTB, NXCD = 8, WGM = 4;

__host__ __device__ __forceinline__ int lds_byte(int r, int c) { const int st = (r >> 4) * 2 + (c >> 5), rr = r & 15, cc = c & 31, ob = rr * 64 + cc * 2; return st * 1024 + (ob ^ (((ob >> 9) & 1) << 5)); }
__host__ __device__ __forceinline__ void stage_rc(int b, int& R, int& C) { const int st = b / 1024, sb = b % 1024, swz = sb ^ (((sb >> 9) & 1) << 5); R = (st >> 1) * 16 + swz / 64; C = (st & 1) * 32 + (swz % 64) / 2; }
__host__ __device__ __forceinline__ int perm32(int rho) { const int n = rho >> 4, i = rho & 15; return 8 * (i >> 2) + 4 * n + (i & 3); }

struct Unit { int pm, pn; };
struct Gemm { const bf16_t* A; const bf16_t* Bt; int M, N, K; };

struct StaticOrder {
    int nM, nN, nwg, G, c;
    __host__ __device__ void init(int M, int N, int G_, int c_) { nM = M / BM; nN = N / BM; nwg = nM * nN; G = G_; c = c_; }
    __host__ __device__ bool next(int i, Unit& u) const {
        const long L = (long)i * G + c; if (L >= nwg) return false;
        int wgid = (int)L; { const int q = nwg / NXCD, r = nwg % NXCD, xcd = wgid % NXCD, off = wgid / NXCD; wgid = (xcd < r ? xcd * (q + 1) : r * (q + 1) + (xcd - r) * q) + off; }
        const int nig = WGM * nN, gid = wgid / nig, fm = gid * WGM, gsz = (nM - fm) < WGM ? (nM - fm) : WGM;
        u.pm = fm + ((wgid % nig) % gsz); u.pn = (wgid % nig) / gsz; return true;
    }
    __device__ __forceinline__ void a_ready(const Unit&) const {}
    __device__ __forceinline__ void done(const Unit&) const {}
};
typedef float f32x2 __attribute__((ext_vector_type(2)));
template <class Epi, class Sched, bool ALIGN_EPI = false, bool SP2 = false>
__device__ __forceinline__ void gemm_phase(PG8_LAS unsigned char* lds, const Gemm g, const Sched& S, const Epi& E) {
    const int tid = threadIdx.x, wid = __builtin_amdgcn_readfirstlane(tid >> 6), lane = tid & 63, wr = wid >> 2, wc = wid & 3, fr = lane & 15, fq = lane >> 4;
    const int K = g.K, nt = K / BK;
    unsigned voffA[2], voffB[2];
#pragma unroll
    for (int i = 0; i < 2; ++i) { int R, C; stage_rc(tid * 16 + i * 8192, R, C); const int Rb = Epi::PERM ? ((R & ~31) + perm32(R & 31)) : R;
        voffA[i] = (unsigned)(R * K + C) * 2u; voffB[i] = (unsigned)(Rb * K + C) * 2u; }
    const size_t kstep = (size_t)(BK * 2);
    const size_t hstep = (size_t)HALF * K * 2;
    const size_t tstep = 2 * hstep;
    const unsigned ldsw = (unsigned)wid * 1024u;
    const int aoff = lds_byte(wr * 64 + fr, fq * 8), boff = lds_byte(wc * 32 + fr, fq * 8);
#define PG8_SA(b, h) (((b) * 2 + (h)) * HTB)
#define PG8_SB(b, h) ((4 + (b) * 2 + (h)) * HTB)
#define PG8_STAGE(bufoff, gbase, voff) do { _Pragma("unroll") for (int _i = 0; _i < 2; ++_i) \
        __builtin_amdgcn_global_load_lds((const unsigned*)((const char*)(gbase) + (voff)[_i]), (PG8_LAS unsigned*)(lds + (bufoff) + ldsw + _i * 8192), 16, 0, 0); } while (0)
#define PG8_LDA(dst, b, h) do { _Pragma("unroll") for (int m = 0; m < 4; ++m) _Pragma("unroll") for (int k = 0; k < 2; ++k) dst[m][k] = *(const PG8_LAS bf16x8*)(lds + PG8_SA(b, h) + aoff + m * 2048 + k * 1024); } while (0)
#define PG8_LDB(dst, b, h) do { _Pragma("unroll") for (int n = 0; n < 2; ++n) _Pragma("unroll") for (int k = 0; k < 2; ++k) dst[n][k] = *(const PG8_LAS bf16x8*)(lds + PG8_SB(b, h) + boff + n * 2048 + k * 1024); } while (0)
#define PG8_MMA(ai, bj, At, Bt) do { __builtin_amdgcn_s_setprio(1); _Pragma("unroll") for (int m = 0; m < 4; ++m) _Pragma("unroll") for (int n = 0; n < 2; ++n) _Pragma("unroll") for (int k = 0; k < 2; ++k) \
        acc[ai][bj][m][n] = __builtin_amdgcn_mfma_f32_16x16x32_bf16(Bt[n][k], At[m][k], acc[ai][bj][m][n], 0, 0, 0); __builtin_amdgcn_s_setprio(0); } while (0)
#define PG8_WAIT_V(n) asm volatile("s_waitcnt vmcnt(" #n ")" ::: "memory")
#define PG8_WAIT_L(n) asm volatile("s_waitcnt lgkmcnt(" #n ")" ::: "memory")
#define PG8_BAR __builtin_amdgcn_s_barrier()
#define PG8_SCHED __builtin_amdgcn_sched_barrier(0)
    Unit cur, nxt; int ui = 0;
    if (!S.next(0, cur)) return;
    f32x4 acc[2][2][4][2];
#pragma unroll
    for (int a = 0; a < 2; ++a)
#pragma unroll
        for (int b = 0; b < 2; ++b)
#pragma unroll
            for (int m = 0; m < 4; ++m)
#pragma unroll
                for (int n = 0; n < 2; ++n) acc[a][b][m][n] = (f32x4){0.f, 0.f, 0.f, 0.f};
    bf16x8 At[4][2], B0[2][2], B1[2][2];
    const char* cA = (const char*)g.A + (size_t)cur.pm * tstep; const char* cB = (const char*)g.Bt + (size_t)cur.pn * tstep;
    S.a_ready(cur);
    if constexpr (SP2) {
        PG8_STAGE(PG8_SB(0, 0), cB, voffB); PG8_STAGE(PG8_SB(0, 1), cB + hstep, voffB); PG8_STAGE(PG8_SA(0, 0), cA, voffA); PG8_STAGE(PG8_SA(0, 1), cA + hstep, voffA);
        if (wr == 1) PG8_BAR;
        PG8_WAIT_V(2); PG8_BAR;
        PG8_STAGE(PG8_SB(1, 0), cB + kstep, voffB); PG8_STAGE(PG8_SA(1, 0), cA + kstep, voffA); PG8_STAGE(PG8_SB(1, 1), cB + hstep + kstep, voffB);
        PG8_WAIT_V(6); PG8_BAR;
    } else {
        PG8_STAGE(PG8_SB(0, 0), cB, voffB); PG8_STAGE(PG8_SA(0, 0), cA, voffA); PG8_STAGE(PG8_SB(0, 1), cB + hstep, voffB); PG8_STAGE(PG8_SA(0, 1), cA + hstep, voffA);
        if (wr == 1) PG8_BAR;
        PG8_WAIT_V(4); PG8_BAR;
        PG8_STAGE(PG8_SB(1, 0), cB + kstep, voffB); PG8_STAGE(PG8_SA(1, 0), cA + kstep, voffA); PG8_STAGE(PG8_SB(1, 1), cB + hstep + kstep, voffB);
        PG8_WAIT_V(6); PG8_BAR;
    }
    for (;;) {
        const bool has_next = S.next(ui + 1, nxt);
        const char* nA = has_next ? (const char*)g.A + (size_t)nxt.pm * tstep : cA; const char* nB = has_next ? (const char*)g.Bt + (size_t)nxt.pn * tstep : cB;
        for (int t = 0; t < nt; t += 2) {
            const bool last = (t == nt - 2);
            const char* a1 = cA + (size_t)(t + 1) * kstep;
            const char* a2 = last ? nA : cA + (size_t)(t + 2) * kstep; const char* b2 = last ? nB : cB + (size_t)(t + 2) * kstep;
            const char* a3 = a2 + kstep; const char* b3 = b2 + kstep;
            if (last && has_next) S.a_ready(nxt);
            if constexpr (SP2) {
            PG8_LDB(B0, 0, 0); PG8_LDB(B1, 0, 1); PG8_SCHED; PG8_LDA(At, 0, 0); PG8_STAGE(PG8_SA(1, 1), a1 + hstep, voffA);
            PG8_WAIT_V(8); PG8_WAIT_L(0); PG8_BAR; PG8_MMA(0, 0, At, B0); PG8_MMA(0, 1, At, B1); PG8_BAR; PG8_SCHED;
            PG8_LDA(At, 0, 1); PG8_STAGE(PG8_SB(0, 0), b2, voffB); PG8_STAGE(PG8_SB(0, 1), b2 + hstep, voffB); PG8_STAGE(PG8_SA(0, 0), a2, voffA);
            PG8_WAIT_V(8); PG8_WAIT_L(0); PG8_BAR; PG8_MMA(1, 0, At, B0); PG8_MMA(1, 1, At, B1); PG8_BAR; PG8_SCHED;
            PG8_LDB(B0, 1, 0); PG8_LDB(B1, 1, 1); PG8_SCHED; PG8_LDA(At, 1, 0); PG8_STAGE(PG8_SA(0, 1), a2 + hstep, voffA);
            PG8_WAIT_V(8); PG8_WAIT_L(0); PG8_BAR; PG8_MMA(0, 0, At, B0); PG8_MMA(0, 1, At, B1); PG8_BAR; PG8_SCHED;
            PG8_LDA(At, 1, 1); PG8_STAGE(PG8_SB(1, 0), b3, voffB); PG8_STAGE(PG8_SB(1, 1), b3 + hstep, voffB); PG8_STAGE(PG8_SA(1, 0), a3, voffA);
            PG8_WAIT_V(8); PG8_WAIT_L(0); PG8_BAR; PG8_MMA(1, 0, At, B0); PG8_MMA(1, 1, At, B1); PG8_BAR; PG8_SCHED;
            } else {
            PG8_LDB(B0, 0, 0); PG8_SCHED; PG8_LDA(At, 0, 0); PG8_STAGE(PG8_SA(1, 1), a1 + hstep, voffA);
            PG8_WAIT_L(8); PG8_BAR; PG8_WAIT_L(0); PG8_MMA(0, 0, At, B0); PG8_BAR; PG8_SCHED;
            PG8_LDB(B1, 0, 1); PG8_STAGE(PG8_SB(0, 0), b2, voffB);
            PG8_BAR; PG8_WAIT_L(0); PG8_MMA(0, 1, At, B1); PG8_BAR;
            PG8_LDA(At, 0, 1); PG8_STAGE(PG8_SA(0, 0), a2, voffA);
            PG8_BAR; PG8_WAIT_L(0); PG8_MMA(1, 0, At, B0); PG8_BAR; PG8_SCHED;
            PG8_STAGE(PG8_SB(0, 1), b2 + hstep, voffB);
            PG8_WAIT_V(6); PG8_BAR; PG8_MMA(1, 1, At, B1); PG8_BAR;
            PG8_LDB(B0, 1, 0); PG8_SCHED; PG8_LDA(At, 1, 0); PG8_STAGE(PG8_SA(0, 1), a2 + hstep, voffA);
            PG8_WAIT_L(8); PG8_BAR; PG8_WAIT_L(0); PG8_MMA(0, 0, At, B0); PG8_BAR; PG8_SCHED;
            PG8_LDB(B1, 1, 1); PG8_STAGE(PG8_SB(1, 0), b3, voffB);
            PG8_BAR; PG8_WAIT_L(0); PG8_MMA(0, 1, At, B1); PG8_BAR;
            PG8_LDA(At, 1, 1); PG8_STAGE(PG8_SA(1, 0), a3, voffA);
            PG8_BAR; PG8_WAIT_L(0); PG8_MMA(1, 0, At, B0); PG8_BAR; PG8_SCHED;
            PG8_STAGE(PG8_SB(1, 1), b3 + hstep, voffB);
            PG8_WAIT_V(6); PG8_BAR; PG8_MMA(1, 1, At, B1); PG8_BAR;
            }
        }
        if constexpr (ALIGN_EPI) { if (wr == 0) PG8_BAR; }
        if constexpr (!Epi::AFTER_DRAIN) { E(acc, cur, wr, wc, fr, fq); S.done(cur); }
        if (!has_next) break;
#pragma unroll
        for (int a = 0; a < 2; ++a)
#pragma unroll
            for (int b = 0; b < 2; ++b)
#pragma unroll
                for (int m = 0; m < 4; ++m)
#pragma unroll
                    for (int n = 0; n < 2; ++n) acc[a][b][m][n] = (f32x4){0.f, 0.f, 0.f, 0.f};
        cur = nxt; cA = nA; cB = nB; ++ui;
        if constexpr (ALIGN_EPI) { if (wr == 1) PG8_BAR; }
    }
    PG8_WAIT_V(0);
    if constexpr (!ALIGN_EPI) { if (wr == 0) PG8_BAR; }
    PG8_BAR;
    if constexpr (Epi::AFTER_DRAIN) { E.fused(acc, cur, wr, wc, fr, fq, lds, wid, lane); S.done(cur); }
#undef PG8_SA
#undef PG8_SB
#undef PG8_STAGE
#undef PG8_LDA
#undef PG8_LDB
#undef PG8_MMA
#undef PG8_WAIT_V
#undef PG8_WAIT_L
#undef PG8_BAR
#undef PG8_SCHED
}
}

namespace cg = cooperative_groups;
using pg8::bf16_t; using pg8::bf16x8; using pg8::f32x4; using pg8::u32x4; using pg8::Unit;
typedef float f32x2c __attribute__((ext_vector_type(2)));
typedef __bf16 bf16x2c __attribute__((ext_vector_type(2)));
__device__ __forceinline__ unsigned cvt_pk_bf16(float lo, float hi) { const f32x2c v = {lo, hi}; return __builtin_bit_cast(unsigned, __builtin_convertvector(v, bf16x2c)); }
#define LAS __attribute__((address_space(3)))
typedef unsigned u32x2 __attribute__((ext_vector_type(2)));
typedef float f32x2v __attribute__((ext_vector_type(2)));

constexpr int M_TOK = 8192, DM = 2048, FF = 5632, HW = 1024, CW = 1024, MIXIN = 7168, PLE = 256, SEQ = 2048;
constexpr float EPS = 1e-6f;
constexpr size_t MiB = 1ull << 20;
constexpr size_t WS_W1GU = 0, WS_W1D = 44 * MiB, WS_WIN = 66 * MiB, WS_WOUT = 94 * MiB, WS_W2GU = 102 * MiB, WS_W2D = 146 * MiB,
                 WS_WPG = 168 * MiB, WS_WPE = 176 * MiB, WS_PB = 177 * MiB, WS_XB = 181 * MiB, WS_MIX = 213 * MiB, WS_G = 245 * MiB,
                 WS_QS = 245 * MiB, WS_VH = 261 * MiB, WS_GH = 277 * MiB, WS_BC = 293 * MiB, WS_UC = 309 * MiB, WS_LF = 325 * MiB,
                 WS_S = 357 * MiB, WS_PLE = 0, WS_SS = 389 * MiB, WS_DD = 389 * MiB + 512 * 1024, WS_BAR = 390 * MiB + 512 * 1024, WS_END = 391 * MiB, WS_U = 0;
constexpr int LDS_BYTES = 150 * 1024;
constexpr int NPHASE = 12;

__device__ __forceinline__ float bf2f(bf16_t b) { return __uint_as_float(((unsigned)b) << 16); }
__device__ __forceinline__ float bflo(unsigned w) { return __uint_as_float(w << 16); }
__device__ __forceinline__ float bfhi(unsigned w) { return __uint_as_float(w & 0xffff0000u); }
__device__ __forceinline__ float wave_sum(float v) {
#pragma unroll
    for (int o = 1; o < 64; o <<= 1) v += __shfl_xor(v, o);
    return v;
}
__device__ __forceinline__ float row16_sum(float x) {
    x += __builtin_bit_cast(float, __builtin_amdgcn_update_dpp(0, __builtin_bit_cast(int, x), 0xB1, 0xF, 0xF, true));
    x += __builtin_bit_cast(float, __builtin_amdgcn_update_dpp(0, __builtin_bit_cast(int, x), 0x4E, 0xF, 0xF, true));
    x += __builtin_bit_cast(float, __builtin_amdgcn_update_dpp(0, __builtin_bit_cast(int, x), 0x141, 0xF, 0xF, true));
    x += __builtin_bit_cast(float, __builtin_amdgcn_update_dpp(0, __builtin_bit_cast(int, x), 0x140, 0xF, 0xF, true));
    return x;
}
__device__ __forceinline__ float fsigmoid(float x) { return __builtin_amdgcn_rcpf(1.0f + __expf(-x)); }
__device__ __forceinline__ float fsilu(float x) { return x * fsigmoid(x); }
__device__ __forceinline__ float rinv_of(float ss) { return rsqrtf(ss * (1.0f / DM) + EPS); }

struct EpiGateUp {
    static constexpr bool PERM = true, AFTER_DRAIN = false;
    bf16_t* G; const float* ss;
    __device__ __forceinline__ void operator()(const f32x4 (&acc)[2][2][4][2], const Unit& u, int wr, int wc, int fr, int fq) const {
        const int row0 = u.pm * 256 + wr * 64 + fr, col0 = u.pn * 128 + wc * 32 + 8 * fq;
#pragma unroll
        for (int ai = 0; ai < 2; ++ai)
#pragma unroll
            for (int m = 0; m < 4; ++m) {
                const int r = row0 + ai * 128 + m * 16; const float ri = rinv_of(ss[r]);
                float v[8];
#pragma unroll
                for (int n = 0; n < 2; ++n)
#pragma unroll
                    for (int j = 0; j < 4; ++j) v[n * 4 + j] = fsilu(acc[ai][0][m][n][j] * ri) * (acc[ai][1][m][n][j] * ri);
                u32x4 w; w.x = cvt_pk_bf16(v[0], v[1]); w.y = cvt_pk_bf16(v[2], v[3]); w.z = cvt_pk_bf16(v[4], v[5]); w.w = cvt_pk_bf16(v[6], v[7]);
                *(u32x4*)(G + (size_t)r * FF + col0) = w;
            }
    }
};
struct EpiResid {
    static constexpr bool PERM = true, AFTER_DRAIN = false;
    bf16_t* XB; float* ss_out; float scale;
    __device__ __forceinline__ void operator()(f32x4 (&acc)[2][2][4][2], const Unit& u, int wr, int wc, int fr, int fq) const {
        const int row0 = u.pm * 256 + wr * 64 + fr, col0 = u.pn * 256 + wc * 32 + 8 * fq;
#pragma unroll
        for (int ai = 0; ai < 2; ++ai) {
#pragma unroll
            for (int m = 0; m < 4; ++m)
#pragma unroll
                for (int bj = 0; bj < 2; ++bj) {
                    const size_t off = (size_t)(row0 + ai * 128 + m * 16) * DM + col0 + bj * 128;
                    const u32x4 xw = *(const u32x4*)(XB + off);
                    f32x4 r0, r1; r0[0] = bflo(xw.x); r0[1] = bfhi(xw.x); r0[2] = bflo(xw.y); r0[3] = bfhi(xw.y); r1[0] = bflo(xw.z); r1[1] = bfhi(xw.z); r1[2] = bflo(xw.w); r1[3] = bfhi(xw.w);
                    acc[ai][bj][m][0] = r0 + acc[ai][bj][m][0] * scale; acc[ai][bj][m][1] = r1 + acc[ai][bj][m][1] * scale;
                }
            asm volatile("" ::: "memory");
#pragma unroll
            for (int m = 0; m < 4; ++m) {
                const int r = row0 + ai * 128 + m * 16; float sq = 0.f;
#pragma unroll
                for (int bj = 0; bj < 2; ++bj) {
                    const size_t off = (size_t)r * DM + col0 + bj * 128;
                    const f32x4 v0 = acc[ai][bj][m][0], v1 = acc[ai][bj][m][1];
                    u32x4 w; w.x = cvt_pk_bf16(v0[0], v0[1]); w.y = cvt_pk_bf16(v0[2], v0[3]); w.z = cvt_pk_bf16(v1[0], v1[1]); w.w = cvt_pk_bf16(v1[2], v1[3]);
                    *(u32x4*)(XB + off) = w;
                    sq += (v0[0] * v0[0] + v0[1] * v0[1]) + (v0[2] * v0[2] + v0[3] * v0[3]) + (v1[0] * v1[0] + v1[1] * v1[1]) + (v1[2] * v1[2] + v1[3] * v1[3]);
                }
                sq += __shfl_xor(sq, 16); sq += __shfl_xor(sq, 32);
                if (fq == 0) atomicAdd(ss_out + r, sq);
            }
            asm volatile("" ::: "memory");
        }
    }
};
struct EpiMixIn {
    static constexpr bool PERM = true, AFTER_DRAIN = false;
    const float* ss; const float* lbl;
    bf16_t *QS, *UC; float* LF;
    __device__ __forceinline__ void operator()(const f32x4 (&acc)[2][2][4][2], const Unit& u, int wr, int wc, int fr, int fq) const {
        const int row0 = u.pm * 256 + wr * 64 + fr; const int sec = u.pn >> 2;
        if (u.pn >= 20) {
            const int col0 = (u.pn - 20) * 128 + wc * 32 + 8 * fq;
#pragma unroll
            for (int ai = 0; ai < 2; ++ai)
#pragma unroll
                for (int m = 0; m < 4; ++m) {
                    const int r = row0 + ai * 128 + m * 16; const float ri = rinv_of(ss[r]); const float ri2 = ri * ri;
                    float v[8];
#pragma unroll
                    for (int n = 0; n < 2; ++n)
#pragma unroll
                        for (int j = 0; j < 4; ++j) v[n * 4 + j] = acc[ai][0][m][n][j] * acc[ai][1][m][n][j] * ri2;
                    u32x4 w; w.x = cvt_pk_bf16(v[0], v[1]); w.y = cvt_pk_bf16(v[2], v[3]); w.z = cvt_pk_bf16(v[4], v[5]); w.w = cvt_pk_bf16(v[6], v[7]);
                    *(u32x4*)(UC + (size_t)r * CW + col0) = w;
                }
            return;
        }
        const int col0 = (u.pn & 3) * 256 + wc * 32 + 8 * fq;
        if (sec == 1) {
#pragma unroll
            for (int bj = 0; bj < 2; ++bj)
#pragma unroll
                for (int n = 0; n < 2; ++n) {
                    const int c = col0 + bj * 128 + 4 * n; const f32x4 l0 = *(const f32x4*)(lbl + c), l1 = *(const f32x4*)(lbl + 1024 + c);
                    f32x4 lb; lb[0] = fsigmoid(l0[0] - l1[0]); lb[1] = fsigmoid(l0[1] - l1[1]); lb[2] = fsigmoid(l0[2] - l1[2]); lb[3] = fsigmoid(l0[3] - l1[3]);
#pragma unroll
                    for (int ai = 0; ai < 2; ++ai)
#pragma unroll
                        for (int m = 0; m < 4; ++m) {
                            const int r = row0 + ai * 128 + m * 16; const float ri = rinv_of(ss[r]);
                            const f32x4 x = acc[ai][bj][m][n]; f32x4 o;
                            o[0] = __logf(lb[0] + (1.0f - lb[0]) * fsigmoid(x[0] * ri)); o[1] = __logf(lb[1] + (1.0f - lb[1]) * fsigmoid(x[1] * ri));
                            o[2] = __logf(lb[2] + (1.0f - lb[2]) * fsigmoid(x[2] * ri)); o[3] = __logf(lb[3] + (1.0f - lb[3]) * fsigmoid(x[3] * ri));
                            *(f32x4*)(LF + (size_t)r * HW + c) = o;
                        }
                }
            return;
        }
        bf16_t* dst = QS + (size_t)(sec == 0 ? 0 : sec - 1) * ((size_t)M_TOK * HW);
        const bool act = (sec == 0 || sec == 3);
#pragma unroll
        for (int ai = 0; ai < 2; ++ai)
#pragma unroll
            for (int m = 0; m < 4; ++m) {
                const int r = row0 + ai * 128 + m * 16; const float ri = rinv_of(ss[r]);
#pragma unroll
                for (int bj = 0; bj < 2; ++bj) {
                    float v[8];
#pragma unroll
                    for (int n = 0; n < 2; ++n)
#pragma unroll
                        for (int j = 0; j < 4; ++j) { const float x = acc[ai][bj][m][n][j] * ri; v[n * 4 + j] = act ? fsilu(x) : x; }
                    u32x4 w; w.x = cvt_pk_bf16(v[0], v[1]); w.y = cvt_pk_bf16(v[2], v[3]); w.z = cvt_pk_bf16(v[4], v[5]); w.w = cvt_pk_bf16(v[6], v[7]);
                    *(u32x4*)(dst + (size_t)r * HW + col0 + bj * 128) = w;
                }
            }
    }
};
struct EpiStoreBf16 {
    static constexpr bool PERM = true, AFTER_DRAIN = false;
    bf16_t* O;
    __device__ __forceinline__ void operator()(const f32x4 (&acc)[2][2][4][2], const Unit& u, int wr, int wc, int fr, int fq) const {
        const int row0 = u.pm * 256 + wr * 64 + fr, col0 = u.pn * 256 + wc * 32 + 8 * fq;
#pragma unroll
        for (int ai = 0; ai < 2; ++ai)
#pragma unroll
            for (int m = 0; m < 4; ++m) {
                const int r = row0 + ai * 128 + m * 16;
#pragma unroll
                for (int bj = 0; bj < 2; ++bj) {
                    const f32x4 v0 = acc[ai][bj][m][0], v1 = acc[ai][bj][m][1];
                    u32x4 w; w.x = cvt_pk_bf16(v0[0], v0[1]); w.y = cvt_pk_bf16(v0[2], v0[3]); w.z = cvt_pk_bf16(v1[0], v1[1]); w.w = cvt_pk_bf16(v1[2], v1[3]);
                    *(u32x4*)(O + (size_t)r * DM + col0 + bj * 128) = w;
                }
            }
    }
};
struct EpiPleGate {
    static constexpr bool PERM = true, AFTER_DRAIN = false;
    const bf16_t* XB; const bf16_t* P; bf16_t* H4; const float* ss;
    __device__ __forceinline__ void operator()(f32x4 (&acc)[2][2][4][2], const Unit& u, int wr, int wc, int fr, int fq) const {
        const int row0 = u.pm * 256 + wr * 64 + fr, col0 = u.pn * 256 + wc * 32 + 8 * fq;
#pragma unroll
        for (int ai = 0; ai < 2; ++ai)
#pragma unroll
            for (int m = 0; m < 4; ++m) {
                const int r = row0 + ai * 128 + m * 16; const float ri = rinv_of(ss[r]);
#pragma unroll
                for (int bj = 0; bj < 2; ++bj) {
                    const size_t off = (size_t)r * DM + col0 + bj * 128;
                    const u32x4 pw = *(const u32x4*)(P + off), xw = *(const u32x4*)(XB + off);
                    const f32x4 a0 = acc[ai][bj][m][0], a1 = acc[ai][bj][m][1];
                    u32x4 w;
                    w.x = cvt_pk_bf16(bflo(xw.x) + fsigmoid(a0[0] * ri) * bflo(pw.x), bfhi(xw.x) + fsigmoid(a0[1] * ri) * bfhi(pw.x));
                    w.y = cvt_pk_bf16(bflo(xw.y) + fsigmoid(a0[2] * ri) * bflo(pw.y), bfhi(xw.y) + fsigmoid(a0[3] * ri) * bfhi(pw.y));
                    w.z = cvt_pk_bf16(bflo(xw.z) + fsigmoid(a1[0] * ri) * bflo(pw.z), bfhi(xw.z) + fsigmoid(a1[1] * ri) * bfhi(pw.z));
                    w.w = cvt_pk_bf16(bflo(xw.w) + fsigmoid(a1[2] * ri) * bflo(pw.w), bfhi(xw.w) + fsigmoid(a1[3] * ri) * bfhi(pw.w));
                    *(u32x4*)(H4 + off) = w;
                }
            }
    }
};

template <int MODE>
__device__ __forceinline__ void p0_item(const float* W, const float* W2, const float* gain, int K, int N, bf16_t* WT, LAS float* scr, int item, int lane) {
    const int nblk_k = K / 64; const int nb = item / nblk_k, kb = item % nblk_k; const int k0 = 64 * kb, n0 = 32 * nb;
    const float* src = W; int c0 = n0;
    if (MODE == 1) { const int t = n0 >> 8, bj = (n0 >> 7) & 1, c = n0 & 127; src = bj ? W2 : W; c0 = 128 * t + c; }
    if (MODE == 2) { if (n0 >= 5120) { const int tt = n0 - 5120; const int t = tt >> 8, bj = (tt >> 7) & 1, c = tt & 127; c0 = 5120 + 1024 * bj + 128 * t + c; } }
    float v[32], gg[32];
    const float* sp = src + (size_t)(k0 + (lane >> 5)) * N + c0 + (lane & 31);
#pragma unroll
    for (int i = 0; i < 32; ++i) v[i] = __builtin_nontemporal_load(sp + (size_t)(2 * i) * N);
    if (gain) {
#pragma unroll
        for (int i = 0; i < 32; ++i) gg[i] = gain[k0 + 2 * i + (lane >> 5)];
#pragma unroll
        for (int i = 0; i < 32; ++i) v[i] *= gg[i];
    }
#pragma unroll
    for (int i = 0; i < 32; ++i) scr[(2 * i + (lane >> 5)) * 33 + (lane & 31)] = v[i];
    asm volatile("s_waitcnt lgkmcnt(0)" ::: "memory");
    const int c = lane & 7;
#pragma unroll
    for (int j = 0; j < 4; ++j) { const int n = (lane >> 3) + 8 * j; const LAS float* s = scr + (8 * c) * 33 + n;
        u32x4 o; o.x = cvt_pk_bf16(s[0 * 33], s[1 * 33]); o.y = cvt_pk_bf16(s[2 * 33], s[3 * 33]); o.z = cvt_pk_bf16(s[4 * 33], s[5 * 33]); o.w = cvt_pk_bf16(s[6 * 33], s[7 * 33]);
        *(u32x4*)(WT + (size_t)(n0 + n) * K + k0 + 8 * c) = o; }
    asm volatile("s_waitcnt lgkmcnt(0)" ::: "memory");
}

struct Args { const float* in[21]; float* out; unsigned char* ws; int ph_lo, ph_hi; };

constexpr int CV_I0 = 32 * 352, CV_I1 = 88 * 64, CV_I2 = 32 * 224, CV_I3 = 32 * 64, CV_I7 = 4 * 64;
constexpr int CV_END = 2 * CV_I0 + 2 * CV_I1 + CV_I2 + 2 * CV_I3 + CV_I7, CV_T1 = CV_END - 10000, CV_T0 = CV_T1 - 10000, CV_TA = CV_I0 + CV_I2 + CV_I3 + CV_I7, CV_P0 = CV_I0 + CV_I7 + CV_I2 - 2000, CV_WO = CV_I0 + CV_I7 + CV_I2;
__device__ __forceinline__ void conv_range(const Args& a, LAS unsigned char* lds, int wave, int lane, int lo, int hi, int w0, int nw) {
    unsigned char* ws = a.ws;
    LAS float* scr = (LAS float*)(lds + wave * 16384);
    for (int it = lo + w0; it < hi; it += nw) {
        int r = it;
        if (r < CV_I0) { p0_item<1>(a.in[3], a.in[4], a.in[2], DM, FF, (bf16_t*)(ws + WS_W1GU), scr, r, lane); continue; } r -= CV_I0;
        if (r < CV_I7) { p0_item<0>(a.in[18], nullptr, nullptr, PLE, DM, (bf16_t*)(ws + WS_WPE), scr, r, lane); continue; } r -= CV_I7;
        if (r < CV_I2) { p0_item<2>(a.in[7], nullptr, a.in[6], DM, MIXIN, (bf16_t*)(ws + WS_WIN), scr, r, lane); continue; } r -= CV_I2;
        if (r < CV_I3) { p0_item<0>(a.in[12], nullptr, nullptr, DM, DM, (bf16_t*)(ws + WS_WOUT), scr, r, lane); continue; } r -= CV_I3;
        if (r < CV_I3) { p0_item<0>(a.in[19], nullptr, a.in[17], DM, DM, (bf16_t*)(ws + WS_WPG), scr, r, lane); continue; } r -= CV_I3;
        if (r < CV_I1) { p0_item<0>(a.in[16], nullptr, nullptr, FF, DM, (bf16_t*)(ws + WS_W2D), scr, r, lane); continue; } r -= CV_I1;
        if (r < CV_I0) { p0_item<1>(a.in[14], a.in[15], a.in[13], DM, FF, (bf16_t*)(ws + WS_W2GU), scr, r, lane); continue; } r -= CV_I0;
        p0_item<0>(a.in[5], nullptr, nullptr, FF, DM, (bf16_t*)(ws + WS_W1D), scr, r, lane);
    }
}
__device__ __forceinline__ void conv_tail(const Args& a, LAS unsigned char* lds, int wave, int lane, int nunits, int lo, int hi, int vc) {
    const int r = nunits % (int)gridDim.x;
    if (r == 0) { conv_range(a, lds, wave, lane, lo, hi, vc * 8 + wave, gridDim.x * 8); return; }
    if (vc >= r) conv_range(a, lds, wave, lane, lo, hi, (vc - r) * 8 + wave, ((int)gridDim.x - r) * 8);
}

__device__ __forceinline__ void phase0(const Args& a, LAS unsigned char* lds, int wave, int lane) {
    unsigned char* ws = a.ws;
    const int gw = blockIdx.x * 8 + wave, NGW = gridDim.x * 8;
    conv_range(a, lds, wave, lane, 0, CV_P0, gw, NGW);
    float* SS = (float*)(ws + WS_SS);
    for (int m = gw; m < M_TOK; m += NGW) {
        const f32x4* xr = (const f32x4*)(a.in[0] + (size_t)m * DM) + lane; u32x2* xb = (u32x2*)((bf16_t*)(ws + WS_XB) + (size_t)m * DM) + lane;
        float s = 0.f;
#pragma unroll
        for (int j = 0; j < 8; ++j) { const f32x4 v = __builtin_nontemporal_load(xr + 64 * j); s += (v[0] * v[0] + v[1] * v[1]) + (v[2] * v[2] + v[3] * v[3]);
            u32x2 w; w.x = cvt_pk_bf16(v[0], v[1]); w.y = cvt_pk_bf16(v[2], v[3]); xb[64 * j] = w; }
        s = wave_sum(s);
        if (lane == 0) { SS[m] = s; SS[8192 + m] = 0.f; SS[16384 + m] = 0.f; SS[24576 + m] = 0.f; }
    }
    { const int gt = blockIdx.x * 512 + threadIdx.x, NT = gridDim.x * 512;
      for (int i = gt; i < M_TOK * PLE / 4; i += NT) { const f32x4 v = __builtin_nontemporal_load((const f32x4*)a.in[1] + i); u32x2 w; w.x = cvt_pk_bf16(v[0], v[1]); w.y = cvt_pk_bf16(v[2], v[3]); ((u32x2*)(ws + WS_PB))[i] = w; } }
}

constexpr int HP = 136, VP = 72;
constexpr int L_QT = 0, L_QH = L_QT + 64 * HP * 2, L_KA = L_QH + 64 * HP * 2, L_KB = L_KA + 64 * HP * 2, L_ST = L_KB + 32 * HP * 2, L_VT = L_ST + 128 * HP * 2,
              L_P = L_VT + 128 * VP * 2, L_SEG = L_P + 64 * VP * 2, L_PART = L_SEG + 8 * 128 * 4, L_RINV = L_PART + 8 * 64 * 4, L_HEND = L_RINV + 256, L_KT = 0;
static_assert(L_HEND <= LDS_BYTES, "LDS");
#define MFMA16(a, b, c) __builtin_amdgcn_mfma_f32_16x16x32_bf16((a), (b), (c), 0, 0, 0)
__device__ __forceinline__ bf16_t f2bf(float x) { return (bf16_t)(cvt_pk_bf16(x, 0.f) & 0xffffu); }

#define LDSBAR() do { asm volatile("s_waitcnt lgkmcnt(0)" ::: "memory"); __builtin_amdgcn_s_barrier(); asm volatile("" ::: "memory"); } while (0)
__device__ __forceinline__ void hgrn_pass_a(const Args& a, LAS unsigned char* lds, int wave, int lane) {
    unsigned char* ws = a.ws;
    const float* LF = (const float*)(ws + WS_LF); const bf16_t* VH = (const bf16_t*)(ws + WS_VH); bf16_t* U = (bf16_t*)(ws + WS_U); float* Dd = (float*)(ws + WS_DD);
    const int tid = threadIdx.x, k = tid & 127, sg = tid >> 7, fr = lane & 15, fq = lane >> 4;
    LAS bf16_t* VT = (LAS bf16_t*)(lds + L_VT); LAS bf16_t* KT = (LAS bf16_t*)(lds + L_KT); LAS float* SEG = (LAS float*)(lds + L_SEG);
    float lf[16]; u32x4 vv[2];
#define PA_LOAD(it) do { const int r0_ = ((it) >> 3) * 64, c0_ = ((it) & 7) * 128; \
        _Pragma("unroll") for (int i = 0; i < 16; ++i) lf[i] = LF[(size_t)(r0_ + 16 * sg + i) * HW + c0_ + k]; \
        _Pragma("unroll") for (int j = 0; j < 2; ++j) { const int idx = tid + 512 * j; vv[j] = *(const u32x4*)(VH + (size_t)(r0_ + (idx >> 4)) * HW + c0_ + 8 * (idx & 15)); } } while (0)
    int item = blockIdx.x;
    if (item < 1024) PA_LOAD(item);
    for (; item < 1024; item += gridDim.x) {
        float b[16];
        float run = 0.f;
#pragma unroll
        for (int i = 0; i < 16; ++i) { run += lf[i]; b[i] = run; }
        SEG[sg * 128 + k] = run;
        LDSBAR();
        const float s0 = SEG[k], s1 = SEG[128 + k], s2 = SEG[256 + k], s3 = SEG[384 + k];
        const float pre = sg == 0 ? 0.f : (sg == 1 ? s0 : (sg == 2 ? s0 + s1 : s0 + s1 + s2));
        const float blast = s0 + s1 + s2 + s3;
        unsigned pk[8];
#pragma unroll
        for (int i = 0; i < 8; ++i) {
            const float e0 = (1.0f - __expf(lf[2 * i])) * __expf(blast - (pre + b[2 * i])), e1 = (1.0f - __expf(lf[2 * i + 1])) * __expf(blast - (pre + b[2 * i + 1]));
            pk[i] = cvt_pk_bf16(e0, e1); }
        { u32x4 w0, w1; w0.x = pk[0]; w0.y = pk[1]; w0.z = pk[2]; w0.w = pk[3]; w1.x = pk[4]; w1.y = pk[5]; w1.z = pk[6]; w1.w = pk[7];
          *(LAS u32x4*)(KT + k * VP + 16 * sg) = w0; *(LAS u32x4*)(KT + k * VP + 16 * sg + 8) = w1; }
#pragma unroll
        for (int j = 0; j < 2; ++j) { const int idx = tid + 512 * j, s = idx >> 4, v0 = 8 * (idx & 15);
            VT[(v0 + 0) * VP + s] = (bf16_t)(vv[j].x & 0xffffu); VT[(v0 + 1) * VP + s] = (bf16_t)(vv[j].x >> 16);
            VT[(v0 + 2) * VP + s] = (bf16_t)(vv[j].y & 0xffffu); VT[(v0 + 3) * VP + s] = (bf16_t)(vv[j].y >> 16);
            VT[(v0 + 4) * VP + s] = (bf16_t)(vv[j].z & 0xffffu); VT[(v0 + 5) * VP + s] = (bf16_t)(vv[j].z >> 16);
            VT[(v0 + 6) * VP + s] = (bf16_t)(vv[j].w & 0xffffu); VT[(v0 + 7) * VP + s] = (bf16_t)(vv[j].w >> 16); }
        if (sg == 0) Dd[item * 128 + k] = __expf(blast);
        if (item + (int)gridDim.x < 1024) PA_LOAD(item + (int)gridDim.x);
        LDSBAR();
        const bf16x8 a0 = *(const LAS bf16x8*)(VT + (16 * wave + fr) * VP + fq * 8), a1 = *(const LAS bf16x8*)(VT + (16 * wave + fr) * VP + 32 + fq * 8);
        bf16_t* up = U + (size_t)item * 16384 + (16 * wave + fr) * 128 + 4 * fq;
#pragma unroll
        for (int kt = 0; kt < 8; ++kt) {
            const bf16x8 b0 = *(const LAS bf16x8*)(KT + (16 * kt + fr) * VP + fq * 8), b1 = *(const LAS bf16x8*)(KT + (16 * kt + fr) * VP + 32 + fq * 8);
            f32x4 acc = {0.f, 0.f, 0.f, 0.f};
            acc = MFMA16(b0, a0, acc); acc = MFMA16(b1, a1, acc);
            u32x2 w; w.x = cvt_pk_bf16(acc[0], acc[1]); w.y = cvt_pk_bf16(acc[2], acc[3]);
            *(u32x2*)(up + 16 * kt) = w;
        }
        LDSBAR();
    }
#undef PA_LOAD
}

__device__ __forceinline__ void hgrn_scan(const Args& a) {
    unsigned char* ws = a.ws;
    const bf16_t* U = (const bf16_t*)(ws + WS_U); const float* Dd = (const float*)(ws + WS_DD); bf16_t* SP = (bf16_t*)(ws + WS_S);
    for (int e = (blockIdx.x * 512 + threadIdx.x) * 4; e < 32 * 16384; e += gridDim.x * 512 * 4) {
        const int bh = e >> 14, vk = e & 16383, bb = bh >> 3, h = bh & 7;
        f32x4 S = {0.f, 0.f, 0.f, 0.f};
#pragma unroll 8
        for (int ci = 0; ci < 32; ++ci) {
            const size_t item = (size_t)((bb * 32 + ci) * 8 + h);
            const u32x2 uw = *(const u32x2*)(U + item * 16384 + vk); f32x4 u; u[0] = bflo(uw.x); u[1] = bfhi(uw.x); u[2] = bflo(uw.y); u[3] = bfhi(uw.y); const f32x4 d = *(const f32x4*)(Dd + item * 128 + (vk & 127));
            u32x2 w; w.x = cvt_pk_bf16(S[0], S[1]); w.y = cvt_pk_bf16(S[2], S[3]); *(u32x2*)(SP + item * 16384 + vk) = w;
            S = d * S + u;
        }
    }
}

__device__ __forceinline__ void conv_mixer(const Args& a, int wave, int lane) {
    unsigned char* ws = a.ws;
    const bf16_t* BC = (const bf16_t*)(ws + WS_BC); const bf16_t* UC = (const bf16_t*)(ws + WS_UC); bf16_t* MIX = (bf16_t*)(ws + WS_MIX);
    const float* cn = a.in[11]; const float* cw = a.in[8];
    const int gw = blockIdx.x * 8 + wave, NGW = gridDim.x * 8;
    for (int it = gw; it < M_TOK * 2; it += NGW) {
        const int row = it >> 1, c = (it & 1) * 512 + lane * 8, t = row & (SEQ - 1);
        const size_t off = (size_t)row * CW + c;
        const u32x4 z = {0u, 0u, 0u, 0u};
        const u32x4 u0 = *(const u32x4*)(UC + off), u1 = t >= 1 ? *(const u32x4*)(UC + off - CW) : z, u2 = t >= 2 ? *(const u32x4*)(UC + off - 2 * CW) : z, bg = *(const u32x4*)(BC + off);
        float y[8]; float ssq = 0.f;
#pragma unroll
        for (int q = 0; q < 4; ++q) {
            const unsigned a0 = u0[q], a1 = u1[q], a2 = u2[q], bb = bg[q]; const int cc = c + 2 * q;
            y[2 * q] = bflo(bb) * (cw[cc] * bflo(a2) + cw[CW + cc] * bflo(a1) + cw[2 * CW + cc] * bflo(a0));
            y[2 * q + 1] = bfhi(bb) * (cw[cc + 1] * bfhi(a2) + cw[CW + cc + 1] * bfhi(a1) + cw[2 * CW + cc + 1] * bfhi(a0));
            ssq += y[2 * q] * y[2 * q] + y[2 * q + 1] * y[2 * q + 1];
        }
        ssq = row16_sum(ssq);
        const float ri = rsqrtf(ssq * (1.0f / 128) + EPS);
        u32x4 w;
        w.x = cvt_pk_bf16(y[0] * ri * cn[c], y[1] * ri * cn[c + 1]); w.y = cvt_pk_bf16(y[2] * ri * cn[c + 2], y[3] * ri * cn[c + 3]);
        w.z = cvt_pk_bf16(y[4] * ri * cn[c + 4], y[5] * ri * cn[c + 5]); w.w = cvt_pk_bf16(y[6] * ri * cn[c + 6], y[7] * ri * cn[c + 7]);
        *(u32x4*)(MIX + (size_t)row * DM + HW + c) = w;
    }
}

__device__ __forceinline__ void hgrn_pass_c(const Args& a, LAS unsigned char* lds, int wave, int lane) {
    unsigned char* ws = a.ws;
    const float* LF = (const float*)(ws + WS_LF); const bf16_t* VH = (const bf16_t*)(ws + WS_VH); const bf16_t* QS = (const bf16_t*)(ws + WS_QS); const bf16_t* GH = (const bf16_t*)(ws + WS_GH);
    const bf16_t* SP = (const bf16_t*)(ws + WS_S); bf16_t* MIX = (bf16_t*)(ws + WS_MIX); const float* hn = a.in[10];
    const int tid = threadIdx.x, k = tid & 127, sg = tid >> 7, fr = lane & 15, fq = lane >> 4;
    LAS bf16_t* QT = (LAS bf16_t*)(lds + L_QT); LAS bf16_t* QH = (LAS bf16_t*)(lds + L_QH); LAS bf16_t* KA = (LAS bf16_t*)(lds + L_KA); LAS bf16_t* KB = (LAS bf16_t*)(lds + L_KB);
    LAS bf16_t* ST = (LAS bf16_t*)(lds + L_ST); LAS bf16_t* VT = (LAS bf16_t*)(lds + L_VT); LAS bf16_t* P = (LAS bf16_t*)(lds + L_P);
    LAS float* SEG = (LAS float*)(lds + L_SEG); LAS float* PART = (LAS float*)(lds + L_PART); LAS float* RINV = (LAS float*)(lds + L_RINV);
    const f32x4 hnv = *(const f32x4*)(hn + 16 * wave + 4 * fq);
    const int k0 = 2 * (tid & 63);
    f32x2v lf2[8]; unsigned q2[8]; u32x4 vv[2], sv[4];
#define PC_LOAD(it) do { const int r0_ = ((it) >> 3) * 64, c0_ = ((it) & 7) * 128; \
        _Pragma("unroll") for (int i = 0; i < 8; ++i) { lf2[i] = *(const f32x2v*)(LF + (size_t)(r0_ + 8 * wave + i) * HW + c0_ + k0); q2[i] = *(const unsigned*)(QS + (size_t)(r0_ + 8 * wave + i) * HW + c0_ + k0); } \
        _Pragma("unroll") for (int j = 0; j < 2; ++j) { const int idx = tid + 512 * j; vv[j] = *(const u32x4*)(VH + (size_t)(r0_ + (idx >> 4)) * HW + c0_ + 8 * (idx & 15)); } \
        _Pragma("unroll") for (int j = 0; j < 4; ++j) { const int idx = tid + 512 * j; sv[j] = *(const u32x4*)(SP + (size_t)(it) * 16384 + (idx >> 4) * 128 + 8 * (idx & 15)); } } while (0)
    int item = blockIdx.x;
    if (item < 1024) PC_LOAD(item);
    for (; item < 1024; item += gridDim.x) {
        const int row0 = (item >> 3) * 64, cb = (item & 7) * 128;
        f32x2v b2[8]; f32x2v run = {0.f, 0.f};
#pragma unroll
        for (int i = 0; i < 8; ++i) { run += lf2[i]; b2[i] = run; }
        *(LAS f32x2v*)(SEG + wave * 128 + k0) = run;
        LDSBAR();
        f32x2v pre = {0.f, 0.f}, beta1 = {0.f, 0.f};
#pragma unroll
        for (int j = 0; j < 8; ++j) { const f32x2v sj = *(const LAS f32x2v*)(SEG + j * 128 + k0); if (j < wave) pre += sj; if (j < 4) beta1 += sj; }
        if (wave < 4) {
#pragma unroll
            for (int i = 0; i < 8; ++i) {
                const int so = (8 * wave + i) * HP + k0; const f32x2v bi = pre + b2[i];
                const float kk0 = 1.0f - __expf(lf2[i][0]), kk1 = 1.0f - __expf(lf2[i][1]);
                const unsigned qw = cvt_pk_bf16(bflo(q2[i]) * __expf(bi[0]), bfhi(q2[i]) * __expf(bi[1]));
                *(LAS unsigned*)(QT + so) = qw; *(LAS unsigned*)(QH + so) = qw;
                *(LAS unsigned*)(KA + so) = cvt_pk_bf16(kk0 * __expf(fminf(-bi[0], 80.f)), kk1 * __expf(fminf(-bi[1], 80.f)));
                *(LAS unsigned*)(KB + so) = cvt_pk_bf16(kk0 * __expf(beta1[0] - bi[0]), kk1 * __expf(beta1[1] - bi[1]));
            }
        } else {
#pragma unroll
            for (int i = 0; i < 8; ++i) {
                const int so = (8 * wave + i) * HP + k0; const f32x2v bi = pre + b2[i];
                const float kk0 = 1.0f - __expf(lf2[i][0]), kk1 = 1.0f - __expf(lf2[i][1]);
                const float q0 = bflo(q2[i]), q1 = bfhi(q2[i]);
                *(LAS unsigned*)(QH + so) = cvt_pk_bf16(q0 * __expf(bi[0]), q1 * __expf(bi[1]));
                *(LAS unsigned*)(QT + so) = cvt_pk_bf16(q0 * __expf(bi[0] - beta1[0]), q1 * __expf(bi[1] - beta1[1]));
                *(LAS unsigned*)(KA + so) = cvt_pk_bf16(kk0 * __expf(fminf(beta1[0] - bi[0], 80.f)), kk1 * __expf(fminf(beta1[1] - bi[1], 80.f)));
            }
        }
#pragma unroll
        for (int j = 0; j < 2; ++j) { const int idx = tid + 512 * j, s = idx >> 4, v0 = 8 * (idx & 15);
            VT[(v0 + 0) * VP + s] = (bf16_t)(vv[j].x & 0xffffu); VT[(v0 + 1) * VP + s] = (bf16_t)(vv[j].x >> 16);
            VT[(v0 + 2) * VP + s] = (bf16_t)(vv[j].y & 0xffffu); VT[(v0 + 3) * VP + s] = (bf16_t)(vv[j].y >> 16);
            VT[(v0 + 4) * VP + s] = (bf16_t)(vv[j].z & 0xffffu); VT[(v0 + 5) * VP + s] = (bf16_t)(vv[j].z >> 16);
            VT[(v0 + 6) * VP + s] = (bf16_t)(vv[j].w & 0xffffu); VT[(v0 + 7) * VP + s] = (bf16_t)(vv[j].w >> 16); }
#pragma unroll
        for (int j = 0; j < 4; ++j) { const int idx = tid + 512 * j; *(LAS u32x4*)(ST + (idx >> 4) * HP + 8 * (idx & 15)) = sv[j]; }
        if (item + (int)gridDim.x < 1024) PC_LOAD(item + (int)gridDim.x);
        LDSBAR();
        u32x2 gh[4];
#pragma unroll
        for (int tt = 0; tt < 4; ++tt) gh[tt] = *(const u32x2*)(GH + (size_t)(row0 + 16 * tt + fr) * HW + cb + 16 * wave + 4 * fq);
#pragma unroll
        for (int pp = 0; pp < 2; ++pp) {
            const int p = wave + 8 * pp, tt = p >> 2, st = p & 3;
            f32x4 acc = {0.f, 0.f, 0.f, 0.f};
            if (st <= tt) {
                const LAS bf16_t* kb = (tt >= 2 && st < 2) ? KB : KA;
#pragma unroll
                for (int ks = 0; ks < 4; ++ks) { const bf16x8 af = *(const LAS bf16x8*)(QT + (16 * tt + fr) * HP + ks * 32 + fq * 8), bfr = *(const LAS bf16x8*)(kb + (16 * st + fr) * HP + ks * 32 + fq * 8);
                    acc = MFMA16(af, bfr, acc); }
            }
#pragma unroll
            for (int r = 0; r < 4; ++r) { const bool keep = (st < tt) || (st == tt && fr <= 4 * fq + r); P[(16 * tt + 4 * fq + r) * VP + 16 * st + fr] = f2bf(keep ? acc[r] : 0.f); }
        }
        LDSBAR();
        bf16x8 bs[4], bv[2];
#pragma unroll
        for (int ks = 0; ks < 4; ++ks) bs[ks] = *(const LAS bf16x8*)(ST + (16 * wave + fr) * HP + ks * 32 + fq * 8);
#pragma unroll
        for (int ks = 0; ks < 2; ++ks) bv[ks] = *(const LAS bf16x8*)(VT + (16 * wave + fr) * VP + ks * 32 + fq * 8);
        f32x4 o[4];
#pragma unroll
        for (int tt = 0; tt < 4; ++tt) {
            f32x4 acc = {0.f, 0.f, 0.f, 0.f};
#pragma unroll
            for (int ks = 0; ks < 4; ++ks) { const bf16x8 af = *(const LAS bf16x8*)(QH + (16 * tt + fr) * HP + ks * 32 + fq * 8); acc = MFMA16(bs[ks], af, acc); }
            { const bf16x8 af = *(const LAS bf16x8*)(P + (16 * tt + fr) * VP + fq * 8); acc = MFMA16(bv[0], af, acc); }
            if (tt >= 2) { const bf16x8 af = *(const LAS bf16x8*)(P + (16 * tt + fr) * VP + 32 + fq * 8); acc = MFMA16(bv[1], af, acc); }
            o[tt] = acc;
        }
#pragma unroll
        for (int tt = 0; tt < 4; ++tt) { float x = (o[tt][0] * o[tt][0] + o[tt][1] * o[tt][1]) + (o[tt][2] * o[tt][2] + o[tt][3] * o[tt][3]);
            x += __shfl_xor(x, 16); x += __shfl_xor(x, 32);
            if (fq == 0) PART[wave * 64 + 16 * tt + fr] = x; }
        LDSBAR();
        if (tid < 64) { float s = 0.f;
#pragma unroll
            for (int w = 0; w < 8; ++w) s += PART[w * 64 + tid];
            RINV[tid] = rsqrtf(s * (1.0f / 128) + EPS); }
        LDSBAR();
#pragma unroll
        for (int tt = 0; tt < 4; ++tt) { const float ri = RINV[16 * tt + fr];
            u32x2 w; w.x = cvt_pk_bf16(o[tt][0] * ri * hnv[0] * bflo(gh[tt].x), o[tt][1] * ri * hnv[1] * bfhi(gh[tt].x));
            w.y = cvt_pk_bf16(o[tt][2] * ri * hnv[2] * bflo(gh[tt].y), o[tt][3] * ri * hnv[3] * bfhi(gh[tt].y));
            *(u32x2*)(MIX + (size_t)(row0 + 16 * tt + fr) * DM + cb + 16 * wave + 4 * fq) = w; }
        LDSBAR();
    }
#undef PC_LOAD
}

__device__ __forceinline__ void phase_final(const Args& a, int wave, int lane) {
    const int gw = blockIdx.x * 8 + wave, NGW = gridDim.x * 8; const float* gF = a.in[20]; const bf16_t* H4 = (const bf16_t*)(a.ws + WS_MIX);
    for (int m = gw; m < M_TOK; m += NGW) {
        const u32x4* hr = (const u32x4*)(H4 + (size_t)m * DM) + lane; u32x4 w[4]; float s = 0.f;
#pragma unroll
        for (int j = 0; j < 4; ++j) { w[j] = __builtin_nontemporal_load(hr + 64 * j);
            s += (bflo(w[j].x) * bflo(w[j].x) + bfhi(w[j].x) * bfhi(w[j].x)) + (bflo(w[j].y) * bflo(w[j].y) + bfhi(w[j].y) * bfhi(w[j].y))
               + (bflo(w[j].z) * bflo(w[j].z) + bfhi(w[j].z) * bfhi(w[j].z)) + (bflo(w[j].w) * bflo(w[j].w) + bfhi(w[j].w) * bfhi(w[j].w)); }
        const float ri = rinv_of(wave_sum(s));
        f32x4* orow = (f32x4*)(a.out + (size_t)m * DM);
#pragma unroll
        for (int j = 0; j < 4; ++j) { const int c = (64 * j + lane) * 8; const f32x4 g0 = *(const f32x4*)(gF + c), g1 = *(const f32x4*)(gF + c + 4);
            f32x4 o0, o1; o0[0] = bflo(w[j].x) * ri * g0[0]; o0[1] = bfhi(w[j].x) * ri * g0[1]; o0[2] = bflo(w[j].y) * ri * g0[2]; o0[3] = bfhi(w[j].y) * ri * g0[3];
            o1[0] = bflo(w[j].z) * ri * g1[0]; o1[1] = bfhi(w[j].z) * ri * g1[1]; o1[2] = bflo(w[j].w) * ri * g1[2]; o1[3] = bfhi(w[j].w) * ri * g1[3];
            __builtin_nontemporal_store(o0, orow + c / 4); __builtin_nontemporal_store(o1, orow + c / 4 + 1); }
    }
}

#define XB_TMO      128
#define XB_XCNT(j)  (256  + 64 * (j))
#define XB_XSUB(j)  (1280 + 64 * (j))
#define XB_XGEN(j)  (2304 + 64 * (j))
#define XB_TOP      3328
#define XB_TOPGEN   3392
#define XCD_BAR_WORDS 3456
#define XB_SPIN_CAP (1u << 18)

__device__ __forceinline__ unsigned xb_ld(unsigned* p)              { return __hip_atomic_load(p, __ATOMIC_RELAXED, __HIP_MEMORY_SCOPE_AGENT); }
__device__ __forceinline__ unsigned xb_add(unsigned* p, unsigned v) { return __hip_atomic_fetch_add(p, v, __ATOMIC_RELAXED, __HIP_MEMORY_SCOPE_AGENT); }
__device__ __forceinline__ unsigned xb_xcc_id() { return (unsigned)__builtin_amdgcn_s_getreg((3 << 11) | 20) & 0xFu; }
#define XB_SPIN(cond, bar) do { unsigned _sp = 0; while (cond) { __builtin_amdgcn_s_sleep(1); \
    if ((++_sp & 255u) == 0u) { if (xb_ld(&(bar)[XB_TMO])) break; if (_sp > XB_SPIN_CAP) { atomicAdd(&(bar)[XB_TMO], 1u); break; } } } } while (0)

struct XcdBarrier {
    unsigned* bar; unsigned x;
    volatile LAS unsigned* st;
};

__device__ __forceinline__ XcdBarrier xcd_barrier_post(unsigned* bar, volatile LAS unsigned* st) {
    XcdBarrier b; b.bar = bar; b.x = xb_xcc_id(); b.st = st;
    if (threadIdx.x == 0) (void)xb_add(&bar[XB_XCNT(b.x)], 1u);
    return b;
}
__device__ __forceinline__ void xcd_barrier_complete(unsigned* bar, unsigned x, unsigned& nloc, unsigned& nx) {
    const unsigned G = gridDim.x * gridDim.y * gridDim.z;
    unsigned sum, cnt, mine, sp = 0u;
    for (;;) {
        sum = 0u; cnt = 0u; mine = 0u;
#pragma unroll
        for (unsigned j = 0; j < 16; ++j) { const unsigned c = xb_ld(&bar[XB_XCNT(j)]); sum += c; cnt += (c > 0u) ? 1u : 0u; mine = (j == x) ? c : mine; }
        if (sum == G) break;
        __builtin_amdgcn_s_sleep(1);
        if ((++sp & 255u) == 0u) { if (xb_ld(&bar[XB_TMO])) break; if (sp > XB_SPIN_CAP) { atomicAdd(&bar[XB_TMO], 1u); break; } }
    }
    nloc = mine > 0u ? mine : 1u; nx = cnt > 0u ? cnt : 1u;
}

__device__ __forceinline__ void xcd_barrier(const XcdBarrier& b) {
    asm volatile("s_waitcnt vmcnt(0)" ::: "memory");
    __syncthreads();
    if (threadIdx.x == 0) {
        unsigned* bar = b.bar;
        __builtin_amdgcn_s_waitcnt(0);
        unsigned nloc = b.st[0], nx = b.st[1];
        if (nloc == 0u) { xcd_barrier_complete(bar, b.x, nloc, nx); b.st[0] = nloc; b.st[1] = nx; }
        const unsigned old = xb_add(&bar[XB_XSUB(b.x)], 1u);
        const unsigned gen = old / nloc;
        if (old + 1u == (gen + 1u) * nloc) {
            __builtin_amdgcn_fence(__ATOMIC_RELEASE, "agent");
            asm volatile("s_waitcnt vmcnt(0)" ::: "memory");
            const unsigned og = xb_add(&bar[XB_TOP], 1u);
            const unsigned tg = og / nx;
            if (og + 1u == (tg + 1u) * nx) xb_add(&bar[XB_TOPGEN], 1u);
            else XB_SPIN(xb_ld(&bar[XB_TOPGEN]) == tg, bar);
            __builtin_amdgcn_fence(__ATOMIC_ACQUIRE, "agent");
            xb_add(&bar[XB_XGEN(b.x)], 1u);
            asm volatile("s_waitcnt vmcnt(0)" ::: "memory");
        } else {
            XB_SPIN(xb_ld(&bar[XB_XGEN(b.x)]) == gen, bar);
            __builtin_amdgcn_fence(__ATOMIC_ACQUIRE, "agent");
            asm volatile("s_waitcnt vmcnt(0)" ::: "memory");
        }
    }
    __syncthreads();
}


template <class Epi>
__device__ __forceinline__ void run_gemm(LAS unsigned char* lds, const bf16_t* A, const bf16_t* Bt, int N, int K, const Epi& E, int vc) {
    pg8::Gemm g; g.A = A; g.Bt = Bt; g.M = M_TOK; g.N = N; g.K = K;
    pg8::StaticOrder S; S.init(M_TOK, N, (int)gridDim.x, vc);
    pg8::gemm_phase<Epi, pg8::StaticOrder, true, true>(lds, g, S, E);
}
struct TailOrder {
    int c, n;
    __device__ __forceinline__ bool next(int i, Unit& u) const { if (c < 0) return false; const int L = i * n + c; if (L >= 256) return false; u.pm = L >> 3; u.pn = L & 7; return true; }
    __device__ __forceinline__ void a_ready(const Unit&) const {}
    __device__ __forceinline__ void done(const Unit&) const {}
};

__global__ void __launch_bounds__(512, 2) fwd_kernel(Args a) {
    extern __shared__ __attribute__((aligned(16))) unsigned char lds_raw[];
    LAS unsigned char* lds = (LAS unsigned char*)lds_raw;
    cg::grid_group grid = cg::this_grid();
    volatile LAS unsigned* xst = (volatile LAS unsigned*)(lds + LDS_BYTES - 16);
    if (threadIdx.x < 4) xst[threadIdx.x] = 0u;
    __syncthreads();
    XcdBarrier xbar = xcd_barrier_post((unsigned*)(a.ws + WS_BAR), xst);
    unsigned* cen = (unsigned*)(a.ws + WS_BAR) + 3584;
    if (threadIdx.x == 0) xst[2] = xb_add(&cen[64 * xbar.x], 1u);
    if (a.ph_hi > NPHASE) grid.sync();
    int vc = blockIdx.x;
    const int tid = threadIdx.x, lane = tid & 63, wave = __builtin_amdgcn_readfirstlane(tid >> 6);
    unsigned char* ws = a.ws;
    float* SS = (float*)(ws + WS_SS);
    bf16_t* XB = (bf16_t*)(ws + WS_XB); bf16_t* G = (bf16_t*)(ws + WS_G); bf16_t* MIX = (bf16_t*)(ws + WS_MIX);
#define PH(i) if (a.ph_lo <= (i) && (i) < a.ph_hi)
#define SYNC(i) if (a.ph_lo <= (i) && (i) + 1 < a.ph_hi) { xcd_barrier(xbar); }
    PH(0) { phase0(a, lds, wave, lane); } SYNC(0)
    if (a.ph_lo == 0 && a.ph_hi == NPHASE && gridDim.x == 256) {
        bool even = true;
#pragma unroll
        for (int j = 0; j < 8; ++j) even = even && (xb_ld(&cen[64 * j]) == 32u);
        if (even) vc = (int)xst[2] * 8 + (int)xbar.x;
    }
    vc = __builtin_amdgcn_readfirstlane(vc);
    PH(1) { EpiGateUp E; E.G = G; E.ss = SS; run_gemm(lds, XB, (const bf16_t*)(ws + WS_W1GU), 2 * FF, DM, E, vc); conv_tail(a, lds, wave, lane, 32 * 44, CV_P0, CV_WO, vc); conv_tail(a, lds, wave, lane, 32 * 44, CV_T1, CV_END, vc); } SYNC(1)
    PH(2) { EpiResid E; E.XB = XB; E.ss_out = SS + 8192; E.scale = 0.5f; run_gemm(lds, G, (const bf16_t*)(ws + WS_W1D), DM, FF, E, vc); } SYNC(2)
    PH(3) { EpiMixIn E; E.ss = SS + 8192; E.lbl = a.in[9]; E.QS = (bf16_t*)(ws + WS_QS);
            E.UC = (bf16_t*)(ws + WS_UC); E.LF = (float*)(ws + WS_LF); run_gemm(lds, XB, (const bf16_t*)(ws + WS_WIN), MIXIN, DM, E, vc); conv_tail(a, lds, wave, lane, 32 * 28, CV_WO, CV_TA, vc); conv_tail(a, lds, wave, lane, 32 * 28, CV_T0, CV_T1, vc); } SYNC(3)
    PH(4) { hgrn_pass_a(a, lds, wave, lane); } SYNC(4)
    PH(5) { hgrn_scan(a); conv_mixer(a, wave, lane); } SYNC(5)
    PH(6) { hgrn_pass_c(a, lds, wave, lane); } SYNC(6)
    PH(7) { EpiResid E; E.XB = XB; E.ss_out = SS + 16384; E.scale = 1.0f; run_gemm(lds, MIX, (const bf16_t*)(ws + WS_WOUT), DM, DM, E, vc); } SYNC(7)
    PH(8) { EpiGateUp E; E.G = G; E.ss = SS + 16384; run_gemm(lds, XB, (const bf16_t*)(ws + WS_W2GU), 2 * FF, DM, E, vc);
            { const int r = (32 * 44) % (int)gridDim.x; TailOrder T; T.n = (int)gridDim.x - r; T.c = vc - r;
              EpiStoreBf16 E2; E2.O = (bf16_t*)(ws + WS_PLE); int kp = PLE; asm volatile("" : "+s"(kp));
              pg8::Gemm g2; g2.A = (const bf16_t*)(ws + WS_PB); g2.Bt = (const bf16_t*)(ws + WS_WPE); g2.M = M_TOK; g2.N = DM; g2.K = kp;
              pg8::gemm_phase<EpiStoreBf16, TailOrder, true, true>(lds, g2, T, E2); }
            conv_tail(a, lds, wave, lane, 32 * 44, CV_TA, CV_T0, vc); } SYNC(8)
    PH(9) { EpiResid E; E.XB = XB; E.ss_out = SS + 24576; E.scale = 0.5f; run_gemm(lds, G, (const bf16_t*)(ws + WS_W2D), DM, FF, E, vc); } SYNC(9)
    PH(10) { EpiPleGate E; E.XB = XB; E.H4 = MIX; E.P = (const bf16_t*)(ws + WS_PLE); E.ss = SS + 24576; run_gemm(lds, XB, (const bf16_t*)(ws + WS_WPG), DM, DM, E, vc); } SYNC(10)
    PH(11) { phase_final(a, wave, lane); }
#undef PH
#undef SYNC
}

#ifndef MK_MULTI
#define MK_MULTI 0
#endif
extern "C" void kernel_launch(void* const* d_in, const int* in_sizes, int n_in, void* d_out, int out_size, void* d_ws, size_t ws_size, hipStream_t stream) {
    static int grid = 0;
    if (grid == 0) {
        if (n_in != 21 || out_size != M_TOK * DM || ws_size < WS_END) { fprintf(stderr, "kernel_launch: unexpected shapes (n_in %d out %d ws %zu need %zu)\n", n_in, out_size, ws_size, (size_t)WS_END); grid = -1; return; }
        int dev = 0, cus = 0, per_cu = 0;
        hipGetDevice(&dev); hipDeviceGetAttribute(&cus, hipDeviceAttributeMultiprocessorCount, dev);
        if (hipFuncSetAttribute((const void*)fwd_kernel, hipFuncAttributeMaxDynamicSharedMemorySize, LDS_BYTES) != hipSuccess) { fprintf(stderr, "kernel_launch: hipFuncSetAttribute failed\n"); grid = -1; return; }
        if (hipOccupancyMaxActiveBlocksPerMultiprocessor(&per_cu, (const void*)fwd_kernel, 512, LDS_BYTES) != hipSuccess || per_cu < 1) { fprintf(stderr, "kernel_launch: occupancy query failed (%d)\n", per_cu); grid = -1; return; }
        grid = cus * per_cu;
    }
    if (grid < 0) return;
    Args a{};
    for (int i = 0; i < 21; ++i) a.in[i] = (const float*)d_in[i];
    a.out = (float*)d_out; a.ws = (unsigned char*)d_ws;
#if MK_MULTI
    for (int p = 0; p < NPHASE; ++p) { a.ph_lo = p; a.ph_hi = p + 1; hipLaunchKernelGGL(fwd_kernel, dim3(grid), dim3(512), LDS_BYTES, stream, a); }
#else
    a.ph_lo = 0; a.ph_hi = NPHASE;
    if (hipMemsetAsync((char*)d_ws + WS_BAR, 0, 4096 * 4, stream) != hipSuccess) { fprintf(stderr, "kernel_launch: memset failed\n"); return; }
    void* args[] = {&a};
    hipError_t e = hipLaunchCooperativeKernel((void*)fwd_kernel, dim3(grid), dim3(512), args, LDS_BYTES, stream);
    if (e != hipSuccess) fprintf(stderr, "cooperative launch failed: %s (grid %d)\n", hipGetErrorString(e), grid);
#endif
}
```

```cpp
#include <hip/hip_runtime.h>
#include <hip/hip_cooperative_groups.h>
#include <cstdio>
#include <cstdint>
namespace pg8 {
#define PG8_LAS __attribute__((address_space(3)))
typedef unsigned short bf16_t;
typedef short bf16x8 __attribute__((ext_vector_type(8)));
typedef float f32x4 __attribute__((ext_vector_type(4)));
typedef unsigned u32x4 __attribute__((ext_vector_type(4)));
constexpr int BM = 256, BK = 64, HALF = 128, HTB = HALF * BK * 2  , STAGE_BYTES = 8 * HTB, NXCD = 8, WGM = 4;

__host__ __device__ __forceinline__ int lds_byte(int r, int c) { const int st = (r >> 4) * 2 + (c >> 5), rr = r & 15, cc = c & 31, ob = rr * 64 + cc * 2; return st * 1024 + (ob ^ (((ob >> 9) & 1) << 5)); }
__host__ __device__ __forceinline__ void stage_rc(int b, int& R, int& C) { const int st = b / 1024, sb = b % 1024, swz = sb ^ (((sb >> 9) & 1) << 5); R = (st >> 1) * 16 + swz / 64; C = (st & 1) * 32 + (swz % 64) / 2; }
__host__ __device__ __forceinline__ int perm32(int rho) { const int n = rho >> 4, i = rho & 15; return 8 * (i >> 2) + 4 * n + (i & 3); }

struct Unit { int pm, pn; };
struct Gemm { const bf16_t* A; const bf16_t* Bt; int M, N, K; };

struct StaticOrder {
    int nM, nN, nwg, G, c;
    __host__ __device__ void init(int M, int N, int G_, int c_) { nM = M / BM; nN = N / BM; nwg = nM * nN; G = G_; c = c_; }
    __host__ __device__ bool next(int i, Unit& u) const {
        const long L = (long)i * G + c; if (L >= nwg) return false;
        int wgid = (int)L; { const int q = nwg / NXCD, r = nwg % NXCD, xcd = wgid % NXCD, off = wgid / NXCD; wgid = (xcd < r ? xcd * (q + 1) : r * (q + 1) + (xcd - r) * q) + off; }
        const int nig = WGM * nN, gid = wgid / nig, fm = gid * WGM, gsz = (nM - fm) < WGM ? (nM - fm) : WGM;
        u.pm = fm + ((wgid % nig) % gsz); u.pn = (wgid % nig) / gsz; return true;
    }
    __device__ __forceinline__ void a_ready(const Unit&) const {}
    __device__ __forceinline__ void done(const Unit&) const {}
};
typedef float f32x2 __attribute__((ext_vector_type(2)));
template <class Epi, class Sched, bool ALIGN_EPI = false, bool SP2 = false>
__device__ __forceinline__ void gemm_phase(PG8_LAS unsigned char* lds, const Gemm g, const Sched& S, const Epi& E) {
    const int tid = threadIdx.x, wid = __builtin_amdgcn_readfirstlane(tid >> 6), lane = tid & 63, wr = wid >> 2, wc = wid & 3, fr = lane & 15, fq = lane >> 4;
    const int K = g.K, nt = K / BK;
    unsigned voffA[2], voffB[2];
#pragma unroll
    for (int i = 0; i < 2; ++i) { int R, C; stage_rc(tid * 16 + i * 8192, R, C); const int Rb = Epi::PERM ? ((R & ~31) + perm32(R & 31)) : R;
        voffA[i] = (unsigned)(R * K + C) * 2u; voffB[i] = (unsigned)(Rb * K + C) * 2u; }
    const size_t kstep = (size_t)(BK * 2);
    const size_t hstep = (size_t)HALF * K * 2;
    const size_t tstep = 2 * hstep;
    const unsigned ldsw = (unsigned)wid * 1024u;
    const int aoff = lds_byte(wr * 64 + fr, fq * 8), boff = lds_byte(wc * 32 + fr, fq * 8);
#define PG8_SA(b, h) (((b) * 2 + (h)) * HTB)
#define PG8_SB(b, h) ((4 + (b) * 2 + (h)) * HTB)
#define PG8_STAGE(bufoff, gbase, voff) do { _Pragma("unroll") for (int _i = 0; _i < 2; ++_i) \
        __builtin_amdgcn_global_load_lds((const unsigned*)((const char*)(gbase) + (voff)[_i]), (PG8_LAS unsigned*)(lds + (bufoff) + ldsw + _i * 8192), 16, 0, 0); } while (0)
#define PG8_LDA(dst, b, h) do { _Pragma("unroll") for (int m = 0; m < 4; ++m) _Pragma("unroll") for (int k = 0; k < 2; ++k) dst[m][k] = *(const PG8_LAS bf16x8*)(lds + PG8_SA(b, h) + aoff + m * 2048 + k * 1024); } while (0)
#define PG8_LDB(dst, b, h) do { _Pragma("unroll") for (int n = 0; n < 2; ++n) _Pragma("unroll") for (int k = 0; k < 2; ++k) dst[n][k] = *(const PG8_LAS bf16x8*)(lds + PG8_SB(b, h) + boff + n * 2048 + k * 1024); } while (0)
#define PG8_MMA(ai, bj, At, Bt) do { __builtin_amdgcn_s_setprio(1); _Pragma("unroll") for (int m = 0; m < 4; ++m) _Pragma("unroll") for (int n = 0; n < 2; ++n) _Pragma("unroll") for (int k = 0; k < 2; ++k) \
        acc[ai][bj][m][n] = __builtin_amdgcn_mfma_f32_16x16x32_bf16(Bt[n][k], At[m][k], acc[ai][bj][m][n], 0, 0, 0); __builtin_amdgcn_s_setprio(0); } while (0)
#define PG8_WAIT_V(n) asm volatile("s_waitcnt vmcnt(" #n ")" ::: "memory")
#define PG8_WAIT_L(n) asm volatile("s_waitcnt lgkmcnt(" #n ")" ::: "memory")
#define PG8_BAR __builtin_amdgcn_s_barrier()
#define PG8_SCHED __builtin_amdgcn_sched_barrier(0)
    Unit cur, nxt; int ui = 0;
    if (!S.next(0, cur)) return;
    f32x4 acc[2][2][4][2];
#pragma unroll
    for (int a = 0; a < 2; ++a)
#pragma unroll
        for (int b = 0; b < 2; ++b)
#pragma unroll
            for (int m = 0; m < 4; ++m)
#pragma unroll
                for (int n = 0; n < 2; ++n) acc[a][b][m][n] = (f32x4){0.f, 0.f, 0.f, 0.f};
    bf16x8 At[4][2], B0[2][2], B1[2][2];
    const char* cA = (const char*)g.A + (size_t)cur.pm * tstep; const char* cB = (const char*)g.Bt + (size_t)cur.pn * tstep;
    S.a_ready(cur);
    if constexpr (SP2) {
        PG8_STAGE(PG8_SB(0, 0), cB, voffB); PG8_STAGE(PG8_SB(0, 1), cB + hstep, voffB); PG8_STAGE(PG8_SA(0, 0), cA, voffA); PG8_STAGE(PG8_SA(0, 1), cA + hstep, voffA);
        if (wr == 1) PG8_BAR;
        PG8_WAIT_V(2); PG8_BAR;
        PG8_STAGE(PG8_SB(1, 0), cB + kstep, voffB); PG8_STAGE(PG8_SA(1, 0), cA + kstep, voffA); PG8_STAGE(PG8_SB(1, 1), cB + hstep + kstep, voffB);
        PG8_WAIT_V(6); PG8_BAR;
    } else {
        PG8_STAGE(PG8_SB(0, 0), cB, voffB); PG8_STAGE(PG8_SA(0, 0), cA, voffA); PG8_STAGE(PG8_SB(0, 1), cB + hstep, voffB); PG8_STAGE(PG8_SA(0, 1), cA + hstep, voffA);
        if (wr == 1) PG8_BAR;
        PG8_WAIT_V(4); PG8_BAR;
        PG8_STAGE(PG8_SB(1, 0), cB + kstep, voffB); PG8_STAGE(PG8_SA(1, 0), cA + kstep, voffA); PG8_STAGE(PG8_SB(1, 1), cB + hstep + kstep, voffB);
        PG8_WAIT_V(6); PG8_BAR;
    }
    for (;;) {
        const bool has_next = S.next(ui + 1, nxt);
        const char* nA = has_next ? (const char*)g.A + (size_t)nxt.pm * tstep : cA; const char* nB = has_next ? (const char*)g.Bt + (size_t)nxt.pn * tstep : cB;
        for (int t = 0; t < nt; t += 2) {
            const bool last = (t == nt - 2);
            const char* a1 = cA + (size_t)(t + 1) * kstep;
            const char* a2 = last ? nA : cA + (size_t)(t + 2) * kstep; const char* b2 = last ? nB : cB + (size_t)(t + 2) * kstep;
            const char* a3 = a2 + kstep; const char* b3 = b2 + kstep;
            if (last && has_next) S.a_ready(nxt);
            if constexpr (SP2) {
            PG8_LDB(B0, 0, 0); PG8_LDB(B1, 0, 1); PG8_SCHED; PG8_LDA(At, 0, 0); PG8_STAGE(PG8_SA(1, 1), a1 + hstep, voffA);
            PG8_WAIT_V(8); PG8_WAIT_L(0); PG8_BAR; PG8_MMA(0, 0, At, B0); PG8_MMA(0, 1, At, B1); PG8_BAR; PG8_SCHED;
            PG8_LDA(At, 0, 1); PG8_STAGE(PG8_SB(0, 0), b2, voffB); PG8_STAGE(PG8_SB(0, 1), b2 + hstep, voffB); PG8_STAGE(PG8_SA(0, 0), a2, voffA);
            PG8_WAIT_V(8); PG8_WAIT_L(0); PG8_BAR; PG8_MMA(1, 0, At, B0); PG8_MMA(1, 1, At, B1); PG8_BAR; PG8_SCHED;
            PG8_LDB(B0, 1, 0); PG8_LDB(B1, 1, 1); PG8_SCHED; PG8_LDA(At, 1, 0); PG8_STAGE(PG8_SA(0, 1), a2 + hstep, voffA);
            PG8_WAIT_V(8); PG8_WAIT_L(0); PG8_BAR; PG8_MMA(0, 0, At, B0); PG8_MMA(0, 1, At, B1); PG8_BAR; PG8_SCHED;
            PG8_LDA(At, 1, 1); PG8_STAGE(PG8_SB(1, 0), b3, voffB); PG8_STAGE(PG8_SB(1, 1), b3 + hstep, voffB); PG8_STAGE(PG8_SA(1, 0), a3, voffA);
            PG8_WAIT_V(8); PG8_WAIT_L(0); PG8_BAR; PG8_MMA(1, 0, At, B0); PG8_MMA(1, 1, At, B1); PG8_BAR; PG8_SCHED;
            } else {
            PG8_LDB(B0, 0, 0); PG8_SCHED; PG8_LDA(At, 0, 0); PG8_STAGE(PG8_SA(1, 1), a1 + hstep, voffA);
            PG8_WAIT_L(8); PG8_BAR; PG8_WAIT_L(0); PG8_MMA(0, 0, At, B0); PG8_BAR; PG8_SCHED;
            PG8_LDB(B1, 0, 1); PG8_STAGE(PG8_SB(0, 0), b2, voffB);
            PG8_BAR; PG8_WAIT_L(0); PG8_MMA(0, 1, At, B1); PG8_BAR;
            PG8_LDA(At, 0, 1); PG8_STAGE(PG8_SA(0, 0), a2, voffA);
            PG8_BAR; PG8_WAIT_L(0); PG8_MMA(1, 0, At, B0); PG8_BAR; PG8_SCHED;
            PG8_STAGE(PG8_SB(0, 1), b2 + hstep, voffB);
            PG8_WAIT_V(6); PG8_BAR; PG8_MMA(1, 1, At, B1); PG8_BAR;
            PG8_LDB(B0, 1, 0); PG8_SCHED; PG8_LDA(At, 1, 0); PG8_STAGE(PG8_SA(0, 1), a2 + hstep, voffA);
            PG8_WAIT_L(8); PG8_BAR; PG8_WAIT_L(0); PG8_MMA(0, 0, At, B0); PG8_BAR; PG8_SCHED;
            PG8_LDB(B1, 1, 1); PG8_STAGE(PG8_SB(1, 0), b3, voffB);
            PG8_BAR; PG8_WAIT_L(0); PG8_MMA(0, 1, At, B1); PG8_BAR;
            PG8_LDA(At, 1, 1); PG8_STAGE(PG8_SA(1, 0), a3, voffA);
            PG8_BAR; PG8_WAIT_L(0); PG8_MMA(1, 0, At, B0); PG8_BAR; PG8_SCHED;
            PG8_STAGE(PG8_SB(1, 1), b3 + hstep, voffB);
            PG8_WAIT_V(6); PG8_BAR; PG8_MMA(1, 1, At, B1); PG8_BAR;
            }
        }
        if constexpr (ALIGN_EPI) { if (wr == 0) PG8_BAR; }
        if constexpr (!Epi::AFTER_DRAIN) { E(acc, cur, wr, wc, fr, fq); S.done(cur); }
        if (!has_next) break;
#pragma unroll
        for (int a = 0; a < 2; ++a)
#pragma unroll
            for (int b = 0; b < 2; ++b)
#pragma unroll
                for (int m = 0; m < 4; ++m)
#pragma unroll
                    for (int n = 0; n < 2; ++n) acc[a][b][m][n] = (f32x4){0.f, 0.f, 0.f, 0.f};
        cur = nxt; cA = nA; cB = nB; ++ui;
        if constexpr (ALIGN_EPI) { if (wr == 1) PG8_BAR; }
    }
    PG8_WAIT_V(0);
    if constexpr (!ALIGN_EPI) { if (wr == 0) PG8_BAR; }
    PG8_BAR;
    if constexpr (Epi::AFTER_DRAIN) { E.fused(acc, cur, wr, wc, fr, fq, lds, wid, lane); S.done(cur); }
#undef PG8_SA
#undef PG8_SB
#undef PG8_STAGE
#undef PG8_LDA
#undef PG8_LDB
#undef PG8_MMA
#undef PG8_WAIT_V
#undef PG8_WAIT_L
#undef PG8_BAR
#undef PG8_SCHED
}
}

namespace cg = cooperative_groups;
using pg8::bf16_t; using pg8::bf16x8; using pg8::f32x4; using pg8::u32x4; using pg8::Unit;
typedef float f32x2c __attribute__((ext_vector_type(2)));
typedef __bf16 bf16x2c __attribute__((ext_vector_type(2)));
__device__ __forceinline__ unsigned cvt_pk_bf16(float lo, float hi) { const f32x2c v = {lo, hi}; return __builtin_bit_cast(unsigned, __builtin_convertvector(v, bf16x2c)); }
#define LAS __attribute__((address_space(3)))
typedef unsigned u32x2 __attribute__((ext_vector_type(2)));
typedef float f32x2v __attribute__((ext_vector_type(2)));

constexpr int M_TOK = 8192, DM = 2048, FF = 5632, HW = 1024, CW = 1024, MIXIN = 7168, PLE = 256, SEQ = 2048;
constexpr float EPS = 1e-6f;
constexpr size_t MiB = 1ull << 20;
constexpr size_t WS_W1GU = 0, WS_W1D = 44 * MiB, WS_WIN = 66 * MiB, WS_WOUT = 94 * MiB, WS_W2GU = 102 * MiB, WS_W2D = 146 * MiB,
                 WS_WPG = 168 * MiB, WS_WPE = 176 * MiB, WS_PB = 177 * MiB, WS_XB = 181 * MiB, WS_MIX = 213 * MiB, WS_G = 245 * MiB,
                 WS_QS = 245 * MiB, WS_VH = 261 * MiB, WS_GH = 277 * MiB, WS_BC = 293 * MiB, WS_UC = 309 * MiB, WS_LF = 325 * MiB,
                 WS_S = 357 * MiB, WS_PLE = 0, WS_SS = 389 * MiB, WS_DD = 389 * MiB + 512 * 1024, WS_BAR = 390 * MiB + 512 * 1024, WS_END = 391 * MiB, WS_U = 0;
constexpr int LDS_BYTES = 150 * 1024;
constexpr int NPHASE = 12;

__device__ __forceinline__ float bf2f(bf16_t b) { return __uint_as_float(((unsigned)b) << 16); }
__device__ __forceinline__ float bflo(unsigned w) { return __uint_as_float(w << 16); }
__device__ __forceinline__ float bfhi(unsigned w) { return __uint_as_float(w & 0xffff0000u); }
__device__ __forceinline__ float wave_sum(float v) {
#pragma unroll
    for (int o = 1; o < 64; o <<= 1) v += __shfl_xor(v, o);
    return v;
}
__device__ __forceinline__ float row16_sum(float x) {
    x += __builtin_bit_cast(float, __builtin_amdgcn_update_dpp(0, __builtin_bit_cast(int, x), 0xB1, 0xF, 0xF, true));
    x += __builtin_bit_cast(float, __builtin_amdgcn_update_dpp(0, __builtin_bit_cast(int, x), 0x4E, 0xF, 0xF, true));
    x += __builtin_bit_cast(float, __builtin_amdgcn_update_dpp(0, __builtin_bit_cast(int, x), 0x141, 0xF, 0xF, true));
    x += __builtin_bit_cast(float, __builtin_amdgcn_update_dpp(0, __builtin_bit_cast(int, x), 0x140, 0xF, 0xF, true));
    return x;
}
__device__ __forceinline__ float fsigmoid(float x) { return __builtin_amdgcn_rcpf(1.0f + __expf(-x)); }
__device__ __forceinline__ float fsilu(float x) { return x * fsigmoid(x); }
__device__ __forceinline__ float rinv_of(float ss) { return rsqrtf(ss * (1.0f / DM) + EPS); }

struct EpiGateUp {
    static constexpr bool PERM = true, AFTER_DRAIN = false;
    bf16_t* G; const float* ss;
    __device__ __forceinline__ void operator()(const f32x4 (&acc)[2][2][4][2], const Unit& u, int wr, int wc, int fr, int fq) const {
        const int row0 = u.pm * 256 + wr * 64 + fr, col0 = u.pn * 128 + wc * 32 + 8 * fq;
#pragma unroll
        for (int ai = 0; ai < 2; ++ai)
#pragma unroll
            for (int m = 0; m < 4; ++m) {
                const int r = row0 + ai * 128 + m * 16; const float ri = rinv_of(ss[r]);
                float v[8];
#pragma unroll
                for (int n = 0; n < 2; ++n)
#pragma unroll
                    for (int j = 0; j < 4; ++j) v[n * 4 + j] = fsilu(acc[ai][0][m][n][j] * ri) * (acc[ai][1][m][n][j] * ri);
                u32x4 w; w.x = cvt_pk_bf16(v[0], v[1]); w.y = cvt_pk_bf16(v[2], v[3]); w.z = cvt_pk_bf16(v[4], v[5]); w.w = cvt_pk_bf16(v[6], v[7]);
                *(u32x4*)(G + (size_t)r * FF + col0) = w;
            }
    }
};
struct EpiResid {
    static constexpr bool PERM = true, AFTER_DRAIN = false;
    bf16_t* XB; float* ss_out; float scale;
    __device__ __forceinline__ void operator()(f32x4 (&acc)[2][2][4][2], const Unit& u, int wr, int wc, int fr, int fq) const {
        const int row0 = u.pm * 256 + wr * 64 + fr, col0 = u.pn * 256 + wc * 32 + 8 * fq;
#pragma unroll
        for (int ai = 0; ai < 2; ++ai) {
#pragma unroll
            for (int m = 0; m < 4; ++m)
#pragma unroll
                for (int bj = 0; bj < 2; ++bj) {
                    const size_t off = (size_t)(row0 + ai * 128 + m * 16) * DM + col0 + bj * 128;
                    const u32x4 xw = *(const u32x4*)(XB + off);
                    f32x4 r0, r1; r0[0] = bflo(xw.x); r0[1] = bfhi(xw.x); r0[2] = bflo(xw.y); r0[3] = bfhi(xw.y); r1[0] = bflo(xw.z); r1[1] = bfhi(xw.z); r1[2] = bflo(xw.w); r1[3] = bfhi(xw.w);
                    acc[ai][bj][m][0] = r0 + acc[ai][bj][m][0] * scale; acc[ai][bj][m][1] = r1 + acc[ai][bj][m][1] * scale;
                }
            asm volatile("" ::: "memory");
#pragma unroll
            for (int m = 0; m < 4; ++m) {
                const int r = row0 + ai * 128 + m * 16; float sq = 0.f;
#pragma unroll
                for (int bj = 0; bj < 2; ++bj) {
                    const size_t off = (size_t)r * DM + col0 + bj * 128;
                    const f32x4 v0 = acc[ai][bj][m][0], v1 = acc[ai][bj][m][1];
                    u32x4 w; w.x = cvt_pk_bf16(v0[0], v0[1]); w.y = cvt_pk_bf16(v0[2], v0[3]); w.z = cvt_pk_bf16(v1[0], v1[1]); w.w = cvt_pk_bf16(v1[2], v1[3]);
                    *(u32x4*)(XB + off) = w;
                    sq += (v0[0] * v0[0] + v0[1] * v0[1]) + (v0[2] * v0[2] + v0[3] * v0[3]) + (v1[0] * v1[0] + v1[1] * v1[1]) + (v1[2] * v1[2] + v1[3] * v1[3]);
                }
                sq += __shfl_xor(sq, 16); sq += __shfl_xor(sq, 32);
                if (fq == 0) atomicAdd(ss_out + r, sq);
            }
            asm volatile("" ::: "memory");
        }
    }
};
struct EpiMixIn {
    static constexpr bool PERM = true, AFTER_DRAIN = false;
    const float* ss; const float* lbl;
    bf16_t *QS, *UC; float* LF;
    __device__ __forceinline__ void operator()(const f32x4 (&acc)[2][2][4][2], const Unit& u, int wr, int wc, int fr, int fq) const {
        const int row0 = u.pm * 256 + wr * 64 + fr; const int sec = u.pn >> 2;
        if (u.pn >= 20) {
            const int col0 = (u.pn - 20) * 128 + wc * 32 + 8 * fq;
#pragma unroll
            for (int ai = 0; ai < 2; ++ai)
#pragma unroll
                for (int m = 0; m < 4; ++m) {
                    const int r = row0 + ai * 128 + m * 16; const float ri = rinv_of(ss[r]); const float ri2 = ri * ri;
                    float v[8];
#pragma unroll
                    for (int n = 0; n < 2; ++n)
#pragma unroll
                        for (int j = 0; j < 4; ++j) v[n * 4 + j] = acc[ai][0][m][n][j] * acc[ai][1][m][n][j] * ri2;
                    u32x4 w; w.x = cvt_pk_bf16(v[0], v[1]); w.y = cvt_pk_bf16(v[2], v[3]); w.z = cvt_pk_bf16(v[4], v[5]); w.w = cvt_pk_bf16(v[6], v[7]);
                    *(u32x4*)(UC + (size_t)r * CW + col0) = w;
                }
            return;
        }
        const int col0 = (u.pn & 3) * 256 + wc * 32 + 8 * fq;
        if (sec == 1) {
#pragma unroll
            for (int bj = 0; bj < 2; ++bj)
#pragma unroll
                for (int n = 0; n < 2; ++n) {
                    const int c = col0 + bj * 128 + 4 * n; const f32x4 l0 = *(const f32x4*)(lbl + c), l1 = *(const f32x4*)(lbl + 1024 + c);
                    f32x4 lb; lb[0] = fsigmoid(l0[0] - l1[0]); lb[1] = fsigmoid(l0[1] - l1[1]); lb[2] = fsigmoid(l0[2] - l1[2]); lb[3] = fsigmoid(l0[3] - l1[3]);
#pragma unroll
                    for (int ai = 0; ai < 2; ++ai)
#pragma unroll
                        for (int m = 0; m < 4; ++m) {
                            const int r = row0 + ai * 128 + m * 16; const float ri = rinv_of(ss[r]);
                            const f32x4 x = acc[ai][bj][m][n]; f32x4 o;
                            o[0] = __logf(lb[0] + (1.0f - lb[0]) * fsigmoid(x[0] * ri)); o[1] = __logf(lb[1] + (1.0f - lb[1]) * fsigmoid(x[1] * ri));
                            o[2] = __logf(lb[2] + (1.0f - lb[2]) * fsigmoid(x[2] * ri)); o[3] = __logf(lb[3] + (1.0f - lb[3]) * fsigmoid(x[3] * ri));
                            *(f32x4*)(LF + (size_t)r * HW + c) = o;
                        }
                }
            return;
        }
        bf16_t* dst = QS + (size_t)(sec == 0 ? 0 : sec - 1) * ((size_t)M_TOK * HW);
        const bool act = (sec == 0 || sec == 3);
#pragma unroll
        for (int ai = 0; ai < 2; ++ai)
#pragma unroll
            for (int m = 0; m < 4; ++m) {
                const int r = row0 + ai * 128 + m * 16; const float ri = rinv_of(ss[r]);
#pragma unroll
                for (int bj = 0; bj < 2; ++bj) {
                    float v[8];
#pragma unroll
                    for (int n = 0; n < 2; ++n)
#pragma unroll
                        for (int j = 0; j < 4; ++j) { const float x = acc[ai][bj][m][n][j] * ri; v[n * 4 + j] = act ? fsilu(x) : x; }
                    u32x4 w; w.x = cvt_pk_bf16(v[0], v[1]); w.y = cvt_pk_bf16(v[2], v[3]); w.z = cvt_pk_bf16(v[4], v[5]); w.w = cvt_pk_bf16(v[6], v[7]);
                    *(u32x4*)(dst + (size_t)r * HW + col0 + bj * 128) = w;
                }
            }
    }
};
struct EpiStoreBf16 {
    static constexpr bool PERM = true, AFTER_DRAIN = false;
    bf16_t* O;
    __device__ __forceinline__ void operator()(const f32x4 (&acc)[2][2][4][2], const Unit& u, int wr, int wc, int fr, int fq) const {
        const int row0 = u.pm * 256 + wr * 64 + fr, col0 = u.pn * 256 + wc * 32 + 8 * fq;
#pragma unroll
        for (int ai = 0; ai < 2; ++ai)
#pragma unroll
            for (int m = 0; m < 4; ++m) {
                const int r = row0 + ai * 128 + m * 16;
#pragma unroll
                for (int bj = 0; bj < 2; ++bj) {
                    const f32x4 v0 = acc[ai][bj][m][0], v1 = acc[ai][bj][m][1];
                    u32x4 w; w.x = cvt_pk_bf16(v0[0], v0[1]); w.y = cvt_pk_bf16(v0[2], v0[3]); w.z = cvt_pk_bf16(v1[0], v1[1]); w.w = cvt_pk_bf16(v1[2], v1[3]);
                    *(u32x4*)(O + (size_t)r * DM + col0 + bj * 128) = w;
                }
            }
    }
};
struct EpiPleGate {
    static constexpr bool PERM = true, AFTER_DRAIN = false;
    const bf16_t* XB; const bf16_t* P; bf16_t* H4; const float* ss;
    __device__ __forceinline__ void operator()(f32x4 (&acc)[2][2][4][2], const Unit& u, int wr, int wc, int fr, int fq) const {
        const int row0 = u.pm * 256 + wr * 64 + fr, col0 = u.pn * 256 + wc * 32 + 8 * fq;
#pragma unroll
        for (int ai = 0; ai < 2; ++ai)
#pragma unroll
            for (int m = 0; m < 4; ++m) {
                const int r = row0 + ai * 128 + m * 16; const float ri = rinv_of(ss[r]);
#pragma unroll
                for (int bj = 0; bj < 2; ++bj) {
                    const size_t off = (size_t)r * DM + col0 + bj * 128;
                    const u32x4 pw = *(const u32x4*)(P + off), xw = *(const u32x4*)(XB + off);
                    const f32x4 a0 = acc[ai][bj][m][0], a1 = acc[ai][bj][m][1];
                    u32x4 w;
                    w.x = cvt_pk_bf16(bflo(xw.x) + fsigmoid(a0[0] * ri) * bflo(pw.x), bfhi(xw.x) + fsigmoid(a0[1] * ri) * bfhi(pw.x));
                    w.y = cvt_pk_bf16(bflo(xw.y) + fsigmoid(a0[2] * ri) * bflo(pw.y), bfhi(xw.y) + fsigmoid(a0[3] * ri) * bfhi(pw.y));
                    w.z = cvt_pk_bf16(bflo(xw.z) + fsigmoid(a1[0] * ri) * bflo(pw.z), bfhi(xw.z) + fsigmoid(a1[1] * ri) * bfhi(pw.z));
                    w.w = cvt_pk_bf16(bflo(xw.w) + fsigmoid(a1[2] * ri) * bflo(pw.w), bfhi(xw.w) + fsigmoid(a1[3] * ri) * bfhi(pw.w));
                    *(u32x4*)(H4 + off) = w;
                }
            }
    }
};

template <int MODE>
__device__ __forceinline__ void p0_item(const float* W, const float* W2, const float* gain, int K, int N, bf16_t* WT, LAS float* scr, int item, int lane) {
    const int nblk_k = K / 64; const int nb = item / nblk_k, kb = item % nblk_k; const int k0 = 64 * kb, n0 = 32 * nb;
    const float* src = W; int c0 = n0;
    if (MODE == 1) { const int t = n0 >> 8, bj = (n0 >> 7) & 1, c = n0 & 127; src = bj ? W2 : W; c0 = 128 * t + c; }
    if (MODE == 2) { if (n0 >= 5120) { const int tt = n0 - 5120; const int t = tt >> 8, bj = (tt >> 7) & 1, c = tt & 127; c0 = 5120 + 1024 * bj + 128 * t + c; } }
    float v[32], gg[32];
    const float* sp = src + (size_t)(k0 + (lane >> 5)) * N + c0 + (lane & 31);
#pragma unroll
    for (int i = 0; i < 32; ++i) v[i] = __builtin_nontemporal_load(sp + (size_t)(2 * i) * N);
    if (gain) {
#pragma unroll
        for (int i = 0; i < 32; ++i) gg[i] = gain[k0 + 2 * i + (lane >> 5)];
#pragma unroll
        for (int i = 0; i < 32; ++i) v[i] *= gg[i];
    }
#pragma unroll
    for (int i = 0; i < 32; ++i) scr[(2 * i + (lane >> 5)) * 33 + (lane & 31)] = v[i];
    asm volatile("s_waitcnt lgkmcnt(0)" ::: "memory");
    const int c = lane & 7;
#pragma unroll
    for (int j = 0; j < 4; ++j) { const int n = (lane >> 3) + 8 * j; const LAS float* s = scr + (8 * c) * 33 + n;
        u32x4 o; o.x = cvt_pk_bf16(s[0 * 33], s[1 * 33]); o.y = cvt_pk_bf16(s[2 * 33], s[3 * 33]); o.z = cvt_pk_bf16(s[4 * 33], s[5 * 33]); o.w = cvt_pk_bf16(s[6 * 33], s[7 * 33]);
        *(u32x4*)(WT + (size_t)(n0 + n) * K + k0 + 8 * c) = o; }
    asm volatile("s_waitcnt lgkmcnt(0)" ::: "memory");
}

struct Args { const float* in[21]; float* out; unsigned char* ws; int ph_lo, ph_hi; };

constexpr int CV_I0 = 32 * 352, CV_I1 = 88 * 64, CV_I2 = 32 * 224, CV_I3 = 32 * 64, CV_I7 = 4 * 64;
constexpr int CV_END = 2 * CV_I0 + 2 * CV_I1 + CV_I2 + 2 * CV_I3 + CV_I7, CV_T1 = CV_END - 10000, CV_T0 = CV_T1 - 10000, CV_TA = CV_I0 + CV_I2 + CV_I3 + CV_I7, CV_P0 = CV_I0 + CV_I7 + CV_I2 - 2000, CV_WO = CV_I0 + CV_I7 + CV_I2;
__device__ __forceinline__ void conv_range(const Args& a, LAS unsigned char* lds, int wave, int lane, int lo, int hi, int w0, int nw) {
    unsigned char* ws = a.ws;
    LAS float* scr = (LAS float*)(lds + wave * 16384);
    for (int it = lo + w0; it < hi; it += nw) {
        int r = it;
        if (r < CV_I0) { p0_item<1>(a.in[3], a.in[4], a.in[2], DM, FF, (bf16_t*)(ws + WS_W1GU), scr, r, lane); continue; } r -= CV_I0;
        if (r < CV_I7) { p0_item<0>(a.in[18], nullptr, nullptr, PLE, DM, (bf16_t*)(ws + WS_WPE), scr, r, lane); continue; } r -= CV_I7;
        if (r < CV_I2) { p0_item<2>(a.in[7], nullptr, a.in[6], DM, MIXIN, (bf16_t*)(ws + WS_WIN), scr, r, lane); continue; } r -= CV_I2;
        if (r < CV_I3) { p0_item<0>(a.in[12], nullptr, nullptr, DM, DM, (bf16_t*)(ws + WS_WOUT), scr, r, lane); continue; } r -= CV_I3;
        if (r < CV_I3) { p0_item<0>(a.in[19], nullptr, a.in[17], DM, DM, (bf16_t*)(ws + WS_WPG), scr, r, lane); continue; } r -= CV_I3;
        if (r < CV_I1) { p0_item<0>(a.in[16], nullptr, nullptr, FF, DM, (bf16_t*)(ws + WS_W2D), scr, r, lane); continue; } r -= CV_I1;
        if (r < CV_I0) { p0_item<1>(a.in[14], a.in[15], a.in[13], DM, FF, (bf16_t*)(ws + WS_W2GU), scr, r, lane); continue; } r -= CV_I0;
        p0_item<0>(a.in[5], nullptr, nullptr, FF, DM, (bf16_t*)(ws + WS_W1D), scr, r, lane);
    }
}
__device__ __forceinline__ void conv_tail(const Args& a, LAS unsigned char* lds, int wave, int lane, int nunits, int lo, int hi, int vc) {
    const int r = nunits % (int)gridDim.x;
    if (r == 0) { conv_range(a, lds, wave, lane, lo, hi, vc * 8 + wave, gridDim.x * 8); return; }
    if (vc >= r) conv_range(a, lds, wave, lane, lo, hi, (vc - r) * 8 + wave, ((int)gridDim.x - r) * 8);
}

__device__ __forceinline__ void phase0(const Args& a, LAS unsigned char* lds, int wave, int lane) {
    unsigned char* ws = a.ws;
    const int gw = blockIdx.x * 8 + wave, NGW = gridDim.x * 8;
    conv_range(a, lds, wave, lane, 0, CV_P0, gw, NGW);
    float* SS = (float*)(ws + WS_SS);
    for (int m = gw; m < M_TOK; m += NGW) {
        const f32x4* xr = (const f32x4*)(a.in[0] + (size_t)m * DM) + lane; u32x2* xb = (u32x2*)((bf16_t*)(ws + WS_XB) + (size_t)m * DM) + lane;
        float s = 0.f;
#pragma unroll
        for (int j = 0; j < 8; ++j) { const f32x4 v = __builtin_nontemporal_load(xr + 64 * j); s += (v[0] * v[0] + v[1] * v[1]) + (v[2] * v[2] + v[3] * v[3]);
            u32x2 w; w.x = cvt_pk_bf16(v[0], v[1]); w.y = cvt_pk_bf16(v[2], v[3]); xb[64 * j] = w; }
        s = wave_sum(s);
        if (lane == 0) { SS[m] = s; SS[8192 + m] = 0.f; SS[16384 + m] = 0.f; SS[24576 + m] = 0.f; }
    }
    { const int gt = blockIdx.x * 512 + threadIdx.x, NT = gridDim.x * 512;
      for (int i = gt; i < M_TOK * PLE / 4; i += NT) { const f32x4 v = __builtin_nontemporal_load((const f32x4*)a.in[1] + i); u32x2 w; w.x = cvt_pk_bf16(v[0], v[1]); w.y = cvt_pk_bf16(v[2], v[3]); ((u32x2*)(ws + WS_PB))[i] = w; } }
}

constexpr int HP = 136, VP = 72;
constexpr int L_QT = 0, L_QH = L_QT + 64 * HP * 2, L_KA = L_QH + 64 * HP * 2, L_KB = L_KA + 64 * HP * 2, L_ST = L_KB + 32 * HP * 2, L_VT = L_ST + 128 * HP * 2,
              L_P = L_VT + 128 * VP * 2, L_SEG = L_P + 64 * VP * 2, L_PART = L_SEG + 8 * 128 * 4, L_RINV = L_PART + 8 * 64 * 4, L_HEND = L_RINV + 256, L_KT = 0;
static_assert(L_HEND <= LDS_BYTES, "LDS");
#define MFMA16(a, b, c) __builtin_amdgcn_mfma_f32_16x16x32_bf16((a), (b), (c), 0, 0, 0)
__device__ __forceinline__ bf16_t f2bf(float x) { return (bf16_t)(cvt_pk_bf16(x, 0.f) & 0xffffu); }

#define LDSBAR() do { asm volatile("s_waitcnt lgkmcnt(0)" ::: "memory"); __builtin_amdgcn_s_barrier(); asm volatile("" ::: "memory"); } while (0)
__device__ __forceinline__ void hgrn_pass_a(const Args& a, LAS unsigned char* lds, int wave, int lane) {
    unsigned char* ws = a.ws;
    const float* LF = (const float*)(ws + WS_LF); const bf16_t* VH = (const bf16_t*)(ws + WS_VH); bf16_t* U = (bf16_t*)(ws + WS_U); float* Dd = (float*)(ws + WS_DD);
    const int tid = threadIdx.x, k = tid & 127, sg = tid >> 7, fr = lane & 15, fq = lane >> 4;
    LAS bf16_t* VT = (LAS bf16_t*)(lds + L_VT); LAS bf16_t* KT = (LAS bf16_t*)(lds + L_KT); LAS float* SEG = (LAS float*)(lds + L_SEG);
    float lf[16]; u32x4 vv[2];
#define PA_LOAD(it) do { const int r0_ = ((it) >> 3) * 64, c0_ = ((it) & 7) * 128; \
        _Pragma("unroll") for (int i = 0; i < 16; ++i) lf[i] = LF[(size_t)(r0_ + 16 * sg + i) * HW + c0_ + k]; \
        _Pragma("unroll") for (int j = 0; j < 2; ++j) { const int idx = tid + 512 * j; vv[j] = *(const u32x4*)(VH + (size_t)(r0_ + (idx >> 4)) * HW + c0_ + 8 * (idx & 15)); } } while (0)
    int item = blockIdx.x;
    if (item < 1024) PA_LOAD(item);
    for (; item < 1024; item += gridDim.x) {
        float b[16];
        float run = 0.f;
#pragma unroll
        for (int i = 0; i < 16; ++i) { run += lf[i]; b[i] = run; }
        SEG[sg * 128 + k] = run;
        LDSBAR();
        const float s0 = SEG[k], s1 = SEG[128 + k], s2 = SEG[256 + k], s3 = SEG[384 + k];
        const float pre = sg == 0 ? 0.f : (sg == 1 ? s0 : (sg == 2 ? s0 + s1 : s0 + s1 + s2));
        const float blast = s0 + s1 + s2 + s3;
        unsigned pk[8];
#pragma unroll
        for (int i = 0; i < 8; ++i) {
            const float e0 = (1.0f - __expf(lf[2 * i])) * __expf(blast - (pre + b[2 * i])), e1 = (1.0f - __expf(lf[2 * i + 1])) * __expf(blast - (pre + b[2 * i + 1]));
            pk[i] = cvt_pk_bf16(e0, e1); }
        { u32x4 w0, w1; w0.x = pk[0]; w0.y = pk[1]; w0.z = pk[2]; w0.w = pk[3]; w1.x = pk[4]; w1.y = pk[5]; w1.z = pk[6]; w1.w = pk[7];
          *(LAS u32x4*)(KT + k * VP + 16 * sg) = w0; *(LAS u32x4*)(KT + k * VP + 16 * sg + 8) = w1; }
#pragma unroll
        for (int j = 0; j < 2; ++j) { const int idx = tid + 512 * j, s = (idx >> 4) ^ ((((idx & 15) >> 1) & 7) << 3), v0 = 8 * (idx & 15);
            VT[(v0 + 0) * VP + s] = (bf16_t)(vv[j].x & 0xffffu); VT[(v0 + 1) * VP + s] = (bf16_t)(vv[j].x >> 16);
            VT[(v0 + 2) * VP + s] = (bf16_t)(vv[j].y & 0xffffu); VT[(v0 + 3) * VP + s] = (bf16_t)(vv[j].y >> 16);
            VT[(v0 + 4) * VP + s] = (bf16_t)(vv[j].z & 0xffffu); VT[(v0 + 5) * VP + s] = (bf16_t)(vv[j].z >> 16);
            VT[(v0 + 6) * VP + s] = (bf16_t)(vv[j].w & 0xffffu); VT[(v0 + 7) * VP + s] = (bf16_t)(vv[j].w >> 16); }
        if (sg == 0) Dd[item * 128 + k] = __expf(blast);
        if (item + (int)gridDim.x < 1024) PA_LOAD(item + (int)gridDim.x);
        LDSBAR();
        const bf16x8 a0 = *(const LAS bf16x8*)(VT + (16 * wave + fr) * VP + ((fq * 8) ^ (wave << 3))), a1 = *(const LAS bf16x8*)(VT + (16 * wave + fr) * VP + ((32 + fq * 8) ^ (wave << 3)));
        bf16_t* up = U + (size_t)item * 16384 + (16 * wave + fr) * 128 + 4 * fq;
#pragma unroll
        for (int kt = 0; kt < 8; ++kt) {
            const bf16x8 b0 = *(const LAS bf16x8*)(KT + (16 * kt + fr) * VP + fq * 8), b1 = *(const LAS bf16x8*)(KT + (16 * kt + fr) * VP + 32 + fq * 8);
            f32x4 acc = {0.f, 0.f, 0.f, 0.f};
            acc = MFMA16(b0, a0, acc); acc = MFMA16(b1, a1, acc);
            u32x2 w; w.x = cvt_pk_bf16(acc[0], acc[1]); w.y = cvt_pk_bf16(acc[2], acc[3]);
            *(u32x2*)(up + 16 * kt) = w;
        }
        LDSBAR();
    }
#undef PA_LOAD
}

__device__ __forceinline__ void hgrn_scan(const Args& a) {
    unsigned char* ws = a.ws;
    const bf16_t* U = (const bf16_t*)(ws + WS_U); const float* Dd = (const float*)(ws + WS_DD); bf16_t* SP = (bf16_t*)(ws + WS_S);
    for (int e = (blockIdx.x * 512 + threadIdx.x) * 4; e < 32 * 16384; e += gridDim.x * 512 * 4) {
        const int bh = e >> 14, vk = e & 16383, bb = bh >> 3, h = bh & 7;
        f32x4 S = {0.f, 0.f, 0.f, 0.f};
#pragma unroll 8
        for (int ci = 0; ci < 32; ++ci) {
            const size_t item = (size_t)((bb * 32 + ci) * 8 + h);
            const u32x2 uw = *(const u32x2*)(U + item * 16384 + vk); f32x4 u; u[0] = bflo(uw.x); u[1] = bfhi(uw.x); u[2] = bflo(uw.y); u[3] = bfhi(uw.y); const f32x4 d = *(const f32x4*)(Dd + item * 128 + (vk & 127));
            u32x2 w; w.x = cvt_pk_bf16(S[0], S[1]); w.y = cvt_pk_bf16(S[2], S[3]); *(u32x2*)(SP + item * 16384 + vk) = w;
            S = d * S + u;
        }
    }
}

__device__ __forceinline__ void conv_mixer(const Args& a, int wave, int lane) {
    unsigned char* ws = a.ws;
    const bf16_t* BC = (const bf16_t*)(ws + WS_BC); const bf16_t* UC = (const bf16_t*)(ws + WS_UC); bf16_t* MIX = (bf16_t*)(ws + WS_MIX);
    const float* cn = a.in[11]; const float* cw = a.in[8];
    const int gw = blockIdx.x * 8 + wave, NGW = gridDim.x * 8;
    for (int it = gw; it < M_TOK * 2; it += NGW) {
        const int row = it >> 1, c = (it & 1) * 512 + lane * 8, t = row & (SEQ - 1);
        const size_t off = (size_t)row * CW + c;
        const u32x4 z = {0u, 0u, 0u, 0u};
        const u32x4 u0 = *(const u32x4*)(UC + off), u1 = t >= 1 ? *(const u32x4*)(UC + off - CW) : z, u2 = t >= 2 ? *(const u32x4*)(UC + off - 2 * CW) : z, bg = *(const u32x4*)(BC + off);
        float y[8]; float ssq = 0.f;
#pragma unroll
        for (int q = 0; q < 4; ++q) {
            const unsigned a0 = u0[q], a1 = u1[q], a2 = u2[q], bb = bg[q]; const int cc = c + 2 * q;
            y[2 * q] = bflo(bb) * (cw[cc] * bflo(a2) + cw[CW + cc] * bflo(a1) + cw[2 * CW + cc] * bflo(a0));
            y[2 * q + 1] = bfhi(bb) * (cw[cc + 1] * bfhi(a2) + cw[CW + cc + 1] * bfhi(a1) + cw[2 * CW + cc + 1] * bfhi(a0));
            ssq += y[2 * q] * y[2 * q] + y[2 * q + 1] * y[2 * q + 1];
        }
        ssq = row16_sum(ssq);
        const float ri = rsqrtf(ssq * (1.0f / 128) + EPS);
        u32x4 w;
        w.x = cvt_pk_bf16(y[0] * ri * cn[c], y[1] * ri * cn[c + 1]); w.y = cvt_pk_bf16(y[2] * ri * cn[c + 2], y[3] * ri * cn[c + 3]);
        w.z = cvt_pk_bf16(y[4] * ri * cn[c + 4], y[5] * ri * cn[c + 5]); w.w = cvt_pk_bf16(y[6] * ri * cn[c + 6], y[7] * ri * cn[c + 7]);
        *(u32x4*)(MIX + (size_t)row * DM + HW + c) = w;
    }
}

__device__ __forceinline__ void hgrn_pass_c(const Args& a, LAS unsigned char* lds, int wave, int lane) {
    unsigned char* ws = a.ws;
    const float* LF = (const float*)(ws + WS_LF); const bf16_t* VH = (const bf16_t*)(ws + WS_VH); const bf16_t* QS = (const bf16_t*)(ws + WS_QS); const bf16_t* GH = (const bf16_t*)(ws + WS_GH);
    const bf16_t* SP = (const bf16_t*)(ws + WS_S); bf16_t* MIX = (bf16_t*)(ws + WS_MIX); const float* hn = a.in[10];
    const int tid = threadIdx.x, k = tid & 127, sg = tid >> 7, fr = lane & 15, fq = lane >> 4;
    LAS bf16_t* QT = (LAS bf16_t*)(lds + L_QT); LAS bf16_t* QH = (LAS bf16_t*)(lds + L_QH); LAS bf16_t* KA = (LAS bf16_t*)(lds + L_KA); LAS bf16_t* KB = (LAS bf16_t*)(lds + L_KB);
    LAS bf16_t* ST = (LAS bf16_t*)(lds + L_ST); LAS bf16_t* VT = (LAS bf16_t*)(lds + L_VT); LAS bf16_t* P = (LAS bf16_t*)(lds + L_P);
    LAS float* SEG = (LAS float*)(lds + L_SEG); LAS float* PART = (LAS float*)(lds + L_PART); LAS float* RINV = (LAS float*)(lds + L_RINV);
    const f32x4 hnv = *(const f32x4*)(hn + 16 * wave + 4 * fq);
    const int k0 = 2 * (tid & 63);
    f32x2v lf2[8]; unsigned q2[8]; u32x4 vv[2], sv[4];
#define PC_LOAD(it) do { const int r0_ = ((it) >> 3) * 64, c0_ = ((it) & 7) * 128; \
        _Pragma("unroll") for (int i = 0; i < 8; ++i) { lf2[i] = *(const f32x2v*)(LF + (size_t)(r0_ + 8 * wave + i) * HW + c0_ + k0); q2[i] = *(const unsigned*)(QS + (size_t)(r0_ + 8 * wave + i) * HW + c0_ + k0); } \
        _Pragma("unroll") for (int j = 0; j < 2; ++j) { const int idx = tid + 512 * j; vv[j] = *(const u32x4*)(VH + (size_t)(r0_ + (idx >> 4)) * HW + c0_ + 8 * (idx & 15)); } \
        _Pragma("unroll") for (int j = 0; j < 4; ++j) { const int idx = tid + 512 * j; sv[j] = *(const u32x4*)(SP + (size_t)(it) * 16384 + (idx >> 4) * 128 + 8 * (idx & 15)); } } while (0)
    int item = blockIdx.x;
    if (item < 1024) PC_LOAD(item);
    for (; item < 1024; item += gridDim.x) {
        const int row0 = (item >> 3) * 64, cb = (item & 7) * 128;
        f32x2v b2[8]; f32x2v run = {0.f, 0.f};
#pragma unroll
        for (int i = 0; i < 8; ++i) { run += lf2[i]; b2[i] = run; }
        *(LAS f32x2v*)(SEG + wave * 128 + k0) = run;
        LDSBAR();
        f32x2v pre = {0.f, 0.f}, beta1 = {0.f, 0.f};
#pragma unroll
        for (int j = 0; j < 8; ++j) { const f32x2v sj = *(const LAS f32x2v*)(SEG + j * 128 + k0); if (j < wave) pre += sj; if (j < 4) beta1 += sj; }
        if (wave < 4) {
#pragma unroll
            for (int i = 0; i < 8; ++i) {
                const int so = (8 * wave + i) * HP + k0; const f32x2v bi = pre + b2[i];
                const float kk0 = 1.0f - __expf(lf2[i][0]), kk1 = 1.0f - __expf(lf2[i][1]);
                const unsigned qw = cvt_pk_bf16(bflo(q2[i]) * __expf(bi[0]), bfhi(q2[i]) * __expf(bi[1]));
                *(LAS unsigned*)(QT + so) = qw; *(LAS unsigned*)(QH + so) = qw;
                *(LAS unsigned*)(KA + so) = cvt_pk_bf16(kk0 * __expf(fminf(-bi[0], 80.f)), kk1 * __expf(fminf(-bi[1], 80.f)));
                *(LAS unsigned*)(KB + so) = cvt_pk_bf16(kk0 * __expf(beta1[0] - bi[0]), kk1 * __expf(beta1[1] - bi[1]));
            }
        } else {
#pragma unroll
            for (int i = 0; i < 8; ++i) {
                const int so = (8 * wave + i) * HP + k0; const f32x2v bi = pre + b2[i];
                const float kk0 = 1.0f - __expf(lf2[i][0]), kk1 = 1.0f - __expf(lf2[i][1]);
                const float q0 = bflo(q2[i]), q1 = bfhi(q2[i]);
                *(LAS unsigned*)(QH + so) = cvt_pk_bf16(q0 * __expf(bi[0]), q1 * __expf(bi[1]));
                *(LAS unsigned*)(QT + so) = cvt_pk_bf16(q0 * __expf(bi[0] - beta1[0]), q1 * __expf(bi[1] - beta1[1]));
                *(LAS unsigned*)(KA + so) = cvt_pk_bf16(kk0 * __expf(fminf(beta1[0] - bi[0], 80.f)), kk1 * __expf(fminf(beta1[1] - bi[1], 80.f)));
            }
        }
#pragma unroll
        for (int j = 0; j < 2; ++j) { const int idx = tid + 512 * j, s = (idx >> 4) ^ ((((idx & 15) >> 1) & 7) << 3), v0 = 8 * (idx & 15);
            VT[(v0 + 0) * VP + s] = (bf16_t)(vv[j].x & 0xffffu); VT[(v0 + 1) * VP + s] = (bf16_t)(vv[j].x >> 16);
            VT[(v0 + 2) * VP + s] = (bf16_t)(vv[j].y & 0xffffu); VT[(v0 + 3) * VP + s] = (bf16_t)(vv[j].y >> 16);
            VT[(v0 + 4) * VP + s] = (bf16_t)(vv[j].z & 0xffffu); VT[(v0 + 5) * VP + s] = (bf16_t)(vv[j].z >> 16);
            VT[(v0 + 6) * VP + s] = (bf16_t)(vv[j].w & 0xffffu); VT[(v0 + 7) * VP + s] = (bf16_t)(vv[j].w >> 16); }
#pragma unroll
        for (int j = 0; j < 4; ++j) { const int idx = tid + 512 * j; *(LAS u32x4*)(ST + (idx >> 4) * HP + 8 * (idx & 15)) = sv[j]; }
        if (item + (int)gridDim.x < 1024) PC_LOAD(item + (int)gridDim.x);
        LDSBAR();
        u32x2 gh[4];
#pragma unroll
        for (int tt = 0; tt < 4; ++tt) gh[tt] = *(const u32x2*)(GH + (size_t)(row0 + 16 * tt + fr) * HW + cb + 16 * wave + 4 * fq);
#pragma unroll
        for (int pp = 0; pp < 2; ++pp) {
            const int p = wave + 8 * pp, tt = p >> 2, st = p & 3;
            f32x4 acc = {0.f, 0.f, 0.f, 0.f};
            if (st <= tt) {
                const LAS bf16_t* kb = (tt >= 2 && st < 2) ? KB : KA;
#pragma unroll
                for (int ks = 0; ks < 4; ++ks) { const bf16x8 af = *(const LAS bf16x8*)(QT + (16 * tt + fr) * HP + ks * 32 + fq * 8), bfr = *(const LAS bf16x8*)(kb + (16 * st + fr) * HP + ks * 32 + fq * 8);
                    acc = MFMA16(af, bfr, acc); }
            }
#pragma unroll
            for (int r = 0; r < 4; ++r) { const bool keep = (st < tt) || (st == tt && fr <= 4 * fq + r); P[(16 * tt + 4 * fq + r) * VP + 16 * st + fr] = f2bf(keep ? acc[r] : 0.f); }
        }
        LDSBAR();
        bf16x8 bs[4], bv[2];
#pragma unroll
        for (int ks = 0; ks < 4; ++ks) bs[ks] = *(const LAS bf16x8*)(ST + (16 * wave + fr) * HP + ks * 32 + fq * 8);
#pragma unroll
        for (int ks = 0; ks < 2; ++ks) bv[ks] = *(const LAS bf16x8*)(VT + (16 * wave + fr) * VP + ((ks * 32 + fq * 8) ^ (wave << 3)));
        f32x4 o[4];
#pragma unroll
        for (int tt = 0; tt < 4; ++tt) {
            f32x4 acc = {0.f, 0.f, 0.f, 0.f};
#pragma unroll
            for (int ks = 0; ks < 4; ++ks) { const bf16x8 af = *(const LAS bf16x8*)(QH + (16 * tt + fr) * HP + ks * 32 + fq * 8); acc = MFMA16(bs[ks], af, acc); }
            { const bf16x8 af = *(const LAS bf16x8*)(P + (16 * tt + fr) * VP + fq * 8); acc = MFMA16(bv[0], af, acc); }
            if (tt >= 2) { const bf16x8 af = *(const LAS bf16x8*)(P + (16 * tt + fr) * VP + 32 + fq * 8); acc = MFMA16(bv[1], af, acc); }
            o[tt] = acc;
        }
#pragma unroll
        for (int tt = 0; tt < 4; ++tt) { float x = (o[tt][0] * o[tt][0] + o[tt][1] * o[tt][1]) + (o[tt][2] * o[tt][2] + o[tt][3] * o[tt][3]);
            x += __shfl_xor(x, 16); x += __shfl_xor(x, 32);
            if (fq == 0) PART[wave * 64 + 16 * tt + fr] = x; }
        LDSBAR();
        if (tid < 64) { float s = 0.f;
#pragma unroll
            for (int w = 0; w < 8; ++w) s += PART[w * 64 + tid];
            RINV[tid] = rsqrtf(s * (1.0f / 128) + EPS); }
        LDSBAR();
#pragma unroll
        for (int tt = 0; tt < 4; ++tt) { const float ri = RINV[16 * tt + fr];
            u32x2 w; w.x = cvt_pk_bf16(o[tt][0] * ri * hnv[0] * bflo(gh[tt].x), o[tt][1] * ri * hnv[1] * bfhi(gh[tt].x));
            w.y = cvt_pk_bf16(o[tt][2] * ri * hnv[2] * bflo(gh[tt].y), o[tt][3] * ri * hnv[3] * bfhi(gh[tt].y));
            *(u32x2*)(MIX + (size_t)(row0 + 16 * tt + fr) * DM + cb + 16 * wave + 4 * fq) = w; }
        LDSBAR();
    }
#undef PC_LOAD
}

__device__ __forceinline__ void phase_final(const Args& a, int wave, int lane) {
    const int gw = blockIdx.x * 8 + wave, NGW = gridDim.x * 8; const float* gF = a.in[20]; const bf16_t* H4 = (const bf16_t*)(a.ws + WS_MIX);
    for (int m = gw; m < M_TOK; m += NGW) {
        const u32x4* hr = (const u32x4*)(H4 + (size_t)m * DM) + lane; u32x4 w[4]; float s = 0.f;
#pragma unroll
        for (int j = 0; j < 4; ++j) { w[j] = __builtin_nontemporal_load(hr + 64 * j);
            s += (bflo(w[j].x) * bflo(w[j].x) + bfhi(w[j].x) * bfhi(w[j].x)) + (bflo(w[j].y) * bflo(w[j].y) + bfhi(w[j].y) * bfhi(w[j].y))
               + (bflo(w[j].z) * bflo(w[j].z) + bfhi(w[j].z) * bfhi(w[j].z)) + (bflo(w[j].w) * bflo(w[j].w) + bfhi(w[j].w) * bfhi(w[j].w)); }
        const float ri = rinv_of(wave_sum(s));
        f32x4* orow = (f32x4*)(a.out + (size_t)m * DM);
#pragma unroll
        for (int j = 0; j < 4; ++j) { const int c = (64 * j + lane) * 8; const f32x4 g0 = *(const f32x4*)(gF + c), g1 = *(const f32x4*)(gF + c + 4);
            f32x4 o0, o1; o0[0] = bflo(w[j].x) * ri * g0[0]; o0[1] = bfhi(w[j].x) * ri * g0[1]; o0[2] = bflo(w[j].y) * ri * g0[2]; o0[3] = bfhi(w[j].y) * ri * g0[3];
            o1[0] = bflo(w[j].z) * ri * g1[0]; o1[1] = bfhi(w[j].z) * ri * g1[1]; o1[2] = bflo(w[j].w) * ri * g1[2]; o1[3] = bfhi(w[j].w) * ri * g1[3];
            __builtin_nontemporal_store(o0, orow + c / 4); __builtin_nontemporal_store(o1, orow + c / 4 + 1); }
    }
}

#define XB_TMO      128
#define XB_XCNT(j)  (256  + 64 * (j))
#define XB_XSUB(j)  (1280 + 64 * (j))
#define XB_XGEN(j)  (2304 + 64 * (j))
#define XB_TOP      3328
#define XB_TOPGEN   3392
#define XCD_BAR_WORDS 3456
#define XB_SPIN_CAP (1u << 18)

__device__ __forceinline__ unsigned xb_ld(unsigned* p)              { return __hip_atomic_load(p, __ATOMIC_RELAXED, __HIP_MEMORY_SCOPE_AGENT); }
__device__ __forceinline__ unsigned xb_add(unsigned* p, unsigned v) { return __hip_atomic_fetch_add(p, v, __ATOMIC_RELAXED, __HIP_MEMORY_SCOPE_AGENT); }
__device__ __forceinline__ unsigned xb_xcc_id() { return (unsigned)__builtin_amdgcn_s_getreg((3 << 11) | 20) & 0xFu; }
#define XB_SPIN(cond, bar) do { unsigned _sp = 0; while (cond) { __builtin_amdgcn_s_sleep(1); \
    if ((++_sp & 255u) == 0u) { if (xb_ld(&(bar)[XB_TMO])) break; if (_sp > XB_SPIN_CAP) { atomicAdd(&(bar)[XB_TMO], 1u); break; } } } } while (0)

struct XcdBarrier {
    unsigned* bar; unsigned x;
    volatile LAS unsigned* st;
};

__device__ __forceinline__ XcdBarrier xcd_barrier_post(unsigned* bar, volatile LAS unsigned* st) {
    XcdBarrier b; b.bar = bar; b.x = xb_xcc_id(); b.st = st;
    if (threadIdx.x == 0) (void)xb_add(&bar[XB_XCNT(b.x)], 1u);
    return b;
}
__device__ __forceinline__ void xcd_barrier_complete(unsigned* bar, unsigned x, unsigned& nloc, unsigned& nx) {
    const unsigned G = gridDim.x * gridDim.y * gridDim.z;
    unsigned sum, cnt, mine, sp = 0u;
    for (;;) {
        sum = 0u; cnt = 0u; mine = 0u;
#pragma unroll
        for (unsigned j = 0; j < 16; ++j) { const unsigned c = xb_ld(&bar[XB_XCNT(j)]); sum += c; cnt += (c > 0u) ? 1u : 0u; mine = (j == x) ? c : mine; }
        if (sum == G) break;
        __builtin_amdgcn_s_sleep(1);
        if ((++sp & 255u) == 0u) { if (xb_ld(&bar[XB_TMO])) break; if (sp > XB_SPIN_CAP) { atomicAdd(&bar[XB_TMO], 1u); break; } }
    }
    nloc = mine > 0u ? mine : 1u; nx = cnt > 0u ? cnt : 1u;
}

__device__ __forceinline__ void xcd_barrier(const XcdBarrier& b) {
    asm volatile("s_waitcnt vmcnt(0)" ::: "memory");
    __syncthreads();
    if (threadIdx.x == 0) {
        unsigned* bar = b.bar;
        __builtin_amdgcn_s_waitcnt(0);
        unsigned nloc = b.st[0], nx = b.st[1];
        if (nloc == 0u) { xcd_barrier_complete(bar, b.x, nloc, nx); b.st[0] = nloc; b.st[1] = nx; }
        const unsigned old = xb_add(&bar[XB_XSUB(b.x)], 1u);
        const unsigned gen = old / nloc;
        if (old + 1u == (gen + 1u) * nloc) {
            __builtin_amdgcn_fence(__ATOMIC_RELEASE, "agent");
            asm volatile("s_waitcnt vmcnt(0)" ::: "memory");
            const unsigned og = xb_add(&bar[XB_TOP], 1u);
            const unsigned tg = og / nx;
            if (og + 1u == (tg + 1u) * nx) xb_add(&bar[XB_TOPGEN], 1u);
            else XB_SPIN(xb_ld(&bar[XB_TOPGEN]) == tg, bar);
            __builtin_amdgcn_fence(__ATOMIC_ACQUIRE, "agent");
            xb_add(&bar[XB_XGEN(b.x)], 1u);
            asm volatile("s_waitcnt vmcnt(0)" ::: "memory");
        } else {
            XB_SPIN(xb_ld(&bar[XB_XGEN(b.x)]) == gen, bar);
            __builtin_amdgcn_fence(__ATOMIC_ACQUIRE, "agent");
            asm volatile("s_waitcnt vmcnt(0)" ::: "memory");
        }
    }
    __syncthreads();
}


template <class Epi>
__device__ __forceinline__ void run_gemm(LAS unsigned char* lds, const bf16_t* A, const bf16_t* Bt, int N, int K, const Epi& E, int vc) {
    pg8::Gemm g; g.A = A; g.Bt = Bt; g.M = M_TOK; g.N = N; g.K = K;
    pg8::StaticOrder S; S.init(M_TOK, N, (int)gridDim.x, vc);
    pg8::gemm_phase<Epi, pg8::StaticOrder, true, true>(lds, g, S, E);
}
struct TailOrder {
    int c, n;
    __device__ __forceinline__ bool next(int i, Unit& u) const { if (c < 0) return false; const int L = i * n + c; if (L >= 256) return false; u.pm = L >> 3; u.pn = L & 7; return true; }
    __device__ __forceinline__ void a_ready(const Unit&) const {}
    __device__ __forceinline__ void done(const Unit&) const {}
};

__global__ void __launch_bounds__(512, 2) fwd_kernel(Args a) {
    extern __shared__ __attribute__((aligned(16))) unsigned char lds_raw[];
    LAS unsigned char* lds = (LAS unsigned char*)lds_raw;
    cg::grid_group grid = cg::this_grid();
    volatile LAS unsigned* xst = (volatile LAS unsigned*)(lds + LDS_BYTES - 16);
    if (threadIdx.x < 4) xst[threadIdx.x] = 0u;
    __syncthreads();
    XcdBarrier xbar = xcd_barrier_post((unsigned*)(a.ws + WS_BAR), xst);
    unsigned* cen = (unsigned*)(a.ws + WS_BAR) + 3584;
    if (threadIdx.x == 0) xst[2] = xb_add(&cen[64 * xbar.x], 1u);
    if (a.ph_lo == 0 && a.ph_hi == NPHASE) grid.sync();
    int vc = blockIdx.x;
    if (a.ph_lo == 0 && a.ph_hi == NPHASE && gridDim.x == 256) {
        bool even = true;
#pragma unroll
        for (int j = 0; j < 8; ++j) even = even && (xb_ld(&cen[64 * j]) == 32u);
        if (even) vc = (int)xst[2] * 8 + (int)xbar.x;
    }
    vc = __builtin_amdgcn_readfirstlane(vc);
    const int tid = threadIdx.x, lane = tid & 63, wave = __builtin_amdgcn_readfirstlane(tid >> 6);
    unsigned char* ws = a.ws;
    float* SS = (float*)(ws + WS_SS);
    bf16_t* XB = (bf16_t*)(ws + WS_XB); bf16_t* G = (bf16_t*)(ws + WS_G); bf16_t* MIX = (bf16_t*)(ws + WS_MIX);
#define PH(i) if (a.ph_lo <= (i) && (i) < a.ph_hi)
#define SYNC(i) if (a.ph_lo <= (i) && (i) + 1 < a.ph_hi) { xcd_barrier(xbar); }
    PH(0) { phase0(a, lds, wave, lane); } SYNC(0)
    PH(1) { EpiGateUp E; E.G = G; E.ss = SS; run_gemm(lds, XB, (const bf16_t*)(ws + WS_W1GU), 2 * FF, DM, E, vc); conv_tail(a, lds, wave, lane, 32 * 44, CV_P0, CV_WO, vc); conv_tail(a, lds, wave, lane, 32 * 44, CV_T1, CV_END, vc); } SYNC(1)
    PH(2) { EpiResid E; E.XB = XB; E.ss_out = SS + 8192; E.scale = 0.5f; run_gemm(lds, G, (const bf16_t*)(ws + WS_W1D), DM, FF, E, vc); } SYNC(2)
    PH(3) { EpiMixIn E; E.ss = SS + 8192; E.lbl = a.in[9]; E.QS = (bf16_t*)(ws + WS_QS);
            E.UC = (bf16_t*)(ws + WS_UC); E.LF = (float*)(ws + WS_LF); run_gemm(lds, XB, (const bf16_t*)(ws + WS_WIN), MIXIN, DM, E, vc); conv_tail(a, lds, wave, lane, 32 * 28, CV_WO, CV_TA, vc); conv_tail(a, lds, wave, lane, 32 * 28, CV_T0, CV_T1, vc); } SYNC(3)
    PH(4) { hgrn_pass_a(a, lds, wave, lane); } SYNC(4)
    PH(5) { hgrn_scan(a); conv_mixer(a, wave, lane); } SYNC(5)
    PH(6) { hgrn_pass_c(a, lds, wave, lane); } SYNC(6)
    PH(7) { EpiResid E; E.XB = XB; E.ss_out = SS + 16384; E.scale = 1.0f; run_gemm(lds, MIX, (const bf16_t*)(ws + WS_WOUT), DM, DM, E, vc); } SYNC(7)
    PH(8) { EpiGateUp E; E.G = G; E.ss = SS + 16384; run_gemm(lds, XB, (const bf16_t*)(ws + WS_W2GU), 2 * FF, DM, E, vc);
            { const int r = (32 * 44) % (int)gridDim.x; TailOrder T; T.n = (int)gridDim.x - r; T.c = vc - r;
              EpiStoreBf16 E2; E2.O = (bf16_t*)(ws + WS_PLE); int kp = PLE; asm volatile("" : "+s"(kp));
              pg8::Gemm g2; g2.A = (const bf16_t*)(ws + WS_PB); g2.Bt = (const bf16_t*)(ws + WS_WPE); g2.M = M_TOK; g2.N = DM; g2.K = kp;
              pg8::gemm_phase<EpiStoreBf16, TailOrder, true, true>(lds, g2, T, E2); }
            conv_tail(a, lds, wave, lane, 32 * 44, CV_TA, CV_T0, vc); } SYNC(8)
    PH(9) { EpiResid E; E.XB = XB; E.ss_out = SS + 24576; E.scale = 0.5f; run_gemm(lds, G, (const bf16_t*)(ws + WS_W2D), DM, FF, E, vc); } SYNC(9)
    PH(10) { EpiPleGate E; E.XB = XB; E.H4 = MIX; E.P = (const bf16_t*)(ws + WS_PLE); E.ss = SS + 24576; run_gemm(lds, XB, (const bf16_t*)(ws + WS_WPG), DM, DM, E, vc); } SYNC(10)
    PH(11) { phase_final(a, wave, lane); }
#undef PH
#undef SYNC
}

#ifndef MK_MULTI
#define MK_MULTI 0
#endif
extern "C" void kernel_launch(void* const* d_in, const int* in_sizes, int n_in, void* d_out, int out_size, void* d_ws, size_t ws_size, hipStream_t stream) {
    static int grid = 0;
    if (grid == 0) {
        if (n_in != 21 || out_size != M_TOK * DM || ws_size < WS_END) { fprintf(stderr, "kernel_launch: unexpected shapes (n_in %d out %d ws %zu need %zu)\n", n_in, out_size, ws_size, (size_t)WS_END); grid = -1; return; }
        int dev = 0, cus = 0, per_cu = 0;
        hipGetDevice(&dev); hipDeviceGetAttribute(&cus, hipDeviceAttributeMultiprocessorCount, dev);
        if (hipFuncSetAttribute((const void*)fwd_kernel, hipFuncAttributeMaxDynamicSharedMemorySize, LDS_BYTES) != hipSuccess) { fprintf(stderr, "kernel_launch: hipFuncSetAttribute failed\n"); grid = -1; return; }
        if (hipOccupancyMaxActiveBlocksPerMultiprocessor(&per_cu, (const void*)fwd_kernel, 512, LDS_BYTES) != hipSuccess || per_cu < 1) { fprintf(stderr, "kernel_launch: occupancy query failed (%d)\n", per_cu); grid = -1; return; }
        grid = cus * per_cu;
    }
    if (grid < 0) return;
    Args a{};
    for (int i = 0; i < 21; ++i) a.in[i] = (const float*)d_in[i];
    a.out = (float*)d_out; a.ws = (unsigned char*)d_ws;
#if MK_MULTI
    for (int p = 0; p < NPHASE; ++p) { a.ph_lo = p; a.ph_hi = p + 1; hipLaunchKernelGGL(fwd_kernel, dim3(grid), dim3(512), LDS_BYTES, stream, a); }
#else
    a.ph_lo = 0; a.ph_hi = NPHASE;
    if (hipMemsetAsync((char*)d_ws + WS_BAR, 0, 4096 * 4, stream) != hipSuccess) { fprintf(stderr, "kernel_launch: memset failed\n"); return; }
    void* args[] = {&a};
    hipError_t e = hipLaunchCooperativeKernel((void*)fwd_kernel, dim3(grid), dim3(512), args, LDS_BYTES, stream);
    if (e != hipSuccess) fprintf(stderr, "cooperative launch failed: %s (grid %d)\n", hipGetErrorString(e), grid);
#endif
}
```

```cpp
#include <hip/hip_runtime.h>
#include <hip/hip_cooperative_groups.h>
#include <cstdio>
#include <cstdint>
namespace pg8 {
#define PG8_LAS __attribute__((address_space(3)))
typedef unsigned short bf16_t;
typedef short bf16x8 __attribute__((ext_vector_type(8)));
typedef float f32x4 __attribute__((ext_vector_type(4)));
typedef unsigned u32x4 __attribute__((ext_vector_type(4)));
constexpr int BM = 256, BK = 64, HALF = 128, HTB = HALF * BK * 2  , STAGE_BYTES = 8 * HTB, NXCD = 8, WGM = 4;

__host__ __device__ __forceinline__ int lds_byte(int r, int c) { const int st = (r >> 4) * 2 + (c >> 5), rr = r & 15, cc = c & 31, ob = rr * 64 + cc * 2; return st * 1024 + (ob ^ (((ob >> 9) & 1) << 5)); }
__host__ __device__ __forceinline__ void stage_rc(int b, int& R, int& C) { const int st = b / 1024, sb = b % 1024, swz = sb ^ (((sb >> 9) & 1) << 5); R = (st >> 1) * 16 + swz / 64; C = (st & 1) * 32 + (swz % 64) / 2; }
__host__ __device__ __forceinline__ int perm32(int rho) { const int n = rho >> 4, i = rho & 15; return 8 * (i >> 2) + 4 * n + (i & 3); }

struct Unit { int pm, pn; };
struct Gemm { const bf16_t* A; const bf16_t* Bt; int M, N, K; };

struct StaticOrder {
    int nM, nN, nwg, G, c;
    __host__ __device__ void init(int M, int N, int G_, int c_) { nM = M / BM; nN = N / BM; nwg = nM * nN; G = G_; c = c_; }
    __host__ __device__ bool next(int i, Unit& u) const {
        const long L = (long)i * G + c; if (L >= nwg) return false;
        int wgid = (int)L; { const int q = nwg / NXCD, r = nwg % NXCD, xcd = wgid % NXCD, off = wgid / NXCD; wgid = (xcd < r ? xcd * (q + 1) : r * (q + 1) + (xcd - r) * q) + off; }
        const int nig = WGM * nN, gid = wgid / nig, fm = gid * WGM, gsz = (nM - fm) < WGM ? (nM - fm) : WGM;
        u.pm = fm + ((wgid % nig) % gsz); u.pn = (wgid % nig) / gsz; return true;
    }
    __device__ __forceinline__ void a_ready(const Unit&) const {}
    __device__ __forceinline__ void done(const Unit&) const {}
};
typedef float f32x2 __attribute__((ext_vector_type(2)));
template <class Epi, class Sched, bool ALIGN_EPI = false, bool SP2 = false>
__device__ __forceinline__ void gemm_phase(PG8_LAS unsigned char* lds, const Gemm g, const Sched& S, const Epi& E) {
    const int tid = threadIdx.x, wid = __builtin_amdgcn_readfirstlane(tid >> 6), lane = tid & 63, wr = wid >> 2, wc = wid & 3, fr = lane & 15, fq = lane >> 4;
    const int K = g.K, nt = K / BK;
    unsigned voffA[2], voffB[2];
#pragma unroll
    for (int i = 0; i < 2; ++i) { int R, C; stage_rc(tid * 16 + i * 8192, R, C); const int Rb = Epi::PERM ? ((R & ~31) + perm32(R & 31)) : R;
        voffA[i] = (unsigned)(R * K + C) * 2u; voffB[i] = (unsigned)(Rb * K + C) * 2u; }
    const size_t kstep = (size_t)(BK * 2);
    const size_t hstep = (size_t)HALF * K * 2;
    const size_t tstep = 2 * hstep;
    const unsigned ldsw = (unsigned)wid * 1024u;
    const int aoff = lds_byte(wr * 64 + fr, fq * 8), boff = lds_byte(wc * 32 + fr, fq * 8);
#define PG8_SA(b, h) (((b) * 2 + (h)) * HTB)
#define PG8_SB(b, h) ((4 + (b) * 2 + (h)) * HTB)
#define PG8_STAGE(bufoff, gbase, voff) do { _Pragma("unroll") for (int _i = 0; _i < 2; ++_i) \
        __builtin_amdgcn_global_load_lds((const unsigned*)((const char*)(gbase) + (voff)[_i]), (PG8_LAS unsigned*)(lds + (bufoff) + ldsw + _i * 8192), 16, 0, 0); } while (0)
#define PG8_LDA(dst, b, h) do { _Pragma("unroll") for (int m = 0; m < 4; ++m) _Pragma("unroll") for (int k = 0; k < 2; ++k) dst[m][k] = *(const PG8_LAS bf16x8*)(lds + PG8_SA(b, h) + aoff + m * 2048 + k * 1024); } while (0)
#define PG8_LDB(dst, b, h) do { _Pragma("unroll") for (int n = 0; n < 2; ++n) _Pragma("unroll") for (int k = 0; k < 2; ++k) dst[n][k] = *(const PG8_LAS bf16x8*)(lds + PG8_SB(b, h) + boff + n * 2048 + k * 1024); } while (0)
#define PG8_MMA(ai, bj, At, Bt) do { __builtin_amdgcn_s_setprio(1); _Pragma("unroll") for (int m = 0; m < 4; ++m) _Pragma("unroll") for (int n = 0; n < 2; ++n) _Pragma("unroll") for (int k = 0; k < 2; ++k) \
        acc[ai][bj][m][n] = __builtin_amdgcn_mfma_f32_16x16x32_bf16(Bt[n][k], At[m][k], acc[ai][bj][m][n], 0, 0, 0); __builtin_amdgcn_s_setprio(0); } while (0)
#define PG8_WAIT_V(n) asm volatile("s_waitcnt vmcnt(" #n ")" ::: "memory")
#define PG8_WAIT_L(n) asm volatile("s_waitcnt lgkmcnt(" #n ")" ::: "memory")
#define PG8_BAR __builtin_amdgcn_s_barrier()
#define PG8_SCHED __builtin_amdgcn_sched_barrier(0)
    Unit cur, nxt; int ui = 0;
    if (!S.next(0, cur)) return;
    f32x4 acc[2][2][4][2];
#pragma unroll
    for (int a = 0; a < 2; ++a)
#pragma unroll
        for (int b = 0; b < 2; ++b)
#pragma unroll
            for (int m = 0; m < 4; ++m)
#pragma unroll
                for (int n = 0; n < 2; ++n) acc[a][b][m][n] = (f32x4){0.f, 0.f, 0.f, 0.f};
    bf16x8 At[4][2], B0[2][2], B1[2][2];
    const char* cA = (const char*)g.A + (size_t)cur.pm * tstep; const char* cB = (const char*)g.Bt + (size_t)cur.pn * tstep;
    S.a_ready(cur);
    if constexpr (SP2) {
        PG8_STAGE(PG8_SB(0, 0), cB, voffB); PG8_STAGE(PG8_SB(0, 1), cB + hstep, voffB); PG8_STAGE(PG8_SA(0, 0), cA, voffA); PG8_STAGE(PG8_SA(0, 1), cA + hstep, voffA);
        if (wr == 1) PG8_BAR;
        PG8_WAIT_V(2); PG8_BAR;
        PG8_STAGE(PG8_SB(1, 0), cB + kstep, voffB); PG8_STAGE(PG8_SA(1, 0), cA + kstep, voffA); PG8_STAGE(PG8_SB(1, 1), cB + hstep + kstep, voffB);
        PG8_WAIT_V(6); PG8_BAR;
    } else {
        PG8_STAGE(PG8_SB(0, 0), cB, voffB); PG8_STAGE(PG8_SA(0, 0), cA, voffA); PG8_STAGE(PG8_SB(0, 1), cB + hstep, voffB); PG8_STAGE(PG8_SA(0, 1), cA + hstep, voffA);
        if (wr == 1) PG8_BAR;
        PG8_WAIT_V(4); PG8_BAR;
        PG8_STAGE(PG8_SB(1, 0), cB + kstep, voffB); PG8_STAGE(PG8_SA(1, 0), cA + kstep, voffA); PG8_STAGE(PG8_SB(1, 1), cB + hstep + kstep, voffB);
        PG8_WAIT_V(6); PG8_BAR;
    }
    for (;;) {
        const bool has_next = S.next(ui + 1, nxt);
        const char* nA = has_next ? (const char*)g.A + (size_t)nxt.pm * tstep : cA; const char* nB = has_next ? (const char*)g.Bt + (size_t)nxt.pn * tstep : cB;
        for (int t = 0; t < nt; t += 2) {
            const bool last = (t == nt - 2);
            const char* a1 = cA + (size_t)(t + 1) * kstep;
            const char* a2 = last ? nA : cA + (size_t)(t + 2) * kstep; const char* b2 = last ? nB : cB + (size_t)(t + 2) * kstep;
            const char* a3 = a2 + kstep; const char* b3 = b2 + kstep;
            if (last && has_next) S.a_ready(nxt);
            if constexpr (SP2) {
            PG8_LDB(B0, 0, 0); PG8_LDB(B1, 0, 1); PG8_SCHED; PG8_LDA(At, 0, 0); PG8_STAGE(PG8_SA(1, 1), a1 + hstep, voffA);
            PG8_WAIT_V(8); PG8_WAIT_L(0); PG8_BAR; PG8_MMA(0, 0, At, B0); PG8_MMA(0, 1, At, B1); PG8_BAR; PG8_SCHED;
            PG8_LDA(At, 0, 1); PG8_STAGE(PG8_SB(0, 0), b2, voffB); PG8_STAGE(PG8_SB(0, 1), b2 + hstep, voffB); PG8_STAGE(PG8_SA(0, 0), a2, voffA);
            PG8_WAIT_V(8); PG8_WAIT_L(0); PG8_BAR; PG8_MMA(1, 0, At, B0); PG8_MMA(1, 1, At, B1); PG8_BAR; PG8_SCHED;
            PG8_LDB(B0, 1, 0); PG8_LDB(B1, 1, 1); PG8_SCHED; PG8_LDA(At, 1, 0); PG8_STAGE(PG8_SA(0, 1), a2 + hstep, voffA);
            PG8_WAIT_V(8); PG8_WAIT_L(0); PG8_BAR; PG8_MMA(0, 0, At, B0); PG8_MMA(0, 1, At, B1); PG8_BAR; PG8_SCHED;
            PG8_LDA(At, 1, 1); PG8_STAGE(PG8_SB(1, 0), b3, voffB); PG8_STAGE(PG8_SB(1, 1), b3 + hstep, voffB); PG8_STAGE(PG8_SA(1, 0), a3, voffA);
            PG8_WAIT_V(8); PG8_WAIT_L(0); PG8_BAR; PG8_MMA(1, 0, At, B0); PG8_MMA(1, 1, At, B1); PG8_BAR; PG8_SCHED;
            } else {
            PG8_LDB(B0, 0, 0); PG8_SCHED; PG8_LDA(At, 0, 0); PG8_STAGE(PG8_SA(1, 1), a1 + hstep, voffA);
            PG8_WAIT_L(8); PG8_BAR; PG8_WAIT_L(0); PG8_MMA(0, 0, At, B0); PG8_BAR; PG8_SCHED;
            PG8_LDB(B1, 0, 1); PG8_STAGE(PG8_SB(0, 0), b2, voffB);
            PG8_BAR; PG8_WAIT_L(0); PG8_MMA(0, 1, At, B1); PG8_BAR;
            PG8_LDA(At, 0, 1); PG8_STAGE(PG8_SA(0, 0), a2, voffA);
            PG8_BAR; PG8_WAIT_L(0); PG8_MMA(1, 0, At, B0); PG8_BAR; PG8_SCHED;
            PG8_STAGE(PG8_SB(0, 1), b2 + hstep, voffB);
            PG8_WAIT_V(6); PG8_BAR; PG8_MMA(1, 1, At, B1); PG8_BAR;
            PG8_LDB(B0, 1, 0); PG8_SCHED; PG8_LDA(At, 1, 0); PG8_STAGE(PG8_SA(0, 1), a2 + hstep, voffA);
            PG8_WAIT_L(8); PG8_BAR; PG8_WAIT_L(0); PG8_MMA(0, 0, At, B0); PG8_BAR; PG8_SCHED;
            PG8_LDB(B1, 1, 1); PG8_STAGE(PG8_SB(1, 0), b3, voffB);
            PG8_BAR; PG8_WAIT_L(0); PG8_MMA(0, 1, At, B1); PG8_BAR;
            PG8_LDA(At, 1, 1); PG8_STAGE(PG8_SA(1, 0), a3, voffA);
            PG8_BAR; PG8_WAIT_L(0); PG8_MMA(1, 0, At, B0); PG8_BAR; PG8_SCHED;
            PG8_STAGE(PG8_SB(1, 1), b3 + hstep, voffB);
            PG8_WAIT_V(6); PG8_BAR; PG8_MMA(1, 1, At, B1); PG8_BAR;
            }
        }
        if constexpr (ALIGN_EPI) { if (wr == 0) PG8_BAR; }
        if constexpr (!Epi::AFTER_DRAIN) { E(acc, cur, wr, wc, fr, fq); S.done(cur); }
        if (!has_next) break;
#pragma unroll
        for (int a = 0; a < 2; ++a)
#pragma unroll
            for (int b = 0; b < 2; ++b)
#pragma unroll
                for (int m = 0; m < 4; ++m)
#pragma unroll
                    for (int n = 0; n < 2; ++n) acc[a][b][m][n] = (f32x4){0.f, 0.f, 0.f, 0.f};
        cur = nxt; cA = nA; cB = nB; ++ui;
        if constexpr (ALIGN_EPI) { if (wr == 1) PG8_BAR; }
    }
    PG8_WAIT_V(0);
    if constexpr (!ALIGN_EPI) { if (wr == 0) PG8_BAR; }
    PG8_BAR;
    if constexpr (Epi::AFTER_DRAIN) { E.fused(acc, cur, wr, wc, fr, fq, lds, wid, lane); S.done(cur); }
#undef PG8_SA
#undef PG8_SB
#undef PG8_STAGE
#undef PG8_LDA
#undef PG8_LDB
#undef PG8_MMA
#undef PG8_WAIT_V
#undef PG8_WAIT_L
#undef PG8_BAR
#undef PG8_SCHED
}
}

namespace cg = cooperative_groups;
using pg8::bf16_t; using pg8::bf16x8; using pg8::f32x4; using pg8::u32x4; using pg8::Unit;
typedef float f32x2c __attribute__((ext_vector_type(2)));
typedef __bf16 bf16x2c __attribute__((ext_vector_type(2)));
__device__ __forceinline__ unsigned cvt_pk_bf16(float lo, float hi) { const f32x2c v = {lo, hi}; return __builtin_bit_cast(unsigned, __builtin_convertvector(v, bf16x2c)); }
#define LAS __attribute__((address_space(3)))
typedef unsigned u32x2 __attribute__((ext_vector_type(2)));
typedef float f32x2v __attribute__((ext_vector_type(2)));

constexpr int M_TOK = 8192, DM = 2048, FF = 5632, HW = 1024, CW = 1024, MIXIN = 7168, PLE = 256, SEQ = 2048;
constexpr float EPS = 1e-6f;
constexpr size_t MiB = 1ull << 20;
constexpr size_t WS_W1GU = 0, WS_W1D = 44 * MiB, WS_WIN = 66 * MiB, WS_WOUT = 94 * MiB, WS_W2GU = 102 * MiB, WS_W2D = 146 * MiB,
                 WS_WPG = 168 * MiB, WS_WPE = 176 * MiB, WS_PB = 177 * MiB, WS_XB = 181 * MiB, WS_MIX = 213 * MiB, WS_G = 245 * MiB,
                 WS_QS = 245 * MiB, WS_VH = 261 * MiB, WS_GH = 277 * MiB, WS_BC = 293 * MiB, WS_UC = 309 * MiB, WS_LF = 325 * MiB,
                 WS_S = 357 * MiB, WS_PLE = 0, WS_SS = 389 * MiB, WS_DD = 389 * MiB + 512 * 1024, WS_BAR = 390 * MiB + 512 * 1024, WS_END = 391 * MiB, WS_U = 0;
constexpr int LDS_BYTES = 150 * 1024;
constexpr int NPHASE = 12;

__device__ __forceinline__ float bf2f(bf16_t b) { return __uint_as_float(((unsigned)b) << 16); }
__device__ __forceinline__ float bflo(unsigned w) { return __uint_as_float(w << 16); }
__device__ __forceinline__ float bfhi(unsigned w) { return __uint_as_float(w & 0xffff0000u); }
__device__ __forceinline__ float wave_sum(float v) {
#pragma unroll
    for (int o = 1; o < 64; o <<= 1) v += __shfl_xor(v, o);
    return v;
}
__device__ __forceinline__ float row16_sum(float x) {
    x += __builtin_bit_cast(float, __builtin_amdgcn_update_dpp(0, __builtin_bit_cast(int, x), 0xB1, 0xF, 0xF, true));
    x += __builtin_bit_cast(float, __builtin_amdgcn_update_dpp(0, __builtin_bit_cast(int, x), 0x4E, 0xF, 0xF, true));
    x += __builtin_bit_cast(float, __builtin_amdgcn_update_dpp(0, __builtin_bit_cast(int, x), 0x141, 0xF, 0xF, true));
    x += __builtin_bit_cast(float, __builtin_amdgcn_update_dpp(0, __builtin_bit_cast(int, x), 0x140, 0xF, 0xF, true));
    return x;
}
__device__ __forceinline__ float fsigmoid(float x) { return __builtin_amdgcn_rcpf(1.0f + __expf(-x)); }
__device__ __forceinline__ float fsilu(float x) { return x * fsigmoid(x); }
__device__ __forceinline__ float rinv_of(float ss) { return rsqrtf(ss * (1.0f / DM) + EPS); }

struct EpiGateUp {
    static constexpr bool PERM = true, AFTER_DRAIN = false;
    bf16_t* G; const float* ss;
    __device__ __forceinline__ void operator()(const f32x4 (&acc)[2][2][4][2], const Unit& u, int wr, int wc, int fr, int fq) const {
        const int row0 = u.pm * 256 + wr * 64 + fr, col0 = u.pn * 128 + wc * 32 + 8 * fq;
#pragma unroll
        for (int ai = 0; ai < 2; ++ai)
#pragma unroll
            for (int m = 0; m < 4; ++m) {
                const int r = row0 + ai * 128 + m * 16; const float ri = rinv_of(ss[r]);
                float v[8];
#pragma unroll
                for (int n = 0; n < 2; ++n)
#pragma unroll
                    for (int j = 0; j < 4; ++j) v[n * 4 + j] = fsilu(acc[ai][0][m][n][j] * ri) * (acc[ai][1][m][n][j] * ri);
                u32x4 w; w.x = cvt_pk_bf16(v[0], v[1]); w.y = cvt_pk_bf16(v[2], v[3]); w.z = cvt_pk_bf16(v[4], v[5]); w.w = cvt_pk_bf16(v[6], v[7]);
                *(u32x4*)(G + (size_t)r * FF + col0) = w;
            }
    }
};
struct EpiResid {
    static constexpr bool PERM = true, AFTER_DRAIN = false;
    bf16_t* XB; float* ss_out; float scale;
    __device__ __forceinline__ void operator()(f32x4 (&acc)[2][2][4][2], const Unit& u, int wr, int wc, int fr, int fq) const {
        const int row0 = u.pm * 256 + wr * 64 + fr, col0 = u.pn * 256 + wc * 32 + 8 * fq;
#pragma unroll
        for (int ai = 0; ai < 2; ++ai) {
#pragma unroll
            for (int m = 0; m < 4; ++m)
#pragma unroll
                for (int bj = 0; bj < 2; ++bj) {
                    const size_t off = (size_t)(row0 + ai * 128 + m * 16) * DM + col0 + bj * 128;
                    const u32x4 xw = *(const u32x4*)(XB + off);
                    f32x4 r0, r1; r0[0] = bflo(xw.x); r0[1] = bfhi(xw.x); r0[2] = bflo(xw.y); r0[3] = bfhi(xw.y); r1[0] = bflo(xw.z); r1[1] = bfhi(xw.z); r1[2] = bflo(xw.w); r1[3] = bfhi(xw.w);
                    acc[ai][bj][m][0] = r0 + acc[ai][bj][m][0] * scale; acc[ai][bj][m][1] = r1 + acc[ai][bj][m][1] * scale;
                }
            asm volatile("" ::: "memory");
#pragma unroll
            for (int m = 0; m < 4; ++m) {
                const int r = row0 + ai * 128 + m * 16; float sq = 0.f;
#pragma unroll
                for (int bj = 0; bj < 2; ++bj) {
                    const size_t off = (size_t)r * DM + col0 + bj * 128;
                    const f32x4 v0 = acc[ai][bj][m][0], v1 = acc[ai][bj][m][1];
                    u32x4 w; w.x = cvt_pk_bf16(v0[0], v0[1]); w.y = cvt_pk_bf16(v0[2], v0[3]); w.z = cvt_pk_bf16(v1[0], v1[1]); w.w = cvt_pk_bf16(v1[2], v1[3]);
                    *(u32x4*)(XB + off) = w;
                    sq += (v0[0] * v0[0] + v0[1] * v0[1]) + (v0[2] * v0[2] + v0[3] * v0[3]) + (v1[0] * v1[0] + v1[1] * v1[1]) + (v1[2] * v1[2] + v1[3] * v1[3]);
                }
                sq += __shfl_xor(sq, 16); sq += __shfl_xor(sq, 32);
                if (fq == 0) atomicAdd(ss_out + r, sq);
            }
            asm volatile("" ::: "memory");
        }
    }
};
struct EpiMixIn {
    static constexpr bool PERM = true, AFTER_DRAIN = false;
    const float* ss; const float* lbl;
    bf16_t *QS, *UC; float* LF;
    __device__ __forceinline__ void operator()(const f32x4 (&acc)[2][2][4][2], const Unit& u, int wr, int wc, int fr, int fq) const {
        const int row0 = u.pm * 256 + wr * 64 + fr; const int sec = u.pn >> 2;
        if (u.pn >= 20) {
            const int col0 = (u.pn - 20) * 128 + wc * 32 + 8 * fq;
#pragma unroll
            for (int ai = 0; ai < 2; ++ai)
#pragma unroll
                for (int m = 0; m < 4; ++m) {
                    const int r = row0 + ai * 128 + m * 16; const float ri = rinv_of(ss[r]); const float ri2 = ri * ri;
                    float v[8];
#pragma unroll
                    for (int n = 0; n < 2; ++n)
#pragma unroll
                        for (int j = 0; j < 4; ++j) v[n * 4 + j] = acc[ai][0][m][n][j] * acc[ai][1][m][n][j] * ri2;
                    u32x4 w; w.x = cvt_pk_bf16(v[0], v[1]); w.y = cvt_pk_bf16(v[2], v[3]); w.z = cvt_pk_bf16(v[4], v[5]); w.w = cvt_pk_bf16(v[6], v[7]);
                    *(u32x4*)(UC + (size_t)r * CW + col0) = w;
                }
            return;
        }
        const int col0 = (u.pn & 3) * 256 + wc * 32 + 8 * fq;
        if (sec == 1) {
#pragma unroll
            for (int bj = 0; bj < 2; ++bj)
#pragma unroll
                for (int n = 0; n < 2; ++n) {
                    const int c = col0 + bj * 128 + 4 * n; const f32x4 l0 = *(const f32x4*)(lbl + c), l1 = *(const f32x4*)(lbl + 1024 + c);
                    f32x4 lb; lb[0] = fsigmoid(l0[0] - l1[0]); lb[1] = fsigmoid(l0[1] - l1[1]); lb[2] = fsigmoid(l0[2] - l1[2]); lb[3] = fsigmoid(l0[3] - l1[3]);
#pragma unroll
                    for (int ai = 0; ai < 2; ++ai)
#pragma unroll
                        for (int m = 0; m < 4; ++m) {
                            const int r = row0 + ai * 128 + m * 16; const float ri = rinv_of(ss[r]);
                            const f32x4 x = acc[ai][bj][m][n]; f32x4 o;
                            o[0] = __logf(lb[0] + (1.0f - lb[0]) * fsigmoid(x[0] * ri)); o[1] = __logf(lb[1] + (1.0f - lb[1]) * fsigmoid(x[1] * ri));
                            o[2] = __logf(lb[2] + (1.0f - lb[2]) * fsigmoid(x[2] * ri)); o[3] = __logf(lb[3] + (1.0f - lb[3]) * fsigmoid(x[3] * ri));
                            *(f32x4*)(LF + (size_t)r * HW + c) = o;
                        }
                }
            return;
        }
        bf16_t* dst = QS + (size_t)(sec == 0 ? 0 : sec - 1) * ((size_t)M_TOK * HW);
        const bool act = (sec == 0 || sec == 3);
#pragma unroll
        for (int ai = 0; ai < 2; ++ai)
#pragma unroll
            for (int m = 0; m < 4; ++m) {
                const int r = row0 + ai * 128 + m * 16; const float ri = rinv_of(ss[r]);
#pragma unroll
                for (int bj = 0; bj < 2; ++bj) {
                    float v[8];
#pragma unroll
                    for (int n = 0; n < 2; ++n)
#pragma unroll
                        for (int j = 0; j < 4; ++j) { const float x = acc[ai][bj][m][n][j] * ri; v[n * 4 + j] = act ? fsilu(x) : x; }
                    u32x4 w; w.x = cvt_pk_bf16(v[0], v[1]); w.y = cvt_pk_bf16(v[2], v[3]); w.z = cvt_pk_bf16(v[4], v[5]); w.w = cvt_pk_bf16(v[6], v[7]);
                    *(u32x4*)(dst + (size_t)r * HW + col0 + bj * 128) = w;
                }
            }
    }
};
struct EpiStoreBf16 {
    static constexpr bool PERM = true, AFTER_DRAIN = false;
    bf16_t* O;
    __device__ __forceinline__ void operator()(const f32x4 (&acc)[2][2][4][2], const Unit& u, int wr, int wc, int fr, int fq) const {
        const int row0 = u.pm * 256 + wr * 64 + fr, col0 = u.pn * 256 + wc * 32 + 8 * fq;
#pragma unroll
        for (int ai = 0; ai < 2; ++ai)
#pragma unroll
            for (int m = 0; m < 4; ++m) {
                const int r = row0 + ai * 128 + m * 16;
#pragma unroll
                for (int bj = 0; bj < 2; ++bj) {
                    const f32x4 v0 = acc[ai][bj][m][0], v1 = acc[ai][bj][m][1];
                    u32x4 w; w.x = cvt_pk_bf16(v0[0], v0[1]); w.y = cvt_pk_bf16(v0[2], v0[3]); w.z = cvt_pk_bf16(v1[0], v1[1]); w.w = cvt_pk_bf16(v1[2], v1[3]);
                    *(u32x4*)(O + (size_t)r * DM + col0 + bj * 128) = w;
                }
            }
    }
};
struct EpiPleGate {
    static constexpr bool PERM = true, AFTER_DRAIN = false;
    const bf16_t* XB; const bf16_t* P; bf16_t* H4; const float* ss;
    __device__ __forceinline__ void operator()(f32x4 (&acc)[2][2][4][2], const Unit& u, int wr, int wc, int fr, int fq) const {
        const int row0 = u.pm * 256 + wr * 64 + fr, col0 = u.pn * 256 + wc * 32 + 8 * fq;
#pragma unroll
        for (int ai = 0; ai < 2; ++ai)
#pragma unroll
            for (int m = 0; m < 4; ++m) {
                const int r = row0 + ai * 128 + m * 16; const float ri = rinv_of(ss[r]);
#pragma unroll
                for (int bj = 0; bj < 2; ++bj) {
                    const size_t off = (size_t)r * DM + col0 + bj * 128;
                    const u32x4 pw = *(const u32x4*)(P + off), xw = *(const u32x4*)(XB + off);
                    const f32x4 a0 = acc[ai][bj][m][0], a1 = acc[ai][bj][m][1];
                    u32x4 w;
                    w.x = cvt_pk_bf16(bflo(xw.x) + fsigmoid(a0[0] * ri) * bflo(pw.x), bfhi(xw.x) + fsigmoid(a0[1] * ri) * bfhi(pw.x));
                    w.y = cvt_pk_bf16(bflo(xw.y) + fsigmoid(a0[2] * ri) * bflo(pw.y), bfhi(xw.y) + fsigmoid(a0[3] * ri) * bfhi(pw.y));
                    w.z = cvt_pk_bf16(bflo(xw.z) + fsigmoid(a1[0] * ri) * bflo(pw.z), bfhi(xw.z) + fsigmoid(a1[1] * ri) * bfhi(pw.z));
                    w.w = cvt_pk_bf16(bflo(xw.w) + fsigmoid(a1[2] * ri) * bflo(pw.w), bfhi(xw.w) + fsigmoid(a1[3] * ri) * bfhi(pw.w));
                    *(u32x4*)(H4 + off) = w;
                }
            }
    }
};

template <int MODE>
__device__ __forceinline__ void p0_item(const float* W, const float* W2, const float* gain, int K, int N, bf16_t* WT, LAS float* scr, int item, int lane) {
    const int nblk_k = K / 64; const int nb = item / nblk_k, kb = item % nblk_k; const int k0 = 64 * kb, n0 = 32 * nb;
    const float* src = W; int c0 = n0;
    if (MODE == 1) { const int t = n0 >> 8, bj = (n0 >> 7) & 1, c = n0 & 127; src = bj ? W2 : W; c0 = 128 * t + c; }
    if (MODE == 2) { if (n0 >= 5120) { const int tt = n0 - 5120; const int t = tt >> 8, bj = (tt >> 7) & 1, c = tt & 127; c0 = 5120 + 1024 * bj + 128 * t + c; } }
    float v[32], gg[32];
    const float* sp = src + (size_t)(k0 + (lane >> 5)) * N + c0 + (lane & 31);
#pragma unroll
    for (int i = 0; i < 32; ++i) v[i] = __builtin_nontemporal_load(sp + (size_t)(2 * i) * N);
    if (gain) {
#pragma unroll
        for (int i = 0; i < 32; ++i) gg[i] = gain[k0 + 2 * i + (lane >> 5)];
#pragma unroll
        for (int i = 0; i < 32; ++i) v[i] *= gg[i];
    }
#pragma unroll
    for (int i = 0; i < 32; ++i) scr[(2 * i + (lane >> 5)) * 33 + (lane & 31)] = v[i];
    asm volatile("s_waitcnt lgkmcnt(0)" ::: "memory");
    const int c = lane & 7;
#pragma unroll
    for (int j = 0; j < 4; ++j) { const int n = (lane >> 3) + 8 * j; const LAS float* s = scr + (8 * c) * 33 + n;
        u32x4 o; o.x = cvt_pk_bf16(s[0 * 33], s[1 * 33]); o.y = cvt_pk_bf16(s[2 * 33], s[3 * 33]); o.z = cvt_pk_bf16(s[4 * 33], s[5 * 33]); o.w = cvt_pk_bf16(s[6 * 33], s[7 * 33]);
        *(u32x4*)(WT + (size_t)(n0 + n) * K + k0 + 8 * c) = o; }
    asm volatile("s_waitcnt lgkmcnt(0)" ::: "memory");
}

struct Args { const float* in[21]; float* out; unsigned char* ws; int ph_lo, ph_hi; };

constexpr int CV_I0 = 32 * 352, CV_I1 = 88 * 64, CV_I2 = 32 * 224, CV_I3 = 32 * 64, CV_I7 = 4 * 64;
constexpr int CV_END = 2 * CV_I0 + 2 * CV_I1 + CV_I2 + 2 * CV_I3 + CV_I7, CV_T1 = CV_END - 10000, CV_T0 = CV_T1 - 10000, CV_TA = CV_I0 + CV_I2 + CV_I3 + CV_I7, CV_P0 = CV_I0 + CV_I7 + CV_I2 - 2000, CV_WO = CV_I0 + CV_I7 + CV_I2;
__device__ __forceinline__ void conv_range(const Args& a, LAS unsigned char* lds, int wave, int lane, int lo, int hi, int w0, int nw) {
    unsigned char* ws = a.ws;
    LAS float* scr = (LAS float*)(lds + wave * 16384);
    for (int it = lo + w0; it < hi; it += nw) {
        int r = it;
        if (r < CV_I0) { p0_item<1>(a.in[3], a.in[4], a.in[2], DM, FF, (bf16_t*)(ws + WS_W1GU), scr, r, lane); continue; } r -= CV_I0;
        if (r < CV_I7) { p0_item<0>(a.in[18], nullptr, nullptr, PLE, DM, (bf16_t*)(ws + WS_WPE), scr, r, lane); continue; } r -= CV_I7;
        if (r < CV_I2) { p0_item<2>(a.in[7], nullptr, a.in[6], DM, MIXIN, (bf16_t*)(ws + WS_WIN), scr, r, lane); continue; } r -= CV_I2;
        if (r < CV_I3) { p0_item<0>(a.in[12], nullptr, nullptr, DM, DM, (bf16_t*)(ws + WS_WOUT), scr, r, lane); continue; } r -= CV_I3;
        if (r < CV_I3) { p0_item<0>(a.in[19], nullptr, a.in[17], DM, DM, (bf16_t*)(ws + WS_WPG), scr, r, lane); continue; } r -= CV_I3;
        if (r < CV_I1) { p0_item<0>(a.in[16], nullptr, nullptr, FF, DM, (bf16_t*)(ws + WS_W2D), scr, r, lane); continue; } r -= CV_I1;
        if (r < CV_I0) { p0_item<1>(a.in[14], a.in[15], a.in[13], DM, FF, (bf16_t*)(ws + WS_W2GU), scr, r, lane); continue; } r -= CV_I0;
        p0_item<0>(a.in[5], nullptr, nullptr, FF, DM, (bf16_t*)(ws + WS_W1D), scr, r, lane);
    }
}
__device__ __forceinline__ void conv_tail(const Args& a, LAS unsigned char* lds, int wave, int lane, int nunits, int lo, int hi, int vc) {
    const int r = nunits % (int)gridDim.x;
    if (r == 0) { conv_range(a, lds, wave, lane, lo, hi, vc * 8 + wave, gridDim.x * 8); return; }
    if (vc >= r) conv_range(a, lds, wave, lane, lo, hi, (vc - r) * 8 + wave, ((int)gridDim.x - r) * 8);
}

__device__ __forceinline__ void phase0(const Args& a, LAS unsigned char* lds, int wave, int lane) {
    unsigned char* ws = a.ws;
    const int gw = blockIdx.x * 8 + wave, NGW = gridDim.x * 8;
    conv_range(a, lds, wave, lane, 0, CV_P0, gw, NGW);
    float* SS = (float*)(ws + WS_SS);
    for (int m = gw; m < M_TOK; m += NGW) {
        const f32x4* xr = (const f32x4*)(a.in[0] + (size_t)m * DM) + lane; u32x2* xb = (u32x2*)((bf16_t*)(ws + WS_XB) + (size_t)m * DM) + lane;
        float s = 0.f;
#pragma unroll
        for (int j = 0; j < 8; ++j) { const f32x4 v = __builtin_nontemporal_load(xr + 64 * j); s += (v[0] * v[0] + v[1] * v[1]) + (v[2] * v[2] + v[3] * v[3]);
            u32x2 w; w.x = cvt_pk_bf16(v[0], v[1]); w.y = cvt_pk_bf16(v[2], v[3]); xb[64 * j] = w; }
        s = wave_sum(s);
        if (lane == 0) { SS[m] = s; SS[8192 + m] = 0.f; SS[16384 + m] = 0.f; SS[24576 + m] = 0.f; }
    }
    { const int gt = blockIdx.x * 512 + threadIdx.x, NT = gridDim.x * 512;
      for (int i = gt; i < M_TOK * PLE / 4; i += NT) { const f32x4 v = __builtin_nontemporal_load((const f32x4*)a.in[1] + i); u32x2 w; w.x = cvt_pk_bf16(v[0], v[1]); w.y = cvt_pk_bf16(v[2], v[3]); ((u32x2*)(ws + WS_PB))[i] = w; } }
}

constexpr int HP = 136, VP = 72;
constexpr int L_QT = 0, L_QH = L_QT + 64 * HP * 2, L_KA = L_QH + 64 * HP * 2, L_KB = L_KA + 64 * HP * 2, L_ST = L_KB + 32 * HP * 2, L_VT = L_ST + 128 * HP * 2,
              L_P = L_VT + 128 * VP * 2, L_SEG = L_P + 64 * VP * 2, L_PART = L_SEG + 8 * 128 * 4, L_RINV = L_PART + 8 * 64 * 4, L_HEND = L_RINV + 256, L_KT = 0;
static_assert(L_HEND <= LDS_BYTES, "LDS");
#define MFMA16(a, b, c) __builtin_amdgcn_mfma_f32_16x16x32_bf16((a), (b), (c), 0, 0, 0)
__device__ __forceinline__ bf16_t f2bf(float x) { return (bf16_t)(cvt_pk_bf16(x, 0.f) & 0xffffu); }

#define LDSBAR() do { asm volatile("s_waitcnt lgkmcnt(0)" ::: "memory"); __builtin_amdgcn_s_barrier(); asm volatile("" ::: "memory"); } while (0)
__device__ __forceinline__ void hgrn_pass_a(const Args& a, LAS unsigned char* lds, int wave, int lane) {
    unsigned char* ws = a.ws;
    const float* LF = (const float*)(ws + WS_LF); const bf16_t* VH = (const bf16_t*)(ws + WS_VH); bf16_t* U = (bf16_t*)(ws + WS_U); float* Dd = (float*)(ws + WS_DD);
    const int tid = threadIdx.x, k = tid & 127, sg = tid >> 7, fr = lane & 15, fq = lane >> 4;
    LAS bf16_t* VT = (LAS bf16_t*)(lds + L_VT); LAS bf16_t* KT = (LAS bf16_t*)(lds + L_KT); LAS float* SEG = (LAS float*)(lds + L_SEG);
    float lf[16]; u32x4 vv[2];
#define PA_LOAD(it) do { const int r0_ = ((it) >> 3) * 64, c0_ = ((it) & 7) * 128; \
        _Pragma("unroll") for (int i = 0; i < 16; ++i) lf[i] = LF[(size_t)(r0_ + 16 * sg + i) * HW + c0_ + k]; \
        _Pragma("unroll") for (int j = 0; j < 2; ++j) { const int idx = tid + 512 * j; vv[j] = *(const u32x4*)(VH + (size_t)(r0_ + (idx >> 4)) * HW + c0_ + 8 * (idx & 15)); } } while (0)
    int item = blockIdx.x;
    if (item < 1024) PA_LOAD(item);
    for (; item < 1024; item += gridDim.x) {
        float b[16];
        float run = 0.f;
#pragma unroll
        for (int i = 0; i < 16; ++i) { run += lf[i]; b[i] = run; }
        SEG[sg * 128 + k] = run;
        LDSBAR();
        const float s0 = SEG[k], s1 = SEG[128 + k], s2 = SEG[256 + k], s3 = SEG[384 + k];
        const float pre = sg == 0 ? 0.f : (sg == 1 ? s0 : (sg == 2 ? s0 + s1 : s0 + s1 + s2));
        const float blast = s0 + s1 + s2 + s3;
        unsigned pk[8];
#pragma unroll
        for (int i = 0; i < 8; ++i) {
            const float e0 = (1.0f - __expf(lf[2 * i])) * __expf(blast - (pre + b[2 * i])), e1 = (1.0f - __expf(lf[2 * i + 1])) * __expf(blast - (pre + b[2 * i + 1]));
            pk[i] = cvt_pk_bf16(e0, e1); }
        { u32x4 w0, w1; w0.x = pk[0]; w0.y = pk[1]; w0.z = pk[2]; w0.w = pk[3]; w1.x = pk[4]; w1.y = pk[5]; w1.z = pk[6]; w1.w = pk[7];
          *(LAS u32x4*)(KT + k * VP + 16 * sg) = w0; *(LAS u32x4*)(KT + k * VP + 16 * sg + 8) = w1; }
#pragma unroll
        for (int j = 0; j < 2; ++j) { const int idx = tid + 512 * j, s = (idx >> 4) ^ ((((idx & 15) >> 1) & 7) << 3), v0 = 8 * (idx & 15);
            VT[(v0 + 0) * VP + s] = (bf16_t)(vv[j].x & 0xffffu); VT[(v0 + 1) * VP + s] = (bf16_t)(vv[j].x >> 16);
            VT[(v0 + 2) * VP + s] = (bf16_t)(vv[j].y & 0xffffu); VT[(v0 + 3) * VP + s] = (bf16_t)(vv[j].y >> 16);
            VT[(v0 + 4) * VP + s] = (bf16_t)(vv[j].z & 0xffffu); VT[(v0 + 5) * VP + s] = (bf16_t)(vv[j].z >> 16);
            VT[(v0 + 6) * VP + s] = (bf16_t)(vv[j].w & 0xffffu); VT[(v0 + 7) * VP + s] = (bf16_t)(vv[j].w >> 16); }
        if (sg == 0) Dd[item * 128 + k] = __expf(blast);
        if (item + (int)gridDim.x < 1024) PA_LOAD(item + (int)gridDim.x);
        LDSBAR();
        const bf16x8 a0 = *(const LAS bf16x8*)(VT + (16 * wave + fr) * VP + ((fq * 8) ^ (wave << 3))), a1 = *(const LAS bf16x8*)(VT + (16 * wave + fr) * VP + ((32 + fq * 8) ^ (wave << 3)));
        bf16_t* up = U + (size_t)item * 16384 + (16 * wave + fr) * 128 + 4 * fq;
#pragma unroll
        for (int kt = 0; kt < 8; ++kt) {
            const bf16x8 b0 = *(const LAS bf16x8*)(KT + (16 * kt + fr) * VP + fq * 8), b1 = *(const LAS bf16x8*)(KT + (16 * kt + fr) * VP + 32 + fq * 8);
            f32x4 acc = {0.f, 0.f, 0.f, 0.f};
            acc = MFMA16(b0, a0, acc); acc = MFMA16(b1, a1, acc);
            u32x2 w; w.x = cvt_pk_bf16(acc[0], acc[1]); w.y = cvt_pk_bf16(acc[2], acc[3]);
            *(u32x2*)(up + 16 * kt) = w;
        }
        LDSBAR();
    }
#undef PA_LOAD
}

__device__ __forceinline__ void hgrn_scan(const Args& a) {
    unsigned char* ws = a.ws;
    const bf16_t* U = (const bf16_t*)(ws + WS_U); const float* Dd = (const float*)(ws + WS_DD); bf16_t* SP = (bf16_t*)(ws + WS_S);
    for (int e = (blockIdx.x * 512 + threadIdx.x) * 4; e < 32 * 16384; e += gridDim.x * 512 * 4) {
        const int bh = e >> 14, vk = e & 16383, bb = bh >> 3, h = bh & 7;
        f32x4 S = {0.f, 0.f, 0.f, 0.f};
#pragma unroll 8
        for (int ci = 0; ci < 32; ++ci) {
            const size_t item = (size_t)((bb * 32 + ci) * 8 + h);
            const u32x2 uw = *(const u32x2*)(U + item * 16384 + vk); f32x4 u; u[0] = bflo(uw.x); u[1] = bfhi(uw.x); u[2] = bflo(uw.y); u[3] = bfhi(uw.y); const f32x4 d = *(const f32x4*)(Dd + item * 128 + (vk & 127));
            u32x2 w; w.x = cvt_pk_bf16(S[0], S[1]); w.y = cvt_pk_bf16(S[2], S[3]); *(u32x2*)(SP + item * 16384 + vk) = w;
            S = d * S + u;
        }
    }
}

__device__ __forceinline__ void conv_mixer(const Args& a, int wave, int lane) {
    unsigned char* ws = a.ws;
    const bf16_t* BC = (const bf16_t*)(ws + WS_BC); const bf16_t* UC = (const bf16_t*)(ws + WS_UC); bf16_t* MIX = (bf16_t*)(ws + WS_MIX);
    const float* cn = a.in[11]; const float* cw = a.in[8];
    const int gw = blockIdx.x * 8 + wave, NGW = gridDim.x * 8;
    for (int it = gw; it < M_TOK * 2; it += NGW) {
        const int row = it >> 1, c = (it & 1) * 512 + lane * 8, t = row & (SEQ - 1);
        const size_t off = (size_t)row * CW + c;
        const u32x4 z = {0u, 0u, 0u, 0u};
        const u32x4 u0 = *(const u32x4*)(UC + off), u1 = t >= 1 ? *(const u32x4*)(UC + off - CW) : z, u2 = t >= 2 ? *(const u32x4*)(UC + off - 2 * CW) : z, bg = *(const u32x4*)(BC + off);
        float y[8]; float ssq = 0.f;
#pragma unroll
        for (int q = 0; q < 4; ++q) {
            const unsigned a0 = u0[q], a1 = u1[q], a2 = u2[q], bb = bg[q]; const int cc = c + 2 * q;
            y[2 * q] = bflo(bb) * (cw[cc] * bflo(a2) + cw[CW + cc] * bflo(a1) + cw[2 * CW + cc] * bflo(a0));
            y[2 * q + 1] = bfhi(bb) * (cw[cc + 1] * bfhi(a2) + cw[CW + cc + 1] * bfhi(a1) + cw[2 * CW + cc + 1] * bfhi(a0));
            ssq += y[2 * q] * y[2 * q] + y[2 * q + 1] * y[2 * q + 1];
        }
        ssq = row16_sum(ssq);
        const float ri = rsqrtf(ssq * (1.0f / 128) + EPS);
        u32x4 w;
        w.x = cvt_pk_bf16(y[0] * ri * cn[c], y[1] * ri * cn[c + 1]); w.y = cvt_pk_bf16(y[2] * ri * cn[c + 2], y[3] * ri * cn[c + 3]);
        w.z = cvt_pk_bf16(y[4] * ri * cn[c + 4], y[5] * ri * cn[c + 5]); w.w = cvt_pk_bf16(y[6] * ri * cn[c + 6], y[7] * ri * cn[c + 7]);
        *(u32x4*)(MIX + (size_t)row * DM + HW + c) = w;
    }
}

__device__ __forceinline__ void hgrn_pass_c(const Args& a, LAS unsigned char* lds, int wave, int lane) {
    unsigned char* ws = a.ws;
    const float* LF = (const float*)(ws + WS_LF); const bf16_t* VH = (const bf16_t*)(ws + WS_VH); const bf16_t* QS = (const bf16_t*)(ws + WS_QS); const bf16_t* GH = (const bf16_t*)(ws + WS_GH);
    const bf16_t* SP = (const bf16_t*)(ws + WS_S); bf16_t* MIX = (bf16_t*)(ws + WS_MIX); const float* hn = a.in[10];
    const int tid = threadIdx.x, k = tid & 127, sg = tid >> 7, fr = lane & 15, fq = lane >> 4;
    LAS bf16_t* QT = (LAS bf16_t*)(lds + L_QT); LAS bf16_t* QH = (LAS bf16_t*)(lds + L_QH); LAS bf16_t* KA = (LAS bf16_t*)(lds + L_KA); LAS bf16_t* KB = (LAS bf16_t*)(lds + L_KB);
    LAS bf16_t* ST = (LAS bf16_t*)(lds + L_ST); LAS bf16_t* VT = (LAS bf16_t*)(lds + L_VT); LAS bf16_t* P = (LAS bf16_t*)(lds + L_P);
    LAS float* SEG = (LAS float*)(lds + L_SEG); LAS float* PART = (LAS float*)(lds + L_PART); LAS float* RINV = (LAS float*)(lds + L_RINV);
    const f32x4 hnv = *(const f32x4*)(hn + 16 * wave + 4 * fq);
    const int k0 = 2 * (tid & 63);
    f32x2v lf2[8]; unsigned q2[8]; u32x4 vv[2], sv[4];
#define PC_LOAD(it) do { const int r0_ = ((it) >> 3) * 64, c0_ = ((it) & 7) * 128; \
        _Pragma("unroll") for (int i = 0; i < 8; ++i) { lf2[i] = *(const f32x2v*)(LF + (size_t)(r0_ + 8 * wave + i) * HW + c0_ + k0); q2[i] = *(const unsigned*)(QS + (size_t)(r0_ + 8 * wave + i) * HW + c0_ + k0); } \
        _Pragma("unroll") for (int j = 0; j < 2; ++j) { const int idx = tid + 512 * j; vv[j] = *(const u32x4*)(VH + (size_t)(r0_ + (idx >> 4)) * HW + c0_ + 8 * (idx & 15)); } \
        _Pragma("unroll") for (int j = 0; j < 4; ++j) { const int idx = tid + 512 * j; sv[j] = *(const u32x4*)(SP + (size_t)(it) * 16384 + (idx >> 4) * 128 + 8 * (idx & 15)); } } while (0)
    int item = blockIdx.x;
    if (item < 1024) PC_LOAD(item);
    for (; item < 1024; item += gridDim.x) {
        const int row0 = (item >> 3) * 64, cb = (item & 7) * 128;
        u32x2 gh[4];
#pragma unroll
        for (int tt = 0; tt < 4; ++tt) gh[tt] = *(const u32x2*)(GH + (size_t)(row0 + 16 * tt + fr) * HW + cb + 16 * wave + 4 * fq);
        f32x2v b2[8]; f32x2v run = {0.f, 0.f};
#pragma unroll
        for (int i = 0; i < 8; ++i) { run += lf2[i]; b2[i] = run; }
        *(LAS f32x2v*)(SEG + wave * 128 + k0) = run;
        LDSBAR();
        f32x2v pre = {0.f, 0.f}, beta1 = {0.f, 0.f};
#pragma unroll
        for (int j = 0; j < 8; ++j) { const f32x2v sj = *(const LAS f32x2v*)(SEG + j * 128 + k0); if (j < wave) pre += sj; if (j < 4) beta1 += sj; }
        if (wave < 4) {
#pragma unroll
            for (int i = 0; i < 8; ++i) {
                const int so = (8 * wave + i) * HP + k0; const f32x2v bi = pre + b2[i];
                const float kk0 = 1.0f - __expf(lf2[i][0]), kk1 = 1.0f - __expf(lf2[i][1]);
                const unsigned qw = cvt_pk_bf16(bflo(q2[i]) * __expf(bi[0]), bfhi(q2[i]) * __expf(bi[1]));
                *(LAS unsigned*)(QT + so) = qw; *(LAS unsigned*)(QH + so) = qw;
                *(LAS unsigned*)(KA + so) = cvt_pk_bf16(kk0 * __expf(fminf(-bi[0], 80.f)), kk1 * __expf(fminf(-bi[1], 80.f)));
                *(LAS unsigned*)(KB + so) = cvt_pk_bf16(kk0 * __expf(beta1[0] - bi[0]), kk1 * __expf(beta1[1] - bi[1]));
            }
        } else {
#pragma unroll
            for (int i = 0; i < 8; ++i) {
                const int so = (8 * wave + i) * HP + k0; const f32x2v bi = pre + b2[i];
                const float kk0 = 1.0f - __expf(lf2[i][0]), kk1 = 1.0f - __expf(lf2[i][1]);
                const float q0 = bflo(q2[i]), q1 = bfhi(q2[i]);
                *(LAS unsigned*)(QH + so) = cvt_pk_bf16(q0 * __expf(bi[0]), q1 * __expf(bi[1]));
                *(LAS unsigned*)(QT + so) = cvt_pk_bf16(q0 * __expf(bi[0] - beta1[0]), q1 * __expf(bi[1] - beta1[1]));
                *(LAS unsigned*)(KA + so) = cvt_pk_bf16(kk0 * __expf(fminf(beta1[0] - bi[0], 80.f)), kk1 * __expf(fminf(beta1[1] - bi[1], 80.f)));
            }
        }
#pragma unroll
        for (int j = 0; j < 2; ++j) { const int idx = tid + 512 * j, s = (idx >> 4) ^ ((((idx & 15) >> 1) & 7) << 3), v0 = 8 * (idx & 15);
            VT[(v0 + 0) * VP + s] = (bf16_t)(vv[j].x & 0xffffu); VT[(v0 + 1) * VP + s] = (bf16_t)(vv[j].x >> 16);
            VT[(v0 + 2) * VP + s] = (bf16_t)(vv[j].y & 0xffffu); VT[(v0 + 3) * VP + s] = (bf16_t)(vv[j].y >> 16);
            VT[(v0 + 4) * VP + s] = (bf16_t)(vv[j].z & 0xffffu); VT[(v0 + 5) * VP + s] = (bf16_t)(vv[j].z >> 16);
            VT[(v0 + 6) * VP + s] = (bf16_t)(vv[j].w & 0xffffu); VT[(v0 + 7) * VP + s] = (bf16_t)(vv[j].w >> 16); }
#pragma unroll
        for (int j = 0; j < 4; ++j) { const int idx = tid + 512 * j; *(LAS u32x4*)(ST + (idx >> 4) * HP + 8 * (idx & 15)) = sv[j]; }
        if (item + (int)gridDim.x < 1024) PC_LOAD(item + (int)gridDim.x);
        LDSBAR();
#pragma unroll
        for (int pp = 0; pp < 2; ++pp) {
            const int p = wave + 8 * pp, tt = p >> 2, st = p & 3;
            f32x4 acc = {0.f, 0.f, 0.f, 0.f};
            if (st <= tt) {
                const LAS bf16_t* kb = (tt >= 2 && st < 2) ? KB : KA;
#pragma unroll
                for (int ks = 0; ks < 4; ++ks) { const bf16x8 af = *(const LAS bf16x8*)(QT + (16 * tt + fr) * HP + ks * 32 + fq * 8), bfr = *(const LAS bf16x8*)(kb + (16 * st + fr) * HP + ks * 32 + fq * 8);
                    acc = MFMA16(af, bfr, acc); }
            }
#pragma unroll
            for (int r = 0; r < 4; ++r) { const bool keep = (st < tt) || (st == tt && fr <= 4 * fq + r); P[(16 * tt + 4 * fq + r) * VP + 16 * st + fr] = f2bf(keep ? acc[r] : 0.f); }
        }
        LDSBAR();
        bf16x8 bs[4], bv[2];
#pragma unroll
        for (int ks = 0; ks < 4; ++ks) bs[ks] = *(const LAS bf16x8*)(ST + (16 * wave + fr) * HP + ks * 32 + fq * 8);
#pragma unroll
        for (int ks = 0; ks < 2; ++ks) bv[ks] = *(const LAS bf16x8*)(VT + (16 * wave + fr) * VP + ((ks * 32 + fq * 8) ^ (wave << 3)));
        f32x4 o[4];
#pragma unroll
        for (int tt = 0; tt < 4; ++tt) {
            f32x4 acc = {0.f, 0.f, 0.f, 0.f};
#pragma unroll
            for (int ks = 0; ks < 4; ++ks) { const bf16x8 af = *(const LAS bf16x8*)(QH + (16 * tt + fr) * HP + ks * 32 + fq * 8); acc = MFMA16(bs[ks], af, acc); }
            { const bf16x8 af = *(const LAS bf16x8*)(P + (16 * tt + fr) * VP + fq * 8); acc = MFMA16(bv[0], af, acc); }
            if (tt >= 2) { const bf16x8 af = *(const LAS bf16x8*)(P + (16 * tt + fr) * VP + 32 + fq * 8); acc = MFMA16(bv[1], af, acc); }
            o[tt] = acc;
        }
#pragma unroll
        for (int tt = 0; tt < 4; ++tt) { float x = (o[tt][0] * o[tt][0] + o[tt][1] * o[tt][1]) + (o[tt][2] * o[tt][2] + o[tt][3] * o[tt][3]);
            x += __shfl_xor(x, 16); x += __shfl_xor(x, 32);
            if (fq == 0) PART[wave * 64 + 16 * tt + fr] = x; }
        LDSBAR();
        if (tid < 64) { float s = 0.f;
#pragma unroll
            for (int w = 0; w < 8; ++w) s += PART[w * 64 + tid];
            RINV[tid] = rsqrtf(s * (1.0f / 128) + EPS); }
        LDSBAR();
#pragma unroll
        for (int tt = 0; tt < 4; ++tt) { const float ri = RINV[16 * tt + fr];
            u32x2 w; w.x = cvt_pk_bf16(o[tt][0] * ri * hnv[0] * bflo(gh[tt].x), o[tt][1] * ri * hnv[1] * bfhi(gh[tt].x));
            w.y = cvt_pk_bf16(o[tt][2] * ri * hnv[2] * bflo(gh[tt].y), o[tt][3] * ri * hnv[3] * bfhi(gh[tt].y));
            *(u32x2*)(MIX + (size_t)(row0 + 16 * tt + fr) * DM + cb + 16 * wave + 4 * fq) = w; }
        LDSBAR();
    }
#undef PC_LOAD
}

__device__ __forceinline__ void phase_final(const Args& a, int wave, int lane) {
    const int gw = blockIdx.x * 8 + wave, NGW = gridDim.x * 8; const float* gF = a.in[20]; const bf16_t* H4 = (const bf16_t*)(a.ws + WS_MIX);
    for (int m = gw; m < M_TOK; m += NGW) {
        const u32x4* hr = (const u32x4*)(H4 + (size_t)m * DM) + lane; u32x4 w[4]; float s = 0.f;
#pragma unroll
        for (int j = 0; j < 4; ++j) { w[j] = __builtin_nontemporal_load(hr + 64 * j);
            s += (bflo(w[j].x) * bflo(w[j].x) + bfhi(w[j].x) * bfhi(w[j].x)) + (bflo(w[j].y) * bflo(w[j].y) + bfhi(w[j].y) * bfhi(w[j].y))
               + (bflo(w[j].z) * bflo(w[j].z) + bfhi(w[j].z) * bfhi(w[j].z)) + (bflo(w[j].w) * bflo(w[j].w) + bfhi(w[j].w) * bfhi(w[j].w)); }
        const float ri = rinv_of(wave_sum(s));
        f32x4* orow = (f32x4*)(a.out + (size_t)m * DM);
#pragma unroll
        for (int j = 0; j < 4; ++j) { const int c = (64 * j + lane) * 8; const f32x4 g0 = *(const f32x4*)(gF + c), g1 = *(const f32x4*)(gF + c + 4);
            f32x4 o0, o1; o0[0] = bflo(w[j].x) * ri * g0[0]; o0[1] = bfhi(w[j].x) * ri * g0[1]; o0[2] = bflo(w[j].y) * ri * g0[2]; o0[3] = bfhi(w[j].y) * ri * g0[3];
            o1[0] = bflo(w[j].z) * ri * g1[0]; o1[1] = bfhi(w[j].z) * ri * g1[1]; o1[2] = bflo(w[j].w) * ri * g1[2]; o1[3] = bfhi(w[j].w) * ri * g1[3];
            __builtin_nontemporal_store(o0, orow + c / 4); __builtin_nontemporal_store(o1, orow + c / 4 + 1); }
    }
}

#define XB_TMO      128
#define XB_XCNT(j)  (256  + 64 * (j))
#define XB_XSUB(j)  (1280 + 64 * (j))
#define XB_XGEN(j)  (2304 + 64 * (j))
#define XB_TOP      3328
#define XB_TOPGEN   3392
#define XCD_BAR_WORDS 3456
#define XB_SPIN_CAP (1u << 18)

__device__ __forceinline__ unsigned xb_ld(unsigned* p)              { return __hip_atomic_load(p, __ATOMIC_RELAXED, __HIP_MEMORY_SCOPE_AGENT); }
__device__ __forceinline__ unsigned xb_add(unsigned* p, unsigned v) { return __hip_atomic_fetch_add(p, v, __ATOMIC_RELAXED, __HIP_MEMORY_SCOPE_AGENT); }
__device__ __forceinline__ unsigned xb_xcc_id() { return (unsigned)__builtin_amdgcn_s_getreg((3 << 11) | 20) & 0xFu; }
#define XB_SPIN(cond, bar) do { unsigned _sp = 0; while (cond) { __builtin_amdgcn_s_sleep(1); \
    if ((++_sp & 255u) == 0u) { if (xb_ld(&(bar)[XB_TMO])) break; if (_sp > XB_SPIN_CAP) { atomicAdd(&(bar)[XB_TMO], 1u); break; } } } } while (0)

struct XcdBarrier {
    unsigned* bar; unsigned x;
    volatile LAS unsigned* st;
};

__device__ __forceinline__ XcdBarrier xcd_barrier_post(unsigned* bar, volatile LAS unsigned* st) {
    XcdBarrier b; b.bar = bar; b.x = xb_xcc_id(); b.st = st;
    if (threadIdx.x == 0) (void)xb_add(&bar[XB_XCNT(b.x)], 1u);
    return b;
}
__device__ __forceinline__ void xcd_barrier_complete(unsigned* bar, unsigned x, unsigned& nloc, unsigned& nx) {
    const unsigned G = gridDim.x * gridDim.y * gridDim.z;
    unsigned sum, cnt, mine, sp = 0u;
    for (;;) {
        sum = 0u; cnt = 0u; mine = 0u;
#pragma unroll
        for (unsigned j = 0; j < 16; ++j) { const unsigned c = xb_ld(&bar[XB_XCNT(j)]); sum += c; cnt += (c > 0u) ? 1u : 0u; mine = (j == x) ? c : mine; }
        if (sum == G) break;
        __builtin_amdgcn_s_sleep(1);
        if ((++sp & 255u) == 0u) { if (xb_ld(&bar[XB_TMO])) break; if (sp > XB_SPIN_CAP) { atomicAdd(&bar[XB_TMO], 1u); break; } }
    }
    nloc = mine > 0u ? mine : 1u; nx = cnt > 0u ? cnt : 1u;
}

__device__ __forceinline__ void xcd_barrier(const XcdBarrier& b) {
    asm volatile("s_waitcnt vmcnt(0)" ::: "memory");
    __syncthreads();
    if (threadIdx.x == 0) {
        unsigned* bar = b.bar;
        __builtin_amdgcn_s_waitcnt(0);
        unsigned nloc = b.st[0], nx = b.st[1];
        if (nloc == 0u) { xcd_barrier_complete(bar, b.x, nloc, nx); b.st[0] = nloc; b.st[1] = nx; }
        const unsigned old = xb_add(&bar[XB_XSUB(b.x)], 1u);
        const unsigned gen = old / nloc;
        if (old + 1u == (gen + 1u) * nloc) {
            __builtin_amdgcn_fence(__ATOMIC_RELEASE, "agent");
            asm volatile("s_waitcnt vmcnt(0)" ::: "memory");
            const unsigned og = xb_add(&bar[XB_TOP], 1u);
            const unsigned tg = og / nx;
            if (og + 1u == (tg + 1u) * nx) xb_add(&bar[XB_TOPGEN], 1u);
            else XB_SPIN(xb_ld(&bar[XB_TOPGEN]) == tg, bar);
            __builtin_amdgcn_fence(__ATOMIC_ACQUIRE, "agent");
            xb_add(&bar[XB_XGEN(b.x)], 1u);
            asm volatile("s_waitcnt vmcnt(0)" ::: "memory");
        } else {
            XB_SPIN(xb_ld(&bar[XB_XGEN(b.x)]) == gen, bar);
            __builtin_amdgcn_fence(__ATOMIC_ACQUIRE, "agent");
            asm volatile("s_waitcnt vmcnt(0)" ::: "memory");
        }
    }
    __syncthreads();
}


template <class Epi>
__device__ __forceinline__ void run_gemm(LAS unsigned char* lds, const bf16_t* A, const bf16_t* Bt, int N, int K, const Epi& E, int vc) {
    pg8::Gemm g; g.A = A; g.Bt = Bt; g.M = M_TOK; g.N = N; g.K = K;
    pg8::StaticOrder S; S.init(M_TOK, N, (int)gridDim.x, vc);
    pg8::gemm_phase<Epi, pg8::StaticOrder, true, true>(lds, g, S, E);
}
struct TailOrder {
    int c, n;
    __device__ __forceinline__ bool next(int i, Unit& u) const { if (c < 0) return false; const int L = i * n + c; if (L >= 256) return false; u.pm = L >> 3; u.pn = L & 7; return true; }
    __device__ __forceinline__ void a_ready(const Unit&) const {}
    __device__ __forceinline__ void done(const Unit&) const {}
};

__global__ void __launch_bounds__(512, 2) fwd_kernel(Args a) {
    extern __shared__ __attribute__((aligned(16))) unsigned char lds_raw[];
    LAS unsigned char* lds = (LAS unsigned char*)lds_raw;
    cg::grid_group grid = cg::this_grid();
    volatile LAS unsigned* xst = (volatile LAS unsigned*)(lds + LDS_BYTES - 16);
    if (threadIdx.x < 4) xst[threadIdx.x] = 0u;
    __syncthreads();
    XcdBarrier xbar = xcd_barrier_post((unsigned*)(a.ws + WS_BAR), xst);
    unsigned* cen = (unsigned*)(a.ws + WS_BAR) + 3584;
    if (threadIdx.x == 0) xst[2] = xb_add(&cen[64 * xbar.x], 1u);
    if (a.ph_lo == 0 && a.ph_hi == NPHASE) grid.sync();
    int vc = blockIdx.x;
    if (a.ph_lo == 0 && a.ph_hi == NPHASE && gridDim.x == 256) {
        bool even = true;
#pragma unroll
        for (int j = 0; j < 8; ++j) even = even && (xb_ld(&cen[64 * j]) == 32u);
        if (even) vc = (int)xst[2] * 8 + (int)xbar.x;
    }
    vc = __builtin_amdgcn_readfirstlane(vc);
    const int tid = threadIdx.x, lane = tid & 63, wave = __builtin_amdgcn_readfirstlane(tid >> 6);
    unsigned char* ws = a.ws;
    float* SS = (float*)(ws + WS_SS);
    bf16_t* XB = (bf16_t*)(ws + WS_XB); bf16_t* G = (bf16_t*)(ws + WS_G); bf16_t* MIX = (bf16_t*)(ws + WS_MIX);
#define PH(i) if (a.ph_lo <= (i) && (i) < a.ph_hi)
#define SYNC(i) if (a.ph_lo <= (i) && (i) + 1 < a.ph_hi) { xcd_barrier(xbar); }
    PH(0) { phase0(a, lds, wave, lane); } SYNC(0)
    PH(1) { EpiGateUp E; E.G = G; E.ss = SS; run_gemm(lds, XB, (const bf16_t*)(ws + WS_W1GU), 2 * FF, DM, E, vc); conv_tail(a, lds, wave, lane, 32 * 44, CV_P0, CV_WO, vc); conv_tail(a, lds, wave, lane, 32 * 44, CV_T1, CV_END, vc); } SYNC(1)
    PH(2) { EpiResid E; E.XB = XB; E.ss_out = SS + 8192; E.scale = 0.5f; run_gemm(lds, G, (const bf16_t*)(ws + WS_W1D), DM, FF, E, vc); } SYNC(2)
    PH(3) { EpiMixIn E; E.ss = SS + 8192; E.lbl = a.in[9]; E.QS = (bf16_t*)(ws + WS_QS);
            E.UC = (bf16_t*)(ws + WS_UC); E.LF = (float*)(ws + WS_LF); run_gemm(lds, XB, (const bf16_t*)(ws + WS_WIN), MIXIN, DM, E, vc); conv_tail(a, lds, wave, lane, 32 * 28, CV_WO, CV_TA, vc); conv_tail(a, lds, wave, lane, 32 * 28, CV_T0, CV_T1, vc); } SYNC(3)
    PH(4) { hgrn_pass_a(a, lds, wave, lane); } SYNC(4)
    PH(5) { hgrn_scan(a); conv_mixer(a, wave, lane); } SYNC(5)
    PH(6) { hgrn_pass_c(a, lds, wave, lane); } SYNC(6)
    PH(7) { EpiResid E; E.XB = XB; E.ss_out = SS + 16384; E.scale = 1.0f; run_gemm(lds, MIX, (const bf16_t*)(ws + WS_WOUT), DM, DM, E, vc); } SYNC(7)
    PH(8) { EpiGateUp E; E.G = G; E.ss = SS + 16384; run_gemm(lds, XB, (const bf16_t*)(ws + WS_W2GU), 2 * FF, DM, E, vc);
            { const int r = (32 * 44) % (int)gridDim.x; TailOrder T; T.n = (int)gridDim.x - r; T.c = vc - r;
              EpiStoreBf16 E2; E2.O = (bf16_t*)(ws + WS_PLE); int kp = PLE; asm volatile("" : "+s"(kp));
              pg8::Gemm g2; g2.A = (const bf16_t*)(ws + WS_PB); g2.Bt = (const bf16_t*)(ws + WS_WPE); g2.M = M_TOK; g2.N = DM; g2.K = kp;
              pg8::gemm_phase<EpiStoreBf16, TailOrder, true, true>(lds, g2, T, E2); }
            conv_tail(a, lds, wave, lane, 32 * 44, CV_TA, CV_T0, vc); } SYNC(8)
    PH(9) { EpiResid E; E.XB = XB; E.ss_out = SS + 24576; E.scale = 0.5f; run_gemm(lds, G, (const bf16_t*)(ws + WS_W2D), DM, FF, E, vc); } SYNC(9)
    PH(10) { EpiPleGate E; E.XB = XB; E.H4 = MIX; E.P = (const bf16_t*)(ws + WS_PLE); E.ss = SS + 24576; run_gemm(lds, XB, (const bf16_t*)(ws + WS_WPG), DM, DM, E, vc); } SYNC(10)
    PH(11) { phase_final(a, wave, lane); }
#undef PH
#undef SYNC
}

#ifndef MK_MULTI
#define MK_MULTI 0
#endif
extern "C" void kernel_launch(void* const* d_in, const int* in_sizes, int n_in, void* d_out, int out_size, void* d_ws, size_t ws_size, hipStream_t stream) {
    static int grid = 0;
    if (grid == 0) {
        if (n_in != 21 || out_size != M_TOK * DM || ws_size < WS_END) { fprintf(stderr, "kernel_launch: unexpected shapes (n_in %d out %d ws %zu need %zu)\n", n_in, out_size, ws_size, (size_t)WS_END); grid = -1; return; }
        int dev = 0, cus = 0, per_cu = 0;
        hipGetDevice(&dev); hipDeviceGetAttribute(&cus, hipDeviceAttributeMultiprocessorCount, dev);
        if (hipFuncSetAttribute((const void*)fwd_kernel, hipFuncAttributeMaxDynamicSharedMemorySize, LDS_BYTES) != hipSuccess) { fprintf(stderr, "kernel_launch: hipFuncSetAttribute failed\n"); grid = -1; return; }
        if (hipOccupancyMaxActiveBlocksPerMultiprocessor(&per_cu, (const void*)fwd_kernel, 512, LDS_BYTES) != hipSuccess || per_cu < 1) { fprintf(stderr, "kernel_launch: occupancy query failed (%d)\n", per_cu); grid = -1; return; }
        grid = cus * per_cu;
    }
    if (grid < 0) return;
    Args a{};
    for (int i = 0; i < 21; ++i) a.in[i] = (const float*)d_in[i];
    a.out = (float*)d_out; a.ws = (unsigned char*)d_ws;
#if MK_MULTI
    for (int p = 0; p < NPHASE; ++p) { a.ph_lo = p; a.ph_hi = p + 1; hipLaunchKernelGGL(fwd_kernel, dim3(grid), dim3(512), LDS_BYTES, stream, a); }
#else
    a.ph_lo = 0; a.ph_hi = NPHASE;
    if (hipMemsetAsync((char*)d_ws + WS_BAR, 0, 4096 * 4, stream) != hipSuccess) { fprintf(stderr, "kernel_launch: memset failed\n"); return; }
    void* args[] = {&a};
    hipError_t e = hipLaunchCooperativeKernel((void*)fwd_kernel, dim3(grid), dim3(512), args, LDS_BYTES, stream);
    if (e != hipSuccess) fprintf(stderr, "cooperative launch failed: %s (grid %d)\n", hipGetErrorString(e), grid);
#endif
}
```
